# Optimizing an MI355X kernel written in HIP

```python
import math
import jax
import jax.numpy as jnp
from jax import lax
import numpy as np

D_MODEL = 1024
BATCH = 16
SEQ = 2048
DEPTH = 4

N_MIXERS = 4
EPS = 1e-6
F32 = jnp.float32
OUT_SCALE = 0.5
A_HEADS = 4
A_DQK = 128
A_DV = 256
A_CHUNK = 64
A_IN = 2 * A_HEADS * A_DQK + 2 * A_HEADS * A_DV + 2 * A_HEADS
B_HEADS = 8
B_DH = 128
B_BLOCK = 256
B_TOPK = 3
B_QBLOCK = 128
ROPE_THETA = 500000.0
ROPE_DIMS = B_DH // 4
B_IN = 3 * B_HEADS * B_DH
C_HEADS = 4
C_DK = D_MODEL // C_HEADS
C_DV = 2 * C_DK
C_CHUNK = 128
C_ROPE_THETA = 10000.0
C_IN = 2 * C_HEADS * C_DK + 2 * C_HEADS * C_DV
D_RNN = D_MODEL
D_BLOCKS = 4
D_BW = D_RNN // D_BLOCKS
D_CONV = 4
LRU_C = 8.0
D_FF = ((8 * D_MODEL // 3 + 255) // 256) * 256
N_LAYERS_A = len(range(0, DEPTH, N_MIXERS))
N_LAYERS_B = len(range(1, DEPTH, N_MIXERS))
N_LAYERS_C = len(range(2, DEPTH, N_MIXERS))
N_LAYERS_D = len(range(3, DEPTH, N_MIXERS))

kernel_name = 'interleaved_mlstm_moba_retention_rglru_trunk'


def rmsnorm(x, g):
    xf = x.astype(F32)
    y = xf * lax.rsqrt(jnp.mean(xf * xf, axis=-1, keepdims=True) + EPS)
    return (y * g.astype(F32)).astype(x.dtype)


def rotary(x, pos, n_rot, theta):
    half = n_rot // 2
    inv = theta ** (-jnp.arange(half, dtype=F32) * (2.0 / n_rot))
    ang = pos.astype(F32)[:, None, :, None] * inv
    cos, sin = jnp.cos(ang), jnp.sin(ang)
    xf = x.astype(F32)
    x1, x2 = xf[..., :half], xf[..., half:n_rot]
    out = jnp.concatenate([x1 * cos - x2 * sin, x2 * cos + x1 * sin, xf[..., n_rot:]], axis=-1)
    return out.astype(x.dtype)


def split_heads(t, h):
    b, s, _ = t.shape
    return t.reshape(b, s, h, -1).transpose(0, 2, 1, 3)


def merge_heads(t):
    b, h, s, d = t.shape
    return t.transpose(0, 2, 1, 3).reshape(b, s, h * d)


def to_chunks(t, l):
    b, h, s, d = t.shape
    return t.reshape(b, h, s // l, l, d).transpose(2, 0, 1, 3, 4)


def from_chunks(t):
    nc, b, h, l, d = t.shape
    return t.transpose(1, 2, 0, 3, 4).reshape(b, h, nc * l, d)


def mlstm_mixer(u, w_in, b_gates, g_out, w_out):
    b, s, _ = u.shape
    h, l = A_HEADS, A_CHUNK
    nc = s // l
    sq, sv = h * A_DQK, h * A_DV
    q, k, v, o, gl = jnp.split(u @ w_in, [sq, 2 * sq, 2 * sq + sv, 2 * sq + 2 * sv], axis=-1)
    gl = gl.astype(F32) + b_gates.astype(F32)
    log_i = gl[..., :h]
    log_f = jax.nn.log_sigmoid(gl[..., h:])
    qh = split_heads(q, h).astype(F32) * (A_DQK ** -0.5)
    kh = split_heads(k, h).astype(F32)
    vh = split_heads(v, h).astype(F32)

    def gate_chunks(g):
        return g.transpose(0, 2, 1).reshape(b, h, nc, l).transpose(2, 0, 1, 3)

    causal = jnp.tril(jnp.ones((l, l), dtype=bool))

    def step(carry, xs):
        c_st, n_st, m_st = carry
        qc, kc, vc, ic, fc = xs
        bcum = jnp.cumsum(fc, axis=-1)
        btot = bcum[..., -1]
        dmat = jnp.where(causal, bcum[..., :, None] - bcum[..., None, :] + ic[..., None, :], -jnp.inf)
        inter = bcum + m_st[..., None]
        m_t = jnp.maximum(inter, jnp.max(dmat, axis=-1))
        w_intra = jnp.exp(dmat - m_t[..., None])
        w_inter = jnp.exp(inter - m_t)
        qk = jnp.einsum('bhtd,bhsd->bhts', qc, kc) * w_intra
        num = jnp.einsum('bhts,bhsv->bhtv', qk, vc) + w_inter[..., None] * jnp.einsum('bhvd,bhtd->bhtv', c_st, qc)
        den = jnp.sum(qk, axis=-1) + w_inter * jnp.einsum('bhd,bhtd->bht', n_st, qc)
        h_out = num / jnp.maximum(jnp.abs(den), jnp.exp(-m_t))[..., None]
        dec = btot[..., None] - bcum + ic
        m_new = jnp.maximum(btot + m_st, jnp.max(dec, axis=-1))
        ws = jnp.exp(dec - m_new[..., None])
        wc = jnp.exp(btot + m_st - m_new)
        c_new = wc[..., None, None] * c_st + jnp.einsum('bhs,bhsv,bhsd->bhvd', ws, vc, kc)
        n_new = wc[..., None] * n_st + jnp.einsum('bhs,bhsd->bhd', ws, kc)
        return (c_new, n_new, m_new), h_out

    init = (jnp.zeros((b, h, A_DV, A_DQK), F32), jnp.zeros((b, h, A_DQK), F32), jnp.zeros((b, h), F32))
    xs = (to_chunks(qh, l), to_chunks(kh, l), to_chunks(vh, l), gate_chunks(log_i), gate_chunks(log_f))
    _, hc = lax.scan(step, init, xs)
    hs = rmsnorm(from_chunks(hc), g_out[:, None, :])
    y = merge_heads(hs).astype(u.dtype) * jax.nn.sigmoid(o)
    return y @ w_out


def moba_mixer(u, positions, w_in, g_q, g_k, w_out):
    b, s, _ = u.shape
    h, dh = B_HEADS, B_DH
    q, k, v = jnp.split(u @ w_in, 3, axis=-1)
    qh = rotary(rmsnorm(split_heads(q, h), g_q), positions, ROPE_DIMS, ROPE_THETA)
    kh = rotary(rmsnorm(split_heads(k, h), g_k), positions, ROPE_DIMS, ROPE_THETA)
    vh = split_heads(v, h)
    nblk = -(-s // B_BLOCK)
    sp = nblk * B_BLOCK
    pad = ((0, 0), (0, 0), (0, sp - s), (0, 0))
    qh, kh, vh = jnp.pad(qh, pad), jnp.pad(kh, pad), jnp.pad(vh, pad)
    kb = kh.reshape(b, h, nblk, B_BLOCK, dh)
    vb = vh.reshape(b, h, nblk, B_BLOCK, dh)
    kmean = jnp.mean(kb.astype(F32), axis=3)
    nqb = sp // B_QBLOCK
    per_blk = B_BLOCK // B_QBLOCK
    topk = min(B_TOPK, nblk - 1)
    qblocks = qh.reshape(b, h, nqb, B_QBLOCK, dh).transpose(0, 2, 1, 3, 4).reshape(b * nqb, h, B_QBLOCK, dh)
    scale = dh ** -0.5
    qoff = jnp.arange(B_QBLOCK)
    koff = jnp.arange(B_BLOCK)

    def attend(args):
        idx, qc = args
        bi = idx // nqb
        qi = idx % nqb
        j = qi // per_blk
        kb_b, vb_b = kb[bi], vb[bi]
        qf = qc.astype(F32) * scale
        qpos = qi * B_QBLOCK + qoff
        kpos = j * B_BLOCK + koff
        k_own = kb_b[:, j].astype(F32)
        v_own = vb_b[:, j].astype(F32)
        s_own = jnp.einsum('hqd,hnd->hqn', qf, k_own)
        s_own = jnp.where(kpos[None, None, :] <= qpos[None, :, None], s_own, -jnp.inf)
        if topk > 0:
            gate = jnp.einsum('hqd,hnd->hqn', qf, kmean[bi])
            gate = jnp.where(jnp.arange(nblk)[None, None, :] < j, gate, -jnp.inf)
            _, sel = lax.top_k(gate, topk)
            k_sel = jax.vmap(lambda kh_, ih_: kh_[ih_])(kb_b, sel).astype(F32)
            v_sel = jax.vmap(lambda vh_, ih_: vh_[ih_])(vb_b, sel).astype(F32)
            s_sel = jnp.einsum('hqd,hqtnd->hqtn', qf, k_sel)
            valid = jnp.arange(topk) < j
            s_sel = jnp.where(valid[None, None, :, None], s_sel, -jnp.inf)
            logits = jnp.concatenate([s_sel.reshape(h, B_QBLOCK, topk * B_BLOCK), s_own], axis=-1)
            p = jax.nn.softmax(logits, axis=-1)
            p_sel = p[..., :topk * B_BLOCK].reshape(h, B_QBLOCK, topk, B_BLOCK)
            out = jnp.einsum('hqtn,hqtnd->hqd', p_sel, v_sel) + jnp.einsum('hqn,hnd->hqd', p[..., topk * B_BLOCK:], v_own)
        else:
            p = jax.nn.softmax(s_own, axis=-1)
            out = jnp.einsum('hqn,hnd->hqd', p, v_own)
        return out.astype(qc.dtype)

    out = lax.map(attend, (jnp.arange(b * nqb, dtype=jnp.int32), qblocks))
    out = out.reshape(b, nqb, h, B_QBLOCK, dh).transpose(0, 2, 1, 3, 4).reshape(b, h, sp, dh)[:, :, :s]
    return merge_heads(out) @ w_out


def retention_mixer(u, positions, w_in, g_out, w_out):
    b, s, _ = u.shape
    h, l = C_HEADS, C_CHUNK
    sk, sv = h * C_DK, h * C_DV
    q, k, v, g = jnp.split(u @ w_in, [sk, 2 * sk, 2 * sk + sv], axis=-1)
    qh = rotary(split_heads(q, h), positions, C_DK, C_ROPE_THETA).astype(F32)
    kh = rotary(split_heads(k, h), positions, C_DK, C_ROPE_THETA).astype(F32) * (C_DK ** -0.5)
    vh = split_heads(v, h).astype(F32)
    log_g = jnp.log1p(-jnp.exp2(-5.0 - jnp.arange(h, dtype=F32)))
    idx = jnp.arange(l, dtype=F32)
    diff = idx[:, None] - idx[None, :]
    intra = jnp.where(diff >= 0, jnp.exp(jnp.maximum(diff, 0.0)[None] * log_g[:, None, None]), 0.0)
    xi = jnp.exp((idx + 1.0)[None, :] * log_g[:, None])
    zeta = jnp.exp((l - 1.0 - idx)[None, :] * log_g[:, None])
    g_chunk = jnp.exp(l * log_g)

    def step(r_st, xs):
        qc, kc, vc = xs
        inner = jnp.einsum('bhts,bhsv->bhtv', jnp.einsum('bhtd,bhsd->bhts', qc, kc) * intra, vc)
        cross = jnp.einsum('bhtd,bhdv->bhtv', qc, r_st) * xi[None, :, :, None]
        r_new = g_chunk[None, :, None, None] * r_st + jnp.einsum('bhsd,bhsv->bhdv', kc * zeta[None, :, :, None], vc)
        return r_new, inner + cross

    _, yc = lax.scan(step, jnp.zeros((b, h, C_DK, C_DV), F32), (to_chunks(qh, l), to_chunks(kh, l), to_chunks(vh, l)))
    ys = from_chunks(yc)
    mu = jnp.mean(ys, axis=-1, keepdims=True)
    var = jnp.mean(jnp.square(ys - mu), axis=-1, keepdims=True)
    yn = (ys - mu) * lax.rsqrt(var + EPS) * g_out[:, None, :].astype(F32)
    y = merge_heads(yn).astype(u.dtype) * jax.nn.silu(g)
    return y @ w_out


def lru_combine(c1, c2):
    a1, b1 = c1
    a2, b2 = c2
    return a1 * a2, a2 * b1 + b2


def rglru_mixer(u, w_in, conv_w, conv_b, w_gates, b_gates, lru_param, w_out):
    b, s, _ = u.shape
    gate_br, xb = jnp.split(u @ w_in, 2, axis=-1)
    xc = lax.conv_general_dilated(xb, conv_w[:, None, :].astype(xb.dtype), window_strides=(1,),
                                  padding=[(D_CONV - 1, 0)], dimension_numbers=('NWC', 'WIO', 'NWC'),
                                  feature_group_count=D_RNN) + conv_b
    gates = jnp.einsum('bsnc,nce->bsne', xc.reshape(b, s, D_BLOCKS, D_BW), w_gates) + b_gates
    r = jax.nn.sigmoid(gates[..., :D_BW].astype(F32)).reshape(b, s, D_RNN)
    i = jax.nn.sigmoid(gates[..., D_BW:].astype(F32)).reshape(b, s, D_RNN)
    log_a = -LRU_C * r * jax.nn.softplus(-lru_param.astype(F32))
    a = jnp.exp(log_a)
    bterm = jnp.sqrt(-jnp.expm1(2.0 * log_a)) * (i * xc.astype(F32))
    _, hs = lax.associative_scan(lru_combine, (a, bterm), axis=1)
    y = hs.astype(u.dtype) * jax.nn.gelu(gate_br)
    return y @ w_out


def swiglu(u, w_in, w_out):
    gt, up = jnp.split(u @ w_in, 2, axis=-1)
    return (jax.nn.silu(gt) * up) @ w_out


def setup_inputs(seed: int = 0) -> dict:
    key = jax.random.key(seed)
    ks = list(jax.random.split(key, 32))

    def rnd(shape, scale):
        return scale * jax.random.normal(ks.pop(), shape, F32)

    def gain(shape):
        return 1.0 + rnd(shape, 0.02)

    x = rnd((BATCH, SEQ, D_MODEL), 1.0)
    offs = jax.random.randint(ks.pop(), (BATCH, 1), 0, 1024, dtype=jnp.int32)
    positions = jnp.arange(SEQ, dtype=jnp.int32)[None, :] + offs
    norm_mix = gain((DEPTH, D_MODEL))
    norm_ffn = gain((DEPTH, D_MODEL))
    ffn_w_in = rnd((DEPTH, D_MODEL, 2 * D_FF), D_MODEL ** -0.5)
    ffn_w_out = rnd((DEPTH, D_FF, D_MODEL), OUT_SCALE * D_FF ** -0.5)
    a_w_in = rnd((N_LAYERS_A, D_MODEL, A_IN), D_MODEL ** -0.5)
    b_i = -1.0 + rnd((N_LAYERS_A, A_HEADS), 0.1)
    b_f = jnp.linspace(3.0, 6.0, A_HEADS, dtype=F32)[None, :] + rnd((N_LAYERS_A, A_HEADS), 0.1)
    a_b_gates = jnp.concatenate([b_i, b_f], axis=-1)
    a_g_out = gain((N_LAYERS_A, A_HEADS, A_DV))
    a_w_out = rnd((N_LAYERS_A, A_HEADS * A_DV, D_MODEL), OUT_SCALE * (A_HEADS * A_DV) ** -0.5)
    b_w_in = rnd((N_LAYERS_B, D_MODEL, B_IN), D_MODEL ** -0.5)
    b_g_q = gain((N_LAYERS_B, B_DH))
    b_g_k = gain((N_LAYERS_B, B_DH))
    b_w_out = rnd((N_LAYERS_B, B_HEADS * B_DH, D_MODEL), OUT_SCALE * (B_HEADS * B_DH) ** -0.5)
    c_w_in = rnd((N_LAYERS_C, D_MODEL, C_IN), D_MODEL ** -0.5)
    c_g_out = gain((N_LAYERS_C, C_HEADS, C_DV))
    c_w_out = rnd((N_LAYERS_C, C_HEADS * C_DV, D_MODEL), OUT_SCALE * (C_HEADS * C_DV) ** -0.5)
    d_w_in = rnd((N_LAYERS_D, D_MODEL, 2 * D_RNN), D_MODEL ** -0.5)
    d_conv_w = rnd((N_LAYERS_D, D_CONV, D_RNN), D_CONV ** -0.5)
    d_conv_b = rnd((N_LAYERS_D, D_RNN), 0.02)
    d_w_gates = rnd((N_LAYERS_D, D_BLOCKS, D_BW, 2 * D_BW), D_BW ** -0.5)
    d_b_gates = rnd((N_LAYERS_D, D_BLOCKS, 2 * D_BW), 0.1)
    a0 = jax.random.uniform(ks.pop(), (N_LAYERS_D, D_RNN), F32, minval=0.9, maxval=0.999)
    d_lru = jnp.log(a0) - jnp.log1p(-a0)
    d_w_out = rnd((N_LAYERS_D, D_RNN, D_MODEL), OUT_SCALE * D_RNN ** -0.5)
    return {'x': x, 'positions': positions, 'norm_mix': norm_mix, 'norm_ffn': norm_ffn,
            'ffn_w_in': ffn_w_in, 'ffn_w_out': ffn_w_out,
            'a_w_in': a_w_in, 'a_b_gates': a_b_gates, 'a_g_out': a_g_out, 'a_w_out': a_w_out,
            'b_w_in': b_w_in, 'b_g_q': b_g_q, 'b_g_k': b_g_k, 'b_w_out': b_w_out,
            'c_w_in': c_w_in, 'c_g_out': c_g_out, 'c_w_out': c_w_out,
            'd_w_in': d_w_in, 'd_conv_w': d_conv_w, 'd_conv_b': d_conv_b, 'd_w_gates': d_w_gates,
            'd_b_gates': d_b_gates, 'd_lru': d_lru, 'd_w_out': d_w_out}


def reference(x, positions, norm_mix, norm_ffn, ffn_w_in, ffn_w_out,
              a_w_in, a_b_gates, a_g_out, a_w_out,
              b_w_in, b_g_q, b_g_k, b_w_out,
              c_w_in, c_g_out, c_w_out,
              d_w_in, d_conv_w, d_conv_b, d_w_gates, d_b_gates, d_lru, d_w_out):
    h = x
    for layer in range(DEPTH):
        mixer, r = layer % N_MIXERS, layer // N_MIXERS
        u = rmsnorm(h, norm_mix[layer])
        if mixer == 0:
            y = mlstm_mixer(u, a_w_in[r], a_b_gates[r], a_g_out[r], a_w_out[r])
        elif mixer == 1:
            y = moba_mixer(u, positions, b_w_in[r], b_g_q[r], b_g_k[r], b_w_out[r])
        elif mixer == 2:
            y = retention_mixer(u, positions, c_w_in[r], c_g_out[r], c_w_out[r])
        else:
            y = rglru_mixer(u, d_w_in[r], d_conv_w[r], d_conv_b[r], d_w_gates[r], d_b_gates[r], d_lru[r], d_w_out[r])
        h = h + y
        h = h + swiglu(rmsnorm(h, norm_ffn[layer]), ffn_w_in[layer], ffn_w_out[layer])
    return h
```

```cpp
#include <hip/hip_runtime.h>
#include <cstdio>
#include <cstdint>
#include <cmath>
namespace pg8 {
#define PG8_LAS __attribute__((address_space(3)))
typedef unsigned short bf16_t;
typedef short bf16x8 __attribute__((ext_vector_type(8)));
typedef float f32x4 __attribute__((ext_vector_type(4)));
typedef unsigned u32x4 __attribute__((ext_vector_type(4)));
constexpr int BM = 256, BK = 64, HALF = 128, HTB = HALF * BK * 2  , STAGE_BYTES = 8 * HTB, NXCD = 8, WGM = 8;

__host__ __device__ __forceinline__ int lds_byte(int r, int c) { const int st = (r >> 4) * 2 + (c >> 5), rr = r & 15, cc = c & 31, ob = rr * 64 + cc * 2; return st * 1024 + (ob ^ (((ob >> 9) & 1) << 5)); }
__host__ __device__ __forceinline__ void stage_rc(int b, int& R, int& C) { const int st = b / 1024, sb = b % 1024, swz = sb ^ (((sb >> 9) & 1) << 5); R = (st >> 1) * 16 + swz / 64; C = (st & 1) * 32 + (swz % 64) / 2; }
__host__ __device__ __forceinline__ int perm32(int rho) { const int n = rho >> 4, i = rho & 15; return 8 * (i >> 2) + 4 * n + (i & 3); }

struct Unit { int pm, pn; };
struct Gemm { const bf16_t* A; const bf16_t* Bt; int M, N, K, lda, ldb; };

struct StaticOrder {
    int nM, nN, nwg, G, c;
    __host__ __device__ void init(int M, int N, int G_, int c_) { nM = M / BM; nN = N / BM; nwg = nM * nN; G = G_; c = c_; }
    __host__ __device__ bool next(int i, Unit& u) const {
        const long L = (long)i * G + c; if (L >= nwg) return false;
        int wgid = (int)L; { const int q = nwg / NXCD, r = nwg % NXCD, xcd = wgid % NXCD, off = wgid / NXCD; wgid = (xcd < r ? xcd * (q + 1) : r * (q + 1) + (xcd - r) * q) + off; }
        const int nig = WGM * nN, gid = wgid / nig, fm = gid * WGM, gsz = (nM - fm) < WGM ? (nM - fm) : WGM;
        u.pm = fm + ((wgid % nig) % gsz); u.pn = (wgid % nig) / gsz; return true;
    }
    __device__ __forceinline__ void a_ready(const Unit&) const {}
    __device__ __forceinline__ void done(const Unit&) const {}
};

__device__ __forceinline__ unsigned cvt_pk_bf16(float lo, float hi) { unsigned r; asm volatile("v_cvt_pk_bf16_f32 %0, %1, %2" : "=v"(r) : "v"(lo), "v"(hi)); return r; }
typedef float f32x2 __attribute__((ext_vector_type(2)));

__device__ __forceinline__ float bf2f(unsigned short b) { return __uint_as_float(((unsigned)b) << 16); }
__device__ __forceinline__ float lo_bf(unsigned w) { return __uint_as_float(w << 16); }
__device__ __forceinline__ float hi_bf(unsigned w) { return __uint_as_float(w & 0xffff0000u); }
__device__ __forceinline__ float fast_sigmoid(float x) { return __builtin_amdgcn_rcpf(1.0f + __expf(-x)); }

struct EpiStore {
    static constexpr bool PERM = true, AFTER_DRAIN = false;
    bf16_t* O; int ldc;
    __device__ __forceinline__ void operator()(const f32x4 (&acc)[2][2][4][2], const Unit& u, int wr, int wc, int fr, int fq) const {
        const int row0 = u.pm * BM + wr * 64 + fr, col0 = u.pn * BM + wc * 32 + 8 * fq;
#pragma unroll
        for (int ai = 0; ai < 2; ++ai)
#pragma unroll
            for (int m = 0; m < 4; ++m) { bf16_t* rowp = O + (size_t)(row0 + ai * HALF + m * 16) * ldc + col0;
#pragma unroll
                for (int bj = 0; bj < 2; ++bj) { const f32x4 v0 = acc[ai][bj][m][0], v1 = acc[ai][bj][m][1];
                    u32x4 w; w.x = cvt_pk_bf16(v0[0], v0[1]); w.y = cvt_pk_bf16(v0[2], v0[3]); w.z = cvt_pk_bf16(v1[0], v1[1]); w.w = cvt_pk_bf16(v1[2], v1[3]);
                    *(u32x4*)(rowp + bj * HALF) = w; } }
    }
};
struct EpiSwiGLU {
    static constexpr bool PERM = true, AFTER_DRAIN = false;
    bf16_t* O; int ldc;
    __device__ __forceinline__ void operator()(const f32x4 (&acc)[2][2][4][2], const Unit& u, int wr, int wc, int fr, int fq) const {
        const int row0 = u.pm * BM + wr * 64 + fr, col0 = u.pn * HALF + wc * 32 + 8 * fq;
#pragma unroll
        for (int ai = 0; ai < 2; ++ai)
#pragma unroll
            for (int m = 0; m < 4; ++m) { bf16_t* rowp = O + (size_t)(row0 + ai * HALF + m * 16) * ldc + col0;
                float h[8];
#pragma unroll
                for (int n = 0; n < 2; ++n)
#pragma unroll
                    for (int j = 0; j < 4; ++j) { const float g = acc[ai][0][m][n][j], up = acc[ai][1][m][n][j]; h[4 * n + j] = g * fast_sigmoid(g) * up; }
                u32x4 w; w.x = cvt_pk_bf16(h[0], h[1]); w.y = cvt_pk_bf16(h[2], h[3]); w.z = cvt_pk_bf16(h[4], h[5]); w.w = cvt_pk_bf16(h[6], h[7]);
                *(u32x4*)rowp = w; }
    }
};
struct EpiResid {
    static constexpr bool PERM = false, AFTER_DRAIN = false;
    const float* base; float* out; int ldc;
    __device__ __forceinline__ void operator()(const f32x4 (&acc)[2][2][4][2], const Unit& u, int wr, int wc, int fr, int fq) const {
        const int row0 = u.pm * BM + wr * 64 + fr, col0 = u.pn * BM + wc * 32 + 4 * fq;
#pragma unroll
        for (int ai = 0; ai < 2; ++ai)
#pragma unroll
            for (int m = 0; m < 4; ++m) { const size_t off = (size_t)(row0 + ai * HALF + m * 16) * ldc + col0;
#pragma unroll
                for (int bj = 0; bj < 2; ++bj)
#pragma unroll
                    for (int n = 0; n < 2; ++n) { const f32x4 b = *(const f32x4*)(base + off + bj * HALF + n * 16); *(f32x4*)(out + off + bj * HALF + n * 16) = b + acc[ai][bj][m][n]; } }
    }
};
struct EpiGateA {
    static constexpr bool PERM = true, AFTER_DRAIN = false;
    bf16_t* Y; const float* ssq; const float* gout;
    __device__ __forceinline__ void operator()(const f32x4 (&acc)[2][2][4][2], const Unit& u, int wr, int wc, int fr, int fq) const {
        const int row0 = u.pm * BM + wr * 64 + fr, col0 = u.pn * BM + wc * 32 + 8 * fq;
        f32x4 gv[2][2];
#pragma unroll
        for (int bj = 0; bj < 2; ++bj)
#pragma unroll
            for (int n = 0; n < 2; ++n) gv[bj][n] = *(const f32x4*)(gout + col0 + bj * HALF + 4 * n);
#pragma unroll
        for (int ai = 0; ai < 2; ++ai)
#pragma unroll
            for (int m = 0; m < 4; ++m) { const int row = row0 + ai * HALF + m * 16; bf16_t* rowp = Y + (size_t)row * 1024 + col0;
                const f32x4 sp = *(const f32x4*)(ssq + (size_t)row * 16 + u.pn * 4);
                const float rstd = 1.0f / sqrtf(((sp[0] + sp[1]) + (sp[2] + sp[3])) * (1.0f / 256.0f) + 1e-6f);
#pragma unroll
                for (int bj = 0; bj < 2; ++bj) { const u32x4 hw = *(const u32x4*)(rowp + bj * HALF); float o[8];
                    const unsigned hh[4] = {hw.x, hw.y, hw.z, hw.w};
#pragma unroll
                    for (int n = 0; n < 2; ++n)
#pragma unroll
                        for (int j = 0; j < 4; ++j) { const unsigned w = hh[2 * n + (j >> 1)]; const float hv = (j & 1) ? hi_bf(w) : lo_bf(w);
                            o[4 * n + j] = hv * rstd * gv[bj][n][j] * fast_sigmoid(acc[ai][bj][m][n][j]); }
                    u32x4 w; w.x = cvt_pk_bf16(o[0], o[1]); w.y = cvt_pk_bf16(o[2], o[3]); w.z = cvt_pk_bf16(o[4], o[5]); w.w = cvt_pk_bf16(o[6], o[7]);
                    *(u32x4*)(rowp + bj * HALF) = w; } }
    }
};
struct EpiGateC {
    static constexpr bool PERM = true, AFTER_DRAIN = false;
    bf16_t* Y; const float* st; const float* gout;
    __device__ __forceinline__ void operator()(const f32x4 (&acc)[2][2][4][2], const Unit& u, int wr, int wc, int fr, int fq) const {
        const int row0 = u.pm * BM + wr * 64 + fr, col0 = u.pn * BM + wc * 32 + 8 * fq, head = u.pn >> 1;
        f32x4 gv[2][2];
#pragma unroll
        for (int bj = 0; bj < 2; ++bj)
#pragma unroll
            for (int n = 0; n < 2; ++n) gv[bj][n] = *(const f32x4*)(gout + col0 + bj * HALF + 4 * n);
#pragma unroll
        for (int ai = 0; ai < 2; ++ai)
#pragma unroll
            for (int m = 0; m < 4; ++m) { const int row = row0 + ai * HALF + m * 16; bf16_t* rowp = Y + (size_t)row * 2048 + col0;
                const f32x4 s0 = *(const f32x4*)(st + (size_t)row * 32 + head * 8), s1 = *(const f32x4*)(st + (size_t)row * 32 + head * 8 + 4);
                const float mu = ((s0[0] + s0[2]) + (s1[0] + s1[2])) * (1.0f / 512.0f), ex2 = ((s0[1] + s0[3]) + (s1[1] + s1[3])) * (1.0f / 512.0f);
                const float var = fmaxf(ex2 - mu * mu, 0.f), rstd = 1.0f / sqrtf(var + 1e-6f);
#pragma unroll
                for (int bj = 0; bj < 2; ++bj) { const u32x4 hw = *(const u32x4*)(rowp + bj * HALF); float o[8];
                    const unsigned hh[4] = {hw.x, hw.y, hw.z, hw.w};
#pragma unroll
                    for (int n = 0; n < 2; ++n)
#pragma unroll
                        for (int j = 0; j < 4; ++j) { const unsigned w = hh[2 * n + (j >> 1)]; const float hv = (j & 1) ? hi_bf(w) : lo_bf(w); const float a = acc[ai][bj][m][n][j];
                            o[4 * n + j] = (hv - mu) * rstd * gv[bj][n][j] * (a * fast_sigmoid(a)); }
                    u32x4 w; w.x = cvt_pk_bf16(o[0], o[1]); w.y = cvt_pk_bf16(o[2], o[3]); w.z = cvt_pk_bf16(o[4], o[5]); w.w = cvt_pk_bf16(o[6], o[7]);
                    *(u32x4*)(rowp + bj * HALF) = w; } }
    }
};
struct EpiLru {
    static constexpr bool PERM = true, AFTER_DRAIN = false;
    const bf16_t* XC; bf16_t* LA; bf16_t* BT; const float* bg; const float* sp; int blk;
    __device__ __forceinline__ void operator()(const f32x4 (&acc)[2][2][4][2], const Unit& u, int wr, int wc, int fr, int fq) const {
        const int row0 = u.pm * BM + wr * 64 + fr, cb = u.pn * HALF + wc * 32 + 8 * fq, ch0 = blk * 256 + cb;
#pragma unroll
        for (int ai = 0; ai < 2; ++ai)
#pragma unroll
            for (int m = 0; m < 4; ++m) { const size_t off = (size_t)(row0 + ai * HALF + m * 16) * 1024 + ch0;
                asm volatile("" ::: "memory");
                const u32x4 xw = *(const u32x4*)(XC + off); const unsigned xx[4] = {xw.x, xw.y, xw.z, xw.w};
                unsigned lw[4], bw[4];
#pragma unroll
                for (int n = 0; n < 2; ++n) { const f32x4 br = *(const f32x4*)(bg + cb + 4 * n), bi = *(const f32x4*)(bg + 256 + cb + 4 * n), spv = *(const f32x4*)(sp + ch0 + 4 * n); float la[4], bt[4];
#pragma unroll
                    for (int j = 0; j < 4; ++j) { const int q = 4 * n + j; const unsigned w = xx[q >> 1]; const float xc = (q & 1) ? hi_bf(w) : lo_bf(w);
                        const float r = fast_sigmoid(acc[ai][0][m][n][j] + br[j]), ig = fast_sigmoid(acc[ai][1][m][n][j] + bi[j]);
                        const float l = -8.0f * r * spv[j]; la[j] = l; bt[j] = sqrtf(fmaxf(1.0f - __expf(2.0f * l), 0.f)) * ig * xc; }
                    lw[2 * n] = cvt_pk_bf16(la[0], la[1]); lw[2 * n + 1] = cvt_pk_bf16(la[2], la[3]); bw[2 * n] = cvt_pk_bf16(bt[0], bt[1]); bw[2 * n + 1] = cvt_pk_bf16(bt[2], bt[3]); }
                u32x4 w; w.x = lw[0]; w.y = lw[1]; w.z = lw[2]; w.w = lw[3]; *(u32x4*)(LA + off) = w;
                w.x = bw[0]; w.y = bw[1]; w.z = bw[2]; w.w = bw[3]; *(u32x4*)(BT + off) = w; }
    }
};

template <class Epi, class Sched, bool ALIGN_EPI = false, bool SP2 = false>
__device__ __forceinline__ void gemm_phase(PG8_LAS unsigned char* lds, const Gemm g, const Sched& S, const Epi& E) {
    int tid_ = threadIdx.x; asm volatile("" : "+v"(tid_));
    const int tid = tid_, wid = __builtin_amdgcn_readfirstlane(tid >> 6), lane = tid & 63, wr = wid >> 2, wc = wid & 3, fr = lane & 15, fq = lane >> 4;
    const int K = g.K, nt = K / BK;
    unsigned voffA[2], voffB[2];
#pragma unroll
    for (int i = 0; i < 2; ++i) { int R, C; stage_rc(tid * 16 + i * 8192, R, C); const int Rb = Epi::PERM ? ((R & ~31) + perm32(R & 31)) : R;
        voffA[i] = (unsigned)(R * g.lda + C) * 2u; voffB[i] = (unsigned)(Rb * g.ldb + C) * 2u; }
    const size_t kstep = (size_t)(BK * 2);
    const size_t hstepA = (size_t)HALF * g.lda * 2, hstepB = (size_t)HALF * g.ldb * 2;
    const size_t tstepA = 2 * hstepA, tstepB = 2 * hstepB;
    const unsigned ldsw = (unsigned)wid * 1024u;
    const int aoff = lds_byte(wr * 64 + fr, fq * 8), boff = lds_byte(wc * 32 + fr, fq * 8);
#define PG8_SA(b, h) (((b) * 2 + (h)) * HTB)
#define PG8_SB(b, h) ((4 + (b) * 2 + (h)) * HTB)
#define PG8_STAGE(bufoff, gbase, voff) do { _Pragma("unroll") for (int _i = 0; _i < 2; ++_i) \
        __builtin_amdgcn_global_load_lds((const unsigned*)((const char*)(gbase) + (voff)[_i]), (PG8_LAS unsigned*)(lds + (bufoff) + ldsw + _i * 8192), 16, 0, 0); } while (0)
#define PG8_LDA(dst, b, h) do { _Pragma("unroll") for (int m = 0; m < 4; ++m) _Pragma("unroll") for (int k = 0; k < 2; ++k) dst[m][k] = *(const PG8_LAS bf16x8*)(lds + PG8_SA(b, h) + aoff + m * 2048 + k * 1024); } while (0)
#define PG8_LDB(dst, b, h) do { _Pragma("unroll") for (int n = 0; n < 2; ++n) _Pragma("unroll") for (int k = 0; k < 2; ++k) dst[n][k] = *(const PG8_LAS bf16x8*)(lds + PG8_SB(b, h) + boff + n * 2048 + k * 1024); } while (0)
#define PG8_MMA(ai, bj, At, Bt) do { __builtin_amdgcn_s_setprio(1); _Pragma("unroll") for (int m = 0; m < 4; ++m) _Pragma("unroll") for (int n = 0; n < 2; ++n) _Pragma("unroll") for (int k = 0; k < 2; ++k) \
        acc[ai][bj][m][n] = __builtin_amdgcn_mfma_f32_16x16x32_bf16(Bt[n][k], At[m][k], acc[ai][bj][m][n], 0, 0, 0); __builtin_amdgcn_s_setprio(0); } while (0)
#define PG8_WAIT_V(n) asm volatile("s_waitcnt vmcnt(" #n ")" ::: "memory")
#define PG8_WAIT_L(n) asm volatile("s_waitcnt lgkmcnt(" #n ")" ::: "memory")
#define PG8_BAR __builtin_amdgcn_s_barrier()
#define PG8_SCHED __builtin_amdgcn_sched_barrier(0)
    Unit cur, nxt; int ui = 0;
    if (!S.next(0, cur)) return;
    f32x4 acc[2][2][4][2];
#pragma unroll
    for (int a = 0; a < 2; ++a)
#pragma unroll
        for (int b = 0; b < 2; ++b)
#pragma unroll
            for (int m = 0; m < 4; ++m)
#pragma unroll
                for (int n = 0; n < 2; ++n) acc[a][b][m][n] = (f32x4){0.f, 0.f, 0.f, 0.f};
    bf16x8 At[4][2], B0[2][2], B1[2][2];
    const char* cA = (const char*)g.A + (size_t)cur.pm * tstepA; const char* cB = (const char*)g.Bt + (size_t)cur.pn * tstepB;
    S.a_ready(cur);
    if constexpr (SP2) {
        PG8_STAGE(PG8_SB(0, 0), cB, voffB); PG8_STAGE(PG8_SB(0, 1), cB + hstepB, voffB); PG8_STAGE(PG8_SA(0, 0), cA, voffA); PG8_STAGE(PG8_SA(0, 1), cA + hstepA, voffA);
        if (wr == 1) PG8_BAR;
        PG8_WAIT_V(2); PG8_BAR;
        PG8_STAGE(PG8_SB(1, 0), cB + kstep, voffB); PG8_STAGE(PG8_SA(1, 0), cA + kstep, voffA); PG8_STAGE(PG8_SB(1, 1), cB + hstepB + kstep, voffB);
        PG8_WAIT_V(6); PG8_BAR;
    } else {
        PG8_STAGE(PG8_SB(0, 0), cB, voffB); PG8_STAGE(PG8_SA(0, 0), cA, voffA); PG8_STAGE(PG8_SB(0, 1), cB + hstepB, voffB); PG8_STAGE(PG8_SA(0, 1), cA + hstepA, voffA);
        if (wr == 1) PG8_BAR;
        PG8_WAIT_V(4); PG8_BAR;
        PG8_STAGE(PG8_SB(1, 0), cB + kstep, voffB); PG8_STAGE(PG8_SA(1, 0), cA + kstep, voffA); PG8_STAGE(PG8_SB(1, 1), cB + hstepB + kstep, voffB);
        PG8_WAIT_V(6); PG8_BAR;
    }
    for (;;) {
        const bool has_next = S.next(ui + 1, nxt);
        const char* nA = has_next ? (const char*)g.A + (size_t)nxt.pm * tstepA : cA; const char* nB = has_next ? (const char*)g.Bt + (size_t)nxt.pn * tstepB : cB;
        for (int t = 0; t < nt; t += 2) {
            const bool last = (t == nt - 2);
            const char* a1 = cA + (size_t)(t + 1) * kstep;
            const char* a2 = last ? nA : cA + (size_t)(t + 2) * kstep; const char* b2 = last ? nB : cB + (size_t)(t + 2) * kstep;
            const char* a3 = a2 + kstep; const char* b3 = b2 + kstep;
            if (last && has_next) S.a_ready(nxt);
            if constexpr (SP2) {
            PG8_LDB(B0, 0, 0); PG8_LDB(B1, 0, 1); PG8_SCHED; PG8_LDA(At, 0, 0); PG8_STAGE(PG8_SA(1, 1), a1 + hstepA, voffA);
            PG8_WAIT_V(8); PG8_WAIT_L(0); PG8_BAR; PG8_MMA(0, 0, At, B0); PG8_MMA(0, 1, At, B1); PG8_BAR; PG8_SCHED;
            PG8_LDA(At, 0, 1); PG8_STAGE(PG8_SB(0, 0), b2, voffB); PG8_STAGE(PG8_SB(0, 1), b2 + hstepB, voffB); PG8_STAGE(PG8_SA(0, 0), a2, voffA);
            PG8_WAIT_V(8); PG8_WAIT_L(0); PG8_BAR; PG8_MMA(1, 0, At, B0); PG8_MMA(1, 1, At, B1); PG8_BAR; PG8_SCHED;
            PG8_LDB(B0, 1, 0); PG8_LDB(B1, 1, 1); PG8_SCHED; PG8_LDA(At, 1, 0); PG8_STAGE(PG8_SA(0, 1), a2 + hstepA, voffA);
            PG8_WAIT_V(8); PG8_WAIT_L(0); PG8_BAR; PG8_MMA(0, 0, At, B0); PG8_MMA(0, 1, At, B1); PG8_BAR; PG8_SCHED;
            PG8_LDA(At, 1, 1); PG8_STAGE(PG8_SB(1, 0), b3, voffB); PG8_STAGE(PG8_SB(1, 1), b3 + hstepB, voffB); PG8_STAGE(PG8_SA(1, 0), a3, voffA);
            PG8_WAIT_V(8); PG8_WAIT_L(0); PG8_BAR; PG8_MMA(1, 0, At, B0); PG8_MMA(1, 1, At, B1); PG8_BAR; PG8_SCHED;
            } else {
            PG8_LDB(B0, 0, 0); PG8_SCHED; PG8_LDA(At, 0, 0); PG8_STAGE(PG8_SA(1, 1), a1 + hstepA, voffA);
            PG8_WAIT_L(8); PG8_BAR; PG8_WAIT_L(0); PG8_MMA(0, 0, At, B0); PG8_BAR; PG8_SCHED;
            PG8_LDB(B1, 0, 1); PG8_STAGE(PG8_SB(0, 0), b2, voffB);
            PG8_BAR; PG8_WAIT_L(0); PG8_MMA(0, 1, At, B1); PG8_BAR;
            PG8_LDA(At, 0, 1); PG8_STAGE(PG8_SA(0, 0), a2, voffA);
            PG8_BAR; PG8_WAIT_L(0); PG8_MMA(1, 0, At, B0); PG8_BAR; PG8_SCHED;
            PG8_STAGE(PG8_SB(0, 1), b2 + hstepB, voffB);
            PG8_WAIT_V(6); PG8_BAR; PG8_MMA(1, 1, At, B1); PG8_BAR;
            PG8_LDB(B0, 1, 0); PG8_SCHED; PG8_LDA(At, 1, 0); PG8_STAGE(PG8_SA(0, 1), a2 + hstepA, voffA);
            PG8_WAIT_L(8); PG8_BAR; PG8_WAIT_L(0); PG8_MMA(0, 0, At, B0); PG8_BAR; PG8_SCHED;
            PG8_LDB(B1, 1, 1); PG8_STAGE(PG8_SB(1, 0), b3, voffB);
            PG8_BAR; PG8_WAIT_L(0); PG8_MMA(0, 1, At, B1); PG8_BAR;
            PG8_LDA(At, 1, 1); PG8_STAGE(PG8_SA(1, 0), a3, voffA);
            PG8_BAR; PG8_WAIT_L(0); PG8_MMA(1, 0, At, B0); PG8_BAR; PG8_SCHED;
            PG8_STAGE(PG8_SB(1, 1), b3 + hstepB, voffB);
            PG8_WAIT_V(6); PG8_BAR; PG8_MMA(1, 1, At, B1); PG8_BAR;
            }
        }
        if constexpr (ALIGN_EPI) { if (wr == 0) PG8_BAR; }
        if constexpr (!Epi::AFTER_DRAIN) { E(acc, cur, wr, wc, fr, fq); S.done(cur); }
        if (!has_next) break;
#pragma unroll
        for (int a = 0; a < 2; ++a)
#pragma unroll
            for (int b = 0; b < 2; ++b)
#pragma unroll
                for (int m = 0; m < 4; ++m)
#pragma unroll
                    for (int n = 0; n < 2; ++n) acc[a][b][m][n] = (f32x4){0.f, 0.f, 0.f, 0.f};
        cur = nxt; cA = nA; cB = nB; ++ui;
        if constexpr (ALIGN_EPI) { if (wr == 1) PG8_BAR; }
    }
    PG8_WAIT_V(0);
    if constexpr (!ALIGN_EPI) { if (wr == 0) PG8_BAR; }
    PG8_BAR;
    if constexpr (Epi::AFTER_DRAIN) { E.fused(acc, cur, wr, wc, fr, fq, lds, wid, lane); S.done(cur); }
#undef PG8_SA
#undef PG8_SB
#undef PG8_STAGE
#undef PG8_LDA
#undef PG8_LDB
#undef PG8_MMA
#undef PG8_WAIT_V
#undef PG8_WAIT_L
#undef PG8_BAR
#undef PG8_SCHED
}
}
#define GAS __attribute__((address_space(1)))
#define LAS __attribute__((address_space(3)))
typedef unsigned short bf16;
typedef unsigned v4u __attribute__((ext_vector_type(4)));
typedef float f32x4 __attribute__((ext_vector_type(4)));
typedef short bf16x8 __attribute__((ext_vector_type(8)));
typedef GAS unsigned gu32;
typedef GAS unsigned long long gu64;
#define RLX_AGENT __ATOMIC_RELAXED, __HIP_MEMORY_SCOPE_AGENT
#define LDS_WAIT() asm volatile("s_waitcnt lgkmcnt(0)" ::: "memory")
#define VM_WAIT() asm volatile("s_waitcnt vmcnt(0)" ::: "memory")
__device__ __forceinline__ unsigned long long rt() { return __builtin_amdgcn_s_memrealtime(); }
__device__ __forceinline__ unsigned f2bf(float f) { unsigned u = __builtin_bit_cast(unsigned, f); return (u + 0x7fffu + ((u >> 16) & 1u)) >> 16; }
__device__ __forceinline__ unsigned pk2(float lo, float hi) { return f2bf(lo) | (f2bf(hi) << 16); }

#define XB_TMO      128
#define XB_XCNT(j)  (256  + 64 * (j))
#define XB_XSUB(j)  (1280 + 64 * (j))
#define XB_XGEN(j)  (2304 + 64 * (j))
#define XB_TOP      3328
#define XB_TOPGEN   3392
#define XCD_BAR_WORDS 3456
#define XB_SPIN_CAP (1u << 18)

__device__ __forceinline__ unsigned xb_ld(unsigned* p)              { return __hip_atomic_load(p, __ATOMIC_RELAXED, __HIP_MEMORY_SCOPE_AGENT); }
__device__ __forceinline__ unsigned xb_add(unsigned* p, unsigned v) { return __hip_atomic_fetch_add(p, v, __ATOMIC_RELAXED, __HIP_MEMORY_SCOPE_AGENT); }
__device__ __forceinline__ unsigned xb_xcc_id() { return (unsigned)__builtin_amdgcn_s_getreg((3 << 11) | 20) & 0xFu; }
#define XB_SPIN(cond, bar) do { unsigned _sp = 0; while (cond) { __builtin_amdgcn_s_sleep(1); \
    if ((++_sp & 255u) == 0u) { if (xb_ld(&(bar)[XB_TMO])) break; if (_sp > XB_SPIN_CAP) { atomicAdd(&(bar)[XB_TMO], 1u); break; } } } } while (0)

struct XcdBarrier {
    unsigned* bar; unsigned x;
    volatile LAS unsigned* st;
};

__device__ __forceinline__ XcdBarrier xcd_barrier_post(unsigned* bar, volatile LAS unsigned* st) {
    XcdBarrier b; b.bar = bar; b.x = xb_xcc_id(); b.st = st;
    if (threadIdx.x == 0) (void)xb_add(&bar[XB_XCNT(b.x)], 1u);
    return b;
}
__device__ __forceinline__ void xcd_barrier_complete(unsigned* bar, unsigned x, unsigned& nloc, unsigned& nx) {
    const unsigned G = gridDim.x * gridDim.y * gridDim.z;
    unsigned sum, cnt, mine, sp = 0u;
    for (;;) {
        sum = 0u; cnt = 0u; mine = 0u;
#pragma unroll
        for (unsigned j = 0; j < 16; ++j) { const unsigned c = xb_ld(&bar[XB_XCNT(j)]); sum += c; cnt += (c > 0u) ? 1u : 0u; mine = (j == x) ? c : mine; }
        if (sum == G) break;
        __builtin_amdgcn_s_sleep(1);
        if ((++sp & 255u) == 0u) { if (xb_ld(&bar[XB_TMO])) break; if (sp > XB_SPIN_CAP) { atomicAdd(&bar[XB_TMO], 1u); break; } }
    }
    nloc = mine > 0u ? mine : 1u; nx = cnt > 0u ? cnt : 1u;
}

__device__ __forceinline__ void xcd_barrier(const XcdBarrier& b) {
    asm volatile("s_waitcnt vmcnt(0)" ::: "memory");
    __syncthreads();
    if (threadIdx.x == 0) {
        unsigned* bar = b.bar;
        __builtin_amdgcn_s_waitcnt(0);
        unsigned nloc = b.st[0], nx = b.st[1];
        if (nloc == 0u) { xcd_barrier_complete(bar, b.x, nloc, nx); b.st[0] = nloc; b.st[1] = nx; }
        const unsigned old = xb_add(&bar[XB_XSUB(b.x)], 1u);
        const unsigned gen = old / nloc;
        if (old + 1u == (gen + 1u) * nloc) {
            __builtin_amdgcn_fence(__ATOMIC_RELEASE, "agent");
            asm volatile("s_waitcnt vmcnt(0)" ::: "memory");
            const unsigned og = xb_add(&bar[XB_TOP], 1u);
            const unsigned tg = og / nx;
            if (og + 1u == (tg + 1u) * nx) xb_add(&bar[XB_TOPGEN], 1u);
            else XB_SPIN(xb_ld(&bar[XB_TOPGEN]) == tg, bar);
            __builtin_amdgcn_fence(__ATOMIC_ACQUIRE, "agent");
            xb_add(&bar[XB_XGEN(b.x)], 1u);
            asm volatile("s_waitcnt vmcnt(0)" ::: "memory");
        } else {
            XB_SPIN(xb_ld(&bar[XB_XGEN(b.x)]) == gen, bar);
            __builtin_amdgcn_fence(__ATOMIC_ACQUIRE, "agent");
            asm volatile("s_waitcnt vmcnt(0)" ::: "memory");
        }
    }
    __syncthreads();
}

constexpr int NWAVES = 8, NTHR = 512;
constexpr int MTOK = 32768, DM = 1024, SEQ = 2048, NB = 16, DFF = 2816;
constexpr size_t MiB = 1u << 20;
constexpr size_t WS_CTL = 0, CTL_ZERO_BYTES = 64 * 1024;
constexpr size_t WS_W_MIXIN = 1 * MiB, WS_W_MIXOUT = 13 * MiB, WS_W_FFNIN = 17 * MiB, WS_W_FFNOUT = 28 * MiB;
constexpr size_t WS_GATESA = 34 * MiB, WS_SSQA = 35 * MiB, WS_STATC = 37 * MiB, WS_KMEAN = 41 * MiB;
constexpr size_t WS_U = 42 * MiB, WS_BIG = 106 * MiB, WS_END = 490 * MiB;
constexpr int CW_BAR = 1024;
static_assert((CW_BAR + 3456) * 4 <= (int)CTL_ZERO_BYTES, "ctl");
constexpr int LDS_BYTES = 147456, MISC_OFF = 143360;

typedef unsigned u32x4 __attribute__((ext_vector_type(4)));
typedef unsigned u32x2 __attribute__((ext_vector_type(2)));
struct Frame { LAS unsigned char* lds; int tid, lane, wave, G; };
struct Args { const void* in[24]; float* out; unsigned char* ws; int ph_lo, ph_hi; };

__device__ __forceinline__ float wave_sum(float v) {
#pragma unroll
    for (int o = 1; o < 64; o <<= 1) v += __shfl_xor(v, o);
    return v;
}
__device__ __forceinline__ float bf2f(bf16 b) { return __uint_as_float(((unsigned)b) << 16); }
__device__ __forceinline__ float lo_bf(unsigned w) { return __uint_as_float(w << 16); }
__device__ __forceinline__ float hi_bf(unsigned w) { return __uint_as_float(w & 0xffff0000u); }
__device__ __forceinline__ unsigned cvtpk(float lo, float hi) { return pg8::cvt_pk_bf16(lo, hi); }

template <int MT, int NT, int K, int LDA, int LDB>
__device__ __forceinline__ void wgemm(f32x4 (&acc)[MT][NT], const LAS bf16* A, const LAS bf16* Bt, int lane) {
    const int fr = lane & 15, fq = lane >> 4;
    const LAS bf16* ap = A + fr * LDA + 8 * fq;
    const LAS bf16* bp = Bt + fr * LDB + 8 * fq;
#pragma unroll
    for (int k0 = 0; k0 < K; k0 += 32) {
        bf16x8 a[MT], b[NT];
#pragma unroll
        for (int i = 0; i < MT; ++i) a[i] = *(const LAS bf16x8*)(ap + 16 * i * LDA + k0);
#pragma unroll
        for (int j = 0; j < NT; ++j) b[j] = *(const LAS bf16x8*)(bp + 16 * j * LDB + k0);
#pragma unroll
        for (int i = 0; i < MT; ++i)
#pragma unroll
            for (int j = 0; j < NT; ++j) acc[i][j] = __builtin_amdgcn_mfma_f32_16x16x32_bf16(a[i], b[j], acc[i][j], 0, 0, 0);
        if (MT * NT >= 8) __builtin_amdgcn_sched_barrier(0);
    }
}

__device__ __forceinline__ int cvt_src_col(int mode, int g0) {
    if (mode == 0) return g0;
    const int pn = g0 >> 8, r = g0 & 255;
    if (mode == 1) return r < 128 ? 128 * pn + r : DFF + 128 * pn + (r - 128);
    return r < 128 ? 128 * pn + r : 256 + 128 * pn + (r - 128);
}
__device__ __forceinline__ void cvt_matrix(Frame& F, const float* W, int ldw, int K, int Np, int mode, bf16* WT) {
    LAS float* scr = (LAS float*)(F.lds + F.wave * 16384);
    const int gw = blockIdx.x * NWAVES + F.wave, NGW = F.G * NWAVES, lane = F.lane;
    const int nblk = Np / 32, nitems = (K / 64) * nblk;
    for (int item = gw; item < nitems; item += NGW) {
        const int kb = item / nblk, nb = item % nblk, k0 = 64 * kb, n0 = 32 * nb, s0 = cvt_src_col(mode, n0);
#pragma unroll 8
        for (int i = 0; i < 32; ++i) { const int kk = 2 * i + (lane >> 5); scr[kk * 33 + (lane & 31)] = W[(size_t)(k0 + kk) * ldw + s0 + (lane & 31)]; }
        LDS_WAIT(); asm volatile("" ::: "memory");
        const int c = lane & 7;
#pragma unroll
        for (int j = 0; j < 4; ++j) { const int n = (lane >> 3) + 8 * j; const LAS float* s = scr + (8 * c) * 33 + n;
            v4u o; o.x = pk2(s[0 * 33], s[1 * 33]); o.y = pk2(s[2 * 33], s[3 * 33]); o.z = pk2(s[4 * 33], s[5 * 33]); o.w = pk2(s[6 * 33], s[7 * 33]);
            *(v4u*)(WT + (size_t)(n0 + n) * K + k0 + 8 * c) = o; }
        LDS_WAIT(); asm volatile("" ::: "memory");
    }
}

template <bool GATES>
__device__ __forceinline__ void norm_phase(Frame& F, const float* src, const float* gain, bf16* dst, const float* wA, const float* bA, float* gout) {
    LAS float* wg = (LAS float*)F.lds;
    if (GATES) {
        for (int i = F.tid; i < 1024 * 8; i += NTHR) wg[i] = wA[(size_t)(i >> 3) * 3080 + 3072 + (i & 7)];
        __syncthreads();
    }
    const int gw = blockIdx.x * NWAVES + F.wave, NGW = F.G * NWAVES, lane = F.lane;
    f32x4 g[4];
#pragma unroll
    for (int j = 0; j < 4; ++j) g[j] = ((const f32x4*)gain)[lane + 64 * j];
    for (int m = gw; m < MTOK; m += NGW) {
        const f32x4* xr = (const f32x4*)(src + (size_t)m * DM) + lane;
        f32x4 v[4]; float s = 0.f;
#pragma unroll
        for (int j = 0; j < 4; ++j) { v[j] = xr[64 * j]; s += (v[j].x * v[j].x + v[j].y * v[j].y) + (v[j].z * v[j].z + v[j].w * v[j].w); }
        const float rstd = 1.0f / sqrtf(wave_sum(s) * (1.0f / DM) + 1e-6f);
        unsigned long long* o8 = (unsigned long long*)(dst + (size_t)m * DM) + lane;
#pragma unroll
        for (int j = 0; j < 4; ++j) { v[j] = v[j] * rstd * g[j];
            o8[64 * j] = (unsigned long long)cvtpk(v[j].x, v[j].y) | ((unsigned long long)cvtpk(v[j].z, v[j].w) << 32); }
        if (GATES) {
            float a[8];
#pragma unroll
            for (int q = 0; q < 8; ++q) a[q] = 0.f;
#pragma unroll
            for (int j = 0; j < 4; ++j)
#pragma unroll
                for (int e = 0; e < 4; ++e) { const int k = 4 * lane + 256 * j + e; const f32x4 w0 = *(const LAS f32x4*)(wg + k * 8), w1 = *(const LAS f32x4*)(wg + k * 8 + 4); const float x = v[j][e];
                    a[0] += x * w0.x; a[1] += x * w0.y; a[2] += x * w0.z; a[3] += x * w0.w; a[4] += x * w1.x; a[5] += x * w1.y; a[6] += x * w1.z; a[7] += x * w1.w; }
#pragma unroll
            for (int q = 0; q < 8; ++q) a[q] = wave_sum(a[q]);
            if (lane == 0) {
#pragma unroll
                for (int q = 0; q < 8; ++q) gout[(size_t)m * 8 + q] = a[q] + bA[q]; }
        }
    }
}

__device__ __forceinline__ void mlstm_core(Frame& F, const bf16* QKV, const float* gates, bf16* hout, float* ssq) {
    constexpr float SCALE = 0.08838834764831845f;
    LAS bf16* Qs = (LAS bf16*)F.lds;
    LAS bf16* Ks = Qs + 64 * 136;
    LAS bf16* KTs = Ks + 64 * 136;
    LAS bf16* VTs = KTs + 128 * 72;
    LAS bf16* VWs = VTs + 64 * 72;
    LAS bf16* Cb = VWs + 64 * 72;
    LAS bf16* Ps = Cb + 64 * 136;
    LAS float* fA = (LAS float*)(Ps + 64 * 72);
    LAS float* fMX = fA + 64, *fWI = fMX + 64, *fEMT = fWI + 64, *fWS = fEMT + 64, *fN = fWS + 64  , *fDENP = fN + 128  , *fDQ = fDENP + 128, *fSSQP = fDQ + 64  , *fSC = fSSQP + 128;
    const int tid = F.tid, lane = F.lane, w = F.wave, fr = lane & 15, fq = lane >> 4, wh = w >> 1, wl = w & 1;
    for (int item = blockIdx.x; item < 256; item += F.G) {
        const int b = item >> 4, h = (item >> 2) & 3, vs = item & 3;
        f32x4 Cacc[1][4];
#pragma unroll
        for (int j = 0; j < 4; ++j) Cacc[0][j] = (f32x4){0.f, 0.f, 0.f, 0.f};
        float m_st = 0.f;
        __syncthreads();
        if (tid < 128) fN[tid] = 0.f;
        for (int c = 0; c < 32; ++c) {
            const size_t t0 = (size_t)b * SEQ + c * 64;
            __syncthreads();
#pragma unroll
            for (int j = 0; j < 4; ++j)
#pragma unroll
                for (int e = 0; e < 4; ++e) Cb[(16 * wh + 4 * fq + e) * 136 + 64 * wl + 16 * j + fr] = (bf16)f2bf(Cacc[0][j][e]);
#pragma unroll
            for (int i = 0; i < 2; ++i) { const int id = tid + NTHR * i, row = id >> 4, c8 = id & 15;
                const bf16* src = QKV + (t0 + row) * 2048 + h * 128 + c8 * 8;
                const v4u q = *(const v4u*)src, k = *(const v4u*)(src + 512);
                *(LAS v4u*)(Qs + row * 136 + c8 * 8) = q; *(LAS v4u*)(Ks + row * 136 + c8 * 8) = k;
                const unsigned kw[4] = {k.x, k.y, k.z, k.w};
#pragma unroll
                for (int e = 0; e < 4; ++e) { KTs[(c8 * 8 + 2 * e) * 72 + row] = (bf16)(kw[e] & 0xffffu); KTs[(c8 * 8 + 2 * e + 1) * 72 + row] = (bf16)(kw[e] >> 16); } }
            { const int row = tid >> 3, c8 = tid & 7;
                const v4u v = *(const v4u*)(QKV + (t0 + row) * 2048 + 1024 + h * 256 + vs * 64 + c8 * 8);
                const unsigned vw[4] = {v.x, v.y, v.z, v.w};
#pragma unroll
                for (int e = 0; e < 4; ++e) { VTs[(c8 * 8 + 2 * e) * 72 + row] = (bf16)(vw[e] & 0xffffu); VTs[(c8 * 8 + 2 * e + 1) * 72 + row] = (bf16)(vw[e] >> 16); } }
            if (w == 0) {
                const float gi = gates[(t0 + lane) * 8 + h], gf = gates[(t0 + lane) * 8 + 4 + h];
                const float fc = fminf(gf, 0.f) - log1pf(expf(-fabsf(gf)));
                float bc = fc;
#pragma unroll
                for (int o = 1; o < 64; o <<= 1) { const float t = __shfl_up(bc, o); if (lane >= o) bc += t; }
                const float a = gi - bc; float pm = a;
#pragma unroll
                for (int o = 1; o < 64; o <<= 1) { const float t = __shfl_up(pm, o); if (lane >= o) pm = fmaxf(pm, t); }
                const float Mx = fmaxf(m_st, pm), wi = expf(m_st - Mx), mt = bc + Mx;
                const float Mx63 = __shfl(Mx, 63), btot = __shfl(bc, 63);
                fA[lane] = a; fMX[lane] = Mx; fWI[lane] = wi; fEMT[lane] = expf(-mt); fWS[lane] = expf(a - Mx63);
                if (lane == 63) fSC[0] = wi;
                m_st = btot + Mx63;
            }
            __syncthreads();
            {
                f32x4 sa[1][2]; sa[0][0] = (f32x4){0.f, 0.f, 0.f, 0.f}; sa[0][1] = sa[0][0];
                wgemm<1, 2, 128, 136, 136>(sa, Qs + 16 * wh * 136, Ks + 32 * wl * 136, lane);
                float rs[4] = {0.f, 0.f, 0.f, 0.f};
#pragma unroll
                for (int e = 0; e < 4; ++e) { const int t = 16 * wh + 4 * fq + e; const float mx = fMX[t];
#pragma unroll
                    for (int j = 0; j < 2; ++j) { const int s = 32 * wl + 16 * j + fr; const float wgt = (s <= t) ? SCALE * expf(fA[s] - mx) : 0.f; const float p = sa[0][j][e] * wgt;
                        Ps[t * 72 + s] = (bf16)f2bf(p); rs[e] += p; } }
#pragma unroll
                for (int e = 0; e < 4; ++e) { float r = rs[e]; r += __shfl_xor(r, 1); r += __shfl_xor(r, 2); r += __shfl_xor(r, 4); r += __shfl_xor(r, 8); if (fr == 0) fDENP[wl * 64 + 16 * wh + 4 * fq + e] = r; }
                { const int v = tid >> 3, s0 = (tid & 7) * 8; const v4u x = *(const LAS v4u*)(VTs + v * 72 + s0); const unsigned xw[4] = {x.x, x.y, x.z, x.w}; v4u o; unsigned ow[4];
#pragma unroll
                    for (int e = 0; e < 4; ++e) ow[e] = cvtpk(lo_bf(xw[e]) * fWS[s0 + 2 * e], hi_bf(xw[e]) * fWS[s0 + 2 * e + 1]);
                    o.x = ow[0]; o.y = ow[1]; o.z = ow[2]; o.w = ow[3]; *(LAS v4u*)(VWs + v * 72 + s0) = o; }
                { const int t = tid >> 3, p = tid & 7; float s = 0.f;
#pragma unroll
                    for (int e = 0; e < 16; ++e) s += fN[p * 16 + e] * bf2f(Qs[t * 136 + p * 16 + e]);
                    s += __shfl_xor(s, 1); s += __shfl_xor(s, 2); s += __shfl_xor(s, 4); if (p == 0) fDQ[t] = SCALE * s; }
            }
            __syncthreads();
            {
                f32x4 ni[1][2], nx[1][2]; ni[0][0] = (f32x4){0.f, 0.f, 0.f, 0.f}; ni[0][1] = ni[0][0]; nx[0][0] = ni[0][0]; nx[0][1] = ni[0][0];
                wgemm<1, 2, 64, 72, 72>(ni, Ps + 16 * wh * 72, VTs + 32 * wl * 72, lane);
                wgemm<1, 2, 128, 136, 136>(nx, Qs + 16 * wh * 136, Cb + 32 * wl * 136, lane);
                float sq[4];
#pragma unroll
                for (int e = 0; e < 4; ++e) { const int t = 16 * wh + 4 * fq + e; const float wi = fWI[t];
                    const float den = fDENP[t] + fDENP[64 + t] + wi * fDQ[t]; const float inv = 1.0f / fmaxf(fabsf(den), fEMT[t]); float q2 = 0.f;
#pragma unroll
                    for (int j = 0; j < 2; ++j) { const float hv = (ni[0][j][e] + SCALE * wi * nx[0][j][e]) * inv; q2 += hv * hv;
                        hout[(t0 + t) * 1024 + h * 256 + vs * 64 + 32 * wl + 16 * j + fr] = (bf16)f2bf(hv); }
                    sq[e] = q2; }
#pragma unroll
                for (int e = 0; e < 4; ++e) { float r = sq[e]; r += __shfl_xor(r, 1); r += __shfl_xor(r, 2); r += __shfl_xor(r, 4); r += __shfl_xor(r, 8); if (fr == 0) fSSQP[wl * 64 + 16 * wh + 4 * fq + e] = r; }
                const float wc = fSC[0];
#pragma unroll
                for (int j = 0; j < 4; ++j) Cacc[0][j] = Cacc[0][j] * wc;
                wgemm<1, 4, 64, 72, 72>(Cacc, VWs + 16 * wh * 72, KTs + 64 * wl * 72, lane);
                if (tid < 128) { float s = 0.f;
#pragma unroll 8
                    for (int k = 0; k < 64; ++k) s += fWS[k] * bf2f(Ks[k * 136 + tid]);
                    fN[tid] = wc * fN[tid] + s; }
            }
            __syncthreads();
            if (tid < 64) ssq[(t0 + tid) * 16 + h * 4 + vs] = fSSQP[tid] + fSSQP[64 + tid];
        }
    }
}

__device__ __forceinline__ void moba_prep(Frame& F, bf16* QKV, const int* pos, const float* gq, const float* gk, float* kmean) {
    const int lane = F.lane, w = F.wave;
    for (int item = blockIdx.x; item < 256; item += F.G) {
        const int b = item >> 4, blk = (item >> 1) & 7, hh = item & 1, head = hh * 4 + (w & 3), isk = w >> 2;
        const float* gp = isk ? gk : gq; const float g0 = gp[2 * lane], g1 = gp[2 * lane + 1];
        const float inv = exp2f(-(float)(2 * (lane & 7)) * (18.931568569324174f / 16.0f)), inv1 = exp2f(-(float)(2 * (lane & 7) + 1) * (18.931568569324174f / 16.0f));
        float km0 = 0.f, km1 = 0.f;
        for (int i = 0; i < 256; ++i) {
            const size_t row = (size_t)b * SEQ + blk * 256 + i;
            unsigned* p = (unsigned*)(QKV + row * 3072 + isk * 1024 + head * 128) + lane;
            const unsigned xw = *p; float x0 = lo_bf(xw), x1 = hi_bf(xw);
            const float ss = wave_sum(x0 * x0 + x1 * x1), rstd = 1.0f / sqrtf(ss * (1.0f / 128.0f) + 1e-6f);
            x0 = x0 * rstd * g0; x1 = x1 * rstd * g1;
            const float ps = (float)pos[row]; float s0, c0, s1, c1; sincosf(ps * inv, &s0, &c0); sincosf(ps * inv1, &s1, &c1);
            const float o0 = __shfl_xor(x0, 8), o1 = __shfl_xor(x1, 8);
            if (lane < 8) { x0 = x0 * c0 - o0 * s0; x1 = x1 * c1 - o1 * s1; }
            else if (lane < 16) { x0 = x0 * c0 + o0 * s0; x1 = x1 * c1 + o1 * s1; }
            *p = cvtpk(x0, x1); km0 += x0; km1 += x1;
        }
        if (isk) { float* kp = kmean + (((size_t)b * 8 + head) * 8 + blk) * 128 + 2 * lane; kp[0] = km0 * (1.0f / 256.0f); kp[1] = km1 * (1.0f / 256.0f); }
    }
}
__device__ __forceinline__ void moba_attn(Frame& F, bf16* QKV, const float* kmean) {
    constexpr float SCALE = 0.08838834764831845f;
    LAS bf16* Qs = (LAS bf16*)F.lds;
    LAS bf16* Ks = Qs + 128 * 136;
    LAS bf16* VTs = Ks + 64 * 136;
    LAS float* kmS = (LAS float*)(VTs + 128 * 72);
    LAS float* gsc = kmS + 1024;
    LAS unsigned* selm = (LAS unsigned*)(gsc + 1024);
    const int tid = F.tid, lane = F.lane, w = F.wave, fr = lane & 15, fq = lane >> 4;
    for (int it = blockIdx.x; it < 2048; it += F.G) {
        const int c = it & 255, r = it >> 8, bh = c & 127, typ = c >> 7, b = bh >> 3, h = bh & 7;
        const int base = (r & 1) ? 15 - (r - 1) : r;
        const int qi = typ ? (base ^ 1) : base;
        const int j = qi >> 1;
        const size_t qrow0 = (size_t)b * SEQ + qi * 128;
        __syncthreads();
#pragma unroll
        for (int i = 0; i < 4; ++i) { const int id = tid + NTHR * i, row = id >> 4, c8 = id & 15;
            *(LAS v4u*)(Qs + row * 136 + c8 * 8) = *(const v4u*)(QKV + (qrow0 + row) * 3072 + h * 128 + c8 * 8); }
        for (int i = tid; i < 1024; i += NTHR) kmS[i] = kmean[((size_t)b * 8 + h) * 1024 + i];
        __syncthreads();
        { const int q = tid >> 2, p = tid & 3;
#pragma unroll
            for (int e = 0; e < 2; ++e) { const int blk = 2 * p + e; float s = 0.f;
                for (int d = 0; d < 128; ++d) s += bf2f(Qs[q * 136 + d]) * kmS[blk * 128 + d];
                gsc[q * 8 + blk] = s; } }
        __syncthreads();
        if (tid < 128) { unsigned mask = 0u;
            if (j <= 3) mask = (1u << j) - 1u;
            else { for (int k = 0; k < 3; ++k) { float best = -INFINITY; int bi = 0;
                    for (int blk = 0; blk < j; ++blk) { const float gv = gsc[tid * 8 + blk]; if (!((mask >> blk) & 1u) && gv > best) { best = gv; bi = blk; } }
                    mask |= 1u << bi; } }
            selm[tid] = mask; }
        __syncthreads();
        bf16x8 qf[4];
#pragma unroll
        for (int ks = 0; ks < 4; ++ks) qf[ks] = *(const LAS bf16x8*)(Qs + (16 * w + fr) * 136 + 32 * ks + 8 * fq);
        const unsigned mymask = selm[16 * w + fr];
        const int qpos = qi * 128 + 16 * w + fr;
        f32x4 oacc[8];
#pragma unroll
        for (int vt = 0; vt < 8; ++vt) oacc[vt] = (f32x4){0.f, 0.f, 0.f, 0.f};
        float mrun = -INFINITY, lrun = 0.f;
        const int ntile_total = 4 * j + 2 * (qi & 1) + 2;
        for (int tile = 0; tile < ntile_total; ++tile) {
            const int kb = tile >> 2, key0 = tile * 64;
            const size_t krow0 = (size_t)b * SEQ + key0;
            __syncthreads();
#pragma unroll
            for (int i = 0; i < 2; ++i) { const int id = tid + NTHR * i, row = id >> 4, c8 = id & 15;
                const bf16* src = QKV + (krow0 + row) * 3072 + 1024 + h * 128 + c8 * 8;
                *(LAS v4u*)(Ks + row * 136 + c8 * 8) = *(const v4u*)src;
                const v4u v = *(const v4u*)(src + 1024); const unsigned vw[4] = {v.x, v.y, v.z, v.w};
#pragma unroll
                for (int e = 0; e < 4; ++e) { VTs[(c8 * 8 + 2 * e) * 72 + row] = (bf16)(vw[e] & 0xffffu); VTs[(c8 * 8 + 2 * e + 1) * 72 + row] = (bf16)(vw[e] >> 16); } }
            __syncthreads();
            const bool own = (kb == j);
            const bool lane_sel = own || ((mymask >> kb) & 1u);
            if (__ballot(lane_sel) == 0ull) continue;
            f32x4 st[4];
#pragma unroll
            for (int kt = 0; kt < 4; ++kt) { st[kt] = (f32x4){0.f, 0.f, 0.f, 0.f};
#pragma unroll
                for (int ks = 0; ks < 4; ++ks) { const bf16x8 kf = *(const LAS bf16x8*)(Ks + (16 * kt + fr) * 136 + 32 * ks + 8 * fq);
                    st[kt] = __builtin_amdgcn_mfma_f32_16x16x32_bf16(kf, qf[ks], st[kt], 0, 0, 0); } }
            float mloc = -INFINITY;
#pragma unroll
            for (int kt = 0; kt < 4; ++kt)
#pragma unroll
                for (int e = 0; e < 4; ++e) { const int kpos = key0 + 16 * kt + 4 * fq + e; const bool ok = own ? (kpos <= qpos) : lane_sel;
                    const float s = ok ? st[kt][e] * SCALE : -INFINITY; st[kt][e] = s; mloc = fmaxf(mloc, s); }
            mloc = fmaxf(mloc, __shfl_xor(mloc, 16)); mloc = fmaxf(mloc, __shfl_xor(mloc, 32));
            const float mnew = fmaxf(mrun, mloc), msafe = (mnew == -INFINITY) ? 0.f : mnew;
            const float alpha = __expf(mrun - msafe);
            float psum = 0.f; bf16x8 pf[2];
#pragma unroll
            for (int kk = 0; kk < 2; ++kk) { float p[8];
#pragma unroll
                for (int e = 0; e < 4; ++e) { p[e] = __expf(st[2 * kk][e] - msafe); p[4 + e] = __expf(st[2 * kk + 1][e] - msafe); }
#pragma unroll
                for (int e = 0; e < 8; ++e) psum += p[e];
                u32x4 pw; pw.x = cvtpk(p[0], p[1]); pw.y = cvtpk(p[2], p[3]); pw.z = cvtpk(p[4], p[5]); pw.w = cvtpk(p[6], p[7]);
                pf[kk] = __builtin_bit_cast(bf16x8, pw); }
            lrun = lrun * alpha + psum; mrun = mnew;
#pragma unroll
            for (int vt = 0; vt < 8; ++vt) { oacc[vt] = oacc[vt] * alpha;
#pragma unroll
                for (int kk = 0; kk < 2; ++kk) { const LAS bf16* vp = VTs + (16 * vt + fr) * 72 + 32 * kk + 4 * fq;
                    const u32x2 v0 = *(const LAS u32x2*)vp, v1 = *(const LAS u32x2*)(vp + 16);
                    u32x4 vw; vw.x = v0.x; vw.y = v0.y; vw.z = v1.x; vw.w = v1.y;
                    oacc[vt] = __builtin_amdgcn_mfma_f32_16x16x32_bf16(__builtin_bit_cast(bf16x8, vw), pf[kk], oacc[vt], 0, 0, 0); } }
        }
        lrun += __shfl_xor(lrun, 16); lrun += __shfl_xor(lrun, 32);
        const float il = 1.0f / lrun;
        bf16* orow = QKV + (qrow0 + 16 * w + fr) * 3072 + h * 128;
#pragma unroll
        for (int vt = 0; vt < 8; ++vt) { u32x2 o; o.x = cvtpk(oacc[vt][0] * il, oacc[vt][1] * il); o.y = cvtpk(oacc[vt][2] * il, oacc[vt][3] * il);
            *(u32x2*)(orow + 16 * vt + 4 * fq) = o; }
    }
}

__device__ __forceinline__ void ret_prep(Frame& F, bf16* QKV, const int* pos) {
    const int gw = blockIdx.x * NWAVES + F.wave, NGW = F.G * NWAVES, lane = F.lane;
    const float i0 = exp2f(-(float)(2 * lane) * (13.287712379549449f / 128.0f)), i1 = exp2f(-(float)(2 * lane + 1) * (13.287712379549449f / 128.0f));
    for (int m = gw; m < MTOK; m += NGW) {
        const float ps = (float)pos[m]; float s0, c0, s1, c1; sincosf(ps * i0, &s0, &c0); sincosf(ps * i1, &s1, &c1);
#pragma unroll
        for (int hd = 0; hd < 8; ++hd) {
            unsigned* p = (unsigned*)(QKV + (size_t)m * 4096 + hd * 256) + lane;
            const unsigned a = p[0], bq = p[64]; const float sc = hd >= 4 ? 0.0625f : 1.0f;
            const float x10 = lo_bf(a), x11 = hi_bf(a), x20 = lo_bf(bq), x21 = hi_bf(bq);
            p[0] = cvtpk((x10 * c0 - x20 * s0) * sc, (x11 * c1 - x21 * s1) * sc);
            p[64] = cvtpk((x20 * c0 + x10 * s0) * sc, (x21 * c1 + x11 * s1) * sc);
        }
    }
}
__device__ __forceinline__ void ret_core(Frame& F, const bf16* QKV, bf16* ys, float* st) {
    LAS bf16* Qd = (LAS bf16*)F.lds;
    LAS bf16* Kd = Qd + 128 * 72;
    LAS bf16* Rb = Kd + 128 * 72;
    LAS bf16* VT = Rb + 128 * 72;
    LAS bf16* Ps = VT + 128 * 136;
    LAS float* fST = (LAS float*)(Ps + 128 * 136);
    LAS bf16* KzT = Kd;
    const int tid = F.tid, lane = F.lane, w = F.wave, fr = lane & 15, fq = lane >> 4, wh = w >> 1, wl = w & 1;
    for (int item = blockIdx.x; item < 256; item += F.G) {
        const int b = item >> 4, h = (item >> 2) & 3, vs = item & 3;
        const float lg = log1pf(-exp2f(-5.0f - (float)h)), gch = expf(128.0f * lg);
        f32x4 Racc[4][1][4];
#pragma unroll
        for (int dt = 0; dt < 4; ++dt)
#pragma unroll
            for (int jj = 0; jj < 4; ++jj) Racc[dt][0][jj] = (f32x4){0.f, 0.f, 0.f, 0.f};
        __syncthreads();
        for (int c = 0; c < 16; ++c) {
            const size_t t0 = (size_t)b * SEQ + c * 128;
            const char* gq = (const char*)(QKV + t0 * 4096 + h * 256);
            const char* gv = (const char*)(QKV + t0 * 4096 + 2048 + h * 512 + vs * 128);
            char* gy = (char*)(ys + t0 * 2048 + h * 512 + vs * 128);
            float lgc = lg * 1.4426950408889634f; asm volatile("" : "+v"(lgc));
#pragma unroll
            for (int i = 0; i < 4; ++i) { const int id = tid + NTHR * i, row = id >> 4, c8 = id & 15;
                const v4u v = *(const v4u*)(gv + (unsigned)((row * 4096 + c8 * 8) * 2)); const unsigned vw[4] = {v.x, v.y, v.z, v.w};
#pragma unroll
                for (int e = 0; e < 4; ++e) { VT[(c8 * 8 + 2 * e) * 136 + row] = (bf16)(vw[e] & 0xffffu); VT[(c8 * 8 + 2 * e + 1) * 136 + row] = (bf16)(vw[e] >> 16); } }
            {
                f32x4 S[2][4];
#pragma unroll
                for (int i = 0; i < 2; ++i)
#pragma unroll
                    for (int jj = 0; jj < 4; ++jj) S[i][jj] = (f32x4){0.f, 0.f, 0.f, 0.f};
#pragma unroll 1
                for (int dt = 0; dt < 4; ++dt) {
                    if (dt) __syncthreads();
#pragma unroll
                    for (int i = 0; i < 2; ++i) { const int id = tid + NTHR * i, row = id >> 3, c8 = id & 7;
                        const char* src = gq + (unsigned)((row * 4096 + dt * 64 + c8 * 8) * 2);
                        *(LAS v4u*)(Qd + row * 72 + c8 * 8) = *(const v4u*)src; *(LAS v4u*)(Kd + row * 72 + c8 * 8) = *(const v4u*)(src + 2048); }
                    __syncthreads();
                    wgemm<2, 4, 64, 72, 72>(S, Qd + 32 * wh * 72, Kd + 64 * wl * 72, lane);
                }
#pragma unroll
                for (int i = 0; i < 2; ++i)
#pragma unroll
                    for (int e = 0; e < 4; ++e) { const int t = 32 * wh + 16 * i + 4 * fq + e;
#pragma unroll
                        for (int jj = 0; jj < 4; ++jj) { const int s = 64 * wl + 16 * jj + fr; const float wgt = (t >= s) ? __builtin_amdgcn_exp2f((float)(t - s) * lgc) : 0.f;
                            Ps[t * 136 + s] = (bf16)f2bf(S[i][jj][e] * wgt); } }
            }
            __syncthreads();
            f32x4 X[2][4];
#pragma unroll
            for (int i = 0; i < 2; ++i)
#pragma unroll
                for (int jj = 0; jj < 4; ++jj) X[i][jj] = (f32x4){0.f, 0.f, 0.f, 0.f};
            wgemm<2, 4, 128, 136, 136>(X, Ps + 32 * wh * 136, VT + 64 * wl * 136, lane);
#pragma unroll
            for (int dt = 0; dt < 4; ++dt) {
                if (dt) __syncthreads();
#pragma unroll
                for (int i = 0; i < 2; ++i) { const int id = tid + NTHR * i, row = id >> 3, c8 = id & 7;
                    const char* src = gq + (unsigned)((row * 4096 + dt * 64 + c8 * 8) * 2);
                    const v4u q = *(const v4u*)src, k = *(const v4u*)(src + 2048); const unsigned qw[4] = {q.x, q.y, q.z, q.w}, kw[4] = {k.x, k.y, k.z, k.w};
                    const float xi = __builtin_amdgcn_exp2f((float)(row + 1) * lgc), z = __builtin_amdgcn_exp2f((float)(127 - row) * lgc);
                    v4u qo; qo.x = cvtpk(lo_bf(qw[0]) * xi, hi_bf(qw[0]) * xi); qo.y = cvtpk(lo_bf(qw[1]) * xi, hi_bf(qw[1]) * xi); qo.z = cvtpk(lo_bf(qw[2]) * xi, hi_bf(qw[2]) * xi); qo.w = cvtpk(lo_bf(qw[3]) * xi, hi_bf(qw[3]) * xi);
                    *(LAS v4u*)(Qd + row * 72 + c8 * 8) = qo;
#pragma unroll
                    for (int e = 0; e < 4; ++e) { KzT[(c8 * 8 + 2 * e) * 136 + row] = (bf16)f2bf(lo_bf(kw[e]) * z); KzT[(c8 * 8 + 2 * e + 1) * 136 + row] = (bf16)f2bf(hi_bf(kw[e]) * z); } }
#pragma unroll
                for (int jj = 0; jj < 4; ++jj)
#pragma unroll
                    for (int e = 0; e < 4; ++e) Rb[(16 * w + 4 * fq + e) * 72 + 16 * jj + fr] = (bf16)f2bf(Racc[dt][0][jj][e]);
                __syncthreads();
                wgemm<2, 4, 64, 72, 72>(X, Qd + 32 * wh * 72, Rb + 64 * wl * 72, lane);
#pragma unroll
                for (int jj = 0; jj < 4; ++jj) Racc[dt][0][jj] = Racc[dt][0][jj] * gch;
                wgemm<1, 4, 128, 136, 136>(Racc[dt], VT + 16 * w * 136, KzT, lane);
            }
#pragma unroll
            for (int i = 0; i < 2; ++i)
#pragma unroll
                for (int e = 0; e < 4; ++e) { const int t = 32 * wh + 16 * i + 4 * fq + e; float s1 = 0.f, s2 = 0.f;
#pragma unroll
                    for (int jj = 0; jj < 4; ++jj) { const float y = X[i][jj][e]; s1 += y; s2 += y * y;
                        *(bf16*)(gy + (unsigned)((t * 2048 + 64 * wl + 16 * jj + fr) * 2)) = (bf16)f2bf(y); }
                    s1 += __shfl_xor(s1, 1); s1 += __shfl_xor(s1, 2); s1 += __shfl_xor(s1, 4); s1 += __shfl_xor(s1, 8);
                    s2 += __shfl_xor(s2, 1); s2 += __shfl_xor(s2, 2); s2 += __shfl_xor(s2, 4); s2 += __shfl_xor(s2, 8);
                    if (fr == 0) { fST[(wl * 128 + t) * 2] = s1; fST[(wl * 128 + t) * 2 + 1] = s2; } }
            __syncthreads();
            if (tid < 128) { float* sp = st + (t0 + tid) * 32 + (h * 4 + vs) * 2; sp[0] = fST[tid * 2] + fST[(128 + tid) * 2]; sp[1] = fST[tid * 2 + 1] + fST[(128 + tid) * 2 + 1]; }
        }
    }
}

__device__ __forceinline__ void lru_conv(Frame& F, const bf16* GX, const float* cw, const float* cb, bf16* XC, const float* lru, float* sptab) {
    if (blockIdx.x == 0) for (int i = F.tid; i < 1024; i += NTHR) { const float l = -lru[i]; sptab[i] = fmaxf(l, 0.f) + log1pf(expf(-fabsf(l))); }
    const size_t total = (size_t)MTOK * 128, stride = (size_t)F.G * NTHR;
    for (size_t id = (size_t)blockIdx.x * NTHR + F.tid; id < total; id += stride) {
        const int row = (int)(id >> 7), c8 = (int)(id & 127), t = row & (SEQ - 1);
        float acc[8];
#pragma unroll
        for (int e = 0; e < 8; ++e) acc[e] = cb[c8 * 8 + e];
#pragma unroll
        for (int wv = 0; wv < 4; ++wv) { if (t - 3 + wv < 0) continue;
            const v4u x = *(const v4u*)(GX + (size_t)(row - 3 + wv) * 2048 + 1024 + c8 * 8); const unsigned xw[4] = {x.x, x.y, x.z, x.w};
            const f32x4 w0 = *(const f32x4*)(cw + wv * 1024 + c8 * 8), w1 = *(const f32x4*)(cw + wv * 1024 + c8 * 8 + 4);
            acc[0] += lo_bf(xw[0]) * w0.x; acc[1] += hi_bf(xw[0]) * w0.y; acc[2] += lo_bf(xw[1]) * w0.z; acc[3] += hi_bf(xw[1]) * w0.w;
            acc[4] += lo_bf(xw[2]) * w1.x; acc[5] += hi_bf(xw[2]) * w1.y; acc[6] += lo_bf(xw[3]) * w1.z; acc[7] += hi_bf(xw[3]) * w1.w; }
        v4u o; o.x = cvtpk(acc[0], acc[1]); o.y = cvtpk(acc[2], acc[3]); o.z = cvtpk(acc[4], acc[5]); o.w = cvtpk(acc[6], acc[7]);
        *(v4u*)(XC + (size_t)row * 1024 + c8 * 8) = o;
    }
}
__device__ __forceinline__ float gelu_tanh(float x) { const float z = 0.7978845608028654f * (x + 0.044715f * x * x * x); const float e = __expf(2.0f * z); const float th = 1.0f - 2.0f * __builtin_amdgcn_rcpf(e + 1.0f); return 0.5f * x * (1.0f + th); }
__device__ __forceinline__ void lru_scan(Frame& F, const bf16* LA, const bf16* BT, const bf16* GX, bf16* Y) {
    LAS float* segL = (LAS float*)F.lds;
    LAS float* segH = segL + 512;
    const int lane = F.lane, w = F.wave;
    for (int item = blockIdx.x; item < 256; item += F.G) {
        const int b = item >> 4, ch = (item & 15) * 64 + lane;
        const size_t r0 = (size_t)b * SEQ + w * 256;
        float L = 0.f, H = 0.f;
#pragma unroll 8
        for (int t = 0; t < 256; ++t) { const float la = bf2f(LA[(r0 + t) * 1024 + ch]), bt = bf2f(BT[(r0 + t) * 1024 + ch]); L += la; H = __expf(la) * H + bt; }
        __syncthreads();
        segL[w * 64 + lane] = L; segH[w * 64 + lane] = H;
        __syncthreads();
        float hc = 0.f;
        for (int s = 0; s < w; ++s) hc = __expf(segL[s * 64 + lane]) * hc + segH[s * 64 + lane];
#pragma unroll 8
        for (int t = 0; t < 256; ++t) { const float la = bf2f(LA[(r0 + t) * 1024 + ch]), bt = bf2f(BT[(r0 + t) * 1024 + ch]); hc = __expf(la) * hc + bt;
            const float gb = bf2f(GX[(r0 + t) * 2048 + ch]); Y[(r0 + t) * 1024 + ch] = (bf16)f2bf(hc * gelu_tanh(gb)); }
    }
}

template <class Epi>
__device__ __forceinline__ void run_gemm(Frame& F, const bf16* A, int lda, const bf16* Bt, int ldb, int N, int K, const Epi& E) {
    pg8::Gemm g{A, Bt, MTOK, N, K, lda, ldb}; pg8::StaticOrder S; S.init(MTOK, N, F.G, (int)blockIdx.x);
    pg8::gemm_phase<Epi, pg8::StaticOrder, true, true>(F.lds, g, S, E);
}

typedef const __attribute__((address_space(4))) struct Args* ArgsP;
constexpr int NPHASE = 34;
__device__ __forceinline__ ArgsP get_args() { ArgsP p = (ArgsP)__builtin_amdgcn_kernarg_segment_ptr(); asm volatile("" : "+s"(p)); return p; }
__device__ __forceinline__ bool in_phase(int k, int lo, int hi) { asm volatile("" : "+s"(lo), "+s"(hi)); return lo <= k && k < hi; }
#define AP ArgsP ap = get_args(); { int t_ = threadIdx.x; asm volatile("" : "+v"(t_)); F.tid = t_; F.lane = t_ & 63; }
__global__ void __launch_bounds__(NTHR, 2) trunk_fwd(Args args) {
    extern __shared__ __attribute__((aligned(16))) unsigned char lds_raw[];
    Frame F; F.lds = (LAS unsigned char*)lds_raw; F.tid = threadIdx.x; F.lane = F.tid & 63; F.wave = __builtin_amdgcn_readfirstlane(F.tid >> 6); F.G = gridDim.x;
    volatile LAS unsigned* MISC = (volatile LAS unsigned*)(F.lds + MISC_OFF);
    if (F.tid < 16) MISC[F.tid] = 0u;
    __syncthreads();
    const int lo = args.ph_lo, hi = args.ph_hi;
    const bool use_bar = (hi - lo) > 1;
    XcdBarrier bar; bar.bar = (unsigned*)(args.ws + WS_CTL) + CW_BAR; bar.x = 0; bar.st = nullptr;
    if (use_bar) bar = xcd_barrier_post((unsigned*)(args.ws + WS_CTL) + CW_BAR, MISC + 8);
#ifndef ONLY_PHASE
#define ONLY_PHASE -1
#endif
#define IN(k) ((ONLY_PHASE < 0 || (k) == ONLY_PHASE) && in_phase((k), lo, hi))
#define SEAM(k) do { if (IN(k) && IN((k) + 1)) xcd_barrier(bar); } while (0)
#define XIN ((const float*)ap->in[0])
#define pos ((const int*)ap->in[1])
#define norm_mix ((const float*)ap->in[2])
#define norm_ffn ((const float*)ap->in[3])
#define ffn_w_in ((const float*)ap->in[4])
#define ffn_w_out ((const float*)ap->in[5])
#define out (ap->out)
#define Wmi ((bf16*)(ap->ws + WS_W_MIXIN))
#define Wmo ((bf16*)(ap->ws + WS_W_MIXOUT))
#define Wfi ((bf16*)(ap->ws + WS_W_FFNIN))
#define Wfo ((bf16*)(ap->ws + WS_W_FFNOUT))
#define U ((bf16*)(ap->ws + WS_U))
#define BIG ((bf16*)(ap->ws + WS_BIG))
#define gatesA ((float*)(ap->ws + WS_GATESA))
#define ssqA ((float*)(ap->ws + WS_SSQA))
#define statC ((float*)(ap->ws + WS_STATC))
#define kmean ((float*)(ap->ws + WS_KMEAN))
#define sptab ((float*)(ap->ws + WS_KMEAN + 512 * 1024))

#define FFN_CVT(l) do { cvt_matrix(F, ffn_w_in + (size_t)(l) * DM * 2 * DFF, 2 * DFF, DM, 2 * DFF, 1, Wfi); cvt_matrix(F, ffn_w_out + (size_t)(l) * DFF * DM, DM, DFF, DM, 0, Wfo); } while (0)
#define FFN_PHASES(p0, l) do { \
    if (IN(p0)) { AP; norm_phase<false>(F, out, norm_ffn + (l) * DM, U, nullptr, nullptr, nullptr); } SEAM(p0); \
    if (IN((p0) + 1)) { AP; pg8::EpiSwiGLU E{BIG, DFF}; run_gemm(F, U, DM, Wfi, DM, 2 * DFF, DM, E); } SEAM((p0) + 1); \
    if (IN((p0) + 2)) { AP; pg8::EpiResid E{out, out, DM}; run_gemm(F, BIG, DFF, Wfo, DFF, DM, DFF, E); } SEAM((p0) + 2); } while (0)

    {
#define a_w_in ((const float*)ap->in[6])
#define a_b ((const float*)ap->in[7])
#define a_g ((const float*)ap->in[8])
#define a_w_out ((const float*)ap->in[9])
#define QKV BIG
#define HO (BIG + (size_t)MTOK * 2048)
        if (IN(0)) { AP; cvt_matrix(F, a_w_in, 3080, DM, 3072, 0, Wmi); cvt_matrix(F, a_w_out, DM, DM, DM, 0, Wmo); FFN_CVT(0);
            __syncthreads(); norm_phase<true>(F, XIN, norm_mix, U, a_w_in, a_b, gatesA); } SEAM(0);
        if (IN(1)) { AP; pg8::EpiStore E{QKV, 2048}; run_gemm(F, U, DM, Wmi, DM, 2048, DM, E); } SEAM(1);
        if (IN(2)) { AP; mlstm_core(F, QKV, gatesA, HO, ssqA); } SEAM(2);
        if (IN(3)) { AP; pg8::EpiGateA E{HO, ssqA, a_g}; run_gemm(F, U, DM, Wmi + (size_t)2048 * DM, DM, DM, DM, E); } SEAM(3);
        if (IN(4)) { AP; pg8::EpiResid E{XIN, out, DM}; run_gemm(F, HO, DM, Wmo, DM, DM, DM, E); } SEAM(4);
        FFN_PHASES(5, 0);
#undef QKV
#undef HO
    }
    {
#define b_w_in ((const float*)ap->in[10])
#define b_gq ((const float*)ap->in[11])
#define b_gk ((const float*)ap->in[12])
#define b_w_out ((const float*)ap->in[13])
#define QKV BIG
        if (IN(8)) { AP; cvt_matrix(F, b_w_in, 3072, DM, 3072, 0, Wmi); cvt_matrix(F, b_w_out, DM, DM, DM, 0, Wmo); FFN_CVT(1);
            __syncthreads(); norm_phase<false>(F, out, norm_mix + DM, U, nullptr, nullptr, nullptr); } SEAM(8);
        if (IN(9)) { AP; pg8::EpiStore E{QKV, 3072}; run_gemm(F, U, DM, Wmi, DM, 3072, DM, E); } SEAM(9);
        if (IN(10)) { AP; moba_prep(F, QKV, pos, b_gq, b_gk, kmean); } SEAM(10);
        if (IN(11)) { AP; moba_attn(F, QKV, kmean); } SEAM(11);
        if (IN(12)) { AP; pg8::EpiResid E{out, out, DM}; run_gemm(F, QKV, 3072, Wmo, DM, DM, DM, E); } SEAM(12);
        FFN_PHASES(13, 1);
#undef QKV
    }
    {
#define c_w_in ((const float*)ap->in[14])
#define c_g ((const float*)ap->in[15])
#define c_w_out ((const float*)ap->in[16])
#define QKV BIG
#define YS (BIG + (size_t)MTOK * 4096)
        if (IN(16)) { AP; cvt_matrix(F, c_w_in, 6144, DM, 6144, 0, Wmi); cvt_matrix(F, c_w_out, DM, 2048, DM, 0, Wmo); FFN_CVT(2);
            __syncthreads(); norm_phase<false>(F, out, norm_mix + 2 * DM, U, nullptr, nullptr, nullptr); } SEAM(16);
        if (IN(17)) { AP; pg8::EpiStore E{QKV, 4096}; run_gemm(F, U, DM, Wmi, DM, 4096, DM, E); } SEAM(17);
        if (IN(18)) { AP; ret_prep(F, QKV, pos); } SEAM(18);
        if (IN(19)) { AP; ret_core(F, QKV, YS, statC); } SEAM(19);
        if (IN(20)) { AP; pg8::EpiGateC E{YS, statC, c_g}; run_gemm(F, U, DM, Wmi + (size_t)4096 * DM, DM, 2048, DM, E); } SEAM(20);
        if (IN(21)) { AP; pg8::EpiResid E{out, out, DM}; run_gemm(F, YS, 2048, Wmo, 2048, DM, 2048, E); } SEAM(21);
        FFN_PHASES(22, 2);
#undef QKV
#undef YS
    }
    {
#define d_w_in ((const float*)ap->in[17])
#define d_cw ((const float*)ap->in[18])
#define d_cb ((const float*)ap->in[19])
#define d_wg ((const float*)ap->in[20])
#define d_bg ((const float*)ap->in[21])
#define d_lru ((const float*)ap->in[22])
#define d_w_out ((const float*)ap->in[23])
#define GX BIG
#define XC (BIG + (size_t)MTOK * 2048)
#define LA (BIG + (size_t)MTOK * 3072)
#define BT (BIG + (size_t)MTOK * 4096)
#define Y (BIG + (size_t)MTOK * 5120)
#define Wg (Wmi + (size_t)2048 * DM)
        if (IN(25)) { AP; cvt_matrix(F, d_w_in, 2048, DM, 2048, 0, Wmi);
#pragma unroll
            for (int blk = 0; blk < 4; ++blk) cvt_matrix(F, d_wg + (size_t)blk * 256 * 512, 512, 256, 512, 2, Wg + (size_t)blk * 512 * 256);
            cvt_matrix(F, d_w_out, DM, DM, DM, 0, Wmo); FFN_CVT(3);
            __syncthreads(); norm_phase<false>(F, out, norm_mix + 3 * DM, U, nullptr, nullptr, nullptr); } SEAM(25);
        if (IN(26)) { AP; pg8::EpiStore E{GX, 2048}; run_gemm(F, U, DM, Wmi, DM, 2048, DM, E); } SEAM(26);
        if (IN(27)) { AP; lru_conv(F, GX, d_cw, d_cb, XC, d_lru, sptab); } SEAM(27);
        if (IN(28)) { AP;
#pragma unroll 1
            for (int blk = 0; blk < 4; ++blk) { pg8::EpiLru E{XC, LA, BT, d_bg + blk * 512, sptab, blk}; run_gemm(F, XC + blk * 256, DM, Wg + (size_t)blk * 512 * 256, 256, 512, 256, E); __syncthreads(); }
        } SEAM(28);
        if (IN(29)) { AP; lru_scan(F, LA, BT, GX, Y); } SEAM(29);
        if (IN(30)) { AP; pg8::EpiResid E{out, out, DM}; run_gemm(F, Y, DM, Wmo, DM, DM, DM, E); } SEAM(30);
        FFN_PHASES(31, 3);
    }
#undef IN
#undef SEAM
#undef XIN
#undef pos
#undef norm_mix
#undef norm_ffn
#undef ffn_w_in
#undef ffn_w_out
#undef out
#undef Wmi
#undef Wmo
#undef Wfi
#undef Wfo
#undef U
#undef BIG
#undef gatesA
#undef ssqA
#undef statC
#undef kmean
#undef sptab
#undef a_w_in
#undef a_b
#undef a_g
#undef a_w_out
#undef b_w_in
#undef b_gq
#undef b_gk
#undef b_w_out
#undef c_w_in
#undef c_g
#undef c_w_out
#undef d_w_in
#undef d_cw
#undef d_cb
#undef d_wg
#undef d_bg
#undef d_lru
#undef d_w_out
#undef GX
#undef XC
#undef LA
#undef BT
#undef Y
#undef Wg
#undef FFN_CVT
#undef FFN_PHASES
}

#ifndef MK_ONE_LAUNCH
#define MK_ONE_LAUNCH 0
#endif
extern "C" void kernel_launch(void* const* d_in, const int* in_sizes, int n_in, void* d_out, int out_size, void* d_ws, size_t ws_size, hipStream_t stream) {
    static int grid = 0;
    if (grid == 0) {
        if (n_in != 24 || out_size != MTOK * DM || ws_size < WS_END) { fprintf(stderr, "kernel_launch: unexpected shapes (n_in %d, out %d, ws %zu); nothing launched\n", n_in, out_size, ws_size); grid = -1; return; }
        int dev = 0, cus = 0, per_cu = 0;
        if (hipGetDevice(&dev) != hipSuccess || hipDeviceGetAttribute(&cus, hipDeviceAttributeMultiprocessorCount, dev) != hipSuccess) { grid = -1; return; }
        if (hipFuncSetAttribute((const void*)trunk_fwd, hipFuncAttributeMaxDynamicSharedMemorySize, LDS_BYTES) != hipSuccess) { fprintf(stderr, "kernel_launch: hipFuncSetAttribute failed\n"); grid = -1; return; }
        if (hipOccupancyMaxActiveBlocksPerMultiprocessor(&per_cu, (const void*)trunk_fwd, NTHR, LDS_BYTES) != hipSuccess || per_cu < 1) { fprintf(stderr, "kernel_launch: occupancy query reports %d blocks per CU\n", per_cu); }
        (void)hipGetLastError();
        grid = cus;
    }
    if (grid < 0) return;
    (void)hipMemsetAsync((char*)d_ws + WS_CTL, 0, CTL_ZERO_BYTES, stream);
    Args a{};
    for (int i = 0; i < 24; ++i) a.in[i] = d_in[i];
    a.out = (float*)d_out; a.ws = (unsigned char*)d_ws;
#if MK_ONE_LAUNCH
    a.ph_lo = 0; a.ph_hi = NPHASE;
    hipLaunchKernelGGL(trunk_fwd, dim3(grid), dim3(NTHR), LDS_BYTES, stream, a);
#else
    for (int p = 0; p < NPHASE; ++p) { a.ph_lo = p; a.ph_hi = p + 1; hipLaunchKernelGGL(trunk_fwd, dim3(grid), dim3(NTHR), LDS_BYTES, stream, a); }
#endif
}
```

```cpp
#include <hip/hip_runtime.h>
#include <cstdio>
#include <cstdint>
#include <cmath>
namespace pg8 {
#define PG8_LAS __attribute__((address_space(3)))
typedef unsigned short bf16_t;
typedef short bf16x8 __attribute__((ext_vector_type(8)));
typedef float f32x4 __attribute__((ext_vector_type(4)));
typedef unsigned u32x4 __attribute__((ext_vector_type(4)));
constexpr int BM = 256, BK = 64, HALF = 128, HTB = HALF * BK * 2  , STAGE_BYTES = 8 * HTB, NXCD = 8, WGM = 8;

__host__ __device__ __forceinline__ int lds_byte(int r, int c) { const int st = (r >> 4) * 2 + (c >> 5), rr = r & 15, cc = c & 31, ob = rr * 64 + cc * 2; return st * 1024 + (ob ^ (((ob >> 9) & 1) << 5)); }
__host__ __device__ __forceinline__ void stage_rc(int b, int& R, int& C) { const int st = b / 1024, sb = b % 1024, swz = sb ^ (((sb >> 9) & 1) << 5); R = (st >> 1) * 16 + swz / 64; C = (st & 1) * 32 + (swz % 64) / 2; }
__host__ __device__ __forceinline__ int perm32(int rho) { const int n = rho >> 4, i = rho & 15; return 8 * (i >> 2) + 4 * n + (i & 3); }

struct Unit { int pm, pn; };
struct Gemm { const bf16_t* A; const bf16_t* Bt; int M, N, K, lda, ldb; };

struct StaticOrder {
    int nM, nN, nwg, G, c;
    __host__ __device__ void init(int M, int N, int G_, int c_) { nM = M / BM; nN = N / BM; nwg = nM * nN; G = G_; c = c_; }
    __host__ __device__ bool next(int i, Unit& u) const {
        const long L = (long)i * G + c; if (L >= nwg) return false;
        int wgid = (int)L; { const int q = nwg / NXCD, r = nwg % NXCD, xcd = wgid % NXCD, off = wgid / NXCD; wgid = (xcd < r ? xcd * (q + 1) : r * (q + 1) + (xcd - r) * q) + off; }
        const int nig = WGM * nN, gid = wgid / nig, fm = gid * WGM, gsz = (nM - fm) < WGM ? (nM - fm) : WGM;
        u.pm = fm + ((wgid % nig) % gsz); u.pn = (wgid % nig) / gsz; return true;
    }
    __device__ __forceinline__ void a_ready(const Unit&) const {}
    __device__ __forceinline__ void done(const Unit&) const {}
};

__device__ __forceinline__ unsigned cvt_pk_bf16(float lo, float hi) { unsigned r; asm volatile("v_cvt_pk_bf16_f32 %0, %1, %2" : "=v"(r) : "v"(lo), "v"(hi)); return r; }
typedef float f32x2 __attribute__((ext_vector_type(2)));

__device__ __forceinline__ float bf2f(unsigned short b) { return __uint_as_float(((unsigned)b) << 16); }
__device__ __forceinline__ float lo_bf(unsigned w) { return __uint_as_float(w << 16); }
__device__ __forceinline__ float hi_bf(unsigned w) { return __uint_as_float(w & 0xffff0000u); }
__device__ __forceinline__ float fast_sigmoid(float x) { return __builtin_amdgcn_rcpf(1.0f + __expf(-x)); }
typedef unsigned u32x2 __attribute__((ext_vector_type(2)));

__device__ __forceinline__ void row_rstd(const float* ssq, int row0, float (&rs)[2][4]) {
#pragma unroll
    for (int ai = 0; ai < 2; ++ai)
#pragma unroll
        for (int m = 0; m < 4; ++m) { const f32x4* p = (const f32x4*)(ssq + (size_t)(row0 + ai * HALF + m * 16) * 16); const f32x4 a = p[0], b = p[1], c = p[2], d = p[3];
            const float t = ((a[0] + a[1]) + (a[2] + a[3])) + ((b[0] + b[1]) + (b[2] + b[3])) + ((c[0] + c[1]) + (c[2] + c[3])) + ((d[0] + d[1]) + (d[2] + d[3]));
            rs[ai][m] = 1.0f / sqrtf(t * (1.0f / 1024.0f) + 1e-6f); }
}
template <bool RS> struct EpiStore {
    static constexpr bool PERM = true, AFTER_DRAIN = false;
    bf16_t* O; int ldc; const float* ssq;
    __device__ __forceinline__ void operator()(const f32x4 (&acc)[2][2][4][2], const Unit& u, int wr, int wc, int fr, int fq) const {
        const int row0 = u.pm * BM + wr * 64 + fr, col0 = u.pn * BM + wc * 32 + 8 * fq;
        float rs[2][4]; if (RS) row_rstd(ssq, row0, rs);
#pragma unroll
        for (int ai = 0; ai < 2; ++ai)
#pragma unroll
            for (int m = 0; m < 4; ++m) { bf16_t* rowp = O + (size_t)(row0 + ai * HALF + m * 16) * ldc + col0; const float sc = RS ? rs[ai][m] : 1.0f;
#pragma unroll
                for (int bj = 0; bj < 2; ++bj) { const f32x4 v0 = acc[ai][bj][m][0] * sc, v1 = acc[ai][bj][m][1] * sc;
                    u32x4 w; w.x = cvt_pk_bf16(v0[0], v0[1]); w.y = cvt_pk_bf16(v0[2], v0[3]); w.z = cvt_pk_bf16(v1[0], v1[1]); w.w = cvt_pk_bf16(v1[2], v1[3]);
                    *(u32x4*)(rowp + bj * HALF) = w;
#if defined(GEMM_EXP) && GEMM_EXP == 3
                    asm volatile("" ::: "memory"); *(volatile u32x4*)(rowp + bj * HALF) = w;
#endif
                } }
    }
};

struct EpiStoreRot {
    static constexpr bool PERM = true, AFTER_DRAIN = false;
    bf16_t* O; const float* cst;
    __device__ __forceinline__ void operator()(const f32x4 (&acc)[2][2][4][2], const Unit& u, int wr, int wc, int fr, int fq) const {
        const int row0 = u.pm * BM + wr * 64 + fr, col0 = u.pn * BM + wc * 32 + 8 * fq, d0 = wc * 32 + 8 * fq;
        const bool rot = u.pn < 8; const float sc = (u.pn >= 4 && u.pn < 8) ? 0.0625f : 1.0f;
#pragma unroll
        for (int ai = 0; ai < 2; ++ai)
#pragma unroll
            for (int m = 0; m < 4; ++m) { const int row = row0 + ai * HALF + m * 16; bf16_t* rowp = O + (size_t)row * 4096 + col0;
                f32x4 v[2][2];
#pragma unroll
                for (int bj = 0; bj < 2; ++bj) { v[bj][0] = acc[ai][bj][m][0]; v[bj][1] = acc[ai][bj][m][1]; }
                if (rot) { const float* cp = cst + (size_t)row * 256 + d0;
#pragma unroll
                    for (int n = 0; n < 2; ++n) { const f32x4 c = *(const f32x4*)(cp + 4 * n), sn = *(const f32x4*)(cp + 128 + 4 * n); const f32x4 x1 = v[0][n], x2 = v[1][n];
                        v[0][n] = (x1 * c - x2 * sn) * sc; v[1][n] = (x2 * c + x1 * sn) * sc; } }
#pragma unroll
                for (int bj = 0; bj < 2; ++bj) { u32x4 w; w.x = cvt_pk_bf16(v[bj][0][0], v[bj][0][1]); w.y = cvt_pk_bf16(v[bj][0][2], v[bj][0][3]); w.z = cvt_pk_bf16(v[bj][1][0], v[bj][1][1]); w.w = cvt_pk_bf16(v[bj][1][2], v[bj][1][3]);
                    *(u32x4*)(rowp + bj * HALF) = w; } }
    }
};
template <bool RS> struct EpiSwiGLU {
    static constexpr bool PERM = true, AFTER_DRAIN = false;
    bf16_t* O; int ldc; const float* ssq;
    __device__ __forceinline__ void operator()(const f32x4 (&acc)[2][2][4][2], const Unit& u, int wr, int wc, int fr, int fq) const {
        const int row0 = u.pm * BM + wr * 64 + fr, col0 = u.pn * HALF + wc * 32 + 8 * fq;
        float rs[2][4]; if (RS) row_rstd(ssq, row0, rs);
#pragma unroll
        for (int ai = 0; ai < 2; ++ai)
#pragma unroll
            for (int m = 0; m < 4; ++m) { bf16_t* rowp = O + (size_t)(row0 + ai * HALF + m * 16) * ldc + col0; const float sc = RS ? rs[ai][m] : 1.0f;
                float h[8];
#pragma unroll
                for (int n = 0; n < 2; ++n)
#pragma unroll
                    for (int j = 0; j < 4; ++j) { const float g = acc[ai][0][m][n][j] * sc, up = acc[ai][1][m][n][j] * sc;
#if defined(GEMM_EXP) && GEMM_EXP == 2
                        h[4 * n + j] = g * (0.5f * (fast_sigmoid(g) + (1.0f - fast_sigmoid(-g)))) * up;
#else
                        h[4 * n + j] = g * fast_sigmoid(g) * up;
#endif
                    }
                u32x4 w; w.x = cvt_pk_bf16(h[0], h[1]); w.y = cvt_pk_bf16(h[2], h[3]); w.z = cvt_pk_bf16(h[4], h[5]); w.w = cvt_pk_bf16(h[6], h[7]);

#if defined(NT_HIDDEN) && NT_HIDDEN
                __builtin_nontemporal_store(w, (u32x4*)rowp);
#else
                *(u32x4*)rowp = w;
#endif
                }
    }
};
template <bool NX> struct EpiResid {
    static constexpr bool PERM = false, AFTER_DRAIN = false;
    const float* base; float* out; int ldc; bf16_t* hb; float* ssq;
    __device__ __forceinline__ void operator()(const f32x4 (&acc)[2][2][4][2], const Unit& u, int wr, int wc, int fr, int fq) const {
        const int row0 = u.pm * BM + wr * 64 + fr, col0 = u.pn * BM + wc * 32 + 4 * fq;
        f32x4 rb[3][4];
#define PG8_RLOAD(g, slot) do { const size_t off_ = (size_t)(row0 + ((g) >> 2) * HALF + ((g) & 3) * 16) * ldc + col0; \
            rb[slot][0] = *(const f32x4*)(base + off_); rb[slot][1] = *(const f32x4*)(base + off_ + 16); rb[slot][2] = *(const f32x4*)(base + off_ + HALF); rb[slot][3] = *(const f32x4*)(base + off_ + HALF + 16); } while (0)
        PG8_RLOAD(0, 0); PG8_RLOAD(1, 1);
#pragma unroll
        for (int g = 0; g < 8; ++g) { const int ai = g >> 2, m = g & 3; const size_t off = (size_t)(row0 + ai * HALF + m * 16) * ldc + col0; float q = 0.f;
            if (g + 2 < 8) PG8_RLOAD(g + 2, (g + 2) % 3);
#pragma unroll
            for (int bj = 0; bj < 2; ++bj)
#pragma unroll
                for (int n = 0; n < 2; ++n) { const f32x4 o = rb[g % 3][bj * 2 + n] + acc[ai][bj][m][n]; *(f32x4*)(out + off + bj * HALF + n * 16) = o;
                    if (NX) { q += (o[0] * o[0] + o[1] * o[1]) + (o[2] * o[2] + o[3] * o[3]); u32x2 w; w.x = cvt_pk_bf16(o[0], o[1]); w.y = cvt_pk_bf16(o[2], o[3]); *(u32x2*)(hb + off + bj * HALF + n * 16) = w; } }
            if (NX) { q += __shfl_xor(q, 16); q += __shfl_xor(q, 32); if (fq == 0) ssq[(size_t)(row0 + ai * HALF + m * 16) * 16 + u.pn * 4 + wc] = q; } }
#undef PG8_RLOAD
    }
};
struct EpiGateA {
    static constexpr bool PERM = true, AFTER_DRAIN = false;
    bf16_t* Y; const float* ssq; const float* gout;
    __device__ __forceinline__ void operator()(const f32x4 (&acc)[2][2][4][2], const Unit& u, int wr, int wc, int fr, int fq) const {
        const int row0 = u.pm * BM + wr * 64 + fr, col0 = u.pn * BM + wc * 32 + 8 * fq;
        f32x4 gv[2][2];
#pragma unroll
        for (int bj = 0; bj < 2; ++bj)
#pragma unroll
            for (int n = 0; n < 2; ++n) gv[bj][n] = *(const f32x4*)(gout + col0 + bj * HALF + 4 * n);
        u32x4 hwb[2][2]; f32x4 spb[2][2];
#define PG8_GLOAD(g, slot) do { const int row_ = row0 + ((g) >> 2) * HALF + ((g) & 3) * 16; const bf16_t* rp_ = Y + (size_t)row_ * 1024 + col0; hwb[slot][0] = *(const u32x4*)rp_; hwb[slot][1] = *(const u32x4*)(rp_ + HALF); \
            spb[slot][0] = *(const f32x4*)(ssq + (size_t)row_ * 32 + u.pn * 8); spb[slot][1] = *(const f32x4*)(ssq + (size_t)row_ * 32 + u.pn * 8 + 4); } while (0)
        PG8_GLOAD(0, 0);
#pragma unroll
        for (int g = 0; g < 8; ++g) { const int ai = g >> 2, m = g & 3, sl = g & 1; const int row = row0 + ai * HALF + m * 16; bf16_t* rowp = Y + (size_t)row * 1024 + col0;
            if (g + 1 < 8) PG8_GLOAD(g + 1, (g + 1) & 1);
            const f32x4 sp = spb[sl][0], sp2 = spb[sl][1];
            const float rstd = 1.0f / sqrtf((((sp[0] + sp[1]) + (sp[2] + sp[3])) + ((sp2[0] + sp2[1]) + (sp2[2] + sp2[3]))) * (1.0f / 256.0f) + 1e-6f);
#pragma unroll
            for (int bj = 0; bj < 2; ++bj) { const u32x4 hw = hwb[sl][bj]; float o[8];
                const unsigned hh[4] = {hw.x, hw.y, hw.z, hw.w};
#pragma unroll
                for (int n = 0; n < 2; ++n)
#pragma unroll
                    for (int j = 0; j < 4; ++j) { const unsigned w = hh[2 * n + (j >> 1)]; const float hv = (j & 1) ? hi_bf(w) : lo_bf(w);
                        o[4 * n + j] = hv * rstd * gv[bj][n][j] * fast_sigmoid(acc[ai][bj][m][n][j]); }
                u32x4 w; w.x = cvt_pk_bf16(o[0], o[1]); w.y = cvt_pk_bf16(o[2], o[3]); w.z = cvt_pk_bf16(o[4], o[5]); w.w = cvt_pk_bf16(o[6], o[7]);
                *(u32x4*)(rowp + bj * HALF) = w; } }
#undef PG8_GLOAD
    }
};
template <bool RS> struct EpiGateC {
    static constexpr bool PERM = true, AFTER_DRAIN = false;
    bf16_t* Y; int ldy; const float* st; const float* gout; const float* hssq;
    __device__ __forceinline__ void operator()(const f32x4 (&acc)[2][2][4][2], const Unit& u, int wr, int wc, int fr, int fq) const {
        const int row0 = u.pm * BM + wr * 64 + fr, col0 = u.pn * BM + wc * 32 + 8 * fq, head = u.pn >> 1;
        float rs[2][4]; if (RS) row_rstd(hssq, row0, rs);
        f32x4 gv[2][2];
#pragma unroll
        for (int bj = 0; bj < 2; ++bj)
#pragma unroll
            for (int n = 0; n < 2; ++n) gv[bj][n] = *(const f32x4*)(gout + col0 + bj * HALF + 4 * n);
        u32x4 hwb[2][2]; f32x4 spb[2][2];
#define PG8_GLOAD(g, slot) do { const int row_ = row0 + ((g) >> 2) * HALF + ((g) & 3) * 16; const bf16_t* rp_ = Y + (size_t)row_ * ldy + col0; hwb[slot][0] = *(const u32x4*)rp_; hwb[slot][1] = *(const u32x4*)(rp_ + HALF); \
            spb[slot][0] = *(const f32x4*)(st + (size_t)row_ * 32 + head * 8); spb[slot][1] = *(const f32x4*)(st + (size_t)row_ * 32 + head * 8 + 4); } while (0)
        PG8_GLOAD(0, 0);
#pragma unroll
        for (int g = 0; g < 8; ++g) { const int ai = g >> 2, m = g & 3, sl = g & 1; const int row = row0 + ai * HALF + m * 16; bf16_t* rowp = Y + (size_t)row * ldy + col0;
            if (g + 1 < 8) PG8_GLOAD(g + 1, (g + 1) & 1);
            const f32x4 s0 = spb[sl][0], s1 = spb[sl][1];
            const float mu = ((s0[0] + s0[2]) + (s1[0] + s1[2])) * (1.0f / 512.0f), ex2 = ((s0[1] + s0[3]) + (s1[1] + s1[3])) * (1.0f / 512.0f);
            const float var = fmaxf(ex2 - mu * mu, 0.f), rstd = 1.0f / sqrtf(var + 1e-6f);
#pragma unroll
            for (int bj = 0; bj < 2; ++bj) { const u32x4 hw = hwb[sl][bj]; float o[8];
                const unsigned hh[4] = {hw.x, hw.y, hw.z, hw.w};
#pragma unroll
                for (int n = 0; n < 2; ++n)
#pragma unroll
                    for (int j = 0; j < 4; ++j) { const unsigned w = hh[2 * n + (j >> 1)]; const float hv = (j & 1) ? hi_bf(w) : lo_bf(w); const float a = RS ? acc[ai][bj][m][n][j] * rs[ai][m] : acc[ai][bj][m][n][j];
                        o[4 * n + j] = (hv - mu) * rstd * gv[bj][n][j] * (a * fast_sigmoid(a)); }
                u32x4 w; w.x = cvt_pk_bf16(o[0], o[1]); w.y = cvt_pk_bf16(o[2], o[3]); w.z = cvt_pk_bf16(o[4], o[5]); w.w = cvt_pk_bf16(o[6], o[7]);
                *(u32x4*)(rowp + bj * HALF) = w; } }
#undef PG8_GLOAD
    }
};
struct EpiLru {
    static constexpr bool PERM = true, AFTER_DRAIN = false;
    const bf16_t* XC; bf16_t* LA; bf16_t* BT; const float* bg; const float* sp; int blk;
    __device__ __forceinline__ void operator()(const f32x4 (&acc)[2][2][4][2], const Unit& u, int wr, int wc, int fr, int fq) const {
        const int row0 = u.pm * BM + wr * 64 + fr, cb = u.pn * HALF + wc * 32 + 8 * fq, ch0 = blk * 256 + cb;
        u32x4 xwb[2]; xwb[0] = *(const u32x4*)(XC + (size_t)row0 * 1024 + ch0);
#pragma unroll
        for (int g = 0; g < 8; ++g) { const int ai = g >> 2, m = g & 3; const size_t off = (size_t)(row0 + ai * HALF + m * 16) * 1024 + ch0;
                if (g + 1 < 8) xwb[(g + 1) & 1] = *(const u32x4*)(XC + (size_t)(row0 + ((g + 1) >> 2) * HALF + ((g + 1) & 3) * 16) * 1024 + ch0);
                const u32x4 xw = xwb[g & 1]; const unsigned xx[4] = {xw.x, xw.y, xw.z, xw.w};
                unsigned lw[4], bw[4];
#pragma unroll
                for (int n = 0; n < 2; ++n) { const f32x4 br = *(const f32x4*)(bg + cb + 4 * n), bi = *(const f32x4*)(bg + 256 + cb + 4 * n), spv = *(const f32x4*)(sp + ch0 + 4 * n); float la[4], bt[4];
#pragma unroll
                    for (int j = 0; j < 4; ++j) { const int q = 4 * n + j; const unsigned w = xx[q >> 1]; const float xc = (q & 1) ? hi_bf(w) : lo_bf(w);
                        const float r = fast_sigmoid(acc[ai][0][m][n][j] + br[j]), ig = fast_sigmoid(acc[ai][1][m][n][j] + bi[j]);
                        const float l = -8.0f * r * spv[j]; la[j] = l; bt[j] = sqrtf(fmaxf(1.0f - __expf(2.0f * l), 0.f)) * ig * xc; }
                    lw[2 * n] = cvt_pk_bf16(la[0], la[1]); lw[2 * n + 1] = cvt_pk_bf16(la[2], la[3]); bw[2 * n] = cvt_pk_bf16(bt[0], bt[1]); bw[2 * n + 1] = cvt_pk_bf16(bt[2], bt[3]); }
                u32x4 w; w.x = lw[0]; w.y = lw[1]; w.z = lw[2]; w.w = lw[3]; *(u32x4*)(LA + off) = w;
                w.x = bw[0]; w.y = bw[1]; w.z = bw[2]; w.w = bw[3]; *(u32x4*)(BT + off) = w; }
    }
};

template <class Epi, class Sched, bool ALIGN_EPI = false, bool SP2 = false>
__device__ __forceinline__ void gemm_phase(PG8_LAS unsigned char* lds, const Gemm g, const Sched& S, const Epi& E) {
    int tid_ = threadIdx.x; asm volatile("" : "+v"(tid_));
    const int tid = tid_, wid = __builtin_amdgcn_readfirstlane(tid >> 6), lane = tid & 63, wr = wid >> 2, wc = wid & 3, fr = lane & 15, fq = lane >> 4;
    const int K = g.K, nt = K / BK;
    unsigned voffA[2], voffB[2];
#pragma unroll
    for (int i = 0; i < 2; ++i) { int R, C; stage_rc(tid * 16 + i * 8192, R, C); const int Rb = Epi::PERM ? ((R & ~31) + perm32(R & 31)) : R;
        voffA[i] = (unsigned)(R * g.lda + C) * 2u; voffB[i] = (unsigned)(Rb * g.ldb + C) * 2u; }
    const size_t kstep = (size_t)(BK * 2);
    const size_t hstepA = (size_t)HALF * g.lda * 2, hstepB = (size_t)HALF * g.ldb * 2;
    const size_t tstepA = 2 * hstepA, tstepB = 2 * hstepB;
    const unsigned ldsw = (unsigned)wid * 1024u;
    const int aoff = lds_byte(wr * 64 + fr, fq * 8), boff = lds_byte(wc * 32 + fr, fq * 8);
#define PG8_SA(b, h) (((b) * 2 + (h)) * HTB)
#define PG8_SB(b, h) ((4 + (b) * 2 + (h)) * HTB)
#define PG8_STAGE(bufoff, gbase, voff) do { _Pragma("unroll") for (int _i = 0; _i < 2; ++_i) \
        __builtin_amdgcn_global_load_lds((const unsigned*)((const char*)(gbase) + (voff)[_i]), (PG8_LAS unsigned*)(lds + (bufoff) + ldsw + _i * 8192), 16, 0, 0); } while (0)
#define PG8_LDA(dst, b, h) do { _Pragma("unroll") for (int m = 0; m < 4; ++m) _Pragma("unroll") for (int k = 0; k < 2; ++k) dst[m][k] = *(const PG8_LAS bf16x8*)(lds + PG8_SA(b, h) + aoff + m * 2048 + k * 1024); } while (0)
#define PG8_LDB(dst, b, h) do { _Pragma("unroll") for (int n = 0; n < 2; ++n) _Pragma("unroll") for (int k = 0; k < 2; ++k) dst[n][k] = *(const PG8_LAS bf16x8*)(lds + PG8_SB(b, h) + boff + n * 2048 + k * 1024); } while (0)
#define PG8_MMA(ai, bj, At, Bt) do { __builtin_amdgcn_s_setprio(1); _Pragma("unroll") for (int m = 0; m < 4; ++m) _Pragma("unroll") for (int n = 0; n < 2; ++n) _Pragma("unroll") for (int k = 0; k < 2; ++k) \
        acc[ai][bj][m][n] = __builtin_amdgcn_mfma_f32_16x16x32_bf16(Bt[n][k], At[m][k], acc[ai][bj][m][n], 0, 0, 0); __builtin_amdgcn_s_setprio(0); } while (0)
#define PG8_WAIT_V(n) asm volatile("s_waitcnt vmcnt(" #n ")" ::: "memory")
#define PG8_WAIT_L(n) asm volatile("s_waitcnt lgkmcnt(" #n ")" ::: "memory")
#define PG8_BAR __builtin_amdgcn_s_barrier()
#define PG8_SCHED __builtin_amdgcn_sched_barrier(0)
    Unit cur, nxt; int ui = 0;
    if (!S.next(0, cur)) return;
    f32x4 acc[2][2][4][2];
#pragma unroll
    for (int a = 0; a < 2; ++a)
#pragma unroll
        for (int b = 0; b < 2; ++b)
#pragma unroll
            for (int m = 0; m < 4; ++m)
#pragma unroll
                for (int n = 0; n < 2; ++n) acc[a][b][m][n] = (f32x4){0.f, 0.f, 0.f, 0.f};
    bf16x8 At[4][2], B0[2][2], B1[2][2];
    const char* cA = (const char*)g.A + (size_t)cur.pm * tstepA; const char* cB = (const char*)g.Bt + (size_t)cur.pn * tstepB;
    S.a_ready(cur);
    if constexpr (SP2) {
        PG8_STAGE(PG8_SB(0, 0), cB, voffB); PG8_STAGE(PG8_SB(0, 1), cB + hstepB, voffB); PG8_STAGE(PG8_SA(0, 0), cA, voffA); PG8_STAGE(PG8_SA(0, 1), cA + hstepA, voffA);
        if (wr == 1) PG8_BAR;
        PG8_WAIT_V(2); PG8_BAR;
        PG8_STAGE(PG8_SB(1, 0), cB + kstep, voffB); PG8_STAGE(PG8_SA(1, 0), cA + kstep, voffA); PG8_STAGE(PG8_SB(1, 1), cB + hstepB + kstep, voffB);
        PG8_WAIT_V(6); PG8_BAR;
    } else {
        PG8_STAGE(PG8_SB(0, 0), cB, voffB); PG8_STAGE(PG8_SA(0, 0), cA, voffA); PG8_STAGE(PG8_SB(0, 1), cB + hstepB, voffB); PG8_STAGE(PG8_SA(0, 1), cA + hstepA, voffA);
        if (wr == 1) PG8_BAR;
        PG8_WAIT_V(4); PG8_BAR;
        PG8_STAGE(PG8_SB(1, 0), cB + kstep, voffB); PG8_STAGE(PG8_SA(1, 0), cA + kstep, voffA); PG8_STAGE(PG8_SB(1, 1), cB + hstepB + kstep, voffB);
        PG8_WAIT_V(6); PG8_BAR;
    }
    for (;;) {
        const bool has_next = S.next(ui + 1, nxt);
        const char* nA = has_next ? (const char*)g.A + (size_t)nxt.pm * tstepA : cA; const char* nB = has_next ? (const char*)g.Bt + (size_t)nxt.pn * tstepB : cB;
        for (int t = 0; t < nt; t += 2) {
            const bool last = (t == nt - 2);
            const char* a1 = cA + (size_t)(t + 1) * kstep;
            const char* a2 = last ? nA : cA + (size_t)(t + 2) * kstep; const char* b2 = last ? nB : cB + (size_t)(t + 2) * kstep;
            const char* a3 = a2 + kstep; const char* b3 = b2 + kstep;
            if (last && has_next) S.a_ready(nxt);
            if constexpr (SP2) {
            PG8_LDB(B0, 0, 0); PG8_LDB(B1, 0, 1); PG8_SCHED; PG8_LDA(At, 0, 0); PG8_STAGE(PG8_SA(1, 1), a1 + hstepA, voffA);
            PG8_WAIT_V(8); PG8_WAIT_L(0); PG8_BAR; PG8_MMA(0, 0, At, B0); PG8_MMA(0, 1, At, B1); PG8_BAR; PG8_SCHED;
            PG8_LDA(At, 0, 1); PG8_STAGE(PG8_SB(0, 0), b2, voffB); PG8_STAGE(PG8_SB(0, 1), b2 + hstepB, voffB); PG8_STAGE(PG8_SA(0, 0), a2, voffA);
            PG8_WAIT_V(8); PG8_WAIT_L(0); PG8_BAR; PG8_MMA(1, 0, At, B0); PG8_MMA(1, 1, At, B1); PG8_BAR; PG8_SCHED;
            PG8_LDB(B0, 1, 0); PG8_LDB(B1, 1, 1); PG8_SCHED; PG8_LDA(At, 1, 0); PG8_STAGE(PG8_SA(0, 1), a2 + hstepA, voffA);
            PG8_WAIT_V(8); PG8_WAIT_L(0); PG8_BAR; PG8_MMA(0, 0, At, B0); PG8_MMA(0, 1, At, B1); PG8_BAR; PG8_SCHED;
            PG8_LDA(At, 1, 1); PG8_STAGE(PG8_SB(1, 0), b3, voffB); PG8_STAGE(PG8_SB(1, 1), b3 + hstepB, voffB); PG8_STAGE(PG8_SA(1, 0), a3, voffA);
            PG8_WAIT_V(8); PG8_WAIT_L(0); PG8_BAR; PG8_MMA(1, 0, At, B0); PG8_MMA(1, 1, At, B1); PG8_BAR; PG8_SCHED;
            } else {
            PG8_LDB(B0, 0, 0); PG8_SCHED; PG8_LDA(At, 0, 0); PG8_STAGE(PG8_SA(1, 1), a1 + hstepA, voffA);
            PG8_WAIT_L(8); PG8_BAR; PG8_WAIT_L(0); PG8_MMA(0, 0, At, B0); PG8_BAR; PG8_SCHED;
            PG8_LDB(B1, 0, 1); PG8_STAGE(PG8_SB(0, 0), b2, voffB);
            PG8_BAR; PG8_WAIT_L(0); PG8_MMA(0, 1, At, B1); PG8_BAR;
            PG8_LDA(At, 0, 1); PG8_STAGE(PG8_SA(0, 0), a2, voffA);
            PG8_BAR; PG8_WAIT_L(0); PG8_MMA(1, 0, At, B0); PG8_BAR; PG8_SCHED;
            PG8_STAGE(PG8_SB(0, 1), b2 + hstepB, voffB);
            PG8_WAIT_V(6); PG8_BAR; PG8_MMA(1, 1, At, B1); PG8_BAR;
            PG8_LDB(B0, 1, 0); PG8_SCHED; PG8_LDA(At, 1, 0); PG8_STAGE(PG8_SA(0, 1), a2 + hstepA, voffA);
            PG8_WAIT_L(8); PG8_BAR; PG8_WAIT_L(0); PG8_MMA(0, 0, At, B0); PG8_BAR; PG8_SCHED;
            PG8_LDB(B1, 1, 1); PG8_STAGE(PG8_SB(1, 0), b3, voffB);
            PG8_BAR; PG8_WAIT_L(0); PG8_MMA(0, 1, At, B1); PG8_BAR;
            PG8_LDA(At, 1, 1); PG8_STAGE(PG8_SA(1, 0), a3, voffA);
            PG8_BAR; PG8_WAIT_L(0); PG8_MMA(1, 0, At, B0); PG8_BAR; PG8_SCHED;
            PG8_STAGE(PG8_SB(1, 1), b3 + hstepB, voffB);
            PG8_WAIT_V(6); PG8_BAR; PG8_MMA(1, 1, At, B1); PG8_BAR;
            }
        }
        if constexpr (ALIGN_EPI) { if (wr == 0) PG8_BAR; }
        if constexpr (!Epi::AFTER_DRAIN) { E(acc, cur, wr, wc, fr, fq); S.done(cur); }
        if (!has_next) break;
#pragma unroll
        for (int a = 0; a < 2; ++a)
#pragma unroll
            for (int b = 0; b < 2; ++b)
#pragma unroll
                for (int m = 0; m < 4; ++m)
#pragma unroll
                    for (int n = 0; n < 2; ++n) acc[a][b][m][n] = (f32x4){0.f, 0.f, 0.f, 0.f};
        cur = nxt; cA = nA; cB = nB; ++ui;
        if constexpr (ALIGN_EPI) { if (wr == 1) PG8_BAR; }
    }
    PG8_WAIT_V(0);
    if constexpr (!ALIGN_EPI) { if (wr == 0) PG8_BAR; }
    PG8_BAR;
    if constexpr (Epi::AFTER_DRAIN) { E.fused(acc, cur, wr, wc, fr, fq, lds, wid, lane); S.done(cur); }
#undef PG8_SA
#undef PG8_SB
#undef PG8_STAGE
#undef PG8_LDA
#undef PG8_LDB
#undef PG8_MMA
#undef PG8_WAIT_V
#undef PG8_WAIT_L
#undef PG8_BAR
#undef PG8_SCHED
}
}
#define GAS __attribute__((address_space(1)))
#define LAS __attribute__((address_space(3)))
typedef unsigned short bf16;
typedef unsigned v4u __attribute__((ext_vector_type(4)));
typedef float f32x4 __attribute__((ext_vector_type(4)));
typedef short bf16x8 __attribute__((ext_vector_type(8)));
typedef GAS unsigned gu32;
typedef GAS unsigned long long gu64;
#define RLX_AGENT __ATOMIC_RELAXED, __HIP_MEMORY_SCOPE_AGENT
#define LDS_WAIT() asm volatile("s_waitcnt lgkmcnt(0)" ::: "memory")
#define VM_WAIT() asm volatile("s_waitcnt vmcnt(0)" ::: "memory")
__device__ __forceinline__ unsigned long long rt() { return __builtin_amdgcn_s_memrealtime(); }
__device__ __forceinline__ unsigned f2bf(float f) { unsigned u = __builtin_bit_cast(unsigned, f); return (u + 0x7fffu + ((u >> 16) & 1u)) >> 16; }
__device__ __forceinline__ unsigned pk2(float lo, float hi) { return f2bf(lo) | (f2bf(hi) << 16); }

#define XB_TMO      128
#define XB_XCNT(j)  (256  + 64 * (j))
#define XB_XSUB(j)  (1280 + 64 * (j))
#define XB_XGEN(j)  (2304 + 64 * (j))
#define XB_TOP      3328
#define XB_TOPGEN   3392
#define XCD_BAR_WORDS 3456
#define XB_SPIN_CAP (1u << 18)

__device__ __forceinline__ unsigned xb_ld(unsigned* p)              { return __hip_atomic_load(p, __ATOMIC_RELAXED, __HIP_MEMORY_SCOPE_AGENT); }
__device__ __forceinline__ unsigned xb_add(unsigned* p, unsigned v) { return __hip_atomic_fetch_add(p, v, __ATOMIC_RELAXED, __HIP_MEMORY_SCOPE_AGENT); }
__device__ __forceinline__ unsigned xb_xcc_id() { return (unsigned)__builtin_amdgcn_s_getreg((3 << 11) | 20) & 0xFu; }
#define XB_SPIN(cond, bar) do { unsigned _sp = 0; while (cond) { __builtin_amdgcn_s_sleep(1); \
    if ((++_sp & 255u) == 0u) { if (xb_ld(&(bar)[XB_TMO])) break; if (_sp > XB_SPIN_CAP) { atomicAdd(&(bar)[XB_TMO], 1u); break; } } } } while (0)

struct XcdBarrier {
    unsigned* bar; unsigned x;
    volatile LAS unsigned* st;
};

__device__ __forceinline__ XcdBarrier xcd_barrier_post(unsigned* bar, volatile LAS unsigned* st) {
    XcdBarrier b; b.bar = bar; b.x = xb_xcc_id(); b.st = st;
    if (threadIdx.x == 0) (void)xb_add(&bar[XB_XCNT(b.x)], 1u);
    return b;
}
__device__ __forceinline__ void xcd_barrier_complete(unsigned* bar, unsigned x, unsigned& nloc, unsigned& nx) {
    const unsigned G = gridDim.x * gridDim.y * gridDim.z;
    unsigned sum, cnt, mine, sp = 0u;
    for (;;) {
        sum = 0u; cnt = 0u; mine = 0u;
#pragma unroll
        for (unsigned j = 0; j < 16; ++j) { const unsigned c = xb_ld(&bar[XB_XCNT(j)]); sum += c; cnt += (c > 0u) ? 1u : 0u; mine = (j == x) ? c : mine; }
        if (sum == G) break;
        __builtin_amdgcn_s_sleep(1);
        if ((++sp & 255u) == 0u) { if (xb_ld(&bar[XB_TMO])) break; if (sp > XB_SPIN_CAP) { atomicAdd(&bar[XB_TMO], 1u); break; } }
    }
    nloc = mine > 0u ? mine : 1u; nx = cnt > 0u ? cnt : 1u;
}

__device__ __forceinline__ void xcd_barrier(const XcdBarrier& b) {
    asm volatile("s_waitcnt vmcnt(0)" ::: "memory");
    __syncthreads();
    if (threadIdx.x == 0) {
        unsigned* bar = b.bar;
        __builtin_amdgcn_s_waitcnt(0);
        unsigned nloc = b.st[0], nx = b.st[1];
        if (nloc == 0u) { xcd_barrier_complete(bar, b.x, nloc, nx); b.st[0] = nloc; b.st[1] = nx; }
        const unsigned old = xb_add(&bar[XB_XSUB(b.x)], 1u);
        const unsigned gen = old / nloc;
        if (old + 1u == (gen + 1u) * nloc) {
            __builtin_amdgcn_fence(__ATOMIC_RELEASE, "agent");
            asm volatile("s_waitcnt vmcnt(0)" ::: "memory");
            const unsigned og = xb_add(&bar[XB_TOP], 1u);
            const unsigned tg = og / nx;
            if (og + 1u == (tg + 1u) * nx) xb_add(&bar[XB_TOPGEN], 1u);
            else XB_SPIN(xb_ld(&bar[XB_TOPGEN]) == tg, bar);
            __builtin_amdgcn_fence(__ATOMIC_ACQUIRE, "agent");
            xb_add(&bar[XB_XGEN(b.x)], 1u);
            asm volatile("s_waitcnt vmcnt(0)" ::: "memory");
        } else {
            XB_SPIN(xb_ld(&bar[XB_XGEN(b.x)]) == gen, bar);
            __builtin_amdgcn_fence(__ATOMIC_ACQUIRE, "agent");
            asm volatile("s_waitcnt vmcnt(0)" ::: "memory");
        }
    }
    __syncthreads();
}

constexpr int NWAVES = 8, NTHR = 512;
constexpr int MTOK = 32768, DM = 1024, SEQ = 2048, NB = 16, DFF = 2816;
constexpr size_t MiB = 1u << 20;
constexpr size_t WS_CTL = 0, CTL_ZERO_BYTES = 64 * 1024;
constexpr size_t WS_W_MIXIN = 1 * MiB, WS_W_MIXOUT = 13 * MiB, WS_W_FFNIN = 17 * MiB, WS_W_FFNOUT = 28 * MiB;
constexpr size_t WS_GATESA = 34 * MiB, WS_SSQA = 35 * MiB, WS_STATC = 492 * MiB, WS_KMEAN = 41 * MiB, WS_SSQH = 42 * MiB, WS_SPTAB = 33 * MiB + 512 * 1024;
constexpr size_t WS_U = 44 * MiB, WS_BIG = 108 * MiB, WS_END = 500 * MiB;
constexpr int CW_BAR = 1024;
static_assert((CW_BAR + 3456) * 4 <= (int)CTL_ZERO_BYTES, "ctl");
constexpr int LDS_BYTES = 163840, MISC_OFF = 163584;

typedef unsigned u32x4 __attribute__((ext_vector_type(4)));
typedef unsigned u32x2 __attribute__((ext_vector_type(2)));
typedef float f32x2 __attribute__((ext_vector_type(2)));
struct Frame { LAS unsigned char* lds; int tid, lane, wave, G; };
struct Args { const void* in[24]; float* out; unsigned char* ws; int ph_lo, ph_hi; };

__device__ __forceinline__ float wave_sum(float v) {
#pragma unroll
    for (int o = 1; o < 64; o <<= 1) v += __shfl_xor(v, o);
    return v;
}
__device__ __forceinline__ float bf2f(bf16 b) { return __uint_as_float(((unsigned)b) << 16); }
__device__ __forceinline__ float lo_bf(unsigned w) { return __uint_as_float(w << 16); }
__device__ __forceinline__ float hi_bf(unsigned w) { return __uint_as_float(w & 0xffff0000u); }
__device__ __forceinline__ unsigned cvtpk(float lo, float hi) { return pg8::cvt_pk_bf16(lo, hi); }

typedef short v4s16 __attribute__((ext_vector_type(4)));
template <int LD> __device__ __forceinline__ bf16x8 tr_frag(const LAS bf16* T, int r0, int c0, int lane) {
    const int fr = lane & 15, fq = lane >> 4;
    const LAS bf16* a = T + (r0 + 8 * fq + (fr >> 2)) * LD + c0 + 4 * (fr & 3);
    const v4s16 lo = __builtin_amdgcn_ds_read_tr16_b64_v4i16((LAS v4s16*)a);
    const v4s16 hi = __builtin_amdgcn_ds_read_tr16_b64_v4i16((LAS v4s16*)(a + 4 * LD));
    return __builtin_shufflevector(lo, hi, 0, 1, 2, 3, 4, 5, 6, 7);
}
template <int MT, int NT, int K, int LDA, int LDB, bool TA = false, bool TB = false, bool SB = true>
__device__ __forceinline__ void wgemm(f32x4 (&acc)[MT][NT], const LAS bf16* A, const LAS bf16* Bt, int lane) {
    const int fr = lane & 15, fq = lane >> 4;
    const LAS bf16* ap = A + fr * LDA + 8 * fq;
    const LAS bf16* bp = Bt + fr * LDB + 8 * fq;
#pragma unroll
    for (int k0 = 0; k0 < K; k0 += 32) {
        bf16x8 a[MT], b[NT];
#pragma unroll
        for (int i = 0; i < MT; ++i) a[i] = TA ? tr_frag<LDA>(A, k0, 16 * i, lane) : *(const LAS bf16x8*)(ap + 16 * i * LDA + k0);
#pragma unroll
        for (int j = 0; j < NT; ++j) b[j] = TB ? tr_frag<LDB>(Bt, k0, 16 * j, lane) : *(const LAS bf16x8*)(bp + 16 * j * LDB + k0);
#pragma unroll
        for (int i = 0; i < MT; ++i)
#pragma unroll
            for (int j = 0; j < NT; ++j) acc[i][j] = __builtin_amdgcn_mfma_f32_16x16x32_bf16(a[i], b[j], acc[i][j], 0, 0, 0);
        if (SB && MT * NT >= 4) __builtin_amdgcn_sched_barrier(0);
    }
    if (!SB) __builtin_amdgcn_sched_barrier(0);
}

__device__ __forceinline__ int cvt_src_col(int mode, int g0) {
    if (mode == 0) return g0;
    const int pn = g0 >> 8, r = g0 & 255;
    if (mode == 1) return r < 128 ? 128 * pn + r : DFF + 128 * pn + (r - 128);
    return r < 128 ? 128 * pn + r : 256 + 128 * pn + (r - 128);
}
__device__ __forceinline__ void cvt_matrix(Frame& F, const float* W, int ldw, int K, int Np, int mode, bf16* WT, const float* gain = nullptr) {
    LAS float* scr = (LAS float*)(F.lds + F.wave * 16384);
    const int gw = blockIdx.x * NWAVES + F.wave, NGW = F.G * NWAVES, lane = F.lane;
    const int nblk = Np / 32, nitems = (K / 64) * nblk;
    for (int item = gw; item < nitems; item += NGW) {
        const int kb = item / nblk, nb = item % nblk, k0 = 64 * kb, n0 = 32 * nb, s0 = cvt_src_col(mode, n0);
        float v[32];
#pragma unroll
        for (int i = 0; i < 32; ++i) { const int kk = 2 * i + (lane >> 5); v[i] = W[(size_t)(k0 + kk) * ldw + s0 + (lane & 31)]; }
        if (gain) {
#pragma unroll
            for (int i = 0; i < 32; ++i) v[i] *= gain[k0 + 2 * i + (lane >> 5)]; }
#pragma unroll
        for (int i = 0; i < 32; ++i) scr[(2 * i + (lane >> 5)) * 33 + (lane & 31)] = v[i];
        LDS_WAIT(); asm volatile("" ::: "memory");
        const int c = lane & 7;
#pragma unroll
        for (int j = 0; j < 4; ++j) { const int n = (lane >> 3) + 8 * j; const LAS float* sp = scr + (8 * c) * 33 + n;
            v4u o; o.x = pk2(sp[0 * 33], sp[1 * 33]); o.y = pk2(sp[2 * 33], sp[3 * 33]); o.z = pk2(sp[4 * 33], sp[5 * 33]); o.w = pk2(sp[6 * 33], sp[7 * 33]);
            *(v4u*)(WT + (size_t)(n0 + n) * K + k0 + 8 * c) = o; }
        LDS_WAIT(); asm volatile("" ::: "memory");
    }
}

template <bool GATES>
__device__ __forceinline__ void norm_phase(Frame& F, const float* src, const float* gain, bf16* dst, const float* wA, const float* bA, float* gout) {
    LAS float* wg = (LAS float*)F.lds;
    if (GATES) {
        for (int i = F.tid; i < 1024 * 8; i += NTHR) wg[i] = wA[(size_t)(i >> 3) * 3080 + 3072 + (i & 7)];
        __syncthreads();
    }
    const int gw = blockIdx.x * NWAVES + F.wave, NGW = F.G * NWAVES, lane = F.lane;
    f32x4 g[4];
#pragma unroll
    for (int j = 0; j < 4; ++j) g[j] = ((const f32x4*)gain)[lane + 64 * j];
    for (int m = gw; m < MTOK; m += NGW) {
        const f32x4* xr = (const f32x4*)(src + (size_t)m * DM) + lane;
        f32x4 v[4]; float s = 0.f;
#pragma unroll
        for (int j = 0; j < 4; ++j) { v[j] = xr[64 * j]; s += (v[j].x * v[j].x + v[j].y * v[j].y) + (v[j].z * v[j].z + v[j].w * v[j].w); }
        const float rstd = 1.0f / sqrtf(wave_sum(s) * (1.0f / DM) + 1e-6f);
        unsigned long long* o8 = (unsigned long long*)(dst + (size_t)m * DM) + lane;
#pragma unroll
        for (int j = 0; j < 4; ++j) { v[j] = v[j] * rstd * g[j];
            o8[64 * j] = (unsigned long long)cvtpk(v[j].x, v[j].y) | ((unsigned long long)cvtpk(v[j].z, v[j].w) << 32); }
        if (GATES) {
            float a[8];
#pragma unroll
            for (int q = 0; q < 8; ++q) a[q] = 0.f;
#pragma unroll
            for (int j = 0; j < 4; ++j)
#pragma unroll
                for (int e = 0; e < 4; ++e) { const int k = 4 * lane + 256 * j + e; const f32x4 w0 = *(const LAS f32x4*)(wg + k * 8), w1 = *(const LAS f32x4*)(wg + k * 8 + 4); const float x = v[j][e];
                    a[0] += x * w0.x; a[1] += x * w0.y; a[2] += x * w0.z; a[3] += x * w0.w; a[4] += x * w1.x; a[5] += x * w1.y; a[6] += x * w1.z; a[7] += x * w1.w; }
#pragma unroll
            for (int q = 0; q < 8; ++q) a[q] = wave_sum(a[q]);
            if (lane == 0) {
#pragma unroll
                for (int q = 0; q < 8; ++q) gout[(size_t)m * 8 + q] = a[q] + bA[q]; }
        }
    }
}

__device__ __forceinline__ void mlstm_pre(Frame& F, const float* gates, float* GT) {
    LAS float* sA = (LAS float*)F.lds, *sPM = sA + 2048, *sBC = sPM + 2048, *sBT = sBC + 2048, *sP63 = sBT + 32, *sM = sP63 + 32;
    const int lane = F.lane, w = F.wave;
    for (int item = blockIdx.x; item < 64; item += F.G) {
        const int b = item >> 2, h = item & 3;
        __syncthreads();
        float gi4[4], gf4[4];
#pragma unroll
        for (int i = 0; i < 4; ++i) { const size_t row = (size_t)b * SEQ + (w + 8 * i) * 64 + lane; gi4[i] = gates[row * 8 + h]; gf4[i] = gates[row * 8 + 4 + h]; }
#pragma unroll
        for (int i = 0; i < 4; ++i) { const int c = w + 8 * i;
            const float gi = gi4[i], gf = gf4[i];
            const float fc = fminf(gf, 0.f) - log1pf(__expf(-fabsf(gf)));
            float bc = fc;
#pragma unroll
            for (int o = 1; o < 64; o <<= 1) { const float t = __shfl_up(bc, o); if (lane >= o) bc += t; }
            const float a = gi - bc; float pm = a;
#pragma unroll
            for (int o = 1; o < 64; o <<= 1) { const float t = __shfl_up(pm, o); if (lane >= o) pm = fmaxf(pm, t); }
            sA[c * 64 + lane] = a; sPM[c * 64 + lane] = pm; sBC[c * 64 + lane] = bc; if (lane == 63) { sBT[c] = bc; sP63[c] = pm; } }
        __syncthreads();
        if (F.tid == 0) { float m = 0.f; for (int c = 0; c < 32; ++c) { sM[c] = m; m = sBT[c] + fmaxf(m, sP63[c]); } }
        __syncthreads();
#pragma unroll
        for (int i = 0; i < 4; ++i) { const int c = w + 8 * i; const float mst = sM[c], Mx = fmaxf(mst, sPM[c * 64 + lane]), Mx63 = fmaxf(mst, sP63[c]);
            float* g = GT + ((size_t)(item * 32 + c)) * 320 + lane;
            g[0] = sA[c * 64 + lane]; g[64] = Mx; g[128] = __expf(mst - Mx); g[192] = __expf(-(sBC[c * 64 + lane] + Mx)); g[256] = __expf(sA[c * 64 + lane] - Mx63); }
    }
}
__device__ __forceinline__ void mlstm_pmat(Frame& F, const bf16* QKV, const float* GT, bf16* PMA, float* DENP) {
    constexpr float SCALE = 0.08838834764831845f;
    LAS bf16* Qs = (LAS bf16*)F.lds;
    LAS bf16* Ks = Qs + 64 * 136;
    LAS bf16* Ps = Ks + 64 * 136;
    LAS float* fA = (LAS float*)(Ps + 64 * 72), *fMX = fA + 64;
    const int tid = F.tid, lane = F.lane, w = F.wave, fr = lane & 15, fq = lane >> 4, wh = w >> 1, wl = w & 1;
    const unsigned qoff0 = (unsigned)((((tid >> 4) * 2048) + (tid & 15) * 8) * 2);
    v4u pQ[2], pK[2]; float pg = 0.f;
    int item = blockIdx.x;
    if (item < 2048) { const int bh = item >> 5, c = item & 31; const char* gq = (const char*)(QKV + ((size_t)(bh >> 2) * SEQ + c * 64) * 2048 + (bh & 3) * 128);
#pragma unroll
        for (int i = 0; i < 2; ++i) { pQ[i] = *(const v4u*)(gq + qoff0 + i * (32 * 2048 * 2)); pK[i] = *(const v4u*)(gq + qoff0 + i * (32 * 2048 * 2) + 1024); }
        if (tid < 128) pg = GT[(size_t)item * 320 + tid]; }
    for (; item < 2048; item += F.G) {
        __syncthreads();
#pragma unroll
        for (int i = 0; i < 2; ++i) { const int id = tid + NTHR * i, row = id >> 4, c8 = id & 15; *(LAS v4u*)(Qs + row * 136 + c8 * 8) = pQ[i]; *(LAS v4u*)(Ks + row * 136 + c8 * 8) = pK[i]; }
        if (tid < 128) fA[tid] = pg;
        const int nit = item + F.G;
        if (nit < 2048) { const int bh = nit >> 5, c = nit & 31; const char* gq = (const char*)(QKV + ((size_t)(bh >> 2) * SEQ + c * 64) * 2048 + (bh & 3) * 128);
#pragma unroll
            for (int i = 0; i < 2; ++i) { pQ[i] = *(const v4u*)(gq + qoff0 + i * (32 * 2048 * 2)); pK[i] = *(const v4u*)(gq + qoff0 + i * (32 * 2048 * 2) + 1024); }
            if (tid < 128) pg = GT[(size_t)nit * 320 + tid]; }
        __syncthreads();
        f32x4 sa[1][2]; sa[0][0] = (f32x4){0.f, 0.f, 0.f, 0.f}; sa[0][1] = sa[0][0];
        wgemm<1, 2, 128, 136, 136>(sa, Qs + 16 * wh * 136, Ks + 32 * wl * 136, lane);
        float rs[4] = {0.f, 0.f, 0.f, 0.f};
#pragma unroll
        for (int e = 0; e < 4; ++e) { const int t = 16 * wh + 4 * fq + e; const float mx = fMX[t];
#pragma unroll
            for (int j = 0; j < 2; ++j) { const int sidx = 32 * wl + 16 * j + fr; const float wgt = (sidx <= t) ? SCALE * __expf(fA[sidx] - mx) : 0.f; const float p = sa[0][j][e] * wgt;
                Ps[t * 72 + sidx] = (bf16)f2bf(p); rs[e] += p; } }
#pragma unroll
        for (int e = 0; e < 4; ++e) { float r = rs[e]; r += __shfl_xor(r, 1); r += __shfl_xor(r, 2); r += __shfl_xor(r, 4); r += __shfl_xor(r, 8); if (fr == 0) DENP[(size_t)item * 128 + wl * 64 + 16 * wh + 4 * fq + e] = r; }
        __syncthreads();
        *(v4u*)(PMA + (size_t)item * 4096 + (tid >> 3) * 64 + (tid & 7) * 8) = *(const LAS v4u*)(Ps + (tid >> 3) * 72 + (tid & 7) * 8);
    }
}
__device__ __forceinline__ void mlstm_core(Frame& F, const bf16* QKV, const float* GT, const bf16* PMA, const float* DENP, bf16* hout, float* ssq) {
    constexpr float SCALE = 0.08838834764831845f;
    LAS bf16* Qs = (LAS bf16*)F.lds;
    LAS bf16* Ks = Qs + 64 * 136;
    LAS bf16* Vs = Ks + 64 * 136;
    LAS bf16* VWs = Vs + 64 * 88;
    LAS bf16* Cb = VWs + 64 * 88;
    LAS bf16* Ps = Cb + 80 * 136;
    LAS bf16* Hs = Ps + 64 * 72;
    const int tid = F.tid, lane = F.lane, w = F.wave, fr = lane & 15, fq = lane >> 4, wh = w >> 1, wl = w & 1;
    const unsigned qoff0 = (unsigned)((((tid >> 4) * 2048) + (tid & 15) * 8) * 2), voff0 = (unsigned)((((tid >> 3) * 2048) + (tid & 7) * 8) * 2);
    for (int item = blockIdx.x; item < 256; item += F.G) {
        const int b = item >> 4, h = (item >> 2) & 3, vs = item & 3, bh = b * 4 + h;
        f32x4 Cacc[1][4], Cn[1][1];
#pragma unroll
        for (int j = 0; j < 4; ++j) Cacc[0][j] = (f32x4){0.f, 0.f, 0.f, 0.f};
        Cn[0][0] = (f32x4){0.f, 0.f, 0.f, 0.f};
        const size_t tb = (size_t)b * SEQ;
        v4u pQ[2], pK[2], pV, pP; float pws, pwc, pwi[4], pem[4], pdn[4];
#define MLSTM_FETCH(cc) do { const size_t t0_ = tb + (size_t)(cc) * 64; const char* gq_ = (const char*)(QKV + t0_ * 2048 + h * 128); const char* gv_ = (const char*)(QKV + t0_ * 2048 + 1024 + h * 256 + vs * 64); \
            _Pragma("unroll") for (int i = 0; i < 2; ++i) { pQ[i] = *(const v4u*)(gq_ + qoff0 + i * (32 * 2048 * 2)); pK[i] = *(const v4u*)(gq_ + qoff0 + i * (32 * 2048 * 2) + 1024); } \
            pV = *(const v4u*)(gv_ + voff0); const size_t it_ = (size_t)(bh * 32 + (cc)); pP = *(const v4u*)(PMA + it_ * 4096 + (tid >> 3) * 64 + (tid & 7) * 8); \
            const float* g_ = GT + it_ * 320; pws = g_[256 + (tid >> 3)]; pwc = g_[128 + 63]; \
            _Pragma("unroll") for (int e = 0; e < 4; ++e) { const int t_ = 16 * wh + 4 * fq + e; pwi[e] = g_[128 + t_]; pem[e] = g_[192 + t_]; pdn[e] = DENP[it_ * 128 + t_] + DENP[it_ * 128 + 64 + t_]; } } while (0)
        MLSTM_FETCH(0);
        for (int c = 0; c < 32; ++c) {
            const size_t t0 = tb + c * 64;
            __syncthreads();
            if (c > 0) *(v4u*)(hout + (t0 - 64 + (tid >> 3)) * 1024 + h * 256 + vs * 64 + (tid & 7) * 8) = *(const LAS v4u*)(Hs + (tid >> 3) * 72 + (tid & 7) * 8);
#pragma unroll
            for (int j = 0; j < 4; ++j)
#pragma unroll
                for (int e = 0; e < 4; ++e) Cb[(16 * wh + 4 * fq + e) * 136 + 64 * wl + 16 * j + fr] = (bf16)f2bf(Cacc[0][j][e]);
#pragma unroll
            for (int e = 0; e < 4; ++e) Cb[(64 + 4 * fq + e) * 136 + 16 * w + fr] = (bf16)f2bf(Cn[0][0][e]);
#pragma unroll
            for (int i = 0; i < 2; ++i) { const int id = tid + NTHR * i, row = id >> 4, c8 = id & 15; *(LAS v4u*)(Qs + row * 136 + c8 * 8) = pQ[i]; *(LAS v4u*)(Ks + row * 136 + c8 * 8) = pK[i]; }
            { const int srow = tid >> 3, c8 = tid & 7; const float wsv = pws;
                *(LAS v4u*)(Vs + srow * 88 + c8 * 8) = pV;
                v4u o; o.x = cvtpk(lo_bf(pV.x) * wsv, hi_bf(pV.x) * wsv); o.y = cvtpk(lo_bf(pV.y) * wsv, hi_bf(pV.y) * wsv); o.z = cvtpk(lo_bf(pV.z) * wsv, hi_bf(pV.z) * wsv); o.w = cvtpk(lo_bf(pV.w) * wsv, hi_bf(pV.w) * wsv);
                *(LAS v4u*)(VWs + srow * 88 + c8 * 8) = o;
                if (c8 < 2) { v4u one; one.x = c8 == 0 ? 0x3f80u : 0u; one.y = 0u; one.z = 0u; one.w = 0u; *(LAS v4u*)(Vs + srow * 88 + 64 + c8 * 8) = one;
                    v4u wv; wv.x = c8 == 0 ? (cvtpk(wsv, 0.f) & 0xffffu) : 0u; wv.y = 0u; wv.z = 0u; wv.w = 0u; *(LAS v4u*)(VWs + srow * 88 + 64 + c8 * 8) = wv; }
                *(LAS v4u*)(Ps + srow * 72 + c8 * 8) = pP; }
            float wi[4], em[4], dn[4]; const float wc = pwc;
#pragma unroll
            for (int e = 0; e < 4; ++e) { wi[e] = pwi[e]; em[e] = pem[e]; dn[e] = pdn[e]; }
            if (c < 31) MLSTM_FETCH(c + 1);
            __syncthreads();
            f32x4 ni[1][2], nx[1][2], nq[1][1]; ni[0][0] = (f32x4){0.f, 0.f, 0.f, 0.f}; ni[0][1] = ni[0][0]; nx[0][0] = ni[0][0]; nx[0][1] = ni[0][0]; nq[0][0] = ni[0][0];
            wgemm<1, 2, 64, 72, 88, false, true>(ni, Ps + 16 * wh * 72, Vs + 32 * wl, lane);
            wgemm<1, 2, 128, 136, 136>(nx, Qs + 16 * wh * 136, Cb + 32 * wl * 136, lane);
            wgemm<1, 1, 128, 136, 136>(nq, Qs + 16 * wh * 136, Cb + 64 * 136, lane);
#pragma unroll
            for (int e = 0; e < 4; ++e) { const int t = 16 * wh + 4 * fq + e;
                const float nqt = __shfl(nq[0][0][e], lane & 48);
                const float den = dn[e] + wi[e] * SCALE * nqt; const float inv = 1.0f / fmaxf(fabsf(den), em[e]); float q2 = 0.f;
#pragma unroll
                for (int j = 0; j < 2; ++j) { const float hv = (ni[0][j][e] + SCALE * wi[e] * nx[0][j][e]) * inv; q2 += hv * hv;
                    Hs[t * 72 + 32 * wl + 16 * j + fr] = (bf16)f2bf(hv); }
                q2 += __shfl_xor(q2, 1); q2 += __shfl_xor(q2, 2); q2 += __shfl_xor(q2, 4); q2 += __shfl_xor(q2, 8);
                if (fr == 0) ssq[(t0 + t) * 32 + (h * 4 + vs) * 2 + wl] = q2; }
#pragma unroll
            for (int j = 0; j < 4; ++j) Cacc[0][j] = Cacc[0][j] * wc;
            Cn[0][0] = Cn[0][0] * wc;
            wgemm<1, 4, 64, 88, 136, true, true>(Cacc, VWs + 16 * wh, Ks + 64 * wl, lane);
            wgemm<1, 1, 64, 88, 136, true, true>(Cn, VWs + 64, Ks + 16 * w, lane);
        }
        __syncthreads();
        *(v4u*)(hout + (tb + 31 * 64 + (tid >> 3)) * 1024 + h * 256 + vs * 64 + (tid & 7) * 8) = *(const LAS v4u*)(Hs + (tid >> 3) * 72 + (tid & 7) * 8);
#undef MLSTM_FETCH
    }
}

__device__ __forceinline__ void moba_prep(Frame& F, bf16* QK, const int* pos, const float* gq, const float* gk, float* kpart) {
    LAS float* part = (LAS float*)F.lds;
    const int lane = F.lane, w = F.wave, c = lane & 15;
    float gqv[8], gkv[8], inv[8];
#pragma unroll
    for (int e = 0; e < 8; ++e) { gqv[e] = gq[c * 8 + e]; gkv[e] = gk[c * 8 + e]; inv[e] = exp2f(-(float)(8 * (c & 1) + e) * (18.931568569324174f / 16.0f)); }
    for (int item = blockIdx.x; item < 256; item += F.G) {
        const int b = item >> 4, blk = (item >> 1) & 7, half = item & 1;
        const size_t row0 = (size_t)b * SEQ + blk * 256 + half * 128 + 16 * w;
        float kacc[2][8];
#pragma unroll
        for (int i = 0; i < 2; ++i)
#pragma unroll
            for (int e = 0; e < 8; ++e) kacc[i][e] = 0.f;
        v4u cur[4], nxt[4];
#pragma unroll
        for (int i4 = 0; i4 < 4; ++i4) cur[i4] = *(const v4u*)(QK + row0 * 2048 + (lane + 64 * i4) * 8);
        for (int t = 0; t < 16; ++t) {
            const size_t row = row0 + t;
            if (t < 15) {
#pragma unroll
                for (int i4 = 0; i4 < 4; ++i4) nxt[i4] = *(const v4u*)(QK + (row + 1) * 2048 + (lane + 64 * i4) * 8); }
            float cs[8], sn[8];
            if (c < 4) { const float ps = (float)pos[row];
#pragma unroll
                for (int e = 0; e < 8; ++e) sincosf(ps * inv[e], &sn[e], &cs[e]); }
            else {
#pragma unroll
                for (int e = 0; e < 8; ++e) { cs[e] = 1.f; sn[e] = 0.f; } }
#pragma unroll
            for (int i4 = 0; i4 < 4; ++i4) {
                const unsigned xw[4] = {cur[i4].x, cur[i4].y, cur[i4].z, cur[i4].w}; float y[8]; float ss = 0.f;
#pragma unroll
                for (int e = 0; e < 4; ++e) { y[2 * e] = lo_bf(xw[e]); y[2 * e + 1] = hi_bf(xw[e]); ss += y[2 * e] * y[2 * e] + y[2 * e + 1] * y[2 * e + 1]; }
                ss += __shfl_xor(ss, 1); ss += __shfl_xor(ss, 2); ss += __shfl_xor(ss, 4); ss += __shfl_xor(ss, 8);
                const float rstd = 1.0f / sqrtf(ss * (1.0f / 128.0f) + 1e-6f);
#pragma unroll
                for (int e = 0; e < 8; ++e) { y[e] = y[e] * rstd * (i4 < 2 ? gqv[e] : gkv[e]); }
#pragma unroll
                for (int e = 0; e < 8; ++e) { const float o = __shfl_xor(y[e], 2); y[e] = (c < 2) ? y[e] * cs[e] - o * sn[e] : (c < 4 ? y[e] * cs[e] + o * sn[e] : y[e]); }
                v4u ov; ov.x = cvtpk(y[0], y[1]); ov.y = cvtpk(y[2], y[3]); ov.z = cvtpk(y[4], y[5]); ov.w = cvtpk(y[6], y[7]);
                *(v4u*)(QK + row * 2048 + (lane + 64 * i4) * 8) = ov;
                if (i4 >= 2) {
#pragma unroll
                    for (int e = 0; e < 8; ++e) kacc[i4 - 2][e] += y[e]; }
            }
#pragma unroll
            for (int i4 = 0; i4 < 4; ++i4) cur[i4] = nxt[i4];
        }
        __syncthreads();
#pragma unroll
        for (int i = 0; i < 2; ++i)
#pragma unroll
            for (int e = 0; e < 8; ++e) part[w * 1024 + i * 512 + lane * 8 + e] = kacc[i][e];
        __syncthreads();
        for (int col = F.tid; col < 1024; col += NTHR) { float sacc = 0.f;
#pragma unroll
            for (int ww = 0; ww < 8; ++ww) sacc += part[ww * 1024 + col];
            kpart[((size_t)(b * 8 + blk) * 2 + half) * 1024 + col] = sacc * (1.0f / 256.0f); }
    }
}
__device__ __forceinline__ void moba_attn(Frame& F, const bf16* QK, const bf16* Vt, const float* kpart, bf16* O) {
    constexpr float SCALE = 0.08838834764831845f;
    constexpr int KVB = 64 * 136 + 128 * 72;
    LAS bf16* R = (LAS bf16*)F.lds;
    LAS bf16* Qs = R;
    LAS float* kmS = (LAS float*)(R + 2 * KVB);
    LAS float* gsc = kmS + 1024;
    LAS unsigned* selm = (LAS unsigned*)(gsc + 2048);
    const int tid = F.tid, lane = F.lane, w = F.wave, fr = lane & 15, fq = lane >> 4;
    for (int it = blockIdx.x; it < 1024; it += F.G) {
        const int c = it & 255, r = it >> 8, bh = c & 127, typ = c >> 7, b = bh >> 3, h = bh & 7;
        const int jb = (r & 1) ? 7 - (r >> 1) : (r >> 1);
        const int j = typ ? ((r & 1) ? jb - 2 : jb + 2) : jb;
        const size_t qrow0 = (size_t)b * SEQ + j * 256;
        __syncthreads();
#pragma unroll
        for (int i = 0; i < 8; ++i) { const int id = tid + NTHR * i, row = id >> 4, c8 = id & 15;
            *(LAS v4u*)(Qs + row * 136 + c8 * 8) = *(const v4u*)(QK + (qrow0 + row) * 2048 + h * 128 + c8 * 8); }
        for (int i = tid; i < 1024; i += NTHR) { const int kb_ = i >> 7, d_ = i & 127; const float* kp = kpart + ((size_t)(b * 8 + kb_) * 2) * 1024 + h * 128 + d_; kmS[i] = kp[0] + kp[1024]; }
        __syncthreads();
        if (j > 3) { const int q = tid >> 1, p = tid & 1;
            for (int e = 0; e < 4; ++e) { const int blk = 4 * p + e; float sdot = 0.f;
                if (blk < j) { for (int d = 0; d < 128; ++d) sdot += bf2f(Qs[q * 136 + d]) * kmS[blk * 128 + d]; }
                gsc[q * 8 + blk] = sdot; } }
        __syncthreads();
        if (tid < 256) { unsigned mask = 0u;
            if (j <= 3) mask = (1u << j) - 1u;
            else { for (int k = 0; k < 3; ++k) { float best = -INFINITY; int bi = 0;
                    for (int blk = 0; blk < j; ++blk) { const float gv = gsc[tid * 8 + blk]; if (!((mask >> blk) & 1u) && gv > best) { best = gv; bi = blk; } }
                    mask |= 1u << bi; } }
            selm[tid] = mask; }
        bf16x8 qf[2][4];
#pragma unroll
        for (int i = 0; i < 2; ++i)
#pragma unroll
            for (int ks = 0; ks < 4; ++ks) qf[i][ks] = *(const LAS bf16x8*)(Qs + (32 * w + 16 * i + fr) * 136 + 32 * ks + 8 * fq);
        __syncthreads();
        const unsigned masks = selm[32 * w + fr] | (selm[32 * w + 16 + fr] << 8);
        f32x4 oacc[2][8];
#pragma unroll
        for (int i = 0; i < 2; ++i)
#pragma unroll
            for (int vt = 0; vt < 8; ++vt) oacc[i][vt] = (f32x4){0.f, 0.f, 0.f, 0.f};
        float mrun[2] = {-INFINITY, -INFINITY}, lrun[2] = {0.f, 0.f};
        const int ntile = 4 * j + 4;
        const bf16* kbase = QK + ((size_t)b * SEQ) * 2048 + 1024 + h * 128;
        const bf16* vbase = Vt + ((size_t)h * 128) * MTOK + (size_t)b * SEQ;
        v4u pk[2], pv[2];
#define KOFF(id) ((unsigned)((((id) >> 4) * 2048 + ((id) & 15) * 8) * 2))
#define VOFF(id) ((unsigned)((((id) >> 3) * MTOK + ((id) & 7) * 8) * 2))
#pragma unroll
        for (int i = 0; i < 2; ++i) { const int id = tid + NTHR * i; pk[i] = *(const v4u*)((const char*)kbase + KOFF(id)); pv[i] = *(const v4u*)((const char*)vbase + VOFF(id)); }
#pragma unroll
        for (int i = 0; i < 2; ++i) { const int id = tid + NTHR * i; *(LAS v4u*)(R + (id >> 4) * 136 + (id & 15) * 8) = pk[i]; *(LAS v4u*)(R + 64 * 136 + (id >> 3) * 72 + (id & 7) * 8) = pv[i]; }
        __syncthreads();
        for (int tile = 0; tile < ntile; ++tile) {
            const int kb = tile >> 2, key0 = tile * 64;
            LAS bf16* Ks = R + (tile & 1) * KVB; LAS bf16* VTs = Ks + 64 * 136;
            int tl = tid; asm volatile("" : "+v"(tl));
            if (tile + 1 < ntile) {
#pragma unroll
                for (int i = 0; i < 2; ++i) { const int id = tl + NTHR * i; pk[i] = *(const v4u*)((const char*)(kbase + (size_t)(key0 + 64) * 2048) + KOFF(id)); pv[i] = *(const v4u*)((const char*)(vbase + key0 + 64) + VOFF(id)); } }
            const bool own = (kb == j);
            const bool sel0 = own || ((masks >> kb) & 1u), sel1 = own || ((masks >> (8 + kb)) & 1u);
            const bool active = own ? (key0 - j * 256 <= 32 * w + 31) : (__ballot(sel0 || sel1) != 0ull);
            if (active) {
                f32x4 st[2][4];
#pragma unroll
                for (int kt = 0; kt < 4; ++kt) { st[0][kt] = (f32x4){0.f, 0.f, 0.f, 0.f}; st[1][kt] = st[0][kt];
#pragma unroll
                    for (int ks = 0; ks < 4; ++ks) { const bf16x8 kf = *(const LAS bf16x8*)(Ks + (16 * kt + fr) * 136 + 32 * ks + 8 * fq);
                        st[0][kt] = __builtin_amdgcn_mfma_f32_16x16x32_bf16(kf, qf[0][ks], st[0][kt], 0, 0, 0);
                        st[1][kt] = __builtin_amdgcn_mfma_f32_16x16x32_bf16(kf, qf[1][ks], st[1][kt], 0, 0, 0); } }
#if !defined(ATT_NOSB)
                __builtin_amdgcn_sched_barrier(0);
#endif
                bf16x8 pf[2][2]; float alpha[2];
                constexpr float C2 = SCALE * 1.4426950408889634f;
#pragma unroll
                for (int i = 0; i < 2; ++i) {
                    const bool lsel = i ? sel1 : sel0;
                    float mloc = -INFINITY;
                    if (own) { const int qpos = j * 256 + 32 * w + 16 * i + fr;
#pragma unroll
                        for (int kt = 0; kt < 4; ++kt)
#pragma unroll
                            for (int e = 0; e < 4; ++e) { const int kpos = key0 + 16 * kt + 4 * fq + e; const float sv = (kpos <= qpos) ? st[i][kt][e] : -INFINITY; st[i][kt][e] = sv; mloc = fmaxf(mloc, sv); } }
                    else {
#pragma unroll
                        for (int kt = 0; kt < 4; ++kt)
#pragma unroll
                            for (int e = 0; e < 4; ++e) mloc = fmaxf(mloc, st[i][kt][e]); }
                    mloc = fmaxf(mloc, __shfl_xor(mloc, 16)); mloc = fmaxf(mloc, __shfl_xor(mloc, 32));
                    const float mnew = lsel ? fmaxf(mrun[i], mloc * C2) : mrun[i], msafe = (mnew == -INFINITY) ? 0.f : mnew;
                    alpha[i] = __builtin_amdgcn_exp2f(mrun[i] - msafe);
                    const float moff = lsel ? msafe : INFINITY;
                    float psum = 0.f;
#pragma unroll
                    for (int kk = 0; kk < 2; ++kk) { float pp[8];
#pragma unroll
                        for (int e = 0; e < 4; ++e) { pp[e] = __builtin_amdgcn_exp2f(__builtin_fmaf(st[i][2 * kk][e], C2, -moff)); pp[4 + e] = __builtin_amdgcn_exp2f(__builtin_fmaf(st[i][2 * kk + 1][e], C2, -moff)); }
#pragma unroll
                        for (int e = 0; e < 8; ++e) psum += pp[e];
                        u32x4 pw; pw.x = cvtpk(pp[0], pp[1]); pw.y = cvtpk(pp[2], pp[3]); pw.z = cvtpk(pp[4], pp[5]); pw.w = cvtpk(pp[6], pp[7]);
                        pf[i][kk] = __builtin_bit_cast(bf16x8, pw); }
                    lrun[i] = lrun[i] * alpha[i] + psum; mrun[i] = mnew;
                }
                const bool rescale = __ballot(alpha[0] != 1.0f || alpha[1] != 1.0f) != 0ull;
#if !defined(ATT_NOSB)
                __builtin_amdgcn_sched_barrier(0);
#endif
#pragma unroll
                for (int vt = 0; vt < 8; ++vt) { if (rescale) { oacc[0][vt] = oacc[0][vt] * alpha[0]; oacc[1][vt] = oacc[1][vt] * alpha[1]; }
#pragma unroll
                    for (int kk = 0; kk < 2; ++kk) { const LAS bf16* vp = VTs + (16 * vt + fr) * 72 + 32 * kk + 4 * fq;
                        const u32x2 v0 = *(const LAS u32x2*)vp, v1 = *(const LAS u32x2*)(vp + 16);
                        u32x4 vw; vw.x = v0.x; vw.y = v0.y; vw.z = v1.x; vw.w = v1.y; const bf16x8 vf = __builtin_bit_cast(bf16x8, vw);
                        oacc[0][vt] = __builtin_amdgcn_mfma_f32_16x16x32_bf16(vf, pf[0][kk], oacc[0][vt], 0, 0, 0);
                        oacc[1][vt] = __builtin_amdgcn_mfma_f32_16x16x32_bf16(vf, pf[1][kk], oacc[1][vt], 0, 0, 0); } }
            }
            if (tile + 1 < ntile) { LAS bf16* Kn = R + ((tile + 1) & 1) * KVB;
#pragma unroll
                for (int i = 0; i < 2; ++i) { const int id = tl + NTHR * i; *(LAS v4u*)(Kn + (id >> 4) * 136 + (id & 15) * 8) = pk[i]; *(LAS v4u*)(Kn + 64 * 136 + (id >> 3) * 72 + (id & 7) * 8) = pv[i]; } }
            __syncthreads();
        }
#undef KOFF
#undef VOFF
#pragma unroll
        for (int i = 0; i < 2; ++i) { float l = lrun[i]; l += __shfl_xor(l, 16); l += __shfl_xor(l, 32); const float il = 1.0f / l;
            bf16* orow = O + (qrow0 + 32 * w + 16 * i + fr) * 1024 + h * 128;
#pragma unroll
            for (int vt = 0; vt < 8; ++vt) { u32x2 o; o.x = cvtpk(oacc[i][vt][0] * il, oacc[i][vt][1] * il); o.y = cvtpk(oacc[i][vt][2] * il, oacc[i][vt][3] * il);
                *(u32x2*)(orow + 16 * vt + 4 * fq) = o; } }
    }
}

__device__ __forceinline__ void ret_rot_table(Frame& F, const int* pos, float* cst) {
    const int gw = blockIdx.x * NWAVES + F.wave, NGW = F.G * NWAVES, lane = F.lane;
    const float i0 = exp2f(-(float)(2 * lane) * (13.287712379549449f / 128.0f)), i1 = exp2f(-(float)(2 * lane + 1) * (13.287712379549449f / 128.0f));
    for (int m = gw; m < MTOK; m += NGW) {
        const float ps = (float)pos[m]; float s0, c0, s1, c1; sincosf(ps * i0, &s0, &c0); sincosf(ps * i1, &s1, &c1);
        f32x2* cp = (f32x2*)(cst + (size_t)m * 256) + lane; cp[0] = (f32x2){c0, c1}; cp[64] = (f32x2){s0, s1};
    }
}
__device__ __forceinline__ void ret_pmat(Frame& F, const bf16* QKV, bf16* PM) {
    LAS bf16* Qd = (LAS bf16*)F.lds;
    LAS bf16* Kd = Qd + 128 * 72;
    LAS bf16* Ps = Kd + 128 * 72;
    const int tid = F.tid, lane = F.lane, w = F.wave, fr = lane & 15, fq = lane >> 4, wh = w >> 1, wl = w & 1;
    const unsigned off0 = (unsigned)((((tid >> 3) * 4096) + (tid & 7) * 8) * 2);
    for (int item = blockIdx.x; item < 1024; item += F.G) {
        const int b = item >> 6, h = (item >> 4) & 3, c = item & 15;
        const float lgc = log1pf(-exp2f(-5.0f - (float)h)) * 1.4426950408889634f;
        const char* gq = (const char*)(QKV + ((size_t)b * SEQ + c * 128) * 4096 + h * 256);
        v4u pq[2], pkk[2];
#pragma unroll
        for (int i = 0; i < 2; ++i) { const char* src = gq + off0 + i * (64 * 4096 * 2); pq[i] = *(const v4u*)src; pkk[i] = *(const v4u*)(src + 2048); }
        f32x4 S[2][4];
#pragma unroll
        for (int i = 0; i < 2; ++i)
#pragma unroll
            for (int jj = 0; jj < 4; ++jj) S[i][jj] = (f32x4){0.f, 0.f, 0.f, 0.f};
#pragma unroll 1
        for (int dt = 0; dt < 4; ++dt) {
            __syncthreads();
#pragma unroll
            for (int i = 0; i < 2; ++i) { const int id = tid + NTHR * i, row = id >> 3, c8 = id & 7; *(LAS v4u*)(Qd + row * 72 + c8 * 8) = pq[i]; *(LAS v4u*)(Kd + row * 72 + c8 * 8) = pkk[i]; }
            if (dt < 3) {
#pragma unroll
                for (int i = 0; i < 2; ++i) { const char* src = gq + (dt + 1) * 128 + off0 + i * (64 * 4096 * 2); pq[i] = *(const v4u*)src; pkk[i] = *(const v4u*)(src + 2048); } }
            __syncthreads();
            wgemm<2, 4, 64, 72, 72>(S, Qd + 32 * wh * 72, Kd + 64 * wl * 72, lane);
        }
#pragma unroll
        for (int i = 0; i < 2; ++i)
#pragma unroll
            for (int e = 0; e < 4; ++e) { const int t = 32 * wh + 16 * i + 4 * fq + e;
#pragma unroll
                for (int jj = 0; jj < 4; ++jj) { const int sidx = 64 * wl + 16 * jj + fr; const float wgt = (t >= sidx) ? __builtin_amdgcn_exp2f((float)(t - sidx) * lgc) : 0.f;
                    Ps[t * 136 + sidx] = (bf16)f2bf(S[i][jj][e] * wgt); } }
        __syncthreads();
        bf16* dst = PM + (size_t)item * 128 * 128;
#pragma unroll
        for (int i = 0; i < 4; ++i) { const int id = tid + NTHR * i, row = id >> 4, c8 = id & 15; *(v4u*)(dst + row * 128 + c8 * 8) = *(const LAS v4u*)(Ps + row * 136 + c8 * 8); }
    }
}
#ifndef RET_EXP
#define RET_EXP 0
#endif
__device__ __forceinline__ void ret_core(Frame& F, bf16* QKV, const bf16* PM, float* st) {
    constexpr int TSET = 3 * 128 * 72;
    LAS bf16* T0 = (LAS bf16*)F.lds;
    LAS bf16* Vs = T0 + 2 * TSET;
    LAS bf16* Ps = T0;
    LAS bf16* Xs = T0 + TSET;
    LAS float* fST = (LAS float*)(Vs + 128 * 136);
    const int tid = F.tid, lane = F.lane, w = F.wave, fr = lane & 15, fq = lane >> 4, wh = w >> 1, wl = w & 1;
    const unsigned off8 = (unsigned)((((tid >> 3) * 4096) + (tid & 7) * 8) * 2);
    const unsigned off16 = (unsigned)((((tid >> 4) * 4096) + (tid & 15) * 8) * 2);
    for (int item = blockIdx.x; item < 256; item += F.G) {
        const int b = item >> 4, h = (item >> 2) & 3, vs = item & 3;
        const float lg = log1pf(-exp2f(-5.0f - (float)h)), gch = expf(128.0f * lg);
        f32x4 Racc[4][1][4];
#pragma unroll
        for (int dt = 0; dt < 4; ++dt)
#pragma unroll
            for (int jj = 0; jj < 4; ++jj) Racc[dt][0][jj] = (f32x4){0.f, 0.f, 0.f, 0.f};
        const size_t tb = (size_t)b * SEQ;
        __syncthreads();
        v4u pq[2], pkk[2], pv[4];
        { const char* gq0 = (const char*)(QKV + tb * 4096 + h * 256); const char* gv0 = (const char*)(QKV + tb * 4096 + 2048 + h * 512 + vs * 128);
#pragma unroll
            for (int i = 0; i < 2; ++i) { const char* src = gq0 + off8 + i * (64 * 4096 * 2); pq[i] = *(const v4u*)src; pkk[i] = *(const v4u*)(src + 2048); }
#pragma unroll
            for (int i = 0; i < 4; ++i) pv[i] = *(const v4u*)(gv0 + off16 + i * (32 * 4096 * 2)); }
        for (int c = 0; c < 16; ++c) {
            const size_t t0 = tb + c * 128;
            const char* gq = (const char*)(QKV + t0 * 4096 + h * 256);
            char* gy = (char*)(QKV + t0 * 4096 + 2048 + h * 512 + vs * 128);
            const bf16* pmt = PM + ((size_t)((b * 4 + h) * 16 + c)) * 128 * 128;
            float lgc = lg * 1.4426950408889634f; asm volatile("" : "+v"(lgc));
#pragma unroll
            for (int i = 0; i < 4; ++i) { const int id = tid + NTHR * i; *(LAS v4u*)(Vs + (id >> 4) * 136 + (id & 15) * 8) = pv[i]; }
            f32x4 X[2][4];
#pragma unroll
            for (int i = 0; i < 2; ++i)
#pragma unroll
                for (int jj = 0; jj < 4; ++jj) X[i][jj] = (f32x4){0.f, 0.f, 0.f, 0.f};
#pragma unroll 1
            for (int dt = 0; dt < 4; ++dt) {
                LAS bf16* Qd = T0 + (dt & 1) * TSET; LAS bf16* Kz = Qd + 128 * 72; LAS bf16* Rb = Kz + 128 * 72;
#pragma unroll
                for (int i = 0; i < 2; ++i) { const int id = tid + NTHR * i, row = id >> 3, c8 = id & 7; const float z = __builtin_amdgcn_exp2f((float)(127 - row) * lgc);
                    *(LAS v4u*)(Qd + row * 72 + c8 * 8) = pq[i];
                    v4u zo; zo.x = cvtpk(lo_bf(pkk[i].x) * z, hi_bf(pkk[i].x) * z); zo.y = cvtpk(lo_bf(pkk[i].y) * z, hi_bf(pkk[i].y) * z); zo.z = cvtpk(lo_bf(pkk[i].z) * z, hi_bf(pkk[i].z) * z); zo.w = cvtpk(lo_bf(pkk[i].w) * z, hi_bf(pkk[i].w) * z);
                    *(LAS v4u*)(Kz + row * 72 + c8 * 8) = zo; }
#pragma unroll
                for (int jj = 0; jj < 4; ++jj)
#pragma unroll
                    for (int e = 0; e < 4; ++e) Rb[(16 * w + 4 * fq + e) * 72 + 16 * jj + fr] = (bf16)f2bf(Racc[0][0][jj][e]);
#if RET_EXP == 3
                asm volatile("" ::: "memory");
#pragma unroll
                for (int jj = 0; jj < 4; ++jj)
#pragma unroll
                    for (int e = 0; e < 4; ++e) *(volatile LAS bf16*)(Rb + (16 * w + 4 * fq + e) * 72 + 16 * jj + fr) = (bf16)f2bf(Racc[0][0][jj][e]);
#endif
                if (dt < 3 || c < 15) {
                    const char* nb = (dt < 3) ? gq + (dt + 1) * 128 : gq + (size_t)128 * 4096 * 2;
#pragma unroll
                    for (int i = 0; i < 2; ++i) { const char* src = nb + off8 + i * (64 * 4096 * 2); pq[i] = *(const v4u*)src; pkk[i] = *(const v4u*)(src + 2048); } }
                __syncthreads();
                wgemm<2, 4, 64, 72, 72, false, false, false>(X, Qd + 32 * wh * 72, Rb + 64 * wl * 72, lane);
#if RET_EXP == 5
                { f32x4 D_[2][4];
#pragma unroll
                  for (int i = 0; i < 2; ++i)
#pragma unroll
                    for (int jj = 0; jj < 4; ++jj) D_[i][jj] = (f32x4){0.f, 0.f, 0.f, 0.f};
                  wgemm<2, 4, 64, 72, 72>(D_, Qd + 32 * wh * 72, Rb + 64 * wl * 72, lane);
#pragma unroll
                  for (int i = 0; i < 2; ++i)
#pragma unroll
                    for (int jj = 0; jj < 4; ++jj) asm volatile("" :: "v"(D_[i][jj])); }
#endif
#if RET_EXP == 6
                { f32x4 D_[1][4];
#pragma unroll
                    for (int jj = 0; jj < 4; ++jj) D_[0][jj] = (f32x4){0.f, 0.f, 0.f, 0.f};
                  wgemm<1, 4, 128, 136, 72, true, true>(D_, Vs + 16 * w, Kz, lane);
#pragma unroll
                    for (int jj = 0; jj < 4; ++jj) asm volatile("" :: "v"(D_[0][jj])); }
#endif
#pragma unroll
                for (int jj = 0; jj < 4; ++jj) Racc[0][0][jj] = Racc[0][0][jj] * gch;
                wgemm<1, 4, 128, 136, 72, true, true, false>(Racc[0], Vs + 16 * w, Kz, lane);
#pragma unroll
                for (int jj = 0; jj < 4; ++jj) { const f32x4 t_ = Racc[0][0][jj]; Racc[0][0][jj] = Racc[1][0][jj]; Racc[1][0][jj] = Racc[2][0][jj]; Racc[2][0][jj] = Racc[3][0][jj]; Racc[3][0][jj] = t_; }
            }
            v4u pp[4];
#pragma unroll
            for (int i = 0; i < 4; ++i) { const int id = tid + NTHR * i; pp[i] = *(const v4u*)(pmt + (id >> 4) * 128 + (id & 15) * 8); }
#if RET_EXP == 2
            asm volatile("s_waitcnt vmcnt(0)" ::: "memory");
#pragma unroll
            for (int i = 0; i < 4; ++i) { const int id = tid + NTHR * i; v4u q_ = *(const volatile v4u*)(pmt + 64 * 128 * 128 + (id >> 4) * 128 + (id & 15) * 8); asm volatile("" :: "v"(q_.x), "v"(q_.y), "v"(q_.z), "v"(q_.w)); }
            asm volatile("s_waitcnt vmcnt(0)" ::: "memory");
#endif
#pragma unroll
            for (int i = 0; i < 2; ++i)
#pragma unroll
                for (int e = 0; e < 4; ++e) { const int t = 32 * wh + 16 * i + 4 * fq + e; const float xi = __builtin_amdgcn_exp2f((float)(t + 1) * lgc);
#pragma unroll
                    for (int jj = 0; jj < 4; ++jj) X[i][jj][e] *= xi; }
#pragma unroll
            for (int i = 0; i < 4; ++i) { const int id = tid + NTHR * i; *(LAS v4u*)(Ps + (id >> 4) * 136 + (id & 15) * 8) = pp[i]; }
            __syncthreads();
            wgemm<2, 4, 128, 136, 136, false, true, false>(X, Ps + 32 * wh * 136, Vs + 64 * wl, lane);
#pragma unroll
            for (int i = 0; i < 2; ++i)
#pragma unroll
                for (int e = 0; e < 4; ++e) { const int t = 32 * wh + 16 * i + 4 * fq + e; float s1 = 0.f, s2 = 0.f;
#pragma unroll
                    for (int jj = 0; jj < 4; ++jj) { const float y = X[i][jj][e]; s1 += y; s2 += y * y; Xs[t * 136 + 64 * wl + 16 * jj + fr] = (bf16)f2bf(y); }
                    s1 += __shfl_xor(s1, 1); s1 += __shfl_xor(s1, 2); s1 += __shfl_xor(s1, 4); s1 += __shfl_xor(s1, 8);
                    s2 += __shfl_xor(s2, 1); s2 += __shfl_xor(s2, 2); s2 += __shfl_xor(s2, 4); s2 += __shfl_xor(s2, 8);
                    if (fr == 0) { fST[(wl * 128 + t) * 2] = s1; fST[(wl * 128 + t) * 2 + 1] = s2; } }
            if (c < 15) { const char* gvn = gy + (size_t)128 * 4096 * 2;
#pragma unroll
                for (int i = 0; i < 4; ++i) pv[i] = *(const v4u*)(gvn + off16 + i * (32 * 4096 * 2)); }
            __syncthreads();
#pragma unroll
            for (int i = 0; i < 4; ++i) { const int id = tid + NTHR * i, row = id >> 4, c8 = id & 15; *(v4u*)(gy + (unsigned)((row * 4096 + c8 * 8) * 2)) = *(const LAS v4u*)(Xs + row * 136 + c8 * 8); }
            if (tid < 128) { float* sp = st + (t0 + tid) * 32 + (h * 4 + vs) * 2; sp[0] = fST[tid * 2] + fST[(128 + tid) * 2]; sp[1] = fST[tid * 2 + 1] + fST[(128 + tid) * 2 + 1]; }
        }
    }
}

__device__ __forceinline__ void lru_conv(Frame& F, const bf16* GX, const float* cw, const float* cb, bf16* XC, const float* lru, float* sptab) {
    if (blockIdx.x == 0) for (int i = F.tid; i < 1024; i += NTHR) { const float l = -lru[i]; sptab[i] = fmaxf(l, 0.f) + log1pf(expf(-fabsf(l))); }
    const size_t total = (size_t)MTOK * 128, stride = (size_t)F.G * NTHR;
    for (size_t id = (size_t)blockIdx.x * NTHR + F.tid; id < total; id += stride) {
        const int row = (int)(id >> 7), c8 = (int)(id & 127), t = row & (SEQ - 1);
        float acc[8];
#pragma unroll
        for (int e = 0; e < 8; ++e) acc[e] = cb[c8 * 8 + e];
#pragma unroll
        for (int wv = 0; wv < 4; ++wv) { if (t - 3 + wv < 0) continue;
            const v4u x = *(const v4u*)(GX + (size_t)(row - 3 + wv) * 2048 + 1024 + c8 * 8); const unsigned xw[4] = {x.x, x.y, x.z, x.w};
            const f32x4 w0 = *(const f32x4*)(cw + wv * 1024 + c8 * 8), w1 = *(const f32x4*)(cw + wv * 1024 + c8 * 8 + 4);
            acc[0] += lo_bf(xw[0]) * w0.x; acc[1] += hi_bf(xw[0]) * w0.y; acc[2] += lo_bf(xw[1]) * w0.z; acc[3] += hi_bf(xw[1]) * w0.w;
            acc[4] += lo_bf(xw[2]) * w1.x; acc[5] += hi_bf(xw[2]) * w1.y; acc[6] += lo_bf(xw[3]) * w1.z; acc[7] += hi_bf(xw[3]) * w1.w; }
        v4u o; o.x = cvtpk(acc[0], acc[1]); o.y = cvtpk(acc[2], acc[3]); o.z = cvtpk(acc[4], acc[5]); o.w = cvtpk(acc[6], acc[7]);
        *(v4u*)(XC + (size_t)row * 1024 + c8 * 8) = o;
    }
}
__device__ __forceinline__ float gelu_tanh(float x) { const float z = 0.7978845608028654f * (x + 0.044715f * x * x * x); const float e = __expf(2.0f * z); const float th = 1.0f - 2.0f * __builtin_amdgcn_rcpf(e + 1.0f); return 0.5f * x * (1.0f + th); }
__device__ __forceinline__ void lru_scan(Frame& F, const bf16* LA, const bf16* BT, const bf16* GX, bf16* Y) {
    LAS float* segL = (LAS float*)F.lds;
    LAS float* segH = segL + 512;
    const int lane = F.lane, w = F.wave;
    for (int item = blockIdx.x; item < 256; item += F.G) {
        const int b = item >> 4, ch = (item & 15) * 64 + lane;
        const size_t r0 = (size_t)b * SEQ + w * 256;
        const bf16* la_p = LA + r0 * 1024 + ch; const bf16* bt_p = BT + r0 * 1024 + ch; const bf16* gx_p = GX + r0 * 2048 + ch; bf16* y_p = Y + r0 * 1024 + ch;
        float L = 0.f, H = 0.f;
        bf16 la0[16], bt0[16], la1[16], bt1[16];
#pragma unroll
        for (int k = 0; k < 16; ++k) { la0[k] = la_p[(size_t)k * 1024]; bt0[k] = bt_p[(size_t)k * 1024]; }
#pragma unroll 1
        for (int tb = 0; tb < 16; tb += 2) {
#pragma unroll
            for (int k = 0; k < 16; ++k) { la1[k] = la_p[(size_t)((tb + 1) * 16 + k) * 1024]; bt1[k] = bt_p[(size_t)((tb + 1) * 16 + k) * 1024]; }
#pragma unroll
            for (int k = 0; k < 16; ++k) { const float la = bf2f(la0[k]); L += la; H = __expf(la) * H + bf2f(bt0[k]); }
            if (tb + 2 < 16) {
#pragma unroll
                for (int k = 0; k < 16; ++k) { la0[k] = la_p[(size_t)((tb + 2) * 16 + k) * 1024]; bt0[k] = bt_p[(size_t)((tb + 2) * 16 + k) * 1024]; } }
#pragma unroll
            for (int k = 0; k < 16; ++k) { const float la = bf2f(la1[k]); L += la; H = __expf(la) * H + bf2f(bt1[k]); }
        }
        __syncthreads();
        segL[w * 64 + lane] = L; segH[w * 64 + lane] = H;
        __syncthreads();
        float hc = 0.f;
        for (int sg = 0; sg < w; ++sg) hc = __expf(segL[sg * 64 + lane]) * hc + segH[sg * 64 + lane];
        bf16 g0[16], g1[16];
#pragma unroll
        for (int k = 0; k < 16; ++k) { la0[k] = la_p[(size_t)k * 1024]; bt0[k] = bt_p[(size_t)k * 1024]; g0[k] = gx_p[(size_t)k * 2048]; }
#pragma unroll 1
        for (int tb = 0; tb < 16; tb += 2) {
#pragma unroll
            for (int k = 0; k < 16; ++k) { const size_t t = (size_t)((tb + 1) * 16 + k); la1[k] = la_p[t * 1024]; bt1[k] = bt_p[t * 1024]; g1[k] = gx_p[t * 2048]; }
#pragma unroll
            for (int k = 0; k < 16; ++k) { hc = __expf(bf2f(la0[k])) * hc + bf2f(bt0[k]); y_p[(size_t)(tb * 16 + k) * 1024] = (bf16)f2bf(hc * gelu_tanh(bf2f(g0[k]))); }
            if (tb + 2 < 16) {
#pragma unroll
                for (int k = 0; k < 16; ++k) { const size_t t = (size_t)((tb + 2) * 16 + k); la0[k] = la_p[t * 1024]; bt0[k] = bt_p[t * 1024]; g0[k] = gx_p[t * 2048]; } }
#pragma unroll
            for (int k = 0; k < 16; ++k) { hc = __expf(bf2f(la1[k])) * hc + bf2f(bt1[k]); y_p[(size_t)((tb + 1) * 16 + k) * 1024] = (bf16)f2bf(hc * gelu_tanh(bf2f(g1[k]))); }
        }
    }
}

template <class Epi>
__device__ __forceinline__ void run_gemm(Frame& F, const bf16* A, int lda, const bf16* Bt, int ldb, int N, int K, const Epi& E, int M = MTOK) {
    pg8::Gemm g{A, Bt, M, N, K, lda, ldb}; pg8::StaticOrder S; S.init(M, N, F.G, (int)blockIdx.x);
#ifndef STAGGER_NG
#define STAGGER_NG 1
#endif
#ifndef STAGGER_STEP
#define STAGGER_STEP 300
#endif
    if (STAGGER_NG > 1 && N >= 4096 && M == MTOK) {
        const unsigned grp = (((unsigned)blockIdx.x >> 3) & 7u) / (8 / STAGGER_NG);
        if (grp) { const unsigned long long t0 = __builtin_amdgcn_s_memrealtime(), dl = (unsigned long long)grp * STAGGER_STEP;
            while (__builtin_amdgcn_s_memrealtime() - t0 < dl) __builtin_amdgcn_s_sleep(8); }
    }
#ifndef FUSE_NX
#define FUSE_NX false
#endif
#ifndef GEMM_ALIGN
#define GEMM_ALIGN true
#endif
#ifndef GEMM_SP2
#define GEMM_SP2 true
#endif
    pg8::gemm_phase<Epi, pg8::StaticOrder, GEMM_ALIGN, GEMM_SP2>(F.lds, g, S, E);
}

typedef const __attribute__((address_space(4))) struct Args* ArgsP;
constexpr int NPHASE = 35;
__device__ __forceinline__ ArgsP get_args() { ArgsP p = (ArgsP)__builtin_amdgcn_kernarg_segment_ptr(); asm volatile("" : "+s"(p)); return p; }
__device__ __forceinline__ bool in_phase(int k) { ArgsP a = get_args(); return a->ph_lo <= k && k < a->ph_hi; }
#ifndef DUP_PHASE
#define DUP_PHASE -1
#endif
#ifndef BAR_EXP
#define BAR_EXP 0
#endif
#ifndef TIMING_MASK
#define TIMING_MASK 0ull
#endif
#define TMISC ((volatile LAS unsigned long long*)((LAS unsigned char*)lds_raw + MISC_OFF))
#define TB(k) do { if (((TIMING_MASK >> (k)) & 1ull) && blockIdx.x == 0 && threadIdx.x == 0) TMISC[0] = __builtin_amdgcn_s_memrealtime(); } while (0)
#define TE(k) do { if (((TIMING_MASK >> (k)) & 1ull) && blockIdx.x == 0 && threadIdx.x == 0) TMISC[1] = TMISC[1] + (__builtin_amdgcn_s_memrealtime() - TMISC[0]); } while (0)
#define REP(k) TB(k); for (int rep_ = 0; rep_ < ((k) == DUP_PHASE ? 2 : 1); ++rep_)
#define AP ArgsP ap = get_args(); { int t_ = threadIdx.x; asm volatile("" : "+v"(t_)); F.tid = t_; F.lane = t_ & 63; F.wave = __builtin_amdgcn_readfirstlane(t_ >> 6); F.G = gridDim.x; F.lds = (LAS unsigned char*)lds_raw; }
__global__ void __launch_bounds__(NTHR, 2) trunk_fwd(Args args) {
    extern __shared__ __attribute__((aligned(16))) unsigned char lds_raw[];
    Frame F; F.lds = (LAS unsigned char*)lds_raw; F.tid = threadIdx.x; F.lane = F.tid & 63; F.wave = __builtin_amdgcn_readfirstlane(F.tid >> 6); F.G = gridDim.x;
    volatile LAS unsigned* MISC = (volatile LAS unsigned*)(F.lds + MISC_OFF);
    if (F.tid < 16) MISC[F.tid] = 0u;
    __syncthreads();
    if (args.ph_hi - args.ph_lo > 1) (void)xcd_barrier_post((unsigned*)(args.ws + WS_CTL) + CW_BAR, MISC + 8);
#ifndef ONLY_PHASE
#define ONLY_PHASE -1
#endif
#define IN(k) ((ONLY_PHASE < 0 || (k) == ONLY_PHASE) && in_phase(k))
#define SEAM(k) do { if (IN(k) && IN((k) + 1)) { XcdBarrier bb; bb.bar = (unsigned*)(get_args()->ws + WS_CTL) + CW_BAR; bb.x = xb_xcc_id(); bb.st = (volatile LAS unsigned*)((LAS unsigned char*)lds_raw + MISC_OFF) + 8; xcd_barrier(bb); if (BAR_EXP) xcd_barrier(bb); } if (IN(k)) TE(k); } while (0)
#define XIN ((const float*)ap->in[0])
#define pos ((const int*)ap->in[1])
#define norm_mix ((const float*)ap->in[2])
#define norm_ffn ((const float*)ap->in[3])
#define ffn_w_in ((const float*)ap->in[4])
#define ffn_w_out ((const float*)ap->in[5])
#define out (ap->out)
#define Wmi ((bf16*)(ap->ws + WS_W_MIXIN))
#define Wmo ((bf16*)(ap->ws + WS_W_MIXOUT))
#define Wfi ((bf16*)(ap->ws + WS_W_FFNIN))
#define Wfo ((bf16*)(ap->ws + WS_W_FFNOUT))
#define U ((bf16*)(ap->ws + WS_U))
#define BIG ((bf16*)(ap->ws + WS_BIG))
#define gatesA ((float*)(ap->ws + WS_GATESA))
#define ssqA ((float*)(ap->ws + WS_SSQA))
#define statC ((float*)(ap->ws + WS_STATC))
#define kmean ((float*)(ap->ws + WS_KMEAN))
#define sptab ((float*)(ap->ws + WS_SPTAB))
#define ssqH ((float*)(ap->ws + WS_SSQH))

#define a_w_in ((const float*)ap->in[6])
#define a_b ((const float*)ap->in[7])
#define a_g ((const float*)ap->in[8])
#define a_w_out ((const float*)ap->in[9])
#define b_w_in ((const float*)ap->in[10])
#define b_gq ((const float*)ap->in[11])
#define b_gk ((const float*)ap->in[12])
#define b_w_out ((const float*)ap->in[13])
#define c_w_in ((const float*)ap->in[14])
#define c_g ((const float*)ap->in[15])
#define c_w_out ((const float*)ap->in[16])
#define d_w_in ((const float*)ap->in[17])
#define d_cw ((const float*)ap->in[18])
#define d_cb ((const float*)ap->in[19])
#define d_wg ((const float*)ap->in[20])
#define d_bg ((const float*)ap->in[21])
#define d_lru ((const float*)ap->in[22])
#define d_w_out ((const float*)ap->in[23])
#define GX BIG
#define XC (BIG + (size_t)MTOK * 2048)
#define LA (BIG + (size_t)MTOK * 3072)
#define BT (BIG + (size_t)MTOK * 4096)
#define Y (BIG + (size_t)MTOK * 5120)
#define Wg (Wmi + (size_t)2048 * DM)
#define FFN_CVT(l) do { cvt_matrix(F, ffn_w_in + (size_t)(l) * DM * 2 * DFF, 2 * DFF, DM, 2 * DFF, 1, Wfi); cvt_matrix(F, ffn_w_out + (size_t)(l) * DFF * DM, DM, DFF, DM, 0, Wfo); } while (0)
#define FFN_PHASES(p0, l) do { \
    if (IN(p0)) { AP; REP(p0) { norm_phase<false>(F, out, norm_ffn + (l) * DM, U, nullptr, nullptr, nullptr); } } SEAM(p0); \
    if (IN((p0) + 1)) { AP; REP((p0) + 1) { pg8::EpiSwiGLU<false> E{BIG, DFF, nullptr}; run_gemm(F, U, DM, Wfi, DM, 2 * DFF, DM, E); } } SEAM((p0) + 1); \
    if (IN((p0) + 2)) { AP; REP((p0) + 2) { pg8::EpiResid<FUSE_NX> E{out, out, DM, U, ssqH}; run_gemm(F, BIG, DFF, Wfo, DFF, DM, DFF, E); } } SEAM((p0) + 2); } while (0)
#define QKV BIG
#define HO (BIG + (size_t)MTOK * 2048)
#define PMAB (BIG + (size_t)MTOK * 3072)
#define GTB ((float*)(BIG + (size_t)MTOK * 3584))
#define DENB ((float*)(BIG + (size_t)MTOK * 3584) + 2048 * 320)
    if (IN(0)) { AP; REP(0) { cvt_matrix(F, a_w_in, 3080, DM, 3072, 0, Wmi); cvt_matrix(F, a_w_out, DM, DM, DM, 0, Wmo); FFN_CVT(0);
        __syncthreads(); norm_phase<true>(F, XIN, norm_mix, U, a_w_in, a_b, gatesA); } } SEAM(0);
    if (IN(1)) { AP; REP(1) { mlstm_pre(F, gatesA, GTB); __syncthreads(); pg8::EpiStore<false> E{QKV, 2048, nullptr}; run_gemm(F, U, DM, Wmi, DM, 2048, DM, E); } } SEAM(1);
    if (IN(2)) { AP; REP(2) { mlstm_pmat(F, QKV, GTB, PMAB, DENB); } } SEAM(2);
    if (IN(3)) { AP; REP(3) { mlstm_core(F, QKV, GTB, PMAB, DENB, HO, ssqA); } } SEAM(3);
    if (IN(4)) { AP; REP(4) { pg8::EpiGateA E{HO, ssqA, a_g}; run_gemm(F, U, DM, Wmi + (size_t)2048 * DM, DM, DM, DM, E); } } SEAM(4);
    if (IN(5)) { AP; REP(5) { pg8::EpiResid<FUSE_NX> E{XIN, out, DM, U, ssqH}; run_gemm(F, HO, DM, Wmo, DM, DM, DM, E); } } SEAM(5);
    FFN_PHASES(6, 0);
#define OB (BIG + (size_t)MTOK * 3072)
#define VTB (BIG + (size_t)MTOK * 2048)
    if (IN(9)) { AP; REP(9) { cvt_matrix(F, b_w_in, 3072, DM, 3072, 0, Wmi); cvt_matrix(F, b_w_out, DM, DM, DM, 0, Wmo); FFN_CVT(1);
        __syncthreads(); norm_phase<false>(F, out, norm_mix + DM, U, nullptr, nullptr, nullptr); } } SEAM(9);
    if (IN(10)) { AP; REP(10) { { pg8::EpiStore<false> E{QKV, 2048, nullptr}; run_gemm(F, U, DM, Wmi, DM, 2048, DM, E); } __syncthreads();
        { pg8::EpiStore<false> E{VTB, MTOK, nullptr}; run_gemm(F, Wmi + (size_t)2048 * DM, DM, U, DM, MTOK, DM, E, DM); } } } SEAM(10);
    if (IN(11)) { AP; REP(11) { moba_prep(F, QKV, pos, b_gq, b_gk, kmean); } } SEAM(11);
    if (IN(12)) { AP; REP(12) { moba_attn(F, QKV, VTB, kmean, OB); } } SEAM(12);
    if (IN(13)) { AP; REP(13) { pg8::EpiResid<FUSE_NX> E{out, out, DM, U, ssqH}; run_gemm(F, OB, DM, Wmo, DM, DM, DM, E); } } SEAM(13);
    FFN_PHASES(14, 1);
#define YS (BIG + 2048)
#define PMB (BIG + (size_t)MTOK * 4096)
#define CSTB ((float*)(BIG + (size_t)MTOK * 4096 + (size_t)16 * 1024 * 1024))
    if (IN(17)) { AP; REP(17) { cvt_matrix(F, c_w_in, 6144, DM, 6144, 0, Wmi); cvt_matrix(F, c_w_out, DM, 2048, DM, 0, Wmo); FFN_CVT(2);
        __syncthreads(); norm_phase<false>(F, out, norm_mix + 2 * DM, U, nullptr, nullptr, nullptr); ret_rot_table(F, pos, CSTB); } } SEAM(17);
    if (IN(18)) { AP; REP(18) { pg8::EpiStoreRot E{QKV, CSTB}; run_gemm(F, U, DM, Wmi, DM, 4096, DM, E); } } SEAM(18);
    if (IN(19)) { AP; REP(19) { ret_pmat(F, QKV, PMB); } } SEAM(19);
    if (IN(20)) { AP; REP(20) { ret_core(F, QKV, PMB, statC); } } SEAM(20);
    if (IN(21)) { AP; REP(21) { pg8::EpiGateC<false> E{YS, 4096, statC, c_g, nullptr}; run_gemm(F, U, DM, Wmi + (size_t)4096 * DM, DM, 2048, DM, E); } } SEAM(21);
    if (IN(22)) { AP; REP(22) { pg8::EpiResid<FUSE_NX> E{out, out, DM, U, ssqH}; run_gemm(F, YS, 4096, Wmo, 2048, DM, 2048, E); } } SEAM(22);
    FFN_PHASES(23, 2);
    if (IN(26)) { AP; REP(26) { cvt_matrix(F, d_w_in, 2048, DM, 2048, 0, Wmi);
#pragma unroll 1
            for (int blk = 0; blk < 4; ++blk) cvt_matrix(F, d_wg + (size_t)blk * 256 * 512, 512, 256, 512, 2, Wg + (size_t)blk * 512 * 256);
            cvt_matrix(F, d_w_out, DM, DM, DM, 0, Wmo); FFN_CVT(3);
        __syncthreads(); norm_phase<false>(F, out, norm_mix + 3 * DM, U, nullptr, nullptr, nullptr); } } SEAM(26);
    if (IN(27)) { AP; REP(27) { pg8::EpiStore<false> E{GX, 2048, nullptr}; run_gemm(F, U, DM, Wmi, DM, 2048, DM, E); } } SEAM(27);
    if (IN(28)) { AP; REP(28) { lru_conv(F, GX, d_cw, d_cb, XC, d_lru, sptab); } } SEAM(28);
    if (IN(29)) { AP; REP(29) {
#pragma unroll 1
            for (int blk = 0; blk < 4; ++blk) { pg8::EpiLru E{XC, LA, BT, d_bg + blk * 512, sptab, blk}; run_gemm(F, XC + blk * 256, DM, Wg + (size_t)blk * 512 * 256, 256, 512, 256, E); __syncthreads(); } } } SEAM(29);
    if (IN(30)) { AP; REP(30) { lru_scan(F, LA, BT, GX, Y); } } SEAM(30);
    if (IN(31)) { AP; REP(31) { pg8::EpiResid<FUSE_NX> E{out, out, DM, U, ssqH}; run_gemm(F, Y, DM, Wmo, DM, DM, DM, E); } } SEAM(31);
    FFN_PHASES(32, 3);
    if (TIMING_MASK != 0ull && blockIdx.x == 0 && threadIdx.x == 0) { const unsigned long long t0_ = __builtin_amdgcn_s_memrealtime(); const unsigned long long tacc_ = TMISC[1]; while (__builtin_amdgcn_s_memrealtime() - t0_ < tacc_) __builtin_amdgcn_s_sleep(8); }
#undef IN
#undef SEAM
#undef XIN
#undef pos
#undef norm_mix
#undef norm_ffn
#undef ffn_w_in
#undef ffn_w_out
#undef out
#undef Wmi
#undef Wmo
#undef Wfi
#undef Wfo
#undef U
#undef BIG
#undef gatesA
#undef ssqA
#undef statC
#undef kmean
#undef sptab
#undef a_w_in
#undef a_b
#undef a_g
#undef a_w_out
#undef b_w_in
#undef b_gq
#undef b_gk
#undef b_w_out
#undef c_w_in
#undef c_g
#undef c_w_out
#undef d_w_in
#undef d_cw
#undef d_cb
#undef d_wg
#undef d_bg
#undef d_lru
#undef d_w_out
#undef GX
#undef XC
#undef LA
#undef BT
#undef Y
#undef Wg
#undef FFN_CVT
#undef OB
#undef CSTB
#undef PMAB
#undef GTB
#undef DENB
#undef PMB
#undef VTB
#undef FFN_PHASES
#undef QKV
#undef HO
#undef YS
#undef ssqH
}

#ifndef MK_ONE_LAUNCH
#define MK_ONE_LAUNCH 1
#endif
extern "C" void kernel_launch(void* const* d_in, const int* in_sizes, int n_in, void* d_out, int out_size, void* d_ws, size_t ws_size, hipStream_t stream) {
    static int grid = 0;
    if (grid == 0) {
        if (n_in != 24 || out_size != MTOK * DM || ws_size < WS_END) { fprintf(stderr, "kernel_launch: unexpected shapes (n_in %d, out %d, ws %zu); nothing launched\n", n_in, out_size, ws_size); grid = -1; return; }
        int dev = 0, cus = 0, per_cu = 0;
        if (hipGetDevice(&dev) != hipSuccess || hipDeviceGetAttribute(&cus, hipDeviceAttributeMultiprocessorCount, dev) != hipSuccess) { grid = -1; return; }
        if (hipFuncSetAttribute((const void*)trunk_fwd, hipFuncAttributeMaxDynamicSharedMemorySize, LDS_BYTES) != hipSuccess) { fprintf(stderr, "kernel_launch: hipFuncSetAttribute failed\n"); grid = -1; return; }
        if (hipOccupancyMaxActiveBlocksPerMultiprocessor(&per_cu, (const void*)trunk_fwd, NTHR, LDS_BYTES) != hipSuccess || per_cu < 1) { fprintf(stderr, "kernel_launch: occupancy query reports %d blocks per CU\n", per_cu); }
        (void)hipGetLastError();
        grid = cus;
    }
    if (grid < 0) return;
    (void)hipMemsetAsync((char*)d_ws + WS_CTL, 0, CTL_ZERO_BYTES, stream);
    Args a{};
    for (int i = 0; i < 24; ++i) a.in[i] = d_in[i];
    a.out = (float*)d_out; a.ws = (unsigned char*)d_ws;
#if MK_ONE_LAUNCH
    a.ph_lo = 0; a.ph_hi = NPHASE;
    hipLaunchKernelGGL(trunk_fwd, dim3(grid), dim3(NTHR), LDS_BYTES, stream, a);
#else
    for (int p = 0; p < NPHASE; ++p) { a.ph_lo = p; a.ph_hi = p + 1; hipLaunchKernelGGL(trunk_fwd, dim3(grid), dim3(NTHR), LDS_BYTES, stream, a); }
#endif
}
```

```cpp
#include <hip/hip_runtime.h>
#include <cstdio>
#include <cstdint>
#include <cmath>
namespace pg8 {
#define PG8_LAS __attribute__((address_space(3)))
typedef unsigned short bf16_t;
typedef short bf16x8 __attribute__((ext_vector_type(8)));
typedef float f32x4 __attribute__((ext_vector_type(4)));
typedef unsigned u32x4 __attribute__((ext_vector_type(4)));
constexpr int BM = 256, BK = 64, HALF = 128, HTB = HALF * BK * 2  , STAGE_BYTES = 8 * HTB, NXCD = 8, WGM = 8;

__host__ __device__ __forceinline__ int lds_byte(int r, int c) { const int st = (r >> 4) * 2 + (c >> 5), rr = r & 15, cc = c & 31, ob = rr * 64 + cc * 2; return st * 1024 + (ob ^ (((ob >> 9) & 1) << 5)); }
__host__ __device__ __forceinline__ void stage_rc(int b, int& R, int& C) { const int st = b / 1024, sb = b % 1024, swz = sb ^ (((sb >> 9) & 1) << 5); R = (st >> 1) * 16 + swz / 64; C = (st & 1) * 32 + (swz % 64) / 2; }
__host__ __device__ __forceinline__ int perm32(int rho) { const int n = rho >> 4, i = rho & 15; return 8 * (i >> 2) + 4 * n + (i & 3); }

struct Unit { int pm, pn; };
struct Gemm { const bf16_t* A; const bf16_t* Bt; int M, N, K, lda, ldb; };

struct StaticOrder {
    int nM, nN, nwg, G, c;
    __host__ __device__ void init(int M, int N, int G_, int c_) { nM = M / BM; nN = N / BM; nwg = nM * nN; G = G_; c = c_; }
    __host__ __device__ bool next(int i, Unit& u) const {
        const long L = (long)i * G + c; if (L >= nwg) return false;
        int wgid = (int)L; { const int q = nwg / NXCD, r = nwg % NXCD, xcd = wgid % NXCD, off = wgid / NXCD; wgid = (xcd < r ? xcd * (q + 1) : r * (q + 1) + (xcd - r) * q) + off; }
        const int nig = WGM * nN, gid = wgid / nig, fm = gid * WGM, gsz = (nM - fm) < WGM ? (nM - fm) : WGM;
        u.pm = fm + ((wgid % nig) % gsz); u.pn = (wgid % nig) / gsz; return true;
    }
    __device__ __forceinline__ void a_ready(const Unit&) const {}
    __device__ __forceinline__ void done(const Unit&) const {}
};

__device__ __forceinline__ unsigned cvt_pk_bf16(float lo, float hi) { unsigned r; asm volatile("v_cvt_pk_bf16_f32 %0, %1, %2" : "=v"(r) : "v"(lo), "v"(hi)); return r; }
typedef float f32x2 __attribute__((ext_vector_type(2)));

__device__ __forceinline__ float bf2f(unsigned short b) { return __uint_as_float(((unsigned)b) << 16); }
__device__ __forceinline__ float lo_bf(unsigned w) { return __uint_as_float(w << 16); }
__device__ __forceinline__ float hi_bf(unsigned w) { return __uint_as_float(w & 0xffff0000u); }
__device__ __forceinline__ float fast_sigmoid(float x) { return __builtin_amdgcn_rcpf(1.0f + __expf(-x)); }
typedef unsigned u32x2 __attribute__((ext_vector_type(2)));

__device__ __forceinline__ void row_rstd(const float* ssq, int row0, float (&rs)[2][4]) {
#pragma unroll
    for (int ai = 0; ai < 2; ++ai)
#pragma unroll
        for (int m = 0; m < 4; ++m) { const f32x4* p = (const f32x4*)(ssq + (size_t)(row0 + ai * HALF + m * 16) * 16); const f32x4 a = p[0], b = p[1], c = p[2], d = p[3];
            const float t = ((a[0] + a[1]) + (a[2] + a[3])) + ((b[0] + b[1]) + (b[2] + b[3])) + ((c[0] + c[1]) + (c[2] + c[3])) + ((d[0] + d[1]) + (d[2] + d[3]));
            rs[ai][m] = 1.0f / sqrtf(t * (1.0f / 1024.0f) + 1e-6f); }
}
template <bool RS> struct EpiStore {
    static constexpr bool PERM = true, AFTER_DRAIN = false;
    bf16_t* O; int ldc; const float* ssq;
    __device__ __forceinline__ void operator()(const f32x4 (&acc)[2][2][4][2], const Unit& u, int wr, int wc, int fr, int fq) const {
        const int row0 = u.pm * BM + wr * 64 + fr, col0 = u.pn * BM + wc * 32 + 8 * fq;
        float rs[2][4]; if (RS) row_rstd(ssq, row0, rs);
#pragma unroll
        for (int ai = 0; ai < 2; ++ai)
#pragma unroll
            for (int m = 0; m < 4; ++m) { bf16_t* rowp = O + (size_t)(row0 + ai * HALF + m * 16) * ldc + col0; const float sc = RS ? rs[ai][m] : 1.0f;
#pragma unroll
                for (int bj = 0; bj < 2; ++bj) { const f32x4 v0 = acc[ai][bj][m][0] * sc, v1 = acc[ai][bj][m][1] * sc;
                    u32x4 w; w.x = cvt_pk_bf16(v0[0], v0[1]); w.y = cvt_pk_bf16(v0[2], v0[3]); w.z = cvt_pk_bf16(v1[0], v1[1]); w.w = cvt_pk_bf16(v1[2], v1[3]);
                    *(u32x4*)(rowp + bj * HALF) = w;
#if defined(GEMM_EXP) && GEMM_EXP == 3
                    asm volatile("" ::: "memory"); *(volatile u32x4*)(rowp + bj * HALF) = w;
#endif
                } }
    }
};

struct EpiStoreRot {
    static constexpr bool PERM = true, AFTER_DRAIN = false;
    bf16_t* O; const float* cst;
    __device__ __forceinline__ void operator()(const f32x4 (&acc)[2][2][4][2], const Unit& u, int wr, int wc, int fr, int fq) const {
        const int row0 = u.pm * BM + wr * 64 + fr, col0 = u.pn * BM + wc * 32 + 8 * fq, d0 = wc * 32 + 8 * fq;
        const bool rot = u.pn < 8; const float sc = (u.pn >= 4 && u.pn < 8) ? 0.0625f : 1.0f;
#pragma unroll
        for (int ai = 0; ai < 2; ++ai)
#pragma unroll
            for (int m = 0; m < 4; ++m) { const int row = row0 + ai * HALF + m * 16; bf16_t* rowp = O + (size_t)row * 4096 + col0;
                f32x4 v[2][2];
#pragma unroll
                for (int bj = 0; bj < 2; ++bj) { v[bj][0] = acc[ai][bj][m][0]; v[bj][1] = acc[ai][bj][m][1]; }
                if (rot) { const float* cp = cst + (size_t)row * 256 + d0;
#pragma unroll
                    for (int n = 0; n < 2; ++n) { const f32x4 c = *(const f32x4*)(cp + 4 * n), sn = *(const f32x4*)(cp + 128 + 4 * n); const f32x4 x1 = v[0][n], x2 = v[1][n];
                        v[0][n] = (x1 * c - x2 * sn) * sc; v[1][n] = (x2 * c + x1 * sn) * sc; } }
#pragma unroll
                for (int bj = 0; bj < 2; ++bj) { u32x4 w; w.x = cvt_pk_bf16(v[bj][0][0], v[bj][0][1]); w.y = cvt_pk_bf16(v[bj][0][2], v[bj][0][3]); w.z = cvt_pk_bf16(v[bj][1][0], v[bj][1][1]); w.w = cvt_pk_bf16(v[bj][1][2], v[bj][1][3]);
                    *(u32x4*)(rowp + bj * HALF) = w; } }
    }
};
template <bool RS> struct EpiSwiGLU {
    static constexpr bool PERM = true, AFTER_DRAIN = false;
    bf16_t* O; int ldc; const float* ssq;
    __device__ __forceinline__ void operator()(const f32x4 (&acc)[2][2][4][2], const Unit& u, int wr, int wc, int fr, int fq) const {
        const int row0 = u.pm * BM + wr * 64 + fr, col0 = u.pn * HALF + wc * 32 + 8 * fq;
        float rs[2][4]; if (RS) row_rstd(ssq, row0, rs);
#pragma unroll
        for (int ai = 0; ai < 2; ++ai)
#pragma unroll
            for (int m = 0; m < 4; ++m) { bf16_t* rowp = O + (size_t)(row0 + ai * HALF + m * 16) * ldc + col0; const float sc = RS ? rs[ai][m] : 1.0f;
                float h[8];
#pragma unroll
                for (int n = 0; n < 2; ++n)
#pragma unroll
                    for (int j = 0; j < 4; ++j) { const float g = acc[ai][0][m][n][j] * sc, up = acc[ai][1][m][n][j] * sc;
#if defined(GEMM_EXP) && GEMM_EXP == 2
                        h[4 * n + j] = g * (0.5f * (fast_sigmoid(g) + (1.0f - fast_sigmoid(-g)))) * up;
#else
                        h[4 * n + j] = g * fast_sigmoid(g) * up;
#endif
                    }
                u32x4 w; w.x = cvt_pk_bf16(h[0], h[1]); w.y = cvt_pk_bf16(h[2], h[3]); w.z = cvt_pk_bf16(h[4], h[5]); w.w = cvt_pk_bf16(h[6], h[7]);

#if defined(NT_HIDDEN) && NT_HIDDEN
                __builtin_nontemporal_store(w, (u32x4*)rowp);
#else
                *(u32x4*)rowp = w;
#endif
                }
    }
};
template <bool NX> struct EpiResid {
    static constexpr bool PERM = false, AFTER_DRAIN = false;
    const float* base; float* out; int ldc; bf16_t* hb; float* ssq;
    __device__ __forceinline__ void operator()(const f32x4 (&acc)[2][2][4][2], const Unit& u, int wr, int wc, int fr, int fq) const {
        const int row0 = u.pm * BM + wr * 64 + fr, col0 = u.pn * BM + wc * 32 + 4 * fq;
        f32x4 rb[3][4];
#define PG8_RLOAD(g, slot) do { const size_t off_ = (size_t)(row0 + ((g) >> 2) * HALF + ((g) & 3) * 16) * ldc + col0; \
            rb[slot][0] = *(const f32x4*)(base + off_); rb[slot][1] = *(const f32x4*)(base + off_ + 16); rb[slot][2] = *(const f32x4*)(base + off_ + HALF); rb[slot][3] = *(const f32x4*)(base + off_ + HALF + 16); } while (0)
        PG8_RLOAD(0, 0); PG8_RLOAD(1, 1);
#pragma unroll
        for (int g = 0; g < 8; ++g) { const int ai = g >> 2, m = g & 3; const size_t off = (size_t)(row0 + ai * HALF + m * 16) * ldc + col0; float q = 0.f;
            if (g + 2 < 8) PG8_RLOAD(g + 2, (g + 2) % 3);
#pragma unroll
            for (int bj = 0; bj < 2; ++bj)
#pragma unroll
                for (int n = 0; n < 2; ++n) { const f32x4 o = rb[g % 3][bj * 2 + n] + acc[ai][bj][m][n]; *(f32x4*)(out + off + bj * HALF + n * 16) = o;
                    if (NX) { q += (o[0] * o[0] + o[1] * o[1]) + (o[2] * o[2] + o[3] * o[3]); u32x2 w; w.x = cvt_pk_bf16(o[0], o[1]); w.y = cvt_pk_bf16(o[2], o[3]); *(u32x2*)(hb + off + bj * HALF + n * 16) = w; } }
            if (NX) { q += __shfl_xor(q, 16); q += __shfl_xor(q, 32); if (fq == 0) ssq[(size_t)(row0 + ai * HALF + m * 16) * 16 + u.pn * 4 + wc] = q; } }
#undef PG8_RLOAD
    }
};
struct EpiGateA {
    static constexpr bool PERM = true, AFTER_DRAIN = false;
    bf16_t* Y; const float* ssq; const float* gout;
    __device__ __forceinline__ void operator()(const f32x4 (&acc)[2][2][4][2], const Unit& u, int wr, int wc, int fr, int fq) const {
        const int row0 = u.pm * BM + wr * 64 + fr, col0 = u.pn * BM + wc * 32 + 8 * fq;
        f32x4 gv[2][2];
#pragma unroll
        for (int bj = 0; bj < 2; ++bj)
#pragma unroll
            for (int n = 0; n < 2; ++n) gv[bj][n] = *(const f32x4*)(gout + col0 + bj * HALF + 4 * n);
        u32x4 hwb[2][2]; f32x4 spb[2][2];
#define PG8_GLOAD(g, slot) do { const int row_ = row0 + ((g) >> 2) * HALF + ((g) & 3) * 16; const bf16_t* rp_ = Y + (size_t)row_ * 1024 + col0; hwb[slot][0] = *(const u32x4*)rp_; hwb[slot][1] = *(const u32x4*)(rp_ + HALF); \
            spb[slot][0] = *(const f32x4*)(ssq + (size_t)row_ * 32 + u.pn * 8); spb[slot][1] = *(const f32x4*)(ssq + (size_t)row_ * 32 + u.pn * 8 + 4); } while (0)
        PG8_GLOAD(0, 0);
#pragma unroll
        for (int g = 0; g < 8; ++g) { const int ai = g >> 2, m = g & 3, sl = g & 1; const int row = row0 + ai * HALF + m * 16; bf16_t* rowp = Y + (size_t)row * 1024 + col0;
            if (g + 1 < 8) PG8_GLOAD(g + 1, (g + 1) & 1);
            const f32x4 sp = spb[sl][0], sp2 = spb[sl][1];
            const float rstd = 1.0f / sqrtf((((sp[0] + sp[1]) + (sp[2] + sp[3])) + ((sp2[0] + sp2[1]) + (sp2[2] + sp2[3]))) * (1.0f / 256.0f) + 1e-6f);
#pragma unroll
            for (int bj = 0; bj < 2; ++bj) { const u32x4 hw = hwb[sl][bj]; float o[8];
                const unsigned hh[4] = {hw.x, hw.y, hw.z, hw.w};
#pragma unroll
                for (int n = 0; n < 2; ++n)
#pragma unroll
                    for (int j = 0; j < 4; ++j) { const unsigned w = hh[2 * n + (j >> 1)]; const float hv = (j & 1) ? hi_bf(w) : lo_bf(w);
                        o[4 * n + j] = hv * rstd * gv[bj][n][j] * fast_sigmoid(acc[ai][bj][m][n][j]); }
                u32x4 w; w.x = cvt_pk_bf16(o[0], o[1]); w.y = cvt_pk_bf16(o[2], o[3]); w.z = cvt_pk_bf16(o[4], o[5]); w.w = cvt_pk_bf16(o[6], o[7]);
                *(u32x4*)(rowp + bj * HALF) = w; } }
#undef PG8_GLOAD
    }
};
template <bool RS> struct EpiGateC {
    static constexpr bool PERM = true, AFTER_DRAIN = false;
    bf16_t* Y; int ldy; const float* st; const float* gout; const float* hssq;
    __device__ __forceinline__ void operator()(const f32x4 (&acc)[2][2][4][2], const Unit& u, int wr, int wc, int fr, int fq) const {
        const int row0 = u.pm * BM + wr * 64 + fr, col0 = u.pn * BM + wc * 32 + 8 * fq, head = u.pn >> 1;
        float rs[2][4]; if (RS) row_rstd(hssq, row0, rs);
        f32x4 gv[2][2];
#pragma unroll
        for (int bj = 0; bj < 2; ++bj)
#pragma unroll
            for (int n = 0; n < 2; ++n) gv[bj][n] = *(const f32x4*)(gout + col0 + bj * HALF + 4 * n);
        u32x4 hwb[2][2]; f32x4 spb[2][2];
#define PG8_GLOAD(g, slot) do { const int row_ = row0 + ((g) >> 2) * HALF + ((g) & 3) * 16; const bf16_t* rp_ = Y + (size_t)row_ * ldy + col0; hwb[slot][0] = *(const u32x4*)rp_; hwb[slot][1] = *(const u32x4*)(rp_ + HALF); \
            spb[slot][0] = *(const f32x4*)(st + (size_t)row_ * 32 + head * 8); spb[slot][1] = *(const f32x4*)(st + (size_t)row_ * 32 + head * 8 + 4); } while (0)
        PG8_GLOAD(0, 0);
#pragma unroll
        for (int g = 0; g < 8; ++g) { const int ai = g >> 2, m = g & 3, sl = g & 1; const int row = row0 + ai * HALF + m * 16; bf16_t* rowp = Y + (size_t)row * ldy + col0;
            if (g + 1 < 8) PG8_GLOAD(g + 1, (g + 1) & 1);
            const f32x4 s0 = spb[sl][0], s1 = spb[sl][1];
            const float mu = ((s0[0] + s0[2]) + (s1[0] + s1[2])) * (1.0f / 512.0f), ex2 = ((s0[1] + s0[3]) + (s1[1] + s1[3])) * (1.0f / 512.0f);
            const float var = fmaxf(ex2 - mu * mu, 0.f), rstd = 1.0f / sqrtf(var + 1e-6f);
#pragma unroll
            for (int bj = 0; bj < 2; ++bj) { const u32x4 hw = hwb[sl][bj]; float o[8];
                const unsigned hh[4] = {hw.x, hw.y, hw.z, hw.w};
#pragma unroll
                for (int n = 0; n < 2; ++n)
#pragma unroll
                    for (int j = 0; j < 4; ++j) { const unsigned w = hh[2 * n + (j >> 1)]; const float hv = (j & 1) ? hi_bf(w) : lo_bf(w); const float a = RS ? acc[ai][bj][m][n][j] * rs[ai][m] : acc[ai][bj][m][n][j];
                        o[4 * n + j] = (hv - mu) * rstd * gv[bj][n][j] * (a * fast_sigmoid(a)); }
                u32x4 w; w.x = cvt_pk_bf16(o[0], o[1]); w.y = cvt_pk_bf16(o[2], o[3]); w.z = cvt_pk_bf16(o[4], o[5]); w.w = cvt_pk_bf16(o[6], o[7]);
                *(u32x4*)(rowp + bj * HALF) = w; } }
#undef PG8_GLOAD
    }
};
struct EpiLru {
    static constexpr bool PERM = true, AFTER_DRAIN = false;
    const bf16_t* XC; bf16_t* LA; bf16_t* BT; const float* bg; const float* sp; int blk;
    __device__ __forceinline__ void operator()(const f32x4 (&acc)[2][2][4][2], const Unit& u, int wr, int wc, int fr, int fq) const {
        const int row0 = u.pm * BM + wr * 64 + fr, cb = u.pn * HALF + wc * 32 + 8 * fq, ch0 = blk * 256 + cb;
        u32x4 xwb[2]; xwb[0] = *(const u32x4*)(XC + (size_t)row0 * 1024 + ch0);
#pragma unroll
        for (int g = 0; g < 8; ++g) { const int ai = g >> 2, m = g & 3; const size_t off = (size_t)(row0 + ai * HALF + m * 16) * 1024 + ch0;
                if (g + 1 < 8) xwb[(g + 1) & 1] = *(const u32x4*)(XC + (size_t)(row0 + ((g + 1) >> 2) * HALF + ((g + 1) & 3) * 16) * 1024 + ch0);
                const u32x4 xw = xwb[g & 1]; const unsigned xx[4] = {xw.x, xw.y, xw.z, xw.w};
                unsigned lw[4], bw[4];
#pragma unroll
                for (int n = 0; n < 2; ++n) { const f32x4 br = *(const f32x4*)(bg + cb + 4 * n), bi = *(const f32x4*)(bg + 256 + cb + 4 * n), spv = *(const f32x4*)(sp + ch0 + 4 * n); float la[4], bt[4];
#pragma unroll
                    for (int j = 0; j < 4; ++j) { const int q = 4 * n + j; const unsigned w = xx[q >> 1]; const float xc = (q & 1) ? hi_bf(w) : lo_bf(w);
                        const float r = fast_sigmoid(acc[ai][0][m][n][j] + br[j]), ig = fast_sigmoid(acc[ai][1][m][n][j] + bi[j]);
                        const float l = -8.0f * r * spv[j]; la[j] = l; bt[j] = sqrtf(fmaxf(1.0f - __expf(2.0f * l), 0.f)) * ig * xc; }
                    lw[2 * n] = cvt_pk_bf16(la[0], la[1]); lw[2 * n + 1] = cvt_pk_bf16(la[2], la[3]); bw[2 * n] = cvt_pk_bf16(bt[0], bt[1]); bw[2 * n + 1] = cvt_pk_bf16(bt[2], bt[3]); }
                u32x4 w; w.x = lw[0]; w.y = lw[1]; w.z = lw[2]; w.w = lw[3]; *(u32x4*)(LA + off) = w;
                w.x = bw[0]; w.y = bw[1]; w.z = bw[2]; w.w = bw[3]; *(u32x4*)(BT + off) = w; }
    }
};

template <class Epi, class Sched, bool ALIGN_EPI = false, bool SP2 = false>
__device__ __forceinline__ void gemm_phase(PG8_LAS unsigned char* lds, const Gemm g, const Sched& S, const Epi& E) {
    int tid_ = threadIdx.x; asm volatile("" : "+v"(tid_));
    const int tid = tid_, wid = __builtin_amdgcn_readfirstlane(tid >> 6), lane = tid & 63, wr = wid >> 2, wc = wid & 3, fr = lane & 15, fq = lane >> 4;
    const int K = g.K, nt = K / BK;
    unsigned voffA[2], voffB[2];
#pragma unroll
    for (int i = 0; i < 2; ++i) { int R, C; stage_rc(tid * 16 + i * 8192, R, C); const int Rb = Epi::PERM ? ((R & ~31) + perm32(R & 31)) : R;
        voffA[i] = (unsigned)(R * g.lda + C) * 2u; voffB[i] = (unsigned)(Rb * g.ldb + C) * 2u; }
    const size_t kstep = (size_t)(BK * 2);
    const size_t hstepA = (size_t)HALF * g.lda * 2, hstepB = (size_t)HALF * g.ldb * 2;
    const size_t tstepA = 2 * hstepA, tstepB = 2 * hstepB;
    const unsigned ldsw = (unsigned)wid * 1024u;
    const int aoff = lds_byte(wr * 64 + fr, fq * 8), boff = lds_byte(wc * 32 + fr, fq * 8);
#define PG8_SA(b, h) (((b) * 2 + (h)) * HTB)
#define PG8_SB(b, h) ((4 + (b) * 2 + (h)) * HTB)
#define PG8_STAGE(bufoff, gbase, voff) do { _Pragma("unroll") for (int _i = 0; _i < 2; ++_i) \
        __builtin_amdgcn_global_load_lds((const unsigned*)((const char*)(gbase) + (voff)[_i]), (PG8_LAS unsigned*)(lds + (bufoff) + ldsw + _i * 8192), 16, 0, 0); } while (0)
#define PG8_LDA(dst, b, h) do { _Pragma("unroll") for (int m = 0; m < 4; ++m) _Pragma("unroll") for (int k = 0; k < 2; ++k) dst[m][k] = *(const PG8_LAS bf16x8*)(lds + PG8_SA(b, h) + aoff + m * 2048 + k * 1024); } while (0)
#define PG8_LDB(dst, b, h) do { _Pragma("unroll") for (int n = 0; n < 2; ++n) _Pragma("unroll") for (int k = 0; k < 2; ++k) dst[n][k] = *(const PG8_LAS bf16x8*)(lds + PG8_SB(b, h) + boff + n * 2048 + k * 1024); } while (0)
#define PG8_MMA(ai, bj, At, Bt) do { __builtin_amdgcn_s_setprio(1); _Pragma("unroll") for (int m = 0; m < 4; ++m) _Pragma("unroll") for (int n = 0; n < 2; ++n) _Pragma("unroll") for (int k = 0; k < 2; ++k) \
        acc[ai][bj][m][n] = __builtin_amdgcn_mfma_f32_16x16x32_bf16(Bt[n][k], At[m][k], acc[ai][bj][m][n], 0, 0, 0); __builtin_amdgcn_s_setprio(0); } while (0)
#define PG8_WAIT_V(n) asm volatile("s_waitcnt vmcnt(" #n ")" ::: "memory")
#define PG8_WAIT_L(n) asm volatile("s_waitcnt lgkmcnt(" #n ")" ::: "memory")
#define PG8_BAR __builtin_amdgcn_s_barrier()
#define PG8_SCHED __builtin_amdgcn_sched_barrier(0)
    Unit cur, nxt; int ui = 0;
    if (!S.next(0, cur)) return;
    f32x4 acc[2][2][4][2];
#pragma unroll
    for (int a = 0; a < 2; ++a)
#pragma unroll
        for (int b = 0; b < 2; ++b)
#pragma unroll
            for (int m = 0; m < 4; ++m)
#pragma unroll
                for (int n = 0; n < 2; ++n) acc[a][b][m][n] = (f32x4){0.f, 0.f, 0.f, 0.f};
    bf16x8 At[4][2], B0[2][2], B1[2][2];
    const char* cA = (const char*)g.A + (size_t)cur.pm * tstepA; const char* cB = (const char*)g.Bt + (size_t)cur.pn * tstepB;
    S.a_ready(cur);
    if constexpr (SP2) {
        PG8_STAGE(PG8_SB(0, 0), cB, voffB); PG8_STAGE(PG8_SB(0, 1), cB + hstepB, voffB); PG8_STAGE(PG8_SA(0, 0), cA, voffA); PG8_STAGE(PG8_SA(0, 1), cA + hstepA, voffA);
        if (wr == 1) PG8_BAR;
        PG8_WAIT_V(2); PG8_BAR;
        PG8_STAGE(PG8_SB(1, 0), cB + kstep, voffB); PG8_STAGE(PG8_SA(1, 0), cA + kstep, voffA); PG8_STAGE(PG8_SB(1, 1), cB + hstepB + kstep, voffB);
        PG8_WAIT_V(6); PG8_BAR;
    } else {
        PG8_STAGE(PG8_SB(0, 0), cB, voffB); PG8_STAGE(PG8_SA(0, 0), cA, voffA); PG8_STAGE(PG8_SB(0, 1), cB + hstepB, voffB); PG8_STAGE(PG8_SA(0, 1), cA + hstepA, voffA);
        if (wr == 1) PG8_BAR;
        PG8_WAIT_V(4); PG8_BAR;
        PG8_STAGE(PG8_SB(1, 0), cB + kstep, voffB); PG8_STAGE(PG8_SA(1, 0), cA + kstep, voffA); PG8_STAGE(PG8_SB(1, 1), cB + hstepB + kstep, voffB);
        PG8_WAIT_V(6); PG8_BAR;
    }
    for (;;) {
        const bool has_next = S.next(ui + 1, nxt);
        const char* nA = has_next ? (const char*)g.A + (size_t)nxt.pm * tstepA : cA; const char* nB = has_next ? (const char*)g.Bt + (size_t)nxt.pn * tstepB : cB;
        for (int t = 0; t < nt; t += 2) {
            const bool last = (t == nt - 2);
            const char* a1 = cA + (size_t)(t + 1) * kstep;
            const char* a2 = last ? nA : cA + (size_t)(t + 2) * kstep; const char* b2 = last ? nB : cB + (size_t)(t + 2) * kstep;
            const char* a3 = a2 + kstep; const char* b3 = b2 + kstep;
            if (last && has_next) S.a_ready(nxt);
            if constexpr (SP2) {
            PG8_LDB(B0, 0, 0); PG8_LDB(B1, 0, 1); PG8_SCHED; PG8_LDA(At, 0, 0); PG8_STAGE(PG8_SA(1, 1), a1 + hstepA, voffA);
            PG8_WAIT_V(8); PG8_WAIT_L(0); PG8_BAR; PG8_MMA(0, 0, At, B0); PG8_MMA(0, 1, At, B1); PG8_BAR; PG8_SCHED;
            PG8_LDA(At, 0, 1); PG8_STAGE(PG8_SB(0, 0), b2, voffB); PG8_STAGE(PG8_SB(0, 1), b2 + hstepB, voffB); PG8_STAGE(PG8_SA(0, 0), a2, voffA);
            PG8_WAIT_V(8); PG8_WAIT_L(0); PG8_BAR; PG8_MMA(1, 0, At, B0); PG8_MMA(1, 1, At, B1); PG8_BAR; PG8_SCHED;
            PG8_LDB(B0, 1, 0); PG8_LDB(B1, 1, 1); PG8_SCHED; PG8_LDA(At, 1, 0); PG8_STAGE(PG8_SA(0, 1), a2 + hstepA, voffA);
            PG8_WAIT_V(8); PG8_WAIT_L(0); PG8_BAR; PG8_MMA(0, 0, At, B0); PG8_MMA(0, 1, At, B1); PG8_BAR; PG8_SCHED;
            PG8_LDA(At, 1, 1); PG8_STAGE(PG8_SB(1, 0), b3, voffB); PG8_STAGE(PG8_SB(1, 1), b3 + hstepB, voffB); PG8_STAGE(PG8_SA(1, 0), a3, voffA);
            PG8_WAIT_V(8); PG8_WAIT_L(0); PG8_BAR; PG8_MMA(1, 0, At, B0); PG8_MMA(1, 1, At, B1); PG8_BAR; PG8_SCHED;
            } else {
            PG8_LDB(B0, 0, 0); PG8_SCHED; PG8_LDA(At, 0, 0); PG8_STAGE(PG8_SA(1, 1), a1 + hstepA, voffA);
            PG8_WAIT_L(8); PG8_BAR; PG8_WAIT_L(0); PG8_MMA(0, 0, At, B0); PG8_BAR; PG8_SCHED;
            PG8_LDB(B1, 0, 1); PG8_STAGE(PG8_SB(0, 0), b2, voffB);
            PG8_BAR; PG8_WAIT_L(0); PG8_MMA(0, 1, At, B1); PG8_BAR;
            PG8_LDA(At, 0, 1); PG8_STAGE(PG8_SA(0, 0), a2, voffA);
            PG8_BAR; PG8_WAIT_L(0); PG8_MMA(1, 0, At, B0); PG8_BAR; PG8_SCHED;
            PG8_STAGE(PG8_SB(0, 1), b2 + hstepB, voffB);
            PG8_WAIT_V(6); PG8_BAR; PG8_MMA(1, 1, At, B1); PG8_BAR;
            PG8_LDB(B0, 1, 0); PG8_SCHED; PG8_LDA(At, 1, 0); PG8_STAGE(PG8_SA(0, 1), a2 + hstepA, voffA);
            PG8_WAIT_L(8); PG8_BAR; PG8_WAIT_L(0); PG8_MMA(0, 0, At, B0); PG8_BAR; PG8_SCHED;
            PG8_LDB(B1, 1, 1); PG8_STAGE(PG8_SB(1, 0), b3, voffB);
            PG8_BAR; PG8_WAIT_L(0); PG8_MMA(0, 1, At, B1); PG8_BAR;
            PG8_LDA(At, 1, 1); PG8_STAGE(PG8_SA(1, 0), a3, voffA);
            PG8_BAR; PG8_WAIT_L(0); PG8_MMA(1, 0, At, B0); PG8_BAR; PG8_SCHED;
            PG8_STAGE(PG8_SB(1, 1), b3 + hstepB, voffB);
            PG8_WAIT_V(6); PG8_BAR; PG8_MMA(1, 1, At, B1); PG8_BAR;
            }
        }
        if constexpr (ALIGN_EPI) { if (wr == 0) PG8_BAR; }
        if constexpr (!Epi::AFTER_DRAIN) { E(acc, cur, wr, wc, fr, fq); S.done(cur); }
        if (!has_next) break;
#pragma unroll
        for (int a = 0; a < 2; ++a)
#pragma unroll
            for (int b = 0; b < 2; ++b)
#pragma unroll
                for (int m = 0; m < 4; ++m)
#pragma unroll
                    for (int n = 0; n < 2; ++n) acc[a][b][m][n] = (f32x4){0.f, 0.f, 0.f, 0.f};
        cur = nxt; cA = nA; cB = nB; ++ui;
        if constexpr (ALIGN_EPI) { if (wr == 1) PG8_BAR; }
    }
    PG8_WAIT_V(0);
    if constexpr (!ALIGN_EPI) { if (wr == 0) PG8_BAR; }
    PG8_BAR;
    if constexpr (Epi::AFTER_DRAIN) { E.fused(acc, cur, wr, wc, fr, fq, lds, wid, lane); S.done(cur); }
#undef PG8_SA
#undef PG8_SB
#undef PG8_STAGE
#undef PG8_LDA
#undef PG8_LDB
#undef PG8_MMA
#undef PG8_WAIT_V
#undef PG8_WAIT_L
#undef PG8_BAR
#undef PG8_SCHED
}
}
#define GAS __attribute__((address_space(1)))
#define LAS __attribute__((address_space(3)))
typedef unsigned short bf16;
typedef unsigned v4u __attribute__((ext_vector_type(4)));
typedef float f32x4 __attribute__((ext_vector_type(4)));
typedef short bf16x8 __attribute__((ext_vector_type(8)));
typedef GAS unsigned gu32;
typedef GAS unsigned long long gu64;
#define RLX_AGENT __ATOMIC_RELAXED, __HIP_MEMORY_SCOPE_AGENT
#define LDS_WAIT() asm volatile("s_waitcnt lgkmcnt(0)" ::: "memory")
#define VM_WAIT() asm volatile("s_waitcnt vmcnt(0)" ::: "memory")
__device__ __forceinline__ unsigned long long rt() { return __builtin_amdgcn_s_memrealtime(); }
__device__ __forceinline__ unsigned f2bf(float f) { unsigned u = __builtin_bit_cast(unsigned, f); return (u + 0x7fffu + ((u >> 16) & 1u)) >> 16; }
__device__ __forceinline__ unsigned pk2(float lo, float hi) { return f2bf(lo) | (f2bf(hi) << 16); }

#define XB_TMO      128
#define XB_XCNT(j)  (256  + 64 * (j))
#define XB_XSUB(j)  (1280 + 64 * (j))
#define XB_XGEN(j)  (2304 + 64 * (j))
#define XB_TOP      3328
#define XB_TOPGEN   3392
#define XCD_BAR_WORDS 3456
#define XB_SPIN_CAP (1u << 18)

__device__ __forceinline__ unsigned xb_ld(unsigned* p)              { return __hip_atomic_load(p, __ATOMIC_RELAXED, __HIP_MEMORY_SCOPE_AGENT); }
__device__ __forceinline__ unsigned xb_add(unsigned* p, unsigned v) { return __hip_atomic_fetch_add(p, v, __ATOMIC_RELAXED, __HIP_MEMORY_SCOPE_AGENT); }
__device__ __forceinline__ unsigned xb_xcc_id() { return (unsigned)__builtin_amdgcn_s_getreg((3 << 11) | 20) & 0xFu; }
#define XB_SPIN(cond, bar) do { unsigned _sp = 0; while (cond) { __builtin_amdgcn_s_sleep(1); \
    if ((++_sp & 255u) == 0u) { if (xb_ld(&(bar)[XB_TMO])) break; if (_sp > XB_SPIN_CAP) { atomicAdd(&(bar)[XB_TMO], 1u); break; } } } } while (0)

struct XcdBarrier {
    unsigned* bar; unsigned x;
    volatile LAS unsigned* st;
};

__device__ __forceinline__ XcdBarrier xcd_barrier_post(unsigned* bar, volatile LAS unsigned* st) {
    XcdBarrier b; b.bar = bar; b.x = xb_xcc_id(); b.st = st;
    if (threadIdx.x == 0) (void)xb_add(&bar[XB_XCNT(b.x)], 1u);
    return b;
}
__device__ __forceinline__ void xcd_barrier_complete(unsigned* bar, unsigned x, unsigned& nloc, unsigned& nx) {
    const unsigned G = gridDim.x * gridDim.y * gridDim.z;
    unsigned sum, cnt, mine, sp = 0u;
    for (;;) {
        sum = 0u; cnt = 0u; mine = 0u;
#pragma unroll
        for (unsigned j = 0; j < 16; ++j) { const unsigned c = xb_ld(&bar[XB_XCNT(j)]); sum += c; cnt += (c > 0u) ? 1u : 0u; mine = (j == x) ? c : mine; }
        if (sum == G) break;
        __builtin_amdgcn_s_sleep(1);
        if ((++sp & 255u) == 0u) { if (xb_ld(&bar[XB_TMO])) break; if (sp > XB_SPIN_CAP) { atomicAdd(&bar[XB_TMO], 1u); break; } }
    }
    nloc = mine > 0u ? mine : 1u; nx = cnt > 0u ? cnt : 1u;
}

__device__ __forceinline__ void xcd_barrier(const XcdBarrier& b) {
    asm volatile("s_waitcnt vmcnt(0)" ::: "memory");
    __syncthreads();
    if (threadIdx.x == 0) {
        unsigned* bar = b.bar;
        __builtin_amdgcn_s_waitcnt(0);
        unsigned nloc = b.st[0], nx = b.st[1];
        if (nloc == 0u) { xcd_barrier_complete(bar, b.x, nloc, nx); b.st[0] = nloc; b.st[1] = nx; }
        const unsigned old = xb_add(&bar[XB_XSUB(b.x)], 1u);
        const unsigned gen = old / nloc;
        if (old + 1u == (gen + 1u) * nloc) {
            __builtin_amdgcn_fence(__ATOMIC_RELEASE, "agent");
            asm volatile("s_waitcnt vmcnt(0)" ::: "memory");
            const unsigned og = xb_add(&bar[XB_TOP], 1u);
            const unsigned tg = og / nx;
            if (og + 1u == (tg + 1u) * nx) xb_add(&bar[XB_TOPGEN], 1u);
            else XB_SPIN(xb_ld(&bar[XB_TOPGEN]) == tg, bar);
            __builtin_amdgcn_fence(__ATOMIC_ACQUIRE, "agent");
            xb_add(&bar[XB_XGEN(b.x)], 1u);
            asm volatile("s_waitcnt vmcnt(0)" ::: "memory");
        } else {
            XB_SPIN(xb_ld(&bar[XB_XGEN(b.x)]) == gen, bar);
            __builtin_amdgcn_fence(__ATOMIC_ACQUIRE, "agent");
            asm volatile("s_waitcnt vmcnt(0)" ::: "memory");
        }
    }
    __syncthreads();
}

constexpr int NWAVES = 8, NTHR = 512;
constexpr int MTOK = 32768, DM = 1024, SEQ = 2048, NB = 16, DFF = 2816;
constexpr size_t MiB = 1u << 20;
constexpr size_t WS_CTL = 0, CTL_ZERO_BYTES = 64 * 1024;
constexpr size_t WS_W_MIXIN = 1 * MiB, WS_W_MIXOUT = 13 * MiB, WS_W_FFNIN = 17 * MiB, WS_W_FFNOUT = 28 * MiB;
constexpr size_t WS_GATESA = 34 * MiB, WS_SSQA = 35 * MiB, WS_STATC = 492 * MiB, WS_KMEAN = 41 * MiB, WS_SSQH = 42 * MiB, WS_SPTAB = 33 * MiB + 512 * 1024;
constexpr size_t WS_U = 44 * MiB, WS_BIG = 108 * MiB, WS_END = 500 * MiB;
constexpr int CW_BAR = 1024;
static_assert((CW_BAR + 3456) * 4 <= (int)CTL_ZERO_BYTES, "ctl");
constexpr int LDS_BYTES = 163840, MISC_OFF = 163584;

typedef unsigned u32x4 __attribute__((ext_vector_type(4)));
typedef unsigned u32x2 __attribute__((ext_vector_type(2)));
typedef float f32x2 __attribute__((ext_vector_type(2)));
struct Frame { LAS unsigned char* lds; int tid, lane, wave, G; };
struct Args { const void* in[24]; float* out; unsigned char* ws; int ph_lo, ph_hi; };

__device__ __forceinline__ float wave_sum(float v) {
#pragma unroll
    for (int o = 1; o < 64; o <<= 1) v += __shfl_xor(v, o);
    return v;
}
__device__ __forceinline__ float bf2f(bf16 b) { return __uint_as_float(((unsigned)b) << 16); }
__device__ __forceinline__ float lo_bf(unsigned w) { return __uint_as_float(w << 16); }
__device__ __forceinline__ float hi_bf(unsigned w) { return __uint_as_float(w & 0xffff0000u); }
__device__ __forceinline__ unsigned cvtpk(float lo, float hi) { return pg8::cvt_pk_bf16(lo, hi); }

typedef short v4s16 __attribute__((ext_vector_type(4)));
template <int LD> __device__ __forceinline__ bf16x8 tr_frag(const LAS bf16* T, int r0, int c0, int lane) {
    const int fr = lane & 15, fq = lane >> 4;
    const LAS bf16* a = T + (r0 + 8 * fq + (fr >> 2)) * LD + c0 + 4 * (fr & 3);
    const v4s16 lo = __builtin_amdgcn_ds_read_tr16_b64_v4i16((LAS v4s16*)a);
    const v4s16 hi = __builtin_amdgcn_ds_read_tr16_b64_v4i16((LAS v4s16*)(a + 4 * LD));
    return __builtin_shufflevector(lo, hi, 0, 1, 2, 3, 4, 5, 6, 7);
}
template <int MT, int NT, int K, int LDA, int LDB, bool TA = false, bool TB = false, bool SB = true>
__device__ __forceinline__ void wgemm(f32x4 (&acc)[MT][NT], const LAS bf16* A, const LAS bf16* Bt, int lane) {
    const int fr = lane & 15, fq = lane >> 4;
    const LAS bf16* ap = A + fr * LDA + 8 * fq;
    const LAS bf16* bp = Bt + fr * LDB + 8 * fq;
#pragma unroll
    for (int k0 = 0; k0 < K; k0 += 32) {
        bf16x8 a[MT], b[NT];
#pragma unroll
        for (int i = 0; i < MT; ++i) a[i] = TA ? tr_frag<LDA>(A, k0, 16 * i, lane) : *(const LAS bf16x8*)(ap + 16 * i * LDA + k0);
#pragma unroll
        for (int j = 0; j < NT; ++j) b[j] = TB ? tr_frag<LDB>(Bt, k0, 16 * j, lane) : *(const LAS bf16x8*)(bp + 16 * j * LDB + k0);
#pragma unroll
        for (int i = 0; i < MT; ++i)
#pragma unroll
            for (int j = 0; j < NT; ++j) acc[i][j] = __builtin_amdgcn_mfma_f32_16x16x32_bf16(a[i], b[j], acc[i][j], 0, 0, 0);
        if (SB && MT * NT >= 4) __builtin_amdgcn_sched_barrier(0);
    }
    if (!SB) __builtin_amdgcn_sched_barrier(0);
}

__device__ __forceinline__ int cvt_src_col(int mode, int g0) {
    if (mode == 0) return g0;
    const int pn = g0 >> 8, r = g0 & 255;
    if (mode == 1) return r < 128 ? 128 * pn + r : DFF + 128 * pn + (r - 128);
    return r < 128 ? 128 * pn + r : 256 + 128 * pn + (r - 128);
}
__device__ __forceinline__ void cvt_matrix(Frame& F, const float* W, int ldw, int K, int Np, int mode, bf16* WT, const float* gain = nullptr) {
    LAS float* scr = (LAS float*)(F.lds + F.wave * 16384);
    const int gw = blockIdx.x * NWAVES + F.wave, NGW = F.G * NWAVES, lane = F.lane;
    const int nblk = Np / 32, nitems = (K / 64) * nblk;
    float v[32], vn[32];
#define CVT_LOAD(dst, it) do { const int kb_ = (it) / nblk, nb_ = (it) % nblk, s0_ = cvt_src_col(mode, 32 * nb_); const float* wp_ = W + (size_t)(64 * kb_ + (lane >> 5)) * ldw + s0_ + (lane & 31); \
        _Pragma("unroll") for (int i = 0; i < 32; ++i) dst[i] = wp_[(size_t)(2 * i) * ldw]; } while (0)
    int item = gw;
    if (item < nitems) CVT_LOAD(v, item);
    for (; item < nitems; item += NGW) {
        const int kb = item / nblk, nb = item % nblk, k0 = 64 * kb, n0 = 32 * nb;
        if (item + NGW < nitems) CVT_LOAD(vn, item + NGW);
        if (gain) {
#pragma unroll
            for (int i = 0; i < 32; ++i) v[i] *= gain[k0 + 2 * i + (lane >> 5)]; }
#pragma unroll
        for (int i = 0; i < 32; ++i) scr[(2 * i + (lane >> 5)) * 33 + (lane & 31)] = v[i];
        LDS_WAIT(); asm volatile("" ::: "memory");
        const int c = lane & 7;
#pragma unroll
        for (int j = 0; j < 4; ++j) { const int n = (lane >> 3) + 8 * j; const LAS float* sp = scr + (8 * c) * 33 + n;
            v4u o; o.x = pk2(sp[0 * 33], sp[1 * 33]); o.y = pk2(sp[2 * 33], sp[3 * 33]); o.z = pk2(sp[4 * 33], sp[5 * 33]); o.w = pk2(sp[6 * 33], sp[7 * 33]);
            *(v4u*)(WT + (size_t)(n0 + n) * K + k0 + 8 * c) = o; }
        LDS_WAIT(); asm volatile("" ::: "memory");
#pragma unroll
        for (int i = 0; i < 32; ++i) v[i] = vn[i];
    }
#undef CVT_LOAD
}

template <bool GATES>
__device__ __forceinline__ void norm_phase(Frame& F, const float* src, const float* gain, bf16* dst, const float* wA, const float* bA, float* gout) {
    LAS float* wg = (LAS float*)F.lds;
    if (GATES) {
        for (int i = F.tid; i < 1024 * 8; i += NTHR) wg[i] = wA[(size_t)(i >> 3) * 3080 + 3072 + (i & 7)];
        __syncthreads();
    }
    const int gw = blockIdx.x * NWAVES + F.wave, NGW = F.G * NWAVES, lane = F.lane;
    f32x4 g[4];
#pragma unroll
    for (int j = 0; j < 4; ++j) g[j] = ((const f32x4*)gain)[lane + 64 * j];
    for (int m = gw; m < MTOK; m += NGW) {
        const f32x4* xr = (const f32x4*)(src + (size_t)m * DM) + lane;
        f32x4 v[4]; float s = 0.f;
#pragma unroll
        for (int j = 0; j < 4; ++j) { v[j] = xr[64 * j]; s += (v[j].x * v[j].x + v[j].y * v[j].y) + (v[j].z * v[j].z + v[j].w * v[j].w); }
        const float rstd = 1.0f / sqrtf(wave_sum(s) * (1.0f / DM) + 1e-6f);
        unsigned long long* o8 = (unsigned long long*)(dst + (size_t)m * DM) + lane;
#pragma unroll
        for (int j = 0; j < 4; ++j) { v[j] = v[j] * rstd * g[j];
            o8[64 * j] = (unsigned long long)cvtpk(v[j].x, v[j].y) | ((unsigned long long)cvtpk(v[j].z, v[j].w) << 32); }
        if (GATES) {
            float a[8];
#pragma unroll
            for (int q = 0; q < 8; ++q) a[q] = 0.f;
#pragma unroll
            for (int j = 0; j < 4; ++j)
#pragma unroll
                for (int e = 0; e < 4; ++e) { const int k = 4 * lane + 256 * j + e; const f32x4 w0 = *(const LAS f32x4*)(wg + k * 8), w1 = *(const LAS f32x4*)(wg + k * 8 + 4); const float x = v[j][e];
                    a[0] += x * w0.x; a[1] += x * w0.y; a[2] += x * w0.z; a[3] += x * w0.w; a[4] += x * w1.x; a[5] += x * w1.y; a[6] += x * w1.z; a[7] += x * w1.w; }
#pragma unroll
            for (int q = 0; q < 8; ++q) a[q] = wave_sum(a[q]);
            if (lane == 0) {
#pragma unroll
                for (int q = 0; q < 8; ++q) gout[(size_t)m * 8 + q] = a[q] + bA[q]; }
        }
    }
}

__device__ __forceinline__ void mlstm_pre(Frame& F, const float* gates, float* GT) {
    LAS float* sA = (LAS float*)F.lds, *sPM = sA + 2048, *sBC = sPM + 2048, *sBT = sBC + 2048, *sP63 = sBT + 32, *sM = sP63 + 32;
    const int lane = F.lane, w = F.wave;
    for (int item = blockIdx.x; item < 64; item += F.G) {
        const int b = item >> 2, h = item & 3;
        __syncthreads();
        float gi4[4], gf4[4];
#pragma unroll
        for (int i = 0; i < 4; ++i) { const size_t row = (size_t)b * SEQ + (w + 8 * i) * 64 + lane; gi4[i] = gates[row * 8 + h]; gf4[i] = gates[row * 8 + 4 + h]; }
#pragma unroll
        for (int i = 0; i < 4; ++i) { const int c = w + 8 * i;
            const float gi = gi4[i], gf = gf4[i];
            const float fc = fminf(gf, 0.f) - log1pf(__expf(-fabsf(gf)));
            float bc = fc;
#pragma unroll
            for (int o = 1; o < 64; o <<= 1) { const float t = __shfl_up(bc, o); if (lane >= o) bc += t; }
            const float a = gi - bc; float pm = a;
#pragma unroll
            for (int o = 1; o < 64; o <<= 1) { const float t = __shfl_up(pm, o); if (lane >= o) pm = fmaxf(pm, t); }
            sA[c * 64 + lane] = a; sPM[c * 64 + lane] = pm; sBC[c * 64 + lane] = bc; if (lane == 63) { sBT[c] = bc; sP63[c] = pm; } }
        __syncthreads();
        if (F.tid == 0) { float m = 0.f; for (int c = 0; c < 32; ++c) { sM[c] = m; m = sBT[c] + fmaxf(m, sP63[c]); } }
        __syncthreads();
#pragma unroll
        for (int i = 0; i < 4; ++i) { const int c = w + 8 * i; const float mst = sM[c], Mx = fmaxf(mst, sPM[c * 64 + lane]), Mx63 = fmaxf(mst, sP63[c]);
            float* g = GT + ((size_t)(item * 32 + c)) * 320 + lane;
            g[0] = sA[c * 64 + lane]; g[64] = Mx; g[128] = __expf(mst - Mx); g[192] = __expf(-(sBC[c * 64 + lane] + Mx)); g[256] = __expf(sA[c * 64 + lane] - Mx63); }
    }
}
__device__ __forceinline__ void mlstm_pmat(Frame& F, const bf16* QKV, const float* GT, bf16* PMA, float* DENP) {
    constexpr float SCALE = 0.08838834764831845f;
    LAS bf16* Qs = (LAS bf16*)F.lds;
    LAS bf16* Ks = Qs + 64 * 136;
    LAS bf16* Ps = Ks + 64 * 136;
    LAS float* fA = (LAS float*)(Ps + 64 * 72), *fMX = fA + 64;
    const int tid = F.tid, lane = F.lane, w = F.wave, fr = lane & 15, fq = lane >> 4, wh = w >> 1, wl = w & 1;
    const unsigned qoff0 = (unsigned)((((tid >> 4) * 2048) + (tid & 15) * 8) * 2);
    v4u pQ[2], pK[2]; float pg = 0.f;
    int item = blockIdx.x;
    if (item < 2048) { const int bh = item >> 5, c = item & 31; const char* gq = (const char*)(QKV + ((size_t)(bh >> 2) * SEQ + c * 64) * 2048 + (bh & 3) * 128);
#pragma unroll
        for (int i = 0; i < 2; ++i) { pQ[i] = *(const v4u*)(gq + qoff0 + i * (32 * 2048 * 2)); pK[i] = *(const v4u*)(gq + qoff0 + i * (32 * 2048 * 2) + 1024); }
        if (tid < 128) pg = GT[(size_t)item * 320 + tid]; }
    for (; item < 2048; item += F.G) {
        __syncthreads();
#pragma unroll
        for (int i = 0; i < 2; ++i) { const int id = tid + NTHR * i, row = id >> 4, c8 = id & 15; *(LAS v4u*)(Qs + row * 136 + c8 * 8) = pQ[i]; *(LAS v4u*)(Ks + row * 136 + c8 * 8) = pK[i]; }
        if (tid < 128) fA[tid] = pg;
        const int nit = item + F.G;
        if (nit < 2048) { const int bh = nit >> 5, c = nit & 31; const char* gq = (const char*)(QKV + ((size_t)(bh >> 2) * SEQ + c * 64) * 2048 + (bh & 3) * 128);
#pragma unroll
            for (int i = 0; i < 2; ++i) { pQ[i] = *(const v4u*)(gq + qoff0 + i * (32 * 2048 * 2)); pK[i] = *(const v4u*)(gq + qoff0 + i * (32 * 2048 * 2) + 1024); }
            if (tid < 128) pg = GT[(size_t)nit * 320 + tid]; }
        __syncthreads();
        f32x4 sa[1][2]; sa[0][0] = (f32x4){0.f, 0.f, 0.f, 0.f}; sa[0][1] = sa[0][0];
        wgemm<1, 2, 128, 136, 136>(sa, Qs + 16 * wh * 136, Ks + 32 * wl * 136, lane);
        float rs[4] = {0.f, 0.f, 0.f, 0.f};
#pragma unroll
        for (int e = 0; e < 4; ++e) { const int t = 16 * wh + 4 * fq + e; const float mx = fMX[t];
#pragma unroll
            for (int j = 0; j < 2; ++j) { const int sidx = 32 * wl + 16 * j + fr; const float wgt = (sidx <= t) ? SCALE * __expf(fA[sidx] - mx) : 0.f; const float p = sa[0][j][e] * wgt;
                Ps[t * 72 + sidx] = (bf16)f2bf(p); rs[e] += p; } }
#pragma unroll
        for (int e = 0; e < 4; ++e) { float r = rs[e]; r += __shfl_xor(r, 1); r += __shfl_xor(r, 2); r += __shfl_xor(r, 4); r += __shfl_xor(r, 8); if (fr == 0) DENP[(size_t)item * 128 + wl * 64 + 16 * wh + 4 * fq + e] = r; }
        __syncthreads();
        *(v4u*)(PMA + (size_t)item * 4096 + (tid >> 3) * 64 + (tid & 7) * 8) = *(const LAS v4u*)(Ps + (tid >> 3) * 72 + (tid & 7) * 8);
    }
}
__device__ __forceinline__ void mlstm_core(Frame& F, const bf16* QKV, const float* GT, const bf16* PMA, const float* DENP, bf16* hout, float* ssq) {
    constexpr float SCALE = 0.08838834764831845f;
    LAS bf16* Qs = (LAS bf16*)F.lds;
    LAS bf16* Ks = Qs + 64 * 136;
    LAS bf16* Vs = Ks + 64 * 136;
    LAS bf16* VWs = Vs + 64 * 88;
    LAS bf16* Cb = VWs + 64 * 88;
    LAS bf16* Ps = Cb + 80 * 136;
    LAS bf16* Hs = Ps + 64 * 72;
    const int tid = F.tid, lane = F.lane, w = F.wave, fr = lane & 15, fq = lane >> 4, wh = w >> 1, wl = w & 1;
    const unsigned qoff0 = (unsigned)((((tid >> 4) * 2048) + (tid & 15) * 8) * 2), voff0 = (unsigned)((((tid >> 3) * 2048) + (tid & 7) * 8) * 2);
    for (int item = blockIdx.x; item < 256; item += F.G) {
        const int b = item >> 4, h = (item >> 2) & 3, vs = item & 3, bh = b * 4 + h;
        f32x4 Cacc[1][4], Cn[1][1];
#pragma unroll
        for (int j = 0; j < 4; ++j) Cacc[0][j] = (f32x4){0.f, 0.f, 0.f, 0.f};
        Cn[0][0] = (f32x4){0.f, 0.f, 0.f, 0.f};
        const size_t tb = (size_t)b * SEQ;
        v4u pQ[2], pK[2], pV, pP; float pws, pwc, pwi[4], pem[4], pdn[4];
#define MLSTM_FETCH(cc) do { const size_t t0_ = tb + (size_t)(cc) * 64; const char* gq_ = (const char*)(QKV + t0_ * 2048 + h * 128); const char* gv_ = (const char*)(QKV + t0_ * 2048 + 1024 + h * 256 + vs * 64); \
            _Pragma("unroll") for (int i = 0; i < 2; ++i) { pQ[i] = *(const v4u*)(gq_ + qoff0 + i * (32 * 2048 * 2)); pK[i] = *(const v4u*)(gq_ + qoff0 + i * (32 * 2048 * 2) + 1024); } \
            pV = *(const v4u*)(gv_ + voff0); const size_t it_ = (size_t)(bh * 32 + (cc)); pP = *(const v4u*)(PMA + it_ * 4096 + (tid >> 3) * 64 + (tid & 7) * 8); \
            const float* g_ = GT + it_ * 320; pws = g_[256 + (tid >> 3)]; pwc = g_[128 + 63]; \
            _Pragma("unroll") for (int e = 0; e < 4; ++e) { const int t_ = 16 * wh + 4 * fq + e; pwi[e] = g_[128 + t_]; pem[e] = g_[192 + t_]; pdn[e] = DENP[it_ * 128 + t_] + DENP[it_ * 128 + 64 + t_]; } } while (0)
        MLSTM_FETCH(0);
        for (int c = 0; c < 32; ++c) {
            const size_t t0 = tb + c * 64;
            __syncthreads();
            v4u hprev; if (c > 0) hprev = *(const LAS v4u*)(Hs + (tid >> 3) * 72 + (tid & 7) * 8);
#pragma unroll
            for (int j = 0; j < 4; ++j)
#pragma unroll
                for (int e = 0; e < 4; ++e) Cb[(16 * wh + 4 * fq + e) * 136 + 64 * wl + 16 * j + fr] = (bf16)f2bf(Cacc[0][j][e]);
#pragma unroll
            for (int e = 0; e < 4; ++e) Cb[(64 + 4 * fq + e) * 136 + 16 * w + fr] = (bf16)f2bf(Cn[0][0][e]);
#pragma unroll
            for (int i = 0; i < 2; ++i) { const int id = tid + NTHR * i, row = id >> 4, c8 = id & 15; *(LAS v4u*)(Qs + row * 136 + c8 * 8) = pQ[i]; *(LAS v4u*)(Ks + row * 136 + c8 * 8) = pK[i]; }
            { const int srow = tid >> 3, c8 = tid & 7; const float wsv = pws;
                *(LAS v4u*)(Vs + srow * 88 + c8 * 8) = pV;
                v4u o; o.x = cvtpk(lo_bf(pV.x) * wsv, hi_bf(pV.x) * wsv); o.y = cvtpk(lo_bf(pV.y) * wsv, hi_bf(pV.y) * wsv); o.z = cvtpk(lo_bf(pV.z) * wsv, hi_bf(pV.z) * wsv); o.w = cvtpk(lo_bf(pV.w) * wsv, hi_bf(pV.w) * wsv);
                *(LAS v4u*)(VWs + srow * 88 + c8 * 8) = o;
                if (c8 < 2) { v4u one; one.x = c8 == 0 ? 0x3f80u : 0u; one.y = 0u; one.z = 0u; one.w = 0u; *(LAS v4u*)(Vs + srow * 88 + 64 + c8 * 8) = one;
                    v4u wv; wv.x = c8 == 0 ? (cvtpk(wsv, 0.f) & 0xffffu) : 0u; wv.y = 0u; wv.z = 0u; wv.w = 0u; *(LAS v4u*)(VWs + srow * 88 + 64 + c8 * 8) = wv; }
                *(LAS v4u*)(Ps + srow * 72 + c8 * 8) = pP; }
            float wi[4], em[4], dn[4]; const float wc = pwc;
#pragma unroll
            for (int e = 0; e < 4; ++e) { wi[e] = pwi[e]; em[e] = pem[e]; dn[e] = pdn[e]; }
            if (c < 31) MLSTM_FETCH(c + 1);
            if (c > 0) *(v4u*)(hout + (t0 - 64 + (tid >> 3)) * 1024 + h * 256 + vs * 64 + (tid & 7) * 8) = hprev;
            __syncthreads();
            f32x4 ni[1][2], nx[1][2], nq[1][1]; ni[0][0] = (f32x4){0.f, 0.f, 0.f, 0.f}; ni[0][1] = ni[0][0]; nx[0][0] = ni[0][0]; nx[0][1] = ni[0][0]; nq[0][0] = ni[0][0];
            wgemm<1, 2, 64, 72, 88, false, true>(ni, Ps + 16 * wh * 72, Vs + 32 * wl, lane);
            wgemm<1, 2, 128, 136, 136>(nx, Qs + 16 * wh * 136, Cb + 32 * wl * 136, lane);
            wgemm<1, 1, 128, 136, 136>(nq, Qs + 16 * wh * 136, Cb + 64 * 136, lane);
#pragma unroll
            for (int e = 0; e < 4; ++e) { const int t = 16 * wh + 4 * fq + e;
                const float nqt = __shfl(nq[0][0][e], lane & 48);
                const float den = dn[e] + wi[e] * SCALE * nqt; const float inv = 1.0f / fmaxf(fabsf(den), em[e]); float q2 = 0.f;
#pragma unroll
                for (int j = 0; j < 2; ++j) { const float hv = (ni[0][j][e] + SCALE * wi[e] * nx[0][j][e]) * inv; q2 += hv * hv;
                    Hs[t * 72 + 32 * wl + 16 * j + fr] = (bf16)f2bf(hv); }
                q2 += __shfl_xor(q2, 1); q2 += __shfl_xor(q2, 2); q2 += __shfl_xor(q2, 4); q2 += __shfl_xor(q2, 8);
                if (fr == 0) ssq[(t0 + t) * 32 + (h * 4 + vs) * 2 + wl] = q2; }
#pragma unroll
            for (int j = 0; j < 4; ++j) Cacc[0][j] = Cacc[0][j] * wc;
            Cn[0][0] = Cn[0][0] * wc;
            wgemm<1, 4, 64, 88, 136, true, true>(Cacc, VWs + 16 * wh, Ks + 64 * wl, lane);
            wgemm<1, 1, 64, 88, 136, true, true>(Cn, VWs + 64, Ks + 16 * w, lane);
        }
        __syncthreads();
        *(v4u*)(hout + (tb + 31 * 64 + (tid >> 3)) * 1024 + h * 256 + vs * 64 + (tid & 7) * 8) = *(const LAS v4u*)(Hs + (tid >> 3) * 72 + (tid & 7) * 8);
#undef MLSTM_FETCH
    }
}

__device__ __forceinline__ void moba_prep(Frame& F, bf16* QK, const int* pos, const float* gq, const float* gk, float* kpart) {
    LAS float* part = (LAS float*)F.lds;
    const int lane = F.lane, w = F.wave, c = lane & 15;
    float gqv[8], gkv[8], inv[8];
#pragma unroll
    for (int e = 0; e < 8; ++e) { gqv[e] = gq[c * 8 + e]; gkv[e] = gk[c * 8 + e]; inv[e] = exp2f(-(float)(8 * (c & 1) + e) * (18.931568569324174f / 16.0f)); }
    for (int item = blockIdx.x; item < 256; item += F.G) {
        const int b = item >> 4, blk = (item >> 1) & 7, half = item & 1;
        const size_t row0 = (size_t)b * SEQ + blk * 256 + half * 128 + 16 * w;
        float kacc[2][8];
#pragma unroll
        for (int i = 0; i < 2; ++i)
#pragma unroll
            for (int e = 0; e < 8; ++e) kacc[i][e] = 0.f;
        v4u cur[4], nxt[4];
#pragma unroll
        for (int i4 = 0; i4 < 4; ++i4) cur[i4] = *(const v4u*)(QK + row0 * 2048 + (lane + 64 * i4) * 8);
        for (int t = 0; t < 16; ++t) {
            const size_t row = row0 + t;
            if (t < 15) {
#pragma unroll
                for (int i4 = 0; i4 < 4; ++i4) nxt[i4] = *(const v4u*)(QK + (row + 1) * 2048 + (lane + 64 * i4) * 8); }
            float cs[8], sn[8];
            if (c < 4) { const float ps = (float)pos[row];
#pragma unroll
                for (int e = 0; e < 8; ++e) sincosf(ps * inv[e], &sn[e], &cs[e]); }
            else {
#pragma unroll
                for (int e = 0; e < 8; ++e) { cs[e] = 1.f; sn[e] = 0.f; } }
#pragma unroll
            for (int i4 = 0; i4 < 4; ++i4) {
                const unsigned xw[4] = {cur[i4].x, cur[i4].y, cur[i4].z, cur[i4].w}; float y[8]; float ss = 0.f;
#pragma unroll
                for (int e = 0; e < 4; ++e) { y[2 * e] = lo_bf(xw[e]); y[2 * e + 1] = hi_bf(xw[e]); ss += y[2 * e] * y[2 * e] + y[2 * e + 1] * y[2 * e + 1]; }
                ss += __shfl_xor(ss, 1); ss += __shfl_xor(ss, 2); ss += __shfl_xor(ss, 4); ss += __shfl_xor(ss, 8);
                const float rstd = 1.0f / sqrtf(ss * (1.0f / 128.0f) + 1e-6f);
#pragma unroll
                for (int e = 0; e < 8; ++e) { y[e] = y[e] * rstd * (i4 < 2 ? gqv[e] : gkv[e]); }
#pragma unroll
                for (int e = 0; e < 8; ++e) { const float o = __shfl_xor(y[e], 2); y[e] = (c < 2) ? y[e] * cs[e] - o * sn[e] : (c < 4 ? y[e] * cs[e] + o * sn[e] : y[e]); }
                v4u ov; ov.x = cvtpk(y[0], y[1]); ov.y = cvtpk(y[2], y[3]); ov.z = cvtpk(y[4], y[5]); ov.w = cvtpk(y[6], y[7]);
                *(v4u*)(QK + row * 2048 + (lane + 64 * i4) * 8) = ov;
                if (i4 >= 2) {
#pragma unroll
                    for (int e = 0; e < 8; ++e) kacc[i4 - 2][e] += y[e]; }
            }
#pragma unroll
            for (int i4 = 0; i4 < 4; ++i4) cur[i4] = nxt[i4];
        }
        __syncthreads();
#pragma unroll
        for (int i = 0; i < 2; ++i)
#pragma unroll
            for (int e = 0; e < 8; ++e) part[w * 1024 + i * 512 + lane * 8 + e] = kacc[i][e];
        __syncthreads();
        for (int col = F.tid; col < 1024; col += NTHR) { float sacc = 0.f;
#pragma unroll
            for (int ww = 0; ww < 8; ++ww) sacc += part[ww * 1024 + col];
            kpart[((size_t)(b * 8 + blk) * 2 + half) * 1024 + col] = sacc * (1.0f / 256.0f); }
    }
}
__device__ __forceinline__ void moba_attn(Frame& F, const bf16* QK, const bf16* Vt, const float* kpart, bf16* O) {
    constexpr float SCALE = 0.08838834764831845f;
    constexpr int KVB = 64 * 136 + 128 * 72;
    LAS bf16* R = (LAS bf16*)F.lds;
    LAS bf16* Qs = R;
    LAS float* kmS = (LAS float*)(R + 2 * KVB);
    LAS float* gsc = kmS + 1024;
    LAS unsigned* selm = (LAS unsigned*)(gsc + 2048);
    const int tid = F.tid, lane = F.lane, w = F.wave, fr = lane & 15, fq = lane >> 4;
    for (int it = blockIdx.x; it < 1024; it += F.G) {
        const int c = it & 255, r = it >> 8, bh = c & 127, typ = c >> 7, b = bh >> 3, h = bh & 7;
        const int jb = (r & 1) ? 7 - (r >> 1) : (r >> 1);
        const int j = typ ? ((r & 1) ? jb - 2 : jb + 2) : jb;
        const size_t qrow0 = (size_t)b * SEQ + j * 256;
        __syncthreads();
#pragma unroll
        for (int i = 0; i < 8; ++i) { const int id = tid + NTHR * i, row = id >> 4, c8 = id & 15;
            *(LAS v4u*)(Qs + row * 136 + c8 * 8) = *(const v4u*)(QK + (qrow0 + row) * 2048 + h * 128 + c8 * 8); }
        for (int i = tid; i < 1024; i += NTHR) { const int kb_ = i >> 7, d_ = i & 127; const float* kp = kpart + ((size_t)(b * 8 + kb_) * 2) * 1024 + h * 128 + d_; kmS[i] = kp[0] + kp[1024]; }
        __syncthreads();
        if (j > 3) { const int q = tid >> 1, p = tid & 1;
            for (int e = 0; e < 4; ++e) { const int blk = 4 * p + e; float sdot = 0.f;
                if (blk < j) { for (int d = 0; d < 128; ++d) sdot += bf2f(Qs[q * 136 + d]) * kmS[blk * 128 + d]; }
                gsc[q * 8 + blk] = sdot; } }
        __syncthreads();
        if (tid < 256) { unsigned mask = 0u;
            if (j <= 3) mask = (1u << j) - 1u;
            else { for (int k = 0; k < 3; ++k) { float best = -INFINITY; int bi = 0;
                    for (int blk = 0; blk < j; ++blk) { const float gv = gsc[tid * 8 + blk]; if (!((mask >> blk) & 1u) && gv > best) { best = gv; bi = blk; } }
                    mask |= 1u << bi; } }
            selm[tid] = mask; }
        bf16x8 qf[2][4];
#pragma unroll
        for (int i = 0; i < 2; ++i)
#pragma unroll
            for (int ks = 0; ks < 4; ++ks) qf[i][ks] = *(const LAS bf16x8*)(Qs + (32 * w + 16 * i + fr) * 136 + 32 * ks + 8 * fq);
        __syncthreads();
        const unsigned masks = selm[32 * w + fr] | (selm[32 * w + 16 + fr] << 8);
        f32x4 oacc[2][8];
#pragma unroll
        for (int i = 0; i < 2; ++i)
#pragma unroll
            for (int vt = 0; vt < 8; ++vt) oacc[i][vt] = (f32x4){0.f, 0.f, 0.f, 0.f};
        float mrun[2] = {-INFINITY, -INFINITY}, lrun[2] = {0.f, 0.f};
        const int ntile = 4 * j + 4;
        const bf16* kbase = QK + ((size_t)b * SEQ) * 2048 + 1024 + h * 128;
        const bf16* vbase = Vt + ((size_t)h * 128) * MTOK + (size_t)b * SEQ;
        v4u pk[2], pv[2];
#define KOFF(id) ((unsigned)((((id) >> 4) * 2048 + ((id) & 15) * 8) * 2))
#define VOFF(id) ((unsigned)((((id) >> 3) * MTOK + ((id) & 7) * 8) * 2))
#pragma unroll
        for (int i = 0; i < 2; ++i) { const int id = tid + NTHR * i; pk[i] = *(const v4u*)((const char*)kbase + KOFF(id)); pv[i] = *(const v4u*)((const char*)vbase + VOFF(id)); }
#pragma unroll
        for (int i = 0; i < 2; ++i) { const int id = tid + NTHR * i; *(LAS v4u*)(R + (id >> 4) * 136 + (id & 15) * 8) = pk[i]; *(LAS v4u*)(R + 64 * 136 + (id >> 3) * 72 + (id & 7) * 8) = pv[i]; }
        __syncthreads();
        for (int tile = 0; tile < ntile; ++tile) {
            const int kb = tile >> 2, key0 = tile * 64;
            LAS bf16* Ks = R + (tile & 1) * KVB; LAS bf16* VTs = Ks + 64 * 136;
            int tl = tid; asm volatile("" : "+v"(tl));
            if (tile + 1 < ntile) {
#pragma unroll
                for (int i = 0; i < 2; ++i) { const int id = tl + NTHR * i; pk[i] = *(const v4u*)((const char*)(kbase + (size_t)(key0 + 64) * 2048) + KOFF(id)); pv[i] = *(const v4u*)((const char*)(vbase + key0 + 64) + VOFF(id)); } }
            const bool own = (kb == j);
            const bool sel0 = own || ((masks >> kb) & 1u), sel1 = own || ((masks >> (8 + kb)) & 1u);
            const bool active = own ? (key0 - j * 256 <= 32 * w + 31) : (__ballot(sel0 || sel1) != 0ull);
            if (active) {
                f32x4 st[2][4];
#pragma unroll
                for (int kt = 0; kt < 4; ++kt) { st[0][kt] = (f32x4){0.f, 0.f, 0.f, 0.f}; st[1][kt] = st[0][kt];
#pragma unroll
                    for (int ks = 0; ks < 4; ++ks) { const bf16x8 kf = *(const LAS bf16x8*)(Ks + (16 * kt + fr) * 136 + 32 * ks + 8 * fq);
                        st[0][kt] = __builtin_amdgcn_mfma_f32_16x16x32_bf16(kf, qf[0][ks], st[0][kt], 0, 0, 0);
                        st[1][kt] = __builtin_amdgcn_mfma_f32_16x16x32_bf16(kf, qf[1][ks], st[1][kt], 0, 0, 0); } }
#if !defined(ATT_NOSB)
                __builtin_amdgcn_sched_barrier(0);
#endif
                bf16x8 pf[2][2]; float alpha[2];
                constexpr float C2 = SCALE * 1.4426950408889634f;
#pragma unroll
                for (int i = 0; i < 2; ++i) {
                    const bool lsel = i ? sel1 : sel0;
                    float mloc = -INFINITY;
                    if (own) { const int qpos = j * 256 + 32 * w + 16 * i + fr;
#pragma unroll
                        for (int kt = 0; kt < 4; ++kt)
#pragma unroll
                            for (int e = 0; e < 4; ++e) { const int kpos = key0 + 16 * kt + 4 * fq + e; const float sv = (kpos <= qpos) ? st[i][kt][e] : -INFINITY; st[i][kt][e] = sv; mloc = fmaxf(mloc, sv); } }
                    else {
#pragma unroll
                        for (int kt = 0; kt < 4; ++kt)
#pragma unroll
                            for (int e = 0; e < 4; ++e) mloc = fmaxf(mloc, st[i][kt][e]); }
                    mloc = fmaxf(mloc, __shfl_xor(mloc, 16)); mloc = fmaxf(mloc, __shfl_xor(mloc, 32));
                    const float mnew = lsel ? fmaxf(mrun[i], mloc * C2) : mrun[i], msafe = (mnew == -INFINITY) ? 0.f : mnew;
                    alpha[i] = __builtin_amdgcn_exp2f(mrun[i] - msafe);
                    const float moff = lsel ? msafe : INFINITY;
                    float psum = 0.f;
#pragma unroll
                    for (int kk = 0; kk < 2; ++kk) { float pp[8];
#pragma unroll
                        for (int e = 0; e < 4; ++e) { pp[e] = __builtin_amdgcn_exp2f(__builtin_fmaf(st[i][2 * kk][e], C2, -moff)); pp[4 + e] = __builtin_amdgcn_exp2f(__builtin_fmaf(st[i][2 * kk + 1][e], C2, -moff)); }
#pragma unroll
                        for (int e = 0; e < 8; ++e) psum += pp[e];
                        u32x4 pw; pw.x = cvtpk(pp[0], pp[1]); pw.y = cvtpk(pp[2], pp[3]); pw.z = cvtpk(pp[4], pp[5]); pw.w = cvtpk(pp[6], pp[7]);
                        pf[i][kk] = __builtin_bit_cast(bf16x8, pw); }
                    lrun[i] = lrun[i] * alpha[i] + psum; mrun[i] = mnew;
                }
                const bool rescale = __ballot(alpha[0] != 1.0f || alpha[1] != 1.0f) != 0ull;
#if !defined(ATT_NOSB)
                __builtin_amdgcn_sched_barrier(0);
#endif
#pragma unroll
                for (int vt = 0; vt < 8; ++vt) { if (rescale) { oacc[0][vt] = oacc[0][vt] * alpha[0]; oacc[1][vt] = oacc[1][vt] * alpha[1]; }
#pragma unroll
                    for (int kk = 0; kk < 2; ++kk) { const LAS bf16* vp = VTs + (16 * vt + fr) * 72 + 32 * kk + 4 * fq;
                        const u32x2 v0 = *(const LAS u32x2*)vp, v1 = *(const LAS u32x2*)(vp + 16);
                        u32x4 vw; vw.x = v0.x; vw.y = v0.y; vw.z = v1.x; vw.w = v1.y; const bf16x8 vf = __builtin_bit_cast(bf16x8, vw);
                        oacc[0][vt] = __builtin_amdgcn_mfma_f32_16x16x32_bf16(vf, pf[0][kk], oacc[0][vt], 0, 0, 0);
                        oacc[1][vt] = __builtin_amdgcn_mfma_f32_16x16x32_bf16(vf, pf[1][kk], oacc[1][vt], 0, 0, 0); } }
            }
            if (tile + 1 < ntile) { LAS bf16* Kn = R + ((tile + 1) & 1) * KVB;
#pragma unroll
                for (int i = 0; i < 2; ++i) { const int id = tl + NTHR * i; *(LAS v4u*)(Kn + (id >> 4) * 136 + (id & 15) * 8) = pk[i]; *(LAS v4u*)(Kn + 64 * 136 + (id >> 3) * 72 + (id & 7) * 8) = pv[i]; } }
            __syncthreads();
        }
#undef KOFF
#undef VOFF
#pragma unroll
        for (int i = 0; i < 2; ++i) { float l = lrun[i]; l += __shfl_xor(l, 16); l += __shfl_xor(l, 32); const float il = 1.0f / l;
            bf16* orow = O + (qrow0 + 32 * w + 16 * i + fr) * 1024 + h * 128;
#pragma unroll
            for (int vt = 0; vt < 8; ++vt) { u32x2 o; o.x = cvtpk(oacc[i][vt][0] * il, oacc[i][vt][1] * il); o.y = cvtpk(oacc[i][vt][2] * il, oacc[i][vt][3] * il);
                *(u32x2*)(orow + 16 * vt + 4 * fq) = o; } }
    }
}

__device__ __forceinline__ void ret_rot_table(Frame& F, const int* pos, float* cst) {
    const int gw = blockIdx.x * NWAVES + F.wave, NGW = F.G * NWAVES, lane = F.lane;
    const float i0 = exp2f(-(float)(2 * lane) * (13.287712379549449f / 128.0f)), i1 = exp2f(-(float)(2 * lane + 1) * (13.287712379549449f / 128.0f));
    for (int m = gw; m < MTOK; m += NGW) {
        const float ps = (float)pos[m]; float s0, c0, s1, c1; sincosf(ps * i0, &s0, &c0); sincosf(ps * i1, &s1, &c1);
        f32x2* cp = (f32x2*)(cst + (size_t)m * 256) + lane; cp[0] = (f32x2){c0, c1}; cp[64] = (f32x2){s0, s1};
    }
}
__device__ __forceinline__ void ret_pmat(Frame& F, const bf16* QKV, bf16* PM) {
    LAS bf16* Qd = (LAS bf16*)F.lds;
    LAS bf16* Kd = Qd + 128 * 72;
    LAS bf16* Ps = Kd + 128 * 72;
    const int tid = F.tid, lane = F.lane, w = F.wave, fr = lane & 15, fq = lane >> 4, wh = w >> 1, wl = w & 1;
    const unsigned off0 = (unsigned)((((tid >> 3) * 4096) + (tid & 7) * 8) * 2);
    for (int item = blockIdx.x; item < 1024; item += F.G) {
        const int b = item >> 6, h = (item >> 4) & 3, c = item & 15;
        const float lgc = log1pf(-exp2f(-5.0f - (float)h)) * 1.4426950408889634f;
        const char* gq = (const char*)(QKV + ((size_t)b * SEQ + c * 128) * 4096 + h * 256);
        v4u pq[2], pkk[2];
#pragma unroll
        for (int i = 0; i < 2; ++i) { const char* src = gq + off0 + i * (64 * 4096 * 2); pq[i] = *(const v4u*)src; pkk[i] = *(const v4u*)(src + 2048); }
        f32x4 S[2][4];
#pragma unroll
        for (int i = 0; i < 2; ++i)
#pragma unroll
            for (int jj = 0; jj < 4; ++jj) S[i][jj] = (f32x4){0.f, 0.f, 0.f, 0.f};
#pragma unroll 1
        for (int dt = 0; dt < 4; ++dt) {
            __syncthreads();
#pragma unroll
            for (int i = 0; i < 2; ++i) { const int id = tid + NTHR * i, row = id >> 3, c8 = id & 7; *(LAS v4u*)(Qd + row * 72 + c8 * 8) = pq[i]; *(LAS v4u*)(Kd + row * 72 + c8 * 8) = pkk[i]; }
            if (dt < 3) {
#pragma unroll
                for (int i = 0; i < 2; ++i) { const char* src = gq + (dt + 1) * 128 + off0 + i * (64 * 4096 * 2); pq[i] = *(const v4u*)src; pkk[i] = *(const v4u*)(src + 2048); } }
            __syncthreads();
            wgemm<2, 4, 64, 72, 72>(S, Qd + 32 * wh * 72, Kd + 64 * wl * 72, lane);
        }
#pragma unroll
        for (int i = 0; i < 2; ++i)
#pragma unroll
            for (int e = 0; e < 4; ++e) { const int t = 32 * wh + 16 * i + 4 * fq + e;
#pragma unroll
                for (int jj = 0; jj < 4; ++jj) { const int sidx = 64 * wl + 16 * jj + fr; const float wgt = (t >= sidx) ? __builtin_amdgcn_exp2f((float)(t - sidx) * lgc) : 0.f;
                    Ps[t * 136 + sidx] = (bf16)f2bf(S[i][jj][e] * wgt); } }
        __syncthreads();
        bf16* dst = PM + (size_t)item * 128 * 128;
#pragma unroll
        for (int i = 0; i < 4; ++i) { const int id = tid + NTHR * i, row = id >> 4, c8 = id & 15; *(v4u*)(dst + row * 128 + c8 * 8) = *(const LAS v4u*)(Ps + row * 136 + c8 * 8); }
    }
}
#ifndef RET_EXP
#define RET_EXP 0
#endif
__device__ __forceinline__ void ret_core(Frame& F, bf16* QKV, const bf16* PM, float* st) {
    constexpr int TSET = 3 * 128 * 72;
    LAS bf16* T0 = (LAS bf16*)F.lds;
    LAS bf16* Vs = T0 + 2 * TSET;
    LAS bf16* Ps = T0;
    LAS bf16* Xs = T0 + TSET;
    LAS float* fST = (LAS float*)(Vs + 128 * 136);
    const int tid = F.tid, lane = F.lane, w = F.wave, fr = lane & 15, fq = lane >> 4, wh = w >> 1, wl = w & 1;
    const unsigned off8 = (unsigned)((((tid >> 3) * 4096) + (tid & 7) * 8) * 2);
    const unsigned off16 = (unsigned)((((tid >> 4) * 4096) + (tid & 15) * 8) * 2);
    for (int item = blockIdx.x; item < 256; item += F.G) {
        const int b = item >> 4, h = (item >> 2) & 3, vs = item & 3;
        const float lg = log1pf(-exp2f(-5.0f - (float)h)), gch = expf(128.0f * lg);
        f32x4 Racc[4][1][4];
#pragma unroll
        for (int dt = 0; dt < 4; ++dt)
#pragma unroll
            for (int jj = 0; jj < 4; ++jj) Racc[dt][0][jj] = (f32x4){0.f, 0.f, 0.f, 0.f};
        const size_t tb = (size_t)b * SEQ;
        __syncthreads();
        v4u pq[2], pkk[2], pv[4];
        { const char* gq0 = (const char*)(QKV + tb * 4096 + h * 256); const char* gv0 = (const char*)(QKV + tb * 4096 + 2048 + h * 512 + vs * 128);
#pragma unroll
            for (int i = 0; i < 2; ++i) { const char* src = gq0 + off8 + i * (64 * 4096 * 2); pq[i] = *(const v4u*)src; pkk[i] = *(const v4u*)(src + 2048); }
#pragma unroll
            for (int i = 0; i < 4; ++i) pv[i] = *(const v4u*)(gv0 + off16 + i * (32 * 4096 * 2)); }
        for (int c = 0; c < 16; ++c) {
            const size_t t0 = tb + c * 128;
            const char* gq = (const char*)(QKV + t0 * 4096 + h * 256);
            char* gy = (char*)(QKV + t0 * 4096 + 2048 + h * 512 + vs * 128);
            const bf16* pmt = PM + ((size_t)((b * 4 + h) * 16 + c)) * 128 * 128;
            float lgc = lg * 1.4426950408889634f; asm volatile("" : "+v"(lgc));
#pragma unroll
            for (int i = 0; i < 4; ++i) { const int id = tid + NTHR * i; *(LAS v4u*)(Vs + (id >> 4) * 136 + (id & 15) * 8) = pv[i]; }
            f32x4 X[2][4];
#pragma unroll
            for (int i = 0; i < 2; ++i)
#pragma unroll
                for (int jj = 0; jj < 4; ++jj) X[i][jj] = (f32x4){0.f, 0.f, 0.f, 0.f};
#pragma unroll 1
            for (int dt = 0; dt < 4; ++dt) {
                LAS bf16* Qd = T0 + (dt & 1) * TSET; LAS bf16* Kz = Qd + 128 * 72; LAS bf16* Rb = Kz + 128 * 72;
#pragma unroll
                for (int i = 0; i < 2; ++i) { const int id = tid + NTHR * i, row = id >> 3, c8 = id & 7; const float z = __builtin_amdgcn_exp2f((float)(127 - row) * lgc);
                    *(LAS v4u*)(Qd + row * 72 + c8 * 8) = pq[i];
                    v4u zo; zo.x = cvtpk(lo_bf(pkk[i].x) * z, hi_bf(pkk[i].x) * z); zo.y = cvtpk(lo_bf(pkk[i].y) * z, hi_bf(pkk[i].y) * z); zo.z = cvtpk(lo_bf(pkk[i].z) * z, hi_bf(pkk[i].z) * z); zo.w = cvtpk(lo_bf(pkk[i].w) * z, hi_bf(pkk[i].w) * z);
                    *(LAS v4u*)(Kz + row * 72 + c8 * 8) = zo; }
#pragma unroll
                for (int jj = 0; jj < 4; ++jj)
#pragma unroll
                    for (int e = 0; e < 4; ++e) Rb[(16 * w + 4 * fq + e) * 72 + 16 * jj + fr] = (bf16)f2bf(Racc[0][0][jj][e]);
#if RET_EXP == 3
                asm volatile("" ::: "memory");
#pragma unroll
                for (int jj = 0; jj < 4; ++jj)
#pragma unroll
                    for (int e = 0; e < 4; ++e) *(volatile LAS bf16*)(Rb + (16 * w + 4 * fq + e) * 72 + 16 * jj + fr) = (bf16)f2bf(Racc[0][0][jj][e]);
#endif
                if (dt < 3 || c < 15) {
                    const char* nb = (dt < 3) ? gq + (dt + 1) * 128 : gq + (size_t)128 * 4096 * 2;
#pragma unroll
                    for (int i = 0; i < 2; ++i) { const char* src = nb + off8 + i * (64 * 4096 * 2); pq[i] = *(const v4u*)src; pkk[i] = *(const v4u*)(src + 2048); } }
                __syncthreads();
                wgemm<2, 4, 64, 72, 72, false, false, false>(X, Qd + 32 * wh * 72, Rb + 64 * wl * 72, lane);
#if RET_EXP == 5
                { f32x4 D_[2][4];
#pragma unroll
                  for (int i = 0; i < 2; ++i)
#pragma unroll
                    for (int jj = 0; jj < 4; ++jj) D_[i][jj] = (f32x4){0.f, 0.f, 0.f, 0.f};
                  wgemm<2, 4, 64, 72, 72>(D_, Qd + 32 * wh * 72, Rb + 64 * wl * 72, lane);
#pragma unroll
                  for (int i = 0; i < 2; ++i)
#pragma unroll
                    for (int jj = 0; jj < 4; ++jj) asm volatile("" :: "v"(D_[i][jj])); }
#endif
#if RET_EXP == 6
                { f32x4 D_[1][4];
#pragma unroll
                    for (int jj = 0; jj < 4; ++jj) D_[0][jj] = (f32x4){0.f, 0.f, 0.f, 0.f};
                  wgemm<1, 4, 128, 136, 72, true, true>(D_, Vs + 16 * w, Kz, lane);
#pragma unroll
                    for (int jj = 0; jj < 4; ++jj) asm volatile("" :: "v"(D_[0][jj])); }
#endif
#pragma unroll
                for (int jj = 0; jj < 4; ++jj) Racc[0][0][jj] = Racc[0][0][jj] * gch;
                wgemm<1, 4, 128, 136, 72, true, true, false>(Racc[0], Vs + 16 * w, Kz, lane);
#pragma unroll
                for (int jj = 0; jj < 4; ++jj) { const f32x4 t_ = Racc[0][0][jj]; Racc[0][0][jj] = Racc[1][0][jj]; Racc[1][0][jj] = Racc[2][0][jj]; Racc[2][0][jj] = Racc[3][0][jj]; Racc[3][0][jj] = t_; }
            }
            v4u pp[4];
#pragma unroll
            for (int i = 0; i < 4; ++i) { const int id = tid + NTHR * i; pp[i] = *(const v4u*)(pmt + (id >> 4) * 128 + (id & 15) * 8); }
#if RET_EXP == 2
            asm volatile("s_waitcnt vmcnt(0)" ::: "memory");
#pragma unroll
            for (int i = 0; i < 4; ++i) { const int id = tid + NTHR * i; v4u q_ = *(const volatile v4u*)(pmt + 64 * 128 * 128 + (id >> 4) * 128 + (id & 15) * 8); asm volatile("" :: "v"(q_.x), "v"(q_.y), "v"(q_.z), "v"(q_.w)); }
            asm volatile("s_waitcnt vmcnt(0)" ::: "memory");
#endif
#pragma unroll
            for (int i = 0; i < 2; ++i)
#pragma unroll
                for (int e = 0; e < 4; ++e) { const int t = 32 * wh + 16 * i + 4 * fq + e; const float xi = __builtin_amdgcn_exp2f((float)(t + 1) * lgc);
#pragma unroll
                    for (int jj = 0; jj < 4; ++jj) X[i][jj][e] *= xi; }
#pragma unroll
            for (int i = 0; i < 4; ++i) { const int id = tid + NTHR * i; *(LAS v4u*)(Ps + (id >> 4) * 136 + (id & 15) * 8) = pp[i]; }
            __syncthreads();
            wgemm<2, 4, 128, 136, 136, false, true, false>(X, Ps + 32 * wh * 136, Vs + 64 * wl, lane);
#pragma unroll
            for (int i = 0; i < 2; ++i)
#pragma unroll
                for (int e = 0; e < 4; ++e) { const int t = 32 * wh + 16 * i + 4 * fq + e; float s1 = 0.f, s2 = 0.f;
#pragma unroll
                    for (int jj = 0; jj < 4; ++jj) { const float y = X[i][jj][e]; s1 += y; s2 += y * y; Xs[t * 136 + 64 * wl + 16 * jj + fr] = (bf16)f2bf(y); }
                    s1 += __shfl_xor(s1, 1); s1 += __shfl_xor(s1, 2); s1 += __shfl_xor(s1, 4); s1 += __shfl_xor(s1, 8);
                    s2 += __shfl_xor(s2, 1); s2 += __shfl_xor(s2, 2); s2 += __shfl_xor(s2, 4); s2 += __shfl_xor(s2, 8);
                    if (fr == 0) { fST[(wl * 128 + t) * 2] = s1; fST[(wl * 128 + t) * 2 + 1] = s2; } }
            if (c < 15) { const char* gvn = gy + (size_t)128 * 4096 * 2;
#pragma unroll
                for (int i = 0; i < 4; ++i) pv[i] = *(const v4u*)(gvn + off16 + i * (32 * 4096 * 2)); }
            __syncthreads();
#pragma unroll
            for (int i = 0; i < 4; ++i) { const int id = tid + NTHR * i, row = id >> 4, c8 = id & 15; *(v4u*)(gy + (unsigned)((row * 4096 + c8 * 8) * 2)) = *(const LAS v4u*)(Xs + row * 136 + c8 * 8); }
            if (tid < 128) { float* sp = st + (t0 + tid) * 32 + (h * 4 + vs) * 2; sp[0] = fST[tid * 2] + fST[(128 + tid) * 2]; sp[1] = fST[tid * 2 + 1] + fST[(128 + tid) * 2 + 1]; }
        }
    }
}

__device__ __forceinline__ void lru_conv(Frame& F, const bf16* GX, const float* cw, const float* cb, bf16* XC, const float* lru, float* sptab) {
    if (blockIdx.x == 0) for (int i = F.tid; i < 1024; i += NTHR) { const float l = -lru[i]; sptab[i] = fmaxf(l, 0.f) + log1pf(expf(-fabsf(l))); }
    const int c8 = F.tid & 127, rsub = F.tid >> 7;
    f32x4 w0[4], w1[4];
#pragma unroll
    for (int wv = 0; wv < 4; ++wv) { w0[wv] = *(const f32x4*)(cw + wv * 1024 + c8 * 8); w1[wv] = *(const f32x4*)(cw + wv * 1024 + c8 * 8 + 4); }
    const f32x4 b0 = *(const f32x4*)(cb + c8 * 8), b1 = *(const f32x4*)(cb + c8 * 8 + 4);
    for (int r0 = blockIdx.x * 16; r0 < MTOK; r0 += F.G * 16) {
        const int rb = r0 + 4 * rsub, t = rb & (SEQ - 1);
        v4u xin[7];
#pragma unroll
        for (int k = 0; k < 7; ++k) { const int rr = rb - 3 + k; xin[k] = (t - 3 + k >= 0) ? *(const v4u*)(GX + (size_t)rr * 2048 + 1024 + c8 * 8) : (v4u){0u, 0u, 0u, 0u}; }
#pragma unroll
        for (int q = 0; q < 4; ++q) { f32x4 a0 = b0, a1 = b1;
#pragma unroll
            for (int wv = 0; wv < 4; ++wv) { const v4u x = xin[q + wv];
                a0 += (f32x4){lo_bf(x.x), hi_bf(x.x), lo_bf(x.y), hi_bf(x.y)} * w0[wv]; a1 += (f32x4){lo_bf(x.z), hi_bf(x.z), lo_bf(x.w), hi_bf(x.w)} * w1[wv]; }
            v4u o; o.x = cvtpk(a0[0], a0[1]); o.y = cvtpk(a0[2], a0[3]); o.z = cvtpk(a1[0], a1[1]); o.w = cvtpk(a1[2], a1[3]);
            *(v4u*)(XC + (size_t)(rb + q) * 1024 + c8 * 8) = o; }
    }
}
__device__ __forceinline__ float gelu_tanh(float x) { const float z = 0.7978845608028654f * (x + 0.044715f * x * x * x); const float e = __expf(2.0f * z); const float th = 1.0f - 2.0f * __builtin_amdgcn_rcpf(e + 1.0f); return 0.5f * x * (1.0f + th); }
__device__ __forceinline__ void lru_scan(Frame& F, const bf16* LA, const bf16* BT, const bf16* GX, bf16* Y) {
    LAS float* segL = (LAS float*)F.lds;
    LAS float* segH = segL + 512;
    const int lane = F.lane, w = F.wave;
    for (int item = blockIdx.x; item < 256; item += F.G) {
        const int b = item >> 4, ch = (item & 15) * 64 + lane;
        const size_t r0 = (size_t)b * SEQ + w * 256;
        const bf16* la_p = LA + r0 * 1024 + ch; const bf16* bt_p = BT + r0 * 1024 + ch; const bf16* gx_p = GX + r0 * 2048 + ch; bf16* y_p = Y + r0 * 1024 + ch;
        float L = 0.f, H = 0.f;
        bf16 la0[16], bt0[16], la1[16], bt1[16];
#pragma unroll
        for (int k = 0; k < 16; ++k) { la0[k] = la_p[(size_t)k * 1024]; bt0[k] = bt_p[(size_t)k * 1024]; }
#pragma unroll 1
        for (int tb = 0; tb < 16; tb += 2) {
#pragma unroll
            for (int k = 0; k < 16; ++k) { la1[k] = la_p[(size_t)((tb + 1) * 16 + k) * 1024]; bt1[k] = bt_p[(size_t)((tb + 1) * 16 + k) * 1024]; }
#pragma unroll
            for (int k = 0; k < 16; ++k) { const float la = bf2f(la0[k]); L += la; H = __expf(la) * H + bf2f(bt0[k]); }
            if (tb + 2 < 16) {
#pragma unroll
                for (int k = 0; k < 16; ++k) { la0[k] = la_p[(size_t)((tb + 2) * 16 + k) * 1024]; bt0[k] = bt_p[(size_t)((tb + 2) * 16 + k) * 1024]; } }
#pragma unroll
            for (int k = 0; k < 16; ++k) { const float la = bf2f(la1[k]); L += la; H = __expf(la) * H + bf2f(bt1[k]); }
        }
        __syncthreads();
        segL[w * 64 + lane] = L; segH[w * 64 + lane] = H;
        __syncthreads();
        float hc = 0.f;
        for (int sg = 0; sg < w; ++sg) hc = __expf(segL[sg * 64 + lane]) * hc + segH[sg * 64 + lane];
        bf16 g0[16], g1[16];
#pragma unroll
        for (int k = 0; k < 16; ++k) { la0[k] = la_p[(size_t)k * 1024]; bt0[k] = bt_p[(size_t)k * 1024]; g0[k] = gx_p[(size_t)k * 2048]; }
#pragma unroll
        for (int k = 0; k < 16; ++k) { const size_t t = (size_t)(16 + k); la1[k] = la_p[t * 1024]; bt1[k] = bt_p[t * 1024]; g1[k] = gx_p[t * 2048]; }
#pragma unroll 1
        for (int tb = 0; tb < 16; tb += 2) {
            bf16 yv[16];
#pragma unroll
            for (int k = 0; k < 16; ++k) { hc = __expf(bf2f(la0[k])) * hc + bf2f(bt0[k]); yv[k] = (bf16)f2bf(hc * gelu_tanh(bf2f(g0[k]))); }
            if (tb + 2 < 16) {
#pragma unroll
                for (int k = 0; k < 16; ++k) { const size_t t = (size_t)((tb + 2) * 16 + k); la0[k] = la_p[t * 1024]; bt0[k] = bt_p[t * 1024]; g0[k] = gx_p[t * 2048]; } }
#pragma unroll
            for (int k = 0; k < 16; ++k) y_p[(size_t)(tb * 16 + k) * 1024] = yv[k];
#pragma unroll
            for (int k = 0; k < 16; ++k) { hc = __expf(bf2f(la1[k])) * hc + bf2f(bt1[k]); yv[k] = (bf16)f2bf(hc * gelu_tanh(bf2f(g1[k]))); }
            if (tb + 3 < 16) {
#pragma unroll
                for (int k = 0; k < 16; ++k) { const size_t t = (size_t)((tb + 3) * 16 + k); la1[k] = la_p[t * 1024]; bt1[k] = bt_p[t * 1024]; g1[k] = gx_p[t * 2048]; } }
#pragma unroll
            for (int k = 0; k < 16; ++k) y_p[(size_t)((tb + 1) * 16 + k) * 1024] = yv[k];
        }
    }
}

template <class Epi>
__device__ __forceinline__ void run_gemm(Frame& F, const bf16* A, int lda, const bf16* Bt, int ldb, int N, int K, const Epi& E, int M = MTOK) {
    pg8::Gemm g{A, Bt, M, N, K, lda, ldb}; pg8::StaticOrder S; S.init(M, N, F.G, (int)blockIdx.x);
#ifndef STAGGER_NG
#define STAGGER_NG 1
#endif
#ifndef STAGGER_STEP
#define STAGGER_STEP 300
#endif
    if (STAGGER_NG > 1 && N >= 4096 && M == MTOK) {
        const unsigned grp = (((unsigned)blockIdx.x >> 3) & 7u) / (8 / STAGGER_NG);
        if (grp) { const unsigned long long t0 = __builtin_amdgcn_s_memrealtime(), dl = (unsigned long long)grp * STAGGER_STEP;
            while (__builtin_amdgcn_s_memrealtime() - t0 < dl) __builtin_amdgcn_s_sleep(8); }
    }
#ifndef FUSE_NX
#define FUSE_NX false
#endif
#ifndef GEMM_ALIGN
#define GEMM_ALIGN true
#endif
#ifndef GEMM_SP2
#define GEMM_SP2 true
#endif
    pg8::gemm_phase<Epi, pg8::StaticOrder, GEMM_ALIGN, GEMM_SP2>(F.lds, g, S, E);
}

typedef const __attribute__((address_space(4))) struct Args* ArgsP;
constexpr int NPHASE = 35;
__device__ __forceinline__ ArgsP get_args() { ArgsP p = (ArgsP)__builtin_amdgcn_kernarg_segment_ptr(); asm volatile("" : "+s"(p)); return p; }
__device__ __forceinline__ bool in_phase(int k) { ArgsP a = get_args(); return a->ph_lo <= k && k < a->ph_hi; }
#ifndef DUP_PHASE
#define DUP_PHASE -1
#endif
#ifndef BAR_EXP
#define BAR_EXP 0
#endif
#ifndef TIMING_MASK
#define TIMING_MASK 0ull
#endif
#define TMISC ((volatile LAS unsigned long long*)((LAS unsigned char*)lds_raw + MISC_OFF))
#define TB(k) do { if (((TIMING_MASK >> (k)) & 1ull) && blockIdx.x == 0 && threadIdx.x == 0) TMISC[0] = __builtin_amdgcn_s_memrealtime(); } while (0)
#define TE(k) do { if (((TIMING_MASK >> (k)) & 1ull) && blockIdx.x == 0 && threadIdx.x == 0) TMISC[1] = TMISC[1] + (__builtin_amdgcn_s_memrealtime() - TMISC[0]); } while (0)
#define REP(k) TB(k); for (int rep_ = 0; rep_ < ((k) == DUP_PHASE ? 2 : 1); ++rep_)
#define AP ArgsP ap = get_args(); { int t_ = threadIdx.x; asm volatile("" : "+v"(t_)); F.tid = t_; F.lane = t_ & 63; F.wave = __builtin_amdgcn_readfirstlane(t_ >> 6); F.G = gridDim.x; F.lds = (LAS unsigned char*)lds_raw; }
__global__ void __launch_bounds__(NTHR, 2) trunk_fwd(Args args) {
    extern __shared__ __attribute__((aligned(16))) unsigned char lds_raw[];
    Frame F; F.lds = (LAS unsigned char*)lds_raw; F.tid = threadIdx.x; F.lane = F.tid & 63; F.wave = __builtin_amdgcn_readfirstlane(F.tid >> 6); F.G = gridDim.x;
    volatile LAS unsigned* MISC = (volatile LAS unsigned*)(F.lds + MISC_OFF);
    if (F.tid < 16) MISC[F.tid] = 0u;
    __syncthreads();
    if (args.ph_hi - args.ph_lo > 1) (void)xcd_barrier_post((unsigned*)(args.ws + WS_CTL) + CW_BAR, MISC + 8);
#ifndef ONLY_PHASE
#define ONLY_PHASE -1
#endif
#define IN(k) ((ONLY_PHASE < 0 || (k) == ONLY_PHASE) && in_phase(k))
#define SEAM(k) do { if (IN(k) && IN((k) + 1)) { XcdBarrier bb; bb.bar = (unsigned*)(get_args()->ws + WS_CTL) + CW_BAR; bb.x = xb_xcc_id(); bb.st = (volatile LAS unsigned*)((LAS unsigned char*)lds_raw + MISC_OFF) + 8; xcd_barrier(bb); if (BAR_EXP) xcd_barrier(bb); } if (IN(k)) TE(k); } while (0)
#define XIN ((const float*)ap->in[0])
#define pos ((const int*)ap->in[1])
#define norm_mix ((const float*)ap->in[2])
#define norm_ffn ((const float*)ap->in[3])
#define ffn_w_in ((const float*)ap->in[4])
#define ffn_w_out ((const float*)ap->in[5])
#define out (ap->out)
#define Wmi ((bf16*)(ap->ws + WS_W_MIXIN))
#define Wmo ((bf16*)(ap->ws + WS_W_MIXOUT))
#define Wfi ((bf16*)(ap->ws + WS_W_FFNIN))
#define Wfo ((bf16*)(ap->ws + WS_W_FFNOUT))
#define U ((bf16*)(ap->ws + WS_U))
#define BIG ((bf16*)(ap->ws + WS_BIG))
#define gatesA ((float*)(ap->ws + WS_GATESA))
#define ssqA ((float*)(ap->ws + WS_SSQA))
#define statC ((float*)(ap->ws + WS_STATC))
#define kmean ((float*)(ap->ws + WS_KMEAN))
#define sptab ((float*)(ap->ws + WS_SPTAB))
#define ssqH ((float*)(ap->ws + WS_SSQH))

#define a_w_in ((const float*)ap->in[6])
#define a_b ((const float*)ap->in[7])
#define a_g ((const float*)ap->in[8])
#define a_w_out ((const float*)ap->in[9])
#define b_w_in ((const float*)ap->in[10])
#define b_gq ((const float*)ap->in[11])
#define b_gk ((const float*)ap->in[12])
#define b_w_out ((const float*)ap->in[13])
#define c_w_in ((const float*)ap->in[14])
#define c_g ((const float*)ap->in[15])
#define c_w_out ((const float*)ap->in[16])
#define d_w_in ((const float*)ap->in[17])
#define d_cw ((const float*)ap->in[18])
#define d_cb ((const float*)ap->in[19])
#define d_wg ((const float*)ap->in[20])
#define d_bg ((const float*)ap->in[21])
#define d_lru ((const float*)ap->in[22])
#define d_w_out ((const float*)ap->in[23])
#define GX BIG
#define XC (BIG + (size_t)MTOK * 2048)
#define LA (BIG + (size_t)MTOK * 3072)
#define BT (BIG + (size_t)MTOK * 4096)
#define Y (BIG + (size_t)MTOK * 5120)
#define Wg (Wmi + (size_t)2048 * DM)
#define FFN_CVT(l) do { cvt_matrix(F, ffn_w_in + (size_t)(l) * DM * 2 * DFF, 2 * DFF, DM, 2 * DFF, 1, Wfi); cvt_matrix(F, ffn_w_out + (size_t)(l) * DFF * DM, DM, DFF, DM, 0, Wfo); } while (0)
#define FFN_PHASES(p0, l) do { \
    if (IN(p0)) { AP; REP(p0) { norm_phase<false>(F, out, norm_ffn + (l) * DM, U, nullptr, nullptr, nullptr); } } SEAM(p0); \
    if (IN((p0) + 1)) { AP; REP((p0) + 1) { pg8::EpiSwiGLU<false> E{BIG, DFF, nullptr}; run_gemm(F, U, DM, Wfi, DM, 2 * DFF, DM, E); } } SEAM((p0) + 1); \
    if (IN((p0) + 2)) { AP; REP((p0) + 2) { pg8::EpiResid<FUSE_NX> E{out, out, DM, U, ssqH}; run_gemm(F, BIG, DFF, Wfo, DFF, DM, DFF, E); } } SEAM((p0) + 2); } while (0)
#define QKV BIG
#define HO (BIG + (size_t)MTOK * 2048)
#define PMAB (BIG + (size_t)MTOK * 3072)
#define GTB ((float*)(BIG + (size_t)MTOK * 3584))
#define DENB ((float*)(BIG + (size_t)MTOK * 3584) + 2048 * 320)
    if (IN(0)) { AP; REP(0) { cvt_matrix(F, a_w_in, 3080, DM, 3072, 0, Wmi); cvt_matrix(F, a_w_out, DM, DM, DM, 0, Wmo); FFN_CVT(0);
        __syncthreads(); norm_phase<true>(F, XIN, norm_mix, U, a_w_in, a_b, gatesA); } } SEAM(0);
    if (IN(1)) { AP; REP(1) { mlstm_pre(F, gatesA, GTB); __syncthreads(); pg8::EpiStore<false> E{QKV, 2048, nullptr}; run_gemm(F, U, DM, Wmi, DM, 2048, DM, E); } } SEAM(1);
    if (IN(2)) { AP; REP(2) { mlstm_pmat(F, QKV, GTB, PMAB, DENB); } } SEAM(2);
    if (IN(3)) { AP; REP(3) { mlstm_core(F, QKV, GTB, PMAB, DENB, HO, ssqA); } } SEAM(3);
    if (IN(4)) { AP; REP(4) { pg8::EpiGateA E{HO, ssqA, a_g}; run_gemm(F, U, DM, Wmi + (size_t)2048 * DM, DM, DM, DM, E); } } SEAM(4);
    if (IN(5)) { AP; REP(5) { pg8::EpiResid<FUSE_NX> E{XIN, out, DM, U, ssqH}; run_gemm(F, HO, DM, Wmo, DM, DM, DM, E); } } SEAM(5);
    FFN_PHASES(6, 0);
#define OB (BIG + (size_t)MTOK * 3072)
#define VTB (BIG + (size_t)MTOK * 2048)
    if (IN(9)) { AP; REP(9) { cvt_matrix(F, b_w_in, 3072, DM, 3072, 0, Wmi); cvt_matrix(F, b_w_out, DM, DM, DM, 0, Wmo); FFN_CVT(1);
        __syncthreads(); norm_phase<false>(F, out, norm_mix + DM, U, nullptr, nullptr, nullptr); } } SEAM(9);
    if (IN(10)) { AP; REP(10) { { pg8::EpiStore<false> E{QKV, 2048, nullptr}; run_gemm(F, U, DM, Wmi, DM, 2048, DM, E); } __syncthreads();
        { pg8::EpiStore<false> E{VTB, MTOK, nullptr}; run_gemm(F, Wmi + (size_t)2048 * DM, DM, U, DM, MTOK, DM, E, DM); } } } SEAM(10);
    if (IN(11)) { AP; REP(11) { moba_prep(F, QKV, pos, b_gq, b_gk, kmean); } } SEAM(11);
    if (IN(12)) { AP; REP(12) { moba_attn(F, QKV, VTB, kmean, OB); } } SEAM(12);
    if (IN(13)) { AP; REP(13) { pg8::EpiResid<FUSE_NX> E{out, out, DM, U, ssqH}; run_gemm(F, OB, DM, Wmo, DM, DM, DM, E); } } SEAM(13);
    FFN_PHASES(14, 1);
#define YS (BIG + 2048)
#define PMB (BIG + (size_t)MTOK * 4096)
#define CSTB ((float*)(BIG + (size_t)MTOK * 4096 + (size_t)16 * 1024 * 1024))
    if (IN(17)) { AP; REP(17) { cvt_matrix(F, c_w_in, 6144, DM, 6144, 0, Wmi); cvt_matrix(F, c_w_out, DM, 2048, DM, 0, Wmo); FFN_CVT(2);
        __syncthreads(); norm_phase<false>(F, out, norm_mix + 2 * DM, U, nullptr, nullptr, nullptr); ret_rot_table(F, pos, CSTB); } } SEAM(17);
    if (IN(18)) { AP; REP(18) { pg8::EpiStoreRot E{QKV, CSTB}; run_gemm(F, U, DM, Wmi, DM, 4096, DM, E); } } SEAM(18);
    if (IN(19)) { AP; REP(19) { ret_pmat(F, QKV, PMB); } } SEAM(19);
    if (IN(20)) { AP; REP(20) { ret_core(F, QKV, PMB, statC); } } SEAM(20);
    if (IN(21)) { AP; REP(21) { pg8::EpiGateC<false> E{YS, 4096, statC, c_g, nullptr}; run_gemm(F, U, DM, Wmi + (size_t)4096 * DM, DM, 2048, DM, E); } } SEAM(21);
    if (IN(22)) { AP; REP(22) { pg8::EpiResid<FUSE_NX> E{out, out, DM, U, ssqH}; run_gemm(F, YS, 4096, Wmo, 2048, DM, 2048, E); } } SEAM(22);
    FFN_PHASES(23, 2);
    if (IN(26)) { AP; REP(26) { cvt_matrix(F, d_w_in, 2048, DM, 2048, 0, Wmi);
#pragma unroll 1
            for (int blk = 0; blk < 4; ++blk) cvt_matrix(F, d_wg + (size_t)blk * 256 * 512, 512, 256, 512, 2, Wg + (size_t)blk * 512 * 256);
            cvt_matrix(F, d_w_out, DM, DM, DM, 0, Wmo); FFN_CVT(3);
        __syncthreads(); norm_phase<false>(F, out, norm_mix + 3 * DM, U, nullptr, nullptr, nullptr); } } SEAM(26);
    if (IN(27)) { AP; REP(27) { pg8::EpiStore<false> E{GX, 2048, nullptr}; run_gemm(F, U, DM, Wmi, DM, 2048, DM, E); } } SEAM(27);
    if (IN(28)) { AP; REP(28) { lru_conv(F, GX, d_cw, d_cb, XC, d_lru, sptab); } } SEAM(28);
    if (IN(29)) { AP; REP(29) {
#pragma unroll 1
            for (int blk = 0; blk < 4; ++blk) { pg8::EpiLru E{XC, LA, BT, d_bg + blk * 512, sptab, blk}; run_gemm(F, XC + blk * 256, DM, Wg + (size_t)blk * 512 * 256, 256, 512, 256, E); __syncthreads(); } } } SEAM(29);
    if (IN(30)) { AP; REP(30) { lru_scan(F, LA, BT, GX, Y); } } SEAM(30);
    if (IN(31)) { AP; REP(31) { pg8::EpiResid<FUSE_NX> E{out, out, DM, U, ssqH}; run_gemm(F, Y, DM, Wmo, DM, DM, DM, E); } } SEAM(31);
    FFN_PHASES(32, 3);
    if (TIMING_MASK != 0ull && blockIdx.x == 0 && threadIdx.x == 0) { const unsigned long long t0_ = __builtin_amdgcn_s_memrealtime(); const unsigned long long tacc_ = TMISC[1]; while (__builtin_amdgcn_s_memrealtime() - t0_ < tacc_) __builtin_amdgcn_s_sleep(8); }
#undef IN
#undef SEAM
#undef XIN
#undef pos
#undef norm_mix
#undef norm_ffn
#undef ffn_w_in
#undef ffn_w_out
#undef out
#undef Wmi
#undef Wmo
#undef Wfi
#undef Wfo
#undef U
#undef BIG
#undef gatesA
#undef ssqA
#undef statC
#undef kmean
#undef sptab
#undef a_w_in
#undef a_b
#undef a_g
#undef a_w_out
#undef b_w_in
#undef b_gq
#undef b_gk
#undef b_w_out
#undef c_w_in
#undef c_g
#undef c_w_out
#undef d_w_in
#undef d_cw
#undef d_cb
#undef d_wg
#undef d_bg
#undef d_lru
#undef d_w_out
#undef GX
#undef XC
#undef LA
#undef BT
#undef Y
#undef Wg
#undef FFN_CVT
#undef OB
#undef CSTB
#undef PMAB
#undef GTB
#undef DENB
#undef PMB
#undef VTB
#undef FFN_PHASES
#undef QKV
#undef HO
#undef YS
#undef ssqH
}

#ifndef MK_ONE_LAUNCH
#define MK_ONE_LAUNCH 1
#endif
extern "C" void kernel_launch(void* const* d_in, const int* in_sizes, int n_in, void* d_out, int out_size, void* d_ws, size_t ws_size, hipStream_t stream) {
    static int grid = 0;
    if (grid == 0) {
        if (n_in != 24 || out_size != MTOK * DM || ws_size < WS_END) { fprintf(stderr, "kernel_launch: unexpected shapes (n_in %d, out %d, ws %zu); nothing launched\n", n_in, out_size, ws_size); grid = -1; return; }
        int dev = 0, cus = 0, per_cu = 0;
        if (hipGetDevice(&dev) != hipSuccess || hipDeviceGetAttribute(&cus, hipDeviceAttributeMultiprocessorCount, dev) != hipSuccess) { grid = -1; return; }
        if (hipFuncSetAttribute((const void*)trunk_fwd, hipFuncAttributeMaxDynamicSharedMemorySize, LDS_BYTES) != hipSuccess) { fprintf(stderr, "kernel_launch: hipFuncSetAttribute failed\n"); grid = -1; return; }
        if (hipOccupancyMaxActiveBlocksPerMultiprocessor(&per_cu, (const void*)trunk_fwd, NTHR, LDS_BYTES) != hipSuccess || per_cu < 1) { fprintf(stderr, "kernel_launch: occupancy query reports %d blocks per CU\n", per_cu); }
        (void)hipGetLastError();
        grid = cus;
    }
    if (grid < 0) return;
    (void)hipMemsetAsync((char*)d_ws + WS_CTL, 0, CTL_ZERO_BYTES, stream);
    Args a{};
    for (int i = 0; i < 24; ++i) a.in[i] = d_in[i];
    a.out = (float*)d_out; a.ws = (unsigned char*)d_ws;
#if MK_ONE_LAUNCH
    a.ph_lo = 0; a.ph_hi = NPHASE;
    hipLaunchKernelGGL(trunk_fwd, dim3(grid), dim3(NTHR), LDS_BYTES, stream, a);
#else
    for (int p = 0; p < NPHASE; ++p) { a.ph_lo = p; a.ph_hi = p + 1; hipLaunchKernelGGL(trunk_fwd, dim3(grid), dim3(NTHR), LDS_BYTES, stream, a); }
#endif
}
```

```cpp
#include <hip/hip_runtime.h>
#include <cstdio>
#include <cstdint>
#include <cmath>
namespace pg8 {
#define PG8_LAS __attribute__((address_space(3)))
typedef unsigned short bf16_t;
typedef short bf16x8 __attribute__((ext_vector_type(8)));
typedef float f32x4 __attribute__((ext_vector_type(4)));
typedef unsigned u32x4 __attribute__((ext_vector_type(4)));
constexpr int BM = 256, BK = 64, HALF = 128, HTB = HALF * BK * 2  , STAGE_BYTES = 8 * HTB, NXCD = 8, WGM = 8;

__host__ __device__ __forceinline__ int lds_byte(int r, int c) { const int st = (r >> 4) * 2 + (c >> 5), rr = r & 15, cc = c & 31, ob = rr * 64 + cc * 2; return st * 1024 + (ob ^ (((ob >> 9) & 1) << 5)); }
__host__ __device__ __forceinline__ void stage_rc(int b, int& R, int& C) { const int st = b / 1024, sb = b % 1024, swz = sb ^ (((sb >> 9) & 1) << 5); R = (st >> 1) * 16 + swz / 64; C = (st & 1) * 32 + (swz % 64) / 2; }
__host__ __device__ __forceinline__ int perm32(int rho) { const int n = rho >> 4, i = rho & 15; return 8 * (i >> 2) + 4 * n + (i & 3); }

struct Unit { int pm, pn; };
struct Gemm { const bf16_t* A; const bf16_t* Bt; int M, N, K, lda, ldb; };

struct StaticOrder {
    int nM, nN, nwg, G, c, wgm;
    __host__ __device__ void init(int M, int N, int G_, int c_, int wgm_ = WGM) { nM = M / BM; nN = N / BM; nwg = nM * nN; G = G_; c = c_; wgm = wgm_; }
    __host__ __device__ bool next(int i, Unit& u) const {
        const long L = (long)i * G + c; if (L >= nwg) return false;
        int wgid = (int)L; { const int q = nwg / NXCD, r = nwg % NXCD, xcd = wgid % NXCD, off = wgid / NXCD; wgid = (xcd < r ? xcd * (q + 1) : r * (q + 1) + (xcd - r) * q) + off; }
        const int nig = wgm * nN, gid = wgid / nig, fm = gid * wgm, gsz = (nM - fm) < wgm ? (nM - fm) : wgm;
        u.pm = fm + ((wgid % nig) % gsz); u.pn = (wgid % nig) / gsz; return true;
    }
    __device__ __forceinline__ void a_ready(const Unit&) const {}
    __device__ __forceinline__ void done(const Unit&) const {}
};

__device__ __forceinline__ unsigned cvt_pk_bf16(float lo, float hi) { unsigned r; asm volatile("v_cvt_pk_bf16_f32 %0, %1, %2" : "=v"(r) : "v"(lo), "v"(hi)); return r; }
typedef float f32x2 __attribute__((ext_vector_type(2)));

__device__ __forceinline__ float bf2f(unsigned short b) { return __uint_as_float(((unsigned)b) << 16); }
__device__ __forceinline__ float lo_bf(unsigned w) { return __uint_as_float(w << 16); }
__device__ __forceinline__ float hi_bf(unsigned w) { return __uint_as_float(w & 0xffff0000u); }
__device__ __forceinline__ float fast_sigmoid(float x) { return __builtin_amdgcn_rcpf(1.0f + __expf(-x)); }
typedef unsigned u32x2 __attribute__((ext_vector_type(2)));

__device__ __forceinline__ void row_rstd(const float* ssq, int row0, float (&rs)[2][4]) {
#pragma unroll
    for (int ai = 0; ai < 2; ++ai)
#pragma unroll
        for (int m = 0; m < 4; ++m) { const f32x4* p = (const f32x4*)(ssq + (size_t)(row0 + ai * HALF + m * 16) * 16); const f32x4 a = p[0], b = p[1], c = p[2], d = p[3];
            const float t = ((a[0] + a[1]) + (a[2] + a[3])) + ((b[0] + b[1]) + (b[2] + b[3])) + ((c[0] + c[1]) + (c[2] + c[3])) + ((d[0] + d[1]) + (d[2] + d[3]));
            rs[ai][m] = 1.0f / sqrtf(t * (1.0f / 1024.0f) + 1e-6f); }
}
template <bool RS> struct EpiStore {
    static constexpr bool PERM = true, AFTER_DRAIN = false;
    bf16_t* O; int ldc; const float* ssq;
    __device__ __forceinline__ void operator()(const f32x4 (&acc)[2][2][4][2], const Unit& u, int wr, int wc, int fr, int fq) const {
        const int row0 = u.pm * BM + wr * 64 + fr, col0 = u.pn * BM + wc * 32 + 8 * fq;
        float rs[2][4]; if (RS) row_rstd(ssq, row0, rs);
#pragma unroll
        for (int ai = 0; ai < 2; ++ai)
#pragma unroll
            for (int m = 0; m < 4; ++m) { bf16_t* rowp = O + (size_t)(row0 + ai * HALF + m * 16) * ldc + col0; const float sc = RS ? rs[ai][m] : 1.0f;
#pragma unroll
                for (int bj = 0; bj < 2; ++bj) { const f32x4 v0 = acc[ai][bj][m][0] * sc, v1 = acc[ai][bj][m][1] * sc;
                    u32x4 w; w.x = cvt_pk_bf16(v0[0], v0[1]); w.y = cvt_pk_bf16(v0[2], v0[3]); w.z = cvt_pk_bf16(v1[0], v1[1]); w.w = cvt_pk_bf16(v1[2], v1[3]);
                    *(u32x4*)(rowp + bj * HALF) = w;
#if defined(GEMM_EXP) && GEMM_EXP == 3
                    asm volatile("" ::: "memory"); *(volatile u32x4*)(rowp + bj * HALF) = w;
#endif
                } }
    }
};

struct EpiStoreRot {
    static constexpr bool PERM = true, AFTER_DRAIN = false;
    bf16_t* O; const float* cst;
    __device__ __forceinline__ void operator()(const f32x4 (&acc)[2][2][4][2], const Unit& u, int wr, int wc, int fr, int fq) const {
        const int row0 = u.pm * BM + wr * 64 + fr, col0 = u.pn * BM + wc * 32 + 8 * fq, d0 = wc * 32 + 8 * fq;
        const bool rot = u.pn < 8; const float sc = (u.pn >= 4 && u.pn < 8) ? 0.0625f : 1.0f;
#pragma unroll
        for (int ai = 0; ai < 2; ++ai)
#pragma unroll
            for (int m = 0; m < 4; ++m) { const int row = row0 + ai * HALF + m * 16; bf16_t* rowp = O + (size_t)row * 4096 + col0;
                f32x4 v[2][2];
#pragma unroll
                for (int bj = 0; bj < 2; ++bj) { v[bj][0] = acc[ai][bj][m][0]; v[bj][1] = acc[ai][bj][m][1]; }
                if (rot) { const float* cp = cst + (size_t)row * 256 + d0;
#pragma unroll
                    for (int n = 0; n < 2; ++n) { const f32x4 c = *(const f32x4*)(cp + 4 * n), sn = *(const f32x4*)(cp + 128 + 4 * n); const f32x4 x1 = v[0][n], x2 = v[1][n];
                        v[0][n] = (x1 * c - x2 * sn) * sc; v[1][n] = (x2 * c + x1 * sn) * sc; } }
#pragma unroll
                for (int bj = 0; bj < 2; ++bj) { u32x4 w; w.x = cvt_pk_bf16(v[bj][0][0], v[bj][0][1]); w.y = cvt_pk_bf16(v[bj][0][2], v[bj][0][3]); w.z = cvt_pk_bf16(v[bj][1][0], v[bj][1][1]); w.w = cvt_pk_bf16(v[bj][1][2], v[bj][1][3]);
                    *(u32x4*)(rowp + bj * HALF) = w; } }
    }
};
template <bool RS> struct EpiSwiGLU {
    static constexpr bool PERM = true, AFTER_DRAIN = false;
    bf16_t* O; int ldc; const float* ssq;
    __device__ __forceinline__ void operator()(const f32x4 (&acc)[2][2][4][2], const Unit& u, int wr, int wc, int fr, int fq) const {
        const int row0 = u.pm * BM + wr * 64 + fr, col0 = u.pn * HALF + wc * 32 + 8 * fq;
        float rs[2][4]; if (RS) row_rstd(ssq, row0, rs);
#pragma unroll
        for (int ai = 0; ai < 2; ++ai)
#pragma unroll
            for (int m = 0; m < 4; ++m) { bf16_t* rowp = O + (size_t)(row0 + ai * HALF + m * 16) * ldc + col0; const float sc = RS ? rs[ai][m] : 1.0f;
                float h[8];
#pragma unroll
                for (int n = 0; n < 2; ++n)
#pragma unroll
                    for (int j = 0; j < 4; ++j) { const float g = acc[ai][0][m][n][j] * sc, up = acc[ai][1][m][n][j] * sc;
#if defined(GEMM_EXP) && GEMM_EXP == 2
                        h[4 * n + j] = g * (0.5f * (fast_sigmoid(g) + (1.0f - fast_sigmoid(-g)))) * up;
#else
                        h[4 * n + j] = g * fast_sigmoid(g) * up;
#endif
                    }
                u32x4 w; w.x = cvt_pk_bf16(h[0], h[1]); w.y = cvt_pk_bf16(h[2], h[3]); w.z = cvt_pk_bf16(h[4], h[5]); w.w = cvt_pk_bf16(h[6], h[7]);

#if defined(NT_HIDDEN) && NT_HIDDEN
                __builtin_nontemporal_store(w, (u32x4*)rowp);
#else
                *(u32x4*)rowp = w;
#endif
                }
    }
};
template <bool NX> struct EpiResid {
    static constexpr bool PERM = false, AFTER_DRAIN = false;
    const float* base; float* out; int ldc; bf16_t* hb; float* ssq;
    __device__ __forceinline__ void operator()(const f32x4 (&acc)[2][2][4][2], const Unit& u, int wr, int wc, int fr, int fq) const {
        const int row0 = u.pm * BM + wr * 64 + fr, col0 = u.pn * BM + wc * 32 + 4 * fq;
        f32x4 rb[3][4];
#define PG8_RLOAD(g, slot) do { const size_t off_ = (size_t)(row0 + ((g) >> 2) * HALF + ((g) & 3) * 16) * ldc + col0; \
            rb[slot][0] = *(const f32x4*)(base + off_); rb[slot][1] = *(const f32x4*)(base + off_ + 16); rb[slot][2] = *(const f32x4*)(base + off_ + HALF); rb[slot][3] = *(const f32x4*)(base + off_ + HALF + 16); } while (0)
        PG8_RLOAD(0, 0); PG8_RLOAD(1, 1);
#pragma unroll
        for (int g = 0; g < 8; ++g) { const int ai = g >> 2, m = g & 3; const size_t off = (size_t)(row0 + ai * HALF + m * 16) * ldc + col0; float q = 0.f;
            if (g + 2 < 8) PG8_RLOAD(g + 2, (g + 2) % 3);
#pragma unroll
            for (int bj = 0; bj < 2; ++bj)
#pragma unroll
                for (int n = 0; n < 2; ++n) { const f32x4 o = rb[g % 3][bj * 2 + n] + acc[ai][bj][m][n]; *(f32x4*)(out + off + bj * HALF + n * 16) = o;
                    if (NX) { q += (o[0] * o[0] + o[1] * o[1]) + (o[2] * o[2] + o[3] * o[3]); u32x2 w; w.x = cvt_pk_bf16(o[0], o[1]); w.y = cvt_pk_bf16(o[2], o[3]); *(u32x2*)(hb + off + bj * HALF + n * 16) = w; } }
            if (NX) { q += __shfl_xor(q, 16); q += __shfl_xor(q, 32); if (fq == 0) ssq[(size_t)(row0 + ai * HALF + m * 16) * 16 + u.pn * 4 + wc] = q; } }
#undef PG8_RLOAD
    }
};
struct EpiGateA {
    static constexpr bool PERM = true, AFTER_DRAIN = false;
    bf16_t* Y; const float* ssq; const float* gout;
    __device__ __forceinline__ void operator()(const f32x4 (&acc)[2][2][4][2], const Unit& u, int wr, int wc, int fr, int fq) const {
        const int row0 = u.pm * BM + wr * 64 + fr, col0 = u.pn * BM + wc * 32 + 8 * fq;
        f32x4 gv[2][2];
#pragma unroll
        for (int bj = 0; bj < 2; ++bj)
#pragma unroll
            for (int n = 0; n < 2; ++n) gv[bj][n] = *(const f32x4*)(gout + col0 + bj * HALF + 4 * n);
        u32x4 hwb[2][2]; f32x4 spb[2][2];
#define PG8_GLOAD(g, slot) do { const int row_ = row0 + ((g) >> 2) * HALF + ((g) & 3) * 16; const bf16_t* rp_ = Y + (size_t)row_ * 1024 + col0; hwb[slot][0] = *(const u32x4*)rp_; hwb[slot][1] = *(const u32x4*)(rp_ + HALF); \
            spb[slot][0] = *(const f32x4*)(ssq + (size_t)row_ * 32 + u.pn * 8); spb[slot][1] = *(const f32x4*)(ssq + (size_t)row_ * 32 + u.pn * 8 + 4); } while (0)
        PG8_GLOAD(0, 0);
#pragma unroll
        for (int g = 0; g < 8; ++g) { const int ai = g >> 2, m = g & 3, sl = g & 1; const int row = row0 + ai * HALF + m * 16; bf16_t* rowp = Y + (size_t)row * 1024 + col0;
            if (g + 1 < 8) PG8_GLOAD(g + 1, (g + 1) & 1);
            const f32x4 sp = spb[sl][0], sp2 = spb[sl][1];
            const float rstd = 1.0f / sqrtf((((sp[0] + sp[1]) + (sp[2] + sp[3])) + ((sp2[0] + sp2[1]) + (sp2[2] + sp2[3]))) * (1.0f / 256.0f) + 1e-6f);
#pragma unroll
            for (int bj = 0; bj < 2; ++bj) { const u32x4 hw = hwb[sl][bj]; float o[8];
                const unsigned hh[4] = {hw.x, hw.y, hw.z, hw.w};
#pragma unroll
                for (int n = 0; n < 2; ++n)
#pragma unroll
                    for (int j = 0; j < 4; ++j) { const unsigned w = hh[2 * n + (j >> 1)]; const float hv = (j & 1) ? hi_bf(w) : lo_bf(w);
                        o[4 * n + j] = hv * rstd * gv[bj][n][j] * fast_sigmoid(acc[ai][bj][m][n][j]); }
                u32x4 w; w.x = cvt_pk_bf16(o[0], o[1]); w.y = cvt_pk_bf16(o[2], o[3]); w.z = cvt_pk_bf16(o[4], o[5]); w.w = cvt_pk_bf16(o[6], o[7]);
                *(u32x4*)(rowp + bj * HALF) = w; } }
#undef PG8_GLOAD
    }
};
template <bool RS> struct EpiGateC {
    static constexpr bool PERM = true, AFTER_DRAIN = false;
    bf16_t* Y; int ldy; const float* st; const float* gout; const float* hssq;
    __device__ __forceinline__ void operator()(const f32x4 (&acc)[2][2][4][2], const Unit& u, int wr, int wc, int fr, int fq) const {
        const int row0 = u.pm * BM + wr * 64 + fr, col0 = u.pn * BM + wc * 32 + 8 * fq, head = u.pn >> 1;
        float rs[2][4]; if (RS) row_rstd(hssq, row0, rs);
        f32x4 gv[2][2];
#pragma unroll
        for (int bj = 0; bj < 2; ++bj)
#pragma unroll
            for (int n = 0; n < 2; ++n) gv[bj][n] = *(const f32x4*)(gout + col0 + bj * HALF + 4 * n);
        u32x4 hwb[2][2]; f32x4 spb[2][2];
#define PG8_GLOAD(g, slot) do { const int row_ = row0 + ((g) >> 2) * HALF + ((g) & 3) * 16; const bf16_t* rp_ = Y + (size_t)row_ * ldy + col0; hwb[slot][0] = *(const u32x4*)rp_; hwb[slot][1] = *(const u32x4*)(rp_ + HALF); \
            spb[slot][0] = *(const f32x4*)(st + (size_t)row_ * 32 + head * 8); spb[slot][1] = *(const f32x4*)(st + (size_t)row_ * 32 + head * 8 + 4); } while (0)
        PG8_GLOAD(0, 0);
#pragma unroll
        for (int g = 0; g < 8; ++g) { const int ai = g >> 2, m = g & 3, sl = g & 1; const int row = row0 + ai * HALF + m * 16; bf16_t* rowp = Y + (size_t)row * ldy + col0;
            if (g + 1 < 8) PG8_GLOAD(g + 1, (g + 1) & 1);
            const f32x4 s0 = spb[sl][0], s1 = spb[sl][1];
            const float mu = ((s0[0] + s0[2]) + (s1[0] + s1[2])) * (1.0f / 512.0f), ex2 = ((s0[1] + s0[3]) + (s1[1] + s1[3])) * (1.0f / 512.0f);
            const float var = fmaxf(ex2 - mu * mu, 0.f), rstd = 1.0f / sqrtf(var + 1e-6f);
#pragma unroll
            for (int bj = 0; bj < 2; ++bj) { const u32x4 hw = hwb[sl][bj]; float o[8];
                const unsigned hh[4] = {hw.x, hw.y, hw.z, hw.w};
#pragma unroll
                for (int n = 0; n < 2; ++n)
#pragma unroll
                    for (int j = 0; j < 4; ++j) { const unsigned w = hh[2 * n + (j >> 1)]; const float hv = (j & 1) ? hi_bf(w) : lo_bf(w); const float a = RS ? acc[ai][bj][m][n][j] * rs[ai][m] : acc[ai][bj][m][n][j];
                        o[4 * n + j] = (hv - mu) * rstd * gv[bj][n][j] * (a * fast_sigmoid(a)); }
                u32x4 w; w.x = cvt_pk_bf16(o[0], o[1]); w.y = cvt_pk_bf16(o[2], o[3]); w.z = cvt_pk_bf16(o[4], o[5]); w.w = cvt_pk_bf16(o[6], o[7]);
                *(u32x4*)(rowp + bj * HALF) = w; } }
#undef PG8_GLOAD
    }
};
struct EpiLru {
    static constexpr bool PERM = true, AFTER_DRAIN = false;
    const bf16_t* XC; bf16_t* LA; bf16_t* BT; const float* bg; const float* sp; int blk;
    __device__ __forceinline__ void operator()(const f32x4 (&acc)[2][2][4][2], const Unit& u, int wr, int wc, int fr, int fq) const {
        const int row0 = u.pm * BM + wr * 64 + fr, cb = u.pn * HALF + wc * 32 + 8 * fq, ch0 = blk * 256 + cb;
        u32x4 xwb[2]; xwb[0] = *(const u32x4*)(XC + (size_t)row0 * 1024 + ch0);
#pragma unroll
        for (int g = 0; g < 8; ++g) { const int ai = g >> 2, m = g & 3; const size_t off = (size_t)(row0 + ai * HALF + m * 16) * 1024 + ch0;
                if (g + 1 < 8) xwb[(g + 1) & 1] = *(const u32x4*)(XC + (size_t)(row0 + ((g + 1) >> 2) * HALF + ((g + 1) & 3) * 16) * 1024 + ch0);
                const u32x4 xw = xwb[g & 1]; const unsigned xx[4] = {xw.x, xw.y, xw.z, xw.w};
                unsigned lw[4], bw[4];
#pragma unroll
                for (int n = 0; n < 2; ++n) { const f32x4 br = *(const f32x4*)(bg + cb + 4 * n), bi = *(const f32x4*)(bg + 256 + cb + 4 * n), spv = *(const f32x4*)(sp + ch0 + 4 * n); float la[4], bt[4];
#pragma unroll
                    for (int j = 0; j < 4; ++j) { const int q = 4 * n + j; const unsigned w = xx[q >> 1]; const float xc = (q & 1) ? hi_bf(w) : lo_bf(w);
                        const float r = fast_sigmoid(acc[ai][0][m][n][j] + br[j]), ig = fast_sigmoid(acc[ai][1][m][n][j] + bi[j]);
                        const float l = -8.0f * r * spv[j]; la[j] = l; bt[j] = sqrtf(fmaxf(1.0f - __expf(2.0f * l), 0.f)) * ig * xc; }
                    lw[2 * n] = cvt_pk_bf16(la[0], la[1]); lw[2 * n + 1] = cvt_pk_bf16(la[2], la[3]); bw[2 * n] = cvt_pk_bf16(bt[0], bt[1]); bw[2 * n + 1] = cvt_pk_bf16(bt[2], bt[3]); }
                u32x4 w; w.x = lw[0]; w.y = lw[1]; w.z = lw[2]; w.w = lw[3]; *(u32x4*)(LA + off) = w;
                w.x = bw[0]; w.y = bw[1]; w.z = bw[2]; w.w = bw[3]; *(u32x4*)(BT + off) = w; }
    }
};

template <class Epi, class Sched, bool ALIGN_EPI = false, bool SP2 = false>
__device__ __forceinline__ void gemm_phase(PG8_LAS unsigned char* lds, const Gemm g, const Sched& S, const Epi& E) {
    int tid_ = threadIdx.x; asm volatile("" : "+v"(tid_));
    const int tid = tid_, wid = __builtin_amdgcn_readfirstlane(tid >> 6), lane = tid & 63, wr = wid >> 2, wc = wid & 3, fr = lane & 15, fq = lane >> 4;
    const int K = g.K, nt = K / BK;
    unsigned voffA[2], voffB[2];
#pragma unroll
    for (int i = 0; i < 2; ++i) { int R, C; stage_rc(tid * 16 + i * 8192, R, C); const int Rb = Epi::PERM ? ((R & ~31) + perm32(R & 31)) : R;
        voffA[i] = (unsigned)(R * g.lda + C) * 2u; voffB[i] = (unsigned)(Rb * g.ldb + C) * 2u; }
    const size_t kstep = (size_t)(BK * 2);
    const size_t hstepA = (size_t)HALF * g.lda * 2, hstepB = (size_t)HALF * g.ldb * 2;
    const size_t tstepA = 2 * hstepA, tstepB = 2 * hstepB;
    const unsigned ldsw = (unsigned)wid * 1024u;
    const int aoff = lds_byte(wr * 64 + fr, fq * 8), boff = lds_byte(wc * 32 + fr, fq * 8);
#define PG8_SA(b, h) (((b) * 2 + (h)) * HTB)
#define PG8_SB(b, h) ((4 + (b) * 2 + (h)) * HTB)
#define PG8_STAGE(bufoff, gbase, voff) do { _Pragma("unroll") for (int _i = 0; _i < 2; ++_i) \
        __builtin_amdgcn_global_load_lds((const unsigned*)((const char*)(gbase) + (voff)[_i]), (PG8_LAS unsigned*)(lds + (bufoff) + ldsw + _i * 8192), 16, 0, 0); } while (0)
#define PG8_LDA(dst, b, h) do { _Pragma("unroll") for (int m = 0; m < 4; ++m) _Pragma("unroll") for (int k = 0; k < 2; ++k) dst[m][k] = *(const PG8_LAS bf16x8*)(lds + PG8_SA(b, h) + aoff + m * 2048 + k * 1024); } while (0)
#define PG8_LDB(dst, b, h) do { _Pragma("unroll") for (int n = 0; n < 2; ++n) _Pragma("unroll") for (int k = 0; k < 2; ++k) dst[n][k] = *(const PG8_LAS bf16x8*)(lds + PG8_SB(b, h) + boff + n * 2048 + k * 1024); } while (0)
#define PG8_MMA(ai, bj, At, Bt) do { __builtin_amdgcn_s_setprio(1); _Pragma("unroll") for (int m = 0; m < 4; ++m) _Pragma("unroll") for (int n = 0; n < 2; ++n) _Pragma("unroll") for (int k = 0; k < 2; ++k) \
        acc[ai][bj][m][n] = __builtin_amdgcn_mfma_f32_16x16x32_bf16(Bt[n][k], At[m][k], acc[ai][bj][m][n], 0, 0, 0); __builtin_amdgcn_s_setprio(0); } while (0)
#define PG8_WAIT_V(n) asm volatile("s_waitcnt vmcnt(" #n ")" ::: "memory")
#define PG8_WAIT_L(n) asm volatile("s_waitcnt lgkmcnt(" #n ")" ::: "memory")
#define PG8_BAR __builtin_amdgcn_s_barrier()
#define PG8_SCHED __builtin_amdgcn_sched_barrier(0)
    Unit cur, nxt; int ui = 0;
    if (!S.next(0, cur)) return;
    f32x4 acc[2][2][4][2];
#pragma unroll
    for (int a = 0; a < 2; ++a)
#pragma unroll
        for (int b = 0; b < 2; ++b)
#pragma unroll
            for (int m = 0; m < 4; ++m)
#pragma unroll
                for (int n = 0; n < 2; ++n) acc[a][b][m][n] = (f32x4){0.f, 0.f, 0.f, 0.f};
    bf16x8 At[4][2], B0[2][2], B1[2][2];
    const char* cA = (const char*)g.A + (size_t)cur.pm * tstepA; const char* cB = (const char*)g.Bt + (size_t)cur.pn * tstepB;
    S.a_ready(cur);
    if constexpr (SP2) {
        PG8_STAGE(PG8_SB(0, 0), cB, voffB); PG8_STAGE(PG8_SB(0, 1), cB + hstepB, voffB); PG8_STAGE(PG8_SA(0, 0), cA, voffA); PG8_STAGE(PG8_SA(0, 1), cA + hstepA, voffA);
        if (wr == 1) PG8_BAR;
        PG8_WAIT_V(2); PG8_BAR;
        PG8_STAGE(PG8_SB(1, 0), cB + kstep, voffB); PG8_STAGE(PG8_SA(1, 0), cA + kstep, voffA); PG8_STAGE(PG8_SB(1, 1), cB + hstepB + kstep, voffB);
        PG8_WAIT_V(6); PG8_BAR;
    } else {
        PG8_STAGE(PG8_SB(0, 0), cB, voffB); PG8_STAGE(PG8_SA(0, 0), cA, voffA); PG8_STAGE(PG8_SB(0, 1), cB + hstepB, voffB); PG8_STAGE(PG8_SA(0, 1), cA + hstepA, voffA);
        if (wr == 1) PG8_BAR;
        PG8_WAIT_V(4); PG8_BAR;
        PG8_STAGE(PG8_SB(1, 0), cB + kstep, voffB); PG8_STAGE(PG8_SA(1, 0), cA + kstep, voffA); PG8_STAGE(PG8_SB(1, 1), cB + hstepB + kstep, voffB);
        PG8_WAIT_V(6); PG8_BAR;
    }
    for (;;) {
        const bool has_next = S.next(ui + 1, nxt);
        const char* nA = has_next ? (const char*)g.A + (size_t)nxt.pm * tstepA : cA; const char* nB = has_next ? (const char*)g.Bt + (size_t)nxt.pn * tstepB : cB;
        for (int t = 0; t < nt; t += 2) {
            const bool last = (t == nt - 2);
            const char* a1 = cA + (size_t)(t + 1) * kstep;
            const char* a2 = last ? nA : cA + (size_t)(t + 2) * kstep; const char* b2 = last ? nB : cB + (size_t)(t + 2) * kstep;
            const char* a3 = a2 + kstep; const char* b3 = b2 + kstep;
            if (last && has_next) S.a_ready(nxt);
            if constexpr (SP2) {
            PG8_LDB(B0, 0, 0); PG8_LDB(B1, 0, 1); PG8_SCHED; PG8_LDA(At, 0, 0); PG8_STAGE(PG8_SA(1, 1), a1 + hstepA, voffA);
            PG8_WAIT_V(8); PG8_WAIT_L(0); PG8_BAR; PG8_MMA(0, 0, At, B0); PG8_MMA(0, 1, At, B1); PG8_BAR; PG8_SCHED;
            PG8_LDA(At, 0, 1); PG8_STAGE(PG8_SB(0, 0), b2, voffB); PG8_STAGE(PG8_SB(0, 1), b2 + hstepB, voffB); PG8_STAGE(PG8_SA(0, 0), a2, voffA);
            PG8_WAIT_V(8); PG8_WAIT_L(0); PG8_BAR; PG8_MMA(1, 0, At, B0); PG8_MMA(1, 1, At, B1); PG8_BAR; PG8_SCHED;
            PG8_LDB(B0, 1, 0); PG8_LDB(B1, 1, 1); PG8_SCHED; PG8_LDA(At, 1, 0); PG8_STAGE(PG8_SA(0, 1), a2 + hstepA, voffA);
            PG8_WAIT_V(8); PG8_WAIT_L(0); PG8_BAR; PG8_MMA(0, 0, At, B0); PG8_MMA(0, 1, At, B1); PG8_BAR; PG8_SCHED;
            PG8_LDA(At, 1, 1); PG8_STAGE(PG8_SB(1, 0), b3, voffB); PG8_STAGE(PG8_SB(1, 1), b3 + hstepB, voffB); PG8_STAGE(PG8_SA(1, 0), a3, voffA);
            PG8_WAIT_V(8); PG8_WAIT_L(0); PG8_BAR; PG8_MMA(1, 0, At, B0); PG8_MMA(1, 1, At, B1); PG8_BAR; PG8_SCHED;
            } else {
            PG8_LDB(B0, 0, 0); PG8_SCHED; PG8_LDA(At, 0, 0); PG8_STAGE(PG8_SA(1, 1), a1 + hstepA, voffA);
            PG8_WAIT_L(8); PG8_BAR; PG8_WAIT_L(0); PG8_MMA(0, 0, At, B0); PG8_BAR; PG8_SCHED;
            PG8_LDB(B1, 0, 1); PG8_STAGE(PG8_SB(0, 0), b2, voffB);
            PG8_BAR; PG8_WAIT_L(0); PG8_MMA(0, 1, At, B1); PG8_BAR;
            PG8_LDA(At, 0, 1); PG8_STAGE(PG8_SA(0, 0), a2, voffA);
            PG8_BAR; PG8_WAIT_L(0); PG8_MMA(1, 0, At, B0); PG8_BAR; PG8_SCHED;
            PG8_STAGE(PG8_SB(0, 1), b2 + hstepB, voffB);
            PG8_WAIT_V(6); PG8_BAR; PG8_MMA(1, 1, At, B1); PG8_BAR;
            PG8_LDB(B0, 1, 0); PG8_SCHED; PG8_LDA(At, 1, 0); PG8_STAGE(PG8_SA(0, 1), a2 + hstepA, voffA);
            PG8_WAIT_L(8); PG8_BAR; PG8_WAIT_L(0); PG8_MMA(0, 0, At, B0); PG8_BAR; PG8_SCHED;
            PG8_LDB(B1, 1, 1); PG8_STAGE(PG8_SB(1, 0), b3, voffB);
            PG8_BAR; PG8_WAIT_L(0); PG8_MMA(0, 1, At, B1); PG8_BAR;
            PG8_LDA(At, 1, 1); PG8_STAGE(PG8_SA(1, 0), a3, voffA);
            PG8_BAR; PG8_WAIT_L(0); PG8_MMA(1, 0, At, B0); PG8_BAR; PG8_SCHED;
            PG8_STAGE(PG8_SB(1, 1), b3 + hstepB, voffB);
            PG8_WAIT_V(6); PG8_BAR; PG8_MMA(1, 1, At, B1); PG8_BAR;
            }
        }
        if constexpr (ALIGN_EPI) { if (wr == 0) PG8_BAR; }
        if constexpr (!Epi::AFTER_DRAIN) { E(acc, cur, wr, wc, fr, fq); S.done(cur); }
        if (!has_next) break;
#pragma unroll
        for (int a = 0; a < 2; ++a)
#pragma unroll
            for (int b = 0; b < 2; ++b)
#pragma unroll
                for (int m = 0; m < 4; ++m)
#pragma unroll
                    for (int n = 0; n < 2; ++n) acc[a][b][m][n] = (f32x4){0.f, 0.f, 0.f, 0.f};
        cur = nxt; cA = nA; cB = nB; ++ui;
        if constexpr (ALIGN_EPI) { if (wr == 1) PG8_BAR; }
    }
    PG8_WAIT_V(0);
    if constexpr (!ALIGN_EPI) { if (wr == 0) PG8_BAR; }
    PG8_BAR;
    if constexpr (Epi::AFTER_DRAIN) { E.fused(acc, cur, wr, wc, fr, fq, lds, wid, lane); S.done(cur); }
#undef PG8_SA
#undef PG8_SB
#undef PG8_STAGE
#undef PG8_LDA
#undef PG8_LDB
#undef PG8_MMA
#undef PG8_WAIT_V
#undef PG8_WAIT_L
#undef PG8_BAR
#undef PG8_SCHED
}
}
#define GAS __attribute__((address_space(1)))
#define LAS __attribute__((address_space(3)))
typedef unsigned short bf16;
typedef unsigned v4u __attribute__((ext_vector_type(4)));
typedef float f32x4 __attribute__((ext_vector_type(4)));
typedef short bf16x8 __attribute__((ext_vector_type(8)));
typedef GAS unsigned gu32;
typedef GAS unsigned long long gu64;
#define RLX_AGENT __ATOMIC_RELAXED, __HIP_MEMORY_SCOPE_AGENT
#define LDS_WAIT() asm volatile("s_waitcnt lgkmcnt(0)" ::: "memory")
#define VM_WAIT() asm volatile("s_waitcnt vmcnt(0)" ::: "memory")
__device__ __forceinline__ unsigned long long rt() { return __builtin_amdgcn_s_memrealtime(); }
__device__ __forceinline__ unsigned f2bf(float f) { unsigned u = __builtin_bit_cast(unsigned, f); return (u + 0x7fffu + ((u >> 16) & 1u)) >> 16; }
__device__ __forceinline__ unsigned pk2(float lo, float hi) { return f2bf(lo) | (f2bf(hi) << 16); }

#define XB_TMO      128
#define XB_XCNT(j)  (256  + 64 * (j))
#define XB_XSUB(j)  (1280 + 64 * (j))
#define XB_XGEN(j)  (2304 + 64 * (j))
#define XB_TOP      3328
#define XB_TOPGEN   3392
#define XCD_BAR_WORDS 3456
#define XB_SPIN_CAP (1u << 18)

__device__ __forceinline__ unsigned xb_ld(unsigned* p)              { return __hip_atomic_load(p, __ATOMIC_RELAXED, __HIP_MEMORY_SCOPE_AGENT); }
__device__ __forceinline__ unsigned xb_add(unsigned* p, unsigned v) { return __hip_atomic_fetch_add(p, v, __ATOMIC_RELAXED, __HIP_MEMORY_SCOPE_AGENT); }
__device__ __forceinline__ unsigned xb_xcc_id() { return (unsigned)__builtin_amdgcn_s_getreg((3 << 11) | 20) & 0xFu; }
#define XB_SPIN(cond, bar) do { unsigned _sp = 0; while (cond) { __builtin_amdgcn_s_sleep(1); \
    if ((++_sp & 255u) == 0u) { if (xb_ld(&(bar)[XB_TMO])) break; if (_sp > XB_SPIN_CAP) { atomicAdd(&(bar)[XB_TMO], 1u); break; } } } } while (0)

struct XcdBarrier {
    unsigned* bar; unsigned x;
    volatile LAS unsigned* st;
};

__device__ __forceinline__ XcdBarrier xcd_barrier_post(unsigned* bar, volatile LAS unsigned* st) {
    XcdBarrier b; b.bar = bar; b.x = xb_xcc_id(); b.st = st;
    if (threadIdx.x == 0) (void)xb_add(&bar[XB_XCNT(b.x)], 1u);
    return b;
}
__device__ __forceinline__ void xcd_barrier_complete(unsigned* bar, unsigned x, unsigned& nloc, unsigned& nx) {
    const unsigned G = gridDim.x * gridDim.y * gridDim.z;
    unsigned sum, cnt, mine, sp = 0u;
    for (;;) {
        sum = 0u; cnt = 0u; mine = 0u;
#pragma unroll
        for (unsigned j = 0; j < 16; ++j) { const unsigned c = xb_ld(&bar[XB_XCNT(j)]); sum += c; cnt += (c > 0u) ? 1u : 0u; mine = (j == x) ? c : mine; }
        if (sum == G) break;
        __builtin_amdgcn_s_sleep(1);
        if ((++sp & 255u) == 0u) { if (xb_ld(&bar[XB_TMO])) break; if (sp > XB_SPIN_CAP) { atomicAdd(&bar[XB_TMO], 1u); break; } }
    }
    nloc = mine > 0u ? mine : 1u; nx = cnt > 0u ? cnt : 1u;
}

__device__ __forceinline__ void xcd_barrier(const XcdBarrier& b) {
    asm volatile("s_waitcnt vmcnt(0)" ::: "memory");
    __syncthreads();
    if (threadIdx.x == 0) {
        unsigned* bar = b.bar;
        __builtin_amdgcn_s_waitcnt(0);
        unsigned nloc = b.st[0], nx = b.st[1];
        if (nloc == 0u) { xcd_barrier_complete(bar, b.x, nloc, nx); b.st[0] = nloc; b.st[1] = nx; }
        const unsigned old = xb_add(&bar[XB_XSUB(b.x)], 1u);
        const unsigned gen = old / nloc;
        if (old + 1u == (gen + 1u) * nloc) {
            __builtin_amdgcn_fence(__ATOMIC_RELEASE, "agent");
            asm volatile("s_waitcnt vmcnt(0)" ::: "memory");
            const unsigned og = xb_add(&bar[XB_TOP], 1u);
            const unsigned tg = og / nx;
            if (og + 1u == (tg + 1u) * nx) xb_add(&bar[XB_TOPGEN], 1u);
            else XB_SPIN(xb_ld(&bar[XB_TOPGEN]) == tg, bar);
            __builtin_amdgcn_fence(__ATOMIC_ACQUIRE, "agent");
            xb_add(&bar[XB_XGEN(b.x)], 1u);
            asm volatile("s_waitcnt vmcnt(0)" ::: "memory");
        } else {
            XB_SPIN(xb_ld(&bar[XB_XGEN(b.x)]) == gen, bar);
            __builtin_amdgcn_fence(__ATOMIC_ACQUIRE, "agent");
            asm volatile("s_waitcnt vmcnt(0)" ::: "memory");
        }
    }
    __syncthreads();
}

constexpr int NWAVES = 8, NTHR = 512;
constexpr int MTOK = 32768, DM = 1024, SEQ = 2048, NB = 16, DFF = 2816;
constexpr size_t MiB = 1u << 20;
constexpr size_t WS_CTL = 0, CTL_ZERO_BYTES = 64 * 1024;
constexpr size_t WS_W_MIXIN = 1 * MiB, WS_W_MIXOUT = 13 * MiB, WS_W_FFNIN = 17 * MiB, WS_W_FFNOUT = 28 * MiB;
constexpr size_t WS_GATESA = 34 * MiB, WS_SSQA = 35 * MiB, WS_STATC = 492 * MiB, WS_KMEAN = 41 * MiB, WS_SSQH = 42 * MiB, WS_SPTAB = 33 * MiB + 512 * 1024;
constexpr size_t WS_U = 44 * MiB, WS_BIG = 108 * MiB, WS_END = 500 * MiB;
constexpr int CW_BAR = 1024;
static_assert((CW_BAR + 3456) * 4 <= (int)CTL_ZERO_BYTES, "ctl");
constexpr int LDS_BYTES = 163840, MISC_OFF = 163584;

typedef unsigned u32x4 __attribute__((ext_vector_type(4)));
typedef unsigned u32x2 __attribute__((ext_vector_type(2)));
typedef float f32x2 __attribute__((ext_vector_type(2)));
struct Frame { LAS unsigned char* lds; int tid, lane, wave, G; };
struct Args { const void* in[24]; float* out; unsigned char* ws; int ph_lo, ph_hi; };

__device__ __forceinline__ float wave_sum(float v) {
#pragma unroll
    for (int o = 1; o < 64; o <<= 1) v += __shfl_xor(v, o);
    return v;
}
__device__ __forceinline__ float bf2f(bf16 b) { return __uint_as_float(((unsigned)b) << 16); }
__device__ __forceinline__ float lo_bf(unsigned w) { return __uint_as_float(w << 16); }
__device__ __forceinline__ float hi_bf(unsigned w) { return __uint_as_float(w & 0xffff0000u); }
__device__ __forceinline__ unsigned cvtpk(float lo, float hi) { return pg8::cvt_pk_bf16(lo, hi); }

typedef short v4s16 __attribute__((ext_vector_type(4)));
template <int LD> __device__ __forceinline__ bf16x8 tr_frag(const LAS bf16* T, int r0, int c0, int lane) {
    const int fr = lane & 15, fq = lane >> 4;
    const LAS bf16* a = T + (r0 + 8 * fq + (fr >> 2)) * LD + c0 + 4 * (fr & 3);
    const v4s16 lo = __builtin_amdgcn_ds_read_tr16_b64_v4i16((LAS v4s16*)a);
    const v4s16 hi = __builtin_amdgcn_ds_read_tr16_b64_v4i16((LAS v4s16*)(a + 4 * LD));
    return __builtin_shufflevector(lo, hi, 0, 1, 2, 3, 4, 5, 6, 7);
}
template <int MT, int NT, int K, int LDA, int LDB, bool TA = false, bool TB = false, bool SB = true>
__device__ __forceinline__ void wgemm(f32x4 (&acc)[MT][NT], const LAS bf16* A, const LAS bf16* Bt, int lane) {
    const int fr = lane & 15, fq = lane >> 4;
    const LAS bf16* ap = A + fr * LDA + 8 * fq;
    const LAS bf16* bp = Bt + fr * LDB + 8 * fq;
#pragma unroll
    for (int k0 = 0; k0 < K; k0 += 32) {
        bf16x8 a[MT], b[NT];
#pragma unroll
        for (int i = 0; i < MT; ++i) a[i] = TA ? tr_frag<LDA>(A, k0, 16 * i, lane) : *(const LAS bf16x8*)(ap + 16 * i * LDA + k0);
#pragma unroll
        for (int j = 0; j < NT; ++j) b[j] = TB ? tr_frag<LDB>(Bt, k0, 16 * j, lane) : *(const LAS bf16x8*)(bp + 16 * j * LDB + k0);
#pragma unroll
        for (int i = 0; i < MT; ++i)
#pragma unroll
            for (int j = 0; j < NT; ++j) acc[i][j] = __builtin_amdgcn_mfma_f32_16x16x32_bf16(a[i], b[j], acc[i][j], 0, 0, 0);
        if (SB && MT * NT >= 4) __builtin_amdgcn_sched_barrier(0);
    }
    if (!SB) __builtin_amdgcn_sched_barrier(0);
}

__device__ __forceinline__ int cvt_src_col(int mode, int g0) {
    if (mode == 0) return g0;
    const int pn = g0 >> 8, r = g0 & 255;
    if (mode == 1) return r < 128 ? 128 * pn + r : DFF + 128 * pn + (r - 128);
    return r < 128 ? 128 * pn + r : 256 + 128 * pn + (r - 128);
}
__device__ __forceinline__ void cvt_matrix(Frame& F, const float* W, int ldw, int K, int Np, int mode, bf16* WT, const float* gain = nullptr) {
    LAS float* scr = (LAS float*)(F.lds + F.wave * 16384);
    const int gw = blockIdx.x * NWAVES + F.wave, NGW = F.G * NWAVES, lane = F.lane;
    const int nblk = Np / 32, nitems = (K / 64) * nblk;
    float v[32], vn[32];
#define CVT_LOAD(dst, it) do { const int kb_ = (it) / nblk, nb_ = (it) % nblk, s0_ = cvt_src_col(mode, 32 * nb_); const float* wp_ = W + (size_t)(64 * kb_ + (lane >> 5)) * ldw + s0_ + (lane & 31); \
        _Pragma("unroll") for (int i = 0; i < 32; ++i) dst[i] = wp_[(size_t)(2 * i) * ldw]; } while (0)
    int item = gw;
    if (item < nitems) CVT_LOAD(v, item);
    for (; item < nitems; item += NGW) {
        const int kb = item / nblk, nb = item % nblk, k0 = 64 * kb, n0 = 32 * nb;
        if (item + NGW < nitems) CVT_LOAD(vn, item + NGW);
        if (gain) {
#pragma unroll
            for (int i = 0; i < 32; ++i) v[i] *= gain[k0 + 2 * i + (lane >> 5)]; }
#pragma unroll
        for (int i = 0; i < 32; ++i) scr[(2 * i + (lane >> 5)) * 33 + (lane & 31)] = v[i];
        LDS_WAIT(); asm volatile("" ::: "memory");
        const int c = lane & 7;
#pragma unroll
        for (int j = 0; j < 4; ++j) { const int n = (lane >> 3) + 8 * j; const LAS float* sp = scr + (8 * c) * 33 + n;
            v4u o; o.x = pk2(sp[0 * 33], sp[1 * 33]); o.y = pk2(sp[2 * 33], sp[3 * 33]); o.z = pk2(sp[4 * 33], sp[5 * 33]); o.w = pk2(sp[6 * 33], sp[7 * 33]);
            *(v4u*)(WT + (size_t)(n0 + n) * K + k0 + 8 * c) = o; }
        LDS_WAIT(); asm volatile("" ::: "memory");
#pragma unroll
        for (int i = 0; i < 32; ++i) v[i] = vn[i];
    }
#undef CVT_LOAD
}

template <bool GATES>
__device__ __forceinline__ void norm_phase(Frame& F, const float* src, const float* gain, bf16* dst, const float* wA, const float* bA, float* gout) {
    LAS float* wg = (LAS float*)F.lds;
    if (GATES) {
        for (int i = F.tid; i < 1024 * 8; i += NTHR) wg[i] = wA[(size_t)(i >> 3) * 3080 + 3072 + (i & 7)];
        __syncthreads();
    }
    const int gw = blockIdx.x * NWAVES + F.wave, NGW = F.G * NWAVES, lane = F.lane;
    f32x4 g[4];
#pragma unroll
    for (int j = 0; j < 4; ++j) g[j] = ((const f32x4*)gain)[lane + 64 * j];
    for (int m = gw; m < MTOK; m += NGW) {
        const f32x4* xr = (const f32x4*)(src + (size_t)m * DM) + lane;
        f32x4 v[4]; float s = 0.f;
#pragma unroll
        for (int j = 0; j < 4; ++j) { v[j] = xr[64 * j]; s += (v[j].x * v[j].x + v[j].y * v[j].y) + (v[j].z * v[j].z + v[j].w * v[j].w); }
        const float rstd = 1.0f / sqrtf(wave_sum(s) * (1.0f / DM) + 1e-6f);
        unsigned long long* o8 = (unsigned long long*)(dst + (size_t)m * DM) + lane;
#pragma unroll
        for (int j = 0; j < 4; ++j) { v[j] = v[j] * rstd * g[j];
            o8[64 * j] = (unsigned long long)cvtpk(v[j].x, v[j].y) | ((unsigned long long)cvtpk(v[j].z, v[j].w) << 32); }
        if (GATES) {
            float a[8];
#pragma unroll
            for (int q = 0; q < 8; ++q) a[q] = 0.f;
#pragma unroll
            for (int j = 0; j < 4; ++j)
#pragma unroll
                for (int e = 0; e < 4; ++e) { const int k = 4 * lane + 256 * j + e; const f32x4 w0 = *(const LAS f32x4*)(wg + k * 8), w1 = *(const LAS f32x4*)(wg + k * 8 + 4); const float x = v[j][e];
                    a[0] += x * w0.x; a[1] += x * w0.y; a[2] += x * w0.z; a[3] += x * w0.w; a[4] += x * w1.x; a[5] += x * w1.y; a[6] += x * w1.z; a[7] += x * w1.w; }
#pragma unroll
            for (int q = 0; q < 8; ++q) a[q] = wave_sum(a[q]);
            if (lane == 0) {
#pragma unroll
                for (int q = 0; q < 8; ++q) gout[(size_t)m * 8 + q] = a[q] + bA[q]; }
        }
    }
}

__device__ __forceinline__ void mlstm_pre(Frame& F, const float* gates, float* GT) {
    LAS float* sA = (LAS float*)F.lds, *sPM = sA + 2048, *sBC = sPM + 2048, *sBT = sBC + 2048, *sP63 = sBT + 32, *sM = sP63 + 32;
    const int lane = F.lane, w = F.wave;
    for (int item = blockIdx.x; item < 64; item += F.G) {
        const int b = item >> 2, h = item & 3;
        __syncthreads();
        float gi4[4], gf4[4];
#pragma unroll
        for (int i = 0; i < 4; ++i) { const size_t row = (size_t)b * SEQ + (w + 8 * i) * 64 + lane; gi4[i] = gates[row * 8 + h]; gf4[i] = gates[row * 8 + 4 + h]; }
#pragma unroll
        for (int i = 0; i < 4; ++i) { const int c = w + 8 * i;
            const float gi = gi4[i], gf = gf4[i];
            const float fc = fminf(gf, 0.f) - log1pf(__expf(-fabsf(gf)));
            float bc = fc;
#pragma unroll
            for (int o = 1; o < 64; o <<= 1) { const float t = __shfl_up(bc, o); if (lane >= o) bc += t; }
            const float a = gi - bc; float pm = a;
#pragma unroll
            for (int o = 1; o < 64; o <<= 1) { const float t = __shfl_up(pm, o); if (lane >= o) pm = fmaxf(pm, t); }
            sA[c * 64 + lane] = a; sPM[c * 64 + lane] = pm; sBC[c * 64 + lane] = bc; if (lane == 63) { sBT[c] = bc; sP63[c] = pm; } }
        __syncthreads();
        if (F.tid == 0) { float m = 0.f; for (int c = 0; c < 32; ++c) { sM[c] = m; m = sBT[c] + fmaxf(m, sP63[c]); } }
        __syncthreads();
#pragma unroll
        for (int i = 0; i < 4; ++i) { const int c = w + 8 * i; const float mst = sM[c], Mx = fmaxf(mst, sPM[c * 64 + lane]), Mx63 = fmaxf(mst, sP63[c]);
            float* g = GT + ((size_t)(item * 32 + c)) * 320 + lane;
            g[0] = sA[c * 64 + lane]; g[64] = Mx; g[128] = __expf(mst - Mx); g[192] = __expf(-(sBC[c * 64 + lane] + Mx)); g[256] = __expf(sA[c * 64 + lane] - Mx63); }
    }
}
__device__ __forceinline__ void mlstm_pmat(Frame& F, const bf16* QKV, const float* GT, bf16* PMA, float* DENP) {
    constexpr float SCALE = 0.08838834764831845f;
    LAS bf16* Qs = (LAS bf16*)F.lds;
    LAS bf16* Ks = Qs + 64 * 136;
    LAS bf16* Ps = Ks + 64 * 136;
    LAS float* fA = (LAS float*)(Ps + 64 * 72), *fMX = fA + 64;
    const int tid = F.tid, lane = F.lane, w = F.wave, fr = lane & 15, fq = lane >> 4, wh = w >> 1, wl = w & 1;
    const unsigned qoff0 = (unsigned)((((tid >> 4) * 2048) + (tid & 15) * 8) * 2);
    v4u pQ[2], pK[2]; float pg = 0.f;
    int item = blockIdx.x;
    if (item < 2048) { const int bh = item >> 5, c = item & 31; const char* gq = (const char*)(QKV + ((size_t)(bh >> 2) * SEQ + c * 64) * 2048 + (bh & 3) * 128);
#pragma unroll
        for (int i = 0; i < 2; ++i) { pQ[i] = *(const v4u*)(gq + qoff0 + i * (32 * 2048 * 2)); pK[i] = *(const v4u*)(gq + qoff0 + i * (32 * 2048 * 2) + 1024); }
        if (tid < 128) pg = GT[(size_t)item * 320 + tid]; }
    for (; item < 2048; item += F.G) {
        __syncthreads();
#pragma unroll
        for (int i = 0; i < 2; ++i) { const int id = tid + NTHR * i, row = id >> 4, c8 = id & 15; *(LAS v4u*)(Qs + row * 136 + c8 * 8) = pQ[i]; *(LAS v4u*)(Ks + row * 136 + c8 * 8) = pK[i]; }
        if (tid < 128) fA[tid] = pg;
        const int nit = item + F.G;
        if (nit < 2048) { const int bh = nit >> 5, c = nit & 31; const char* gq = (const char*)(QKV + ((size_t)(bh >> 2) * SEQ + c * 64) * 2048 + (bh & 3) * 128);
#pragma unroll
            for (int i = 0; i < 2; ++i) { pQ[i] = *(const v4u*)(gq + qoff0 + i * (32 * 2048 * 2)); pK[i] = *(const v4u*)(gq + qoff0 + i * (32 * 2048 * 2) + 1024); }
            if (tid < 128) pg = GT[(size_t)nit * 320 + tid]; }
        __syncthreads();
        f32x4 sa[1][2]; sa[0][0] = (f32x4){0.f, 0.f, 0.f, 0.f}; sa[0][1] = sa[0][0];
        wgemm<1, 2, 128, 136, 136>(sa, Qs + 16 * wh * 136, Ks + 32 * wl * 136, lane);
        float rs[4] = {0.f, 0.f, 0.f, 0.f};
#pragma unroll
        for (int e = 0; e < 4; ++e) { const int t = 16 * wh + 4 * fq + e; const float mx = fMX[t];
#pragma unroll
            for (int j = 0; j < 2; ++j) { const int sidx = 32 * wl + 16 * j + fr; const float wgt = (sidx <= t) ? SCALE * __expf(fA[sidx] - mx) : 0.f; const float p = sa[0][j][e] * wgt;
                Ps[t * 72 + sidx] = (bf16)f2bf(p); rs[e] += p; } }
#pragma unroll
        for (int e = 0; e < 4; ++e) { float r = rs[e]; r += __shfl_xor(r, 1); r += __shfl_xor(r, 2); r += __shfl_xor(r, 4); r += __shfl_xor(r, 8); if (fr == 0) DENP[(size_t)item * 128 + wl * 64 + 16 * wh + 4 * fq + e] = r; }
        __syncthreads();
        *(v4u*)(PMA + (size_t)item * 4096 + (tid >> 3) * 64 + (tid & 7) * 8) = *(const LAS v4u*)(Ps + (tid >> 3) * 72 + (tid & 7) * 8);
    }
}
__device__ __forceinline__ void mlstm_core(Frame& F, const bf16* QKV, const float* GT, const bf16* PMA, const float* DENP, bf16* hout, float* ssq) {
    constexpr float SCALE = 0.08838834764831845f;
    LAS bf16* Qs = (LAS bf16*)F.lds;
    LAS bf16* Ks = Qs + 64 * 136;
    LAS bf16* Vs = Ks + 64 * 136;
    LAS bf16* VWs = Vs + 64 * 88;
    LAS bf16* Cb = VWs + 64 * 88;
    LAS bf16* Ps = Cb + 80 * 136;
    LAS bf16* Hs = Ps + 64 * 72;
    const int tid = F.tid, lane = F.lane, w = F.wave, fr = lane & 15, fq = lane >> 4, wh = w >> 1, wl = w & 1;
    const unsigned qoff0 = (unsigned)((((tid >> 4) * 2048) + (tid & 15) * 8) * 2), voff0 = (unsigned)((((tid >> 3) * 2048) + (tid & 7) * 8) * 2);
    for (int item = blockIdx.x; item < 256; item += F.G) {
        const int b = item >> 4, h = (item >> 2) & 3, vs = item & 3, bh = b * 4 + h;
        f32x4 Cacc[1][4], Cn[1][1];
#pragma unroll
        for (int j = 0; j < 4; ++j) Cacc[0][j] = (f32x4){0.f, 0.f, 0.f, 0.f};
        Cn[0][0] = (f32x4){0.f, 0.f, 0.f, 0.f};
        const size_t tb = (size_t)b * SEQ;
        v4u pQ[2], pK[2], pV, pP; float pws, pwc, pwi[4], pem[4], pdn[4];
#define MLSTM_FETCH(cc) do { const size_t t0_ = tb + (size_t)(cc) * 64; const char* gq_ = (const char*)(QKV + t0_ * 2048 + h * 128); const char* gv_ = (const char*)(QKV + t0_ * 2048 + 1024 + h * 256 + vs * 64); \
            _Pragma("unroll") for (int i = 0; i < 2; ++i) { pQ[i] = *(const v4u*)(gq_ + qoff0 + i * (32 * 2048 * 2)); pK[i] = *(const v4u*)(gq_ + qoff0 + i * (32 * 2048 * 2) + 1024); } \
            pV = *(const v4u*)(gv_ + voff0); const size_t it_ = (size_t)(bh * 32 + (cc)); pP = *(const v4u*)(PMA + it_ * 4096 + (tid >> 3) * 64 + (tid & 7) * 8); \
            const float* g_ = GT + it_ * 320; pws = g_[256 + (tid >> 3)]; pwc = g_[128 + 63]; \
            _Pragma("unroll") for (int e = 0; e < 4; ++e) { const int t_ = 16 * wh + 4 * fq + e; pwi[e] = g_[128 + t_]; pem[e] = g_[192 + t_]; pdn[e] = DENP[it_ * 128 + t_] + DENP[it_ * 128 + 64 + t_]; } } while (0)
        MLSTM_FETCH(0);
        for (int c = 0; c < 32; ++c) {
            const size_t t0 = tb + c * 64;
            __syncthreads();
            v4u hprev; if (c > 0) hprev = *(const LAS v4u*)(Hs + (tid >> 3) * 72 + (tid & 7) * 8);
#pragma unroll
            for (int j = 0; j < 4; ++j)
#pragma unroll
                for (int e = 0; e < 4; ++e) Cb[(16 * wh + 4 * fq + e) * 136 + 64 * wl + 16 * j + fr] = (bf16)f2bf(Cacc[0][j][e]);
#pragma unroll
            for (int e = 0; e < 4; ++e) Cb[(64 + 4 * fq + e) * 136 + 16 * w + fr] = (bf16)f2bf(Cn[0][0][e]);
#pragma unroll
            for (int i = 0; i < 2; ++i) { const int id = tid + NTHR * i, row = id >> 4, c8 = id & 15; *(LAS v4u*)(Qs + row * 136 + c8 * 8) = pQ[i]; *(LAS v4u*)(Ks + row * 136 + c8 * 8) = pK[i]; }
            { const int srow = tid >> 3, c8 = tid & 7; const float wsv = pws;
                *(LAS v4u*)(Vs + srow * 88 + c8 * 8) = pV;
                v4u o; o.x = cvtpk(lo_bf(pV.x) * wsv, hi_bf(pV.x) * wsv); o.y = cvtpk(lo_bf(pV.y) * wsv, hi_bf(pV.y) * wsv); o.z = cvtpk(lo_bf(pV.z) * wsv, hi_bf(pV.z) * wsv); o.w = cvtpk(lo_bf(pV.w) * wsv, hi_bf(pV.w) * wsv);
                *(LAS v4u*)(VWs + srow * 88 + c8 * 8) = o;
                if (c8 < 2) { v4u one; one.x = c8 == 0 ? 0x3f80u : 0u; one.y = 0u; one.z = 0u; one.w = 0u; *(LAS v4u*)(Vs + srow * 88 + 64 + c8 * 8) = one;
                    v4u wv; wv.x = c8 == 0 ? (cvtpk(wsv, 0.f) & 0xffffu) : 0u; wv.y = 0u; wv.z = 0u; wv.w = 0u; *(LAS v4u*)(VWs + srow * 88 + 64 + c8 * 8) = wv; }
                *(LAS v4u*)(Ps + srow * 72 + c8 * 8) = pP; }
            float wi[4], em[4], dn[4]; const float wc = pwc;
#pragma unroll
            for (int e = 0; e < 4; ++e) { wi[e] = pwi[e]; em[e] = pem[e]; dn[e] = pdn[e]; }
            if (c < 31) MLSTM_FETCH(c + 1);
            if (c > 0) *(v4u*)(hout + (t0 - 64 + (tid >> 3)) * 1024 + h * 256 + vs * 64 + (tid & 7) * 8) = hprev;
            __syncthreads();
            f32x4 ni[1][2], nx[1][2], nq[1][1]; ni[0][0] = (f32x4){0.f, 0.f, 0.f, 0.f}; ni[0][1] = ni[0][0]; nx[0][0] = ni[0][0]; nx[0][1] = ni[0][0]; nq[0][0] = ni[0][0];
            wgemm<1, 2, 64, 72, 88, false, true>(ni, Ps + 16 * wh * 72, Vs + 32 * wl, lane);
            wgemm<1, 2, 128, 136, 136>(nx, Qs + 16 * wh * 136, Cb + 32 * wl * 136, lane);
            wgemm<1, 1, 128, 136, 136>(nq, Qs + 16 * wh * 136, Cb + 64 * 136, lane);
#pragma unroll
            for (int e = 0; e < 4; ++e) { const int t = 16 * wh + 4 * fq + e;
                const float nqt = __shfl(nq[0][0][e], lane & 48);
                const float den = dn[e] + wi[e] * SCALE * nqt; const float inv = 1.0f / fmaxf(fabsf(den), em[e]); float q2 = 0.f;
#pragma unroll
                for (int j = 0; j < 2; ++j) { const float hv = (ni[0][j][e] + SCALE * wi[e] * nx[0][j][e]) * inv; q2 += hv * hv;
                    Hs[t * 72 + 32 * wl + 16 * j + fr] = (bf16)f2bf(hv); }
                q2 += __shfl_xor(q2, 1); q2 += __shfl_xor(q2, 2); q2 += __shfl_xor(q2, 4); q2 += __shfl_xor(q2, 8);
                if (fr == 0) ssq[(t0 + t) * 32 + (h * 4 + vs) * 2 + wl] = q2; }
#pragma unroll
            for (int j = 0; j < 4; ++j) Cacc[0][j] = Cacc[0][j] * wc;
            Cn[0][0] = Cn[0][0] * wc;
            wgemm<1, 4, 64, 88, 136, true, true>(Cacc, VWs + 16 * wh, Ks + 64 * wl, lane);
            wgemm<1, 1, 64, 88, 136, true, true>(Cn, VWs + 64, Ks + 16 * w, lane);
        }
        __syncthreads();
        *(v4u*)(hout + (tb + 31 * 64 + (tid >> 3)) * 1024 + h * 256 + vs * 64 + (tid & 7) * 8) = *(const LAS v4u*)(Hs + (tid >> 3) * 72 + (tid & 7) * 8);
#undef MLSTM_FETCH
    }
}

__device__ __forceinline__ void moba_prep(Frame& F, bf16* QK, const int* pos, const float* gq, const float* gk, float* kpart) {
    LAS float* part = (LAS float*)F.lds;
    const int lane = F.lane, w = F.wave, c = lane & 15;
    float gqv[8], gkv[8], inv[8];
#pragma unroll
    for (int e = 0; e < 8; ++e) { gqv[e] = gq[c * 8 + e]; gkv[e] = gk[c * 8 + e]; inv[e] = exp2f(-(float)(8 * (c & 1) + e) * (18.931568569324174f / 16.0f)); }
    for (int item = blockIdx.x; item < 256; item += F.G) {
        const int b = item >> 4, blk = (item >> 1) & 7, half = item & 1;
        const size_t row0 = (size_t)b * SEQ + blk * 256 + half * 128 + 16 * w;
        float kacc[2][8];
#pragma unroll
        for (int i = 0; i < 2; ++i)
#pragma unroll
            for (int e = 0; e < 8; ++e) kacc[i][e] = 0.f;
        v4u cur[4], nxt[4];
#pragma unroll
        for (int i4 = 0; i4 < 4; ++i4) cur[i4] = *(const v4u*)(QK + row0 * 2048 + (lane + 64 * i4) * 8);
        for (int t = 0; t < 16; ++t) {
            const size_t row = row0 + t;
            if (t < 15) {
#pragma unroll
                for (int i4 = 0; i4 < 4; ++i4) nxt[i4] = *(const v4u*)(QK + (row + 1) * 2048 + (lane + 64 * i4) * 8); }
            float cs[8], sn[8];
            if (c < 4) { const float ps = (float)pos[row];
#pragma unroll
                for (int e = 0; e < 8; ++e) sincosf(ps * inv[e], &sn[e], &cs[e]); }
            else {
#pragma unroll
                for (int e = 0; e < 8; ++e) { cs[e] = 1.f; sn[e] = 0.f; } }
#pragma unroll
            for (int i4 = 0; i4 < 4; ++i4) {
                const unsigned xw[4] = {cur[i4].x, cur[i4].y, cur[i4].z, cur[i4].w}; float y[8]; float ss = 0.f;
#pragma unroll
                for (int e = 0; e < 4; ++e) { y[2 * e] = lo_bf(xw[e]); y[2 * e + 1] = hi_bf(xw[e]); ss += y[2 * e] * y[2 * e] + y[2 * e + 1] * y[2 * e + 1]; }
                ss += __shfl_xor(ss, 1); ss += __shfl_xor(ss, 2); ss += __shfl_xor(ss, 4); ss += __shfl_xor(ss, 8);
                const float rstd = 1.0f / sqrtf(ss * (1.0f / 128.0f) + 1e-6f);
#pragma unroll
                for (int e = 0; e < 8; ++e) { y[e] = y[e] * rstd * (i4 < 2 ? gqv[e] : gkv[e]); }
#pragma unroll
                for (int e = 0; e < 8; ++e) { const float o = __shfl_xor(y[e], 2); y[e] = (c < 2) ? y[e] * cs[e] - o * sn[e] : (c < 4 ? y[e] * cs[e] + o * sn[e] : y[e]); }
                v4u ov; ov.x = cvtpk(y[0], y[1]); ov.y = cvtpk(y[2], y[3]); ov.z = cvtpk(y[4], y[5]); ov.w = cvtpk(y[6], y[7]);
                *(v4u*)(QK + row * 2048 + (lane + 64 * i4) * 8) = ov;
                if (i4 >= 2) {
#pragma unroll
                    for (int e = 0; e < 8; ++e) kacc[i4 - 2][e] += y[e]; }
            }
#pragma unroll
            for (int i4 = 0; i4 < 4; ++i4) cur[i4] = nxt[i4];
        }
        __syncthreads();
#pragma unroll
        for (int i = 0; i < 2; ++i)
#pragma unroll
            for (int e = 0; e < 8; ++e) part[w * 1024 + i * 512 + lane * 8 + e] = kacc[i][e];
        __syncthreads();
        for (int col = F.tid; col < 1024; col += NTHR) { float sacc = 0.f;
#pragma unroll
            for (int ww = 0; ww < 8; ++ww) sacc += part[ww * 1024 + col];
            kpart[((size_t)(b * 8 + blk) * 2 + half) * 1024 + col] = sacc * (1.0f / 256.0f); }
    }
}
__device__ __forceinline__ void moba_attn(Frame& F, const bf16* QK, const bf16* Vt, const float* kpart, bf16* O) {
    constexpr float SCALE = 0.08838834764831845f;
    constexpr int KVB = 64 * 136 + 128 * 72;
    LAS bf16* R = (LAS bf16*)F.lds;
    LAS bf16* Qs = R;
    LAS float* kmS = (LAS float*)(R + 2 * KVB);
    LAS float* gsc = kmS + 1024;
    LAS unsigned* selm = (LAS unsigned*)(gsc + 2048);
    const int tid = F.tid, lane = F.lane, w = F.wave, fr = lane & 15, fq = lane >> 4;
    for (int it = blockIdx.x; it < 1024; it += F.G) {
        const int c = it & 255, r = it >> 8, bh = c & 127, typ = c >> 7, b = bh >> 3, h = bh & 7;
        const int jb = (r & 1) ? 7 - (r >> 1) : (r >> 1);
        const int j = typ ? ((r & 1) ? jb - 2 : jb + 2) : jb;
        const size_t qrow0 = (size_t)b * SEQ + j * 256;
        __syncthreads();
#pragma unroll
        for (int i = 0; i < 8; ++i) { const int id = tid + NTHR * i, row = id >> 4, c8 = id & 15;
            *(LAS v4u*)(Qs + row * 136 + c8 * 8) = *(const v4u*)(QK + (qrow0 + row) * 2048 + h * 128 + c8 * 8); }
        for (int i = tid; i < 1024; i += NTHR) { const int kb_ = i >> 7, d_ = i & 127; const float* kp = kpart + ((size_t)(b * 8 + kb_) * 2) * 1024 + h * 128 + d_; kmS[i] = kp[0] + kp[1024]; }
        __syncthreads();
        if (j > 3) { const int q = tid >> 1, p = tid & 1;
            for (int e = 0; e < 4; ++e) { const int blk = 4 * p + e; float sdot = 0.f;
                if (blk < j) { for (int d = 0; d < 128; ++d) sdot += bf2f(Qs[q * 136 + d]) * kmS[blk * 128 + d]; }
                gsc[q * 8 + blk] = sdot; } }
        __syncthreads();
        if (tid < 256) { unsigned mask = 0u;
            if (j <= 3) mask = (1u << j) - 1u;
            else { for (int k = 0; k < 3; ++k) { float best = -INFINITY; int bi = 0;
                    for (int blk = 0; blk < j; ++blk) { const float gv = gsc[tid * 8 + blk]; if (!((mask >> blk) & 1u) && gv > best) { best = gv; bi = blk; } }
                    mask |= 1u << bi; } }
            selm[tid] = mask; }
        bf16x8 qf[2][4];
#pragma unroll
        for (int i = 0; i < 2; ++i)
#pragma unroll
            for (int ks = 0; ks < 4; ++ks) qf[i][ks] = *(const LAS bf16x8*)(Qs + (32 * w + 16 * i + fr) * 136 + 32 * ks + 8 * fq);
        __syncthreads();
        const unsigned masks = selm[32 * w + fr] | (selm[32 * w + 16 + fr] << 8);
        f32x4 oacc[2][8];
#pragma unroll
        for (int i = 0; i < 2; ++i)
#pragma unroll
            for (int vt = 0; vt < 8; ++vt) oacc[i][vt] = (f32x4){0.f, 0.f, 0.f, 0.f};
        float mrun[2] = {-INFINITY, -INFINITY}, lrun[2] = {0.f, 0.f};
        const int ntile = 4 * j + 4;
        const bf16* kbase = QK + ((size_t)b * SEQ) * 2048 + 1024 + h * 128;
        const bf16* vbase = Vt + ((size_t)h * 128) * MTOK + (size_t)b * SEQ;
        v4u pk[2], pv[2];
#define KOFF(id) ((unsigned)((((id) >> 4) * 2048 + ((id) & 15) * 8) * 2))
#define VOFF(id) ((unsigned)((((id) >> 3) * MTOK + ((id) & 7) * 8) * 2))
#pragma unroll
        for (int i = 0; i < 2; ++i) { const int id = tid + NTHR * i; pk[i] = *(const v4u*)((const char*)kbase + KOFF(id)); pv[i] = *(const v4u*)((const char*)vbase + VOFF(id)); }
#pragma unroll
        for (int i = 0; i < 2; ++i) { const int id = tid + NTHR * i; *(LAS v4u*)(R + (id >> 4) * 136 + (id & 15) * 8) = pk[i]; *(LAS v4u*)(R + 64 * 136 + (id >> 3) * 72 + (id & 7) * 8) = pv[i]; }
        __syncthreads();
        for (int tile = 0; tile < ntile; ++tile) {
            const int kb = tile >> 2, key0 = tile * 64;
            LAS bf16* Ks = R + (tile & 1) * KVB; LAS bf16* VTs = Ks + 64 * 136;
            int tl = tid; asm volatile("" : "+v"(tl));
            if (tile + 1 < ntile) {
#pragma unroll
                for (int i = 0; i < 2; ++i) { const int id = tl + NTHR * i; pk[i] = *(const v4u*)((const char*)(kbase + (size_t)(key0 + 64) * 2048) + KOFF(id)); pv[i] = *(const v4u*)((const char*)(vbase + key0 + 64) + VOFF(id)); } }
            const bool own = (kb == j);
            const bool sel0 = own || ((masks >> kb) & 1u), sel1 = own || ((masks >> (8 + kb)) & 1u);
            const bool active = own ? (key0 - j * 256 <= 32 * w + 31) : (__ballot(sel0 || sel1) != 0ull);
            if (active) {
                f32x4 st[2][4];
#pragma unroll
                for (int kt = 0; kt < 4; ++kt) { st[0][kt] = (f32x4){0.f, 0.f, 0.f, 0.f}; st[1][kt] = st[0][kt];
#pragma unroll
                    for (int ks = 0; ks < 4; ++ks) { const bf16x8 kf = *(const LAS bf16x8*)(Ks + (16 * kt + fr) * 136 + 32 * ks + 8 * fq);
                        st[0][kt] = __builtin_amdgcn_mfma_f32_16x16x32_bf16(kf, qf[0][ks], st[0][kt], 0, 0, 0);
                        st[1][kt] = __builtin_amdgcn_mfma_f32_16x16x32_bf16(kf, qf[1][ks], st[1][kt], 0, 0, 0); } }
#if !defined(ATT_NOSB)
                __builtin_amdgcn_sched_barrier(0);
#endif
                bf16x8 pf[2][2]; float alpha[2];
                constexpr float C2 = SCALE * 1.4426950408889634f;
#pragma unroll
                for (int i = 0; i < 2; ++i) {
                    const bool lsel = i ? sel1 : sel0;
                    float mloc = -INFINITY;
                    if (own) { const int qpos = j * 256 + 32 * w + 16 * i + fr;
#pragma unroll
                        for (int kt = 0; kt < 4; ++kt)
#pragma unroll
                            for (int e = 0; e < 4; ++e) { const int kpos = key0 + 16 * kt + 4 * fq + e; const float sv = (kpos <= qpos) ? st[i][kt][e] : -INFINITY; st[i][kt][e] = sv; mloc = fmaxf(mloc, sv); } }
                    else {
#pragma unroll
                        for (int kt = 0; kt < 4; ++kt)
#pragma unroll
                            for (int e = 0; e < 4; ++e) mloc = fmaxf(mloc, st[i][kt][e]); }
                    mloc = fmaxf(mloc, __shfl_xor(mloc, 16)); mloc = fmaxf(mloc, __shfl_xor(mloc, 32));
                    const float mnew = lsel ? fmaxf(mrun[i], mloc * C2) : mrun[i], msafe = (mnew == -INFINITY) ? 0.f : mnew;
                    alpha[i] = __builtin_amdgcn_exp2f(mrun[i] - msafe);
                    const float moff = lsel ? msafe : INFINITY;
                    float psum = 0.f;
#pragma unroll
                    for (int kk = 0; kk < 2; ++kk) { float pp[8];
#pragma unroll
                        for (int e = 0; e < 4; ++e) { pp[e] = __builtin_amdgcn_exp2f(__builtin_fmaf(st[i][2 * kk][e], C2, -moff)); pp[4 + e] = __builtin_amdgcn_exp2f(__builtin_fmaf(st[i][2 * kk + 1][e], C2, -moff)); }
#pragma unroll
                        for (int e = 0; e < 8; ++e) psum += pp[e];
                        u32x4 pw; pw.x = cvtpk(pp[0], pp[1]); pw.y = cvtpk(pp[2], pp[3]); pw.z = cvtpk(pp[4], pp[5]); pw.w = cvtpk(pp[6], pp[7]);
                        pf[i][kk] = __builtin_bit_cast(bf16x8, pw); }
                    lrun[i] = lrun[i] * alpha[i] + psum; mrun[i] = mnew;
                }
                const bool rescale = __ballot(alpha[0] != 1.0f || alpha[1] != 1.0f) != 0ull;
#if !defined(ATT_NOSB)
                __builtin_amdgcn_sched_barrier(0);
#endif
#pragma unroll
                for (int vt = 0; vt < 8; ++vt) { if (rescale) { oacc[0][vt] = oacc[0][vt] * alpha[0]; oacc[1][vt] = oacc[1][vt] * alpha[1]; }
#pragma unroll
                    for (int kk = 0; kk < 2; ++kk) { const LAS bf16* vp = VTs + (16 * vt + fr) * 72 + 32 * kk + 4 * fq;
                        const u32x2 v0 = *(const LAS u32x2*)vp, v1 = *(const LAS u32x2*)(vp + 16);
                        u32x4 vw; vw.x = v0.x; vw.y = v0.y; vw.z = v1.x; vw.w = v1.y; const bf16x8 vf = __builtin_bit_cast(bf16x8, vw);
                        oacc[0][vt] = __builtin_amdgcn_mfma_f32_16x16x32_bf16(vf, pf[0][kk], oacc[0][vt], 0, 0, 0);
                        oacc[1][vt] = __builtin_amdgcn_mfma_f32_16x16x32_bf16(vf, pf[1][kk], oacc[1][vt], 0, 0, 0); } }
            }
            if (tile + 1 < ntile) { LAS bf16* Kn = R + ((tile + 1) & 1) * KVB;
#pragma unroll
                for (int i = 0; i < 2; ++i) { const int id = tl + NTHR * i; *(LAS v4u*)(Kn + (id >> 4) * 136 + (id & 15) * 8) = pk[i]; *(LAS v4u*)(Kn + 64 * 136 + (id >> 3) * 72 + (id & 7) * 8) = pv[i]; } }
            __syncthreads();
        }
#undef KOFF
#undef VOFF
#pragma unroll
        for (int i = 0; i < 2; ++i) { float l = lrun[i]; l += __shfl_xor(l, 16); l += __shfl_xor(l, 32); const float il = 1.0f / l;
            bf16* orow = O + (qrow0 + 32 * w + 16 * i + fr) * 1024 + h * 128;
#pragma unroll
            for (int vt = 0; vt < 8; ++vt) { u32x2 o; o.x = cvtpk(oacc[i][vt][0] * il, oacc[i][vt][1] * il); o.y = cvtpk(oacc[i][vt][2] * il, oacc[i][vt][3] * il);
                *(u32x2*)(orow + 16 * vt + 4 * fq) = o; } }
    }
}

__device__ __forceinline__ void ret_rot_table(Frame& F, const int* pos, float* cst) {
    const int gw = blockIdx.x * NWAVES + F.wave, NGW = F.G * NWAVES, lane = F.lane;
    const float i0 = exp2f(-(float)(2 * lane) * (13.287712379549449f / 128.0f)), i1 = exp2f(-(float)(2 * lane + 1) * (13.287712379549449f / 128.0f));
    for (int m = gw; m < MTOK; m += NGW) {
        const float ps = (float)pos[m]; float s0, c0, s1, c1; sincosf(ps * i0, &s0, &c0); sincosf(ps * i1, &s1, &c1);
        f32x2* cp = (f32x2*)(cst + (size_t)m * 256) + lane; cp[0] = (f32x2){c0, c1}; cp[64] = (f32x2){s0, s1};
    }
}
__device__ __forceinline__ void ret_pmat(Frame& F, const bf16* QKV, bf16* PM) {
    LAS bf16* Qd = (LAS bf16*)F.lds;
    LAS bf16* Kd = Qd + 128 * 72;
    LAS bf16* Ps = Kd + 128 * 72;
    const int tid = F.tid, lane = F.lane, w = F.wave, fr = lane & 15, fq = lane >> 4, wh = w >> 1, wl = w & 1;
    const unsigned off0 = (unsigned)((((tid >> 3) * 4096) + (tid & 7) * 8) * 2);
    for (int item = blockIdx.x; item < 1024; item += F.G) {
        const int b = item >> 6, h = (item >> 4) & 3, c = item & 15;
        const float lgc = log1pf(-exp2f(-5.0f - (float)h)) * 1.4426950408889634f;
        const char* gq = (const char*)(QKV + ((size_t)b * SEQ + c * 128) * 4096 + h * 256);
        v4u pq[2], pkk[2];
#pragma unroll
        for (int i = 0; i < 2; ++i) { const char* src = gq + off0 + i * (64 * 4096 * 2); pq[i] = *(const v4u*)src; pkk[i] = *(const v4u*)(src + 2048); }
        f32x4 S[2][4];
#pragma unroll
        for (int i = 0; i < 2; ++i)
#pragma unroll
            for (int jj = 0; jj < 4; ++jj) S[i][jj] = (f32x4){0.f, 0.f, 0.f, 0.f};
#pragma unroll 1
        for (int dt = 0; dt < 4; ++dt) {
            __syncthreads();
#pragma unroll
            for (int i = 0; i < 2; ++i) { const int id = tid + NTHR * i, row = id >> 3, c8 = id & 7; *(LAS v4u*)(Qd + row * 72 + c8 * 8) = pq[i]; *(LAS v4u*)(Kd + row * 72 + c8 * 8) = pkk[i]; }
            if (dt < 3) {
#pragma unroll
                for (int i = 0; i < 2; ++i) { const char* src = gq + (dt + 1) * 128 + off0 + i * (64 * 4096 * 2); pq[i] = *(const v4u*)src; pkk[i] = *(const v4u*)(src + 2048); } }
            __syncthreads();
            wgemm<2, 4, 64, 72, 72>(S, Qd + 32 * wh * 72, Kd + 64 * wl * 72, lane);
        }
#pragma unroll
        for (int i = 0; i < 2; ++i)
#pragma unroll
            for (int e = 0; e < 4; ++e) { const int t = 32 * wh + 16 * i + 4 * fq + e;
#pragma unroll
                for (int jj = 0; jj < 4; ++jj) { const int sidx = 64 * wl + 16 * jj + fr; const float wgt = (t >= sidx) ? __builtin_amdgcn_exp2f((float)(t - sidx) * lgc) : 0.f;
                    Ps[t * 136 + sidx] = (bf16)f2bf(S[i][jj][e] * wgt); } }
        __syncthreads();
        bf16* dst = PM + (size_t)item * 128 * 128;
#pragma unroll
        for (int i = 0; i < 4; ++i) { const int id = tid + NTHR * i, row = id >> 4, c8 = id & 15; *(v4u*)(dst + row * 128 + c8 * 8) = *(const LAS v4u*)(Ps + row * 136 + c8 * 8); }
    }
}
#ifndef RET_EXP
#define RET_EXP 0
#endif
__device__ __forceinline__ void ret_core(Frame& F, bf16* QKV, const bf16* PM, float* st) {
    constexpr int TSET = 3 * 128 * 72;
    LAS bf16* T0 = (LAS bf16*)F.lds;
    LAS bf16* Vs = T0 + 2 * TSET;
    LAS bf16* Ps = T0;
    LAS bf16* Xs = T0 + TSET;
    LAS float* fST = (LAS float*)(Vs + 128 * 136);
    const int tid = F.tid, lane = F.lane, w = F.wave, fr = lane & 15, fq = lane >> 4, wh = w >> 1, wl = w & 1;
    const unsigned off8 = (unsigned)((((tid >> 3) * 4096) + (tid & 7) * 8) * 2);
    const unsigned off16 = (unsigned)((((tid >> 4) * 4096) + (tid & 15) * 8) * 2);
    for (int item = blockIdx.x; item < 256; item += F.G) {
        const int b = item >> 4, h = (item >> 2) & 3, vs = item & 3;
        const float lg = log1pf(-exp2f(-5.0f - (float)h)), gch = expf(128.0f * lg);
        f32x4 Racc[4][1][4];
#pragma unroll
        for (int dt = 0; dt < 4; ++dt)
#pragma unroll
            for (int jj = 0; jj < 4; ++jj) Racc[dt][0][jj] = (f32x4){0.f, 0.f, 0.f, 0.f};
        const size_t tb = (size_t)b * SEQ;
        __syncthreads();
        v4u pq[2], pkk[2], pv[4];
        { const char* gq0 = (const char*)(QKV + tb * 4096 + h * 256); const char* gv0 = (const char*)(QKV + tb * 4096 + 2048 + h * 512 + vs * 128);
#pragma unroll
            for (int i = 0; i < 2; ++i) { const char* src = gq0 + off8 + i * (64 * 4096 * 2); pq[i] = *(const v4u*)src; pkk[i] = *(const v4u*)(src + 2048); }
#pragma unroll
            for (int i = 0; i < 4; ++i) pv[i] = *(const v4u*)(gv0 + off16 + i * (32 * 4096 * 2)); }
        for (int c = 0; c < 16; ++c) {
            const size_t t0 = tb + c * 128;
            const char* gq = (const char*)(QKV + t0 * 4096 + h * 256);
            char* gy = (char*)(QKV + t0 * 4096 + 2048 + h * 512 + vs * 128);
            const bf16* pmt = PM + ((size_t)((b * 4 + h) * 16 + c)) * 128 * 128;
            float lgc = lg * 1.4426950408889634f; asm volatile("" : "+v"(lgc));
#pragma unroll
            for (int i = 0; i < 4; ++i) { const int id = tid + NTHR * i; *(LAS v4u*)(Vs + (id >> 4) * 136 + (id & 15) * 8) = pv[i]; }
            f32x4 X[2][4];
#pragma unroll
            for (int i = 0; i < 2; ++i)
#pragma unroll
                for (int jj = 0; jj < 4; ++jj) X[i][jj] = (f32x4){0.f, 0.f, 0.f, 0.f};
#pragma unroll 1
            for (int dt = 0; dt < 4; ++dt) {
                LAS bf16* Qd = T0 + (dt & 1) * TSET; LAS bf16* Kz = Qd + 128 * 72; LAS bf16* Rb = Kz + 128 * 72;
#pragma unroll
                for (int i = 0; i < 2; ++i) { const int id = tid + NTHR * i, row = id >> 3, c8 = id & 7; const float z = __builtin_amdgcn_exp2f((float)(127 - row) * lgc);
                    *(LAS v4u*)(Qd + row * 72 + c8 * 8) = pq[i];
                    v4u zo; zo.x = cvtpk(lo_bf(pkk[i].x) * z, hi_bf(pkk[i].x) * z); zo.y = cvtpk(lo_bf(pkk[i].y) * z, hi_bf(pkk[i].y) * z); zo.z = cvtpk(lo_bf(pkk[i].z) * z, hi_bf(pkk[i].z) * z); zo.w = cvtpk(lo_bf(pkk[i].w) * z, hi_bf(pkk[i].w) * z);
                    *(LAS v4u*)(Kz + row * 72 + c8 * 8) = zo; }
#pragma unroll
                for (int jj = 0; jj < 4; ++jj)
#pragma unroll
                    for (int e = 0; e < 4; ++e) Rb[(16 * w + 4 * fq + e) * 72 + 16 * jj + fr] = (bf16)f2bf(Racc[0][0][jj][e]);
#if RET_EXP == 3
                asm volatile("" ::: "memory");
#pragma unroll
                for (int jj = 0; jj < 4; ++jj)
#pragma unroll
                    for (int e = 0; e < 4; ++e) *(volatile LAS bf16*)(Rb + (16 * w + 4 * fq + e) * 72 + 16 * jj + fr) = (bf16)f2bf(Racc[0][0][jj][e]);
#endif
                if (dt < 3 || c < 15) {
                    const char* nb = (dt < 3) ? gq + (dt + 1) * 128 : gq + (size_t)128 * 4096 * 2;
#pragma unroll
                    for (int i = 0; i < 2; ++i) { const char* src = nb + off8 + i * (64 * 4096 * 2); pq[i] = *(const v4u*)src; pkk[i] = *(const v4u*)(src + 2048); } }
                __syncthreads();
                wgemm<2, 4, 64, 72, 72, false, false, false>(X, Qd + 32 * wh * 72, Rb + 64 * wl * 72, lane);
#if RET_EXP == 5
                { f32x4 D_[2][4];
#pragma unroll
                  for (int i = 0; i < 2; ++i)
#pragma unroll
                    for (int jj = 0; jj < 4; ++jj) D_[i][jj] = (f32x4){0.f, 0.f, 0.f, 0.f};
                  wgemm<2, 4, 64, 72, 72>(D_, Qd + 32 * wh * 72, Rb + 64 * wl * 72, lane);
#pragma unroll
                  for (int i = 0; i < 2; ++i)
#pragma unroll
                    for (int jj = 0; jj < 4; ++jj) asm volatile("" :: "v"(D_[i][jj])); }
#endif
#if RET_EXP == 6
                { f32x4 D_[1][4];
#pragma unroll
                    for (int jj = 0; jj < 4; ++jj) D_[0][jj] = (f32x4){0.f, 0.f, 0.f, 0.f};
                  wgemm<1, 4, 128, 136, 72, true, true>(D_, Vs + 16 * w, Kz, lane);
#pragma unroll
                    for (int jj = 0; jj < 4; ++jj) asm volatile("" :: "v"(D_[0][jj])); }
#endif
#pragma unroll
                for (int jj = 0; jj < 4; ++jj) Racc[0][0][jj] = Racc[0][0][jj] * gch;
                wgemm<1, 4, 128, 136, 72, true, true, false>(Racc[0], Vs + 16 * w, Kz, lane);
#pragma unroll
                for (int jj = 0; jj < 4; ++jj) { const f32x4 t_ = Racc[0][0][jj]; Racc[0][0][jj] = Racc[1][0][jj]; Racc[1][0][jj] = Racc[2][0][jj]; Racc[2][0][jj] = Racc[3][0][jj]; Racc[3][0][jj] = t_; }
            }
            v4u pp[4];
#pragma unroll
            for (int i = 0; i < 4; ++i) { const int id = tid + NTHR * i; pp[i] = *(const v4u*)(pmt + (id >> 4) * 128 + (id & 15) * 8); }
#if RET_EXP == 2
            asm volatile("s_waitcnt vmcnt(0)" ::: "memory");
#pragma unroll
            for (int i = 0; i < 4; ++i) { const int id = tid + NTHR * i; v4u q_ = *(const volatile v4u*)(pmt + 64 * 128 * 128 + (id >> 4) * 128 + (id & 15) * 8); asm volatile("" :: "v"(q_.x), "v"(q_.y), "v"(q_.z), "v"(q_.w)); }
            asm volatile("s_waitcnt vmcnt(0)" ::: "memory");
#endif
#pragma unroll
            for (int i = 0; i < 2; ++i)
#pragma unroll
                for (int e = 0; e < 4; ++e) { const int t = 32 * wh + 16 * i + 4 * fq + e; const float xi = __builtin_amdgcn_exp2f((float)(t + 1) * lgc);
#pragma unroll
                    for (int jj = 0; jj < 4; ++jj) X[i][jj][e] *= xi; }
#pragma unroll
            for (int i = 0; i < 4; ++i) { const int id = tid + NTHR * i; *(LAS v4u*)(Ps + (id >> 4) * 136 + (id & 15) * 8) = pp[i]; }
            __syncthreads();
            wgemm<2, 4, 128, 136, 136, false, true, false>(X, Ps + 32 * wh * 136, Vs + 64 * wl, lane);
#pragma unroll
            for (int i = 0; i < 2; ++i)
#pragma unroll
                for (int e = 0; e < 4; ++e) { const int t = 32 * wh + 16 * i + 4 * fq + e; float s1 = 0.f, s2 = 0.f;
#pragma unroll
                    for (int jj = 0; jj < 4; ++jj) { const float y = X[i][jj][e]; s1 += y; s2 += y * y; Xs[t * 136 + 64 * wl + 16 * jj + fr] = (bf16)f2bf(y); }
                    s1 += __shfl_xor(s1, 1); s1 += __shfl_xor(s1, 2); s1 += __shfl_xor(s1, 4); s1 += __shfl_xor(s1, 8);
                    s2 += __shfl_xor(s2, 1); s2 += __shfl_xor(s2, 2); s2 += __shfl_xor(s2, 4); s2 += __shfl_xor(s2, 8);
                    if (fr == 0) { fST[(wl * 128 + t) * 2] = s1; fST[(wl * 128 + t) * 2 + 1] = s2; } }
            if (c < 15) { const char* gvn = gy + (size_t)128 * 4096 * 2;
#pragma unroll
                for (int i = 0; i < 4; ++i) pv[i] = *(const v4u*)(gvn + off16 + i * (32 * 4096 * 2)); }
            __syncthreads();
#pragma unroll
            for (int i = 0; i < 4; ++i) { const int id = tid + NTHR * i, row = id >> 4, c8 = id & 15; *(v4u*)(gy + (unsigned)((row * 4096 + c8 * 8) * 2)) = *(const LAS v4u*)(Xs + row * 136 + c8 * 8); }
            if (tid < 128) { float* sp = st + (t0 + tid) * 32 + (h * 4 + vs) * 2; sp[0] = fST[tid * 2] + fST[(128 + tid) * 2]; sp[1] = fST[tid * 2 + 1] + fST[(128 + tid) * 2 + 1]; }
        }
    }
}

__device__ __forceinline__ void lru_conv(Frame& F, const bf16* GX, const float* cw, const float* cb, bf16* XC, const float* lru, float* sptab) {
    if (blockIdx.x == 0) for (int i = F.tid; i < 1024; i += NTHR) { const float l = -lru[i]; sptab[i] = fmaxf(l, 0.f) + log1pf(expf(-fabsf(l))); }
    const int c8 = F.tid & 127, rsub = F.tid >> 7;
    f32x4 w0[4], w1[4];
#pragma unroll
    for (int wv = 0; wv < 4; ++wv) { w0[wv] = *(const f32x4*)(cw + wv * 1024 + c8 * 8); w1[wv] = *(const f32x4*)(cw + wv * 1024 + c8 * 8 + 4); }
    const f32x4 b0 = *(const f32x4*)(cb + c8 * 8), b1 = *(const f32x4*)(cb + c8 * 8 + 4);
    for (int r0 = blockIdx.x * 16; r0 < MTOK; r0 += F.G * 16) {
        const int rb = r0 + 4 * rsub, t = rb & (SEQ - 1);
        v4u xin[7];
#pragma unroll
        for (int k = 0; k < 7; ++k) { const int rr = rb - 3 + k; xin[k] = (t - 3 + k >= 0) ? *(const v4u*)(GX + (size_t)rr * 2048 + 1024 + c8 * 8) : (v4u){0u, 0u, 0u, 0u}; }
#pragma unroll
        for (int q = 0; q < 4; ++q) { f32x4 a0 = b0, a1 = b1;
#pragma unroll
            for (int wv = 0; wv < 4; ++wv) { const v4u x = xin[q + wv];
                a0 += (f32x4){lo_bf(x.x), hi_bf(x.x), lo_bf(x.y), hi_bf(x.y)} * w0[wv]; a1 += (f32x4){lo_bf(x.z), hi_bf(x.z), lo_bf(x.w), hi_bf(x.w)} * w1[wv]; }
            v4u o; o.x = cvtpk(a0[0], a0[1]); o.y = cvtpk(a0[2], a0[3]); o.z = cvtpk(a1[0], a1[1]); o.w = cvtpk(a1[2], a1[3]);
            *(v4u*)(XC + (size_t)(rb + q) * 1024 + c8 * 8) = o; }
    }
}
__device__ __forceinline__ float gelu_tanh(float x) { const float z = 0.7978845608028654f * (x + 0.044715f * x * x * x); const float e = __expf(2.0f * z); const float th = 1.0f - 2.0f * __builtin_amdgcn_rcpf(e + 1.0f); return 0.5f * x * (1.0f + th); }
__device__ __forceinline__ void lru_scan(Frame& F, const bf16* LA, const bf16* BT, const bf16* GX, bf16* Y) {
    LAS float* segL = (LAS float*)F.lds;
    LAS float* segH = segL + 512;
    const int lane = F.lane, w = F.wave;
    for (int item = blockIdx.x; item < 256; item += F.G) {
        const int b = item >> 4, ch = (item & 15) * 64 + lane;
        const size_t r0 = (size_t)b * SEQ + w * 256;
        const bf16* la_p = LA + r0 * 1024 + ch; const bf16* bt_p = BT + r0 * 1024 + ch; const bf16* gx_p = GX + r0 * 2048 + ch; bf16* y_p = Y + r0 * 1024 + ch;
        float L = 0.f, H = 0.f;
        bf16 la0[16], bt0[16], la1[16], bt1[16];
#pragma unroll
        for (int k = 0; k < 16; ++k) { la0[k] = la_p[(size_t)k * 1024]; bt0[k] = bt_p[(size_t)k * 1024]; }
#pragma unroll 1
        for (int tb = 0; tb < 16; tb += 2) {
#pragma unroll
            for (int k = 0; k < 16; ++k) { la1[k] = la_p[(size_t)((tb + 1) * 16 + k) * 1024]; bt1[k] = bt_p[(size_t)((tb + 1) * 16 + k) * 1024]; }
#pragma unroll
            for (int k = 0; k < 16; ++k) { const float la = bf2f(la0[k]); L += la; H = __expf(la) * H + bf2f(bt0[k]); }
            if (tb + 2 < 16) {
#pragma unroll
                for (int k = 0; k < 16; ++k) { la0[k] = la_p[(size_t)((tb + 2) * 16 + k) * 1024]; bt0[k] = bt_p[(size_t)((tb + 2) * 16 + k) * 1024]; } }
#pragma unroll
            for (int k = 0; k < 16; ++k) { const float la = bf2f(la1[k]); L += la; H = __expf(la) * H + bf2f(bt1[k]); }
        }
        __syncthreads();
        segL[w * 64 + lane] = L; segH[w * 64 + lane] = H;
        __syncthreads();
        float hc = 0.f;
        for (int sg = 0; sg < w; ++sg) hc = __expf(segL[sg * 64 + lane]) * hc + segH[sg * 64 + lane];
        bf16 g0[16], g1[16];
#pragma unroll
        for (int k = 0; k < 16; ++k) { la0[k] = la_p[(size_t)k * 1024]; bt0[k] = bt_p[(size_t)k * 1024]; g0[k] = gx_p[(size_t)k * 2048]; }
#pragma unroll
        for (int k = 0; k < 16; ++k) { const size_t t = (size_t)(16 + k); la1[k] = la_p[t * 1024]; bt1[k] = bt_p[t * 1024]; g1[k] = gx_p[t * 2048]; }
#pragma unroll 1
        for (int tb = 0; tb < 16; tb += 2) {
            bf16 yv[16];
#pragma unroll
            for (int k = 0; k < 16; ++k) { hc = __expf(bf2f(la0[k])) * hc + bf2f(bt0[k]); yv[k] = (bf16)f2bf(hc * gelu_tanh(bf2f(g0[k]))); }
            if (tb + 2 < 16) {
#pragma unroll
                for (int k = 0; k < 16; ++k) { const size_t t = (size_t)((tb + 2) * 16 + k); la0[k] = la_p[t * 1024]; bt0[k] = bt_p[t * 1024]; g0[k] = gx_p[t * 2048]; } }
#pragma unroll
            for (int k = 0; k < 16; ++k) y_p[(size_t)(tb * 16 + k) * 1024] = yv[k];
#pragma unroll
            for (int k = 0; k < 16; ++k) { hc = __expf(bf2f(la1[k])) * hc + bf2f(bt1[k]); yv[k] = (bf16)f2bf(hc * gelu_tanh(bf2f(g1[k]))); }
            if (tb + 3 < 16) {
#pragma unroll
                for (int k = 0; k < 16; ++k) { const size_t t = (size_t)((tb + 3) * 16 + k); la1[k] = la_p[t * 1024]; bt1[k] = bt_p[t * 1024]; g1[k] = gx_p[t * 2048]; } }
#pragma unroll
            for (int k = 0; k < 16; ++k) y_p[(size_t)((tb + 1) * 16 + k) * 1024] = yv[k];
        }
    }
}

#ifndef WGM_BIG
#define WGM_BIG 8
#endif
#ifndef WGM_N4
#define WGM_N4 4
#endif
#ifndef WGM_MID
#define WGM_MID 8
#endif
template <class Epi>
__device__ __forceinline__ void run_gemm(Frame& F, const bf16* A, int lda, const bf16* Bt, int ldb, int N, int K, const Epi& E, int M = MTOK) {
    pg8::Gemm g{A, Bt, M, N, K, lda, ldb}; pg8::StaticOrder S; S.init(M, N, F.G, (int)blockIdx.x, (N >= 4096) ? WGM_BIG : (N <= 1024 ? WGM_N4 : WGM_MID));
#ifndef STAGGER_NG
#define STAGGER_NG 1
#endif
#ifndef STAGGER_STEP
#define STAGGER_STEP 300
#endif
    if (STAGGER_NG > 1 && N >= 4096 && M == MTOK) {
        const unsigned grp = (((unsigned)blockIdx.x >> 3) & 7u) / (8 / STAGGER_NG);
        if (grp) { const unsigned long long t0 = __builtin_amdgcn_s_memrealtime(), dl = (unsigned long long)grp * STAGGER_STEP;
            while (__builtin_amdgcn_s_memrealtime() - t0 < dl) __builtin_amdgcn_s_sleep(8); }
    }
#ifndef FUSE_NX
#define FUSE_NX false
#endif
#ifndef GEMM_ALIGN
#define GEMM_ALIGN true
#endif
#ifndef GEMM_SP2
#define GEMM_SP2 true
#endif
    pg8::gemm_phase<Epi, pg8::StaticOrder, GEMM_ALIGN, GEMM_SP2>(F.lds, g, S, E);
}

typedef const __attribute__((address_space(4))) struct Args* ArgsP;
constexpr int NPHASE = 35;
__device__ __forceinline__ ArgsP get_args() { ArgsP p = (ArgsP)__builtin_amdgcn_kernarg_segment_ptr(); asm volatile("" : "+s"(p)); return p; }
__device__ __forceinline__ bool in_phase(int k) { ArgsP a = get_args(); return a->ph_lo <= k && k < a->ph_hi; }
#ifndef DUP_PHASE
#define DUP_PHASE -1
#endif
#ifndef BAR_EXP
#define BAR_EXP 0
#endif
#ifndef TIMING_MASK
#define TIMING_MASK 0ull
#endif
#define TMISC ((volatile LAS unsigned long long*)((LAS unsigned char*)lds_raw + MISC_OFF))
#define TB(k) do { if (((TIMING_MASK >> (k)) & 1ull) && blockIdx.x == 0 && threadIdx.x == 0) TMISC[0] = __builtin_amdgcn_s_memrealtime(); } while (0)
#define TE(k) do { if (((TIMING_MASK >> (k)) & 1ull) && blockIdx.x == 0 && threadIdx.x == 0) TMISC[1] = TMISC[1] + (__builtin_amdgcn_s_memrealtime() - TMISC[0]); } while (0)
#define REP(k) TB(k); for (int rep_ = 0; rep_ < ((k) == DUP_PHASE ? 2 : 1); ++rep_)
#define AP ArgsP ap = get_args(); { int t_ = threadIdx.x; asm volatile("" : "+v"(t_)); F.tid = t_; F.lane = t_ & 63; F.wave = __builtin_amdgcn_readfirstlane(t_ >> 6); F.G = gridDim.x; F.lds = (LAS unsigned char*)lds_raw; }
__global__ void __launch_bounds__(NTHR, 2) trunk_fwd(Args args) {
    extern __shared__ __attribute__((aligned(16))) unsigned char lds_raw[];
    Frame F; F.lds = (LAS unsigned char*)lds_raw; F.tid = threadIdx.x; F.lane = F.tid & 63; F.wave = __builtin_amdgcn_readfirstlane(F.tid >> 6); F.G = gridDim.x;
    volatile LAS unsigned* MISC = (volatile LAS unsigned*)(F.lds + MISC_OFF);
    if (F.tid < 16) MISC[F.tid] = 0u;
    __syncthreads();
    if (args.ph_hi - args.ph_lo > 1) (void)xcd_barrier_post((unsigned*)(args.ws + WS_CTL) + CW_BAR, MISC + 8);
#ifndef ONLY_PHASE
#define ONLY_PHASE -1
#endif
#define IN(k) ((ONLY_PHASE < 0 || (k) == ONLY_PHASE) && in_phase(k))
#define SEAM(k) do { if (IN(k) && IN((k) + 1)) { XcdBarrier bb; bb.bar = (unsigned*)(get_args()->ws + WS_CTL) + CW_BAR; bb.x = xb_xcc_id(); bb.st = (volatile LAS unsigned*)((LAS unsigned char*)lds_raw + MISC_OFF) + 8; xcd_barrier(bb); if (BAR_EXP) xcd_barrier(bb); } if (IN(k)) TE(k); } while (0)
#define XIN ((const float*)ap->in[0])
#define pos ((const int*)ap->in[1])
#define norm_mix ((const float*)ap->in[2])
#define norm_ffn ((const float*)ap->in[3])
#define ffn_w_in ((const float*)ap->in[4])
#define ffn_w_out ((const float*)ap->in[5])
#define out (ap->out)
#define Wmi ((bf16*)(ap->ws + WS_W_MIXIN))
#define Wmo ((bf16*)(ap->ws + WS_W_MIXOUT))
#define Wfi ((bf16*)(ap->ws + WS_W_FFNIN))
#define Wfo ((bf16*)(ap->ws + WS_W_FFNOUT))
#define U ((bf16*)(ap->ws + WS_U))
#define BIG ((bf16*)(ap->ws + WS_BIG))
#define gatesA ((float*)(ap->ws + WS_GATESA))
#define ssqA ((float*)(ap->ws + WS_SSQA))
#define statC ((float*)(ap->ws + WS_STATC))
#define kmean ((float*)(ap->ws + WS_KMEAN))
#define sptab ((float*)(ap->ws + WS_SPTAB))
#define ssqH ((float*)(ap->ws + WS_SSQH))

#define a_w_in ((const float*)ap->in[6])
#define a_b ((const float*)ap->in[7])
#define a_g ((const float*)ap->in[8])
#define a_w_out ((const float*)ap->in[9])
#define b_w_in ((const float*)ap->in[10])
#define b_gq ((const float*)ap->in[11])
#define b_gk ((const float*)ap->in[12])
#define b_w_out ((const float*)ap->in[13])
#define c_w_in ((const float*)ap->in[14])
#define c_g ((const float*)ap->in[15])
#define c_w_out ((const float*)ap->in[16])
#define d_w_in ((const float*)ap->in[17])
#define d_cw ((const float*)ap->in[18])
#define d_cb ((const float*)ap->in[19])
#define d_wg ((const float*)ap->in[20])
#define d_bg ((const float*)ap->in[21])
#define d_lru ((const float*)ap->in[22])
#define d_w_out ((const float*)ap->in[23])
#define GX BIG
#define XC (BIG + (size_t)MTOK * 2048)
#define LA (BIG + (size_t)MTOK * 3072)
#define BT (BIG + (size_t)MTOK * 4096)
#define Y (BIG + (size_t)MTOK * 5120)
#define Wg (Wmi + (size_t)2048 * DM)
#define FFN_CVT(l) do { cvt_matrix(F, ffn_w_in + (size_t)(l) * DM * 2 * DFF, 2 * DFF, DM, 2 * DFF, 1, Wfi); cvt_matrix(F, ffn_w_out + (size_t)(l) * DFF * DM, DM, DFF, DM, 0, Wfo); } while (0)
#define FFN_PHASES(p0, l) do { \
    if (IN(p0)) { AP; REP(p0) { norm_phase<false>(F, out, norm_ffn + (l) * DM, U, nullptr, nullptr, nullptr); } } SEAM(p0); \
    if (IN((p0) + 1)) { AP; REP((p0) + 1) { pg8::EpiSwiGLU<false> E{BIG, DFF, nullptr}; run_gemm(F, U, DM, Wfi, DM, 2 * DFF, DM, E); } } SEAM((p0) + 1); \
    if (IN((p0) + 2)) { AP; REP((p0) + 2) { pg8::EpiResid<FUSE_NX> E{out, out, DM, U, ssqH}; run_gemm(F, BIG, DFF, Wfo, DFF, DM, DFF, E); } } SEAM((p0) + 2); } while (0)
#define QKV BIG
#define HO (BIG + (size_t)MTOK * 2048)
#define PMAB (BIG + (size_t)MTOK * 3072)
#define GTB ((float*)(BIG + (size_t)MTOK * 3584))
#define DENB ((float*)(BIG + (size_t)MTOK * 3584) + 2048 * 320)
    if (IN(0)) { AP; REP(0) { cvt_matrix(F, a_w_in, 3080, DM, 3072, 0, Wmi); cvt_matrix(F, a_w_out, DM, DM, DM, 0, Wmo); FFN_CVT(0);
        __syncthreads(); norm_phase<true>(F, XIN, norm_mix, U, a_w_in, a_b, gatesA); } } SEAM(0);
    if (IN(1)) { AP; REP(1) { mlstm_pre(F, gatesA, GTB); __syncthreads(); pg8::EpiStore<false> E{QKV, 2048, nullptr}; run_gemm(F, U, DM, Wmi, DM, 2048, DM, E); } } SEAM(1);
    if (IN(2)) { AP; REP(2) { mlstm_pmat(F, QKV, GTB, PMAB, DENB); } } SEAM(2);
    if (IN(3)) { AP; REP(3) { mlstm_core(F, QKV, GTB, PMAB, DENB, HO, ssqA); } } SEAM(3);
    if (IN(4)) { AP; REP(4) { pg8::EpiGateA E{HO, ssqA, a_g}; run_gemm(F, U, DM, Wmi + (size_t)2048 * DM, DM, DM, DM, E); } } SEAM(4);
    if (IN(5)) { AP; REP(5) { pg8::EpiResid<FUSE_NX> E{XIN, out, DM, U, ssqH}; run_gemm(F, HO, DM, Wmo, DM, DM, DM, E); } } SEAM(5);
    FFN_PHASES(6, 0);
#define OB (BIG + (size_t)MTOK * 3072)
#define VTB (BIG + (size_t)MTOK * 2048)
    if (IN(9)) { AP; REP(9) { cvt_matrix(F, b_w_in, 3072, DM, 3072, 0, Wmi); cvt_matrix(F, b_w_out, DM, DM, DM, 0, Wmo); FFN_CVT(1);
        __syncthreads(); norm_phase<false>(F, out, norm_mix + DM, U, nullptr, nullptr, nullptr); } } SEAM(9);
    if (IN(10)) { AP; REP(10) { { pg8::EpiStore<false> E{QKV, 2048, nullptr}; run_gemm(F, U, DM, Wmi, DM, 2048, DM, E); } __syncthreads();
        { pg8::EpiStore<false> E{VTB, MTOK, nullptr}; run_gemm(F, Wmi + (size_t)2048 * DM, DM, U, DM, MTOK, DM, E, DM); } } } SEAM(10);
    if (IN(11)) { AP; REP(11) { moba_prep(F, QKV, pos, b_gq, b_gk, kmean); } } SEAM(11);
    if (IN(12)) { AP; REP(12) { moba_attn(F, QKV, VTB, kmean, OB); } } SEAM(12);
    if (IN(13)) { AP; REP(13) { pg8::EpiResid<FUSE_NX> E{out, out, DM, U, ssqH}; run_gemm(F, OB, DM, Wmo, DM, DM, DM, E); } } SEAM(13);
    FFN_PHASES(14, 1);
#define YS (BIG + 2048)
#define PMB (BIG + (size_t)MTOK * 4096)
#define CSTB ((float*)(BIG + (size_t)MTOK * 4096 + (size_t)16 * 1024 * 1024))
    if (IN(17)) { AP; REP(17) { cvt_matrix(F, c_w_in, 6144, DM, 6144, 0, Wmi); cvt_matrix(F, c_w_out, DM, 2048, DM, 0, Wmo); FFN_CVT(2);
        __syncthreads(); norm_phase<false>(F, out, norm_mix + 2 * DM, U, nullptr, nullptr, nullptr); ret_rot_table(F, pos, CSTB); } } SEAM(17);
    if (IN(18)) { AP; REP(18) { pg8::EpiStoreRot E{QKV, CSTB}; run_gemm(F, U, DM, Wmi, DM, 4096, DM, E); } } SEAM(18);
    if (IN(19)) { AP; REP(19) { ret_pmat(F, QKV, PMB); } } SEAM(19);
    if (IN(20)) { AP; REP(20) { ret_core(F, QKV, PMB, statC); } } SEAM(20);
    if (IN(21)) { AP; REP(21) { pg8::EpiGateC<false> E{YS, 4096, statC, c_g, nullptr}; run_gemm(F, U, DM, Wmi + (size_t)4096 * DM, DM, 2048, DM, E); } } SEAM(21);
    if (IN(22)) { AP; REP(22) { pg8::EpiResid<FUSE_NX> E{out, out, DM, U, ssqH}; run_gemm(F, YS, 4096, Wmo, 2048, DM, 2048, E); } } SEAM(22);
    FFN_PHASES(23, 2);
    if (IN(26)) { AP; REP(26) { cvt_matrix(F, d_w_in, 2048, DM, 2048, 0, Wmi);
#pragma unroll 1
            for (int blk = 0; blk < 4; ++blk) cvt_matrix(F, d_wg + (size_t)blk * 256 * 512, 512, 256, 512, 2, Wg + (size_t)blk * 512 * 256);
            cvt_matrix(F, d_w_out, DM, DM, DM, 0, Wmo); FFN_CVT(3);
        __syncthreads(); norm_phase<false>(F, out, norm_mix + 3 * DM, U, nullptr, nullptr, nullptr); } } SEAM(26);
    if (IN(27)) { AP; REP(27) { pg8::EpiStore<false> E{GX, 2048, nullptr}; run_gemm(F, U, DM, Wmi, DM, 2048, DM, E); } } SEAM(27);
    if (IN(28)) { AP; REP(28) { lru_conv(F, GX, d_cw, d_cb, XC, d_lru, sptab); } } SEAM(28);
    if (IN(29)) { AP; REP(29) {
#pragma unroll 1
            for (int blk = 0; blk < 4; ++blk) { pg8::EpiLru E{XC, LA, BT, d_bg + blk * 512, sptab, blk}; run_gemm(F, XC + blk * 256, DM, Wg + (size_t)blk * 512 * 256, 256, 512, 256, E); __syncthreads(); } } } SEAM(29);
    if (IN(30)) { AP; REP(30) { lru_scan(F, LA, BT, GX, Y); } } SEAM(30);
    if (IN(31)) { AP; REP(31) { pg8::EpiResid<FUSE_NX> E{out, out, DM, U, ssqH}; run_gemm(F, Y, DM, Wmo, DM, DM, DM, E); } } SEAM(31);
    FFN_PHASES(32, 3);
    if (TIMING_MASK != 0ull && blockIdx.x == 0 && threadIdx.x == 0) { const unsigned long long t0_ = __builtin_amdgcn_s_memrealtime(); const unsigned long long tacc_ = TMISC[1]; while (__builtin_amdgcn_s_memrealtime() - t0_ < tacc_) __builtin_amdgcn_s_sleep(8); }
#undef IN
#undef SEAM
#undef XIN
#undef pos
#undef norm_mix
#undef norm_ffn
#undef ffn_w_in
#undef ffn_w_out
#undef out
#undef Wmi
#undef Wmo
#undef Wfi
#undef Wfo
#undef U
#undef BIG
#undef gatesA
#undef ssqA
#undef statC
#undef kmean
#undef sptab
#undef a_w_in
#undef a_b
#undef a_g
#undef a_w_out
#undef b_w_in
#undef b_gq
#undef b_gk
#undef b_w_out
#undef c_w_in
#undef c_g
#undef c_w_out
#undef d_w_in
#undef d_cw
#undef d_cb
#undef d_wg
#undef d_bg
#undef d_lru
#undef d_w_out
#undef GX
#undef XC
#undef LA
#undef BT
#undef Y
#undef Wg
#undef FFN_CVT
#undef OB
#undef CSTB
#undef PMAB
#undef GTB
#undef DENB
#undef PMB
#undef VTB
#undef FFN_PHASES
#undef QKV
#undef HO
#undef YS
#undef ssqH
}

#ifndef MK_ONE_LAUNCH
#define MK_ONE_LAUNCH 1
#endif
extern "C" void kernel_launch(void* const* d_in, const int* in_sizes, int n_in, void* d_out, int out_size, void* d_ws, size_t ws_size, hipStream_t stream) {
    static int grid = 0;
    if (grid == 0) {
        if (n_in != 24 || out_size != MTOK * DM || ws_size < WS_END) { fprintf(stderr, "kernel_launch: unexpected shapes (n_in %d, out %d, ws %zu); nothing launched\n", n_in, out_size, ws_size); grid = -1; return; }
        int dev = 0, cus = 0, per_cu = 0;
        if (hipGetDevice(&dev) != hipSuccess || hipDeviceGetAttribute(&cus, hipDeviceAttributeMultiprocessorCount, dev) != hipSuccess) { grid = -1; return; }
        if (hipFuncSetAttribute((const void*)trunk_fwd, hipFuncAttributeMaxDynamicSharedMemorySize, LDS_BYTES) != hipSuccess) { fprintf(stderr, "kernel_launch: hipFuncSetAttribute failed\n"); grid = -1; return; }
        if (hipOccupancyMaxActiveBlocksPerMultiprocessor(&per_cu, (const void*)trunk_fwd, NTHR, LDS_BYTES) != hipSuccess || per_cu < 1) { fprintf(stderr, "kernel_launch: occupancy query reports %d blocks per CU\n", per_cu); }
        (void)hipGetLastError();
        grid = cus;
    }
    if (grid < 0) return;
    (void)hipMemsetAsync((char*)d_ws + WS_CTL, 0, CTL_ZERO_BYTES, stream);
    Args a{};
    for (int i = 0; i < 24; ++i) a.in[i] = d_in[i];
    a.out = (float*)d_out; a.ws = (unsigned char*)d_ws;
#if MK_ONE_LAUNCH
    a.ph_lo = 0; a.ph_hi = NPHASE;
    hipLaunchKernelGGL(trunk_fwd, dim3(grid), dim3(NTHR), LDS_BYTES, stream, a);
#else
    for (int p = 0; p < NPHASE; ++p) { a.ph_lo = p; a.ph_hi = p + 1; hipLaunchKernelGGL(trunk_fwd, dim3(grid), dim3(NTHR), LDS_BYTES, stream, a); }
#endif
}
```

```cpp
#include <hip/hip_runtime.h>
#include <cstdio>
#include <cstdint>
#include <cmath>
namespace pg8 {
#define PG8_LAS __attribute__((address_space(3)))
typedef unsigned short bf16_t;
typedef short bf16x8 __attribute__((ext_vector_type(8)));
typedef float f32x4 __attribute__((ext_vector_type(4)));
typedef unsigned u32x4 __attribute__((ext_vector_type(4)));
constexpr int BM = 256, BK = 64, HALF = 128, HTB = HALF * BK * 2  , STAGE_BYTES = 8 * HTB, NXCD = 8, WGM = 8;

__host__ __device__ __forceinline__ int lds_byte(int r, int c) { const int st = (r >> 4) * 2 + (c >> 5), rr = r & 15, cc = c & 31, ob = rr * 64 + cc * 2; return st * 1024 + (ob ^ (((ob >> 9) & 1) << 5)); }
__host__ __device__ __forceinline__ void stage_rc(int b, int& R, int& C) { const int st = b / 1024, sb = b % 1024, swz = sb ^ (((sb >> 9) & 1) << 5); R = (st >> 1) * 16 + swz / 64; C = (st & 1) * 32 + (swz % 64) / 2; }
__host__ __device__ __forceinline__ int perm32(int rho) { const int n = rho >> 4, i = rho & 15; return 8 * (i >> 2) + 4 * n + (i & 3); }

struct Unit { int pm, pn; };
struct Gemm { const bf16_t* A; const bf16_t* Bt; int M, N, K, lda, ldb, ablk; };

struct StaticOrder {
    int nM, nN, nwg, G, c, wgm;
    __host__ __device__ void init(int M, int N, int G_, int c_, int wgm_ = WGM) { nM = M / BM; nN = N / BM; nwg = nM * nN; G = G_; c = c_; wgm = wgm_; }
    __host__ __device__ bool next(int i, Unit& u) const {
        const long L = (long)i * G + c; if (L >= nwg) return false;
        int wgid = (int)L; { const int q = nwg / NXCD, r = nwg % NXCD, xcd = wgid % NXCD, off = wgid / NXCD; wgid = (xcd < r ? xcd * (q + 1) : r * (q + 1) + (xcd - r) * q) + off; }
        const int nig = wgm * nN, gid = wgid / nig, fm = gid * wgm, gsz = (nM - fm) < wgm ? (nM - fm) : wgm;
        u.pm = fm + ((wgid % nig) % gsz); u.pn = (wgid % nig) / gsz; return true;
    }
    __device__ __forceinline__ void a_ready(const Unit&) const {}
    __device__ __forceinline__ void done(const Unit&) const {}
};

__device__ __forceinline__ unsigned cvt_pk_bf16(float lo, float hi) { unsigned r; asm volatile("v_cvt_pk_bf16_f32 %0, %1, %2" : "=v"(r) : "v"(lo), "v"(hi)); return r; }
typedef float f32x2 __attribute__((ext_vector_type(2)));

__device__ __forceinline__ float bf2f(unsigned short b) { return __uint_as_float(((unsigned)b) << 16); }
__device__ __forceinline__ float lo_bf(unsigned w) { return __uint_as_float(w << 16); }
__device__ __forceinline__ float hi_bf(unsigned w) { return __uint_as_float(w & 0xffff0000u); }
__device__ __forceinline__ float fast_sigmoid(float x) { return __builtin_amdgcn_rcpf(1.0f + __expf(-x)); }
typedef unsigned u32x2 __attribute__((ext_vector_type(2)));

__device__ __forceinline__ void row_rstd(const float* ssq, int row0, float (&rs)[2][4]) {
#pragma unroll
    for (int ai = 0; ai < 2; ++ai)
#pragma unroll
        for (int m = 0; m < 4; ++m) { const f32x4* p = (const f32x4*)(ssq + (size_t)(row0 + ai * HALF + m * 16) * 16); const f32x4 a = p[0], b = p[1], c = p[2], d = p[3];
            const float t = ((a[0] + a[1]) + (a[2] + a[3])) + ((b[0] + b[1]) + (b[2] + b[3])) + ((c[0] + c[1]) + (c[2] + c[3])) + ((d[0] + d[1]) + (d[2] + d[3]));
            rs[ai][m] = 1.0f / sqrtf(t * (1.0f / 1024.0f) + 1e-6f); }
}
template <bool RS> struct EpiStore {
    static constexpr bool PERM = true, AFTER_DRAIN = false;
    bf16_t* O; int ldc; const float* ssq;
    __device__ __forceinline__ void operator()(const f32x4 (&acc)[2][2][4][2], const Unit& u, int wr, int wc, int fr, int fq) const {
        const int row0 = u.pm * BM + wr * 64 + fr, col0 = u.pn * BM + wc * 32 + 8 * fq;
        float rs[2][4]; if (RS) row_rstd(ssq, row0, rs);
#pragma unroll
        for (int ai = 0; ai < 2; ++ai)
#pragma unroll
            for (int m = 0; m < 4; ++m) { bf16_t* rowp = O + (size_t)(row0 + ai * HALF + m * 16) * ldc + col0; const float sc = RS ? rs[ai][m] : 1.0f;
#pragma unroll
                for (int bj = 0; bj < 2; ++bj) { const f32x4 v0 = acc[ai][bj][m][0] * sc, v1 = acc[ai][bj][m][1] * sc;
                    u32x4 w; w.x = cvt_pk_bf16(v0[0], v0[1]); w.y = cvt_pk_bf16(v0[2], v0[3]); w.z = cvt_pk_bf16(v1[0], v1[1]); w.w = cvt_pk_bf16(v1[2], v1[3]);
                    *(u32x4*)(rowp + bj * HALF) = w;
#if defined(GEMM_EXP) && GEMM_EXP == 3
                    asm volatile("" ::: "memory"); *(volatile u32x4*)(rowp + bj * HALF) = w;
#endif
                } }
    }
};

struct EpiStoreRot {
    static constexpr bool PERM = true, AFTER_DRAIN = false;
    bf16_t* O; const float* cst;
    __device__ __forceinline__ void operator()(const f32x4 (&acc)[2][2][4][2], const Unit& u, int wr, int wc, int fr, int fq) const {
        const int row0 = u.pm * BM + wr * 64 + fr, col0 = u.pn * BM + wc * 32 + 8 * fq, d0 = wc * 32 + 8 * fq;
        const bool rot = u.pn < 8; const float sc = (u.pn >= 4 && u.pn < 8) ? 0.0625f : 1.0f;
#pragma unroll
        for (int ai = 0; ai < 2; ++ai)
#pragma unroll
            for (int m = 0; m < 4; ++m) { const int row = row0 + ai * HALF + m * 16; bf16_t* rowp = O + (size_t)row * 4096 + col0;
                f32x4 v[2][2];
#pragma unroll
                for (int bj = 0; bj < 2; ++bj) { v[bj][0] = acc[ai][bj][m][0]; v[bj][1] = acc[ai][bj][m][1]; }
                if (rot) { const float* cp = cst + (size_t)row * 256 + d0;
#pragma unroll
                    for (int n = 0; n < 2; ++n) { const f32x4 c = *(const f32x4*)(cp + 4 * n), sn = *(const f32x4*)(cp + 128 + 4 * n); const f32x4 x1 = v[0][n], x2 = v[1][n];
                        v[0][n] = (x1 * c - x2 * sn) * sc; v[1][n] = (x2 * c + x1 * sn) * sc; } }
#pragma unroll
                for (int bj = 0; bj < 2; ++bj) { u32x4 w; w.x = cvt_pk_bf16(v[bj][0][0], v[bj][0][1]); w.y = cvt_pk_bf16(v[bj][0][2], v[bj][0][3]); w.z = cvt_pk_bf16(v[bj][1][0], v[bj][1][1]); w.w = cvt_pk_bf16(v[bj][1][2], v[bj][1][3]);
                    *(u32x4*)(rowp + bj * HALF) = w; } }
    }
};
template <bool RS> struct EpiSwiGLU {
    static constexpr bool PERM = true, AFTER_DRAIN = false;
    bf16_t* O; int ldc; const float* ssq;
    __device__ __forceinline__ void operator()(const f32x4 (&acc)[2][2][4][2], const Unit& u, int wr, int wc, int fr, int fq) const {
        const int row0 = u.pm * BM + wr * 64 + fr, col0 = u.pn * HALF + wc * 32 + 8 * fq;
        float rs[2][4]; if (RS) row_rstd(ssq, row0, rs);
#pragma unroll
        for (int ai = 0; ai < 2; ++ai)
#pragma unroll
            for (int m = 0; m < 4; ++m) { bf16_t* rowp = O + (size_t)(row0 + ai * HALF + m * 16) * ldc + col0; const float sc = RS ? rs[ai][m] : 1.0f;
                float h[8];
#pragma unroll
                for (int n = 0; n < 2; ++n)
#pragma unroll
                    for (int j = 0; j < 4; ++j) { const float g = acc[ai][0][m][n][j] * sc, up = acc[ai][1][m][n][j] * sc;
#if defined(GEMM_EXP) && GEMM_EXP == 2
                        h[4 * n + j] = g * (0.5f * (fast_sigmoid(g) + (1.0f - fast_sigmoid(-g)))) * up;
#else
                        h[4 * n + j] = g * fast_sigmoid(g) * up;
#endif
                    }
                u32x4 w; w.x = cvt_pk_bf16(h[0], h[1]); w.y = cvt_pk_bf16(h[2], h[3]); w.z = cvt_pk_bf16(h[4], h[5]); w.w = cvt_pk_bf16(h[6], h[7]);

#if defined(NT_HIDDEN) && NT_HIDDEN
                __builtin_nontemporal_store(w, (u32x4*)rowp);
#else
                *(u32x4*)rowp = w;
#endif
                }
    }
};
template <bool NX> struct EpiResid {
    static constexpr bool PERM = false, AFTER_DRAIN = false;
    const float* base; float* out; int ldc; bf16_t* hb; float* ssq;
    __device__ __forceinline__ void operator()(const f32x4 (&acc)[2][2][4][2], const Unit& u, int wr, int wc, int fr, int fq) const {
        const int row0 = u.pm * BM + wr * 64 + fr, col0 = u.pn * BM + wc * 32 + 4 * fq;
        f32x4 rb[3][4];
#define PG8_RLOAD(g, slot) do { const size_t off_ = (size_t)(row0 + ((g) >> 2) * HALF + ((g) & 3) * 16) * ldc + col0; \
            rb[slot][0] = *(const f32x4*)(base + off_); rb[slot][1] = *(const f32x4*)(base + off_ + 16); rb[slot][2] = *(const f32x4*)(base + off_ + HALF); rb[slot][3] = *(const f32x4*)(base + off_ + HALF + 16); } while (0)
        PG8_RLOAD(0, 0); PG8_RLOAD(1, 1);
#pragma unroll
        for (int g = 0; g < 8; ++g) { const int ai = g >> 2, m = g & 3; const size_t off = (size_t)(row0 + ai * HALF + m * 16) * ldc + col0; float q = 0.f;
            if (g + 2 < 8) PG8_RLOAD(g + 2, (g + 2) % 3);
#pragma unroll
            for (int bj = 0; bj < 2; ++bj)
#pragma unroll
                for (int n = 0; n < 2; ++n) { const f32x4 o = rb[g % 3][bj * 2 + n] + acc[ai][bj][m][n]; *(f32x4*)(out + off + bj * HALF + n * 16) = o;
                    if (NX) { q += (o[0] * o[0] + o[1] * o[1]) + (o[2] * o[2] + o[3] * o[3]); u32x2 w; w.x = cvt_pk_bf16(o[0], o[1]); w.y = cvt_pk_bf16(o[2], o[3]); *(u32x2*)(hb + off + bj * HALF + n * 16) = w; } }
            if (NX) { q += __shfl_xor(q, 16); q += __shfl_xor(q, 32); if (fq == 0) ssq[(size_t)(row0 + ai * HALF + m * 16) * 16 + u.pn * 4 + wc] = q; } }
#undef PG8_RLOAD
    }
};
struct EpiGateA {
    static constexpr bool PERM = true, AFTER_DRAIN = false;
    bf16_t* Y; const float* ssq; const float* gout;
    __device__ __forceinline__ void operator()(const f32x4 (&acc)[2][2][4][2], const Unit& u, int wr, int wc, int fr, int fq) const {
        const int row0 = u.pm * BM + wr * 64 + fr, col0 = u.pn * BM + wc * 32 + 8 * fq;
        f32x4 gv[2][2];
#pragma unroll
        for (int bj = 0; bj < 2; ++bj)
#pragma unroll
            for (int n = 0; n < 2; ++n) gv[bj][n] = *(const f32x4*)(gout + col0 + bj * HALF + 4 * n);
        u32x4 hwb[2][2]; f32x4 spb[2][2];
#define PG8_GLOAD(g, slot) do { const int row_ = row0 + ((g) >> 2) * HALF + ((g) & 3) * 16; const bf16_t* rp_ = Y + (size_t)row_ * 1024 + col0; hwb[slot][0] = *(const u32x4*)rp_; hwb[slot][1] = *(const u32x4*)(rp_ + HALF); \
            spb[slot][0] = *(const f32x4*)(ssq + (size_t)row_ * 32 + u.pn * 8); spb[slot][1] = *(const f32x4*)(ssq + (size_t)row_ * 32 + u.pn * 8 + 4); } while (0)
        PG8_GLOAD(0, 0);
#pragma unroll
        for (int g = 0; g < 8; ++g) { const int ai = g >> 2, m = g & 3, sl = g & 1; const int row = row0 + ai * HALF + m * 16; bf16_t* rowp = Y + (size_t)row * 1024 + col0;
            if (g + 1 < 8) PG8_GLOAD(g + 1, (g + 1) & 1);
            const f32x4 sp = spb[sl][0], sp2 = spb[sl][1];
            const float rstd = 1.0f / sqrtf((((sp[0] + sp[1]) + (sp[2] + sp[3])) + ((sp2[0] + sp2[1]) + (sp2[2] + sp2[3]))) * (1.0f / 256.0f) + 1e-6f);
#pragma unroll
            for (int bj = 0; bj < 2; ++bj) { const u32x4 hw = hwb[sl][bj]; float o[8];
                const unsigned hh[4] = {hw.x, hw.y, hw.z, hw.w};
#pragma unroll
                for (int n = 0; n < 2; ++n)
#pragma unroll
                    for (int j = 0; j < 4; ++j) { const unsigned w = hh[2 * n + (j >> 1)]; const float hv = (j & 1) ? hi_bf(w) : lo_bf(w);
                        o[4 * n + j] = hv * rstd * gv[bj][n][j] * fast_sigmoid(acc[ai][bj][m][n][j]); }
                u32x4 w; w.x = cvt_pk_bf16(o[0], o[1]); w.y = cvt_pk_bf16(o[2], o[3]); w.z = cvt_pk_bf16(o[4], o[5]); w.w = cvt_pk_bf16(o[6], o[7]);
                *(u32x4*)(rowp + bj * HALF) = w; } }
#undef PG8_GLOAD
    }
};
template <bool RS> struct EpiGateC {
    static constexpr bool PERM = true, AFTER_DRAIN = false;
    bf16_t* Y; int ldy; const float* st; const float* gout; const float* hssq;
    __device__ __forceinline__ void operator()(const f32x4 (&acc)[2][2][4][2], const Unit& u, int wr, int wc, int fr, int fq) const {
        const int row0 = u.pm * BM + wr * 64 + fr, col0 = u.pn * BM + wc * 32 + 8 * fq, head = u.pn >> 1;
        float rs[2][4]; if (RS) row_rstd(hssq, row0, rs);
        f32x4 gv[2][2];
#pragma unroll
        for (int bj = 0; bj < 2; ++bj)
#pragma unroll
            for (int n = 0; n < 2; ++n) gv[bj][n] = *(const f32x4*)(gout + col0 + bj * HALF + 4 * n);
        u32x4 hwb[2][2]; f32x4 spb[2][2];
#define PG8_GLOAD(g, slot) do { const int row_ = row0 + ((g) >> 2) * HALF + ((g) & 3) * 16; const bf16_t* rp_ = Y + (size_t)row_ * ldy + col0; hwb[slot][0] = *(const u32x4*)rp_; hwb[slot][1] = *(const u32x4*)(rp_ + HALF); \
            spb[slot][0] = *(const f32x4*)(st + (size_t)row_ * 32 + head * 8); spb[slot][1] = *(const f32x4*)(st + (size_t)row_ * 32 + head * 8 + 4); } while (0)
        PG8_GLOAD(0, 0);
#pragma unroll
        for (int g = 0; g < 8; ++g) { const int ai = g >> 2, m = g & 3, sl = g & 1; const int row = row0 + ai * HALF + m * 16; bf16_t* rowp = Y + (size_t)row * ldy + col0;
            if (g + 1 < 8) PG8_GLOAD(g + 1, (g + 1) & 1);
            const f32x4 s0 = spb[sl][0], s1 = spb[sl][1];
            const float mu = ((s0[0] + s0[2]) + (s1[0] + s1[2])) * (1.0f / 512.0f), ex2 = ((s0[1] + s0[3]) + (s1[1] + s1[3])) * (1.0f / 512.0f);
            const float var = fmaxf(ex2 - mu * mu, 0.f), rstd = 1.0f / sqrtf(var + 1e-6f);
#pragma unroll
            for (int bj = 0; bj < 2; ++bj) { const u32x4 hw = hwb[sl][bj]; float o[8];
                const unsigned hh[4] = {hw.x, hw.y, hw.z, hw.w};
#pragma unroll
                for (int n = 0; n < 2; ++n)
#pragma unroll
                    for (int j = 0; j < 4; ++j) { const unsigned w = hh[2 * n + (j >> 1)]; const float hv = (j & 1) ? hi_bf(w) : lo_bf(w); const float a = RS ? acc[ai][bj][m][n][j] * rs[ai][m] : acc[ai][bj][m][n][j];
                        o[4 * n + j] = (hv - mu) * rstd * gv[bj][n][j] * (a * fast_sigmoid(a)); }
                u32x4 w; w.x = cvt_pk_bf16(o[0], o[1]); w.y = cvt_pk_bf16(o[2], o[3]); w.z = cvt_pk_bf16(o[4], o[5]); w.w = cvt_pk_bf16(o[6], o[7]);
                *(u32x4*)(rowp + bj * HALF) = w; } }
#undef PG8_GLOAD
    }
};
struct EpiLru {
    static constexpr bool PERM = true, AFTER_DRAIN = false;
    const bf16_t* XC; bf16_t* LA; bf16_t* BT; const float* bgall; const float* sp;
    __device__ __forceinline__ void operator()(const f32x4 (&acc)[2][2][4][2], const Unit& u, int wr, int wc, int fr, int fq) const {
        const int blk = u.pn >> 1; const float* bg = bgall + blk * 512;
        const int row0 = u.pm * BM + wr * 64 + fr, cb = (u.pn & 1) * HALF + wc * 32 + 8 * fq, ch0 = blk * 256 + cb;
        u32x4 xwb[2]; xwb[0] = *(const u32x4*)(XC + (size_t)row0 * 1024 + ch0);
#pragma unroll
        for (int g = 0; g < 8; ++g) { const int ai = g >> 2, m = g & 3; const size_t off = (size_t)(row0 + ai * HALF + m * 16) * 1024 + ch0;
                if (g + 1 < 8) xwb[(g + 1) & 1] = *(const u32x4*)(XC + (size_t)(row0 + ((g + 1) >> 2) * HALF + ((g + 1) & 3) * 16) * 1024 + ch0);
                const u32x4 xw = xwb[g & 1]; const unsigned xx[4] = {xw.x, xw.y, xw.z, xw.w};
                unsigned lw[4], bw[4];
#pragma unroll
                for (int n = 0; n < 2; ++n) { const f32x4 br = *(const f32x4*)(bg + cb + 4 * n), bi = *(const f32x4*)(bg + 256 + cb + 4 * n), spv = *(const f32x4*)(sp + ch0 + 4 * n); float la[4], bt[4];
#pragma unroll
                    for (int j = 0; j < 4; ++j) { const int q = 4 * n + j; const unsigned w = xx[q >> 1]; const float xc = (q & 1) ? hi_bf(w) : lo_bf(w);
                        const float r = fast_sigmoid(acc[ai][0][m][n][j] + br[j]), ig = fast_sigmoid(acc[ai][1][m][n][j] + bi[j]);
                        const float l = -8.0f * r * spv[j]; la[j] = l; bt[j] = sqrtf(fmaxf(1.0f - __expf(2.0f * l), 0.f)) * ig * xc; }
                    lw[2 * n] = cvt_pk_bf16(la[0], la[1]); lw[2 * n + 1] = cvt_pk_bf16(la[2], la[3]); bw[2 * n] = cvt_pk_bf16(bt[0], bt[1]); bw[2 * n + 1] = cvt_pk_bf16(bt[2], bt[3]); }
                u32x4 w; w.x = lw[0]; w.y = lw[1]; w.z = lw[2]; w.w = lw[3]; *(u32x4*)(LA + off) = w;
                w.x = bw[0]; w.y = bw[1]; w.z = bw[2]; w.w = bw[3]; *(u32x4*)(BT + off) = w; }
    }
};

template <class Epi, class Sched, bool ALIGN_EPI = false, bool SP2 = false>
__device__ __forceinline__ void gemm_phase(PG8_LAS unsigned char* lds, const Gemm g, const Sched& S, const Epi& E) {
    int tid_ = threadIdx.x; asm volatile("" : "+v"(tid_));
    const int tid = tid_, wid = __builtin_amdgcn_readfirstlane(tid >> 6), lane = tid & 63, wr = wid >> 2, wc = wid & 3, fr = lane & 15, fq = lane >> 4;
    const int K = g.K, nt = K / BK;
    unsigned voffA[2], voffB[2];
#pragma unroll
    for (int i = 0; i < 2; ++i) { int R, C; stage_rc(tid * 16 + i * 8192, R, C); const int Rb = Epi::PERM ? ((R & ~31) + perm32(R & 31)) : R;
        voffA[i] = (unsigned)(R * g.lda + C) * 2u; voffB[i] = (unsigned)(Rb * g.ldb + C) * 2u; }
    const size_t kstep = (size_t)(BK * 2);
    const size_t hstepA = (size_t)HALF * g.lda * 2, hstepB = (size_t)HALF * g.ldb * 2;
    const size_t tstepA = 2 * hstepA, tstepB = 2 * hstepB;
    const unsigned ldsw = (unsigned)wid * 1024u;
    const int aoff = lds_byte(wr * 64 + fr, fq * 8), boff = lds_byte(wc * 32 + fr, fq * 8);
#define PG8_SA(b, h) (((b) * 2 + (h)) * HTB)
#define PG8_SB(b, h) ((4 + (b) * 2 + (h)) * HTB)
#define PG8_STAGE(bufoff, gbase, voff) do { _Pragma("unroll") for (int _i = 0; _i < 2; ++_i) \
        __builtin_amdgcn_global_load_lds((const unsigned*)((const char*)(gbase) + (voff)[_i]), (PG8_LAS unsigned*)(lds + (bufoff) + ldsw + _i * 8192), 16, 0, 0); } while (0)
#define PG8_LDA(dst, b, h) do { _Pragma("unroll") for (int m = 0; m < 4; ++m) _Pragma("unroll") for (int k = 0; k < 2; ++k) dst[m][k] = *(const PG8_LAS bf16x8*)(lds + PG8_SA(b, h) + aoff + m * 2048 + k * 1024); } while (0)
#define PG8_LDB(dst, b, h) do { _Pragma("unroll") for (int n = 0; n < 2; ++n) _Pragma("unroll") for (int k = 0; k < 2; ++k) dst[n][k] = *(const PG8_LAS bf16x8*)(lds + PG8_SB(b, h) + boff + n * 2048 + k * 1024); } while (0)
#define PG8_MMA(ai, bj, At, Bt) do { __builtin_amdgcn_s_setprio(1); _Pragma("unroll") for (int m = 0; m < 4; ++m) _Pragma("unroll") for (int n = 0; n < 2; ++n) _Pragma("unroll") for (int k = 0; k < 2; ++k) \
        acc[ai][bj][m][n] = __builtin_amdgcn_mfma_f32_16x16x32_bf16(Bt[n][k], At[m][k], acc[ai][bj][m][n], 0, 0, 0); __builtin_amdgcn_s_setprio(0); } while (0)
#define PG8_WAIT_V(n) asm volatile("s_waitcnt vmcnt(" #n ")" ::: "memory")
#define PG8_WAIT_L(n) asm volatile("s_waitcnt lgkmcnt(" #n ")" ::: "memory")
#define PG8_BAR __builtin_amdgcn_s_barrier()
#define PG8_SCHED __builtin_amdgcn_sched_barrier(0)
    Unit cur, nxt; int ui = 0;
    if (!S.next(0, cur)) return;
    f32x4 acc[2][2][4][2];
#pragma unroll
    for (int a = 0; a < 2; ++a)
#pragma unroll
        for (int b = 0; b < 2; ++b)
#pragma unroll
            for (int m = 0; m < 4; ++m)
#pragma unroll
                for (int n = 0; n < 2; ++n) acc[a][b][m][n] = (f32x4){0.f, 0.f, 0.f, 0.f};
    bf16x8 At[4][2], B0[2][2], B1[2][2];
    const char* cA = (const char*)g.A + (size_t)cur.pm * tstepA + (size_t)((cur.pn >> 1) * g.ablk) * 2; const char* cB = (const char*)g.Bt + (size_t)cur.pn * tstepB;
    S.a_ready(cur);
    if constexpr (SP2) {
        PG8_STAGE(PG8_SB(0, 0), cB, voffB); PG8_STAGE(PG8_SB(0, 1), cB + hstepB, voffB); PG8_STAGE(PG8_SA(0, 0), cA, voffA); PG8_STAGE(PG8_SA(0, 1), cA + hstepA, voffA);
        if (wr == 1) PG8_BAR;
        PG8_WAIT_V(2); PG8_BAR;
        PG8_STAGE(PG8_SB(1, 0), cB + kstep, voffB); PG8_STAGE(PG8_SA(1, 0), cA + kstep, voffA); PG8_STAGE(PG8_SB(1, 1), cB + hstepB + kstep, voffB);
        PG8_WAIT_V(6); PG8_BAR;
    } else {
        PG8_STAGE(PG8_SB(0, 0), cB, voffB); PG8_STAGE(PG8_SA(0, 0), cA, voffA); PG8_STAGE(PG8_SB(0, 1), cB + hstepB, voffB); PG8_STAGE(PG8_SA(0, 1), cA + hstepA, voffA);
        if (wr == 1) PG8_BAR;
        PG8_WAIT_V(4); PG8_BAR;
        PG8_STAGE(PG8_SB(1, 0), cB + kstep, voffB); PG8_STAGE(PG8_SA(1, 0), cA + kstep, voffA); PG8_STAGE(PG8_SB(1, 1), cB + hstepB + kstep, voffB);
        PG8_WAIT_V(6); PG8_BAR;
    }
    for (;;) {
        const bool has_next = S.next(ui + 1, nxt);
        const char* nA = has_next ? (const char*)g.A + (size_t)nxt.pm * tstepA + (size_t)((nxt.pn >> 1) * g.ablk) * 2 : cA; const char* nB = has_next ? (const char*)g.Bt + (size_t)nxt.pn * tstepB : cB;
        for (int t = 0; t < nt; t += 2) {
            const bool last = (t == nt - 2);
            const char* a1 = cA + (size_t)(t + 1) * kstep;
            const char* a2 = last ? nA : cA + (size_t)(t + 2) * kstep; const char* b2 = last ? nB : cB + (size_t)(t + 2) * kstep;
            const char* a3 = a2 + kstep; const char* b3 = b2 + kstep;
            if (last && has_next) S.a_ready(nxt);
            if constexpr (SP2) {
            PG8_LDB(B0, 0, 0); PG8_LDB(B1, 0, 1); PG8_SCHED; PG8_LDA(At, 0, 0); PG8_STAGE(PG8_SA(1, 1), a1 + hstepA, voffA);
            PG8_WAIT_V(8); PG8_WAIT_L(0); PG8_BAR; PG8_MMA(0, 0, At, B0); PG8_MMA(0, 1, At, B1); PG8_BAR; PG8_SCHED;
            PG8_LDA(At, 0, 1); PG8_STAGE(PG8_SB(0, 0), b2, voffB); PG8_STAGE(PG8_SB(0, 1), b2 + hstepB, voffB); PG8_STAGE(PG8_SA(0, 0), a2, voffA);
            PG8_WAIT_V(8); PG8_WAIT_L(0); PG8_BAR; PG8_MMA(1, 0, At, B0); PG8_MMA(1, 1, At, B1); PG8_BAR; PG8_SCHED;
            PG8_LDB(B0, 1, 0); PG8_LDB(B1, 1, 1); PG8_SCHED; PG8_LDA(At, 1, 0); PG8_STAGE(PG8_SA(0, 1), a2 + hstepA, voffA);
            PG8_WAIT_V(8); PG8_WAIT_L(0); PG8_BAR; PG8_MMA(0, 0, At, B0); PG8_MMA(0, 1, At, B1); PG8_BAR; PG8_SCHED;
            PG8_LDA(At, 1, 1); PG8_STAGE(PG8_SB(1, 0), b3, voffB); PG8_STAGE(PG8_SB(1, 1), b3 + hstepB, voffB); PG8_STAGE(PG8_SA(1, 0), a3, voffA);
            PG8_WAIT_V(8); PG8_WAIT_L(0); PG8_BAR; PG8_MMA(1, 0, At, B0); PG8_MMA(1, 1, At, B1); PG8_BAR; PG8_SCHED;
            } else {
            PG8_LDB(B0, 0, 0); PG8_SCHED; PG8_LDA(At, 0, 0); PG8_STAGE(PG8_SA(1, 1), a1 + hstepA, voffA);
            PG8_WAIT_L(8); PG8_BAR; PG8_WAIT_L(0); PG8_MMA(0, 0, At, B0); PG8_BAR; PG8_SCHED;
            PG8_LDB(B1, 0, 1); PG8_STAGE(PG8_SB(0, 0), b2, voffB);
            PG8_BAR; PG8_WAIT_L(0); PG8_MMA(0, 1, At, B1); PG8_BAR;
            PG8_LDA(At, 0, 1); PG8_STAGE(PG8_SA(0, 0), a2, voffA);
            PG8_BAR; PG8_WAIT_L(0); PG8_MMA(1, 0, At, B0); PG8_BAR; PG8_SCHED;
            PG8_STAGE(PG8_SB(0, 1), b2 + hstepB, voffB);
            PG8_WAIT_V(6); PG8_BAR; PG8_MMA(1, 1, At, B1); PG8_BAR;
            PG8_LDB(B0, 1, 0); PG8_SCHED; PG8_LDA(At, 1, 0); PG8_STAGE(PG8_SA(0, 1), a2 + hstepA, voffA);
            PG8_WAIT_L(8); PG8_BAR; PG8_WAIT_L(0); PG8_MMA(0, 0, At, B0); PG8_BAR; PG8_SCHED;
            PG8_LDB(B1, 1, 1); PG8_STAGE(PG8_SB(1, 0), b3, voffB);
            PG8_BAR; PG8_WAIT_L(0); PG8_MMA(0, 1, At, B1); PG8_BAR;
            PG8_LDA(At, 1, 1); PG8_STAGE(PG8_SA(1, 0), a3, voffA);
            PG8_BAR; PG8_WAIT_L(0); PG8_MMA(1, 0, At, B0); PG8_BAR; PG8_SCHED;
            PG8_STAGE(PG8_SB(1, 1), b3 + hstepB, voffB);
            PG8_WAIT_V(6); PG8_BAR; PG8_MMA(1, 1, At, B1); PG8_BAR;
            }
        }
        if constexpr (ALIGN_EPI) { if (wr == 0) PG8_BAR; }
        if constexpr (!Epi::AFTER_DRAIN) { E(acc, cur, wr, wc, fr, fq); S.done(cur); }
        if (!has_next) break;
#pragma unroll
        for (int a = 0; a < 2; ++a)
#pragma unroll
            for (int b = 0; b < 2; ++b)
#pragma unroll
                for (int m = 0; m < 4; ++m)
#pragma unroll
                    for (int n = 0; n < 2; ++n) acc[a][b][m][n] = (f32x4){0.f, 0.f, 0.f, 0.f};
        cur = nxt; cA = nA; cB = nB; ++ui;
        if constexpr (ALIGN_EPI) { if (wr == 1) PG8_BAR; }
    }
    PG8_WAIT_V(0);
    if constexpr (!ALIGN_EPI) { if (wr == 0) PG8_BAR; }
    PG8_BAR;
    if constexpr (Epi::AFTER_DRAIN) { E.fused(acc, cur, wr, wc, fr, fq, lds, wid, lane); S.done(cur); }
#undef PG8_SA
#undef PG8_SB
#undef PG8_STAGE
#undef PG8_LDA
#undef PG8_LDB
#undef PG8_MMA
#undef PG8_WAIT_V
#undef PG8_WAIT_L
#undef PG8_BAR
#undef PG8_SCHED
}
}
#define GAS __attribute__((address_space(1)))
#define LAS __attribute__((address_space(3)))
typedef unsigned short bf16;
typedef unsigned v4u __attribute__((ext_vector_type(4)));
typedef float f32x4 __attribute__((ext_vector_type(4)));
typedef short bf16x8 __attribute__((ext_vector_type(8)));
typedef GAS unsigned gu32;
typedef GAS unsigned long long gu64;
#define RLX_AGENT __ATOMIC_RELAXED, __HIP_MEMORY_SCOPE_AGENT
#define LDS_WAIT() asm volatile("s_waitcnt lgkmcnt(0)" ::: "memory")
#define VM_WAIT() asm volatile("s_waitcnt vmcnt(0)" ::: "memory")
__device__ __forceinline__ unsigned long long rt() { return __builtin_amdgcn_s_memrealtime(); }
__device__ __forceinline__ unsigned f2bf(float f) { unsigned u = __builtin_bit_cast(unsigned, f); return (u + 0x7fffu + ((u >> 16) & 1u)) >> 16; }
__device__ __forceinline__ unsigned pk2(float lo, float hi) { return f2bf(lo) | (f2bf(hi) << 16); }

#define XB_TMO      128
#define XB_XCNT(j)  (256  + 64 * (j))
#define XB_XSUB(j)  (1280 + 64 * (j))
#define XB_XGEN(j)  (2304 + 64 * (j))
#define XB_TOP      3328
#define XB_TOPGEN   3392
#define XCD_BAR_WORDS 3456
#define XB_SPIN_CAP (1u << 18)

__device__ __forceinline__ unsigned xb_ld(unsigned* p)              { return __hip_atomic_load(p, __ATOMIC_RELAXED, __HIP_MEMORY_SCOPE_AGENT); }
__device__ __forceinline__ unsigned xb_add(unsigned* p, unsigned v) { return __hip_atomic_fetch_add(p, v, __ATOMIC_RELAXED, __HIP_MEMORY_SCOPE_AGENT); }
__device__ __forceinline__ unsigned xb_xcc_id() { return (unsigned)__builtin_amdgcn_s_getreg((3 << 11) | 20) & 0xFu; }
#define XB_SPIN(cond, bar) do { unsigned _sp = 0; while (cond) { __builtin_amdgcn_s_sleep(1); \
    if ((++_sp & 255u) == 0u) { if (xb_ld(&(bar)[XB_TMO])) break; if (_sp > XB_SPIN_CAP) { atomicAdd(&(bar)[XB_TMO], 1u); break; } } } } while (0)

struct XcdBarrier {
    unsigned* bar; unsigned x;
    volatile LAS unsigned* st;
};

__device__ __forceinline__ XcdBarrier xcd_barrier_post(unsigned* bar, volatile LAS unsigned* st) {
    XcdBarrier b; b.bar = bar; b.x = xb_xcc_id(); b.st = st;
    if (threadIdx.x == 0) (void)xb_add(&bar[XB_XCNT(b.x)], 1u);
    return b;
}
__device__ __forceinline__ void xcd_barrier_complete(unsigned* bar, unsigned x, unsigned& nloc, unsigned& nx) {
    const unsigned G = gridDim.x * gridDim.y * gridDim.z;
    unsigned sum, cnt, mine, sp = 0u;
    for (;;) {
        sum = 0u; cnt = 0u; mine = 0u;
#pragma unroll
        for (unsigned j = 0; j < 16; ++j) { const unsigned c = xb_ld(&bar[XB_XCNT(j)]); sum += c; cnt += (c > 0u) ? 1u : 0u; mine = (j == x) ? c : mine; }
        if (sum == G) break;
        __builtin_amdgcn_s_sleep(1);
        if ((++sp & 255u) == 0u) { if (xb_ld(&bar[XB_TMO])) break; if (sp > XB_SPIN_CAP) { atomicAdd(&bar[XB_TMO], 1u); break; } }
    }
    nloc = mine > 0u ? mine : 1u; nx = cnt > 0u ? cnt : 1u;
}

__device__ __forceinline__ void xcd_barrier(const XcdBarrier& b) {
    asm volatile("s_waitcnt vmcnt(0)" ::: "memory");
    __syncthreads();
    if (threadIdx.x == 0) {
        unsigned* bar = b.bar;
        __builtin_amdgcn_s_waitcnt(0);
        unsigned nloc = b.st[0], nx = b.st[1];
        if (nloc == 0u) { xcd_barrier_complete(bar, b.x, nloc, nx); b.st[0] = nloc; b.st[1] = nx; }
        const unsigned old = xb_add(&bar[XB_XSUB(b.x)], 1u);
        const unsigned gen = old / nloc;
        if (old + 1u == (gen + 1u) * nloc) {
            __builtin_amdgcn_fence(__ATOMIC_RELEASE, "agent");
            asm volatile("s_waitcnt vmcnt(0)" ::: "memory");
            const unsigned og = xb_add(&bar[XB_TOP], 1u);
            const unsigned tg = og / nx;
            if (og + 1u == (tg + 1u) * nx) xb_add(&bar[XB_TOPGEN], 1u);
            else XB_SPIN(xb_ld(&bar[XB_TOPGEN]) == tg, bar);
            __builtin_amdgcn_fence(__ATOMIC_ACQUIRE, "agent");
            xb_add(&bar[XB_XGEN(b.x)], 1u);
            asm volatile("s_waitcnt vmcnt(0)" ::: "memory");
        } else {
            XB_SPIN(xb_ld(&bar[XB_XGEN(b.x)]) == gen, bar);
            __builtin_amdgcn_fence(__ATOMIC_ACQUIRE, "agent");
            asm volatile("s_waitcnt vmcnt(0)" ::: "memory");
        }
    }
    __syncthreads();
}

constexpr int NWAVES = 8, NTHR = 512;
constexpr int MTOK = 32768, DM = 1024, SEQ = 2048, NB = 16, DFF = 2816;
constexpr size_t MiB = 1u << 20;
constexpr size_t WS_CTL = 0, CTL_ZERO_BYTES = 64 * 1024;
constexpr size_t WS_W_MIXIN = 1 * MiB, WS_W_MIXOUT = 13 * MiB, WS_W_FFNIN = 17 * MiB, WS_W_FFNOUT = 28 * MiB;
constexpr size_t WS_GATESA = 34 * MiB, WS_SSQA = 35 * MiB, WS_STATC = 492 * MiB, WS_KMEAN = 41 * MiB, WS_SSQH = 42 * MiB, WS_SPTAB = 33 * MiB + 512 * 1024;
constexpr size_t WS_U = 44 * MiB, WS_BIG = 108 * MiB, WS_END = 500 * MiB;
constexpr int CW_BAR = 1024;
static_assert((CW_BAR + 3456) * 4 <= (int)CTL_ZERO_BYTES, "ctl");
constexpr int LDS_BYTES = 163840, MISC_OFF = 163584;

typedef unsigned u32x4 __attribute__((ext_vector_type(4)));
typedef unsigned u32x2 __attribute__((ext_vector_type(2)));
typedef float f32x2 __attribute__((ext_vector_type(2)));
struct Frame { LAS unsigned char* lds; int tid, lane, wave, G; };
struct Args { const void* in[24]; float* out; unsigned char* ws; int ph_lo, ph_hi; };

__device__ __forceinline__ float wave_sum(float v) {
#pragma unroll
    for (int o = 1; o < 64; o <<= 1) v += __shfl_xor(v, o);
    return v;
}
__device__ __forceinline__ float bf2f(bf16 b) { return __uint_as_float(((unsigned)b) << 16); }
__device__ __forceinline__ float lo_bf(unsigned w) { return __uint_as_float(w << 16); }
__device__ __forceinline__ float hi_bf(unsigned w) { return __uint_as_float(w & 0xffff0000u); }
__device__ __forceinline__ unsigned cvtpk(float lo, float hi) { return pg8::cvt_pk_bf16(lo, hi); }

typedef short v4s16 __attribute__((ext_vector_type(4)));
template <int LD> __device__ __forceinline__ bf16x8 tr_frag(const LAS bf16* T, int r0, int c0, int lane) {
    const int fr = lane & 15, fq = lane >> 4;
    const LAS bf16* a = T + (r0 + 8 * fq + (fr >> 2)) * LD + c0 + 4 * (fr & 3);
    const v4s16 lo = __builtin_amdgcn_ds_read_tr16_b64_v4i16((LAS v4s16*)a);
    const v4s16 hi = __builtin_amdgcn_ds_read_tr16_b64_v4i16((LAS v4s16*)(a + 4 * LD));
    return __builtin_shufflevector(lo, hi, 0, 1, 2, 3, 4, 5, 6, 7);
}
template <int MT, int NT, int K, int LDA, int LDB, bool TA = false, bool TB = false, bool SB = true>
__device__ __forceinline__ void wgemm(f32x4 (&acc)[MT][NT], const LAS bf16* A, const LAS bf16* Bt, int lane) {
    const int fr = lane & 15, fq = lane >> 4;
    const LAS bf16* ap = A + fr * LDA + 8 * fq;
    const LAS bf16* bp = Bt + fr * LDB + 8 * fq;
#pragma unroll
    for (int k0 = 0; k0 < K; k0 += 32) {
        bf16x8 a[MT], b[NT];
#pragma unroll
        for (int i = 0; i < MT; ++i) a[i] = TA ? tr_frag<LDA>(A, k0, 16 * i, lane) : *(const LAS bf16x8*)(ap + 16 * i * LDA + k0);
#pragma unroll
        for (int j = 0; j < NT; ++j) b[j] = TB ? tr_frag<LDB>(Bt, k0, 16 * j, lane) : *(const LAS bf16x8*)(bp + 16 * j * LDB + k0);
#pragma unroll
        for (int i = 0; i < MT; ++i)
#pragma unroll
            for (int j = 0; j < NT; ++j) acc[i][j] = __builtin_amdgcn_mfma_f32_16x16x32_bf16(a[i], b[j], acc[i][j], 0, 0, 0);
        if (SB && MT * NT >= 4) __builtin_amdgcn_sched_barrier(0);
    }
    if (!SB) __builtin_amdgcn_sched_barrier(0);
}

__device__ __forceinline__ int cvt_src_col(int mode, int g0) {
    if (mode == 0) return g0;
    const int pn = g0 >> 8, r = g0 & 255;
    if (mode == 1) return r < 128 ? 128 * pn + r : DFF + 128 * pn + (r - 128);
    return r < 128 ? 128 * pn + r : 256 + 128 * pn + (r - 128);
}
__device__ __forceinline__ void cvt_matrix(Frame& F, const float* W, int ldw, int K, int Np, int mode, bf16* WT, const float* gain = nullptr) {
    LAS float* scr = (LAS float*)(F.lds + F.wave * 16384);
    const int gw = blockIdx.x * NWAVES + F.wave, NGW = F.G * NWAVES, lane = F.lane;
    const int nblk = Np / 32, nitems = (K / 64) * nblk;
    float v[32], vn[32];
#define CVT_LOAD(dst, it) do { const int kb_ = (it) / nblk, nb_ = (it) % nblk, s0_ = cvt_src_col(mode, 32 * nb_); const float* wp_ = W + (size_t)(64 * kb_ + (lane >> 5)) * ldw + s0_ + (lane & 31); \
        _Pragma("unroll") for (int i = 0; i < 32; ++i) dst[i] = wp_[(size_t)(2 * i) * ldw]; } while (0)
    int item = gw;
    if (item < nitems) CVT_LOAD(v, item);
    for (; item < nitems; item += NGW) {
        const int kb = item / nblk, nb = item % nblk, k0 = 64 * kb, n0 = 32 * nb;
        if (item + NGW < nitems) CVT_LOAD(vn, item + NGW);
        if (gain) {
#pragma unroll
            for (int i = 0; i < 32; ++i) v[i] *= gain[k0 + 2 * i + (lane >> 5)]; }
#pragma unroll
        for (int i = 0; i < 32; ++i) scr[(2 * i + (lane >> 5)) * 33 + (lane & 31)] = v[i];
        LDS_WAIT(); asm volatile("" ::: "memory");
        const int c = lane & 7;
#pragma unroll
        for (int j = 0; j < 4; ++j) { const int n = (lane >> 3) + 8 * j; const LAS float* sp = scr + (8 * c) * 33 + n;
            v4u o; o.x = pk2(sp[0 * 33], sp[1 * 33]); o.y = pk2(sp[2 * 33], sp[3 * 33]); o.z = pk2(sp[4 * 33], sp[5 * 33]); o.w = pk2(sp[6 * 33], sp[7 * 33]);
            *(v4u*)(WT + (size_t)(n0 + n) * K + k0 + 8 * c) = o; }
        LDS_WAIT(); asm volatile("" ::: "memory");
#pragma unroll
        for (int i = 0; i < 32; ++i) v[i] = vn[i];
    }
#undef CVT_LOAD
}

template <bool GATES>
__device__ __forceinline__ void norm_phase(Frame& F, const float* src, const float* gain, bf16* dst, const float* wA, const float* bA, float* gout) {
    LAS float* wg = (LAS float*)F.lds;
    if (GATES) {
        for (int i = F.tid; i < 1024 * 8; i += NTHR) wg[i] = wA[(size_t)(i >> 3) * 3080 + 3072 + (i & 7)];
        __syncthreads();
    }
    const int gw = blockIdx.x * NWAVES + F.wave, NGW = F.G * NWAVES, lane = F.lane;
    f32x4 g[4];
#pragma unroll
    for (int j = 0; j < 4; ++j) g[j] = ((const f32x4*)gain)[lane + 64 * j];
    for (int m = gw; m < MTOK; m += NGW) {
        const f32x4* xr = (const f32x4*)(src + (size_t)m * DM) + lane;
        f32x4 v[4]; float s = 0.f;
#pragma unroll
        for (int j = 0; j < 4; ++j) { v[j] = xr[64 * j]; s += (v[j].x * v[j].x + v[j].y * v[j].y) + (v[j].z * v[j].z + v[j].w * v[j].w); }
        const float rstd = 1.0f / sqrtf(wave_sum(s) * (1.0f / DM) + 1e-6f);
        unsigned long long* o8 = (unsigned long long*)(dst + (size_t)m * DM) + lane;
#pragma unroll
        for (int j = 0; j < 4; ++j) { v[j] = v[j] * rstd * g[j];
            o8[64 * j] = (unsigned long long)cvtpk(v[j].x, v[j].y) | ((unsigned long long)cvtpk(v[j].z, v[j].w) << 32); }
        if (GATES) {
            float a[8];
#pragma unroll
            for (int q = 0; q < 8; ++q) a[q] = 0.f;
#pragma unroll
            for (int j = 0; j < 4; ++j)
#pragma unroll
                for (int e = 0; e < 4; ++e) { const int k = 4 * lane + 256 * j + e; const f32x4 w0 = *(const LAS f32x4*)(wg + k * 8), w1 = *(const LAS f32x4*)(wg + k * 8 + 4); const float x = v[j][e];
                    a[0] += x * w0.x; a[1] += x * w0.y; a[2] += x * w0.z; a[3] += x * w0.w; a[4] += x * w1.x; a[5] += x * w1.y; a[6] += x * w1.z; a[7] += x * w1.w; }
#pragma unroll
            for (int q = 0; q < 8; ++q) a[q] = wave_sum(a[q]);
            if (lane == 0) {
#pragma unroll
                for (int q = 0; q < 8; ++q) gout[(size_t)m * 8 + q] = a[q] + bA[q]; }
        }
    }
}

__device__ __forceinline__ void mlstm_pre(Frame& F, const float* gates, float* GT) {
    LAS float* sA = (LAS float*)F.lds, *sPM = sA + 2048, *sBC = sPM + 2048, *sBT = sBC + 2048, *sP63 = sBT + 32, *sM = sP63 + 32;
    const int lane = F.lane, w = F.wave;
    for (int item = blockIdx.x; item < 64; item += F.G) {
        const int b = item >> 2, h = item & 3;
        __syncthreads();
        float gi4[4], gf4[4];
#pragma unroll
        for (int i = 0; i < 4; ++i) { const size_t row = (size_t)b * SEQ + (w + 8 * i) * 64 + lane; gi4[i] = gates[row * 8 + h]; gf4[i] = gates[row * 8 + 4 + h]; }
#pragma unroll
        for (int i = 0; i < 4; ++i) { const int c = w + 8 * i;
            const float gi = gi4[i], gf = gf4[i];
            const float fc = fminf(gf, 0.f) - log1pf(__expf(-fabsf(gf)));
            float bc = fc;
#pragma unroll
            for (int o = 1; o < 64; o <<= 1) { const float t = __shfl_up(bc, o); if (lane >= o) bc += t; }
            const float a = gi - bc; float pm = a;
#pragma unroll
            for (int o = 1; o < 64; o <<= 1) { const float t = __shfl_up(pm, o); if (lane >= o) pm = fmaxf(pm, t); }
            sA[c * 64 + lane] = a; sPM[c * 64 + lane] = pm; sBC[c * 64 + lane] = bc; if (lane == 63) { sBT[c] = bc; sP63[c] = pm; } }
        __syncthreads();
        if (F.tid == 0) { float m = 0.f; for (int c = 0; c < 32; ++c) { sM[c] = m; m = sBT[c] + fmaxf(m, sP63[c]); } }
        __syncthreads();
#pragma unroll
        for (int i = 0; i < 4; ++i) { const int c = w + 8 * i; const float mst = sM[c], Mx = fmaxf(mst, sPM[c * 64 + lane]), Mx63 = fmaxf(mst, sP63[c]);
            float* g = GT + ((size_t)(item * 32 + c)) * 320 + lane;
            g[0] = sA[c * 64 + lane]; g[64] = Mx; g[128] = __expf(mst - Mx); g[192] = __expf(-(sBC[c * 64 + lane] + Mx)); g[256] = __expf(sA[c * 64 + lane] - Mx63); }
    }
}
__device__ __forceinline__ void mlstm_pmat(Frame& F, const bf16* QKV, const float* GT, bf16* PMA, float* DENP) {
    constexpr float SCALE = 0.08838834764831845f;
    LAS bf16* Qs = (LAS bf16*)F.lds;
    LAS bf16* Ks = Qs + 64 * 136;
    LAS bf16* Ps = Ks + 64 * 136;
    LAS float* fA = (LAS float*)(Ps + 64 * 72), *fMX = fA + 64;
    const int tid = F.tid, lane = F.lane, w = F.wave, fr = lane & 15, fq = lane >> 4, wh = w >> 1, wl = w & 1;
    const unsigned qoff0 = (unsigned)((((tid >> 4) * 2048) + (tid & 15) * 8) * 2);
    v4u pQ[2], pK[2]; float pg = 0.f;
    int item = blockIdx.x;
    if (item < 2048) { const int bh = item >> 5, c = item & 31; const char* gq = (const char*)(QKV + ((size_t)(bh >> 2) * SEQ + c * 64) * 2048 + (bh & 3) * 128);
#pragma unroll
        for (int i = 0; i < 2; ++i) { pQ[i] = *(const v4u*)(gq + qoff0 + i * (32 * 2048 * 2)); pK[i] = *(const v4u*)(gq + qoff0 + i * (32 * 2048 * 2) + 1024); }
        if (tid < 128) pg = GT[(size_t)item * 320 + tid]; }
    for (; item < 2048; item += F.G) {
        __syncthreads();
#pragma unroll
        for (int i = 0; i < 2; ++i) { const int id = tid + NTHR * i, row = id >> 4, c8 = id & 15; *(LAS v4u*)(Qs + row * 136 + c8 * 8) = pQ[i]; *(LAS v4u*)(Ks + row * 136 + c8 * 8) = pK[i]; }
        if (tid < 128) fA[tid] = pg;
        const int nit = item + F.G;
        if (nit < 2048) { const int bh = nit >> 5, c = nit & 31; const char* gq = (const char*)(QKV + ((size_t)(bh >> 2) * SEQ + c * 64) * 2048 + (bh & 3) * 128);
#pragma unroll
            for (int i = 0; i < 2; ++i) { pQ[i] = *(const v4u*)(gq + qoff0 + i * (32 * 2048 * 2)); pK[i] = *(const v4u*)(gq + qoff0 + i * (32 * 2048 * 2) + 1024); }
            if (tid < 128) pg = GT[(size_t)nit * 320 + tid]; }
        __syncthreads();
        f32x4 sa[1][2]; sa[0][0] = (f32x4){0.f, 0.f, 0.f, 0.f}; sa[0][1] = sa[0][0];
        wgemm<1, 2, 128, 136, 136>(sa, Qs + 16 * wh * 136, Ks + 32 * wl * 136, lane);
        float rs[4] = {0.f, 0.f, 0.f, 0.f};
#pragma unroll
        for (int e = 0; e < 4; ++e) { const int t = 16 * wh + 4 * fq + e; const float mx = fMX[t];
#pragma unroll
            for (int j = 0; j < 2; ++j) { const int sidx = 32 * wl + 16 * j + fr; const float wgt = (sidx <= t) ? SCALE * __expf(fA[sidx] - mx) : 0.f; const float p = sa[0][j][e] * wgt;
                Ps[t * 72 + sidx] = (bf16)f2bf(p); rs[e] += p; } }
#pragma unroll
        for (int e = 0; e < 4; ++e) { float r = rs[e]; r += __shfl_xor(r, 1); r += __shfl_xor(r, 2); r += __shfl_xor(r, 4); r += __shfl_xor(r, 8); if (fr == 0) DENP[(size_t)item * 128 + wl * 64 + 16 * wh + 4 * fq + e] = r; }
        __syncthreads();
        *(v4u*)(PMA + (size_t)item * 4096 + (tid >> 3) * 64 + (tid & 7) * 8) = *(const LAS v4u*)(Ps + (tid >> 3) * 72 + (tid & 7) * 8);
    }
}
__device__ __forceinline__ void mlstm_core(Frame& F, const bf16* QKV, const float* GT, const bf16* PMA, const float* DENP, bf16* hout, float* ssq) {
    constexpr float SCALE = 0.08838834764831845f;
    LAS bf16* Qs = (LAS bf16*)F.lds;
    LAS bf16* Ks = Qs + 64 * 136;
    LAS bf16* Vs = Ks + 64 * 136;
    LAS bf16* VWs = Vs + 64 * 88;
    LAS bf16* Cb = VWs + 64 * 88;
    LAS bf16* Ps = Cb + 80 * 136;
    LAS bf16* Hs = Ps + 64 * 72;
    const int tid = F.tid, lane = F.lane, w = F.wave, fr = lane & 15, fq = lane >> 4, wh = w >> 1, wl = w & 1;
    const unsigned qoff0 = (unsigned)((((tid >> 4) * 2048) + (tid & 15) * 8) * 2), voff0 = (unsigned)((((tid >> 3) * 2048) + (tid & 7) * 8) * 2);
    for (int item = blockIdx.x; item < 256; item += F.G) {
        const int b = item >> 4, h = (item >> 2) & 3, vs = item & 3, bh = b * 4 + h;
        f32x4 Cacc[1][4], Cn[1][1];
#pragma unroll
        for (int j = 0; j < 4; ++j) Cacc[0][j] = (f32x4){0.f, 0.f, 0.f, 0.f};
        Cn[0][0] = (f32x4){0.f, 0.f, 0.f, 0.f};
        const size_t tb = (size_t)b * SEQ;
        v4u pQ[2], pK[2], pV, pP; float pws, pwc, pwi[4], pem[4], pdn[4];
#define MLSTM_FETCH(cc) do { const size_t t0_ = tb + (size_t)(cc) * 64; const char* gq_ = (const char*)(QKV + t0_ * 2048 + h * 128); const char* gv_ = (const char*)(QKV + t0_ * 2048 + 1024 + h * 256 + vs * 64); \
            _Pragma("unroll") for (int i = 0; i < 2; ++i) { pQ[i] = *(const v4u*)(gq_ + qoff0 + i * (32 * 2048 * 2)); pK[i] = *(const v4u*)(gq_ + qoff0 + i * (32 * 2048 * 2) + 1024); } \
            pV = *(const v4u*)(gv_ + voff0); const size_t it_ = (size_t)(bh * 32 + (cc)); pP = *(const v4u*)(PMA + it_ * 4096 + (tid >> 3) * 64 + (tid & 7) * 8); \
            const float* g_ = GT + it_ * 320; pws = g_[256 + (tid >> 3)]; pwc = g_[128 + 63]; \
            _Pragma("unroll") for (int e = 0; e < 4; ++e) { const int t_ = 16 * wh + 4 * fq + e; pwi[e] = g_[128 + t_]; pem[e] = g_[192 + t_]; pdn[e] = DENP[it_ * 128 + t_] + DENP[it_ * 128 + 64 + t_]; } } while (0)
        MLSTM_FETCH(0);
        for (int c = 0; c < 32; ++c) {
            const size_t t0 = tb + c * 64;
            __syncthreads();
            v4u hprev; if (c > 0) hprev = *(const LAS v4u*)(Hs + (tid >> 3) * 72 + (tid & 7) * 8);
#pragma unroll
            for (int j = 0; j < 4; ++j)
#pragma unroll
                for (int e = 0; e < 4; ++e) Cb[(16 * wh + 4 * fq + e) * 136 + 64 * wl + 16 * j + fr] = (bf16)f2bf(Cacc[0][j][e]);
#pragma unroll
            for (int e = 0; e < 4; ++e) Cb[(64 + 4 * fq + e) * 136 + 16 * w + fr] = (bf16)f2bf(Cn[0][0][e]);
#pragma unroll
            for (int i = 0; i < 2; ++i) { const int id = tid + NTHR * i, row = id >> 4, c8 = id & 15; *(LAS v4u*)(Qs + row * 136 + c8 * 8) = pQ[i]; *(LAS v4u*)(Ks + row * 136 + c8 * 8) = pK[i]; }
            { const int srow = tid >> 3, c8 = tid & 7; const float wsv = pws;
                *(LAS v4u*)(Vs + srow * 88 + c8 * 8) = pV;
                v4u o; o.x = cvtpk(lo_bf(pV.x) * wsv, hi_bf(pV.x) * wsv); o.y = cvtpk(lo_bf(pV.y) * wsv, hi_bf(pV.y) * wsv); o.z = cvtpk(lo_bf(pV.z) * wsv, hi_bf(pV.z) * wsv); o.w = cvtpk(lo_bf(pV.w) * wsv, hi_bf(pV.w) * wsv);
                *(LAS v4u*)(VWs + srow * 88 + c8 * 8) = o;
                if (c8 < 2) { v4u one; one.x = c8 == 0 ? 0x3f80u : 0u; one.y = 0u; one.z = 0u; one.w = 0u; *(LAS v4u*)(Vs + srow * 88 + 64 + c8 * 8) = one;
                    v4u wv; wv.x = c8 == 0 ? (cvtpk(wsv, 0.f) & 0xffffu) : 0u; wv.y = 0u; wv.z = 0u; wv.w = 0u; *(LAS v4u*)(VWs + srow * 88 + 64 + c8 * 8) = wv; }
                *(LAS v4u*)(Ps + srow * 72 + c8 * 8) = pP; }
            float wi[4], em[4], dn[4]; const float wc = pwc;
#pragma unroll
            for (int e = 0; e < 4; ++e) { wi[e] = pwi[e]; em[e] = pem[e]; dn[e] = pdn[e]; }
            if (c < 31) MLSTM_FETCH(c + 1);
            if (c > 0) *(v4u*)(hout + (t0 - 64 + (tid >> 3)) * 1024 + h * 256 + vs * 64 + (tid & 7) * 8) = hprev;
            __syncthreads();
            f32x4 ni[1][2], nx[1][2], nq[1][1]; ni[0][0] = (f32x4){0.f, 0.f, 0.f, 0.f}; ni[0][1] = ni[0][0]; nx[0][0] = ni[0][0]; nx[0][1] = ni[0][0]; nq[0][0] = ni[0][0];
            wgemm<1, 2, 64, 72, 88, false, true>(ni, Ps + 16 * wh * 72, Vs + 32 * wl, lane);
            wgemm<1, 2, 128, 136, 136>(nx, Qs + 16 * wh * 136, Cb + 32 * wl * 136, lane);
            wgemm<1, 1, 128, 136, 136>(nq, Qs + 16 * wh * 136, Cb + 64 * 136, lane);
#pragma unroll
            for (int e = 0; e < 4; ++e) { const int t = 16 * wh + 4 * fq + e;
                const float nqt = __shfl(nq[0][0][e], lane & 48);
                const float den = dn[e] + wi[e] * SCALE * nqt; const float inv = 1.0f / fmaxf(fabsf(den), em[e]); float q2 = 0.f;
#pragma unroll
                for (int j = 0; j < 2; ++j) { const float hv = (ni[0][j][e] + SCALE * wi[e] * nx[0][j][e]) * inv; q2 += hv * hv;
                    Hs[t * 72 + 32 * wl + 16 * j + fr] = (bf16)f2bf(hv); }
                q2 += __shfl_xor(q2, 1); q2 += __shfl_xor(q2, 2); q2 += __shfl_xor(q2, 4); q2 += __shfl_xor(q2, 8);
                if (fr == 0) ssq[(t0 + t) * 32 + (h * 4 + vs) * 2 + wl] = q2; }
#pragma unroll
            for (int j = 0; j < 4; ++j) Cacc[0][j] = Cacc[0][j] * wc;
            Cn[0][0] = Cn[0][0] * wc;
            wgemm<1, 4, 64, 88, 136, true, true>(Cacc, VWs + 16 * wh, Ks + 64 * wl, lane);
            wgemm<1, 1, 64, 88, 136, true, true>(Cn, VWs + 64, Ks + 16 * w, lane);
        }
        __syncthreads();
        *(v4u*)(hout + (tb + 31 * 64 + (tid >> 3)) * 1024 + h * 256 + vs * 64 + (tid & 7) * 8) = *(const LAS v4u*)(Hs + (tid >> 3) * 72 + (tid & 7) * 8);
#undef MLSTM_FETCH
    }
}

__device__ __forceinline__ void moba_prep(Frame& F, bf16* QK, const int* pos, const float* gq, const float* gk, float* kpart) {
    LAS float* part = (LAS float*)F.lds;
    const int lane = F.lane, w = F.wave, c = lane & 15;
    float gqv[8], gkv[8], inv[8];
#pragma unroll
    for (int e = 0; e < 8; ++e) { gqv[e] = gq[c * 8 + e]; gkv[e] = gk[c * 8 + e]; inv[e] = exp2f(-(float)(8 * (c & 1) + e) * (18.931568569324174f / 16.0f)); }
    for (int item = blockIdx.x; item < 256; item += F.G) {
        const int b = item >> 4, blk = (item >> 1) & 7, half = item & 1;
        const size_t row0 = (size_t)b * SEQ + blk * 256 + half * 128 + 16 * w;
        float kacc[2][8];
#pragma unroll
        for (int i = 0; i < 2; ++i)
#pragma unroll
            for (int e = 0; e < 8; ++e) kacc[i][e] = 0.f;
        v4u cur[4], nxt[4];
#pragma unroll
        for (int i4 = 0; i4 < 4; ++i4) cur[i4] = *(const v4u*)(QK + row0 * 2048 + (lane + 64 * i4) * 8);
        for (int t = 0; t < 16; ++t) {
            const size_t row = row0 + t;
            if (t < 15) {
#pragma unroll
                for (int i4 = 0; i4 < 4; ++i4) nxt[i4] = *(const v4u*)(QK + (row + 1) * 2048 + (lane + 64 * i4) * 8); }
            float cs[8], sn[8];
            if (c < 4) { const float ps = (float)pos[row];
#pragma unroll
                for (int e = 0; e < 8; ++e) sincosf(ps * inv[e], &sn[e], &cs[e]); }
            else {
#pragma unroll
                for (int e = 0; e < 8; ++e) { cs[e] = 1.f; sn[e] = 0.f; } }
#pragma unroll
            for (int i4 = 0; i4 < 4; ++i4) {
                const unsigned xw[4] = {cur[i4].x, cur[i4].y, cur[i4].z, cur[i4].w}; float y[8]; float ss = 0.f;
#pragma unroll
                for (int e = 0; e < 4; ++e) { y[2 * e] = lo_bf(xw[e]); y[2 * e + 1] = hi_bf(xw[e]); ss += y[2 * e] * y[2 * e] + y[2 * e + 1] * y[2 * e + 1]; }
                ss += __shfl_xor(ss, 1); ss += __shfl_xor(ss, 2); ss += __shfl_xor(ss, 4); ss += __shfl_xor(ss, 8);
                const float rstd = 1.0f / sqrtf(ss * (1.0f / 128.0f) + 1e-6f);
#pragma unroll
                for (int e = 0; e < 8; ++e) { y[e] = y[e] * rstd * (i4 < 2 ? gqv[e] : gkv[e]); }
#pragma unroll
                for (int e = 0; e < 8; ++e) { const float o = __shfl_xor(y[e], 2); y[e] = (c < 2) ? y[e] * cs[e] - o * sn[e] : (c < 4 ? y[e] * cs[e] + o * sn[e] : y[e]); }
                v4u ov; ov.x = cvtpk(y[0], y[1]); ov.y = cvtpk(y[2], y[3]); ov.z = cvtpk(y[4], y[5]); ov.w = cvtpk(y[6], y[7]);
                *(v4u*)(QK + row * 2048 + (lane + 64 * i4) * 8) = ov;
                if (i4 >= 2) {
#pragma unroll
                    for (int e = 0; e < 8; ++e) kacc[i4 - 2][e] += y[e]; }
            }
#pragma unroll
            for (int i4 = 0; i4 < 4; ++i4) cur[i4] = nxt[i4];
        }
        __syncthreads();
#pragma unroll
        for (int i = 0; i < 2; ++i)
#pragma unroll
            for (int e = 0; e < 8; ++e) part[w * 1024 + i * 512 + lane * 8 + e] = kacc[i][e];
        __syncthreads();
        for (int col = F.tid; col < 1024; col += NTHR) { float sacc = 0.f;
#pragma unroll
            for (int ww = 0; ww < 8; ++ww) sacc += part[ww * 1024 + col];
            kpart[((size_t)(b * 8 + blk) * 2 + half) * 1024 + col] = sacc * (1.0f / 256.0f); }
    }
}
__device__ __forceinline__ void moba_attn(Frame& F, const bf16* QK, const bf16* Vt, const float* kpart, bf16* O) {
    constexpr float SCALE = 0.08838834764831845f;
    constexpr int KVB = 64 * 136 + 128 * 72;
    LAS bf16* R = (LAS bf16*)F.lds;
    LAS bf16* Qs = R;
    LAS float* kmS = (LAS float*)(R + 2 * KVB);
    LAS float* gsc = kmS + 1024;
    LAS unsigned* selm = (LAS unsigned*)(gsc + 2048);
    const int tid = F.tid, lane = F.lane, w = F.wave, fr = lane & 15, fq = lane >> 4;
    for (int it = blockIdx.x; it < 1024; it += F.G) {
        const int c = it & 255, r = it >> 8, bh = c & 127, typ = c >> 7, b = bh >> 3, h = bh & 7;
        const int jb = (r & 1) ? 7 - (r >> 1) : (r >> 1);
        const int j = typ ? ((r & 1) ? jb - 2 : jb + 2) : jb;
        const size_t qrow0 = (size_t)b * SEQ + j * 256;
        __syncthreads();
#pragma unroll
        for (int i = 0; i < 8; ++i) { const int id = tid + NTHR * i, row = id >> 4, c8 = id & 15;
            *(LAS v4u*)(Qs + row * 136 + c8 * 8) = *(const v4u*)(QK + (qrow0 + row) * 2048 + h * 128 + c8 * 8); }
        for (int i = tid; i < 1024; i += NTHR) { const int kb_ = i >> 7, d_ = i & 127; const float* kp = kpart + ((size_t)(b * 8 + kb_) * 2) * 1024 + h * 128 + d_; kmS[i] = kp[0] + kp[1024]; }
        __syncthreads();
        if (j > 3) { const int q = tid >> 1, p = tid & 1;
            for (int e = 0; e < 4; ++e) { const int blk = 4 * p + e; float sdot = 0.f;
                if (blk < j) { for (int d = 0; d < 128; ++d) sdot += bf2f(Qs[q * 136 + d]) * kmS[blk * 128 + d]; }
                gsc[q * 8 + blk] = sdot; } }
        __syncthreads();
        if (tid < 256) { unsigned mask = 0u;
            if (j <= 3) mask = (1u << j) - 1u;
            else { for (int k = 0; k < 3; ++k) { float best = -INFINITY; int bi = 0;
                    for (int blk = 0; blk < j; ++blk) { const float gv = gsc[tid * 8 + blk]; if (!((mask >> blk) & 1u) && gv > best) { best = gv; bi = blk; } }
                    mask |= 1u << bi; } }
            selm[tid] = mask; }
        bf16x8 qf[2][4];
#pragma unroll
        for (int i = 0; i < 2; ++i)
#pragma unroll
            for (int ks = 0; ks < 4; ++ks) qf[i][ks] = *(const LAS bf16x8*)(Qs + (32 * w + 16 * i + fr) * 136 + 32 * ks + 8 * fq);
        __syncthreads();
        const unsigned masks = selm[32 * w + fr] | (selm[32 * w + 16 + fr] << 8);
        f32x4 oacc[2][8];
#pragma unroll
        for (int i = 0; i < 2; ++i)
#pragma unroll
            for (int vt = 0; vt < 8; ++vt) oacc[i][vt] = (f32x4){0.f, 0.f, 0.f, 0.f};
        float mrun[2] = {-INFINITY, -INFINITY}, lrun[2] = {0.f, 0.f};
        const int ntile = 4 * j + 4;
        const bf16* kbase = QK + ((size_t)b * SEQ) * 2048 + 1024 + h * 128;
        const bf16* vbase = Vt + ((size_t)h * 128) * MTOK + (size_t)b * SEQ;
        v4u pk[2], pv[2];
#define KOFF(id) ((unsigned)((((id) >> 4) * 2048 + ((id) & 15) * 8) * 2))
#define VOFF(id) ((unsigned)((((id) >> 3) * MTOK + ((id) & 7) * 8) * 2))
#pragma unroll
        for (int i = 0; i < 2; ++i) { const int id = tid + NTHR * i; pk[i] = *(const v4u*)((const char*)kbase + KOFF(id)); pv[i] = *(const v4u*)((const char*)vbase + VOFF(id)); }
#pragma unroll
        for (int i = 0; i < 2; ++i) { const int id = tid + NTHR * i; *(LAS v4u*)(R + (id >> 4) * 136 + (id & 15) * 8) = pk[i]; *(LAS v4u*)(R + 64 * 136 + (id >> 3) * 72 + (id & 7) * 8) = pv[i]; }
        __syncthreads();
        for (int tile = 0; tile < ntile; ++tile) {
            const int kb = tile >> 2, key0 = tile * 64;
            LAS bf16* Ks = R + (tile & 1) * KVB; LAS bf16* VTs = Ks + 64 * 136;
            int tl = tid; asm volatile("" : "+v"(tl));
            if (tile + 1 < ntile) {
#pragma unroll
                for (int i = 0; i < 2; ++i) { const int id = tl + NTHR * i; pk[i] = *(const v4u*)((const char*)(kbase + (size_t)(key0 + 64) * 2048) + KOFF(id)); pv[i] = *(const v4u*)((const char*)(vbase + key0 + 64) + VOFF(id)); } }
            const bool own = (kb == j);
            const bool sel0 = own || ((masks >> kb) & 1u), sel1 = own || ((masks >> (8 + kb)) & 1u);
            const bool active = own ? (key0 - j * 256 <= 32 * w + 31) : (__ballot(sel0 || sel1) != 0ull);
            if (active) {
                f32x4 st[2][4];
#pragma unroll
                for (int kt = 0; kt < 4; ++kt) { st[0][kt] = (f32x4){0.f, 0.f, 0.f, 0.f}; st[1][kt] = st[0][kt];
#pragma unroll
                    for (int ks = 0; ks < 4; ++ks) { const bf16x8 kf = *(const LAS bf16x8*)(Ks + (16 * kt + fr) * 136 + 32 * ks + 8 * fq);
                        st[0][kt] = __builtin_amdgcn_mfma_f32_16x16x32_bf16(kf, qf[0][ks], st[0][kt], 0, 0, 0);
                        st[1][kt] = __builtin_amdgcn_mfma_f32_16x16x32_bf16(kf, qf[1][ks], st[1][kt], 0, 0, 0); } }
#if !defined(ATT_NOSB)
                __builtin_amdgcn_sched_barrier(0);
#endif
                bf16x8 pf[2][2]; float alpha[2];
                constexpr float C2 = SCALE * 1.4426950408889634f;
#pragma unroll
                for (int i = 0; i < 2; ++i) {
                    const bool lsel = i ? sel1 : sel0;
                    float mloc = -INFINITY;
                    if (own) { const int qpos = j * 256 + 32 * w + 16 * i + fr;
#pragma unroll
                        for (int kt = 0; kt < 4; ++kt)
#pragma unroll
                            for (int e = 0; e < 4; ++e) { const int kpos = key0 + 16 * kt + 4 * fq + e; const float sv = (kpos <= qpos) ? st[i][kt][e] : -INFINITY; st[i][kt][e] = sv; mloc = fmaxf(mloc, sv); } }
                    else {
#pragma unroll
                        for (int kt = 0; kt < 4; ++kt)
#pragma unroll
                            for (int e = 0; e < 4; ++e) mloc = fmaxf(mloc, st[i][kt][e]); }
                    mloc = fmaxf(mloc, __shfl_xor(mloc, 16)); mloc = fmaxf(mloc, __shfl_xor(mloc, 32));
                    const float mnew = lsel ? fmaxf(mrun[i], mloc * C2) : mrun[i], msafe = (mnew == -INFINITY) ? 0.f : mnew;
                    alpha[i] = __builtin_amdgcn_exp2f(mrun[i] - msafe);
                    const float moff = lsel ? msafe : INFINITY;
                    float psum = 0.f;
#pragma unroll
                    for (int kk = 0; kk < 2; ++kk) { float pp[8];
#pragma unroll
                        for (int e = 0; e < 4; ++e) { pp[e] = __builtin_amdgcn_exp2f(__builtin_fmaf(st[i][2 * kk][e], C2, -moff)); pp[4 + e] = __builtin_amdgcn_exp2f(__builtin_fmaf(st[i][2 * kk + 1][e], C2, -moff)); }
#pragma unroll
                        for (int e = 0; e < 8; ++e) psum += pp[e];
                        u32x4 pw; pw.x = cvtpk(pp[0], pp[1]); pw.y = cvtpk(pp[2], pp[3]); pw.z = cvtpk(pp[4], pp[5]); pw.w = cvtpk(pp[6], pp[7]);
                        pf[i][kk] = __builtin_bit_cast(bf16x8, pw); }
                    lrun[i] = lrun[i] * alpha[i] + psum; mrun[i] = mnew;
                }
#if ATT_EXP == 2
                {
                    constexpr float C2b = SCALE * 1.4426950408889634f;
#pragma unroll
                    for (int i = 0; i < 2; ++i) { const bool lsel = i ? sel1 : sel0; float mloc = -INFINITY;
#pragma unroll
                        for (int kt = 0; kt < 4; ++kt)
#pragma unroll
                            for (int e = 0; e < 4; ++e) mloc = fmaxf(mloc, st[i][kt][e] + 1.0f);
                        mloc = fmaxf(mloc, __shfl_xor(mloc, 16)); mloc = fmaxf(mloc, __shfl_xor(mloc, 32));
                        const float mnew = lsel ? fmaxf(mrun[i], mloc * C2b) : mrun[i], msafe = (mnew == -INFINITY) ? 0.f : mnew;
                        const float moff = lsel ? msafe : INFINITY; float psum = 0.f; unsigned acc_ = 0u;
#pragma unroll
                        for (int kk = 0; kk < 2; ++kk) { float pp[8];
#pragma unroll
                            for (int e = 0; e < 4; ++e) { pp[e] = __builtin_amdgcn_exp2f(__builtin_fmaf(st[i][2 * kk][e], C2b, -moff)); pp[4 + e] = __builtin_amdgcn_exp2f(__builtin_fmaf(st[i][2 * kk + 1][e], C2b, -moff)); }
#pragma unroll
                            for (int e = 0; e < 8; ++e) psum += pp[e];
                            acc_ ^= cvtpk(pp[0], pp[1]) ^ cvtpk(pp[2], pp[3]) ^ cvtpk(pp[4], pp[5]) ^ cvtpk(pp[6], pp[7]); }
                        asm volatile("" :: "v"(psum), "v"(acc_)); } }
#endif
                const bool rescale = __ballot(alpha[0] != 1.0f || alpha[1] != 1.0f) != 0ull;
#if !defined(ATT_NOSB)
                __builtin_amdgcn_sched_barrier(0);
#endif
#pragma unroll
                for (int vt = 0; vt < 8; ++vt) { if (rescale) { oacc[0][vt] = oacc[0][vt] * alpha[0]; oacc[1][vt] = oacc[1][vt] * alpha[1]; }
#pragma unroll
                    for (int kk = 0; kk < 2; ++kk) { const LAS bf16* vp = VTs + (16 * vt + fr) * 72 + 32 * kk + 4 * fq;
                        const u32x2 v0 = *(const LAS u32x2*)vp, v1 = *(const LAS u32x2*)(vp + 16);
                        u32x4 vw; vw.x = v0.x; vw.y = v0.y; vw.z = v1.x; vw.w = v1.y; const bf16x8 vf = __builtin_bit_cast(bf16x8, vw);
                        oacc[0][vt] = __builtin_amdgcn_mfma_f32_16x16x32_bf16(vf, pf[0][kk], oacc[0][vt], 0, 0, 0);
                        oacc[1][vt] = __builtin_amdgcn_mfma_f32_16x16x32_bf16(vf, pf[1][kk], oacc[1][vt], 0, 0, 0); } }
            }
            if (tile + 1 < ntile) { LAS bf16* Kn = R + ((tile + 1) & 1) * KVB;
#pragma unroll
                for (int i = 0; i < 2; ++i) { const int id = tl + NTHR * i; *(LAS v4u*)(Kn + (id >> 4) * 136 + (id & 15) * 8) = pk[i]; *(LAS v4u*)(Kn + 64 * 136 + (id >> 3) * 72 + (id & 7) * 8) = pv[i]; } }
            __syncthreads();
        }
#undef KOFF
#undef VOFF
#pragma unroll
        for (int i = 0; i < 2; ++i) { float l = lrun[i]; l += __shfl_xor(l, 16); l += __shfl_xor(l, 32); const float il = 1.0f / l;
            bf16* orow = O + (qrow0 + 32 * w + 16 * i + fr) * 1024 + h * 128;
#pragma unroll
            for (int vt = 0; vt < 8; ++vt) { u32x2 o; o.x = cvtpk(oacc[i][vt][0] * il, oacc[i][vt][1] * il); o.y = cvtpk(oacc[i][vt][2] * il, oacc[i][vt][3] * il);
                *(u32x2*)(orow + 16 * vt + 4 * fq) = o; } }
    }
}

__device__ __forceinline__ void ret_rot_table(Frame& F, const int* pos, float* cst) {
    const int gw = blockIdx.x * NWAVES + F.wave, NGW = F.G * NWAVES, lane = F.lane;
    const float i0 = exp2f(-(float)(2 * lane) * (13.287712379549449f / 128.0f)), i1 = exp2f(-(float)(2 * lane + 1) * (13.287712379549449f / 128.0f));
    for (int m = gw; m < MTOK; m += NGW) {
        const float ps = (float)pos[m]; float s0, c0, s1, c1; sincosf(ps * i0, &s0, &c0); sincosf(ps * i1, &s1, &c1);
        f32x2* cp = (f32x2*)(cst + (size_t)m * 256) + lane; cp[0] = (f32x2){c0, c1}; cp[64] = (f32x2){s0, s1};
    }
}
__device__ __forceinline__ void ret_pmat(Frame& F, const bf16* QKV, bf16* PM) {
    LAS bf16* Qd = (LAS bf16*)F.lds;
    LAS bf16* Kd = Qd + 128 * 72;
    LAS bf16* Ps = Kd + 128 * 72;
    const int tid = F.tid, lane = F.lane, w = F.wave, fr = lane & 15, fq = lane >> 4, wh = w >> 1, wl = w & 1;
    const unsigned off0 = (unsigned)((((tid >> 3) * 4096) + (tid & 7) * 8) * 2);
    for (int item = blockIdx.x; item < 1024; item += F.G) {
        const int b = item >> 6, h = (item >> 4) & 3, c = item & 15;
        const float lgc = log1pf(-exp2f(-5.0f - (float)h)) * 1.4426950408889634f;
        const char* gq = (const char*)(QKV + ((size_t)b * SEQ + c * 128) * 4096 + h * 256);
        v4u pq[2], pkk[2];
#pragma unroll
        for (int i = 0; i < 2; ++i) { const char* src = gq + off0 + i * (64 * 4096 * 2); pq[i] = *(const v4u*)src; pkk[i] = *(const v4u*)(src + 2048); }
        f32x4 S[2][4];
#pragma unroll
        for (int i = 0; i < 2; ++i)
#pragma unroll
            for (int jj = 0; jj < 4; ++jj) S[i][jj] = (f32x4){0.f, 0.f, 0.f, 0.f};
#pragma unroll 1
        for (int dt = 0; dt < 4; ++dt) {
            __syncthreads();
#pragma unroll
            for (int i = 0; i < 2; ++i) { const int id = tid + NTHR * i, row = id >> 3, c8 = id & 7; *(LAS v4u*)(Qd + row * 72 + c8 * 8) = pq[i]; *(LAS v4u*)(Kd + row * 72 + c8 * 8) = pkk[i]; }
            if (dt < 3) {
#pragma unroll
                for (int i = 0; i < 2; ++i) { const char* src = gq + (dt + 1) * 128 + off0 + i * (64 * 4096 * 2); pq[i] = *(const v4u*)src; pkk[i] = *(const v4u*)(src + 2048); } }
            __syncthreads();
            wgemm<2, 4, 64, 72, 72>(S, Qd + 32 * wh * 72, Kd + 64 * wl * 72, lane);
        }
#pragma unroll
        for (int i = 0; i < 2; ++i)
#pragma unroll
            for (int e = 0; e < 4; ++e) { const int t = 32 * wh + 16 * i + 4 * fq + e;
#pragma unroll
                for (int jj = 0; jj < 4; ++jj) { const int sidx = 64 * wl + 16 * jj + fr; const float wgt = (t >= sidx) ? __builtin_amdgcn_exp2f((float)(t - sidx) * lgc) : 0.f;
                    Ps[t * 136 + sidx] = (bf16)f2bf(S[i][jj][e] * wgt); } }
        __syncthreads();
        bf16* dst = PM + (size_t)item * 128 * 128;
#pragma unroll
        for (int i = 0; i < 4; ++i) { const int id = tid + NTHR * i, row = id >> 4, c8 = id & 15; *(v4u*)(dst + row * 128 + c8 * 8) = *(const LAS v4u*)(Ps + row * 136 + c8 * 8); }
    }
}
#ifndef RET_EXP
#define RET_EXP 0
#endif
__device__ __forceinline__ void ret_core(Frame& F, bf16* QKV, const bf16* PM, float* st) {
    constexpr int TSET = 3 * 128 * 72;
    LAS bf16* T0 = (LAS bf16*)F.lds;
    LAS bf16* Vs = T0 + 2 * TSET;
    LAS bf16* Ps = T0;
    LAS bf16* Xs = T0 + TSET;
    LAS float* fST = (LAS float*)(Vs + 128 * 136);
    const int tid = F.tid, lane = F.lane, w = F.wave, fr = lane & 15, fq = lane >> 4, wh = w >> 1, wl = w & 1;
    const unsigned off8 = (unsigned)((((tid >> 3) * 4096) + (tid & 7) * 8) * 2);
    const unsigned off16 = (unsigned)((((tid >> 4) * 4096) + (tid & 15) * 8) * 2);
    for (int item = blockIdx.x; item < 256; item += F.G) {
        const int b = item >> 4, h = (item >> 2) & 3, vs = item & 3;
        const float lg = log1pf(-exp2f(-5.0f - (float)h)), gch = expf(128.0f * lg);
        f32x4 Racc[4][1][4];
#pragma unroll
        for (int dt = 0; dt < 4; ++dt)
#pragma unroll
            for (int jj = 0; jj < 4; ++jj) Racc[dt][0][jj] = (f32x4){0.f, 0.f, 0.f, 0.f};
        const size_t tb = (size_t)b * SEQ;
        __syncthreads();
        v4u pq[2], pkk[2], pv[4];
        { const char* gq0 = (const char*)(QKV + tb * 4096 + h * 256); const char* gv0 = (const char*)(QKV + tb * 4096 + 2048 + h * 512 + vs * 128);
#pragma unroll
            for (int i = 0; i < 2; ++i) { const char* src = gq0 + off8 + i * (64 * 4096 * 2); pq[i] = *(const v4u*)src; pkk[i] = *(const v4u*)(src + 2048); }
#pragma unroll
            for (int i = 0; i < 4; ++i) pv[i] = *(const v4u*)(gv0 + off16 + i * (32 * 4096 * 2)); }
        for (int c = 0; c < 16; ++c) {
            const size_t t0 = tb + c * 128;
            const char* gq = (const char*)(QKV + t0 * 4096 + h * 256);
            char* gy = (char*)(QKV + t0 * 4096 + 2048 + h * 512 + vs * 128);
            const bf16* pmt = PM + ((size_t)((b * 4 + h) * 16 + c)) * 128 * 128;
            float lgc = lg * 1.4426950408889634f; asm volatile("" : "+v"(lgc));
#pragma unroll
            for (int i = 0; i < 4; ++i) { const int id = tid + NTHR * i; *(LAS v4u*)(Vs + (id >> 4) * 136 + (id & 15) * 8) = pv[i]; }
            f32x4 X[2][4];
#pragma unroll
            for (int i = 0; i < 2; ++i)
#pragma unroll
                for (int jj = 0; jj < 4; ++jj) X[i][jj] = (f32x4){0.f, 0.f, 0.f, 0.f};
#pragma unroll 1
            for (int dt = 0; dt < 4; ++dt) {
                LAS bf16* Qd = T0 + (dt & 1) * TSET; LAS bf16* Kz = Qd + 128 * 72; LAS bf16* Rb = Kz + 128 * 72;
#pragma unroll
                for (int i = 0; i < 2; ++i) { const int id = tid + NTHR * i, row = id >> 3, c8 = id & 7; const float z = __builtin_amdgcn_exp2f((float)(127 - row) * lgc);
                    *(LAS v4u*)(Qd + row * 72 + c8 * 8) = pq[i];
                    v4u zo; zo.x = cvtpk(lo_bf(pkk[i].x) * z, hi_bf(pkk[i].x) * z); zo.y = cvtpk(lo_bf(pkk[i].y) * z, hi_bf(pkk[i].y) * z); zo.z = cvtpk(lo_bf(pkk[i].z) * z, hi_bf(pkk[i].z) * z); zo.w = cvtpk(lo_bf(pkk[i].w) * z, hi_bf(pkk[i].w) * z);
                    *(LAS v4u*)(Kz + row * 72 + c8 * 8) = zo; }
#pragma unroll
                for (int jj = 0; jj < 4; ++jj)
#pragma unroll
                    for (int e = 0; e < 4; ++e) Rb[(16 * w + 4 * fq + e) * 72 + 16 * jj + fr] = (bf16)f2bf(Racc[0][0][jj][e]);
#if RET_EXP == 3
                asm volatile("" ::: "memory");
#pragma unroll
                for (int jj = 0; jj < 4; ++jj)
#pragma unroll
                    for (int e = 0; e < 4; ++e) *(volatile LAS bf16*)(Rb + (16 * w + 4 * fq + e) * 72 + 16 * jj + fr) = (bf16)f2bf(Racc[0][0][jj][e]);
#endif
                if (dt < 3 || c < 15) {
                    const char* nb = (dt < 3) ? gq + (dt + 1) * 128 : gq + (size_t)128 * 4096 * 2;
#pragma unroll
                    for (int i = 0; i < 2; ++i) { const char* src = nb + off8 + i * (64 * 4096 * 2); pq[i] = *(const v4u*)src; pkk[i] = *(const v4u*)(src + 2048); } }
                __syncthreads();
                wgemm<2, 4, 64, 72, 72, false, false, false>(X, Qd + 32 * wh * 72, Rb + 64 * wl * 72, lane);
#if RET_EXP == 5
                { f32x4 D_[2][4];
#pragma unroll
                  for (int i = 0; i < 2; ++i)
#pragma unroll
                    for (int jj = 0; jj < 4; ++jj) D_[i][jj] = (f32x4){0.f, 0.f, 0.f, 0.f};
                  wgemm<2, 4, 64, 72, 72>(D_, Qd + 32 * wh * 72, Rb + 64 * wl * 72, lane);
#pragma unroll
                  for (int i = 0; i < 2; ++i)
#pragma unroll
                    for (int jj = 0; jj < 4; ++jj) asm volatile("" :: "v"(D_[i][jj])); }
#endif
#if RET_EXP == 6
                { f32x4 D_[1][4];
#pragma unroll
                    for (int jj = 0; jj < 4; ++jj) D_[0][jj] = (f32x4){0.f, 0.f, 0.f, 0.f};
                  wgemm<1, 4, 128, 136, 72, true, true>(D_, Vs + 16 * w, Kz, lane);
#pragma unroll
                    for (int jj = 0; jj < 4; ++jj) asm volatile("" :: "v"(D_[0][jj])); }
#endif
#pragma unroll
                for (int jj = 0; jj < 4; ++jj) Racc[0][0][jj] = Racc[0][0][jj] * gch;
                wgemm<1, 4, 128, 136, 72, true, true, false>(Racc[0], Vs + 16 * w, Kz, lane);
#pragma unroll
                for (int jj = 0; jj < 4; ++jj) { const f32x4 t_ = Racc[0][0][jj]; Racc[0][0][jj] = Racc[1][0][jj]; Racc[1][0][jj] = Racc[2][0][jj]; Racc[2][0][jj] = Racc[3][0][jj]; Racc[3][0][jj] = t_; }
            }
            v4u pp[4];
#pragma unroll
            for (int i = 0; i < 4; ++i) { const int id = tid + NTHR * i; pp[i] = *(const v4u*)(pmt + (id >> 4) * 128 + (id & 15) * 8); }
#if RET_EXP == 2
            asm volatile("s_waitcnt vmcnt(0)" ::: "memory");
#pragma unroll
            for (int i = 0; i < 4; ++i) { const int id = tid + NTHR * i; v4u q_ = *(const volatile v4u*)(pmt + 64 * 128 * 128 + (id >> 4) * 128 + (id & 15) * 8); asm volatile("" :: "v"(q_.x), "v"(q_.y), "v"(q_.z), "v"(q_.w)); }
            asm volatile("s_waitcnt vmcnt(0)" ::: "memory");
#endif
#pragma unroll
            for (int i = 0; i < 2; ++i)
#pragma unroll
                for (int e = 0; e < 4; ++e) { const int t = 32 * wh + 16 * i + 4 * fq + e; const float xi = __builtin_amdgcn_exp2f((float)(t + 1) * lgc);
#pragma unroll
                    for (int jj = 0; jj < 4; ++jj) X[i][jj][e] *= xi; }
#pragma unroll
            for (int i = 0; i < 4; ++i) { const int id = tid + NTHR * i; *(LAS v4u*)(Ps + (id >> 4) * 136 + (id & 15) * 8) = pp[i]; }
            __syncthreads();
            wgemm<2, 4, 128, 136, 136, false, true, false>(X, Ps + 32 * wh * 136, Vs + 64 * wl, lane);
#pragma unroll
            for (int i = 0; i < 2; ++i)
#pragma unroll
                for (int e = 0; e < 4; ++e) { const int t = 32 * wh + 16 * i + 4 * fq + e; float s1 = 0.f, s2 = 0.f;
#pragma unroll
                    for (int jj = 0; jj < 4; ++jj) { const float y = X[i][jj][e]; s1 += y; s2 += y * y; Xs[t * 136 + 64 * wl + 16 * jj + fr] = (bf16)f2bf(y); }
                    s1 += __shfl_xor(s1, 1); s1 += __shfl_xor(s1, 2); s1 += __shfl_xor(s1, 4); s1 += __shfl_xor(s1, 8);
                    s2 += __shfl_xor(s2, 1); s2 += __shfl_xor(s2, 2); s2 += __shfl_xor(s2, 4); s2 += __shfl_xor(s2, 8);
                    if (fr == 0) { fST[(wl * 128 + t) * 2] = s1; fST[(wl * 128 + t) * 2 + 1] = s2; } }
            if (c < 15) { const char* gvn = gy + (size_t)128 * 4096 * 2;
#pragma unroll
                for (int i = 0; i < 4; ++i) pv[i] = *(const v4u*)(gvn + off16 + i * (32 * 4096 * 2)); }
            __syncthreads();
#pragma unroll
            for (int i = 0; i < 4; ++i) { const int id = tid + NTHR * i, row = id >> 4, c8 = id & 15; *(v4u*)(gy + (unsigned)((row * 4096 + c8 * 8) * 2)) = *(const LAS v4u*)(Xs + row * 136 + c8 * 8); }
            if (tid < 128) { float* sp = st + (t0 + tid) * 32 + (h * 4 + vs) * 2; sp[0] = fST[tid * 2] + fST[(128 + tid) * 2]; sp[1] = fST[tid * 2 + 1] + fST[(128 + tid) * 2 + 1]; }
        }
    }
}

__device__ __forceinline__ void lru_conv(Frame& F, const bf16* GX, const float* cw, const float* cb, bf16* XC, const float* lru, float* sptab) {
    if (blockIdx.x == 0) for (int i = F.tid; i < 1024; i += NTHR) { const float l = -lru[i]; sptab[i] = fmaxf(l, 0.f) + log1pf(expf(-fabsf(l))); }
    const int c8 = F.tid & 127, rsub = F.tid >> 7;
    f32x4 w0[4], w1[4];
#pragma unroll
    for (int wv = 0; wv < 4; ++wv) { w0[wv] = *(const f32x4*)(cw + wv * 1024 + c8 * 8); w1[wv] = *(const f32x4*)(cw + wv * 1024 + c8 * 8 + 4); }
    const f32x4 b0 = *(const f32x4*)(cb + c8 * 8), b1 = *(const f32x4*)(cb + c8 * 8 + 4);
    for (int r0 = blockIdx.x * 16; r0 < MTOK; r0 += F.G * 16) {
        const int rb = r0 + 4 * rsub, t = rb & (SEQ - 1);
        v4u xin[7];
#pragma unroll
        for (int k = 0; k < 7; ++k) { const int rr = rb - 3 + k; xin[k] = (t - 3 + k >= 0) ? *(const v4u*)(GX + (size_t)rr * 2048 + 1024 + c8 * 8) : (v4u){0u, 0u, 0u, 0u}; }
#pragma unroll
        for (int q = 0; q < 4; ++q) { f32x4 a0 = b0, a1 = b1;
#pragma unroll
            for (int wv = 0; wv < 4; ++wv) { const v4u x = xin[q + wv];
                a0 += (f32x4){lo_bf(x.x), hi_bf(x.x), lo_bf(x.y), hi_bf(x.y)} * w0[wv]; a1 += (f32x4){lo_bf(x.z), hi_bf(x.z), lo_bf(x.w), hi_bf(x.w)} * w1[wv]; }
            v4u o; o.x = cvtpk(a0[0], a0[1]); o.y = cvtpk(a0[2], a0[3]); o.z = cvtpk(a1[0], a1[1]); o.w = cvtpk(a1[2], a1[3]);
            *(v4u*)(XC + (size_t)(rb + q) * 1024 + c8 * 8) = o; }
    }
}
__device__ __forceinline__ float gelu_tanh(float x) { const float z = 0.7978845608028654f * (x + 0.044715f * x * x * x); const float e = __expf(2.0f * z); const float th = 1.0f - 2.0f * __builtin_amdgcn_rcpf(e + 1.0f); return 0.5f * x * (1.0f + th); }
__device__ __forceinline__ void lru_scan(Frame& F, const bf16* LA, const bf16* BT, const bf16* GX, bf16* Y) {
    LAS float* segL = (LAS float*)F.lds;
    LAS float* segH = segL + 512;
    const int lane = F.lane, w = F.wave;
    for (int item = blockIdx.x; item < 256; item += F.G) {
        const int b = item >> 4, ch = (item & 15) * 64 + lane;
        const size_t r0 = (size_t)b * SEQ + w * 256;
        const bf16* la_p = LA + r0 * 1024 + ch; const bf16* bt_p = BT + r0 * 1024 + ch; const bf16* gx_p = GX + r0 * 2048 + ch; bf16* y_p = Y + r0 * 1024 + ch;
        float L = 0.f, H = 0.f;
        bf16 la0[16], bt0[16], la1[16], bt1[16];
#pragma unroll
        for (int k = 0; k < 16; ++k) { la0[k] = la_p[(size_t)k * 1024]; bt0[k] = bt_p[(size_t)k * 1024]; }
#pragma unroll 1
        for (int tb = 0; tb < 16; tb += 2) {
#pragma unroll
            for (int k = 0; k < 16; ++k) { la1[k] = la_p[(size_t)((tb + 1) * 16 + k) * 1024]; bt1[k] = bt_p[(size_t)((tb + 1) * 16 + k) * 1024]; }
#pragma unroll
            for (int k = 0; k < 16; ++k) { const float la = bf2f(la0[k]); L += la; H = __expf(la) * H + bf2f(bt0[k]); }
            if (tb + 2 < 16) {
#pragma unroll
                for (int k = 0; k < 16; ++k) { la0[k] = la_p[(size_t)((tb + 2) * 16 + k) * 1024]; bt0[k] = bt_p[(size_t)((tb + 2) * 16 + k) * 1024]; } }
#pragma unroll
            for (int k = 0; k < 16; ++k) { const float la = bf2f(la1[k]); L += la; H = __expf(la) * H + bf2f(bt1[k]); }
        }
        __syncthreads();
        segL[w * 64 + lane] = L; segH[w * 64 + lane] = H;
        __syncthreads();
        float hc = 0.f;
        for (int sg = 0; sg < w; ++sg) hc = __expf(segL[sg * 64 + lane]) * hc + segH[sg * 64 + lane];
        bf16 g0[16], g1[16];
#pragma unroll
        for (int k = 0; k < 16; ++k) { la0[k] = la_p[(size_t)k * 1024]; bt0[k] = bt_p[(size_t)k * 1024]; g0[k] = gx_p[(size_t)k * 2048]; }
#pragma unroll
        for (int k = 0; k < 16; ++k) { const size_t t = (size_t)(16 + k); la1[k] = la_p[t * 1024]; bt1[k] = bt_p[t * 1024]; g1[k] = gx_p[t * 2048]; }
#pragma unroll 1
        for (int tb = 0; tb < 16; tb += 2) {
            bf16 yv[16];
#pragma unroll
            for (int k = 0; k < 16; ++k) { hc = __expf(bf2f(la0[k])) * hc + bf2f(bt0[k]); yv[k] = (bf16)f2bf(hc * gelu_tanh(bf2f(g0[k]))); }
            if (tb + 2 < 16) {
#pragma unroll
                for (int k = 0; k < 16; ++k) { const size_t t = (size_t)((tb + 2) * 16 + k); la0[k] = la_p[t * 1024]; bt0[k] = bt_p[t * 1024]; g0[k] = gx_p[t * 2048]; } }
#pragma unroll
            for (int k = 0; k < 16; ++k) y_p[(size_t)(tb * 16 + k) * 1024] = yv[k];
#pragma unroll
            for (int k = 0; k < 16; ++k) { hc = __expf(bf2f(la1[k])) * hc + bf2f(bt1[k]); yv[k] = (bf16)f2bf(hc * gelu_tanh(bf2f(g1[k]))); }
            if (tb + 3 < 16) {
#pragma unroll
                for (int k = 0; k < 16; ++k) { const size_t t = (size_t)((tb + 3) * 16 + k); la1[k] = la_p[t * 1024]; bt1[k] = bt_p[t * 1024]; g1[k] = gx_p[t * 2048]; } }
#pragma unroll
            for (int k = 0; k < 16; ++k) y_p[(size_t)((tb + 1) * 16 + k) * 1024] = yv[k];
        }
    }
}

#ifndef WGM_BIG
#define WGM_BIG 8
#endif
#ifndef WGM_N4
#define WGM_N4 4
#endif
#ifndef WGM_MID
#define WGM_MID 8
#endif
template <class Epi>
__device__ __forceinline__ void run_gemm(Frame& F, const bf16* A, int lda, const bf16* Bt, int ldb, int N, int K, const Epi& E, int M = MTOK, int ablk = 0) {
    pg8::Gemm g{A, Bt, M, N, K, lda, ldb, ablk}; pg8::StaticOrder S; S.init(M, N, F.G, (int)blockIdx.x, (N >= 4096) ? WGM_BIG : (N <= 1024 ? WGM_N4 : WGM_MID));
#ifndef STAGGER_NG
#define STAGGER_NG 1
#endif
#ifndef STAGGER_STEP
#define STAGGER_STEP 300
#endif
    if (STAGGER_NG > 1 && N >= 4096 && M == MTOK) {
        const unsigned grp = (((unsigned)blockIdx.x >> 3) & 7u) / (8 / STAGGER_NG);
        if (grp) { const unsigned long long t0 = __builtin_amdgcn_s_memrealtime(), dl = (unsigned long long)grp * STAGGER_STEP;
            while (__builtin_amdgcn_s_memrealtime() - t0 < dl) __builtin_amdgcn_s_sleep(8); }
    }
#ifndef FUSE_NX
#define FUSE_NX false
#endif
#ifndef GEMM_ALIGN
#define GEMM_ALIGN true
#endif
#ifndef GEMM_SP2
#define GEMM_SP2 true
#endif
    pg8::gemm_phase<Epi, pg8::StaticOrder, GEMM_ALIGN, GEMM_SP2>(F.lds, g, S, E);
}

typedef const __attribute__((address_space(4))) struct Args* ArgsP;
constexpr int NPHASE = 35;
__device__ __forceinline__ ArgsP get_args() { ArgsP p = (ArgsP)__builtin_amdgcn_kernarg_segment_ptr(); asm volatile("" : "+s"(p)); return p; }
__device__ __forceinline__ bool in_phase(int k) { ArgsP a = get_args(); return a->ph_lo <= k && k < a->ph_hi; }
#ifndef DUP_PHASE
#define DUP_PHASE -1
#endif
#ifndef BAR_EXP
#define BAR_EXP 0
#endif
#ifndef TIMING_MASK
#define TIMING_MASK 0ull
#endif
#define TMISC ((volatile LAS unsigned long long*)((LAS unsigned char*)lds_raw + MISC_OFF))
#define TB(k) do { if (((TIMING_MASK >> (k)) & 1ull) && blockIdx.x == 0 && threadIdx.x == 0) TMISC[0] = __builtin_amdgcn_s_memrealtime(); } while (0)
#define TE(k) do { if (((TIMING_MASK >> (k)) & 1ull) && blockIdx.x == 0 && threadIdx.x == 0) TMISC[1] = TMISC[1] + (__builtin_amdgcn_s_memrealtime() - TMISC[0]); } while (0)
#define REP(k) TB(k); for (int rep_ = 0; rep_ < ((k) == DUP_PHASE ? 2 : 1); ++rep_)
#define AP ArgsP ap = get_args(); { int t_ = threadIdx.x; asm volatile("" : "+v"(t_)); F.tid = t_; F.lane = t_ & 63; F.wave = __builtin_amdgcn_readfirstlane(t_ >> 6); F.G = gridDim.x; F.lds = (LAS unsigned char*)lds_raw; }
__global__ void __launch_bounds__(NTHR, 2) trunk_fwd(Args args) {
    extern __shared__ __attribute__((aligned(16))) unsigned char lds_raw[];
    Frame F; F.lds = (LAS unsigned char*)lds_raw; F.tid = threadIdx.x; F.lane = F.tid & 63; F.wave = __builtin_amdgcn_readfirstlane(F.tid >> 6); F.G = gridDim.x;
    volatile LAS unsigned* MISC = (volatile LAS unsigned*)(F.lds + MISC_OFF);
    if (F.tid < 16) MISC[F.tid] = 0u;
    __syncthreads();
    if (args.ph_hi - args.ph_lo > 1) (void)xcd_barrier_post((unsigned*)(args.ws + WS_CTL) + CW_BAR, MISC + 8);
#ifndef ONLY_PHASE
#define ONLY_PHASE -1
#endif
#define IN(k) ((ONLY_PHASE < 0 || (k) == ONLY_PHASE) && in_phase(k))
#define SEAM(k) do { if (IN(k) && IN((k) + 1)) { XcdBarrier bb; bb.bar = (unsigned*)(get_args()->ws + WS_CTL) + CW_BAR; bb.x = xb_xcc_id(); bb.st = (volatile LAS unsigned*)((LAS unsigned char*)lds_raw + MISC_OFF) + 8; xcd_barrier(bb); if (BAR_EXP) xcd_barrier(bb); } if (IN(k)) TE(k); } while (0)
#define XIN ((const float*)ap->in[0])
#define pos ((const int*)ap->in[1])
#define norm_mix ((const float*)ap->in[2])
#define norm_ffn ((const float*)ap->in[3])
#define ffn_w_in ((const float*)ap->in[4])
#define ffn_w_out ((const float*)ap->in[5])
#define out (ap->out)
#define Wmi ((bf16*)(ap->ws + WS_W_MIXIN))
#define Wmo ((bf16*)(ap->ws + WS_W_MIXOUT))
#define Wfi ((bf16*)(ap->ws + WS_W_FFNIN))
#define Wfo ((bf16*)(ap->ws + WS_W_FFNOUT))
#define U ((bf16*)(ap->ws + WS_U))
#define BIG ((bf16*)(ap->ws + WS_BIG))
#define gatesA ((float*)(ap->ws + WS_GATESA))
#define ssqA ((float*)(ap->ws + WS_SSQA))
#define statC ((float*)(ap->ws + WS_STATC))
#define kmean ((float*)(ap->ws + WS_KMEAN))
#define sptab ((float*)(ap->ws + WS_SPTAB))
#define ssqH ((float*)(ap->ws + WS_SSQH))

#define a_w_in ((const float*)ap->in[6])
#define a_b ((const float*)ap->in[7])
#define a_g ((const float*)ap->in[8])
#define a_w_out ((const float*)ap->in[9])
#define b_w_in ((const float*)ap->in[10])
#define b_gq ((const float*)ap->in[11])
#define b_gk ((const float*)ap->in[12])
#define b_w_out ((const float*)ap->in[13])
#define c_w_in ((const float*)ap->in[14])
#define c_g ((const float*)ap->in[15])
#define c_w_out ((const float*)ap->in[16])
#define d_w_in ((const float*)ap->in[17])
#define d_cw ((const float*)ap->in[18])
#define d_cb ((const float*)ap->in[19])
#define d_wg ((const float*)ap->in[20])
#define d_bg ((const float*)ap->in[21])
#define d_lru ((const float*)ap->in[22])
#define d_w_out ((const float*)ap->in[23])
#define GX BIG
#define XC (BIG + (size_t)MTOK * 2048)
#define LA (BIG + (size_t)MTOK * 3072)
#define BT (BIG + (size_t)MTOK * 4096)
#define Y (BIG + (size_t)MTOK * 5120)
#define Wg (Wmi + (size_t)2048 * DM)
#define FFN_CVT(l) do { cvt_matrix(F, ffn_w_in + (size_t)(l) * DM * 2 * DFF, 2 * DFF, DM, 2 * DFF, 1, Wfi); cvt_matrix(F, ffn_w_out + (size_t)(l) * DFF * DM, DM, DFF, DM, 0, Wfo); } while (0)
#define FFN_PHASES(p0, l) do { \
    if (IN(p0)) { AP; REP(p0) { norm_phase<false>(F, out, norm_ffn + (l) * DM, U, nullptr, nullptr, nullptr); } } SEAM(p0); \
    if (IN((p0) + 1)) { AP; REP((p0) + 1) { pg8::EpiSwiGLU<false> E{BIG, DFF, nullptr}; run_gemm(F, U, DM, Wfi, DM, 2 * DFF, DM, E); } } SEAM((p0) + 1); \
    if (IN((p0) + 2)) { AP; REP((p0) + 2) { pg8::EpiResid<FUSE_NX> E{out, out, DM, U, ssqH}; run_gemm(F, BIG, DFF, Wfo, DFF, DM, DFF, E); } } SEAM((p0) + 2); } while (0)
#define QKV BIG
#define HO (BIG + (size_t)MTOK * 2048)
#define PMAB (BIG + (size_t)MTOK * 3072)
#define GTB ((float*)(BIG + (size_t)MTOK * 3584))
#define DENB ((float*)(BIG + (size_t)MTOK * 3584) + 2048 * 320)
    if (IN(0)) { AP; REP(0) { cvt_matrix(F, a_w_in, 3080, DM, 3072, 0, Wmi); cvt_matrix(F, a_w_out, DM, DM, DM, 0, Wmo); FFN_CVT(0);
        __syncthreads(); norm_phase<true>(F, XIN, norm_mix, U, a_w_in, a_b, gatesA); } } SEAM(0);
    if (IN(1)) { AP; REP(1) { mlstm_pre(F, gatesA, GTB); __syncthreads(); pg8::EpiStore<false> E{QKV, 2048, nullptr}; run_gemm(F, U, DM, Wmi, DM, 2048, DM, E); } } SEAM(1);
    if (IN(2)) { AP; REP(2) { mlstm_pmat(F, QKV, GTB, PMAB, DENB); } } SEAM(2);
    if (IN(3)) { AP; REP(3) { mlstm_core(F, QKV, GTB, PMAB, DENB, HO, ssqA); } } SEAM(3);
    if (IN(4)) { AP; REP(4) { pg8::EpiGateA E{HO, ssqA, a_g}; run_gemm(F, U, DM, Wmi + (size_t)2048 * DM, DM, DM, DM, E); } } SEAM(4);
    if (IN(5)) { AP; REP(5) { pg8::EpiResid<FUSE_NX> E{XIN, out, DM, U, ssqH}; run_gemm(F, HO, DM, Wmo, DM, DM, DM, E); } } SEAM(5);
    FFN_PHASES(6, 0);
#define OB (BIG + (size_t)MTOK * 3072)
#define VTB (BIG + (size_t)MTOK * 2048)
    if (IN(9)) { AP; REP(9) { cvt_matrix(F, b_w_in, 3072, DM, 3072, 0, Wmi); cvt_matrix(F, b_w_out, DM, DM, DM, 0, Wmo); FFN_CVT(1);
        __syncthreads(); norm_phase<false>(F, out, norm_mix + DM, U, nullptr, nullptr, nullptr); } } SEAM(9);
    if (IN(10)) { AP; REP(10) { { pg8::EpiStore<false> E{QKV, 2048, nullptr}; run_gemm(F, U, DM, Wmi, DM, 2048, DM, E); } __syncthreads();
        { pg8::EpiStore<false> E{VTB, MTOK, nullptr}; run_gemm(F, Wmi + (size_t)2048 * DM, DM, U, DM, MTOK, DM, E, DM); } } } SEAM(10);
    if (IN(11)) { AP; REP(11) { moba_prep(F, QKV, pos, b_gq, b_gk, kmean); } } SEAM(11);
    if (IN(12)) { AP; REP(12) { moba_attn(F, QKV, VTB, kmean, OB); } } SEAM(12);
    if (IN(13)) { AP; REP(13) { pg8::EpiResid<FUSE_NX> E{out, out, DM, U, ssqH}; run_gemm(F, OB, DM, Wmo, DM, DM, DM, E); } } SEAM(13);
    FFN_PHASES(14, 1);
#define YS (BIG + 2048)
#define PMB (BIG + (size_t)MTOK * 4096)
#define CSTB ((float*)(BIG + (size_t)MTOK * 4096 + (size_t)16 * 1024 * 1024))
    if (IN(17)) { AP; REP(17) { cvt_matrix(F, c_w_in, 6144, DM, 6144, 0, Wmi); cvt_matrix(F, c_w_out, DM, 2048, DM, 0, Wmo); FFN_CVT(2);
        __syncthreads(); norm_phase<false>(F, out, norm_mix + 2 * DM, U, nullptr, nullptr, nullptr); ret_rot_table(F, pos, CSTB); } } SEAM(17);
    if (IN(18)) { AP; REP(18) { pg8::EpiStoreRot E{QKV, CSTB}; run_gemm(F, U, DM, Wmi, DM, 4096, DM, E); } } SEAM(18);
    if (IN(19)) { AP; REP(19) { ret_pmat(F, QKV, PMB); } } SEAM(19);
    if (IN(20)) { AP; REP(20) { ret_core(F, QKV, PMB, statC); } } SEAM(20);
    if (IN(21)) { AP; REP(21) { pg8::EpiGateC<false> E{YS, 4096, statC, c_g, nullptr}; run_gemm(F, U, DM, Wmi + (size_t)4096 * DM, DM, 2048, DM, E); } } SEAM(21);
    if (IN(22)) { AP; REP(22) { pg8::EpiResid<FUSE_NX> E{out, out, DM, U, ssqH}; run_gemm(F, YS, 4096, Wmo, 2048, DM, 2048, E); } } SEAM(22);
    FFN_PHASES(23, 2);
    if (IN(26)) { AP; REP(26) { cvt_matrix(F, d_w_in, 2048, DM, 2048, 0, Wmi);
#pragma unroll 1
            for (int blk = 0; blk < 4; ++blk) cvt_matrix(F, d_wg + (size_t)blk * 256 * 512, 512, 256, 512, 2, Wg + (size_t)blk * 512 * 256);
            cvt_matrix(F, d_w_out, DM, DM, DM, 0, Wmo); FFN_CVT(3);
        __syncthreads(); norm_phase<false>(F, out, norm_mix + 3 * DM, U, nullptr, nullptr, nullptr); } } SEAM(26);
    if (IN(27)) { AP; REP(27) { pg8::EpiStore<false> E{GX, 2048, nullptr}; run_gemm(F, U, DM, Wmi, DM, 2048, DM, E); } } SEAM(27);
    if (IN(28)) { AP; REP(28) { lru_conv(F, GX, d_cw, d_cb, XC, d_lru, sptab); } } SEAM(28);
    if (IN(29)) { AP; REP(29) { pg8::EpiLru E{XC, LA, BT, d_bg, sptab}; run_gemm(F, XC, DM, Wg, 256, 2048, 256, E, MTOK, 256); } } SEAM(29);
    if (IN(30)) { AP; REP(30) { lru_scan(F, LA, BT, GX, Y); } } SEAM(30);
    if (IN(31)) { AP; REP(31) { pg8::EpiResid<FUSE_NX> E{out, out, DM, U, ssqH}; run_gemm(F, Y, DM, Wmo, DM, DM, DM, E); } } SEAM(31);
    FFN_PHASES(32, 3);
    if (TIMING_MASK != 0ull && blockIdx.x == 0 && threadIdx.x == 0) { const unsigned long long t0_ = __builtin_amdgcn_s_memrealtime(); const unsigned long long tacc_ = TMISC[1]; while (__builtin_amdgcn_s_memrealtime() - t0_ < tacc_) __builtin_amdgcn_s_sleep(8); }
#undef IN
#undef SEAM
#undef XIN
#undef pos
#undef norm_mix
#undef norm_ffn
#undef ffn_w_in
#undef ffn_w_out
#undef out
#undef Wmi
#undef Wmo
#undef Wfi
#undef Wfo
#undef U
#undef BIG
#undef gatesA
#undef ssqA
#undef statC
#undef kmean
#undef sptab
#undef a_w_in
#undef a_b
#undef a_g
#undef a_w_out
#undef b_w_in
#undef b_gq
#undef b_gk
#undef b_w_out
#undef c_w_in
#undef c_g
#undef c_w_out
#undef d_w_in
#undef d_cw
#undef d_cb
#undef d_wg
#undef d_bg
#undef d_lru
#undef d_w_out
#undef GX
#undef XC
#undef LA
#undef BT
#undef Y
#undef Wg
#undef FFN_CVT
#undef OB
#undef CSTB
#undef PMAB
#undef GTB
#undef DENB
#undef PMB
#undef VTB
#undef FFN_PHASES
#undef QKV
#undef HO
#undef YS
#undef ssqH
}

#ifndef MK_ONE_LAUNCH
#define MK_ONE_LAUNCH 1
#endif
extern "C" void kernel_launch(void* const* d_in, const int* in_sizes, int n_in, void* d_out, int out_size, void* d_ws, size_t ws_size, hipStream_t stream) {
    static int grid = 0;
    if (grid == 0) {
        if (n_in != 24 || out_size != MTOK * DM || ws_size < WS_END) { fprintf(stderr, "kernel_launch: unexpected shapes (n_in %d, out %d, ws %zu); nothing launched\n", n_in, out_size, ws_size); grid = -1; return; }
        int dev = 0, cus = 0, per_cu = 0;
        if (hipGetDevice(&dev) != hipSuccess || hipDeviceGetAttribute(&cus, hipDeviceAttributeMultiprocessorCount, dev) != hipSuccess) { grid = -1; return; }
        if (hipFuncSetAttribute((const void*)trunk_fwd, hipFuncAttributeMaxDynamicSharedMemorySize, LDS_BYTES) != hipSuccess) { fprintf(stderr, "kernel_launch: hipFuncSetAttribute failed\n"); grid = -1; return; }
        if (hipOccupancyMaxActiveBlocksPerMultiprocessor(&per_cu, (const void*)trunk_fwd, NTHR, LDS_BYTES) != hipSuccess || per_cu < 1) { fprintf(stderr, "kernel_launch: occupancy query reports %d blocks per CU\n", per_cu); }
        (void)hipGetLastError();
        grid = cus;
    }
    if (grid < 0) return;
    (void)hipMemsetAsync((char*)d_ws + WS_CTL, 0, CTL_ZERO_BYTES, stream);
    Args a{};
    for (int i = 0; i < 24; ++i) a.in[i] = d_in[i];
    a.out = (float*)d_out; a.ws = (unsigned char*)d_ws;
#if MK_ONE_LAUNCH
    a.ph_lo = 0; a.ph_hi = NPHASE;
    hipLaunchKernelGGL(trunk_fwd, dim3(grid), dim3(NTHR), LDS_BYTES, stream, a);
#else
    for (int p = 0; p < NPHASE; ++p) { a.ph_lo = p; a.ph_hi = p + 1; hipLaunchKernelGGL(trunk_fwd, dim3(grid), dim3(NTHR), LDS_BYTES, stream, a); }
#endif
}
```

```cpp
#include <hip/hip_runtime.h>
#include <cstdio>
#include <cstdint>
#include <cmath>
namespace pg8 {
#define PG8_LAS __attribute__((address_space(3)))
typedef unsigned short bf16_t;
typedef short bf16x8 __attribute__((ext_vector_type(8)));
typedef float f32x4 __attribute__((ext_vector_type(4)));
typedef unsigned u32x4 __attribute__((ext_vector_type(4)));
constexpr int BM = 256, BK = 64, HALF = 128, HTB = HALF * BK * 2  , STAGE_BYTES = 8 * HTB, NXCD = 8, WGM = 8;

__host__ __device__ __forceinline__ int lds_byte(int r, int c) { const int st = (r >> 4) * 2 + (c >> 5), rr = r & 15, cc = c & 31, ob = rr * 64 + cc * 2; return st * 1024 + (ob ^ (((ob >> 9) & 1) << 5)); }
__host__ __device__ __forceinline__ void stage_rc(int b, int& R, int& C) { const int st = b / 1024, sb = b % 1024, swz = sb ^ (((sb >> 9) & 1) << 5); R = (st >> 1) * 16 + swz / 64; C = (st & 1) * 32 + (swz % 64) / 2; }
__host__ __device__ __forceinline__ int perm32(int rho) { const int n = rho >> 4, i = rho & 15; return 8 * (i >> 2) + 4 * n + (i & 3); }

struct Unit { int pm, pn; };
struct Gemm { const bf16_t* A; const bf16_t* Bt; int M, N, K, lda, ldb, ablk; };

struct StaticOrder {
    int nM, nN, nwg, G, c, wgm;
    __host__ __device__ void init(int M, int N, int G_, int c_, int wgm_ = WGM) { nM = M / BM; nN = N / BM; nwg = nM * nN; G = G_; c = c_; wgm = wgm_; }
    __host__ __device__ bool next(int i, Unit& u) const {
        const long L = (long)i * G + c; if (L >= nwg) return false;
        int wgid = (int)L; { const int q = nwg / NXCD, r = nwg % NXCD, xcd = wgid % NXCD, off = wgid / NXCD; wgid = (xcd < r ? xcd * (q + 1) : r * (q + 1) + (xcd - r) * q) + off; }
        const int nig = wgm * nN, gid = wgid / nig, fm = gid * wgm, gsz = (nM - fm) < wgm ? (nM - fm) : wgm;
        u.pm = fm + ((wgid % nig) % gsz); u.pn = (wgid % nig) / gsz; return true;
    }
    __device__ __forceinline__ void a_ready(const Unit&) const {}
    __device__ __forceinline__ void done(const Unit&) const {}
};

__device__ __forceinline__ unsigned cvt_pk_bf16(float lo, float hi) { unsigned r; asm volatile("v_cvt_pk_bf16_f32 %0, %1, %2" : "=v"(r) : "v"(lo), "v"(hi)); return r; }
typedef float f32x2 __attribute__((ext_vector_type(2)));

__device__ __forceinline__ float bf2f(unsigned short b) { return __uint_as_float(((unsigned)b) << 16); }
__device__ __forceinline__ float lo_bf(unsigned w) { return __uint_as_float(w << 16); }
__device__ __forceinline__ float hi_bf(unsigned w) { return __uint_as_float(w & 0xffff0000u); }
__device__ __forceinline__ float fast_sigmoid(float x) { return __builtin_amdgcn_rcpf(1.0f + __expf(-x)); }
typedef unsigned u32x2 __attribute__((ext_vector_type(2)));

__device__ __forceinline__ void row_rstd(const float* ssq, int row0, float (&rs)[2][4]) {
#pragma unroll
    for (int ai = 0; ai < 2; ++ai)
#pragma unroll
        for (int m = 0; m < 4; ++m) { const f32x4* p = (const f32x4*)(ssq + (size_t)(row0 + ai * HALF + m * 16) * 16); const f32x4 a = p[0], b = p[1], c = p[2], d = p[3];
            const float t = ((a[0] + a[1]) + (a[2] + a[3])) + ((b[0] + b[1]) + (b[2] + b[3])) + ((c[0] + c[1]) + (c[2] + c[3])) + ((d[0] + d[1]) + (d[2] + d[3]));
            rs[ai][m] = 1.0f / sqrtf(t * (1.0f / 1024.0f) + 1e-6f); }
}
template <bool RS> struct EpiStore {
    static constexpr bool PERM = true, AFTER_DRAIN = false;
    bf16_t* O; int ldc; const float* ssq;
    __device__ __forceinline__ void operator()(const f32x4 (&acc)[2][2][4][2], const Unit& u, int wr, int wc, int fr, int fq) const {
        const int row0 = u.pm * BM + wr * 64 + fr, col0 = u.pn * BM + wc * 32 + 8 * fq;
        float rs[2][4]; if (RS) row_rstd(ssq, row0, rs);
#pragma unroll
        for (int ai = 0; ai < 2; ++ai)
#pragma unroll
            for (int m = 0; m < 4; ++m) { bf16_t* rowp = O + (size_t)(row0 + ai * HALF + m * 16) * ldc + col0; const float sc = RS ? rs[ai][m] : 1.0f;
#pragma unroll
                for (int bj = 0; bj < 2; ++bj) { const f32x4 v0 = acc[ai][bj][m][0] * sc, v1 = acc[ai][bj][m][1] * sc;
                    u32x4 w; w.x = cvt_pk_bf16(v0[0], v0[1]); w.y = cvt_pk_bf16(v0[2], v0[3]); w.z = cvt_pk_bf16(v1[0], v1[1]); w.w = cvt_pk_bf16(v1[2], v1[3]);
                    *(u32x4*)(rowp + bj * HALF) = w;
#if defined(GEMM_EXP) && GEMM_EXP == 3
                    asm volatile("" ::: "memory"); *(volatile u32x4*)(rowp + bj * HALF) = w;
#endif
                } }
    }
};

struct EpiStoreRot {
    static constexpr bool PERM = true, AFTER_DRAIN = false;
    bf16_t* O; const float* cst;
    __device__ __forceinline__ void operator()(const f32x4 (&acc)[2][2][4][2], const Unit& u, int wr, int wc, int fr, int fq) const {
        const int row0 = u.pm * BM + wr * 64 + fr, col0 = u.pn * BM + wc * 32 + 8 * fq, d0 = wc * 32 + 8 * fq;
        const bool rot = u.pn < 8; const float sc = (u.pn >= 4 && u.pn < 8) ? 0.0625f : 1.0f;
#pragma unroll
        for (int ai = 0; ai < 2; ++ai)
#pragma unroll
            for (int m = 0; m < 4; ++m) { const int row = row0 + ai * HALF + m * 16; bf16_t* rowp = O + (size_t)row * 4096 + col0;
                f32x4 v[2][2];
#pragma unroll
                for (int bj = 0; bj < 2; ++bj) { v[bj][0] = acc[ai][bj][m][0]; v[bj][1] = acc[ai][bj][m][1]; }
                if (rot) { const float* cp = cst + (size_t)row * 256 + d0;
#pragma unroll
                    for (int n = 0; n < 2; ++n) { const f32x4 c = *(const f32x4*)(cp + 4 * n), sn = *(const f32x4*)(cp + 128 + 4 * n); const f32x4 x1 = v[0][n], x2 = v[1][n];
                        v[0][n] = (x1 * c - x2 * sn) * sc; v[1][n] = (x2 * c + x1 * sn) * sc; } }
#pragma unroll
                for (int bj = 0; bj < 2; ++bj) { u32x4 w; w.x = cvt_pk_bf16(v[bj][0][0], v[bj][0][1]); w.y = cvt_pk_bf16(v[bj][0][2], v[bj][0][3]); w.z = cvt_pk_bf16(v[bj][1][0], v[bj][1][1]); w.w = cvt_pk_bf16(v[bj][1][2], v[bj][1][3]);
                    *(u32x4*)(rowp + bj * HALF) = w; } }
    }
};
template <bool RS> struct EpiSwiGLU {
    static constexpr bool PERM = true, AFTER_DRAIN = false;
    bf16_t* O; int ldc; const float* ssq;
    __device__ __forceinline__ void operator()(const f32x4 (&acc)[2][2][4][2], const Unit& u, int wr, int wc, int fr, int fq) const {
        const int row0 = u.pm * BM + wr * 64 + fr, col0 = u.pn * HALF + wc * 32 + 8 * fq;
        float rs[2][4]; if (RS) row_rstd(ssq, row0, rs);
#pragma unroll
        for (int ai = 0; ai < 2; ++ai)
#pragma unroll
            for (int m = 0; m < 4; ++m) { bf16_t* rowp = O + (size_t)(row0 + ai * HALF + m * 16) * ldc + col0; const float sc = RS ? rs[ai][m] : 1.0f;
                float h[8];
#pragma unroll
                for (int n = 0; n < 2; ++n)
#pragma unroll
                    for (int j = 0; j < 4; ++j) { const float g = acc[ai][0][m][n][j] * sc, up = acc[ai][1][m][n][j] * sc;
#if defined(GEMM_EXP) && GEMM_EXP == 2
                        h[4 * n + j] = g * (0.5f * (fast_sigmoid(g) + (1.0f - fast_sigmoid(-g)))) * up;
#else
                        h[4 * n + j] = g * fast_sigmoid(g) * up;
#endif
                    }
                u32x4 w; w.x = cvt_pk_bf16(h[0], h[1]); w.y = cvt_pk_bf16(h[2], h[3]); w.z = cvt_pk_bf16(h[4], h[5]); w.w = cvt_pk_bf16(h[6], h[7]);

#if defined(NT_HIDDEN) && NT_HIDDEN
                __builtin_nontemporal_store(w, (u32x4*)rowp);
#else
                *(u32x4*)rowp = w;
#endif
                }
    }
};
template <bool NX> struct EpiResid {
    static constexpr bool PERM = false, AFTER_DRAIN = false;
    const float* base; float* out; int ldc; bf16_t* hb; float* ssq;
    __device__ __forceinline__ void operator()(const f32x4 (&acc)[2][2][4][2], const Unit& u, int wr, int wc, int fr, int fq) const {
        const int row0 = u.pm * BM + wr * 64 + fr, col0 = u.pn * BM + wc * 32 + 4 * fq;
        f32x4 rb[3][4];
#define PG8_RLOAD(g, slot) do { const size_t off_ = (size_t)(row0 + ((g) >> 2) * HALF + ((g) & 3) * 16) * ldc + col0; \
            rb[slot][0] = *(const f32x4*)(base + off_); rb[slot][1] = *(const f32x4*)(base + off_ + 16); rb[slot][2] = *(const f32x4*)(base + off_ + HALF); rb[slot][3] = *(const f32x4*)(base + off_ + HALF + 16); } while (0)
        PG8_RLOAD(0, 0); PG8_RLOAD(1, 1);
#pragma unroll
        for (int g = 0; g < 8; ++g) { const int ai = g >> 2, m = g & 3; const size_t off = (size_t)(row0 + ai * HALF + m * 16) * ldc + col0; float q = 0.f;
            if (g + 2 < 8) PG8_RLOAD(g + 2, (g + 2) % 3);
#pragma unroll
            for (int bj = 0; bj < 2; ++bj)
#pragma unroll
                for (int n = 0; n < 2; ++n) { const f32x4 o = rb[g % 3][bj * 2 + n] + acc[ai][bj][m][n]; *(f32x4*)(out + off + bj * HALF + n * 16) = o;
                    if (NX) { q += (o[0] * o[0] + o[1] * o[1]) + (o[2] * o[2] + o[3] * o[3]); u32x2 w; w.x = cvt_pk_bf16(o[0], o[1]); w.y = cvt_pk_bf16(o[2], o[3]); *(u32x2*)(hb + off + bj * HALF + n * 16) = w; } }
            if (NX) { q += __shfl_xor(q, 16); q += __shfl_xor(q, 32); if (fq == 0) ssq[(size_t)(row0 + ai * HALF + m * 16) * 16 + u.pn * 4 + wc] = q; } }
#undef PG8_RLOAD
    }
};
struct EpiGateA {
    static constexpr bool PERM = true, AFTER_DRAIN = false;
    bf16_t* Y; const float* ssq; const float* gout;
    __device__ __forceinline__ void operator()(const f32x4 (&acc)[2][2][4][2], const Unit& u, int wr, int wc, int fr, int fq) const {
        const int row0 = u.pm * BM + wr * 64 + fr, col0 = u.pn * BM + wc * 32 + 8 * fq;
        f32x4 gv[2][2];
#pragma unroll
        for (int bj = 0; bj < 2; ++bj)
#pragma unroll
            for (int n = 0; n < 2; ++n) gv[bj][n] = *(const f32x4*)(gout + col0 + bj * HALF + 4 * n);
        u32x4 hwb[2][2]; f32x4 spb[2][2];
#define PG8_GLOAD(g, slot) do { const int row_ = row0 + ((g) >> 2) * HALF + ((g) & 3) * 16; const bf16_t* rp_ = Y + (size_t)row_ * 1024 + col0; hwb[slot][0] = *(const u32x4*)rp_; hwb[slot][1] = *(const u32x4*)(rp_ + HALF); \
            spb[slot][0] = *(const f32x4*)(ssq + (size_t)row_ * 32 + u.pn * 8); spb[slot][1] = *(const f32x4*)(ssq + (size_t)row_ * 32 + u.pn * 8 + 4); } while (0)
        PG8_GLOAD(0, 0);
#pragma unroll
        for (int g = 0; g < 8; ++g) { const int ai = g >> 2, m = g & 3, sl = g & 1; const int row = row0 + ai * HALF + m * 16; bf16_t* rowp = Y + (size_t)row * 1024 + col0;
            if (g + 1 < 8) PG8_GLOAD(g + 1, (g + 1) & 1);
            const f32x4 sp = spb[sl][0], sp2 = spb[sl][1];
            const float rstd = 1.0f / sqrtf((((sp[0] + sp[1]) + (sp[2] + sp[3])) + ((sp2[0] + sp2[1]) + (sp2[2] + sp2[3]))) * (1.0f / 256.0f) + 1e-6f);
#pragma unroll
            for (int bj = 0; bj < 2; ++bj) { const u32x4 hw = hwb[sl][bj]; float o[8];
                const unsigned hh[4] = {hw.x, hw.y, hw.z, hw.w};
#pragma unroll
                for (int n = 0; n < 2; ++n)
#pragma unroll
                    for (int j = 0; j < 4; ++j) { const unsigned w = hh[2 * n + (j >> 1)]; const float hv = (j & 1) ? hi_bf(w) : lo_bf(w);
                        o[4 * n + j] = hv * rstd * gv[bj][n][j] * fast_sigmoid(acc[ai][bj][m][n][j]); }
                u32x4 w; w.x = cvt_pk_bf16(o[0], o[1]); w.y = cvt_pk_bf16(o[2], o[3]); w.z = cvt_pk_bf16(o[4], o[5]); w.w = cvt_pk_bf16(o[6], o[7]);
                *(u32x4*)(rowp + bj * HALF) = w; } }
#undef PG8_GLOAD
    }
};
template <bool RS> struct EpiGateC {
    static constexpr bool PERM = true, AFTER_DRAIN = false;
    bf16_t* Y; int ldy; const float* st; const float* gout; const float* hssq;
    __device__ __forceinline__ void operator()(const f32x4 (&acc)[2][2][4][2], const Unit& u, int wr, int wc, int fr, int fq) const {
        const int row0 = u.pm * BM + wr * 64 + fr, col0 = u.pn * BM + wc * 32 + 8 * fq, head = u.pn >> 1;
        float rs[2][4]; if (RS) row_rstd(hssq, row0, rs);
        f32x4 gv[2][2];
#pragma unroll
        for (int bj = 0; bj < 2; ++bj)
#pragma unroll
            for (int n = 0; n < 2; ++n) gv[bj][n] = *(const f32x4*)(gout + col0 + bj * HALF + 4 * n);
        u32x4 hwb[2][2]; f32x4 spb[2][2];
#define PG8_GLOAD(g, slot) do { const int row_ = row0 + ((g) >> 2) * HALF + ((g) & 3) * 16; const bf16_t* rp_ = Y + (size_t)row_ * ldy + col0; hwb[slot][0] = *(const u32x4*)rp_; hwb[slot][1] = *(const u32x4*)(rp_ + HALF); \
            spb[slot][0] = *(const f32x4*)(st + (size_t)row_ * 32 + head * 8); spb[slot][1] = *(const f32x4*)(st + (size_t)row_ * 32 + head * 8 + 4); } while (0)
        PG8_GLOAD(0, 0);
#pragma unroll
        for (int g = 0; g < 8; ++g) { const int ai = g >> 2, m = g & 3, sl = g & 1; const int row = row0 + ai * HALF + m * 16; bf16_t* rowp = Y + (size_t)row * ldy + col0;
            if (g + 1 < 8) PG8_GLOAD(g + 1, (g + 1) & 1);
            const f32x4 s0 = spb[sl][0], s1 = spb[sl][1];
            const float mu = ((s0[0] + s0[2]) + (s1[0] + s1[2])) * (1.0f / 512.0f), ex2 = ((s0[1] + s0[3]) + (s1[1] + s1[3])) * (1.0f / 512.0f);
            const float var = fmaxf(ex2 - mu * mu, 0.f), rstd = 1.0f / sqrtf(var + 1e-6f);
#pragma unroll
            for (int bj = 0; bj < 2; ++bj) { const u32x4 hw = hwb[sl][bj]; float o[8];
                const unsigned hh[4] = {hw.x, hw.y, hw.z, hw.w};
#pragma unroll
                for (int n = 0; n < 2; ++n)
#pragma unroll
                    for (int j = 0; j < 4; ++j) { const unsigned w = hh[2 * n + (j >> 1)]; const float hv = (j & 1) ? hi_bf(w) : lo_bf(w); const float a = RS ? acc[ai][bj][m][n][j] * rs[ai][m] : acc[ai][bj][m][n][j];
                        o[4 * n + j] = (hv - mu) * rstd * gv[bj][n][j] * (a * fast_sigmoid(a)); }
                u32x4 w; w.x = cvt_pk_bf16(o[0], o[1]); w.y = cvt_pk_bf16(o[2], o[3]); w.z = cvt_pk_bf16(o[4], o[5]); w.w = cvt_pk_bf16(o[6], o[7]);
                *(u32x4*)(rowp + bj * HALF) = w; } }
#undef PG8_GLOAD
    }
};
struct EpiLru {
    static constexpr bool PERM = true, AFTER_DRAIN = false;
    const bf16_t* XC; bf16_t* LA; bf16_t* BT; const float* bgall; const float* sp;
    __device__ __forceinline__ void operator()(const f32x4 (&acc)[2][2][4][2], const Unit& u, int wr, int wc, int fr, int fq) const {
        const int blk = u.pn >> 1; const float* bg = bgall + blk * 512;
        const int row0 = u.pm * BM + wr * 64 + fr, cb = (u.pn & 1) * HALF + wc * 32 + 8 * fq, ch0 = blk * 256 + cb;
        u32x4 xwb[2]; xwb[0] = *(const u32x4*)(XC + (size_t)row0 * 1024 + ch0);
#pragma unroll
        for (int g = 0; g < 8; ++g) { const int ai = g >> 2, m = g & 3; const size_t off = (size_t)(row0 + ai * HALF + m * 16) * 1024 + ch0;
                if (g + 1 < 8) xwb[(g + 1) & 1] = *(const u32x4*)(XC + (size_t)(row0 + ((g + 1) >> 2) * HALF + ((g + 1) & 3) * 16) * 1024 + ch0);
                const u32x4 xw = xwb[g & 1]; const unsigned xx[4] = {xw.x, xw.y, xw.z, xw.w};
                unsigned lw[4], bw[4];
#pragma unroll
                for (int n = 0; n < 2; ++n) { const f32x4 br = *(const f32x4*)(bg + cb + 4 * n), bi = *(const f32x4*)(bg + 256 + cb + 4 * n), spv = *(const f32x4*)(sp + ch0 + 4 * n); float la[4], bt[4];
#pragma unroll
                    for (int j = 0; j < 4; ++j) { const int q = 4 * n + j; const unsigned w = xx[q >> 1]; const float xc = (q & 1) ? hi_bf(w) : lo_bf(w);
                        const float r = fast_sigmoid(acc[ai][0][m][n][j] + br[j]), ig = fast_sigmoid(acc[ai][1][m][n][j] + bi[j]);
                        const float l = -8.0f * r * spv[j]; la[j] = l; bt[j] = sqrtf(fmaxf(1.0f - __expf(2.0f * l), 0.f)) * ig * xc; }
                    lw[2 * n] = cvt_pk_bf16(la[0], la[1]); lw[2 * n + 1] = cvt_pk_bf16(la[2], la[3]); bw[2 * n] = cvt_pk_bf16(bt[0], bt[1]); bw[2 * n + 1] = cvt_pk_bf16(bt[2], bt[3]); }
                u32x4 w; w.x = lw[0]; w.y = lw[1]; w.z = lw[2]; w.w = lw[3]; *(u32x4*)(LA + off) = w;
                w.x = bw[0]; w.y = bw[1]; w.z = bw[2]; w.w = bw[3]; *(u32x4*)(BT + off) = w; }
    }
};

template <class Epi, class Sched, bool ALIGN_EPI = false, bool SP2 = false>
__device__ __forceinline__ void gemm_phase(PG8_LAS unsigned char* lds, const Gemm g, const Sched& S, const Epi& E) {
    int tid_ = threadIdx.x; asm volatile("" : "+v"(tid_));
    const int tid = tid_, wid = __builtin_amdgcn_readfirstlane(tid >> 6), lane = tid & 63, wr = wid >> 2, wc = wid & 3, fr = lane & 15, fq = lane >> 4;
    const int K = g.K, nt = K / BK;
    unsigned voffA[2], voffB[2];
#pragma unroll
    for (int i = 0; i < 2; ++i) { int R, C; stage_rc(tid * 16 + i * 8192, R, C); const int Rb = Epi::PERM ? ((R & ~31) + perm32(R & 31)) : R;
        voffA[i] = (unsigned)(R * g.lda + C) * 2u; voffB[i] = (unsigned)(Rb * g.ldb + C) * 2u; }
    const size_t kstep = (size_t)(BK * 2);
    const size_t hstepA = (size_t)HALF * g.lda * 2, hstepB = (size_t)HALF * g.ldb * 2;
    const size_t tstepA = 2 * hstepA, tstepB = 2 * hstepB;
    const unsigned ldsw = (unsigned)wid * 1024u;
    const int aoff = lds_byte(wr * 64 + fr, fq * 8), boff = lds_byte(wc * 32 + fr, fq * 8);
#define PG8_SA(b, h) (((b) * 2 + (h)) * HTB)
#define PG8_SB(b, h) ((4 + (b) * 2 + (h)) * HTB)
#define PG8_STAGE(bufoff, gbase, voff) do { _Pragma("unroll") for (int _i = 0; _i < 2; ++_i) \
        __builtin_amdgcn_global_load_lds((const unsigned*)((const char*)(gbase) + (voff)[_i]), (PG8_LAS unsigned*)(lds + (bufoff) + ldsw + _i * 8192), 16, 0, 0); } while (0)
#define PG8_LDA(dst, b, h) do { _Pragma("unroll") for (int m = 0; m < 4; ++m) _Pragma("unroll") for (int k = 0; k < 2; ++k) dst[m][k] = *(const PG8_LAS bf16x8*)(lds + PG8_SA(b, h) + aoff + m * 2048 + k * 1024); } while (0)
#define PG8_LDB(dst, b, h) do { _Pragma("unroll") for (int n = 0; n < 2; ++n) _Pragma("unroll") for (int k = 0; k < 2; ++k) dst[n][k] = *(const PG8_LAS bf16x8*)(lds + PG8_SB(b, h) + boff + n * 2048 + k * 1024); } while (0)
#define PG8_MMA(ai, bj, At, Bt) do { __builtin_amdgcn_s_setprio(1); _Pragma("unroll") for (int m = 0; m < 4; ++m) _Pragma("unroll") for (int n = 0; n < 2; ++n) _Pragma("unroll") for (int k = 0; k < 2; ++k) \
        acc[ai][bj][m][n] = __builtin_amdgcn_mfma_f32_16x16x32_bf16(Bt[n][k], At[m][k], acc[ai][bj][m][n], 0, 0, 0); __builtin_amdgcn_s_setprio(0); } while (0)
#define PG8_WAIT_V(n) asm volatile("s_waitcnt vmcnt(" #n ")" ::: "memory")
#define PG8_WAIT_L(n) asm volatile("s_waitcnt lgkmcnt(" #n ")" ::: "memory")
#define PG8_BAR __builtin_amdgcn_s_barrier()
#define PG8_SCHED __builtin_amdgcn_sched_barrier(0)
    Unit cur, nxt; int ui = 0;
    if (!S.next(0, cur)) return;
    f32x4 acc[2][2][4][2];
#pragma unroll
    for (int a = 0; a < 2; ++a)
#pragma unroll
        for (int b = 0; b < 2; ++b)
#pragma unroll
            for (int m = 0; m < 4; ++m)
#pragma unroll
                for (int n = 0; n < 2; ++n) acc[a][b][m][n] = (f32x4){0.f, 0.f, 0.f, 0.f};
    bf16x8 At[4][2], B0[2][2], B1[2][2];
    const char* cA = (const char*)g.A + (size_t)cur.pm * tstepA + (size_t)((cur.pn >> 1) * g.ablk) * 2; const char* cB = (const char*)g.Bt + (size_t)cur.pn * tstepB;
    S.a_ready(cur);
    if constexpr (SP2) {
        PG8_STAGE(PG8_SB(0, 0), cB, voffB); PG8_STAGE(PG8_SB(0, 1), cB + hstepB, voffB); PG8_STAGE(PG8_SA(0, 0), cA, voffA); PG8_STAGE(PG8_SA(0, 1), cA + hstepA, voffA);
        if (wr == 1) PG8_BAR;
        PG8_WAIT_V(2); PG8_BAR;
        PG8_STAGE(PG8_SB(1, 0), cB + kstep, voffB); PG8_STAGE(PG8_SA(1, 0), cA + kstep, voffA); PG8_STAGE(PG8_SB(1, 1), cB + hstepB + kstep, voffB);
        PG8_WAIT_V(6); PG8_BAR;
    } else {
        PG8_STAGE(PG8_SB(0, 0), cB, voffB); PG8_STAGE(PG8_SA(0, 0), cA, voffA); PG8_STAGE(PG8_SB(0, 1), cB + hstepB, voffB); PG8_STAGE(PG8_SA(0, 1), cA + hstepA, voffA);
        if (wr == 1) PG8_BAR;
        PG8_WAIT_V(4); PG8_BAR;
        PG8_STAGE(PG8_SB(1, 0), cB + kstep, voffB); PG8_STAGE(PG8_SA(1, 0), cA + kstep, voffA); PG8_STAGE(PG8_SB(1, 1), cB + hstepB + kstep, voffB);
        PG8_WAIT_V(6); PG8_BAR;
    }
    for (;;) {
        const bool has_next = S.next(ui + 1, nxt);
        const char* nA = has_next ? (const char*)g.A + (size_t)nxt.pm * tstepA + (size_t)((nxt.pn >> 1) * g.ablk) * 2 : cA; const char* nB = has_next ? (const char*)g.Bt + (size_t)nxt.pn * tstepB : cB;
        for (int t = 0; t < nt; t += 2) {
            const bool last = (t == nt - 2);
            const char* a1 = cA + (size_t)(t + 1) * kstep;
            const char* a2 = last ? nA : cA + (size_t)(t + 2) * kstep; const char* b2 = last ? nB : cB + (size_t)(t + 2) * kstep;
            const char* a3 = a2 + kstep; const char* b3 = b2 + kstep;
            if (last && has_next) S.a_ready(nxt);
            if constexpr (SP2) {
            PG8_LDB(B0, 0, 0); PG8_LDB(B1, 0, 1); PG8_SCHED; PG8_LDA(At, 0, 0); PG8_STAGE(PG8_SA(1, 1), a1 + hstepA, voffA);
            PG8_WAIT_V(8); PG8_WAIT_L(0); PG8_BAR; PG8_MMA(0, 0, At, B0); PG8_MMA(0, 1, At, B1); PG8_BAR; PG8_SCHED;
            PG8_LDA(At, 0, 1); PG8_STAGE(PG8_SB(0, 0), b2, voffB); PG8_STAGE(PG8_SB(0, 1), b2 + hstepB, voffB); PG8_STAGE(PG8_SA(0, 0), a2, voffA);
            PG8_WAIT_V(8); PG8_WAIT_L(0); PG8_BAR; PG8_MMA(1, 0, At, B0); PG8_MMA(1, 1, At, B1); PG8_BAR; PG8_SCHED;
            PG8_LDB(B0, 1, 0); PG8_LDB(B1, 1, 1); PG8_SCHED; PG8_LDA(At, 1, 0); PG8_STAGE(PG8_SA(0, 1), a2 + hstepA, voffA);
            PG8_WAIT_V(8); PG8_WAIT_L(0); PG8_BAR; PG8_MMA(0, 0, At, B0); PG8_MMA(0, 1, At, B1); PG8_BAR; PG8_SCHED;
            PG8_LDA(At, 1, 1); PG8_STAGE(PG8_SB(1, 0), b3, voffB); PG8_STAGE(PG8_SB(1, 1), b3 + hstepB, voffB); PG8_STAGE(PG8_SA(1, 0), a3, voffA);
            PG8_WAIT_V(8); PG8_WAIT_L(0); PG8_BAR; PG8_MMA(1, 0, At, B0); PG8_MMA(1, 1, At, B1); PG8_BAR; PG8_SCHED;
            } else {
            PG8_LDB(B0, 0, 0); PG8_SCHED; PG8_LDA(At, 0, 0); PG8_STAGE(PG8_SA(1, 1), a1 + hstepA, voffA);
            PG8_WAIT_L(8); PG8_BAR; PG8_WAIT_L(0); PG8_MMA(0, 0, At, B0); PG8_BAR; PG8_SCHED;
            PG8_LDB(B1, 0, 1); PG8_STAGE(PG8_SB(0, 0), b2, voffB);
            PG8_BAR; PG8_WAIT_L(0); PG8_MMA(0, 1, At, B1); PG8_BAR;
            PG8_LDA(At, 0, 1); PG8_STAGE(PG8_SA(0, 0), a2, voffA);
            PG8_BAR; PG8_WAIT_L(0); PG8_MMA(1, 0, At, B0); PG8_BAR; PG8_SCHED;
            PG8_STAGE(PG8_SB(0, 1), b2 + hstepB, voffB);
            PG8_WAIT_V(6); PG8_BAR; PG8_MMA(1, 1, At, B1); PG8_BAR;
            PG8_LDB(B0, 1, 0); PG8_SCHED; PG8_LDA(At, 1, 0); PG8_STAGE(PG8_SA(0, 1), a2 + hstepA, voffA);
            PG8_WAIT_L(8); PG8_BAR; PG8_WAIT_L(0); PG8_MMA(0, 0, At, B0); PG8_BAR; PG8_SCHED;
            PG8_LDB(B1, 1, 1); PG8_STAGE(PG8_SB(1, 0), b3, voffB);
            PG8_BAR; PG8_WAIT_L(0); PG8_MMA(0, 1, At, B1); PG8_BAR;
            PG8_LDA(At, 1, 1); PG8_STAGE(PG8_SA(1, 0), a3, voffA);
            PG8_BAR; PG8_WAIT_L(0); PG8_MMA(1, 0, At, B0); PG8_BAR; PG8_SCHED;
            PG8_STAGE(PG8_SB(1, 1), b3 + hstepB, voffB);
            PG8_WAIT_V(6); PG8_BAR; PG8_MMA(1, 1, At, B1); PG8_BAR;
            }
        }
        if constexpr (ALIGN_EPI) { if (wr == 0) PG8_BAR; }
        if constexpr (!Epi::AFTER_DRAIN) { E(acc, cur, wr, wc, fr, fq); S.done(cur); }
        if (!has_next) break;
#pragma unroll
        for (int a = 0; a < 2; ++a)
#pragma unroll
            for (int b = 0; b < 2; ++b)
#pragma unroll
                for (int m = 0; m < 4; ++m)
#pragma unroll
                    for (int n = 0; n < 2; ++n) acc[a][b][m][n] = (f32x4){0.f, 0.f, 0.f, 0.f};
        cur = nxt; cA = nA; cB = nB; ++ui;
        if constexpr (ALIGN_EPI) { if (wr == 1) PG8_BAR; }
    }
    PG8_WAIT_V(0);
    if constexpr (!ALIGN_EPI) { if (wr == 0) PG8_BAR; }
    PG8_BAR;
    if constexpr (Epi::AFTER_DRAIN) { E.fused(acc, cur, wr, wc, fr, fq, lds, wid, lane); S.done(cur); }
#undef PG8_SA
#undef PG8_SB
#undef PG8_STAGE
#undef PG8_LDA
#undef PG8_LDB
#undef PG8_MMA
#undef PG8_WAIT_V
#undef PG8_WAIT_L
#undef PG8_BAR
#undef PG8_SCHED
}
}
#define GAS __attribute__((address_space(1)))
#define LAS __attribute__((address_space(3)))
typedef unsigned short bf16;
typedef unsigned v4u __attribute__((ext_vector_type(4)));
typedef float f32x4 __attribute__((ext_vector_type(4)));
typedef short bf16x8 __attribute__((ext_vector_type(8)));
typedef GAS unsigned gu32;
typedef GAS unsigned long long gu64;
#define RLX_AGENT __ATOMIC_RELAXED, __HIP_MEMORY_SCOPE_AGENT
#define LDS_WAIT() asm volatile("s_waitcnt lgkmcnt(0)" ::: "memory")
#define VM_WAIT() asm volatile("s_waitcnt vmcnt(0)" ::: "memory")
__device__ __forceinline__ unsigned long long rt() { return __builtin_amdgcn_s_memrealtime(); }
__device__ __forceinline__ unsigned f2bf(float f) { unsigned u = __builtin_bit_cast(unsigned, f); return (u + 0x7fffu + ((u >> 16) & 1u)) >> 16; }
__device__ __forceinline__ unsigned pk2(float lo, float hi) { return f2bf(lo) | (f2bf(hi) << 16); }

#define XB_TMO      128
#define XB_XCNT(j)  (256  + 64 * (j))
#define XB_XSUB(j)  (1280 + 64 * (j))
#define XB_XGEN(j)  (2304 + 64 * (j))
#define XB_TOP      3328
#define XB_TOPGEN   3392
#define XCD_BAR_WORDS 3456
#define XB_SPIN_CAP (1u << 18)

__device__ __forceinline__ unsigned xb_ld(unsigned* p)              { return __hip_atomic_load(p, __ATOMIC_RELAXED, __HIP_MEMORY_SCOPE_AGENT); }
__device__ __forceinline__ unsigned xb_add(unsigned* p, unsigned v) { return __hip_atomic_fetch_add(p, v, __ATOMIC_RELAXED, __HIP_MEMORY_SCOPE_AGENT); }
__device__ __forceinline__ unsigned xb_xcc_id() { return (unsigned)__builtin_amdgcn_s_getreg((3 << 11) | 20) & 0xFu; }
#define XB_SPIN(cond, bar) do { unsigned _sp = 0; while (cond) { __builtin_amdgcn_s_sleep(1); \
    if ((++_sp & 255u) == 0u) { if (xb_ld(&(bar)[XB_TMO])) break; if (_sp > XB_SPIN_CAP) { atomicAdd(&(bar)[XB_TMO], 1u); break; } } } } while (0)

struct XcdBarrier {
    unsigned* bar; unsigned x;
    volatile LAS unsigned* st;
};

__device__ __forceinline__ XcdBarrier xcd_barrier_post(unsigned* bar, volatile LAS unsigned* st) {
    XcdBarrier b; b.bar = bar; b.x = xb_xcc_id(); b.st = st;
    if (threadIdx.x == 0) (void)xb_add(&bar[XB_XCNT(b.x)], 1u);
    return b;
}
__device__ __forceinline__ void xcd_barrier_complete(unsigned* bar, unsigned x, unsigned& nloc, unsigned& nx) {
    const unsigned G = gridDim.x * gridDim.y * gridDim.z;
    unsigned sum, cnt, mine, sp = 0u;
    for (;;) {
        sum = 0u; cnt = 0u; mine = 0u;
#pragma unroll
        for (unsigned j = 0; j < 16; ++j) { const unsigned c = xb_ld(&bar[XB_XCNT(j)]); sum += c; cnt += (c > 0u) ? 1u : 0u; mine = (j == x) ? c : mine; }
        if (sum == G) break;
        __builtin_amdgcn_s_sleep(1);
        if ((++sp & 255u) == 0u) { if (xb_ld(&bar[XB_TMO])) break; if (sp > XB_SPIN_CAP) { atomicAdd(&bar[XB_TMO], 1u); break; } }
    }
    nloc = mine > 0u ? mine : 1u; nx = cnt > 0u ? cnt : 1u;
}

__device__ __forceinline__ void xcd_barrier(const XcdBarrier& b) {
    asm volatile("s_waitcnt vmcnt(0)" ::: "memory");
    __syncthreads();
    if (threadIdx.x == 0) {
        unsigned* bar = b.bar;
        __builtin_amdgcn_s_waitcnt(0);
        unsigned nloc = b.st[0], nx = b.st[1];
        if (nloc == 0u) { xcd_barrier_complete(bar, b.x, nloc, nx); b.st[0] = nloc; b.st[1] = nx; }
        const unsigned old = xb_add(&bar[XB_XSUB(b.x)], 1u);
        const unsigned gen = old / nloc;
        if (old + 1u == (gen + 1u) * nloc) {
            __builtin_amdgcn_fence(__ATOMIC_RELEASE, "agent");
            asm volatile("s_waitcnt vmcnt(0)" ::: "memory");
            const unsigned og = xb_add(&bar[XB_TOP], 1u);
            const unsigned tg = og / nx;
            if (og + 1u == (tg + 1u) * nx) xb_add(&bar[XB_TOPGEN], 1u);
            else XB_SPIN(xb_ld(&bar[XB_TOPGEN]) == tg, bar);
            __builtin_amdgcn_fence(__ATOMIC_ACQUIRE, "agent");
            xb_add(&bar[XB_XGEN(b.x)], 1u);
            asm volatile("s_waitcnt vmcnt(0)" ::: "memory");
        } else {
            XB_SPIN(xb_ld(&bar[XB_XGEN(b.x)]) == gen, bar);
            __builtin_amdgcn_fence(__ATOMIC_ACQUIRE, "agent");
            asm volatile("s_waitcnt vmcnt(0)" ::: "memory");
        }
    }
    __syncthreads();
}
namespace mattn {
typedef unsigned short bf16;
constexpr int D = 128, NW = 8, QBLK = 32, KVBLK = 64;
constexpr float SCALE = 0.088388347648318440f, THR = 8.f;
constexpr int LDQ = 3072, LDK = 3072, LDO = 1024;
constexpr size_t SHM_V = KVBLK * D * 2, SHM_K = KVBLK * D * 2, SHM_ATTN = 2 * SHM_V + 2 * SHM_K + NW * 64 * 4;
using bf16x8 = __attribute__((ext_vector_type(8))) short;
using s16x4  = __attribute__((ext_vector_type(4))) short;
using f32x16 = __attribute__((ext_vector_type(16))) float;
using u32x4  = __attribute__((ext_vector_type(4))) unsigned;
#define KSWZ(row, colB) ((row) * 256 + ((colB) ^ (((row) & 7) << 4)))
#define SBAR() __builtin_amdgcn_sched_barrier(0)
__device__ __forceinline__ int crow(int r, int hi) { return (r & 3) + 8 * (r >> 2) + 4 * hi; }
__device__ __forceinline__ unsigned cvtpk(float lo, float hi) { unsigned r; asm volatile("v_cvt_pk_bf16_f32 %0, %1, %2" : "=v"(r) : "v"(lo), "v"(hi)); return r; }
struct Msk { int j; unsigned sel; int qpos; };
__device__ __forceinline__ float sconst(unsigned bits) { return __uint_as_float((unsigned)__builtin_amdgcn_readfirstlane((int)bits)); }
__device__ __forceinline__ void partialSM(f32x16& p0, f32x16& p1, float& m_reg, float& mn, float& alpha, int tile, const Msk& mk, int hi) {
  constexpr float C = SCALE * 1.4426950408889634f;
  const int kb = tile >> 2; const bool own = (kb == mk.j), lsel = own || ((mk.sel >> kb) & 1u);
  float pmax = p0[0];
#pragma unroll
for (int r = 1; r < 16; ++r) pmax = fmaxf(pmax, p0[r]);
#pragma unroll
for (int r = 0; r < 16; ++r) pmax = fmaxf(pmax, p1[r]);
  { auto rr = __builtin_amdgcn_permlane32_swap(__float_as_uint(pmax), __float_as_uint(pmax), false, false);
    pmax = fmaxf(__uint_as_float(rr[0]), __uint_as_float(rr[1])); }
  if (!lsel) pmax = sconst(0xf149f2cau);
  if (__builtin_expect(__all(pmax - m_reg <= THR / SCALE), 1)) { mn = m_reg; alpha = 1.f; }
  else { mn = fmaxf(m_reg, pmax); alpha = __builtin_amdgcn_exp2f((m_reg - mn) * C); m_reg = mn; }
  const float mnC = lsel ? -mn * C : sconst(0xff800000u);
#pragma unroll
for (int r = 0; r < 16; ++r) p0[r] = fmaf(p0[r], C, mnC);
#pragma unroll
for (int r = 0; r < 16; ++r) p1[r] = fmaf(p1[r], C, mnC);
#pragma unroll
for (int r = 0; r < 16; ++r) p0[r] = __builtin_amdgcn_exp2f(p0[r]);
}
__device__ __forceinline__ void finishSM(f32x16& p0, f32x16& p1, float alpha, float& l_reg, bf16x8& pa0, bf16x8& pa1, bf16x8& pa2, bf16x8& pa3) {
#pragma unroll
for (int r = 0; r < 16; ++r) p1[r] = __builtin_amdgcn_exp2f(p1[r]);
  float ps = 0;
#pragma unroll
for (int r = 0; r < 16; ++r) ps += p0[r];
#pragma unroll
for (int r = 0; r < 16; ++r) ps += p1[r];
  { auto rr = __builtin_amdgcn_permlane32_swap(__float_as_uint(ps), __float_as_uint(ps), false, false);
    ps = __uint_as_float(rr[0]) + __uint_as_float(rr[1]); }
  l_reg = l_reg * alpha + ps;
#define PK4(P, BASE, OUT) do { unsigned a0 = cvtpk(P[BASE + 0], P[BASE + 1]), a1 = cvtpk(P[BASE + 2], P[BASE + 3]);   \
    unsigned b0 = cvtpk(P[BASE + 4], P[BASE + 5]), b1 = cvtpk(P[BASE + 6], P[BASE + 7]);                              \
    auto r0 = __builtin_amdgcn_permlane32_swap(a0, b0, false, false); auto r1 = __builtin_amdgcn_permlane32_swap(a1, b1, false, false); \
    u32x4 w = {r0[0], r1[0], r0[1], r1[1]}; OUT = *reinterpret_cast<bf16x8*>(&w); } while (0)
  PK4(p0, 0, pa0); PK4(p0, 8, pa1); PK4(p1, 0, pa2); PK4(p1, 8, pa3);
#undef PK4
}
__device__ __forceinline__ void qkt(f32x16& p0, f32x16& p1, const bf16* Ks, const bf16x8* qr, int r32, int hi, int tile, const Msk& mk) {
  if ((tile >> 2) == mk.j) { const float NEGB = sconst(0xf149f2cau); int qp = mk.qpos - (tile & 3) * 64; asm volatile("" : "+v"(qp));
#pragma unroll
    for (int r = 0; r < 16; ++r) { const int k0 = crow(r, hi); p0[r] = (k0 > qp) ? NEGB : 0.f; p1[r] = (k0 + 32 > qp) ? NEGB : 0.f; } }
  else { p0 = f32x16{}; p1 = f32x16{}; }
#pragma unroll
for (int d0 = 0; d0 < 8; ++d0) { int cb = (d0 * 16 + hi * 8) * 2;
    bf16x8 b0 = *reinterpret_cast<const bf16x8*>((const char*)Ks + KSWZ(r32, cb));
    bf16x8 b1 = *reinterpret_cast<const bf16x8*>((const char*)Ks + KSWZ(32 + r32, cb));
    p0 = __builtin_amdgcn_mfma_f32_32x32x16_bf16(b0, qr[d0], p0, 0, 0, 0);
    p1 = __builtin_amdgcn_mfma_f32_32x32x16_bf16(b1, qr[d0], p1, 0, 0, 0); }
}
__device__ __forceinline__ int v_st(int k, int c) { const int kk = (k & ~0xC) | ((k & 4) << 1) | ((k & 8) >> 1); return ((kk >> 3) * 4 + (c >> 5)) * 512 + ((kk & 7) * 32 + (c & 31)) * 2; }
__device__ __forceinline__ int v_rd_base(int lane) { return ((lane & 3) << 3) | (((lane >> 2) & 3) << 6) | (((lane >> 4) & 1) << 5) | (((lane >> 5) & 1) << 8); }
constexpr int v_rd_off(int d0, int ks, int half) { return d0 * 512 + ks * 4096 + half * 2048; }
template <int OFF> __device__ __forceinline__ s16x4 tr_read(int vb) { s16x4 r; asm volatile("ds_read_b64_tr_b16 %0, %1 offset:%2" : "=&v"(r) : "v"(vb), "i"(OFF) : "memory"); return r; }
template <int D0> __device__ __forceinline__ void pv_one(f32x16& od, int vb, bf16x8 pa0, bf16x8 pa1, bf16x8 pa2, bf16x8 pa3) {
  const s16x4 l0 = tr_read<v_rd_off(D0, 0, 0)>(vb), h0 = tr_read<v_rd_off(D0, 0, 1)>(vb), l1 = tr_read<v_rd_off(D0, 1, 0)>(vb), h1 = tr_read<v_rd_off(D0, 1, 1)>(vb);
  const s16x4 l2 = tr_read<v_rd_off(D0, 2, 0)>(vb), h2 = tr_read<v_rd_off(D0, 2, 1)>(vb), l3 = tr_read<v_rd_off(D0, 3, 0)>(vb), h3 = tr_read<v_rd_off(D0, 3, 1)>(vb);
  asm volatile("s_waitcnt lgkmcnt(0)" ::: "memory"); SBAR();
#define PK(L, H) (bf16x8){L[0], L[1], L[2], L[3], H[0], H[1], H[2], H[3]}
  od = __builtin_amdgcn_mfma_f32_32x32x16_bf16(pa0, PK(l0, h0), od, 0, 0, 0);
  od = __builtin_amdgcn_mfma_f32_32x32x16_bf16(pa1, PK(l1, h1), od, 0, 0, 0);
  od = __builtin_amdgcn_mfma_f32_32x32x16_bf16(pa2, PK(l2, h2), od, 0, 0, 0);
  od = __builtin_amdgcn_mfma_f32_32x32x16_bf16(pa3, PK(l3, h3), od, 0, 0, 0);
#undef PK
}
__device__ __forceinline__ void pv_d0(f32x16* o, int vb, bf16x8 pa0, bf16x8 pa1, bf16x8 pa2, bf16x8 pa3) {
  pv_one<0>(o[0], vb, pa0, pa1, pa2, pa3); pv_one<1>(o[1], vb, pa0, pa1, pa2, pa3); pv_one<2>(o[2], vb, pa0, pa1, pa2, pa3); pv_one<3>(o[3], vb, pa0, pa1, pa2, pa3);
}
__device__ __forceinline__ void body(const bf16x8 (&qr)[8], const bf16* __restrict__ Kh, const bf16* __restrict__ Vh, bf16* __restrict__ Ob, int seq, char* lds, const Msk mk) {
  int tid_ = threadIdx.x; asm volatile("" : "+v"(tid_));
  const int tid = tid_, wid = tid >> 6, lane = tid & 63, r32 = lane & 31, hi = lane >> 5;
  bf16* V_lds = (bf16*)lds; bf16* K_lds = (bf16*)(lds + 2 * SHM_V);
  float* ws = (float*)(lds + 2 * SHM_V + 2 * SHM_K) + wid * 64; float* li_l = ws; float* al_l = ws + 32;
  float m_reg = -1e30f, l_reg = 0; f32x16 o[4] = {};
#define VB0() ({ int l2_ = lane; asm volatile("" : "+v"(l2_)); (int)(uintptr_t)V_lds + v_rd_base(l2_); })
  struct { bf16x8 vs0, vs1, ks0, ks1; } sr_[1];
#define STG_IDX() int t2_ = tid; asm volatile("" : "+v"(t2_)); const int sr = t2_ >> 4, sc = (t2_ & 15) * 8
#define SLOAD(i, k0) do { STG_IDX(); const unsigned goff0 = (unsigned)((sr * LDK + sc) * 2), goff1 = (unsigned)(((32 + sr) * LDK + sc) * 2); \
    const char* vb_ = (const char*)(Vh + (long)(k0) * LDK); const char* kb_ = (const char*)(Kh + (long)(k0) * LDK); \
    sr_[i].vs0 = *(const bf16x8*)(vb_ + goff0); sr_[i].vs1 = *(const bf16x8*)(vb_ + goff1); sr_[i].ks0 = *(const bf16x8*)(kb_ + goff0); sr_[i].ks1 = *(const bf16x8*)(kb_ + goff1); } while (0)
#define SWRITE(b, i) do { STG_IDX(); const int vst0 = v_st(sr, sc), vst1 = v_st(32 + sr, sc); *(bf16x8*)((char*)V_lds + (b) * SHM_V + vst0) = sr_[i].vs0; *(bf16x8*)((char*)V_lds + (b) * SHM_V + vst1) = sr_[i].vs1; int kc = sc * 2; \
    *(bf16x8*)((char*)K_lds + (b) * SHM_K + KSWZ(sr, kc)) = sr_[i].ks0; *(bf16x8*)((char*)K_lds + (b) * SHM_K + KSWZ(32 + sr, kc)) = sr_[i].ks1; } while (0)
#define SWAIT() asm volatile("s_waitcnt vmcnt(0)" ::: "memory")
#define RESC(a) do { if (__any((a) < 1.f)) { if (hi == 0) al_l[r32] = (a); asm volatile("s_waitcnt lgkmcnt(0)" ::: "memory"); \
    _Pragma("unroll") for (int d = 0; d < 4; ++d) _Pragma("unroll") for (int r = 0; r < 16; ++r) o[d][r] *= al_l[crow(r, hi)]; } } while (0)
  f32x16 pA0, pA1, pB0, pB1; float mnA, mnB, alA, alB; bf16x8 pa0, pa1, pa2, pa3; const int NT = seq / KVBLK;
  constexpr int SE = 0, SO = 0;
  SLOAD(SE, 0); asm volatile("s_waitcnt vmcnt(0)" ::: "memory"); SWRITE(0, SE); __syncthreads();
  qkt(pA0, pA1, K_lds, qr, r32, hi, 0, mk); partialSM(pA0, pA1, m_reg, mnA, alA, 0, mk, hi);
  SLOAD(SO, KVBLK);
  SWAIT(); SWRITE(1, SO); __syncthreads();
#pragma unroll 1
  for (int j = 1; j + 1 < NT; j += 2) {
    SBAR(); qkt(pB0, pB1, (bf16*)((char*)K_lds + SHM_K), qr, r32, hi, j, mk);
    finishSM(pA0, pA1, alA, l_reg, pa0, pa1, pa2, pa3); SBAR();
    SLOAD(SO, (j + 1) * KVBLK); SBAR();
    pv_d0(o, VB0(), pa0, pa1, pa2, pa3); partialSM(pB0, pB1, m_reg, mnB, alB, j, mk, hi);
    __syncthreads(); SWAIT(); SWRITE(0, SE);
    RESC(alB); __syncthreads();
    SBAR(); qkt(pA0, pA1, K_lds, qr, r32, hi, j + 1, mk);
    finishSM(pB0, pB1, alB, l_reg, pa0, pa1, pa2, pa3); SBAR();
    SLOAD(SE, (j + 2) * KVBLK); SBAR();
    pv_d0(o, VB0() + (int)SHM_V, pa0, pa1, pa2, pa3); partialSM(pA0, pA1, m_reg, mnA, alA, j + 1, mk, hi);
    __syncthreads(); SWAIT(); SWRITE(1, SO);
    RESC(alA); __syncthreads();
  }
  SBAR(); qkt(pB0, pB1, (bf16*)((char*)K_lds + SHM_K), qr, r32, hi, NT - 1, mk);
  finishSM(pA0, pA1, alA, l_reg, pa0, pa1, pa2, pa3); SBAR();
  pv_d0(o, VB0(), pa0, pa1, pa2, pa3); partialSM(pB0, pB1, m_reg, mnB, alB, NT - 1, mk, hi);
  __syncthreads(); RESC(alB);
  finishSM(pB0, pB1, alB, l_reg, pa0, pa1, pa2, pa3); SBAR();
  pv_d0(o, VB0() + (int)SHM_V, pa0, pa1, pa2, pa3);
  if (hi == 0) li_l[r32] = l_reg; asm volatile("s_waitcnt lgkmcnt(0)" ::: "memory");
  float rli[16];
#pragma unroll
for (int r = 0; r < 16; ++r) rli[r] = __builtin_amdgcn_rcpf(li_l[crow(r, hi)]);
  bf16* Ow = Ob + (long)(wid * QBLK) * LDO;
#pragma unroll
for (int r = 0; r < 16; ++r) { int orow = crow(r, hi);
#pragma unroll
for (int d0 = 0; d0 < 4; ++d0) { const float v = o[d0][r] * rli[r]; unsigned u = __float_as_uint(v); u = (u + 0x7fffu + ((u >> 16) & 1u)) >> 16; Ow[(long)orow * LDO + d0 * 32 + r32] = (bf16)u; } }
#undef SLOAD
#undef VB0
#undef STG_IDX
#undef SWRITE
#undef SWAIT
#undef RESC
}
#undef KSWZ
#undef SBAR
}


constexpr int NWAVES = 8, NTHR = 512;
constexpr int MTOK = 32768, DM = 1024, SEQ = 2048, NB = 16, DFF = 2816;
constexpr size_t MiB = 1u << 20;
constexpr size_t WS_CTL = 0, CTL_ZERO_BYTES = 64 * 1024;
constexpr size_t WS_W_MIXIN = 1 * MiB, WS_W_MIXOUT = 13 * MiB, WS_W_FFNIN = 17 * MiB, WS_W_FFNOUT = 28 * MiB;
constexpr size_t WS_GATESA = 34 * MiB, WS_SSQA = 35 * MiB, WS_STATC = 492 * MiB, WS_KMEAN = 41 * MiB, WS_SSQH = 42 * MiB, WS_SPTAB = 33 * MiB + 512 * 1024;
constexpr size_t WS_U = 44 * MiB, WS_BIG = 108 * MiB, WS_END = 500 * MiB;
constexpr int CW_BAR = 1024;
static_assert((CW_BAR + 3456) * 4 <= (int)CTL_ZERO_BYTES, "ctl");
constexpr int LDS_BYTES = 163840, MISC_OFF = 163584;

typedef unsigned u32x4 __attribute__((ext_vector_type(4)));
typedef unsigned u32x2 __attribute__((ext_vector_type(2)));
typedef float f32x2 __attribute__((ext_vector_type(2)));
struct Frame { LAS unsigned char* lds; int tid, lane, wave, G; };
struct Args { const void* in[24]; float* out; unsigned char* ws; int ph_lo, ph_hi; };

__device__ __forceinline__ float wave_sum(float v) {
#pragma unroll
    for (int o = 1; o < 64; o <<= 1) v += __shfl_xor(v, o);
    return v;
}
__device__ __forceinline__ float bf2f(bf16 b) { return __uint_as_float(((unsigned)b) << 16); }
__device__ __forceinline__ float lo_bf(unsigned w) { return __uint_as_float(w << 16); }
__device__ __forceinline__ float hi_bf(unsigned w) { return __uint_as_float(w & 0xffff0000u); }
__device__ __forceinline__ unsigned cvtpk(float lo, float hi) { return pg8::cvt_pk_bf16(lo, hi); }

typedef short v4s16 __attribute__((ext_vector_type(4)));
template <int LD> __device__ __forceinline__ bf16x8 tr_frag(const LAS bf16* T, int r0, int c0, int lane) {
    const int fr = lane & 15, fq = lane >> 4;
    const LAS bf16* a = T + (r0 + 8 * fq + (fr >> 2)) * LD + c0 + 4 * (fr & 3);
    const v4s16 lo = __builtin_amdgcn_ds_read_tr16_b64_v4i16((LAS v4s16*)a);
    const v4s16 hi = __builtin_amdgcn_ds_read_tr16_b64_v4i16((LAS v4s16*)(a + 4 * LD));
    return __builtin_shufflevector(lo, hi, 0, 1, 2, 3, 4, 5, 6, 7);
}
template <int MT, int NT, int K, int LDA, int LDB, bool TA = false, bool TB = false, bool SB = true>
__device__ __forceinline__ void wgemm(f32x4 (&acc)[MT][NT], const LAS bf16* A, const LAS bf16* Bt, int lane) {
    const int fr = lane & 15, fq = lane >> 4;
    const LAS bf16* ap = A + fr * LDA + 8 * fq;
    const LAS bf16* bp = Bt + fr * LDB + 8 * fq;
#pragma unroll
    for (int k0 = 0; k0 < K; k0 += 32) {
        bf16x8 a[MT], b[NT];
#pragma unroll
        for (int i = 0; i < MT; ++i) a[i] = TA ? tr_frag<LDA>(A, k0, 16 * i, lane) : *(const LAS bf16x8*)(ap + 16 * i * LDA + k0);
#pragma unroll
        for (int j = 0; j < NT; ++j) b[j] = TB ? tr_frag<LDB>(Bt, k0, 16 * j, lane) : *(const LAS bf16x8*)(bp + 16 * j * LDB + k0);
#pragma unroll
        for (int i = 0; i < MT; ++i)
#pragma unroll
            for (int j = 0; j < NT; ++j) acc[i][j] = __builtin_amdgcn_mfma_f32_16x16x32_bf16(a[i], b[j], acc[i][j], 0, 0, 0);
        if (SB && MT * NT >= 4) __builtin_amdgcn_sched_barrier(0);
    }
    if (!SB) __builtin_amdgcn_sched_barrier(0);
}

__device__ __forceinline__ int cvt_src_col(int mode, int g0) {
    if (mode == 0) return g0;
    const int pn = g0 >> 8, r = g0 & 255;
    if (mode == 1) return r < 128 ? 128 * pn + r : DFF + 128 * pn + (r - 128);
    return r < 128 ? 128 * pn + r : 256 + 128 * pn + (r - 128);
}
__device__ __forceinline__ void cvt_matrix(Frame& F, const float* W, int ldw, int K, int Np, int mode, bf16* WT, const float* gain = nullptr) {
    LAS float* scr = (LAS float*)(F.lds + F.wave * 16384);
    const int gw = blockIdx.x * NWAVES + F.wave, NGW = F.G * NWAVES, lane = F.lane;
    const int nblk = Np / 32, nitems = (K / 64) * nblk;
    float v[32], vn[32];
#define CVT_LOAD(dst, it) do { const int kb_ = (it) / nblk, nb_ = (it) % nblk, s0_ = cvt_src_col(mode, 32 * nb_); const float* wp_ = W + (size_t)(64 * kb_ + (lane >> 5)) * ldw + s0_ + (lane & 31); \
        _Pragma("unroll") for (int i = 0; i < 32; ++i) dst[i] = wp_[(size_t)(2 * i) * ldw]; } while (0)
    int item = gw;
    if (item < nitems) CVT_LOAD(v, item);
    for (; item < nitems; item += NGW) {
        const int kb = item / nblk, nb = item % nblk, k0 = 64 * kb, n0 = 32 * nb;
        if (item + NGW < nitems) CVT_LOAD(vn, item + NGW);
        if (gain) {
#pragma unroll
            for (int i = 0; i < 32; ++i) v[i] *= gain[k0 + 2 * i + (lane >> 5)]; }
#pragma unroll
        for (int i = 0; i < 32; ++i) scr[(2 * i + (lane >> 5)) * 33 + (lane & 31)] = v[i];
        LDS_WAIT(); asm volatile("" ::: "memory");
        const int c = lane & 7;
#pragma unroll
        for (int j = 0; j < 4; ++j) { const int n = (lane >> 3) + 8 * j; const LAS float* sp = scr + (8 * c) * 33 + n;
            v4u o; o.x = pk2(sp[0 * 33], sp[1 * 33]); o.y = pk2(sp[2 * 33], sp[3 * 33]); o.z = pk2(sp[4 * 33], sp[5 * 33]); o.w = pk2(sp[6 * 33], sp[7 * 33]);
            *(v4u*)(WT + (size_t)(n0 + n) * K + k0 + 8 * c) = o; }
        LDS_WAIT(); asm volatile("" ::: "memory");
#pragma unroll
        for (int i = 0; i < 32; ++i) v[i] = vn[i];
    }
#undef CVT_LOAD
}

template <bool GATES>
__device__ __forceinline__ void norm_phase(Frame& F, const float* src, const float* gain, bf16* dst, const float* wA, const float* bA, float* gout) {
    LAS float* wg = (LAS float*)F.lds;
    if (GATES) {
        for (int i = F.tid; i < 1024 * 8; i += NTHR) wg[i] = wA[(size_t)(i >> 3) * 3080 + 3072 + (i & 7)];
        __syncthreads();
    }
    const int gw = blockIdx.x * NWAVES + F.wave, NGW = F.G * NWAVES, lane = F.lane;
    f32x4 g[4];
#pragma unroll
    for (int j = 0; j < 4; ++j) g[j] = ((const f32x4*)gain)[lane + 64 * j];
    for (int m = gw; m < MTOK; m += NGW) {
        const f32x4* xr = (const f32x4*)(src + (size_t)m * DM) + lane;
        f32x4 v[4]; float s = 0.f;
#pragma unroll
        for (int j = 0; j < 4; ++j) { v[j] = xr[64 * j]; s += (v[j].x * v[j].x + v[j].y * v[j].y) + (v[j].z * v[j].z + v[j].w * v[j].w); }
        const float rstd = 1.0f / sqrtf(wave_sum(s) * (1.0f / DM) + 1e-6f);
        unsigned long long* o8 = (unsigned long long*)(dst + (size_t)m * DM) + lane;
#pragma unroll
        for (int j = 0; j < 4; ++j) { v[j] = v[j] * rstd * g[j];
            o8[64 * j] = (unsigned long long)cvtpk(v[j].x, v[j].y) | ((unsigned long long)cvtpk(v[j].z, v[j].w) << 32); }
        if (GATES) {
            float a[8];
#pragma unroll
            for (int q = 0; q < 8; ++q) a[q] = 0.f;
#pragma unroll
            for (int j = 0; j < 4; ++j)
#pragma unroll
                for (int e = 0; e < 4; ++e) { const int k = 4 * lane + 256 * j + e; const f32x4 w0 = *(const LAS f32x4*)(wg + k * 8), w1 = *(const LAS f32x4*)(wg + k * 8 + 4); const float x = v[j][e];
                    a[0] += x * w0.x; a[1] += x * w0.y; a[2] += x * w0.z; a[3] += x * w0.w; a[4] += x * w1.x; a[5] += x * w1.y; a[6] += x * w1.z; a[7] += x * w1.w; }
#pragma unroll
            for (int q = 0; q < 8; ++q) a[q] = wave_sum(a[q]);
            if (lane == 0) {
#pragma unroll
                for (int q = 0; q < 8; ++q) gout[(size_t)m * 8 + q] = a[q] + bA[q]; }
        }
    }
}

__device__ __forceinline__ void mlstm_pre(Frame& F, const float* gates, float* GT) {
    LAS float* sA = (LAS float*)F.lds, *sPM = sA + 2048, *sBC = sPM + 2048, *sBT = sBC + 2048, *sP63 = sBT + 32, *sM = sP63 + 32;
    const int lane = F.lane, w = F.wave;
    for (int item = blockIdx.x; item < 64; item += F.G) {
        const int b = item >> 2, h = item & 3;
        __syncthreads();
        float gi4[4], gf4[4];
#pragma unroll
        for (int i = 0; i < 4; ++i) { const size_t row = (size_t)b * SEQ + (w + 8 * i) * 64 + lane; gi4[i] = gates[row * 8 + h]; gf4[i] = gates[row * 8 + 4 + h]; }
#pragma unroll
        for (int i = 0; i < 4; ++i) { const int c = w + 8 * i;
            const float gi = gi4[i], gf = gf4[i];
            const float fc = fminf(gf, 0.f) - log1pf(__expf(-fabsf(gf)));
            float bc = fc;
#pragma unroll
            for (int o = 1; o < 64; o <<= 1) { const float t = __shfl_up(bc, o); if (lane >= o) bc += t; }
            const float a = gi - bc; float pm = a;
#pragma unroll
            for (int o = 1; o < 64; o <<= 1) { const float t = __shfl_up(pm, o); if (lane >= o) pm = fmaxf(pm, t); }
            sA[c * 64 + lane] = a; sPM[c * 64 + lane] = pm; sBC[c * 64 + lane] = bc; if (lane == 63) { sBT[c] = bc; sP63[c] = pm; } }
        __syncthreads();
        if (F.tid == 0) { float m = 0.f; for (int c = 0; c < 32; ++c) { sM[c] = m; m = sBT[c] + fmaxf(m, sP63[c]); } }
        __syncthreads();
#pragma unroll
        for (int i = 0; i < 4; ++i) { const int c = w + 8 * i; const float mst = sM[c], Mx = fmaxf(mst, sPM[c * 64 + lane]), Mx63 = fmaxf(mst, sP63[c]);
            float* g = GT + ((size_t)(item * 32 + c)) * 320 + lane;
            g[0] = sA[c * 64 + lane]; g[64] = Mx; g[128] = __expf(mst - Mx); g[192] = __expf(-(sBC[c * 64 + lane] + Mx)); g[256] = __expf(sA[c * 64 + lane] - Mx63); }
    }
}
__device__ __forceinline__ void mlstm_pmat(Frame& F, const bf16* QKV, const float* GT, bf16* PMA, float* DENP) {
    constexpr float SCALE = 0.08838834764831845f;
    LAS bf16* Qs = (LAS bf16*)F.lds;
    LAS bf16* Ks = Qs + 64 * 136;
    LAS bf16* Ps = Ks + 64 * 136;
    LAS float* fA = (LAS float*)(Ps + 64 * 72), *fMX = fA + 64;
    const int tid = F.tid, lane = F.lane, w = F.wave, fr = lane & 15, fq = lane >> 4, wh = w >> 1, wl = w & 1;
    const unsigned qoff0 = (unsigned)((((tid >> 4) * 2048) + (tid & 15) * 8) * 2);
    v4u pQ[2], pK[2]; float pg = 0.f;
    int item = blockIdx.x;
    if (item < 2048) { const int bh = item >> 5, c = item & 31; const char* gq = (const char*)(QKV + ((size_t)(bh >> 2) * SEQ + c * 64) * 2048 + (bh & 3) * 128);
#pragma unroll
        for (int i = 0; i < 2; ++i) { pQ[i] = *(const v4u*)(gq + qoff0 + i * (32 * 2048 * 2)); pK[i] = *(const v4u*)(gq + qoff0 + i * (32 * 2048 * 2) + 1024); }
        if (tid < 128) pg = GT[(size_t)item * 320 + tid]; }
    for (; item < 2048; item += F.G) {
        __syncthreads();
#pragma unroll
        for (int i = 0; i < 2; ++i) { const int id = tid + NTHR * i, row = id >> 4, c8 = id & 15; *(LAS v4u*)(Qs + row * 136 + c8 * 8) = pQ[i]; *(LAS v4u*)(Ks + row * 136 + c8 * 8) = pK[i]; }
        if (tid < 128) fA[tid] = pg;
        const int nit = item + F.G;
        if (nit < 2048) { const int bh = nit >> 5, c = nit & 31; const char* gq = (const char*)(QKV + ((size_t)(bh >> 2) * SEQ + c * 64) * 2048 + (bh & 3) * 128);
#pragma unroll
            for (int i = 0; i < 2; ++i) { pQ[i] = *(const v4u*)(gq + qoff0 + i * (32 * 2048 * 2)); pK[i] = *(const v4u*)(gq + qoff0 + i * (32 * 2048 * 2) + 1024); }
            if (tid < 128) pg = GT[(size_t)nit * 320 + tid]; }
        __syncthreads();
        f32x4 sa[1][2]; sa[0][0] = (f32x4){0.f, 0.f, 0.f, 0.f}; sa[0][1] = sa[0][0];
        wgemm<1, 2, 128, 136, 136>(sa, Qs + 16 * wh * 136, Ks + 32 * wl * 136, lane);
        float rs[4] = {0.f, 0.f, 0.f, 0.f};
#pragma unroll
        for (int e = 0; e < 4; ++e) { const int t = 16 * wh + 4 * fq + e; const float mx = fMX[t];
#pragma unroll
            for (int j = 0; j < 2; ++j) { const int sidx = 32 * wl + 16 * j + fr; const float wgt = (sidx <= t) ? SCALE * __expf(fA[sidx] - mx) : 0.f; const float p = sa[0][j][e] * wgt;
                Ps[t * 72 + sidx] = (bf16)f2bf(p); rs[e] += p; } }
#pragma unroll
        for (int e = 0; e < 4; ++e) { float r = rs[e]; r += __shfl_xor(r, 1); r += __shfl_xor(r, 2); r += __shfl_xor(r, 4); r += __shfl_xor(r, 8); if (fr == 0) DENP[(size_t)item * 128 + wl * 64 + 16 * wh + 4 * fq + e] = r; }
        __syncthreads();
        *(v4u*)(PMA + (size_t)item * 4096 + (tid >> 3) * 64 + (tid & 7) * 8) = *(const LAS v4u*)(Ps + (tid >> 3) * 72 + (tid & 7) * 8);
    }
}
__device__ __forceinline__ void mlstm_core(Frame& F, const bf16* QKV, const float* GT, const bf16* PMA, const float* DENP, bf16* hout, float* ssq) {
    constexpr float SCALE = 0.08838834764831845f;
    LAS bf16* Qs = (LAS bf16*)F.lds;
    LAS bf16* Ks = Qs + 64 * 136;
    LAS bf16* Vs = Ks + 64 * 136;
    LAS bf16* VWs = Vs + 64 * 88;
    LAS bf16* Cb = VWs + 64 * 88;
    LAS bf16* Ps = Cb + 80 * 136;
    LAS bf16* Hs = Ps + 64 * 72;
    const int tid = F.tid, lane = F.lane, w = F.wave, fr = lane & 15, fq = lane >> 4, wh = w >> 1, wl = w & 1;
    const unsigned qoff0 = (unsigned)((((tid >> 4) * 2048) + (tid & 15) * 8) * 2), voff0 = (unsigned)((((tid >> 3) * 2048) + (tid & 7) * 8) * 2);
    for (int item = blockIdx.x; item < 256; item += F.G) {
        const int b = item >> 4, h = (item >> 2) & 3, vs = item & 3, bh = b * 4 + h;
        f32x4 Cacc[1][4], Cn[1][1];
#pragma unroll
        for (int j = 0; j < 4; ++j) Cacc[0][j] = (f32x4){0.f, 0.f, 0.f, 0.f};
        Cn[0][0] = (f32x4){0.f, 0.f, 0.f, 0.f};
        const size_t tb = (size_t)b * SEQ;
        v4u pQ[2], pK[2], pV, pP; float pws, pwc, pwi[4], pem[4], pdn[4];
#define MLSTM_FETCH(cc) do { const size_t t0_ = tb + (size_t)(cc) * 64; const char* gq_ = (const char*)(QKV + t0_ * 2048 + h * 128); const char* gv_ = (const char*)(QKV + t0_ * 2048 + 1024 + h * 256 + vs * 64); \
            _Pragma("unroll") for (int i = 0; i < 2; ++i) { pQ[i] = *(const v4u*)(gq_ + qoff0 + i * (32 * 2048 * 2)); pK[i] = *(const v4u*)(gq_ + qoff0 + i * (32 * 2048 * 2) + 1024); } \
            pV = *(const v4u*)(gv_ + voff0); const size_t it_ = (size_t)(bh * 32 + (cc)); pP = *(const v4u*)(PMA + it_ * 4096 + (tid >> 3) * 64 + (tid & 7) * 8); \
            const float* g_ = GT + it_ * 320; pws = g_[256 + (tid >> 3)]; pwc = g_[128 + 63]; \
            _Pragma("unroll") for (int e = 0; e < 4; ++e) { const int t_ = 16 * wh + 4 * fq + e; pwi[e] = g_[128 + t_]; pem[e] = g_[192 + t_]; pdn[e] = DENP[it_ * 128 + t_] + DENP[it_ * 128 + 64 + t_]; } } while (0)
        MLSTM_FETCH(0);
        for (int c = 0; c < 32; ++c) {
            const size_t t0 = tb + c * 64;
            __syncthreads();
            v4u hprev; if (c > 0) hprev = *(const LAS v4u*)(Hs + (tid >> 3) * 72 + (tid & 7) * 8);
#pragma unroll
            for (int j = 0; j < 4; ++j)
#pragma unroll
                for (int e = 0; e < 4; ++e) Cb[(16 * wh + 4 * fq + e) * 136 + 64 * wl + 16 * j + fr] = (bf16)f2bf(Cacc[0][j][e]);
#pragma unroll
            for (int e = 0; e < 4; ++e) Cb[(64 + 4 * fq + e) * 136 + 16 * w + fr] = (bf16)f2bf(Cn[0][0][e]);
#pragma unroll
            for (int i = 0; i < 2; ++i) { const int id = tid + NTHR * i, row = id >> 4, c8 = id & 15; *(LAS v4u*)(Qs + row * 136 + c8 * 8) = pQ[i]; *(LAS v4u*)(Ks + row * 136 + c8 * 8) = pK[i]; }
            { const int srow = tid >> 3, c8 = tid & 7; const float wsv = pws;
                *(LAS v4u*)(Vs + srow * 88 + c8 * 8) = pV;
                v4u o; o.x = cvtpk(lo_bf(pV.x) * wsv, hi_bf(pV.x) * wsv); o.y = cvtpk(lo_bf(pV.y) * wsv, hi_bf(pV.y) * wsv); o.z = cvtpk(lo_bf(pV.z) * wsv, hi_bf(pV.z) * wsv); o.w = cvtpk(lo_bf(pV.w) * wsv, hi_bf(pV.w) * wsv);
                *(LAS v4u*)(VWs + srow * 88 + c8 * 8) = o;
                if (c8 < 2) { v4u one; one.x = c8 == 0 ? 0x3f80u : 0u; one.y = 0u; one.z = 0u; one.w = 0u; *(LAS v4u*)(Vs + srow * 88 + 64 + c8 * 8) = one;
                    v4u wv; wv.x = c8 == 0 ? (cvtpk(wsv, 0.f) & 0xffffu) : 0u; wv.y = 0u; wv.z = 0u; wv.w = 0u; *(LAS v4u*)(VWs + srow * 88 + 64 + c8 * 8) = wv; }
                *(LAS v4u*)(Ps + srow * 72 + c8 * 8) = pP; }
            float wi[4], em[4], dn[4]; const float wc = pwc;
#pragma unroll
            for (int e = 0; e < 4; ++e) { wi[e] = pwi[e]; em[e] = pem[e]; dn[e] = pdn[e]; }
            if (c < 31) MLSTM_FETCH(c + 1);
            if (c > 0) *(v4u*)(hout + (t0 - 64 + (tid >> 3)) * 1024 + h * 256 + vs * 64 + (tid & 7) * 8) = hprev;
            __syncthreads();
            f32x4 ni[1][2], nx[1][2], nq[1][1]; ni[0][0] = (f32x4){0.f, 0.f, 0.f, 0.f}; ni[0][1] = ni[0][0]; nx[0][0] = ni[0][0]; nx[0][1] = ni[0][0]; nq[0][0] = ni[0][0];
            wgemm<1, 2, 64, 72, 88, false, true>(ni, Ps + 16 * wh * 72, Vs + 32 * wl, lane);
            wgemm<1, 2, 128, 136, 136>(nx, Qs + 16 * wh * 136, Cb + 32 * wl * 136, lane);
            wgemm<1, 1, 128, 136, 136>(nq, Qs + 16 * wh * 136, Cb + 64 * 136, lane);
#pragma unroll
            for (int e = 0; e < 4; ++e) { const int t = 16 * wh + 4 * fq + e;
                const float nqt = __shfl(nq[0][0][e], lane & 48);
                const float den = dn[e] + wi[e] * SCALE * nqt; const float inv = 1.0f / fmaxf(fabsf(den), em[e]); float q2 = 0.f;
#pragma unroll
                for (int j = 0; j < 2; ++j) { const float hv = (ni[0][j][e] + SCALE * wi[e] * nx[0][j][e]) * inv; q2 += hv * hv;
                    Hs[t * 72 + 32 * wl + 16 * j + fr] = (bf16)f2bf(hv); }
                q2 += __shfl_xor(q2, 1); q2 += __shfl_xor(q2, 2); q2 += __shfl_xor(q2, 4); q2 += __shfl_xor(q2, 8);
                if (fr == 0) ssq[(t0 + t) * 32 + (h * 4 + vs) * 2 + wl] = q2; }
#pragma unroll
            for (int j = 0; j < 4; ++j) Cacc[0][j] = Cacc[0][j] * wc;
            Cn[0][0] = Cn[0][0] * wc;
            wgemm<1, 4, 64, 88, 136, true, true>(Cacc, VWs + 16 * wh, Ks + 64 * wl, lane);
            wgemm<1, 1, 64, 88, 136, true, true>(Cn, VWs + 64, Ks + 16 * w, lane);
        }
        __syncthreads();
        *(v4u*)(hout + (tb + 31 * 64 + (tid >> 3)) * 1024 + h * 256 + vs * 64 + (tid & 7) * 8) = *(const LAS v4u*)(Hs + (tid >> 3) * 72 + (tid & 7) * 8);
#undef MLSTM_FETCH
    }
}

__device__ __forceinline__ void moba_prep(Frame& F, bf16* QK, const int* pos, const float* gq, const float* gk, float* kpart) {
    LAS float* part = (LAS float*)F.lds;
    const int lane = F.lane, w = F.wave, c = lane & 15;
    float gqv[8], gkv[8], inv[8];
#pragma unroll
    for (int e = 0; e < 8; ++e) { gqv[e] = gq[c * 8 + e]; gkv[e] = gk[c * 8 + e]; inv[e] = exp2f(-(float)(8 * (c & 1) + e) * (18.931568569324174f / 16.0f)); }
    for (int item = blockIdx.x; item < 256; item += F.G) {
        const int b = item >> 4, blk = (item >> 1) & 7, half = item & 1;
        const size_t row0 = (size_t)b * SEQ + blk * 256 + half * 128 + 16 * w;
        float kacc[2][8];
#pragma unroll
        for (int i = 0; i < 2; ++i)
#pragma unroll
            for (int e = 0; e < 8; ++e) kacc[i][e] = 0.f;
        v4u cur[4], nxt[4];
#pragma unroll
        for (int i4 = 0; i4 < 4; ++i4) cur[i4] = *(const v4u*)(QK + row0 * 3072 + (lane + 64 * i4) * 8);
        for (int t = 0; t < 16; ++t) {
            const size_t row = row0 + t;
            if (t < 15) {
#pragma unroll
                for (int i4 = 0; i4 < 4; ++i4) nxt[i4] = *(const v4u*)(QK + (row + 1) * 3072 + (lane + 64 * i4) * 8); }
            float cs[8], sn[8];
            if (c < 4) { const float ps = (float)pos[row];
#pragma unroll
                for (int e = 0; e < 8; ++e) sincosf(ps * inv[e], &sn[e], &cs[e]); }
            else {
#pragma unroll
                for (int e = 0; e < 8; ++e) { cs[e] = 1.f; sn[e] = 0.f; } }
#pragma unroll
            for (int i4 = 0; i4 < 4; ++i4) {
                const unsigned xw[4] = {cur[i4].x, cur[i4].y, cur[i4].z, cur[i4].w}; float y[8]; float ss = 0.f;
#pragma unroll
                for (int e = 0; e < 4; ++e) { y[2 * e] = lo_bf(xw[e]); y[2 * e + 1] = hi_bf(xw[e]); ss += y[2 * e] * y[2 * e] + y[2 * e + 1] * y[2 * e + 1]; }
                ss += __shfl_xor(ss, 1); ss += __shfl_xor(ss, 2); ss += __shfl_xor(ss, 4); ss += __shfl_xor(ss, 8);
                const float rstd = 1.0f / sqrtf(ss * (1.0f / 128.0f) + 1e-6f);
#pragma unroll
                for (int e = 0; e < 8; ++e) { y[e] = y[e] * rstd * (i4 < 2 ? gqv[e] : gkv[e]); }
#pragma unroll
                for (int e = 0; e < 8; ++e) { const float o = __shfl_xor(y[e], 2); y[e] = (c < 2) ? y[e] * cs[e] - o * sn[e] : (c < 4 ? y[e] * cs[e] + o * sn[e] : y[e]); }
                v4u ov; ov.x = cvtpk(y[0], y[1]); ov.y = cvtpk(y[2], y[3]); ov.z = cvtpk(y[4], y[5]); ov.w = cvtpk(y[6], y[7]);
                *(v4u*)(QK + row * 3072 + (lane + 64 * i4) * 8) = ov;
                if (i4 >= 2) {
#pragma unroll
                    for (int e = 0; e < 8; ++e) kacc[i4 - 2][e] += y[e]; }
            }
#pragma unroll
            for (int i4 = 0; i4 < 4; ++i4) cur[i4] = nxt[i4];
        }
        __syncthreads();
#pragma unroll
        for (int i = 0; i < 2; ++i)
#pragma unroll
            for (int e = 0; e < 8; ++e) part[w * 1024 + i * 512 + lane * 8 + e] = kacc[i][e];
        __syncthreads();
        for (int col = F.tid; col < 1024; col += NTHR) { float sacc = 0.f;
#pragma unroll
            for (int ww = 0; ww < 8; ++ww) sacc += part[ww * 1024 + col];
            kpart[((size_t)(b * 8 + blk) * 2 + half) * 1024 + col] = sacc * (1.0f / 256.0f); }
    }
}
__device__ __forceinline__ void moba_attn(Frame& F, const bf16* QKV, const float* kpart, bf16* O) {
    char* ldsg = (char*)F.lds;
    LAS float* kmS = (LAS float*)(F.lds + mattn::SHM_ATTN);
    for (int it = blockIdx.x; it < 1024; it += F.G) {
        int tid_ = threadIdx.x; asm volatile("" : "+v"(tid_));
        const int tid = tid_, lane = tid & 63, w = __builtin_amdgcn_readfirstlane(tid >> 6), r32 = lane & 31, hi = lane >> 5;
        const int c = it & 255, r = it >> 8, bh = c & 127, typ = c >> 7, b = bh >> 3, h = bh & 7;
        const int jb = (r & 1) ? 7 - (r >> 1) : (r >> 1);
        const int j = typ ? ((r & 1) ? jb - 2 : jb + 2) : jb;
        const size_t qrow0 = (size_t)b * SEQ + j * 256;
        __syncthreads();
        for (int i = tid; i < 1024; i += NTHR) { const int kb_ = i >> 7, d_ = i & 127; const float* kp = kpart + ((size_t)(b * 8 + kb_) * 2) * 1024 + h * 128 + d_; kmS[i] = kp[0] + kp[1024]; }
        mattn::bf16x8 qr[8];
        { const bf16* Qw = QKV + (qrow0 + w * 32 + r32) * 3072 + h * 128 + hi * 8;
#pragma unroll
            for (int d0 = 0; d0 < 8; ++d0) qr[d0] = *(const mattn::bf16x8*)(Qw + d0 * 16); }
        __syncthreads();
        unsigned sel = 0u;
        if (j <= 3) sel = (1u << j) - 1u;
        else { float v0 = -INFINITY, v1 = -INFINITY, v2 = -INFINITY; int i0 = 0, i1 = 0, i2 = 0;
#pragma unroll 1
            for (int blk = 0; blk < j; ++blk) { float sdot = 0.f; const LAS float* km = kmS + blk * 128 + hi * 8;
#pragma unroll
                for (int d0 = 0; d0 < 8; ++d0) asm volatile("" : "+v"(qr[d0]));
#pragma unroll
                for (int d0 = 0; d0 < 8; ++d0) {
#pragma unroll
                    for (int e = 0; e < 8; ++e) sdot += __uint_as_float(((unsigned)(unsigned short)qr[d0][e]) << 16) * km[d0 * 16 + e];
                    __builtin_amdgcn_sched_barrier(0); }
                auto rr = __builtin_amdgcn_permlane32_swap(__float_as_uint(sdot), __float_as_uint(sdot), false, false);
                sdot = __uint_as_float(rr[0]) + __uint_as_float(rr[1]);
                if (sdot > v0) { v2 = v1; i2 = i1; v1 = v0; i1 = i0; v0 = sdot; i0 = blk; }
                else if (sdot > v1) { v2 = v1; i2 = i1; v1 = sdot; i1 = blk; }
                else if (sdot > v2) { v2 = sdot; i2 = blk; } }
            sel = (1u << i0) | (1u << i1) | (1u << i2); }
        const mattn::Msk mk{j, sel, w * 32 + r32};
        const bf16* Kh = QKV + ((size_t)b * SEQ) * 3072 + 1024 + h * 128;
        mattn::body(qr, Kh, Kh + 1024, O + qrow0 * 1024 + h * 128, (j + 1) * 256, ldsg, mk);
    }
}

__device__ __forceinline__ void ret_rot_table(Frame& F, const int* pos, float* cst) {
    const int gw = blockIdx.x * NWAVES + F.wave, NGW = F.G * NWAVES, lane = F.lane;
    const float i0 = exp2f(-(float)(2 * lane) * (13.287712379549449f / 128.0f)), i1 = exp2f(-(float)(2 * lane + 1) * (13.287712379549449f / 128.0f));
    for (int m = gw; m < MTOK; m += NGW) {
        const float ps = (float)pos[m]; float s0, c0, s1, c1; sincosf(ps * i0, &s0, &c0); sincosf(ps * i1, &s1, &c1);
        f32x2* cp = (f32x2*)(cst + (size_t)m * 256) + lane; cp[0] = (f32x2){c0, c1}; cp[64] = (f32x2){s0, s1};
    }
}
__device__ __forceinline__ void ret_pmat(Frame& F, const bf16* QKV, bf16* PM) {
    LAS bf16* Qd = (LAS bf16*)F.lds;
    LAS bf16* Kd = Qd + 128 * 72;
    LAS bf16* Ps = Kd + 128 * 72;
    const int tid = F.tid, lane = F.lane, w = F.wave, fr = lane & 15, fq = lane >> 4, wh = w >> 1, wl = w & 1;
    const unsigned off0 = (unsigned)((((tid >> 3) * 4096) + (tid & 7) * 8) * 2);
    for (int item = blockIdx.x; item < 1024; item += F.G) {
        const int b = item >> 6, h = (item >> 4) & 3, c = item & 15;
        const float lgc = log1pf(-exp2f(-5.0f - (float)h)) * 1.4426950408889634f;
        const char* gq = (const char*)(QKV + ((size_t)b * SEQ + c * 128) * 4096 + h * 256);
        v4u pq[2], pkk[2];
#pragma unroll
        for (int i = 0; i < 2; ++i) { const char* src = gq + off0 + i * (64 * 4096 * 2); pq[i] = *(const v4u*)src; pkk[i] = *(const v4u*)(src + 2048); }
        f32x4 S[2][4];
#pragma unroll
        for (int i = 0; i < 2; ++i)
#pragma unroll
            for (int jj = 0; jj < 4; ++jj) S[i][jj] = (f32x4){0.f, 0.f, 0.f, 0.f};
#pragma unroll 1
        for (int dt = 0; dt < 4; ++dt) {
            __syncthreads();
#pragma unroll
            for (int i = 0; i < 2; ++i) { const int id = tid + NTHR * i, row = id >> 3, c8 = id & 7; *(LAS v4u*)(Qd + row * 72 + c8 * 8) = pq[i]; *(LAS v4u*)(Kd + row * 72 + c8 * 8) = pkk[i]; }
            if (dt < 3) {
#pragma unroll
                for (int i = 0; i < 2; ++i) { const char* src = gq + (dt + 1) * 128 + off0 + i * (64 * 4096 * 2); pq[i] = *(const v4u*)src; pkk[i] = *(const v4u*)(src + 2048); } }
            __syncthreads();
            wgemm<2, 4, 64, 72, 72>(S, Qd + 32 * wh * 72, Kd + 64 * wl * 72, lane);
        }
#pragma unroll
        for (int i = 0; i < 2; ++i)
#pragma unroll
            for (int e = 0; e < 4; ++e) { const int t = 32 * wh + 16 * i + 4 * fq + e;
#pragma unroll
                for (int jj = 0; jj < 4; ++jj) { const int sidx = 64 * wl + 16 * jj + fr; const float wgt = (t >= sidx) ? __builtin_amdgcn_exp2f((float)(t - sidx) * lgc) : 0.f;
                    Ps[t * 136 + sidx] = (bf16)f2bf(S[i][jj][e] * wgt); } }
        __syncthreads();
        bf16* dst = PM + (size_t)item * 128 * 128;
#pragma unroll
        for (int i = 0; i < 4; ++i) { const int id = tid + NTHR * i, row = id >> 4, c8 = id & 15; *(v4u*)(dst + row * 128 + c8 * 8) = *(const LAS v4u*)(Ps + row * 136 + c8 * 8); }
    }
}
#ifndef RET_EXP
#define RET_EXP 0
#endif
__device__ __forceinline__ void ret_core(Frame& F, bf16* QKV, const bf16* PM, float* st) {
    constexpr int TSET = 3 * 128 * 72;
    LAS bf16* T0 = (LAS bf16*)F.lds;
    LAS bf16* Vs = T0 + 2 * TSET;
    LAS bf16* Ps = T0;
    LAS bf16* Xs = T0 + TSET;
    LAS float* fST = (LAS float*)(Vs + 128 * 136);
    const int tid = F.tid, lane = F.lane, w = F.wave, fr = lane & 15, fq = lane >> 4, wh = w >> 1, wl = w & 1;
    const unsigned off8 = (unsigned)((((tid >> 3) * 4096) + (tid & 7) * 8) * 2);
    const unsigned off16 = (unsigned)((((tid >> 4) * 4096) + (tid & 15) * 8) * 2);
    for (int item = blockIdx.x; item < 256; item += F.G) {
        const int b = item >> 4, h = (item >> 2) & 3, vs = item & 3;
        const float lg = log1pf(-exp2f(-5.0f - (float)h)), gch = expf(128.0f * lg);
        f32x4 Racc[4][1][4];
#pragma unroll
        for (int dt = 0; dt < 4; ++dt)
#pragma unroll
            for (int jj = 0; jj < 4; ++jj) Racc[dt][0][jj] = (f32x4){0.f, 0.f, 0.f, 0.f};
        const size_t tb = (size_t)b * SEQ;
        __syncthreads();
        v4u pq[2], pkk[2], pv[4];
        { const char* gq0 = (const char*)(QKV + tb * 4096 + h * 256); const char* gv0 = (const char*)(QKV + tb * 4096 + 2048 + h * 512 + vs * 128);
#pragma unroll
            for (int i = 0; i < 2; ++i) { const char* src = gq0 + off8 + i * (64 * 4096 * 2); pq[i] = *(const v4u*)src; pkk[i] = *(const v4u*)(src + 2048); }
#pragma unroll
            for (int i = 0; i < 4; ++i) pv[i] = *(const v4u*)(gv0 + off16 + i * (32 * 4096 * 2)); }
        for (int c = 0; c < 16; ++c) {
            const size_t t0 = tb + c * 128;
            const char* gq = (const char*)(QKV + t0 * 4096 + h * 256);
            char* gy = (char*)(QKV + t0 * 4096 + 2048 + h * 512 + vs * 128);
            const bf16* pmt = PM + ((size_t)((b * 4 + h) * 16 + c)) * 128 * 128;
            float lgc = lg * 1.4426950408889634f; asm volatile("" : "+v"(lgc));
#pragma unroll
            for (int i = 0; i < 4; ++i) { const int id = tid + NTHR * i; *(LAS v4u*)(Vs + (id >> 4) * 136 + (id & 15) * 8) = pv[i]; }
            f32x4 X[2][4];
#pragma unroll
            for (int i = 0; i < 2; ++i)
#pragma unroll
                for (int jj = 0; jj < 4; ++jj) X[i][jj] = (f32x4){0.f, 0.f, 0.f, 0.f};
#pragma unroll 1
            for (int dt = 0; dt < 4; ++dt) {
                LAS bf16* Qd = T0 + (dt & 1) * TSET; LAS bf16* Kz = Qd + 128 * 72; LAS bf16* Rb = Kz + 128 * 72;
#pragma unroll
                for (int i = 0; i < 2; ++i) { const int id = tid + NTHR * i, row = id >> 3, c8 = id & 7; const float z = __builtin_amdgcn_exp2f((float)(127 - row) * lgc);
                    *(LAS v4u*)(Qd + row * 72 + c8 * 8) = pq[i];
                    v4u zo; zo.x = cvtpk(lo_bf(pkk[i].x) * z, hi_bf(pkk[i].x) * z); zo.y = cvtpk(lo_bf(pkk[i].y) * z, hi_bf(pkk[i].y) * z); zo.z = cvtpk(lo_bf(pkk[i].z) * z, hi_bf(pkk[i].z) * z); zo.w = cvtpk(lo_bf(pkk[i].w) * z, hi_bf(pkk[i].w) * z);
                    *(LAS v4u*)(Kz + row * 72 + c8 * 8) = zo; }
#pragma unroll
                for (int jj = 0; jj < 4; ++jj)
#pragma unroll
                    for (int e = 0; e < 4; ++e) Rb[(16 * w + 4 * fq + e) * 72 + 16 * jj + fr] = (bf16)f2bf(Racc[0][0][jj][e]);
#if RET_EXP == 3
                asm volatile("" ::: "memory");
#pragma unroll
                for (int jj = 0; jj < 4; ++jj)
#pragma unroll
                    for (int e = 0; e < 4; ++e) *(volatile LAS bf16*)(Rb + (16 * w + 4 * fq + e) * 72 + 16 * jj + fr) = (bf16)f2bf(Racc[0][0][jj][e]);
#endif
                if (dt < 3 || c < 15) {
                    const char* nb = (dt < 3) ? gq + (dt + 1) * 128 : gq + (size_t)128 * 4096 * 2;
#pragma unroll
                    for (int i = 0; i < 2; ++i) { const char* src = nb + off8 + i * (64 * 4096 * 2); pq[i] = *(const v4u*)src; pkk[i] = *(const v4u*)(src + 2048); } }
                __syncthreads();
                wgemm<2, 4, 64, 72, 72, false, false, false>(X, Qd + 32 * wh * 72, Rb + 64 * wl * 72, lane);
#if RET_EXP == 5
                { f32x4 D_[2][4];
#pragma unroll
                  for (int i = 0; i < 2; ++i)
#pragma unroll
                    for (int jj = 0; jj < 4; ++jj) D_[i][jj] = (f32x4){0.f, 0.f, 0.f, 0.f};
                  wgemm<2, 4, 64, 72, 72>(D_, Qd + 32 * wh * 72, Rb + 64 * wl * 72, lane);
#pragma unroll
                  for (int i = 0; i < 2; ++i)
#pragma unroll
                    for (int jj = 0; jj < 4; ++jj) asm volatile("" :: "v"(D_[i][jj])); }
#endif
#if RET_EXP == 6
                { f32x4 D_[1][4];
#pragma unroll
                    for (int jj = 0; jj < 4; ++jj) D_[0][jj] = (f32x4){0.f, 0.f, 0.f, 0.f};
                  wgemm<1, 4, 128, 136, 72, true, true>(D_, Vs + 16 * w, Kz, lane);
#pragma unroll
                    for (int jj = 0; jj < 4; ++jj) asm volatile("" :: "v"(D_[0][jj])); }
#endif
#pragma unroll
                for (int jj = 0; jj < 4; ++jj) Racc[0][0][jj] = Racc[0][0][jj] * gch;
                wgemm<1, 4, 128, 136, 72, true, true, false>(Racc[0], Vs + 16 * w, Kz, lane);
#pragma unroll
                for (int jj = 0; jj < 4; ++jj) { const f32x4 t_ = Racc[0][0][jj]; Racc[0][0][jj] = Racc[1][0][jj]; Racc[1][0][jj] = Racc[2][0][jj]; Racc[2][0][jj] = Racc[3][0][jj]; Racc[3][0][jj] = t_; }
            }
            v4u pp[4];
#pragma unroll
            for (int i = 0; i < 4; ++i) { const int id = tid + NTHR * i; pp[i] = *(const v4u*)(pmt + (id >> 4) * 128 + (id & 15) * 8); }
#if RET_EXP == 2
            asm volatile("s_waitcnt vmcnt(0)" ::: "memory");
#pragma unroll
            for (int i = 0; i < 4; ++i) { const int id = tid + NTHR * i; v4u q_ = *(const volatile v4u*)(pmt + 64 * 128 * 128 + (id >> 4) * 128 + (id & 15) * 8); asm volatile("" :: "v"(q_.x), "v"(q_.y), "v"(q_.z), "v"(q_.w)); }
            asm volatile("s_waitcnt vmcnt(0)" ::: "memory");
#endif
#pragma unroll
            for (int i = 0; i < 2; ++i)
#pragma unroll
                for (int e = 0; e < 4; ++e) { const int t = 32 * wh + 16 * i + 4 * fq + e; const float xi = __builtin_amdgcn_exp2f((float)(t + 1) * lgc);
#pragma unroll
                    for (int jj = 0; jj < 4; ++jj) X[i][jj][e] *= xi; }
#pragma unroll
            for (int i = 0; i < 4; ++i) { const int id = tid + NTHR * i; *(LAS v4u*)(Ps + (id >> 4) * 136 + (id & 15) * 8) = pp[i]; }
            __syncthreads();
            wgemm<2, 4, 128, 136, 136, false, true, false>(X, Ps + 32 * wh * 136, Vs + 64 * wl, lane);
#pragma unroll
            for (int i = 0; i < 2; ++i)
#pragma unroll
                for (int e = 0; e < 4; ++e) { const int t = 32 * wh + 16 * i + 4 * fq + e; float s1 = 0.f, s2 = 0.f;
#pragma unroll
                    for (int jj = 0; jj < 4; ++jj) { const float y = X[i][jj][e]; s1 += y; s2 += y * y; Xs[t * 136 + 64 * wl + 16 * jj + fr] = (bf16)f2bf(y); }
                    s1 += __shfl_xor(s1, 1); s1 += __shfl_xor(s1, 2); s1 += __shfl_xor(s1, 4); s1 += __shfl_xor(s1, 8);
                    s2 += __shfl_xor(s2, 1); s2 += __shfl_xor(s2, 2); s2 += __shfl_xor(s2, 4); s2 += __shfl_xor(s2, 8);
                    if (fr == 0) { fST[(wl * 128 + t) * 2] = s1; fST[(wl * 128 + t) * 2 + 1] = s2; } }
            if (c < 15) { const char* gvn = gy + (size_t)128 * 4096 * 2;
#pragma unroll
                for (int i = 0; i < 4; ++i) pv[i] = *(const v4u*)(gvn + off16 + i * (32 * 4096 * 2)); }
            __syncthreads();
#pragma unroll
            for (int i = 0; i < 4; ++i) { const int id = tid + NTHR * i, row = id >> 4, c8 = id & 15; *(v4u*)(gy + (unsigned)((row * 4096 + c8 * 8) * 2)) = *(const LAS v4u*)(Xs + row * 136 + c8 * 8); }
            if (tid < 128) { float* sp = st + (t0 + tid) * 32 + (h * 4 + vs) * 2; sp[0] = fST[tid * 2] + fST[(128 + tid) * 2]; sp[1] = fST[tid * 2 + 1] + fST[(128 + tid) * 2 + 1]; }
        }
    }
}

__device__ __forceinline__ void lru_conv(Frame& F, const bf16* GX, const float* cw, const float* cb, bf16* XC, const float* lru, float* sptab) {
    if (blockIdx.x == 0) for (int i = F.tid; i < 1024; i += NTHR) { const float l = -lru[i]; sptab[i] = fmaxf(l, 0.f) + log1pf(expf(-fabsf(l))); }
    const int c8 = F.tid & 127, rsub = F.tid >> 7;
    f32x4 w0[4], w1[4];
#pragma unroll
    for (int wv = 0; wv < 4; ++wv) { w0[wv] = *(const f32x4*)(cw + wv * 1024 + c8 * 8); w1[wv] = *(const f32x4*)(cw + wv * 1024 + c8 * 8 + 4); }
    const f32x4 b0 = *(const f32x4*)(cb + c8 * 8), b1 = *(const f32x4*)(cb + c8 * 8 + 4);
    for (int r0 = blockIdx.x * 16; r0 < MTOK; r0 += F.G * 16) {
        const int rb = r0 + 4 * rsub, t = rb & (SEQ - 1);
        v4u xin[7];
#pragma unroll
        for (int k = 0; k < 7; ++k) { const int rr = rb - 3 + k; xin[k] = (t - 3 + k >= 0) ? *(const v4u*)(GX + (size_t)rr * 2048 + 1024 + c8 * 8) : (v4u){0u, 0u, 0u, 0u}; }
#pragma unroll
        for (int q = 0; q < 4; ++q) { f32x4 a0 = b0, a1 = b1;
#pragma unroll
            for (int wv = 0; wv < 4; ++wv) { const v4u x = xin[q + wv];
                a0 += (f32x4){lo_bf(x.x), hi_bf(x.x), lo_bf(x.y), hi_bf(x.y)} * w0[wv]; a1 += (f32x4){lo_bf(x.z), hi_bf(x.z), lo_bf(x.w), hi_bf(x.w)} * w1[wv]; }
            v4u o; o.x = cvtpk(a0[0], a0[1]); o.y = cvtpk(a0[2], a0[3]); o.z = cvtpk(a1[0], a1[1]); o.w = cvtpk(a1[2], a1[3]);
            *(v4u*)(XC + (size_t)(rb + q) * 1024 + c8 * 8) = o; }
    }
}
__device__ __forceinline__ float gelu_tanh(float x) { const float z = 0.7978845608028654f * (x + 0.044715f * x * x * x); const float e = __expf(2.0f * z); const float th = 1.0f - 2.0f * __builtin_amdgcn_rcpf(e + 1.0f); return 0.5f * x * (1.0f + th); }
__device__ __forceinline__ void lru_scan(Frame& F, const bf16* LA, const bf16* BT, const bf16* GX, bf16* Y) {
    LAS float* segL = (LAS float*)F.lds;
    LAS float* segH = segL + 512;
    const int lane = F.lane, w = F.wave;
    for (int item = blockIdx.x; item < 256; item += F.G) {
        const int b = item >> 4, ch = (item & 15) * 64 + lane;
        const size_t r0 = (size_t)b * SEQ + w * 256;
        const bf16* la_p = LA + r0 * 1024 + ch; const bf16* bt_p = BT + r0 * 1024 + ch; const bf16* gx_p = GX + r0 * 2048 + ch; bf16* y_p = Y + r0 * 1024 + ch;
        float L = 0.f, H = 0.f;
        bf16 la0[16], bt0[16], la1[16], bt1[16];
#pragma unroll
        for (int k = 0; k < 16; ++k) { la0[k] = la_p[(size_t)k * 1024]; bt0[k] = bt_p[(size_t)k * 1024]; }
#pragma unroll 1
        for (int tb = 0; tb < 16; tb += 2) {
#pragma unroll
            for (int k = 0; k < 16; ++k) { la1[k] = la_p[(size_t)((tb + 1) * 16 + k) * 1024]; bt1[k] = bt_p[(size_t)((tb + 1) * 16 + k) * 1024]; }
#pragma unroll
            for (int k = 0; k < 16; ++k) { const float la = bf2f(la0[k]); L += la; H = __expf(la) * H + bf2f(bt0[k]); }
            if (tb + 2 < 16) {
#pragma unroll
                for (int k = 0; k < 16; ++k) { la0[k] = la_p[(size_t)((tb + 2) * 16 + k) * 1024]; bt0[k] = bt_p[(size_t)((tb + 2) * 16 + k) * 1024]; } }
#pragma unroll
            for (int k = 0; k < 16; ++k) { const float la = bf2f(la1[k]); L += la; H = __expf(la) * H + bf2f(bt1[k]); }
        }
        __syncthreads();
        segL[w * 64 + lane] = L; segH[w * 64 + lane] = H;
        __syncthreads();
        float hc = 0.f;
        for (int sg = 0; sg < w; ++sg) hc = __expf(segL[sg * 64 + lane]) * hc + segH[sg * 64 + lane];
        bf16 g0[16], g1[16];
#pragma unroll
        for (int k = 0; k < 16; ++k) { la0[k] = la_p[(size_t)k * 1024]; bt0[k] = bt_p[(size_t)k * 1024]; g0[k] = gx_p[(size_t)k * 2048]; }
#pragma unroll
        for (int k = 0; k < 16; ++k) { const size_t t = (size_t)(16 + k); la1[k] = la_p[t * 1024]; bt1[k] = bt_p[t * 1024]; g1[k] = gx_p[t * 2048]; }
#pragma unroll 1
        for (int tb = 0; tb < 16; tb += 2) {
            bf16 yv[16];
#pragma unroll
            for (int k = 0; k < 16; ++k) { hc = __expf(bf2f(la0[k])) * hc + bf2f(bt0[k]); yv[k] = (bf16)f2bf(hc * gelu_tanh(bf2f(g0[k]))); }
            if (tb + 2 < 16) {
#pragma unroll
                for (int k = 0; k < 16; ++k) { const size_t t = (size_t)((tb + 2) * 16 + k); la0[k] = la_p[t * 1024]; bt0[k] = bt_p[t * 1024]; g0[k] = gx_p[t * 2048]; } }
#pragma unroll
            for (int k = 0; k < 16; ++k) y_p[(size_t)(tb * 16 + k) * 1024] = yv[k];
#pragma unroll
            for (int k = 0; k < 16; ++k) { hc = __expf(bf2f(la1[k])) * hc + bf2f(bt1[k]); yv[k] = (bf16)f2bf(hc * gelu_tanh(bf2f(g1[k]))); }
            if (tb + 3 < 16) {
#pragma unroll
                for (int k = 0; k < 16; ++k) { const size_t t = (size_t)((tb + 3) * 16 + k); la1[k] = la_p[t * 1024]; bt1[k] = bt_p[t * 1024]; g1[k] = gx_p[t * 2048]; } }
#pragma unroll
            for (int k = 0; k < 16; ++k) y_p[(size_t)((tb + 1) * 16 + k) * 1024] = yv[k];
        }
    }
}

#ifndef WGM_BIG
#define WGM_BIG 8
#endif
#ifndef WGM_N4
#define WGM_N4 4
#endif
#ifndef WGM_MID
#define WGM_MID 8
#endif
template <class Epi>
__device__ __forceinline__ void run_gemm(Frame& F, const bf16* A, int lda, const bf16* Bt, int ldb, int N, int K, const Epi& E, int M = MTOK, int ablk = 0) {
    pg8::Gemm g{A, Bt, M, N, K, lda, ldb, ablk}; pg8::StaticOrder S; S.init(M, N, F.G, (int)blockIdx.x, (N >= 4096) ? WGM_BIG : (N <= 1024 ? WGM_N4 : WGM_MID));
#ifndef STAGGER_NG
#define STAGGER_NG 1
#endif
#ifndef STAGGER_STEP
#define STAGGER_STEP 300
#endif
    if (STAGGER_NG > 1 && N >= 4096 && M == MTOK) {
        const unsigned grp = (((unsigned)blockIdx.x >> 3) & 7u) / (8 / STAGGER_NG);
        if (grp) { const unsigned long long t0 = __builtin_amdgcn_s_memrealtime(), dl = (unsigned long long)grp * STAGGER_STEP;
            while (__builtin_amdgcn_s_memrealtime() - t0 < dl) __builtin_amdgcn_s_sleep(8); }
    }
#ifndef FUSE_NX
#define FUSE_NX false
#endif
#ifndef GEMM_ALIGN
#define GEMM_ALIGN true
#endif
#ifndef GEMM_SP2
#define GEMM_SP2 true
#endif
    pg8::gemm_phase<Epi, pg8::StaticOrder, GEMM_ALIGN, GEMM_SP2>(F.lds, g, S, E);
}

typedef const __attribute__((address_space(4))) struct Args* ArgsP;
constexpr int NPHASE = 35;
__device__ __forceinline__ ArgsP get_args() { ArgsP p = (ArgsP)__builtin_amdgcn_kernarg_segment_ptr(); asm volatile("" : "+s"(p)); return p; }
__device__ __forceinline__ bool in_phase(int k) { ArgsP a = get_args(); return a->ph_lo <= k && k < a->ph_hi; }
#ifndef DUP_PHASE
#define DUP_PHASE -1
#endif
#ifndef BAR_EXP
#define BAR_EXP 0
#endif
#ifndef TIMING_MASK
#define TIMING_MASK 0ull
#endif
#define TMISC ((volatile LAS unsigned long long*)((LAS unsigned char*)lds_raw + MISC_OFF))
#define TB(k) do { if (((TIMING_MASK >> (k)) & 1ull) && blockIdx.x == 0 && threadIdx.x == 0) TMISC[0] = __builtin_amdgcn_s_memrealtime(); } while (0)
#define TE(k) do { if (((TIMING_MASK >> (k)) & 1ull) && blockIdx.x == 0 && threadIdx.x == 0) TMISC[1] = TMISC[1] + (__builtin_amdgcn_s_memrealtime() - TMISC[0]); } while (0)
#define REP(k) TB(k); for (int rep_ = 0; rep_ < ((k) == DUP_PHASE ? 2 : 1); ++rep_)
#define AP ArgsP ap = get_args(); { int t_ = threadIdx.x; asm volatile("" : "+v"(t_)); F.tid = t_; F.lane = t_ & 63; F.wave = __builtin_amdgcn_readfirstlane(t_ >> 6); F.G = gridDim.x; F.lds = (LAS unsigned char*)lds_raw; }
__global__ void __launch_bounds__(NTHR, 2) trunk_fwd(Args args) {
    extern __shared__ __attribute__((aligned(16))) unsigned char lds_raw[];
    Frame F; F.lds = (LAS unsigned char*)lds_raw; F.tid = threadIdx.x; F.lane = F.tid & 63; F.wave = __builtin_amdgcn_readfirstlane(F.tid >> 6); F.G = gridDim.x;
    volatile LAS unsigned* MISC = (volatile LAS unsigned*)(F.lds + MISC_OFF);
    if (F.tid < 16) MISC[F.tid] = 0u;
    __syncthreads();
    if (args.ph_hi - args.ph_lo > 1) (void)xcd_barrier_post((unsigned*)(args.ws + WS_CTL) + CW_BAR, MISC + 8);
#ifndef ONLY_PHASE
#define ONLY_PHASE -1
#endif
#define IN(k) ((ONLY_PHASE < 0 || (k) == ONLY_PHASE) && in_phase(k))
#define SEAM(k) do { if (IN(k) && IN((k) + 1)) { XcdBarrier bb; bb.bar = (unsigned*)(get_args()->ws + WS_CTL) + CW_BAR; bb.x = xb_xcc_id(); bb.st = (volatile LAS unsigned*)((LAS unsigned char*)lds_raw + MISC_OFF) + 8; xcd_barrier(bb); if (BAR_EXP) xcd_barrier(bb); } if (IN(k)) TE(k); } while (0)
#define XIN ((const float*)ap->in[0])
#define pos ((const int*)ap->in[1])
#define norm_mix ((const float*)ap->in[2])
#define norm_ffn ((const float*)ap->in[3])
#define ffn_w_in ((const float*)ap->in[4])
#define ffn_w_out ((const float*)ap->in[5])
#define out (ap->out)
#define Wmi ((bf16*)(ap->ws + WS_W_MIXIN))
#define Wmo ((bf16*)(ap->ws + WS_W_MIXOUT))
#define Wfi ((bf16*)(ap->ws + WS_W_FFNIN))
#define Wfo ((bf16*)(ap->ws + WS_W_FFNOUT))
#define U ((bf16*)(ap->ws + WS_U))
#define BIG ((bf16*)(ap->ws + WS_BIG))
#define gatesA ((float*)(ap->ws + WS_GATESA))
#define ssqA ((float*)(ap->ws + WS_SSQA))
#define statC ((float*)(ap->ws + WS_STATC))
#define kmean ((float*)(ap->ws + WS_KMEAN))
#define sptab ((float*)(ap->ws + WS_SPTAB))
#define ssqH ((float*)(ap->ws + WS_SSQH))

#define a_w_in ((const float*)ap->in[6])
#define a_b ((const float*)ap->in[7])
#define a_g ((const float*)ap->in[8])
#define a_w_out ((const float*)ap->in[9])
#define b_w_in ((const float*)ap->in[10])
#define b_gq ((const float*)ap->in[11])
#define b_gk ((const float*)ap->in[12])
#define b_w_out ((const float*)ap->in[13])
#define c_w_in ((const float*)ap->in[14])
#define c_g ((const float*)ap->in[15])
#define c_w_out ((const float*)ap->in[16])
#define d_w_in ((const float*)ap->in[17])
#define d_cw ((const float*)ap->in[18])
#define d_cb ((const float*)ap->in[19])
#define d_wg ((const float*)ap->in[20])
#define d_bg ((const float*)ap->in[21])
#define d_lru ((const float*)ap->in[22])
#define d_w_out ((const float*)ap->in[23])
#define GX BIG
#define XC (BIG + (size_t)MTOK * 2048)
#define LA (BIG + (size_t)MTOK * 3072)
#define BT (BIG + (size_t)MTOK * 4096)
#define Y (BIG + (size_t)MTOK * 5120)
#define Wg (Wmi + (size_t)2048 * DM)
#define FFN_CVT(l) do { cvt_matrix(F, ffn_w_in + (size_t)(l) * DM * 2 * DFF, 2 * DFF, DM, 2 * DFF, 1, Wfi); cvt_matrix(F, ffn_w_out + (size_t)(l) * DFF * DM, DM, DFF, DM, 0, Wfo); } while (0)
#define FFN_PHASES(p0, l) do { \
    if (IN(p0)) { AP; REP(p0) { norm_phase<false>(F, out, norm_ffn + (l) * DM, U, nullptr, nullptr, nullptr); } } SEAM(p0); \
    if (IN((p0) + 1)) { AP; REP((p0) + 1) { pg8::EpiSwiGLU<false> E{BIG, DFF, nullptr}; run_gemm(F, U, DM, Wfi, DM, 2 * DFF, DM, E); } } SEAM((p0) + 1); \
    if (IN((p0) + 2)) { AP; REP((p0) + 2) { pg8::EpiResid<FUSE_NX> E{out, out, DM, U, ssqH}; run_gemm(F, BIG, DFF, Wfo, DFF, DM, DFF, E); } } SEAM((p0) + 2); } while (0)
#define QKV BIG
#define HO (BIG + (size_t)MTOK * 2048)
#define PMAB (BIG + (size_t)MTOK * 3072)
#define GTB ((float*)(BIG + (size_t)MTOK * 3584))
#define DENB ((float*)(BIG + (size_t)MTOK * 3584) + 2048 * 320)
    if (IN(0)) { AP; REP(0) { cvt_matrix(F, a_w_in, 3080, DM, 3072, 0, Wmi); cvt_matrix(F, a_w_out, DM, DM, DM, 0, Wmo); FFN_CVT(0);
        __syncthreads(); norm_phase<true>(F, XIN, norm_mix, U, a_w_in, a_b, gatesA); } } SEAM(0);
    if (IN(1)) { AP; REP(1) { mlstm_pre(F, gatesA, GTB); __syncthreads(); pg8::EpiStore<false> E{QKV, 2048, nullptr}; run_gemm(F, U, DM, Wmi, DM, 2048, DM, E); } } SEAM(1);
    if (IN(2)) { AP; REP(2) { mlstm_pmat(F, QKV, GTB, PMAB, DENB); } } SEAM(2);
    if (IN(3)) { AP; REP(3) { mlstm_core(F, QKV, GTB, PMAB, DENB, HO, ssqA); } } SEAM(3);
    if (IN(4)) { AP; REP(4) { pg8::EpiGateA E{HO, ssqA, a_g}; run_gemm(F, U, DM, Wmi + (size_t)2048 * DM, DM, DM, DM, E); } } SEAM(4);
    if (IN(5)) { AP; REP(5) { pg8::EpiResid<FUSE_NX> E{XIN, out, DM, U, ssqH}; run_gemm(F, HO, DM, Wmo, DM, DM, DM, E); } } SEAM(5);
    FFN_PHASES(6, 0);
#define OB (BIG + (size_t)MTOK * 3072)
#define VTB (BIG + (size_t)MTOK * 2048)
    if (IN(9)) { AP; REP(9) { cvt_matrix(F, b_w_in, 3072, DM, 3072, 0, Wmi); cvt_matrix(F, b_w_out, DM, DM, DM, 0, Wmo); FFN_CVT(1);
        __syncthreads(); norm_phase<false>(F, out, norm_mix + DM, U, nullptr, nullptr, nullptr); } } SEAM(9);
    if (IN(10)) { AP; REP(10) { pg8::EpiStore<false> E{QKV, 3072, nullptr}; run_gemm(F, U, DM, Wmi, DM, 3072, DM, E); } } SEAM(10);
    if (IN(11)) { AP; REP(11) { moba_prep(F, QKV, pos, b_gq, b_gk, kmean); } } SEAM(11);
    if (IN(12)) { AP; REP(12) { moba_attn(F, QKV, kmean, OB); } } SEAM(12);
    if (IN(13)) { AP; REP(13) { pg8::EpiResid<FUSE_NX> E{out, out, DM, U, ssqH}; run_gemm(F, OB, DM, Wmo, DM, DM, DM, E); } } SEAM(13);
    FFN_PHASES(14, 1);
#define YS (BIG + 2048)
#define PMB (BIG + (size_t)MTOK * 4096)
#define CSTB ((float*)(BIG + (size_t)MTOK * 4096 + (size_t)16 * 1024 * 1024))
    if (IN(17)) { AP; REP(17) { cvt_matrix(F, c_w_in, 6144, DM, 6144, 0, Wmi); cvt_matrix(F, c_w_out, DM, 2048, DM, 0, Wmo); FFN_CVT(2);
        __syncthreads(); norm_phase<false>(F, out, norm_mix + 2 * DM, U, nullptr, nullptr, nullptr); ret_rot_table(F, pos, CSTB); } } SEAM(17);
    if (IN(18)) { AP; REP(18) { pg8::EpiStoreRot E{QKV, CSTB}; run_gemm(F, U, DM, Wmi, DM, 4096, DM, E); } } SEAM(18);
    if (IN(19)) { AP; REP(19) { ret_pmat(F, QKV, PMB); } } SEAM(19);
    if (IN(20)) { AP; REP(20) { ret_core(F, QKV, PMB, statC); } } SEAM(20);
    if (IN(21)) { AP; REP(21) { pg8::EpiGateC<false> E{YS, 4096, statC, c_g, nullptr}; run_gemm(F, U, DM, Wmi + (size_t)4096 * DM, DM, 2048, DM, E); } } SEAM(21);
    if (IN(22)) { AP; REP(22) { pg8::EpiResid<FUSE_NX> E{out, out, DM, U, ssqH}; run_gemm(F, YS, 4096, Wmo, 2048, DM, 2048, E); } } SEAM(22);
    FFN_PHASES(23, 2);
    if (IN(26)) { AP; REP(26) { cvt_matrix(F, d_w_in, 2048, DM, 2048, 0, Wmi);
#pragma unroll 1
            for (int blk = 0; blk < 4; ++blk) cvt_matrix(F, d_wg + (size_t)blk * 256 * 512, 512, 256, 512, 2, Wg + (size_t)blk * 512 * 256);
            cvt_matrix(F, d_w_out, DM, DM, DM, 0, Wmo); FFN_CVT(3);
        __syncthreads(); norm_phase<false>(F, out, norm_mix + 3 * DM, U, nullptr, nullptr, nullptr); } } SEAM(26);
    if (IN(27)) { AP; REP(27) { pg8::EpiStore<false> E{GX, 2048, nullptr}; run_gemm(F, U, DM, Wmi, DM, 2048, DM, E); } } SEAM(27);
    if (IN(28)) { AP; REP(28) { lru_conv(F, GX, d_cw, d_cb, XC, d_lru, sptab); } } SEAM(28);
    if (IN(29)) { AP; REP(29) { pg8::EpiLru E{XC, LA, BT, d_bg, sptab}; run_gemm(F, XC, DM, Wg, 256, 2048, 256, E, MTOK, 256); } } SEAM(29);
    if (IN(30)) { AP; REP(30) { lru_scan(F, LA, BT, GX, Y); } } SEAM(30);
    if (IN(31)) { AP; REP(31) { pg8::EpiResid<FUSE_NX> E{out, out, DM, U, ssqH}; run_gemm(F, Y, DM, Wmo, DM, DM, DM, E); } } SEAM(31);
    FFN_PHASES(32, 3);
    if (TIMING_MASK != 0ull && blockIdx.x == 0 && threadIdx.x == 0) { const unsigned long long t0_ = __builtin_amdgcn_s_memrealtime(); const unsigned long long tacc_ = TMISC[1]; while (__builtin_amdgcn_s_memrealtime() - t0_ < tacc_) __builtin_amdgcn_s_sleep(8); }
#undef IN
#undef SEAM
#undef XIN
#undef pos
#undef norm_mix
#undef norm_ffn
#undef ffn_w_in
#undef ffn_w_out
#undef out
#undef Wmi
#undef Wmo
#undef Wfi
#undef Wfo
#undef U
#undef BIG
#undef gatesA
#undef ssqA
#undef statC
#undef kmean
#undef sptab
#undef a_w_in
#undef a_b
#undef a_g
#undef a_w_out
#undef b_w_in
#undef b_gq
#undef b_gk
#undef b_w_out
#undef c_w_in
#undef c_g
#undef c_w_out
#undef d_w_in
#undef d_cw
#undef d_cb
#undef d_wg
#undef d_bg
#undef d_lru
#undef d_w_out
#undef GX
#undef XC
#undef LA
#undef BT
#undef Y
#undef Wg
#undef FFN_CVT
#undef OB
#undef CSTB
#undef PMAB
#undef GTB
#undef DENB
#undef PMB
#undef VTB
#undef FFN_PHASES
#undef QKV
#undef HO
#undef YS
#undef ssqH
}

#ifndef MK_ONE_LAUNCH
#define MK_ONE_LAUNCH 1
#endif
extern "C" void kernel_launch(void* const* d_in, const int* in_sizes, int n_in, void* d_out, int out_size, void* d_ws, size_t ws_size, hipStream_t stream) {
    static int grid = 0;
    if (grid == 0) {
        if (n_in != 24 || out_size != MTOK * DM || ws_size < WS_END) { fprintf(stderr, "kernel_launch: unexpected shapes (n_in %d, out %d, ws %zu); nothing launched\n", n_in, out_size, ws_size); grid = -1; return; }
        int dev = 0, cus = 0, per_cu = 0;
        if (hipGetDevice(&dev) != hipSuccess || hipDeviceGetAttribute(&cus, hipDeviceAttributeMultiprocessorCount, dev) != hipSuccess) { grid = -1; return; }
        if (hipFuncSetAttribute((const void*)trunk_fwd, hipFuncAttributeMaxDynamicSharedMemorySize, LDS_BYTES) != hipSuccess) { fprintf(stderr, "kernel_launch: hipFuncSetAttribute failed\n"); grid = -1; return; }
        if (hipOccupancyMaxActiveBlocksPerMultiprocessor(&per_cu, (const void*)trunk_fwd, NTHR, LDS_BYTES) != hipSuccess || per_cu < 1) { fprintf(stderr, "kernel_launch: occupancy query reports %d blocks per CU\n", per_cu); }
        (void)hipGetLastError();
        grid = cus;
    }
    if (grid < 0) return;
    (void)hipMemsetAsync((char*)d_ws + WS_CTL, 0, CTL_ZERO_BYTES, stream);
    Args a{};
    for (int i = 0; i < 24; ++i) a.in[i] = d_in[i];
    a.out = (float*)d_out; a.ws = (unsigned char*)d_ws;
#if MK_ONE_LAUNCH
    a.ph_lo = 0; a.ph_hi = NPHASE;
    hipLaunchKernelGGL(trunk_fwd, dim3(grid), dim3(NTHR), LDS_BYTES, stream, a);
#else
    for (int p = 0; p < NPHASE; ++p) { a.ph_lo = p; a.ph_hi = p + 1; hipLaunchKernelGGL(trunk_fwd, dim3(grid), dim3(NTHR), LDS_BYTES, stream, a); }
#endif
}
```

```cpp
#include <hip/hip_runtime.h>
#include <cstdio>
#include <cstdint>
#include <cmath>
namespace pg8 {
#define PG8_LAS __attribute__((address_space(3)))
typedef unsigned short bf16_t;
typedef short bf16x8 __attribute__((ext_vector_type(8)));
typedef float f32x4 __attribute__((ext_vector_type(4)));
typedef unsigned u32x4 __attribute__((ext_vector_type(4)));
constexpr int BM = 256, BK = 64, HALF = 128, HTB = HALF * BK * 2  , STAGE_BYTES = 8 * HTB, NXCD = 8, WGM = 8;

__host__ __device__ __forceinline__ int lds_byte(int r, int c) { const int st = (r >> 4) * 2 + (c >> 5), rr = r & 15, cc = c & 31, ob = rr * 64 + cc * 2; return st * 1024 + (ob ^ (((ob >> 9) & 1) << 5)); }
__host__ __device__ __forceinline__ void stage_rc(int b, int& R, int& C) { const int st = b / 1024, sb = b % 1024, swz = sb ^ (((sb >> 9) & 1) << 5); R = (st >> 1) * 16 + swz / 64; C = (st & 1) * 32 + (swz % 64) / 2; }
__host__ __device__ __forceinline__ int perm32(int rho) { const int n = rho >> 4, i = rho & 15; return 8 * (i >> 2) + 4 * n + (i & 3); }

struct Unit { int pm, pn; };
struct Gemm { const bf16_t* A; const bf16_t* Bt; int M, N, K, lda, ldb, ablk; };

struct StaticOrder {
    int nM, nN, nwg, G, c, wgm;
    __host__ __device__ void init(int M, int N, int G_, int c_, int wgm_ = WGM) { nM = M / BM; nN = N / BM; nwg = nM * nN; G = G_; c = c_; wgm = wgm_; }
    __host__ __device__ bool next(int i, Unit& u) const {
        const long L = (long)i * G + c; if (L >= nwg) return false;
        int wgid = (int)L; { const int q = nwg / NXCD, r = nwg % NXCD, xcd = wgid % NXCD, off = wgid / NXCD; wgid = (xcd < r ? xcd * (q + 1) : r * (q + 1) + (xcd - r) * q) + off; }
        const int nig = wgm * nN, gid = wgid / nig, fm = gid * wgm, gsz = (nM - fm) < wgm ? (nM - fm) : wgm;
        u.pm = fm + ((wgid % nig) % gsz); u.pn = (wgid % nig) / gsz; return true;
    }
    __device__ __forceinline__ void a_ready(const Unit&) const {}
    __device__ __forceinline__ void done(const Unit&) const {}
};

__device__ __forceinline__ unsigned cvt_pk_bf16(float lo, float hi) { unsigned r; asm volatile("v_cvt_pk_bf16_f32 %0, %1, %2" : "=v"(r) : "v"(lo), "v"(hi)); return r; }
typedef float f32x2 __attribute__((ext_vector_type(2)));

__device__ __forceinline__ float bf2f(unsigned short b) { return __uint_as_float(((unsigned)b) << 16); }
__device__ __forceinline__ float lo_bf(unsigned w) { return __uint_as_float(w << 16); }
__device__ __forceinline__ float hi_bf(unsigned w) { return __uint_as_float(w & 0xffff0000u); }
__device__ __forceinline__ float fast_sigmoid(float x) { return __builtin_amdgcn_rcpf(1.0f + __expf(-x)); }
typedef unsigned u32x2 __attribute__((ext_vector_type(2)));


#ifndef EPI_SC1
#define EPI_SC1 0
#endif
__device__ __forceinline__ void st16(void* p, u32x4 w) {
#if EPI_SC1
    asm volatile("global_store_dwordx4 %0, %1, off sc1" :: "v"(p), "v"(w) : "memory");
#else
    *(u32x4*)p = w;
#endif
}
__device__ __forceinline__ void row_rstd(const float* ssq, int row0, float (&rs)[2][4]) {
#pragma unroll
    for (int ai = 0; ai < 2; ++ai)
#pragma unroll
        for (int m = 0; m < 4; ++m) { const f32x4* p = (const f32x4*)(ssq + (size_t)(row0 + ai * HALF + m * 16) * 16); const f32x4 a = p[0], b = p[1], c = p[2], d = p[3];
            const float t = ((a[0] + a[1]) + (a[2] + a[3])) + ((b[0] + b[1]) + (b[2] + b[3])) + ((c[0] + c[1]) + (c[2] + c[3])) + ((d[0] + d[1]) + (d[2] + d[3]));
            rs[ai][m] = 1.0f / sqrtf(t * (1.0f / 1024.0f) + 1e-6f); }
}
template <bool RS> struct EpiStore {
    static constexpr bool PERM = true, AFTER_DRAIN = false; static constexpr int NST = 16;
    bf16_t* O; int ldc; const float* ssq;
    __device__ __forceinline__ void operator()(const f32x4 (&acc)[2][2][4][2], const Unit& u, int wr, int wc, int fr, int fq) const {
        const int row0 = u.pm * BM + wr * 64 + fr, col0 = u.pn * BM + wc * 32 + 8 * fq;
        float rs[2][4]; if (RS) row_rstd(ssq, row0, rs);
#pragma unroll
        for (int ai = 0; ai < 2; ++ai)
#pragma unroll
            for (int m = 0; m < 4; ++m) { bf16_t* rowp = O + (size_t)(row0 + ai * HALF + m * 16) * ldc + col0; const float sc = RS ? rs[ai][m] : 1.0f;
#pragma unroll
                for (int bj = 0; bj < 2; ++bj) { const f32x4 v0 = acc[ai][bj][m][0] * sc, v1 = acc[ai][bj][m][1] * sc;
                    u32x4 w; w.x = cvt_pk_bf16(v0[0], v0[1]); w.y = cvt_pk_bf16(v0[2], v0[3]); w.z = cvt_pk_bf16(v1[0], v1[1]); w.w = cvt_pk_bf16(v1[2], v1[3]);
                    st16(rowp + bj * HALF, w);
#if defined(GEMM_EXP) && GEMM_EXP == 3
                    asm volatile("" ::: "memory"); *(volatile u32x4*)(rowp + bj * HALF) = w;
#endif
                } }
    }
};

struct EpiStoreRot {
    static constexpr bool PERM = true, AFTER_DRAIN = false; static constexpr int NST = 16;
    bf16_t* O; const float* cst;
    __device__ __forceinline__ void operator()(const f32x4 (&acc)[2][2][4][2], const Unit& u, int wr, int wc, int fr, int fq) const {
        const int row0 = u.pm * BM + wr * 64 + fr, col0 = u.pn * BM + wc * 32 + 8 * fq, d0 = wc * 32 + 8 * fq;
        const bool rot = u.pn < 8; const float sc = (u.pn >= 4 && u.pn < 8) ? 0.0625f : 1.0f;
#pragma unroll
        for (int ai = 0; ai < 2; ++ai)
#pragma unroll
            for (int m = 0; m < 4; ++m) { const int row = row0 + ai * HALF + m * 16; bf16_t* rowp = O + (size_t)row * 4096 + col0;
                f32x4 v[2][2];
#pragma unroll
                for (int bj = 0; bj < 2; ++bj) { v[bj][0] = acc[ai][bj][m][0]; v[bj][1] = acc[ai][bj][m][1]; }
                if (rot) { const float* cp = cst + (size_t)row * 256 + d0;
#pragma unroll
                    for (int n = 0; n < 2; ++n) { const f32x4 c = *(const f32x4*)(cp + 4 * n), sn = *(const f32x4*)(cp + 128 + 4 * n); const f32x4 x1 = v[0][n], x2 = v[1][n];
                        v[0][n] = (x1 * c - x2 * sn) * sc; v[1][n] = (x2 * c + x1 * sn) * sc; } }
#pragma unroll
                for (int bj = 0; bj < 2; ++bj) { u32x4 w; w.x = cvt_pk_bf16(v[bj][0][0], v[bj][0][1]); w.y = cvt_pk_bf16(v[bj][0][2], v[bj][0][3]); w.z = cvt_pk_bf16(v[bj][1][0], v[bj][1][1]); w.w = cvt_pk_bf16(v[bj][1][2], v[bj][1][3]);
                    *(u32x4*)(rowp + bj * HALF) = w; } }
    }
};
template <bool RS> struct EpiSwiGLU {
    static constexpr bool PERM = true, AFTER_DRAIN = false; static constexpr int NST = 8;
    bf16_t* O; int ldc; const float* ssq;
    __device__ __forceinline__ void operator()(const f32x4 (&acc)[2][2][4][2], const Unit& u, int wr, int wc, int fr, int fq) const {
        const int row0 = u.pm * BM + wr * 64 + fr, col0 = u.pn * HALF + wc * 32 + 8 * fq;
        float rs[2][4]; if (RS) row_rstd(ssq, row0, rs);
#pragma unroll
        for (int ai = 0; ai < 2; ++ai)
#pragma unroll
            for (int m = 0; m < 4; ++m) { bf16_t* rowp = O + (size_t)(row0 + ai * HALF + m * 16) * ldc + col0; const float sc = RS ? rs[ai][m] : 1.0f;
                float h[8];
#pragma unroll
                for (int n = 0; n < 2; ++n)
#pragma unroll
                    for (int j = 0; j < 4; ++j) { const float g = acc[ai][0][m][n][j] * sc, up = acc[ai][1][m][n][j] * sc;
#if defined(GEMM_EXP) && GEMM_EXP == 2
                        h[4 * n + j] = g * (0.5f * (fast_sigmoid(g) + (1.0f - fast_sigmoid(-g)))) * up;
#else
                        h[4 * n + j] = g * fast_sigmoid(g) * up;
#endif
                    }
                u32x4 w; w.x = cvt_pk_bf16(h[0], h[1]); w.y = cvt_pk_bf16(h[2], h[3]); w.z = cvt_pk_bf16(h[4], h[5]); w.w = cvt_pk_bf16(h[6], h[7]);

                st16(rowp, w);
                }
    }
};
template <bool NX> struct EpiResid {
    static constexpr bool PERM = false, AFTER_DRAIN = false; static constexpr int NST = 32;
    const float* base; float* out; int ldc; bf16_t* hb; float* ssq;
    __device__ __forceinline__ void operator()(const f32x4 (&acc)[2][2][4][2], const Unit& u, int wr, int wc, int fr, int fq) const {
        const int row0 = u.pm * BM + wr * 64 + fr, col0 = u.pn * BM + wc * 32 + 4 * fq;
        f32x4 rb[3][4];
#define PG8_RLOAD(g, slot) do { const size_t off_ = (size_t)(row0 + ((g) >> 2) * HALF + ((g) & 3) * 16) * ldc + col0; \
            rb[slot][0] = *(const f32x4*)(base + off_); rb[slot][1] = *(const f32x4*)(base + off_ + 16); rb[slot][2] = *(const f32x4*)(base + off_ + HALF); rb[slot][3] = *(const f32x4*)(base + off_ + HALF + 16); } while (0)
        PG8_RLOAD(0, 0); PG8_RLOAD(1, 1);
#pragma unroll
        for (int g = 0; g < 8; ++g) { const int ai = g >> 2, m = g & 3; const size_t off = (size_t)(row0 + ai * HALF + m * 16) * ldc + col0; float q = 0.f;
            if (g + 2 < 8) PG8_RLOAD(g + 2, (g + 2) % 3);
#pragma unroll
            for (int bj = 0; bj < 2; ++bj)
#pragma unroll
                for (int n = 0; n < 2; ++n) { const f32x4 o = rb[g % 3][bj * 2 + n] + acc[ai][bj][m][n]; *(f32x4*)(out + off + bj * HALF + n * 16) = o;
                    if (NX) { q += (o[0] * o[0] + o[1] * o[1]) + (o[2] * o[2] + o[3] * o[3]); u32x2 w; w.x = cvt_pk_bf16(o[0], o[1]); w.y = cvt_pk_bf16(o[2], o[3]); *(u32x2*)(hb + off + bj * HALF + n * 16) = w; } }
            if (NX) { q += __shfl_xor(q, 16); q += __shfl_xor(q, 32); if (fq == 0) ssq[(size_t)(row0 + ai * HALF + m * 16) * 16 + u.pn * 4 + wc] = q; } }
#undef PG8_RLOAD
    }
};
struct EpiGateA {
    static constexpr bool PERM = true, AFTER_DRAIN = false; static constexpr int NST = 16;
    bf16_t* Y; const float* ssq; const float* gout;
    __device__ __forceinline__ void operator()(const f32x4 (&acc)[2][2][4][2], const Unit& u, int wr, int wc, int fr, int fq) const {
        const int row0 = u.pm * BM + wr * 64 + fr, col0 = u.pn * BM + wc * 32 + 8 * fq;
        f32x4 gv[2][2];
#pragma unroll
        for (int bj = 0; bj < 2; ++bj)
#pragma unroll
            for (int n = 0; n < 2; ++n) gv[bj][n] = *(const f32x4*)(gout + col0 + bj * HALF + 4 * n);
        u32x4 hwb[2][2]; f32x4 spb[2][2];
#define PG8_GLOAD(g, slot) do { const int row_ = row0 + ((g) >> 2) * HALF + ((g) & 3) * 16; const bf16_t* rp_ = Y + (size_t)row_ * 1024 + col0; hwb[slot][0] = *(const u32x4*)rp_; hwb[slot][1] = *(const u32x4*)(rp_ + HALF); \
            spb[slot][0] = *(const f32x4*)(ssq + (size_t)row_ * 32 + u.pn * 8); spb[slot][1] = *(const f32x4*)(ssq + (size_t)row_ * 32 + u.pn * 8 + 4); } while (0)
        PG8_GLOAD(0, 0);
#pragma unroll
        for (int g = 0; g < 8; ++g) { const int ai = g >> 2, m = g & 3, sl = g & 1; const int row = row0 + ai * HALF + m * 16; bf16_t* rowp = Y + (size_t)row * 1024 + col0;
            if (g + 1 < 8) PG8_GLOAD(g + 1, (g + 1) & 1);
            const f32x4 sp = spb[sl][0], sp2 = spb[sl][1];
            const float rstd = 1.0f / sqrtf((((sp[0] + sp[1]) + (sp[2] + sp[3])) + ((sp2[0] + sp2[1]) + (sp2[2] + sp2[3]))) * (1.0f / 256.0f) + 1e-6f);
#pragma unroll
            for (int bj = 0; bj < 2; ++bj) { const u32x4 hw = hwb[sl][bj]; float o[8];
                const unsigned hh[4] = {hw.x, hw.y, hw.z, hw.w};
#pragma unroll
                for (int n = 0; n < 2; ++n)
#pragma unroll
                    for (int j = 0; j < 4; ++j) { const unsigned w = hh[2 * n + (j >> 1)]; const float hv = (j & 1) ? hi_bf(w) : lo_bf(w);
                        o[4 * n + j] = hv * rstd * gv[bj][n][j] * fast_sigmoid(acc[ai][bj][m][n][j]); }
                u32x4 w; w.x = cvt_pk_bf16(o[0], o[1]); w.y = cvt_pk_bf16(o[2], o[3]); w.z = cvt_pk_bf16(o[4], o[5]); w.w = cvt_pk_bf16(o[6], o[7]);
                *(u32x4*)(rowp + bj * HALF) = w; } }
#undef PG8_GLOAD
    }
};
template <bool RS> struct EpiGateC {
    static constexpr bool PERM = true, AFTER_DRAIN = false; static constexpr int NST = 16;
    bf16_t* Y; int ldy; const float* st; const float* gout; const float* hssq;
    __device__ __forceinline__ void operator()(const f32x4 (&acc)[2][2][4][2], const Unit& u, int wr, int wc, int fr, int fq) const {
        const int row0 = u.pm * BM + wr * 64 + fr, col0 = u.pn * BM + wc * 32 + 8 * fq, head = u.pn >> 1;
        float rs[2][4]; if (RS) row_rstd(hssq, row0, rs);
        f32x4 gv[2][2];
#pragma unroll
        for (int bj = 0; bj < 2; ++bj)
#pragma unroll
            for (int n = 0; n < 2; ++n) gv[bj][n] = *(const f32x4*)(gout + col0 + bj * HALF + 4 * n);
        u32x4 hwb[2][2]; f32x4 spb[2][2];
#define PG8_GLOAD(g, slot) do { const int row_ = row0 + ((g) >> 2) * HALF + ((g) & 3) * 16; const bf16_t* rp_ = Y + (size_t)row_ * ldy + col0; hwb[slot][0] = *(const u32x4*)rp_; hwb[slot][1] = *(const u32x4*)(rp_ + HALF); \
            spb[slot][0] = *(const f32x4*)(st + (size_t)row_ * 32 + head * 8); spb[slot][1] = *(const f32x4*)(st + (size_t)row_ * 32 + head * 8 + 4); } while (0)
        PG8_GLOAD(0, 0);
#pragma unroll
        for (int g = 0; g < 8; ++g) { const int ai = g >> 2, m = g & 3, sl = g & 1; const int row = row0 + ai * HALF + m * 16; bf16_t* rowp = Y + (size_t)row * ldy + col0;
            if (g + 1 < 8) PG8_GLOAD(g + 1, (g + 1) & 1);
            const f32x4 s0 = spb[sl][0], s1 = spb[sl][1];
            const float mu = ((s0[0] + s0[2]) + (s1[0] + s1[2])) * (1.0f / 512.0f), ex2 = ((s0[1] + s0[3]) + (s1[1] + s1[3])) * (1.0f / 512.0f);
            const float var = fmaxf(ex2 - mu * mu, 0.f), rstd = 1.0f / sqrtf(var + 1e-6f);
#pragma unroll
            for (int bj = 0; bj < 2; ++bj) { const u32x4 hw = hwb[sl][bj]; float o[8];
                const unsigned hh[4] = {hw.x, hw.y, hw.z, hw.w};
#pragma unroll
                for (int n = 0; n < 2; ++n)
#pragma unroll
                    for (int j = 0; j < 4; ++j) { const unsigned w = hh[2 * n + (j >> 1)]; const float hv = (j & 1) ? hi_bf(w) : lo_bf(w); const float a = RS ? acc[ai][bj][m][n][j] * rs[ai][m] : acc[ai][bj][m][n][j];
                        o[4 * n + j] = (hv - mu) * rstd * gv[bj][n][j] * (a * fast_sigmoid(a)); }
                u32x4 w; w.x = cvt_pk_bf16(o[0], o[1]); w.y = cvt_pk_bf16(o[2], o[3]); w.z = cvt_pk_bf16(o[4], o[5]); w.w = cvt_pk_bf16(o[6], o[7]);
                *(u32x4*)(rowp + bj * HALF) = w; } }
#undef PG8_GLOAD
    }
};
struct EpiLru {
    static constexpr bool PERM = true, AFTER_DRAIN = false; static constexpr int NST = 16;
    const bf16_t* XC; bf16_t* LA; bf16_t* BT; const float* bgall; const float* sp;
    __device__ __forceinline__ void operator()(const f32x4 (&acc)[2][2][4][2], const Unit& u, int wr, int wc, int fr, int fq) const {
        const int blk = u.pn >> 1; const float* bg = bgall + blk * 512;
        const int row0 = u.pm * BM + wr * 64 + fr, cb = (u.pn & 1) * HALF + wc * 32 + 8 * fq, ch0 = blk * 256 + cb;
        u32x4 xwb[2]; xwb[0] = *(const u32x4*)(XC + (size_t)row0 * 1024 + ch0);
#pragma unroll
        for (int g = 0; g < 8; ++g) { const int ai = g >> 2, m = g & 3; const size_t off = (size_t)(row0 + ai * HALF + m * 16) * 1024 + ch0;
                if (g + 1 < 8) xwb[(g + 1) & 1] = *(const u32x4*)(XC + (size_t)(row0 + ((g + 1) >> 2) * HALF + ((g + 1) & 3) * 16) * 1024 + ch0);
                const u32x4 xw = xwb[g & 1]; const unsigned xx[4] = {xw.x, xw.y, xw.z, xw.w};
                unsigned lw[4], bw[4];
#pragma unroll
                for (int n = 0; n < 2; ++n) { const f32x4 br = *(const f32x4*)(bg + cb + 4 * n), bi = *(const f32x4*)(bg + 256 + cb + 4 * n), spv = *(const f32x4*)(sp + ch0 + 4 * n); float la[4], bt[4];
#pragma unroll
                    for (int j = 0; j < 4; ++j) { const int q = 4 * n + j; const unsigned w = xx[q >> 1]; const float xc = (q & 1) ? hi_bf(w) : lo_bf(w);
                        const float r = fast_sigmoid(acc[ai][0][m][n][j] + br[j]), ig = fast_sigmoid(acc[ai][1][m][n][j] + bi[j]);
                        const float l = -8.0f * r * spv[j]; la[j] = l; bt[j] = sqrtf(fmaxf(1.0f - __expf(2.0f * l), 0.f)) * ig * xc; }
                    lw[2 * n] = cvt_pk_bf16(la[0], la[1]); lw[2 * n + 1] = cvt_pk_bf16(la[2], la[3]); bw[2 * n] = cvt_pk_bf16(bt[0], bt[1]); bw[2 * n + 1] = cvt_pk_bf16(bt[2], bt[3]); }
                u32x4 w; w.x = lw[0]; w.y = lw[1]; w.z = lw[2]; w.w = lw[3]; *(u32x4*)(LA + off) = w;
                w.x = bw[0]; w.y = bw[1]; w.z = bw[2]; w.w = bw[3]; *(u32x4*)(BT + off) = w; }
    }
};

template <class Epi, class Sched, bool ALIGN_EPI = false, bool SP2 = false>
__device__ __forceinline__ void gemm_phase(PG8_LAS unsigned char* lds, const Gemm g, const Sched& S, const Epi& E) {
    int tid_ = threadIdx.x; asm volatile("" : "+v"(tid_));
    const int tid = tid_, wid = __builtin_amdgcn_readfirstlane(tid >> 6), lane = tid & 63, wr = wid >> 2, wc = wid & 3, fr = lane & 15, fq = lane >> 4;
    const int K = g.K, nt = K / BK;
    unsigned voffA[2], voffB[2];
#pragma unroll
    for (int i = 0; i < 2; ++i) { int R, C; stage_rc(tid * 16 + i * 8192, R, C); const int Rb = Epi::PERM ? ((R & ~31) + perm32(R & 31)) : R;
        voffA[i] = (unsigned)(R * g.lda + C) * 2u; voffB[i] = (unsigned)(Rb * g.ldb + C) * 2u; }
    const size_t kstep = (size_t)(BK * 2);
    const size_t hstepA = (size_t)HALF * g.lda * 2, hstepB = (size_t)HALF * g.ldb * 2;
    const size_t tstepA = 2 * hstepA, tstepB = 2 * hstepB;
    const unsigned ldsw = (unsigned)wid * 1024u;
    const int aoff = lds_byte(wr * 64 + fr, fq * 8), boff = lds_byte(wc * 32 + fr, fq * 8);
#define PG8_SA(b, h) (((b) * 2 + (h)) * HTB)
#define PG8_SB(b, h) ((4 + (b) * 2 + (h)) * HTB)
#define PG8_STAGE(bufoff, gbase, voff) do { _Pragma("unroll") for (int _i = 0; _i < 2; ++_i) \
        __builtin_amdgcn_global_load_lds((const unsigned*)((const char*)(gbase) + (voff)[_i]), (PG8_LAS unsigned*)(lds + (bufoff) + ldsw + _i * 8192), 16, 0, 0); } while (0)
#define PG8_LDA(dst, b, h) do { _Pragma("unroll") for (int m = 0; m < 4; ++m) _Pragma("unroll") for (int k = 0; k < 2; ++k) dst[m][k] = *(const PG8_LAS bf16x8*)(lds + PG8_SA(b, h) + aoff + m * 2048 + k * 1024); } while (0)
#define PG8_LDB(dst, b, h) do { _Pragma("unroll") for (int n = 0; n < 2; ++n) _Pragma("unroll") for (int k = 0; k < 2; ++k) dst[n][k] = *(const PG8_LAS bf16x8*)(lds + PG8_SB(b, h) + boff + n * 2048 + k * 1024); } while (0)
#define PG8_MMA(ai, bj, At, Bt) do { __builtin_amdgcn_s_setprio(1); _Pragma("unroll") for (int m = 0; m < 4; ++m) _Pragma("unroll") for (int n = 0; n < 2; ++n) _Pragma("unroll") for (int k = 0; k < 2; ++k) \
        acc[ai][bj][m][n] = __builtin_amdgcn_mfma_f32_16x16x32_bf16(Bt[n][k], At[m][k], acc[ai][bj][m][n], 0, 0, 0); __builtin_amdgcn_s_setprio(0); } while (0)
#define PG8_WAIT_V(n) asm volatile("s_waitcnt vmcnt(" #n ")" ::: "memory")
#ifndef PG8_RELAX
#define PG8_RELAX 0
#endif
#define PG8_WAIT_V8F do { if (PG8_RELAX) asm volatile("s_cmp_eq_u32 %0, 0\n\ts_cbranch_scc1 .Lpg8w%=a\n\ts_waitcnt vmcnt(%1)\n\ts_branch .Lpg8w%=b\n.Lpg8w%=a:\n\ts_waitcnt vmcnt(8)\n.Lpg8w%=b:" :: "s"(relax_), "n"(8 + Epi::NST) : "memory", "scc"); else PG8_WAIT_V(8); } while (0)
#define PG8_WAIT_L(n) asm volatile("s_waitcnt lgkmcnt(" #n ")" ::: "memory")
#define PG8_BAR __builtin_amdgcn_s_barrier()
#define PG8_SCHED __builtin_amdgcn_sched_barrier(0)
    Unit cur, nxt; int ui = 0;
    if (!S.next(0, cur)) return;
    f32x4 acc[2][2][4][2];
#pragma unroll
    for (int a = 0; a < 2; ++a)
#pragma unroll
        for (int b = 0; b < 2; ++b)
#pragma unroll
            for (int m = 0; m < 4; ++m)
#pragma unroll
                for (int n = 0; n < 2; ++n) acc[a][b][m][n] = (f32x4){0.f, 0.f, 0.f, 0.f};
    bf16x8 At[4][2], B0[2][2], B1[2][2];
    const char* cA = (const char*)g.A + (size_t)cur.pm * tstepA + (size_t)((cur.pn >> 1) * g.ablk) * 2; const char* cB = (const char*)g.Bt + (size_t)cur.pn * tstepB;
    S.a_ready(cur);
    if constexpr (SP2) {
        PG8_STAGE(PG8_SB(0, 0), cB, voffB); PG8_STAGE(PG8_SB(0, 1), cB + hstepB, voffB); PG8_STAGE(PG8_SA(0, 0), cA, voffA); PG8_STAGE(PG8_SA(0, 1), cA + hstepA, voffA);
        if (wr == 1) PG8_BAR;
        PG8_WAIT_V(2); PG8_BAR;
        PG8_STAGE(PG8_SB(1, 0), cB + kstep, voffB); PG8_STAGE(PG8_SA(1, 0), cA + kstep, voffA); PG8_STAGE(PG8_SB(1, 1), cB + hstepB + kstep, voffB);
        PG8_WAIT_V(6); PG8_BAR;
    } else {
        PG8_STAGE(PG8_SB(0, 0), cB, voffB); PG8_STAGE(PG8_SA(0, 0), cA, voffA); PG8_STAGE(PG8_SB(0, 1), cB + hstepB, voffB); PG8_STAGE(PG8_SA(0, 1), cA + hstepA, voffA);
        if (wr == 1) PG8_BAR;
        PG8_WAIT_V(4); PG8_BAR;
        PG8_STAGE(PG8_SB(1, 0), cB + kstep, voffB); PG8_STAGE(PG8_SA(1, 0), cA + kstep, voffA); PG8_STAGE(PG8_SB(1, 1), cB + hstepB + kstep, voffB);
        PG8_WAIT_V(6); PG8_BAR;
    }
    for (;;) {
        const bool has_next = S.next(ui + 1, nxt);
        const char* nA = has_next ? (const char*)g.A + (size_t)nxt.pm * tstepA + (size_t)((nxt.pn >> 1) * g.ablk) * 2 : cA; const char* nB = has_next ? (const char*)g.Bt + (size_t)nxt.pn * tstepB : cB;
        for (int t = 0; t < nt; t += 2) {
            const bool last = (t == nt - 2);
            const int relax_ = __builtin_amdgcn_readfirstlane((t == 0 && ui > 0) ? 1 : 0);
            const char* a1 = cA + (size_t)(t + 1) * kstep;
            const char* a2 = last ? nA : cA + (size_t)(t + 2) * kstep; const char* b2 = last ? nB : cB + (size_t)(t + 2) * kstep;
            const char* a3 = a2 + kstep; const char* b3 = b2 + kstep;
            if (last && has_next) S.a_ready(nxt);
            if constexpr (SP2) {
            PG8_LDB(B0, 0, 0); PG8_LDB(B1, 0, 1); PG8_SCHED; PG8_LDA(At, 0, 0); PG8_STAGE(PG8_SA(1, 1), a1 + hstepA, voffA);
            PG8_WAIT_V8F; PG8_WAIT_L(0); PG8_BAR; PG8_MMA(0, 0, At, B0); PG8_MMA(0, 1, At, B1); PG8_BAR; PG8_SCHED;
            PG8_LDA(At, 0, 1); PG8_STAGE(PG8_SB(0, 0), b2, voffB); PG8_STAGE(PG8_SB(0, 1), b2 + hstepB, voffB); PG8_STAGE(PG8_SA(0, 0), a2, voffA);
            PG8_WAIT_V8F; PG8_WAIT_L(0); PG8_BAR; PG8_MMA(1, 0, At, B0); PG8_MMA(1, 1, At, B1); PG8_BAR; PG8_SCHED;
            PG8_LDB(B0, 1, 0); PG8_LDB(B1, 1, 1); PG8_SCHED; PG8_LDA(At, 1, 0); PG8_STAGE(PG8_SA(0, 1), a2 + hstepA, voffA);
            PG8_WAIT_V(8); PG8_WAIT_L(0); PG8_BAR; PG8_MMA(0, 0, At, B0); PG8_MMA(0, 1, At, B1); PG8_BAR; PG8_SCHED;
            PG8_LDA(At, 1, 1); PG8_STAGE(PG8_SB(1, 0), b3, voffB); PG8_STAGE(PG8_SB(1, 1), b3 + hstepB, voffB); PG8_STAGE(PG8_SA(1, 0), a3, voffA);
            PG8_WAIT_V(8); PG8_WAIT_L(0); PG8_BAR; PG8_MMA(1, 0, At, B0); PG8_MMA(1, 1, At, B1); PG8_BAR; PG8_SCHED;
            } else {
            PG8_LDB(B0, 0, 0); PG8_SCHED; PG8_LDA(At, 0, 0); PG8_STAGE(PG8_SA(1, 1), a1 + hstepA, voffA);
            PG8_WAIT_L(8); PG8_BAR; PG8_WAIT_L(0); PG8_MMA(0, 0, At, B0); PG8_BAR; PG8_SCHED;
            PG8_LDB(B1, 0, 1); PG8_STAGE(PG8_SB(0, 0), b2, voffB);
            PG8_BAR; PG8_WAIT_L(0); PG8_MMA(0, 1, At, B1); PG8_BAR;
            PG8_LDA(At, 0, 1); PG8_STAGE(PG8_SA(0, 0), a2, voffA);
            PG8_BAR; PG8_WAIT_L(0); PG8_MMA(1, 0, At, B0); PG8_BAR; PG8_SCHED;
            PG8_STAGE(PG8_SB(0, 1), b2 + hstepB, voffB);
            PG8_WAIT_V(6); PG8_BAR; PG8_MMA(1, 1, At, B1); PG8_BAR;
            PG8_LDB(B0, 1, 0); PG8_SCHED; PG8_LDA(At, 1, 0); PG8_STAGE(PG8_SA(0, 1), a2 + hstepA, voffA);
            PG8_WAIT_L(8); PG8_BAR; PG8_WAIT_L(0); PG8_MMA(0, 0, At, B0); PG8_BAR; PG8_SCHED;
            PG8_LDB(B1, 1, 1); PG8_STAGE(PG8_SB(1, 0), b3, voffB);
            PG8_BAR; PG8_WAIT_L(0); PG8_MMA(0, 1, At, B1); PG8_BAR;
            PG8_LDA(At, 1, 1); PG8_STAGE(PG8_SA(1, 0), a3, voffA);
            PG8_BAR; PG8_WAIT_L(0); PG8_MMA(1, 0, At, B0); PG8_BAR; PG8_SCHED;
            PG8_STAGE(PG8_SB(1, 1), b3 + hstepB, voffB);
            PG8_WAIT_V(6); PG8_BAR; PG8_MMA(1, 1, At, B1); PG8_BAR;
            }
        }
        if constexpr (ALIGN_EPI) { if (wr == 0) PG8_BAR; }
        if constexpr (!Epi::AFTER_DRAIN) { E(acc, cur, wr, wc, fr, fq); S.done(cur); }
        if (!has_next) break;
#pragma unroll
        for (int a = 0; a < 2; ++a)
#pragma unroll
            for (int b = 0; b < 2; ++b)
#pragma unroll
                for (int m = 0; m < 4; ++m)
#pragma unroll
                    for (int n = 0; n < 2; ++n) acc[a][b][m][n] = (f32x4){0.f, 0.f, 0.f, 0.f};
        cur = nxt; cA = nA; cB = nB; ++ui;
        if constexpr (ALIGN_EPI) { if (wr == 1) PG8_BAR; }
    }
    PG8_WAIT_V(0);
    if constexpr (!ALIGN_EPI) { if (wr == 0) PG8_BAR; }
    PG8_BAR;
    if constexpr (Epi::AFTER_DRAIN) { E.fused(acc, cur, wr, wc, fr, fq, lds, wid, lane); S.done(cur); }
#undef PG8_SA
#undef PG8_SB
#undef PG8_STAGE
#undef PG8_LDA
#undef PG8_LDB
#undef PG8_MMA
#undef PG8_WAIT_V
#undef PG8_WAIT_V8F
#undef PG8_WAIT_L
#undef PG8_BAR
#undef PG8_SCHED
}
}
#define GAS __attribute__((address_space(1)))
#define LAS __attribute__((address_space(3)))
typedef unsigned short bf16;
typedef unsigned v4u __attribute__((ext_vector_type(4)));
typedef float f32x4 __attribute__((ext_vector_type(4)));
typedef short bf16x8 __attribute__((ext_vector_type(8)));
typedef GAS unsigned gu32;
typedef GAS unsigned long long gu64;
#define RLX_AGENT __ATOMIC_RELAXED, __HIP_MEMORY_SCOPE_AGENT
#define LDS_WAIT() asm volatile("s_waitcnt lgkmcnt(0)" ::: "memory")
#define VM_WAIT() asm volatile("s_waitcnt vmcnt(0)" ::: "memory")
__device__ __forceinline__ unsigned long long rt() { return __builtin_amdgcn_s_memrealtime(); }
__device__ __forceinline__ unsigned f2bf(float f) { unsigned u = __builtin_bit_cast(unsigned, f); return (u + 0x7fffu + ((u >> 16) & 1u)) >> 16; }
__device__ __forceinline__ unsigned pk2(float lo, float hi) { return f2bf(lo) | (f2bf(hi) << 16); }

#define XB_TMO      128
#define XB_XCNT(j)  (256  + 64 * (j))
#define XB_XSUB(j)  (1280 + 64 * (j))
#define XB_XGEN(j)  (2304 + 64 * (j))
#define XB_TOP      3328
#define XB_TOPGEN   3392
#define XCD_BAR_WORDS 3456
#define XB_SPIN_CAP (1u << 18)

__device__ __forceinline__ unsigned xb_ld(unsigned* p)              { return __hip_atomic_load(p, __ATOMIC_RELAXED, __HIP_MEMORY_SCOPE_AGENT); }
__device__ __forceinline__ unsigned xb_add(unsigned* p, unsigned v) { return __hip_atomic_fetch_add(p, v, __ATOMIC_RELAXED, __HIP_MEMORY_SCOPE_AGENT); }
__device__ __forceinline__ unsigned xb_xcc_id() { return (unsigned)__builtin_amdgcn_s_getreg((3 << 11) | 20) & 0xFu; }
#define XB_SPIN(cond, bar) do { unsigned _sp = 0; while (cond) { __builtin_amdgcn_s_sleep(1); \
    if ((++_sp & 255u) == 0u) { if (xb_ld(&(bar)[XB_TMO])) break; if (_sp > XB_SPIN_CAP) { atomicAdd(&(bar)[XB_TMO], 1u); break; } } } } while (0)

struct XcdBarrier {
    unsigned* bar; unsigned x;
    volatile LAS unsigned* st;
};

__device__ __forceinline__ XcdBarrier xcd_barrier_post(unsigned* bar, volatile LAS unsigned* st) {
    XcdBarrier b; b.bar = bar; b.x = xb_xcc_id(); b.st = st;
    if (threadIdx.x == 0) (void)xb_add(&bar[XB_XCNT(b.x)], 1u);
    return b;
}
__device__ __forceinline__ void xcd_barrier_complete(unsigned* bar, unsigned x, unsigned& nloc, unsigned& nx) {
    const unsigned G = gridDim.x * gridDim.y * gridDim.z;
    unsigned sum, cnt, mine, sp = 0u;
    for (;;) {
        sum = 0u; cnt = 0u; mine = 0u;
#pragma unroll
        for (unsigned j = 0; j < 16; ++j) { const unsigned c = xb_ld(&bar[XB_XCNT(j)]); sum += c; cnt += (c > 0u) ? 1u : 0u; mine = (j == x) ? c : mine; }
        if (sum == G) break;
        __builtin_amdgcn_s_sleep(1);
        if ((++sp & 255u) == 0u) { if (xb_ld(&bar[XB_TMO])) break; if (sp > XB_SPIN_CAP) { atomicAdd(&bar[XB_TMO], 1u); break; } }
    }
    nloc = mine > 0u ? mine : 1u; nx = cnt > 0u ? cnt : 1u;
}

__device__ __forceinline__ void xcd_barrier(const XcdBarrier& b) {
    asm volatile("s_waitcnt vmcnt(0)" ::: "memory");
    __syncthreads();
    if (threadIdx.x == 0) {
        unsigned* bar = b.bar;
        __builtin_amdgcn_s_waitcnt(0);
        unsigned nloc = b.st[0], nx = b.st[1];
        if (nloc == 0u) { xcd_barrier_complete(bar, b.x, nloc, nx); b.st[0] = nloc; b.st[1] = nx; }
        const unsigned old = xb_add(&bar[XB_XSUB(b.x)], 1u);
        const unsigned gen = old / nloc;
        if (old + 1u == (gen + 1u) * nloc) {
            __builtin_amdgcn_fence(__ATOMIC_RELEASE, "agent");
            asm volatile("s_waitcnt vmcnt(0)" ::: "memory");
            const unsigned og = xb_add(&bar[XB_TOP], 1u);
            const unsigned tg = og / nx;
            if (og + 1u == (tg + 1u) * nx) xb_add(&bar[XB_TOPGEN], 1u);
            else XB_SPIN(xb_ld(&bar[XB_TOPGEN]) == tg, bar);
            __builtin_amdgcn_fence(__ATOMIC_ACQUIRE, "agent");
            xb_add(&bar[XB_XGEN(b.x)], 1u);
            asm volatile("s_waitcnt vmcnt(0)" ::: "memory");
        } else {
            XB_SPIN(xb_ld(&bar[XB_XGEN(b.x)]) == gen, bar);
            __builtin_amdgcn_fence(__ATOMIC_ACQUIRE, "agent");
            asm volatile("s_waitcnt vmcnt(0)" ::: "memory");
        }
    }
    __syncthreads();
}
namespace mattn {
typedef unsigned short bf16;
constexpr int D = 128, NW = 8, QBLK = 32, KVBLK = 64;
constexpr float SCALE = 0.088388347648318440f, THR = 8.f;
constexpr int LDQ = 3072, LDK = 3072, LDO = 1024;
constexpr size_t SHM_V = KVBLK * D * 2, SHM_K = KVBLK * D * 2, SHM_ATTN = 2 * SHM_V + 2 * SHM_K + NW * 64 * 4;
using bf16x8 = __attribute__((ext_vector_type(8))) short;
using s16x4  = __attribute__((ext_vector_type(4))) short;
using f32x16 = __attribute__((ext_vector_type(16))) float;
using u32x4  = __attribute__((ext_vector_type(4))) unsigned;
#define KSWZ(row, colB) ((row) * 256 + ((colB) ^ (((row) & 7) << 4)))
#define SBAR() __builtin_amdgcn_sched_barrier(0)
__device__ __forceinline__ int crow(int r, int hi) { return (r & 3) + 8 * (r >> 2) + 4 * hi; }
__device__ __forceinline__ unsigned cvtpk(float lo, float hi) { unsigned r; asm volatile("v_cvt_pk_bf16_f32 %0, %1, %2" : "=v"(r) : "v"(lo), "v"(hi)); return r; }
struct Msk { int j; unsigned sel; int qpos; };
__device__ __forceinline__ float sconst(unsigned bits) { return __uint_as_float((unsigned)__builtin_amdgcn_readfirstlane((int)bits)); }
__device__ __forceinline__ void partialSM(f32x16& p0, f32x16& p1, float& m_reg, float& mn, float& alpha, int tile, const Msk& mk, int hi) {
  constexpr float C = SCALE * 1.4426950408889634f;
  const int kb = tile >> 2; const bool own = (kb == mk.j), lsel = own || ((mk.sel >> kb) & 1u);
  float pmax = p0[0];
#pragma unroll
for (int r = 1; r < 16; ++r) pmax = fmaxf(pmax, p0[r]);
#pragma unroll
for (int r = 0; r < 16; ++r) pmax = fmaxf(pmax, p1[r]);
  { auto rr = __builtin_amdgcn_permlane32_swap(__float_as_uint(pmax), __float_as_uint(pmax), false, false);
    pmax = fmaxf(__uint_as_float(rr[0]), __uint_as_float(rr[1])); }
  if (!lsel) pmax = sconst(0xf149f2cau);
  if (__builtin_expect(__all(pmax - m_reg <= THR / SCALE), 1)) { mn = m_reg; alpha = 1.f; }
  else { mn = fmaxf(m_reg, pmax); alpha = __builtin_amdgcn_exp2f((m_reg - mn) * C); m_reg = mn; }
  const float mnC = lsel ? -mn * C : sconst(0xff800000u);
#pragma unroll
for (int r = 0; r < 16; ++r) p0[r] = fmaf(p0[r], C, mnC);
#pragma unroll
for (int r = 0; r < 16; ++r) p1[r] = fmaf(p1[r], C, mnC);
#pragma unroll
for (int r = 0; r < 16; ++r) p0[r] = __builtin_amdgcn_exp2f(p0[r]);
}
__device__ __forceinline__ void finishSM(f32x16& p0, f32x16& p1, float alpha, float& l_reg, bf16x8& pa0, bf16x8& pa1, bf16x8& pa2, bf16x8& pa3) {
#pragma unroll
for (int r = 0; r < 16; ++r) p1[r] = __builtin_amdgcn_exp2f(p1[r]);
  float ps = 0;
#pragma unroll
for (int r = 0; r < 16; ++r) ps += p0[r];
#pragma unroll
for (int r = 0; r < 16; ++r) ps += p1[r];
  { auto rr = __builtin_amdgcn_permlane32_swap(__float_as_uint(ps), __float_as_uint(ps), false, false);
    ps = __uint_as_float(rr[0]) + __uint_as_float(rr[1]); }
  l_reg = l_reg * alpha + ps;
#define PK4(P, BASE, OUT) do { unsigned a0 = cvtpk(P[BASE + 0], P[BASE + 1]), a1 = cvtpk(P[BASE + 2], P[BASE + 3]);   \
    unsigned b0 = cvtpk(P[BASE + 4], P[BASE + 5]), b1 = cvtpk(P[BASE + 6], P[BASE + 7]);                              \
    auto r0 = __builtin_amdgcn_permlane32_swap(a0, b0, false, false); auto r1 = __builtin_amdgcn_permlane32_swap(a1, b1, false, false); \
    u32x4 w = {r0[0], r1[0], r0[1], r1[1]}; OUT = *reinterpret_cast<bf16x8*>(&w); } while (0)
  PK4(p0, 0, pa0); PK4(p0, 8, pa1); PK4(p1, 0, pa2); PK4(p1, 8, pa3);
#undef PK4
}
__device__ __forceinline__ void qkt(f32x16& p0, f32x16& p1, const bf16* Ks, const bf16x8* qr, int r32, int hi, int tile, const Msk& mk) {
  if ((tile >> 2) == mk.j) { const float NEGB = sconst(0xf149f2cau); int qp = mk.qpos - (tile & 3) * 64; asm volatile("" : "+v"(qp));
#pragma unroll
    for (int r = 0; r < 16; ++r) { const int k0 = crow(r, hi); p0[r] = (k0 > qp) ? NEGB : 0.f; p1[r] = (k0 + 32 > qp) ? NEGB : 0.f; } }
  else { p0 = f32x16{}; p1 = f32x16{}; }
#pragma unroll
for (int d0 = 0; d0 < 8; ++d0) { int cb = (d0 * 16 + hi * 8) * 2;
    bf16x8 b0 = *reinterpret_cast<const bf16x8*>((const char*)Ks + KSWZ(r32, cb));
    bf16x8 b1 = *reinterpret_cast<const bf16x8*>((const char*)Ks + KSWZ(32 + r32, cb));
    p0 = __builtin_amdgcn_mfma_f32_32x32x16_bf16(b0, qr[d0], p0, 0, 0, 0);
    p1 = __builtin_amdgcn_mfma_f32_32x32x16_bf16(b1, qr[d0], p1, 0, 0, 0); }
}
__device__ __forceinline__ int v_st(int k, int c) { const int kk = (k & ~0xC) | ((k & 4) << 1) | ((k & 8) >> 1); return ((kk >> 3) * 4 + (c >> 5)) * 512 + ((kk & 7) * 32 + (c & 31)) * 2; }
__device__ __forceinline__ int v_rd_base(int lane) { return ((lane & 3) << 3) | (((lane >> 2) & 3) << 6) | (((lane >> 4) & 1) << 5) | (((lane >> 5) & 1) << 8); }
constexpr int v_rd_off(int d0, int ks, int half) { return d0 * 512 + ks * 4096 + half * 2048; }
template <int OFF> __device__ __forceinline__ s16x4 tr_read(int vb) { s16x4 r; asm volatile("ds_read_b64_tr_b16 %0, %1 offset:%2" : "=&v"(r) : "v"(vb), "i"(OFF) : "memory"); return r; }
template <int D0> __device__ __forceinline__ void pv_one(f32x16& od, int vb, bf16x8 pa0, bf16x8 pa1, bf16x8 pa2, bf16x8 pa3) {
  const s16x4 l0 = tr_read<v_rd_off(D0, 0, 0)>(vb), h0 = tr_read<v_rd_off(D0, 0, 1)>(vb), l1 = tr_read<v_rd_off(D0, 1, 0)>(vb), h1 = tr_read<v_rd_off(D0, 1, 1)>(vb);
  const s16x4 l2 = tr_read<v_rd_off(D0, 2, 0)>(vb), h2 = tr_read<v_rd_off(D0, 2, 1)>(vb), l3 = tr_read<v_rd_off(D0, 3, 0)>(vb), h3 = tr_read<v_rd_off(D0, 3, 1)>(vb);
  asm volatile("s_waitcnt lgkmcnt(0)" ::: "memory"); SBAR();
#define PK(L, H) (bf16x8){L[0], L[1], L[2], L[3], H[0], H[1], H[2], H[3]}
  od = __builtin_amdgcn_mfma_f32_32x32x16_bf16(pa0, PK(l0, h0), od, 0, 0, 0);
  od = __builtin_amdgcn_mfma_f32_32x32x16_bf16(pa1, PK(l1, h1), od, 0, 0, 0);
  od = __builtin_amdgcn_mfma_f32_32x32x16_bf16(pa2, PK(l2, h2), od, 0, 0, 0);
  od = __builtin_amdgcn_mfma_f32_32x32x16_bf16(pa3, PK(l3, h3), od, 0, 0, 0);
#undef PK
}
__device__ __forceinline__ void pv_d0(f32x16* o, int vb, bf16x8 pa0, bf16x8 pa1, bf16x8 pa2, bf16x8 pa3) {
  pv_one<0>(o[0], vb, pa0, pa1, pa2, pa3); pv_one<1>(o[1], vb, pa0, pa1, pa2, pa3); pv_one<2>(o[2], vb, pa0, pa1, pa2, pa3); pv_one<3>(o[3], vb, pa0, pa1, pa2, pa3);
}
__device__ __forceinline__ void body(const bf16x8 (&qr)[8], const bf16* __restrict__ Kh, const bf16* __restrict__ Vh, bf16* __restrict__ Ob, int seq, char* lds, const Msk mk) {
  int tid_ = threadIdx.x; asm volatile("" : "+v"(tid_));
  const int tid = tid_, wid = tid >> 6, lane = tid & 63, r32 = lane & 31, hi = lane >> 5;
  bf16* V_lds = (bf16*)lds; bf16* K_lds = (bf16*)(lds + 2 * SHM_V);
  float* ws = (float*)(lds + 2 * SHM_V + 2 * SHM_K) + wid * 64; float* li_l = ws; float* al_l = ws + 32;
  float m_reg = -1e30f, l_reg = 0; f32x16 o[4] = {};
#define VB0() ({ int l2_ = lane; asm volatile("" : "+v"(l2_)); (int)(uintptr_t)V_lds + v_rd_base(l2_); })
  struct { bf16x8 vs0, vs1, ks0, ks1; } sr_[1];
#define STG_IDX() int t2_ = tid; asm volatile("" : "+v"(t2_)); const int sr = t2_ >> 4, sc = (t2_ & 15) * 8
#define SLOAD(i, k0) do { STG_IDX(); const unsigned goff0 = (unsigned)((sr * LDK + sc) * 2), goff1 = (unsigned)(((32 + sr) * LDK + sc) * 2); \
    const char* vb_ = (const char*)(Vh + (long)(k0) * LDK); const char* kb_ = (const char*)(Kh + (long)(k0) * LDK); \
    sr_[i].vs0 = *(const bf16x8*)(vb_ + goff0); sr_[i].vs1 = *(const bf16x8*)(vb_ + goff1); sr_[i].ks0 = *(const bf16x8*)(kb_ + goff0); sr_[i].ks1 = *(const bf16x8*)(kb_ + goff1); } while (0)
#define SWRITE(b, i) do { STG_IDX(); const int vst0 = v_st(sr, sc), vst1 = v_st(32 + sr, sc); *(bf16x8*)((char*)V_lds + (b) * SHM_V + vst0) = sr_[i].vs0; *(bf16x8*)((char*)V_lds + (b) * SHM_V + vst1) = sr_[i].vs1; int kc = sc * 2; \
    *(bf16x8*)((char*)K_lds + (b) * SHM_K + KSWZ(sr, kc)) = sr_[i].ks0; *(bf16x8*)((char*)K_lds + (b) * SHM_K + KSWZ(32 + sr, kc)) = sr_[i].ks1; } while (0)
#define SWAIT() asm volatile("s_waitcnt vmcnt(0)" ::: "memory")
#define RESC(a) do { if (__any((a) < 1.f)) { if (hi == 0) al_l[r32] = (a); asm volatile("s_waitcnt lgkmcnt(0)" ::: "memory"); \
    _Pragma("unroll") for (int d = 0; d < 4; ++d) _Pragma("unroll") for (int r = 0; r < 16; ++r) o[d][r] *= al_l[crow(r, hi)]; } } while (0)
  f32x16 pA0, pA1, pB0, pB1; float mnA, mnB, alA, alB; bf16x8 pa0, pa1, pa2, pa3; const int NT = seq / KVBLK;
  constexpr int SE = 0, SO = 0;
  SLOAD(SE, 0); asm volatile("s_waitcnt vmcnt(0)" ::: "memory"); SWRITE(0, SE); __syncthreads();
  qkt(pA0, pA1, K_lds, qr, r32, hi, 0, mk); partialSM(pA0, pA1, m_reg, mnA, alA, 0, mk, hi);
  SLOAD(SO, KVBLK);
  SWAIT(); SWRITE(1, SO); __syncthreads();
#pragma unroll 1
  for (int j = 1; j + 1 < NT; j += 2) {
    SBAR(); qkt(pB0, pB1, (bf16*)((char*)K_lds + SHM_K), qr, r32, hi, j, mk);
    finishSM(pA0, pA1, alA, l_reg, pa0, pa1, pa2, pa3); SBAR();
    SLOAD(SO, (j + 1) * KVBLK); SBAR();
    pv_d0(o, VB0(), pa0, pa1, pa2, pa3); partialSM(pB0, pB1, m_reg, mnB, alB, j, mk, hi);
    __syncthreads(); SWAIT(); SWRITE(0, SE);
    RESC(alB); __syncthreads();
    SBAR(); qkt(pA0, pA1, K_lds, qr, r32, hi, j + 1, mk);
    finishSM(pB0, pB1, alB, l_reg, pa0, pa1, pa2, pa3); SBAR();
    SLOAD(SE, (j + 2) * KVBLK); SBAR();
    pv_d0(o, VB0() + (int)SHM_V, pa0, pa1, pa2, pa3); partialSM(pA0, pA1, m_reg, mnA, alA, j + 1, mk, hi);
    __syncthreads(); SWAIT(); SWRITE(1, SO);
    RESC(alA); __syncthreads();
  }
  SBAR(); qkt(pB0, pB1, (bf16*)((char*)K_lds + SHM_K), qr, r32, hi, NT - 1, mk);
  finishSM(pA0, pA1, alA, l_reg, pa0, pa1, pa2, pa3); SBAR();
  pv_d0(o, VB0(), pa0, pa1, pa2, pa3); partialSM(pB0, pB1, m_reg, mnB, alB, NT - 1, mk, hi);
  __syncthreads(); RESC(alB);
  finishSM(pB0, pB1, alB, l_reg, pa0, pa1, pa2, pa3); SBAR();
  pv_d0(o, VB0() + (int)SHM_V, pa0, pa1, pa2, pa3);
  if (hi == 0) li_l[r32] = l_reg; asm volatile("s_waitcnt lgkmcnt(0)" ::: "memory");
  float rli[16];
#pragma unroll
for (int r = 0; r < 16; ++r) rli[r] = __builtin_amdgcn_rcpf(li_l[crow(r, hi)]);
  bf16* Ow = Ob + (long)(wid * QBLK) * LDO;
#pragma unroll
for (int r = 0; r < 16; ++r) { int orow = crow(r, hi);
#pragma unroll
for (int d0 = 0; d0 < 4; ++d0) { const float v = o[d0][r] * rli[r]; unsigned u = __float_as_uint(v); u = (u + 0x7fffu + ((u >> 16) & 1u)) >> 16; Ow[(long)orow * LDO + d0 * 32 + r32] = (bf16)u; } }
#undef SLOAD
#undef VB0
#undef STG_IDX
#undef SWRITE
#undef SWAIT
#undef RESC
}
#undef KSWZ
#undef SBAR
}


constexpr int NWAVES = 8, NTHR = 512;
constexpr int MTOK = 32768, DM = 1024, SEQ = 2048, NB = 16, DFF = 2816;
constexpr size_t MiB = 1u << 20;
constexpr size_t WS_CTL = 0, CTL_ZERO_BYTES = 64 * 1024;
constexpr size_t WS_W_MIXIN = 1 * MiB, WS_W_MIXOUT = 13 * MiB, WS_W_FFNIN = 17 * MiB, WS_W_FFNOUT = 28 * MiB;
constexpr size_t WS_GATESA = 34 * MiB, WS_SSQA = 35 * MiB, WS_STATC = 492 * MiB, WS_KMEAN = 41 * MiB, WS_SSQH = 42 * MiB, WS_SPTAB = 33 * MiB + 512 * 1024;
constexpr size_t WS_U = 44 * MiB, WS_BIG = 108 * MiB, WS_END = 500 * MiB;
constexpr int CW_BAR = 1024;
static_assert((CW_BAR + 3456) * 4 <= (int)CTL_ZERO_BYTES, "ctl");
constexpr int LDS_BYTES = 163840, MISC_OFF = 163584;

typedef unsigned u32x4 __attribute__((ext_vector_type(4)));
typedef unsigned u32x2 __attribute__((ext_vector_type(2)));
typedef float f32x2 __attribute__((ext_vector_type(2)));
struct Frame { LAS unsigned char* lds; int tid, lane, wave, G; };
struct Args { const void* in[24]; float* out; unsigned char* ws; int ph_lo, ph_hi; };

__device__ __forceinline__ float wave_sum(float v) {
#pragma unroll
    for (int o = 1; o < 64; o <<= 1) v += __shfl_xor(v, o);
    return v;
}
__device__ __forceinline__ float bf2f(bf16 b) { return __uint_as_float(((unsigned)b) << 16); }
__device__ __forceinline__ float lo_bf(unsigned w) { return __uint_as_float(w << 16); }
__device__ __forceinline__ float hi_bf(unsigned w) { return __uint_as_float(w & 0xffff0000u); }
__device__ __forceinline__ unsigned cvtpk(float lo, float hi) { return pg8::cvt_pk_bf16(lo, hi); }

typedef short v4s16 __attribute__((ext_vector_type(4)));
template <int LD> __device__ __forceinline__ bf16x8 tr_frag(const LAS bf16* T, int r0, int c0, int lane) {
    const int fr = lane & 15, fq = lane >> 4;
    const LAS bf16* a = T + (r0 + 8 * fq + (fr >> 2)) * LD + c0 + 4 * (fr & 3);
    const v4s16 lo = __builtin_amdgcn_ds_read_tr16_b64_v4i16((LAS v4s16*)a);
    const v4s16 hi = __builtin_amdgcn_ds_read_tr16_b64_v4i16((LAS v4s16*)(a + 4 * LD));
    return __builtin_shufflevector(lo, hi, 0, 1, 2, 3, 4, 5, 6, 7);
}
template <int MT, int NT, int K, int LDA, int LDB, bool TA = false, bool TB = false, bool SB = true>
__device__ __forceinline__ void wgemm(f32x4 (&acc)[MT][NT], const LAS bf16* A, const LAS bf16* Bt, int lane) {
    const int fr = lane & 15, fq = lane >> 4;
    const LAS bf16* ap = A + fr * LDA + 8 * fq;
    const LAS bf16* bp = Bt + fr * LDB + 8 * fq;
#pragma unroll
    for (int k0 = 0; k0 < K; k0 += 32) {
        bf16x8 a[MT], b[NT];
#pragma unroll
        for (int i = 0; i < MT; ++i) a[i] = TA ? tr_frag<LDA>(A, k0, 16 * i, lane) : *(const LAS bf16x8*)(ap + 16 * i * LDA + k0);
#pragma unroll
        for (int j = 0; j < NT; ++j) b[j] = TB ? tr_frag<LDB>(Bt, k0, 16 * j, lane) : *(const LAS bf16x8*)(bp + 16 * j * LDB + k0);
#pragma unroll
        for (int i = 0; i < MT; ++i)
#pragma unroll
            for (int j = 0; j < NT; ++j) acc[i][j] = __builtin_amdgcn_mfma_f32_16x16x32_bf16(a[i], b[j], acc[i][j], 0, 0, 0);
        if (SB && MT * NT >= 4) __builtin_amdgcn_sched_barrier(0);
    }
    if (!SB) __builtin_amdgcn_sched_barrier(0);
}

__device__ __forceinline__ int cvt_src_col(int mode, int g0) {
    if (mode == 0) return g0;
    const int pn = g0 >> 8, r = g0 & 255;
    if (mode == 1) return r < 128 ? 128 * pn + r : DFF + 128 * pn + (r - 128);
    return r < 128 ? 128 * pn + r : 256 + 128 * pn + (r - 128);
}
__device__ __forceinline__ void cvt_matrix(Frame& F, const float* W, int ldw, int K, int Np, int mode, bf16* WT, const float* gain = nullptr) {
    LAS float* scr = (LAS float*)(F.lds + F.wave * 16384);
    const int gw = blockIdx.x * NWAVES + F.wave, NGW = F.G * NWAVES, lane = F.lane;
    const int nblk = Np / 32, nitems = (K / 64) * nblk;
    float v[32], vn[32];
#define CVT_LOAD(dst, it) do { const int kb_ = (it) / nblk, nb_ = (it) % nblk, s0_ = cvt_src_col(mode, 32 * nb_); const float* wp_ = W + (size_t)(64 * kb_ + (lane >> 5)) * ldw + s0_ + (lane & 31); \
        _Pragma("unroll") for (int i = 0; i < 32; ++i) dst[i] = wp_[(size_t)(2 * i) * ldw]; } while (0)
    int item = gw;
    if (item < nitems) CVT_LOAD(v, item);
    for (; item < nitems; item += NGW) {
        const int kb = item / nblk, nb = item % nblk, k0 = 64 * kb, n0 = 32 * nb;
        if (item + NGW < nitems) CVT_LOAD(vn, item + NGW);
        if (gain) {
#pragma unroll
            for (int i = 0; i < 32; ++i) v[i] *= gain[k0 + 2 * i + (lane >> 5)]; }
#pragma unroll
        for (int i = 0; i < 32; ++i) scr[(2 * i + (lane >> 5)) * 33 + (lane & 31)] = v[i];
        LDS_WAIT(); asm volatile("" ::: "memory");
        const int c = lane & 7;
#pragma unroll
        for (int j = 0; j < 4; ++j) { const int n = (lane >> 3) + 8 * j; const LAS float* sp = scr + (8 * c) * 33 + n;
            v4u o; o.x = pk2(sp[0 * 33], sp[1 * 33]); o.y = pk2(sp[2 * 33], sp[3 * 33]); o.z = pk2(sp[4 * 33], sp[5 * 33]); o.w = pk2(sp[6 * 33], sp[7 * 33]);
            *(v4u*)(WT + (size_t)(n0 + n) * K + k0 + 8 * c) = o; }
        LDS_WAIT(); asm volatile("" ::: "memory");
#pragma unroll
        for (int i = 0; i < 32; ++i) v[i] = vn[i];
    }
#undef CVT_LOAD
}

template <bool GATES>
__device__ __forceinline__ void norm_phase(Frame& F, const float* src, const float* gain, bf16* dst, const float* wA, const float* bA, float* gout) {
    LAS float* wg = (LAS float*)F.lds;
    if (GATES) {
        for (int i = F.tid; i < 1024 * 8; i += NTHR) wg[i] = wA[(size_t)(i >> 3) * 3080 + 3072 + (i & 7)];
        __syncthreads();
    }
    const int gw = blockIdx.x * NWAVES + F.wave, NGW = F.G * NWAVES, lane = F.lane;
    f32x4 g[4];
#pragma unroll
    for (int j = 0; j < 4; ++j) g[j] = ((const f32x4*)gain)[lane + 64 * j];
    for (int m = gw; m < MTOK; m += NGW) {
        const f32x4* xr = (const f32x4*)(src + (size_t)m * DM) + lane;
        f32x4 v[4]; float s = 0.f;
#pragma unroll
        for (int j = 0; j < 4; ++j) { v[j] = xr[64 * j]; s += (v[j].x * v[j].x + v[j].y * v[j].y) + (v[j].z * v[j].z + v[j].w * v[j].w); }
        const float rstd = 1.0f / sqrtf(wave_sum(s) * (1.0f / DM) + 1e-6f);
        unsigned long long* o8 = (unsigned long long*)(dst + (size_t)m * DM) + lane;
#pragma unroll
        for (int j = 0; j < 4; ++j) { v[j] = v[j] * rstd * g[j];
            o8[64 * j] = (unsigned long long)cvtpk(v[j].x, v[j].y) | ((unsigned long long)cvtpk(v[j].z, v[j].w) << 32); }
        if (GATES) {
            float a[8];
#pragma unroll
            for (int q = 0; q < 8; ++q) a[q] = 0.f;
#pragma unroll
            for (int j = 0; j < 4; ++j)
#pragma unroll
                for (int e = 0; e < 4; ++e) { const int k = 4 * lane + 256 * j + e; const f32x4 w0 = *(const LAS f32x4*)(wg + k * 8), w1 = *(const LAS f32x4*)(wg + k * 8 + 4); const float x = v[j][e];
                    a[0] += x * w0.x; a[1] += x * w0.y; a[2] += x * w0.z; a[3] += x * w0.w; a[4] += x * w1.x; a[5] += x * w1.y; a[6] += x * w1.z; a[7] += x * w1.w; }
#pragma unroll
            for (int q = 0; q < 8; ++q) a[q] = wave_sum(a[q]);
            if (lane == 0) {
#pragma unroll
                for (int q = 0; q < 8; ++q) gout[(size_t)m * 8 + q] = a[q] + bA[q]; }
        }
    }
}

__device__ __forceinline__ void mlstm_pre(Frame& F, const float* gates, float* GT) {
    LAS float* sA = (LAS float*)F.lds, *sPM = sA + 2048, *sBC = sPM + 2048, *sBT = sBC + 2048, *sP63 = sBT + 32, *sM = sP63 + 32;
    const int lane = F.lane, w = F.wave;
    for (int item = blockIdx.x; item < 64; item += F.G) {
        const int b = item >> 2, h = item & 3;
        __syncthreads();
        float gi4[4], gf4[4];
#pragma unroll
        for (int i = 0; i < 4; ++i) { const size_t row = (size_t)b * SEQ + (w + 8 * i) * 64 + lane; gi4[i] = gates[row * 8 + h]; gf4[i] = gates[row * 8 + 4 + h]; }
#pragma unroll
        for (int i = 0; i < 4; ++i) { const int c = w + 8 * i;
            const float gi = gi4[i], gf = gf4[i];
            const float fc = fminf(gf, 0.f) - log1pf(__expf(-fabsf(gf)));
            float bc = fc;
#pragma unroll
            for (int o = 1; o < 64; o <<= 1) { const float t = __shfl_up(bc, o); if (lane >= o) bc += t; }
            const float a = gi - bc; float pm = a;
#pragma unroll
            for (int o = 1; o < 64; o <<= 1) { const float t = __shfl_up(pm, o); if (lane >= o) pm = fmaxf(pm, t); }
            sA[c * 64 + lane] = a; sPM[c * 64 + lane] = pm; sBC[c * 64 + lane] = bc; if (lane == 63) { sBT[c] = bc; sP63[c] = pm; } }
        __syncthreads();
        if (F.tid == 0) { float m = 0.f; for (int c = 0; c < 32; ++c) { sM[c] = m; m = sBT[c] + fmaxf(m, sP63[c]); } }
        __syncthreads();
#pragma unroll
        for (int i = 0; i < 4; ++i) { const int c = w + 8 * i; const float mst = sM[c], Mx = fmaxf(mst, sPM[c * 64 + lane]), Mx63 = fmaxf(mst, sP63[c]);
            float* g = GT + ((size_t)(item * 32 + c)) * 320 + lane;
            g[0] = sA[c * 64 + lane]; g[64] = Mx; g[128] = __expf(mst - Mx); g[192] = __expf(-(sBC[c * 64 + lane] + Mx)); g[256] = __expf(sA[c * 64 + lane] - Mx63); }
    }
}
__device__ __forceinline__ void mlstm_pmat(Frame& F, const bf16* QKV, const float* GT, bf16* PMA, float* DENP) {
    constexpr float SCALE = 0.08838834764831845f;
    LAS bf16* Qs = (LAS bf16*)F.lds;
    LAS bf16* Ks = Qs + 64 * 136;
    LAS bf16* Ps = Ks + 64 * 136;
    LAS float* fA = (LAS float*)(Ps + 64 * 72), *fMX = fA + 64;
    const int tid = F.tid, lane = F.lane, w = F.wave, fr = lane & 15, fq = lane >> 4, wh = w >> 1, wl = w & 1;
    const unsigned qoff0 = (unsigned)((((tid >> 4) * 2048) + (tid & 15) * 8) * 2);
    v4u pQ[2], pK[2]; float pg = 0.f;
    int item = blockIdx.x;
    if (item < 2048) { const int bh = item >> 5, c = item & 31; const char* gq = (const char*)(QKV + ((size_t)(bh >> 2) * SEQ + c * 64) * 2048 + (bh & 3) * 128);
#pragma unroll
        for (int i = 0; i < 2; ++i) { pQ[i] = *(const v4u*)(gq + qoff0 + i * (32 * 2048 * 2)); pK[i] = *(const v4u*)(gq + qoff0 + i * (32 * 2048 * 2) + 1024); }
        if (tid < 128) pg = GT[(size_t)item * 320 + tid]; }
    for (; item < 2048; item += F.G) {
        __syncthreads();
#pragma unroll
        for (int i = 0; i < 2; ++i) { const int id = tid + NTHR * i, row = id >> 4, c8 = id & 15; *(LAS v4u*)(Qs + row * 136 + c8 * 8) = pQ[i]; *(LAS v4u*)(Ks + row * 136 + c8 * 8) = pK[i]; }
        if (tid < 128) fA[tid] = pg;
        const int nit = item + F.G;
        if (nit < 2048) { const int bh = nit >> 5, c = nit & 31; const char* gq = (const char*)(QKV + ((size_t)(bh >> 2) * SEQ + c * 64) * 2048 + (bh & 3) * 128);
#pragma unroll
            for (int i = 0; i < 2; ++i) { pQ[i] = *(const v4u*)(gq + qoff0 + i * (32 * 2048 * 2)); pK[i] = *(const v4u*)(gq + qoff0 + i * (32 * 2048 * 2) + 1024); }
            if (tid < 128) pg = GT[(size_t)nit * 320 + tid]; }
        __syncthreads();
        f32x4 sa[1][2]; sa[0][0] = (f32x4){0.f, 0.f, 0.f, 0.f}; sa[0][1] = sa[0][0];
        wgemm<1, 2, 128, 136, 136>(sa, Qs + 16 * wh * 136, Ks + 32 * wl * 136, lane);
        float rs[4] = {0.f, 0.f, 0.f, 0.f};
#pragma unroll
        for (int e = 0; e < 4; ++e) { const int t = 16 * wh + 4 * fq + e; const float mx = fMX[t];
#pragma unroll
            for (int j = 0; j < 2; ++j) { const int sidx = 32 * wl + 16 * j + fr; const float wgt = (sidx <= t) ? SCALE * __expf(fA[sidx] - mx) : 0.f; const float p = sa[0][j][e] * wgt;
                Ps[t * 72 + sidx] = (bf16)f2bf(p); rs[e] += p; } }
#pragma unroll
        for (int e = 0; e < 4; ++e) { float r = rs[e]; r += __shfl_xor(r, 1); r += __shfl_xor(r, 2); r += __shfl_xor(r, 4); r += __shfl_xor(r, 8); if (fr == 0) DENP[(size_t)item * 128 + wl * 64 + 16 * wh + 4 * fq + e] = r; }
        __syncthreads();
        *(v4u*)(PMA + (size_t)item * 4096 + (tid >> 3) * 64 + (tid & 7) * 8) = *(const LAS v4u*)(Ps + (tid >> 3) * 72 + (tid & 7) * 8);
    }
}
__device__ __forceinline__ void mlstm_core(Frame& F, const bf16* QKV, const float* GT, const bf16* PMA, const float* DENP, bf16* hout, float* ssq) {
    constexpr float SCALE = 0.08838834764831845f;
    LAS bf16* Qs = (LAS bf16*)F.lds;
    LAS bf16* Ks = Qs + 64 * 136;
    LAS bf16* Vs = Ks + 64 * 144;
    LAS bf16* VWs = Vs + 64 * 80;
    LAS bf16* Cb = VWs + 64 * 80;
    LAS bf16* Ps = Cb + 80 * 136;
    LAS bf16* Hs = Ps + 64 * 72;
    const int tid = F.tid, lane = F.lane, w = F.wave, fr = lane & 15, fq = lane >> 4, wh = w >> 1, wl = w & 1;
    const unsigned qoff0 = (unsigned)((((tid >> 4) * 2048) + (tid & 15) * 8) * 2), voff0 = (unsigned)((((tid >> 3) * 2048) + (tid & 7) * 8) * 2);
    for (int item = blockIdx.x; item < 256; item += F.G) {
        const int b = item >> 4, h = (item >> 2) & 3, vs = item & 3, bh = b * 4 + h;
        f32x4 Cacc[1][4], Cn[1][1];
#pragma unroll
        for (int j = 0; j < 4; ++j) Cacc[0][j] = (f32x4){0.f, 0.f, 0.f, 0.f};
        Cn[0][0] = (f32x4){0.f, 0.f, 0.f, 0.f};
        const size_t tb = (size_t)b * SEQ;
        v4u pQ[2], pK[2], pV, pP; float pws, pwc, pwi[4], pem[4], pdn[4];
#define MLSTM_FETCH(cc) do { const size_t t0_ = tb + (size_t)(cc) * 64; const char* gq_ = (const char*)(QKV + t0_ * 2048 + h * 128); const char* gv_ = (const char*)(QKV + t0_ * 2048 + 1024 + h * 256 + vs * 64); \
            _Pragma("unroll") for (int i = 0; i < 2; ++i) { pQ[i] = *(const v4u*)(gq_ + qoff0 + i * (32 * 2048 * 2)); pK[i] = *(const v4u*)(gq_ + qoff0 + i * (32 * 2048 * 2) + 1024); } \
            pV = *(const v4u*)(gv_ + voff0); const size_t it_ = (size_t)(bh * 32 + (cc)); pP = *(const v4u*)(PMA + it_ * 4096 + (tid >> 3) * 64 + (tid & 7) * 8); \
            const float* g_ = GT + it_ * 320; pws = g_[256 + (tid >> 3)]; pwc = g_[128 + 63]; \
            _Pragma("unroll") for (int e = 0; e < 4; ++e) { const int t_ = 16 * wh + 4 * fq + e; pwi[e] = g_[128 + t_]; pem[e] = g_[192 + t_]; pdn[e] = DENP[it_ * 128 + t_] + DENP[it_ * 128 + 64 + t_]; } } while (0)
        MLSTM_FETCH(0);
        for (int c = 0; c < 32; ++c) {
            const size_t t0 = tb + c * 64;
            __syncthreads();
            v4u hprev; if (c > 0) hprev = *(const LAS v4u*)(Hs + (tid >> 3) * 72 + (tid & 7) * 8);
#pragma unroll
            for (int j = 0; j < 4; ++j)
#pragma unroll
                for (int e = 0; e < 4; ++e) Cb[(16 * wh + 4 * fq + e) * 136 + 64 * wl + 16 * j + fr] = (bf16)f2bf(Cacc[0][j][e]);
#pragma unroll
            for (int e = 0; e < 4; ++e) Cb[(64 + 4 * fq + e) * 136 + 16 * w + fr] = (bf16)f2bf(Cn[0][0][e]);
#pragma unroll
            for (int i = 0; i < 2; ++i) { const int id = tid + NTHR * i, row = id >> 4, c8 = id & 15; *(LAS v4u*)(Qs + row * 136 + c8 * 8) = pQ[i]; *(LAS v4u*)(Ks + row * 144 + c8 * 8) = pK[i]; }
            { const int srow = tid >> 3, c8 = tid & 7; const float wsv = pws;
                *(LAS v4u*)(Vs + srow * 80 + c8 * 8) = pV;
                v4u o; o.x = cvtpk(lo_bf(pV.x) * wsv, hi_bf(pV.x) * wsv); o.y = cvtpk(lo_bf(pV.y) * wsv, hi_bf(pV.y) * wsv); o.z = cvtpk(lo_bf(pV.z) * wsv, hi_bf(pV.z) * wsv); o.w = cvtpk(lo_bf(pV.w) * wsv, hi_bf(pV.w) * wsv);
                *(LAS v4u*)(VWs + srow * 80 + c8 * 8) = o;
                if (c8 < 2) { v4u one; one.x = c8 == 0 ? 0x3f80u : 0u; one.y = 0u; one.z = 0u; one.w = 0u; *(LAS v4u*)(Vs + srow * 80 + 64 + c8 * 8) = one;
                    v4u wv; wv.x = c8 == 0 ? (cvtpk(wsv, 0.f) & 0xffffu) : 0u; wv.y = 0u; wv.z = 0u; wv.w = 0u; *(LAS v4u*)(VWs + srow * 80 + 64 + c8 * 8) = wv; }
                *(LAS v4u*)(Ps + srow * 72 + c8 * 8) = pP; }
            float wi[4], em[4], dn[4]; const float wc = pwc;
#pragma unroll
            for (int e = 0; e < 4; ++e) { wi[e] = pwi[e]; em[e] = pem[e]; dn[e] = pdn[e]; }
            if (c < 31) MLSTM_FETCH(c + 1);
            if (c > 0) *(v4u*)(hout + (t0 - 64 + (tid >> 3)) * 1024 + h * 256 + vs * 64 + (tid & 7) * 8) = hprev;
            __syncthreads();
            f32x4 ni[1][2], nx[1][2], nq[1][1]; ni[0][0] = (f32x4){0.f, 0.f, 0.f, 0.f}; ni[0][1] = ni[0][0]; nx[0][0] = ni[0][0]; nx[0][1] = ni[0][0]; nq[0][0] = ni[0][0];
            wgemm<1, 2, 64, 72, 80, false, true>(ni, Ps + 16 * wh * 72, Vs + 32 * wl, lane);
            wgemm<1, 2, 128, 136, 136>(nx, Qs + 16 * wh * 136, Cb + 32 * wl * 136, lane);
            wgemm<1, 1, 128, 136, 136>(nq, Qs + 16 * wh * 136, Cb + 64 * 136, lane);
#pragma unroll
            for (int e = 0; e < 4; ++e) { const int t = 16 * wh + 4 * fq + e;
                const float nqt = __shfl(nq[0][0][e], lane & 48);
                const float den = dn[e] + wi[e] * SCALE * nqt; const float inv = 1.0f / fmaxf(fabsf(den), em[e]); float q2 = 0.f;
#pragma unroll
                for (int j = 0; j < 2; ++j) { const float hv = (ni[0][j][e] + SCALE * wi[e] * nx[0][j][e]) * inv; q2 += hv * hv;
                    Hs[t * 72 + 32 * wl + 16 * j + fr] = (bf16)f2bf(hv); }
                q2 += __shfl_xor(q2, 1); q2 += __shfl_xor(q2, 2); q2 += __shfl_xor(q2, 4); q2 += __shfl_xor(q2, 8);
                if (fr == 0) ssq[(t0 + t) * 32 + (h * 4 + vs) * 2 + wl] = q2; }
#pragma unroll
            for (int j = 0; j < 4; ++j) Cacc[0][j] = Cacc[0][j] * wc;
            Cn[0][0] = Cn[0][0] * wc;
            wgemm<1, 4, 64, 80, 144, true, true>(Cacc, VWs + 16 * wh, Ks + 64 * wl, lane);
            wgemm<1, 1, 64, 80, 144, true, true>(Cn, VWs + 64, Ks + 16 * w, lane);
        }
        __syncthreads();
        *(v4u*)(hout + (tb + 31 * 64 + (tid >> 3)) * 1024 + h * 256 + vs * 64 + (tid & 7) * 8) = *(const LAS v4u*)(Hs + (tid >> 3) * 72 + (tid & 7) * 8);
#undef MLSTM_FETCH
    }
}

__device__ __forceinline__ void moba_prep(Frame& F, bf16* QK, const int* pos, const float* gq, const float* gk, float* kpart) {
    LAS float* part = (LAS float*)F.lds;
    const int lane = F.lane, w = F.wave, c = lane & 15;
    float gqv[8], gkv[8], inv[8];
#pragma unroll
    for (int e = 0; e < 8; ++e) { gqv[e] = gq[c * 8 + e]; gkv[e] = gk[c * 8 + e]; inv[e] = exp2f(-(float)(8 * (c & 1) + e) * (18.931568569324174f / 16.0f)); }
    for (int item = blockIdx.x; item < 256; item += F.G) {
        const int b = item >> 4, blk = (item >> 1) & 7, half = item & 1;
        const size_t row0 = (size_t)b * SEQ + blk * 256 + half * 128 + 16 * w;
        float kacc[2][8];
#pragma unroll
        for (int i = 0; i < 2; ++i)
#pragma unroll
            for (int e = 0; e < 8; ++e) kacc[i][e] = 0.f;
        v4u cur[4], nxt[4];
#pragma unroll
        for (int i4 = 0; i4 < 4; ++i4) cur[i4] = *(const v4u*)(QK + row0 * 3072 + (lane + 64 * i4) * 8);
        for (int t = 0; t < 16; ++t) {
            const size_t row = row0 + t;
            if (t < 15) {
#pragma unroll
                for (int i4 = 0; i4 < 4; ++i4) nxt[i4] = *(const v4u*)(QK + (row + 1) * 3072 + (lane + 64 * i4) * 8); }
            float cs[8], sn[8];
            if (c < 4) { const float ps = (float)pos[row];
#pragma unroll
                for (int e = 0; e < 8; ++e) sincosf(ps * inv[e], &sn[e], &cs[e]); }
            else {
#pragma unroll
                for (int e = 0; e < 8; ++e) { cs[e] = 1.f; sn[e] = 0.f; } }
#pragma unroll
            for (int i4 = 0; i4 < 4; ++i4) {
                const unsigned xw[4] = {cur[i4].x, cur[i4].y, cur[i4].z, cur[i4].w}; float y[8]; float ss = 0.f;
#pragma unroll
                for (int e = 0; e < 4; ++e) { y[2 * e] = lo_bf(xw[e]); y[2 * e + 1] = hi_bf(xw[e]); ss += y[2 * e] * y[2 * e] + y[2 * e + 1] * y[2 * e + 1]; }
                ss += __shfl_xor(ss, 1); ss += __shfl_xor(ss, 2); ss += __shfl_xor(ss, 4); ss += __shfl_xor(ss, 8);
                const float rstd = 1.0f / sqrtf(ss * (1.0f / 128.0f) + 1e-6f);
#pragma unroll
                for (int e = 0; e < 8; ++e) { y[e] = y[e] * rstd * (i4 < 2 ? gqv[e] : gkv[e]); }
#pragma unroll
                for (int e = 0; e < 8; ++e) { const float o = __shfl_xor(y[e], 2); y[e] = (c < 2) ? y[e] * cs[e] - o * sn[e] : (c < 4 ? y[e] * cs[e] + o * sn[e] : y[e]); }
                v4u ov; ov.x = cvtpk(y[0], y[1]); ov.y = cvtpk(y[2], y[3]); ov.z = cvtpk(y[4], y[5]); ov.w = cvtpk(y[6], y[7]);
                *(v4u*)(QK + row * 3072 + (lane + 64 * i4) * 8) = ov;
                if (i4 >= 2) {
#pragma unroll
                    for (int e = 0; e < 8; ++e) kacc[i4 - 2][e] += y[e]; }
            }
#pragma unroll
            for (int i4 = 0; i4 < 4; ++i4) cur[i4] = nxt[i4];
        }
        __syncthreads();
#pragma unroll
        for (int i = 0; i < 2; ++i)
#pragma unroll
            for (int e = 0; e < 8; ++e) part[w * 1024 + i * 512 + lane * 8 + e] = kacc[i][e];
        __syncthreads();
        for (int col = F.tid; col < 1024; col += NTHR) { float sacc = 0.f;
#pragma unroll
            for (int ww = 0; ww < 8; ++ww) sacc += part[ww * 1024 + col];
            kpart[((size_t)(b * 8 + blk) * 2 + half) * 1024 + col] = sacc * (1.0f / 256.0f); }
    }
}
__device__ __forceinline__ void moba_attn(Frame& F, const bf16* QKV, const float* kpart, bf16* O) {
    char* ldsg = (char*)F.lds;
    LAS float* kmS = (LAS float*)(F.lds + mattn::SHM_ATTN);
    for (int it = blockIdx.x; it < 1024; it += F.G) {
        int tid_ = threadIdx.x; asm volatile("" : "+v"(tid_));
        const int tid = tid_, lane = tid & 63, w = __builtin_amdgcn_readfirstlane(tid >> 6), r32 = lane & 31, hi = lane >> 5;
        const int c = it & 255, r = it >> 8, bh = c & 127, typ = c >> 7, b = bh >> 3, h = bh & 7;
        const int jb = (r & 1) ? 7 - (r >> 1) : (r >> 1);
        const int j = typ ? ((r & 1) ? jb - 2 : jb + 2) : jb;
        const size_t qrow0 = (size_t)b * SEQ + j * 256;
        __syncthreads();
        for (int i = tid; i < 1024; i += NTHR) { const int kb_ = i >> 7, d_ = i & 127; const float* kp = kpart + ((size_t)(b * 8 + kb_) * 2) * 1024 + h * 128 + d_; kmS[i] = kp[0] + kp[1024]; }
        mattn::bf16x8 qr[8];
        { const bf16* Qw = QKV + (qrow0 + w * 32 + r32) * 3072 + h * 128 + hi * 8;
#pragma unroll
            for (int d0 = 0; d0 < 8; ++d0) qr[d0] = *(const mattn::bf16x8*)(Qw + d0 * 16); }
        __syncthreads();
        unsigned sel = 0u;
        if (j <= 3) sel = (1u << j) - 1u;
        else { float v0 = -INFINITY, v1 = -INFINITY, v2 = -INFINITY; int i0 = 0, i1 = 0, i2 = 0;
#pragma unroll 1
            for (int blk = 0; blk < j; ++blk) { float sdot = 0.f; const LAS float* km = kmS + blk * 128 + hi * 8;
#pragma unroll
                for (int d0 = 0; d0 < 8; ++d0) asm volatile("" : "+v"(qr[d0]));
#pragma unroll
                for (int d0 = 0; d0 < 8; ++d0) {
#pragma unroll
                    for (int e = 0; e < 8; ++e) sdot += __uint_as_float(((unsigned)(unsigned short)qr[d0][e]) << 16) * km[d0 * 16 + e];
                    __builtin_amdgcn_sched_barrier(0); }
                auto rr = __builtin_amdgcn_permlane32_swap(__float_as_uint(sdot), __float_as_uint(sdot), false, false);
                sdot = __uint_as_float(rr[0]) + __uint_as_float(rr[1]);
                if (sdot > v0) { v2 = v1; i2 = i1; v1 = v0; i1 = i0; v0 = sdot; i0 = blk; }
                else if (sdot > v1) { v2 = v1; i2 = i1; v1 = sdot; i1 = blk; }
                else if (sdot > v2) { v2 = sdot; i2 = blk; } }
            sel = (1u << i0) | (1u << i1) | (1u << i2); }
        const mattn::Msk mk{j, sel, w * 32 + r32};
        const bf16* Kh = QKV + ((size_t)b * SEQ) * 3072 + 1024 + h * 128;
        mattn::body(qr, Kh, Kh + 1024, O + qrow0 * 1024 + h * 128, (j + 1) * 256, ldsg, mk);
    }
}

__device__ __forceinline__ void ret_rot_table(Frame& F, const int* pos, float* cst) {
    const int gw = blockIdx.x * NWAVES + F.wave, NGW = F.G * NWAVES, lane = F.lane;
    const float i0 = exp2f(-(float)(2 * lane) * (13.287712379549449f / 128.0f)), i1 = exp2f(-(float)(2 * lane + 1) * (13.287712379549449f / 128.0f));
    for (int m = gw; m < MTOK; m += NGW) {
        const float ps = (float)pos[m]; float s0, c0, s1, c1; sincosf(ps * i0, &s0, &c0); sincosf(ps * i1, &s1, &c1);
        f32x2* cp = (f32x2*)(cst + (size_t)m * 256) + lane; cp[0] = (f32x2){c0, c1}; cp[64] = (f32x2){s0, s1};
    }
}
__device__ __forceinline__ void ret_pmat(Frame& F, const bf16* QKV, bf16* PM) {
    LAS bf16* Qd = (LAS bf16*)F.lds;
    LAS bf16* Kd = Qd + 128 * 72;
    LAS bf16* Ps = Kd + 128 * 72;
    const int tid = F.tid, lane = F.lane, w = F.wave, fr = lane & 15, fq = lane >> 4, wh = w >> 1, wl = w & 1;
    const unsigned off0 = (unsigned)((((tid >> 3) * 4096) + (tid & 7) * 8) * 2);
    for (int item = blockIdx.x; item < 1024; item += F.G) {
        const int b = item >> 6, h = (item >> 4) & 3, c = item & 15;
        const float lgc = log1pf(-exp2f(-5.0f - (float)h)) * 1.4426950408889634f;
        const char* gq = (const char*)(QKV + ((size_t)b * SEQ + c * 128) * 4096 + h * 256);
        v4u pq[2], pkk[2];
#pragma unroll
        for (int i = 0; i < 2; ++i) { const char* src = gq + off0 + i * (64 * 4096 * 2); pq[i] = *(const v4u*)src; pkk[i] = *(const v4u*)(src + 2048); }
        f32x4 S[2][4];
#pragma unroll
        for (int i = 0; i < 2; ++i)
#pragma unroll
            for (int jj = 0; jj < 4; ++jj) S[i][jj] = (f32x4){0.f, 0.f, 0.f, 0.f};
#pragma unroll 1
        for (int dt = 0; dt < 4; ++dt) {
            __syncthreads();
#pragma unroll
            for (int i = 0; i < 2; ++i) { const int id = tid + NTHR * i, row = id >> 3, c8 = id & 7; *(LAS v4u*)(Qd + row * 72 + c8 * 8) = pq[i]; *(LAS v4u*)(Kd + row * 72 + c8 * 8) = pkk[i]; }
            if (dt < 3) {
#pragma unroll
                for (int i = 0; i < 2; ++i) { const char* src = gq + (dt + 1) * 128 + off0 + i * (64 * 4096 * 2); pq[i] = *(const v4u*)src; pkk[i] = *(const v4u*)(src + 2048); } }
            __syncthreads();
            wgemm<2, 4, 64, 72, 72>(S, Qd + 32 * wh * 72, Kd + 64 * wl * 72, lane);
        }
#pragma unroll
        for (int i = 0; i < 2; ++i)
#pragma unroll
            for (int e = 0; e < 4; ++e) { const int t = 32 * wh + 16 * i + 4 * fq + e;
#pragma unroll
                for (int jj = 0; jj < 4; ++jj) { const int sidx = 64 * wl + 16 * jj + fr; const float wgt = (t >= sidx) ? __builtin_amdgcn_exp2f((float)(t - sidx) * lgc) : 0.f;
                    Ps[t * 136 + sidx] = (bf16)f2bf(S[i][jj][e] * wgt); } }
        __syncthreads();
        bf16* dst = PM + (size_t)item * 128 * 128;
#pragma unroll
        for (int i = 0; i < 4; ++i) { const int id = tid + NTHR * i, row = id >> 4, c8 = id & 15; *(v4u*)(dst + row * 128 + c8 * 8) = *(const LAS v4u*)(Ps + row * 136 + c8 * 8); }
    }
}
#ifndef RET_EXP
#define RET_EXP 0
#endif
__device__ __forceinline__ void ret_core(Frame& F, bf16* QKV, const bf16* PM, float* st) {
    constexpr int TSET = 3 * 128 * 72;
    LAS bf16* T0 = (LAS bf16*)F.lds;
    LAS bf16* Vs = T0 + 2 * TSET;
    LAS bf16* Ps = T0;
    LAS bf16* Xs = T0 + TSET;
    LAS float* fST = (LAS float*)(Vs + 128 * 144);
    const int tid = F.tid, lane = F.lane, w = F.wave, fr = lane & 15, fq = lane >> 4, wh = w >> 1, wl = w & 1;
    const unsigned off8 = (unsigned)((((tid >> 3) * 4096) + (tid & 7) * 8) * 2);
    const unsigned off16 = (unsigned)((((tid >> 4) * 4096) + (tid & 15) * 8) * 2);
    for (int item = blockIdx.x; item < 256; item += F.G) {
        const int b = item >> 4, h = (item >> 2) & 3, vs = item & 3;
        const float lg = log1pf(-exp2f(-5.0f - (float)h)), gch = expf(128.0f * lg);
        f32x4 Racc[4][1][4];
#pragma unroll
        for (int dt = 0; dt < 4; ++dt)
#pragma unroll
            for (int jj = 0; jj < 4; ++jj) Racc[dt][0][jj] = (f32x4){0.f, 0.f, 0.f, 0.f};
        const size_t tb = (size_t)b * SEQ;
        __syncthreads();
        v4u pq[2], pkk[2], pv[4];
        { const char* gq0 = (const char*)(QKV + tb * 4096 + h * 256); const char* gv0 = (const char*)(QKV + tb * 4096 + 2048 + h * 512 + vs * 128);
#pragma unroll
            for (int i = 0; i < 2; ++i) { const char* src = gq0 + off8 + i * (64 * 4096 * 2); pq[i] = *(const v4u*)src; pkk[i] = *(const v4u*)(src + 2048); }
#pragma unroll
            for (int i = 0; i < 4; ++i) pv[i] = *(const v4u*)(gv0 + off16 + i * (32 * 4096 * 2)); }
        for (int c = 0; c < 16; ++c) {
            const size_t t0 = tb + c * 128;
            const char* gq = (const char*)(QKV + t0 * 4096 + h * 256);
            char* gy = (char*)(QKV + t0 * 4096 + 2048 + h * 512 + vs * 128);
            const bf16* pmt = PM + ((size_t)((b * 4 + h) * 16 + c)) * 128 * 128;
            float lgc = lg * 1.4426950408889634f; asm volatile("" : "+v"(lgc));
#pragma unroll
            for (int i = 0; i < 4; ++i) { const int id = tid + NTHR * i; *(LAS v4u*)(Vs + (id >> 4) * 144 + (id & 15) * 8) = pv[i]; }
            f32x4 X[2][4];
#pragma unroll
            for (int i = 0; i < 2; ++i)
#pragma unroll
                for (int jj = 0; jj < 4; ++jj) X[i][jj] = (f32x4){0.f, 0.f, 0.f, 0.f};
#pragma unroll 1
            for (int dt = 0; dt < 4; ++dt) {
                LAS bf16* Qd = T0 + (dt & 1) * TSET; LAS bf16* Kz = Qd + 128 * 72; LAS bf16* Rb = Kz + 128 * 72;
#pragma unroll
                for (int i = 0; i < 2; ++i) { const int id = tid + NTHR * i, row = id >> 3, c8 = id & 7; const float z = __builtin_amdgcn_exp2f((float)(127 - row) * lgc);
                    *(LAS v4u*)(Qd + row * 72 + c8 * 8) = pq[i];
                    v4u zo; zo.x = cvtpk(lo_bf(pkk[i].x) * z, hi_bf(pkk[i].x) * z); zo.y = cvtpk(lo_bf(pkk[i].y) * z, hi_bf(pkk[i].y) * z); zo.z = cvtpk(lo_bf(pkk[i].z) * z, hi_bf(pkk[i].z) * z); zo.w = cvtpk(lo_bf(pkk[i].w) * z, hi_bf(pkk[i].w) * z);
                    *(LAS v4u*)(Kz + row * 72 + c8 * 8) = zo; }
#pragma unroll
                for (int jj = 0; jj < 4; ++jj)
#pragma unroll
                    for (int e = 0; e < 4; ++e) Rb[(16 * w + 4 * fq + e) * 72 + 16 * jj + fr] = (bf16)f2bf(Racc[0][0][jj][e]);
#if RET_EXP == 3
                asm volatile("" ::: "memory");
#pragma unroll
                for (int jj = 0; jj < 4; ++jj)
#pragma unroll
                    for (int e = 0; e < 4; ++e) *(volatile LAS bf16*)(Rb + (16 * w + 4 * fq + e) * 72 + 16 * jj + fr) = (bf16)f2bf(Racc[0][0][jj][e]);
#endif
                if (dt < 3 || c < 15) {
                    const char* nb = (dt < 3) ? gq + (dt + 1) * 128 : gq + (size_t)128 * 4096 * 2;
#pragma unroll
                    for (int i = 0; i < 2; ++i) { const char* src = nb + off8 + i * (64 * 4096 * 2); pq[i] = *(const v4u*)src; pkk[i] = *(const v4u*)(src + 2048); } }
                __syncthreads();
                wgemm<2, 4, 64, 72, 72, false, false, false>(X, Qd + 32 * wh * 72, Rb + 64 * wl * 72, lane);
#if RET_EXP == 5
                { f32x4 D_[2][4];
#pragma unroll
                  for (int i = 0; i < 2; ++i)
#pragma unroll
                    for (int jj = 0; jj < 4; ++jj) D_[i][jj] = (f32x4){0.f, 0.f, 0.f, 0.f};
                  wgemm<2, 4, 64, 72, 72>(D_, Qd + 32 * wh * 72, Rb + 64 * wl * 72, lane);
#pragma unroll
                  for (int i = 0; i < 2; ++i)
#pragma unroll
                    for (int jj = 0; jj < 4; ++jj) asm volatile("" :: "v"(D_[i][jj])); }
#endif
#if RET_EXP == 6
                { f32x4 D_[1][4];
#pragma unroll
                    for (int jj = 0; jj < 4; ++jj) D_[0][jj] = (f32x4){0.f, 0.f, 0.f, 0.f};
                  wgemm<1, 4, 128, 136, 72, true, true>(D_, Vs + 16 * w, Kz, lane);
#pragma unroll
                    for (int jj = 0; jj < 4; ++jj) asm volatile("" :: "v"(D_[0][jj])); }
#endif
#pragma unroll
                for (int jj = 0; jj < 4; ++jj) Racc[0][0][jj] = Racc[0][0][jj] * gch;
                wgemm<1, 4, 128, 144, 72, true, true, false>(Racc[0], Vs + 16 * w, Kz, lane);
#pragma unroll
                for (int jj = 0; jj < 4; ++jj) { const f32x4 t_ = Racc[0][0][jj]; Racc[0][0][jj] = Racc[1][0][jj]; Racc[1][0][jj] = Racc[2][0][jj]; Racc[2][0][jj] = Racc[3][0][jj]; Racc[3][0][jj] = t_; }
            }
            v4u pp[4];
#pragma unroll
            for (int i = 0; i < 4; ++i) { const int id = tid + NTHR * i; pp[i] = *(const v4u*)(pmt + (id >> 4) * 128 + (id & 15) * 8); }
#if RET_EXP == 2
            asm volatile("s_waitcnt vmcnt(0)" ::: "memory");
#pragma unroll
            for (int i = 0; i < 4; ++i) { const int id = tid + NTHR * i; v4u q_ = *(const volatile v4u*)(pmt + 64 * 128 * 128 + (id >> 4) * 128 + (id & 15) * 8); asm volatile("" :: "v"(q_.x), "v"(q_.y), "v"(q_.z), "v"(q_.w)); }
            asm volatile("s_waitcnt vmcnt(0)" ::: "memory");
#endif
#pragma unroll
            for (int i = 0; i < 2; ++i)
#pragma unroll
                for (int e = 0; e < 4; ++e) { const int t = 32 * wh + 16 * i + 4 * fq + e; const float xi = __builtin_amdgcn_exp2f((float)(t + 1) * lgc);
#pragma unroll
                    for (int jj = 0; jj < 4; ++jj) X[i][jj][e] *= xi; }
#pragma unroll
            for (int i = 0; i < 4; ++i) { const int id = tid + NTHR * i; *(LAS v4u*)(Ps + (id >> 4) * 136 + (id & 15) * 8) = pp[i]; }
            __syncthreads();
            wgemm<2, 4, 128, 136, 144, false, true, false>(X, Ps + 32 * wh * 136, Vs + 64 * wl, lane);
#pragma unroll
            for (int i = 0; i < 2; ++i)
#pragma unroll
                for (int e = 0; e < 4; ++e) { const int t = 32 * wh + 16 * i + 4 * fq + e; float s1 = 0.f, s2 = 0.f;
#pragma unroll
                    for (int jj = 0; jj < 4; ++jj) { const float y = X[i][jj][e]; s1 += y; s2 += y * y; Xs[t * 136 + 64 * wl + 16 * jj + fr] = (bf16)f2bf(y); }
                    s1 += __shfl_xor(s1, 1); s1 += __shfl_xor(s1, 2); s1 += __shfl_xor(s1, 4); s1 += __shfl_xor(s1, 8);
                    s2 += __shfl_xor(s2, 1); s2 += __shfl_xor(s2, 2); s2 += __shfl_xor(s2, 4); s2 += __shfl_xor(s2, 8);
                    if (fr == 0) { fST[(wl * 128 + t) * 2] = s1; fST[(wl * 128 + t) * 2 + 1] = s2; } }
            if (c < 15) { const char* gvn = gy + (size_t)128 * 4096 * 2;
#pragma unroll
                for (int i = 0; i < 4; ++i) pv[i] = *(const v4u*)(gvn + off16 + i * (32 * 4096 * 2)); }
            __syncthreads();
#pragma unroll
            for (int i = 0; i < 4; ++i) { const int id = tid + NTHR * i, row = id >> 4, c8 = id & 15; *(v4u*)(gy + (unsigned)((row * 4096 + c8 * 8) * 2)) = *(const LAS v4u*)(Xs + row * 136 + c8 * 8); }
            if (tid < 128) { float* sp = st + (t0 + tid) * 32 + (h * 4 + vs) * 2; sp[0] = fST[tid * 2] + fST[(128 + tid) * 2]; sp[1] = fST[tid * 2 + 1] + fST[(128 + tid) * 2 + 1]; }
        }
    }
}

__device__ __forceinline__ void lru_conv(Frame& F, const bf16* GX, const float* cw, const float* cb, bf16* XC, const float* lru, float* sptab) {
    if (blockIdx.x == 0) for (int i = F.tid; i < 1024; i += NTHR) { const float l = -lru[i]; sptab[i] = fmaxf(l, 0.f) + log1pf(expf(-fabsf(l))); }
    const int c8 = F.tid & 127, rsub = F.tid >> 7;
    f32x4 w0[4], w1[4];
#pragma unroll
    for (int wv = 0; wv < 4; ++wv) { w0[wv] = *(const f32x4*)(cw + wv * 1024 + c8 * 8); w1[wv] = *(const f32x4*)(cw + wv * 1024 + c8 * 8 + 4); }
    const f32x4 b0 = *(const f32x4*)(cb + c8 * 8), b1 = *(const f32x4*)(cb + c8 * 8 + 4);
    for (int r0 = blockIdx.x * 16; r0 < MTOK; r0 += F.G * 16) {
        const int rb = r0 + 4 * rsub, t = rb & (SEQ - 1);
        v4u xin[7];
#pragma unroll
        for (int k = 0; k < 7; ++k) { const int rr = rb - 3 + k; xin[k] = (t - 3 + k >= 0) ? *(const v4u*)(GX + (size_t)rr * 2048 + 1024 + c8 * 8) : (v4u){0u, 0u, 0u, 0u}; }
#pragma unroll
        for (int q = 0; q < 4; ++q) { f32x4 a0 = b0, a1 = b1;
#pragma unroll
            for (int wv = 0; wv < 4; ++wv) { const v4u x = xin[q + wv];
                a0 += (f32x4){lo_bf(x.x), hi_bf(x.x), lo_bf(x.y), hi_bf(x.y)} * w0[wv]; a1 += (f32x4){lo_bf(x.z), hi_bf(x.z), lo_bf(x.w), hi_bf(x.w)} * w1[wv]; }
            v4u o; o.x = cvtpk(a0[0], a0[1]); o.y = cvtpk(a0[2], a0[3]); o.z = cvtpk(a1[0], a1[1]); o.w = cvtpk(a1[2], a1[3]);
            *(v4u*)(XC + (size_t)(rb + q) * 1024 + c8 * 8) = o; }
    }
}
__device__ __forceinline__ float gelu_tanh(float x) { const float z = 0.7978845608028654f * (x + 0.044715f * x * x * x); const float e = __expf(2.0f * z); const float th = 1.0f - 2.0f * __builtin_amdgcn_rcpf(e + 1.0f); return 0.5f * x * (1.0f + th); }
__device__ __forceinline__ void lru_scan(Frame& F, const bf16* LA, const bf16* BT, const bf16* GX, bf16* Y) {
    LAS float* segL = (LAS float*)F.lds;
    LAS float* segH = segL + 512;
    const int lane = F.lane, w = F.wave;
    for (int item = blockIdx.x; item < 256; item += F.G) {
        const int b = item >> 4, ch = (item & 15) * 64 + lane;
        const size_t r0 = (size_t)b * SEQ + w * 256;
        const bf16* la_p = LA + r0 * 1024 + ch; const bf16* bt_p = BT + r0 * 1024 + ch; const bf16* gx_p = GX + r0 * 2048 + ch; bf16* y_p = Y + r0 * 1024 + ch;
        float L = 0.f, H = 0.f;
        bf16 la0[16], bt0[16], la1[16], bt1[16];
#pragma unroll
        for (int k = 0; k < 16; ++k) { la0[k] = la_p[(size_t)k * 1024]; bt0[k] = bt_p[(size_t)k * 1024]; }
#pragma unroll 1
        for (int tb = 0; tb < 16; tb += 2) {
#pragma unroll
            for (int k = 0; k < 16; ++k) { la1[k] = la_p[(size_t)((tb + 1) * 16 + k) * 1024]; bt1[k] = bt_p[(size_t)((tb + 1) * 16 + k) * 1024]; }
#pragma unroll
            for (int k = 0; k < 16; ++k) { const float la = bf2f(la0[k]); L += la; H = __expf(la) * H + bf2f(bt0[k]); }
            if (tb + 2 < 16) {
#pragma unroll
                for (int k = 0; k < 16; ++k) { la0[k] = la_p[(size_t)((tb + 2) * 16 + k) * 1024]; bt0[k] = bt_p[(size_t)((tb + 2) * 16 + k) * 1024]; } }
#pragma unroll
            for (int k = 0; k < 16; ++k) { const float la = bf2f(la1[k]); L += la; H = __expf(la) * H + bf2f(bt1[k]); }
        }
        __syncthreads();
        segL[w * 64 + lane] = L; segH[w * 64 + lane] = H;
        __syncthreads();
        float hc = 0.f;
        for (int sg = 0; sg < w; ++sg) hc = __expf(segL[sg * 64 + lane]) * hc + segH[sg * 64 + lane];
        bf16 g0[16], g1[16];
#pragma unroll
        for (int k = 0; k < 16; ++k) { la0[k] = la_p[(size_t)k * 1024]; bt0[k] = bt_p[(size_t)k * 1024]; g0[k] = gx_p[(size_t)k * 2048]; }
#pragma unroll
        for (int k = 0; k < 16; ++k) { const size_t t = (size_t)(16 + k); la1[k] = la_p[t * 1024]; bt1[k] = bt_p[t * 1024]; g1[k] = gx_p[t * 2048]; }
#pragma unroll 1
        for (int tb = 0; tb < 16; tb += 2) {
            bf16 yv[16];
#pragma unroll
            for (int k = 0; k < 16; ++k) { hc = __expf(bf2f(la0[k])) * hc + bf2f(bt0[k]); yv[k] = (bf16)f2bf(hc * gelu_tanh(bf2f(g0[k]))); }
            if (tb + 2 < 16) {
#pragma unroll
                for (int k = 0; k < 16; ++k) { const size_t t = (size_t)((tb + 2) * 16 + k); la0[k] = la_p[t * 1024]; bt0[k] = bt_p[t * 1024]; g0[k] = gx_p[t * 2048]; } }
#pragma unroll
            for (int k = 0; k < 16; ++k) y_p[(size_t)(tb * 16 + k) * 1024] = yv[k];
#pragma unroll
            for (int k = 0; k < 16; ++k) { hc = __expf(bf2f(la1[k])) * hc + bf2f(bt1[k]); yv[k] = (bf16)f2bf(hc * gelu_tanh(bf2f(g1[k]))); }
            if (tb + 3 < 16) {
#pragma unroll
                for (int k = 0; k < 16; ++k) { const size_t t = (size_t)((tb + 3) * 16 + k); la1[k] = la_p[t * 1024]; bt1[k] = bt_p[t * 1024]; g1[k] = gx_p[t * 2048]; } }
#pragma unroll
            for (int k = 0; k < 16; ++k) y_p[(size_t)((tb + 1) * 16 + k) * 1024] = yv[k];
        }
    }
}

#ifndef WGM_BIG
#define WGM_BIG 8
#endif
#ifndef WGM_N4
#define WGM_N4 4
#endif
#ifndef WGM_MID
#define WGM_MID 8
#endif
template <class Epi>
__device__ __forceinline__ void run_gemm(Frame& F, const bf16* A, int lda, const bf16* Bt, int ldb, int N, int K, const Epi& E, int M = MTOK, int ablk = 0) {
    pg8::Gemm g{A, Bt, M, N, K, lda, ldb, ablk}; pg8::StaticOrder S; S.init(M, N, F.G, (int)blockIdx.x, (N >= 4096) ? WGM_BIG : (N <= 1024 ? WGM_N4 : WGM_MID));
#ifndef STAGGER_NG
#define STAGGER_NG 1
#endif
#ifndef STAGGER_STEP
#define STAGGER_STEP 300
#endif
    if (STAGGER_NG > 1 && N >= 4096 && M == MTOK) {
        const unsigned grp = (((unsigned)blockIdx.x >> 3) & 7u) / (8 / STAGGER_NG);
        if (grp) { const unsigned long long t0 = __builtin_amdgcn_s_memrealtime(), dl = (unsigned long long)grp * STAGGER_STEP;
            while (__builtin_amdgcn_s_memrealtime() - t0 < dl) __builtin_amdgcn_s_sleep(8); }
    }
#ifndef FUSE_NX
#define FUSE_NX false
#endif
#ifndef GEMM_ALIGN
#define GEMM_ALIGN true
#endif
#ifndef GEMM_SP2
#define GEMM_SP2 true
#endif
    pg8::gemm_phase<Epi, pg8::StaticOrder, GEMM_ALIGN, GEMM_SP2>(F.lds, g, S, E);
}

typedef const __attribute__((address_space(4))) struct Args* ArgsP;
constexpr int NPHASE = 35;
__device__ __forceinline__ ArgsP get_args() { ArgsP p = (ArgsP)__builtin_amdgcn_kernarg_segment_ptr(); asm volatile("" : "+s"(p)); return p; }
__device__ __forceinline__ bool in_phase(int k) { ArgsP a = get_args(); return a->ph_lo <= k && k < a->ph_hi; }
#ifndef DUP_PHASE
#define DUP_PHASE -1
#endif
#ifndef BAR_EXP
#define BAR_EXP 0
#endif
#ifndef TIMING_MASK
#define TIMING_MASK 0ull
#endif
#define TMISC ((volatile LAS unsigned long long*)((LAS unsigned char*)lds_raw + MISC_OFF))
#define TB(k) do { if (((TIMING_MASK >> (k)) & 1ull) && blockIdx.x == 0 && threadIdx.x == 0) TMISC[0] = __builtin_amdgcn_s_memrealtime(); } while (0)
#define TE(k) do { if (((TIMING_MASK >> (k)) & 1ull) && blockIdx.x == 0 && threadIdx.x == 0) TMISC[1] = TMISC[1] + (__builtin_amdgcn_s_memrealtime() - TMISC[0]); } while (0)
#define REP(k) TB(k); for (int rep_ = 0; rep_ < ((k) == DUP_PHASE ? 2 : 1); ++rep_)
#define AP ArgsP ap = get_args(); { int t_ = threadIdx.x; asm volatile("" : "+v"(t_)); F.tid = t_; F.lane = t_ & 63; F.wave = __builtin_amdgcn_readfirstlane(t_ >> 6); F.G = gridDim.x; F.lds = (LAS unsigned char*)lds_raw; }
__global__ void __launch_bounds__(NTHR, 2) trunk_fwd(Args args) {
    extern __shared__ __attribute__((aligned(16))) unsigned char lds_raw[];
    Frame F; F.lds = (LAS unsigned char*)lds_raw; F.tid = threadIdx.x; F.lane = F.tid & 63; F.wave = __builtin_amdgcn_readfirstlane(F.tid >> 6); F.G = gridDim.x;
    volatile LAS unsigned* MISC = (volatile LAS unsigned*)(F.lds + MISC_OFF);
    if (F.tid < 16) MISC[F.tid] = 0u;
    __syncthreads();
    if (args.ph_hi - args.ph_lo > 1) (void)xcd_barrier_post((unsigned*)(args.ws + WS_CTL) + CW_BAR, MISC + 8);
#ifndef ONLY_PHASE
#define ONLY_PHASE -1
#endif
#define IN(k) ((ONLY_PHASE < 0 || (k) == ONLY_PHASE) && in_phase(k))
#define SEAM(k) do { if (IN(k) && IN((k) + 1)) { XcdBarrier bb; bb.bar = (unsigned*)(get_args()->ws + WS_CTL) + CW_BAR; bb.x = xb_xcc_id(); bb.st = (volatile LAS unsigned*)((LAS unsigned char*)lds_raw + MISC_OFF) + 8; xcd_barrier(bb); if (BAR_EXP) xcd_barrier(bb); } if (IN(k)) TE(k); } while (0)
#define XIN ((const float*)ap->in[0])
#define pos ((const int*)ap->in[1])
#define norm_mix ((const float*)ap->in[2])
#define norm_ffn ((const float*)ap->in[3])
#define ffn_w_in ((const float*)ap->in[4])
#define ffn_w_out ((const float*)ap->in[5])
#define out (ap->out)
#define Wmi ((bf16*)(ap->ws + WS_W_MIXIN))
#define Wmo ((bf16*)(ap->ws + WS_W_MIXOUT))
#define Wfi ((bf16*)(ap->ws + WS_W_FFNIN))
#define Wfo ((bf16*)(ap->ws + WS_W_FFNOUT))
#define U ((bf16*)(ap->ws + WS_U))
#define BIG ((bf16*)(ap->ws + WS_BIG))
#define gatesA ((float*)(ap->ws + WS_GATESA))
#define ssqA ((float*)(ap->ws + WS_SSQA))
#define statC ((float*)(ap->ws + WS_STATC))
#define kmean ((float*)(ap->ws + WS_KMEAN))
#define sptab ((float*)(ap->ws + WS_SPTAB))
#define ssqH ((float*)(ap->ws + WS_SSQH))

#define a_w_in ((const float*)ap->in[6])
#define a_b ((const float*)ap->in[7])
#define a_g ((const float*)ap->in[8])
#define a_w_out ((const float*)ap->in[9])
#define b_w_in ((const float*)ap->in[10])
#define b_gq ((const float*)ap->in[11])
#define b_gk ((const float*)ap->in[12])
#define b_w_out ((const float*)ap->in[13])
#define c_w_in ((const float*)ap->in[14])
#define c_g ((const float*)ap->in[15])
#define c_w_out ((const float*)ap->in[16])
#define d_w_in ((const float*)ap->in[17])
#define d_cw ((const float*)ap->in[18])
#define d_cb ((const float*)ap->in[19])
#define d_wg ((const float*)ap->in[20])
#define d_bg ((const float*)ap->in[21])
#define d_lru ((const float*)ap->in[22])
#define d_w_out ((const float*)ap->in[23])
#define GX BIG
#define XC (BIG + (size_t)MTOK * 2048)
#define LA (BIG + (size_t)MTOK * 3072)
#define BT (BIG + (size_t)MTOK * 4096)
#define Y (BIG + (size_t)MTOK * 5120)
#define Wg (Wmi + (size_t)2048 * DM)
#define FFN_CVT(l) do { cvt_matrix(F, ffn_w_in + (size_t)(l) * DM * 2 * DFF, 2 * DFF, DM, 2 * DFF, 1, Wfi); cvt_matrix(F, ffn_w_out + (size_t)(l) * DFF * DM, DM, DFF, DM, 0, Wfo); } while (0)
#define FFN_PHASES(p0, l) do { \
    if (IN(p0)) { AP; REP(p0) { norm_phase<false>(F, out, norm_ffn + (l) * DM, U, nullptr, nullptr, nullptr); } } SEAM(p0); \
    if (IN((p0) + 1)) { AP; REP((p0) + 1) { pg8::EpiSwiGLU<false> E{BIG, DFF, nullptr}; run_gemm(F, U, DM, Wfi, DM, 2 * DFF, DM, E); } } SEAM((p0) + 1); \
    if (IN((p0) + 2)) { AP; REP((p0) + 2) { pg8::EpiResid<FUSE_NX> E{out, out, DM, U, ssqH}; run_gemm(F, BIG, DFF, Wfo, DFF, DM, DFF, E); } } SEAM((p0) + 2); } while (0)
#define QKV BIG
#define HO (BIG + (size_t)MTOK * 2048)
#define PMAB (BIG + (size_t)MTOK * 3072)
#define GTB ((float*)(BIG + (size_t)MTOK * 3584))
#define DENB ((float*)(BIG + (size_t)MTOK * 3584) + 2048 * 320)
    if (IN(0)) { AP; REP(0) { cvt_matrix(F, a_w_in, 3080, DM, 3072, 0, Wmi); cvt_matrix(F, a_w_out, DM, DM, DM, 0, Wmo); FFN_CVT(0);
        __syncthreads(); norm_phase<true>(F, XIN, norm_mix, U, a_w_in, a_b, gatesA); } } SEAM(0);
    if (IN(1)) { AP; REP(1) { mlstm_pre(F, gatesA, GTB); __syncthreads(); pg8::EpiStore<false> E{QKV, 2048, nullptr}; run_gemm(F, U, DM, Wmi, DM, 2048, DM, E); } } SEAM(1);
    if (IN(2)) { AP; REP(2) { mlstm_pmat(F, QKV, GTB, PMAB, DENB); } } SEAM(2);
    if (IN(3)) { AP; REP(3) { mlstm_core(F, QKV, GTB, PMAB, DENB, HO, ssqA); } } SEAM(3);
    if (IN(4)) { AP; REP(4) { pg8::EpiGateA E{HO, ssqA, a_g}; run_gemm(F, U, DM, Wmi + (size_t)2048 * DM, DM, DM, DM, E); } } SEAM(4);
    if (IN(5)) { AP; REP(5) { pg8::EpiResid<FUSE_NX> E{XIN, out, DM, U, ssqH}; run_gemm(F, HO, DM, Wmo, DM, DM, DM, E); } } SEAM(5);
    FFN_PHASES(6, 0);
#define OB (BIG + (size_t)MTOK * 3072)
#define VTB (BIG + (size_t)MTOK * 2048)
    if (IN(9)) { AP; REP(9) { cvt_matrix(F, b_w_in, 3072, DM, 3072, 0, Wmi); cvt_matrix(F, b_w_out, DM, DM, DM, 0, Wmo); FFN_CVT(1);
        __syncthreads(); norm_phase<false>(F, out, norm_mix + DM, U, nullptr, nullptr, nullptr); } } SEAM(9);
    if (IN(10)) { AP; REP(10) { pg8::EpiStore<false> E{QKV, 3072, nullptr}; run_gemm(F, U, DM, Wmi, DM, 3072, DM, E); } } SEAM(10);
    if (IN(11)) { AP; REP(11) { moba_prep(F, QKV, pos, b_gq, b_gk, kmean); } } SEAM(11);
    if (IN(12)) { AP; REP(12) { moba_attn(F, QKV, kmean, OB); } } SEAM(12);
    if (IN(13)) { AP; REP(13) { pg8::EpiResid<FUSE_NX> E{out, out, DM, U, ssqH}; run_gemm(F, OB, DM, Wmo, DM, DM, DM, E); } } SEAM(13);
    FFN_PHASES(14, 1);
#define YS (BIG + 2048)
#define PMB (BIG + (size_t)MTOK * 4096)
#define CSTB ((float*)(BIG + (size_t)MTOK * 4096 + (size_t)16 * 1024 * 1024))
    if (IN(17)) { AP; REP(17) { cvt_matrix(F, c_w_in, 6144, DM, 6144, 0, Wmi); cvt_matrix(F, c_w_out, DM, 2048, DM, 0, Wmo); FFN_CVT(2);
        __syncthreads(); norm_phase<false>(F, out, norm_mix + 2 * DM, U, nullptr, nullptr, nullptr); ret_rot_table(F, pos, CSTB); } } SEAM(17);
    if (IN(18)) { AP; REP(18) { pg8::EpiStoreRot E{QKV, CSTB}; run_gemm(F, U, DM, Wmi, DM, 4096, DM, E); } } SEAM(18);
    if (IN(19)) { AP; REP(19) { ret_pmat(F, QKV, PMB); } } SEAM(19);
    if (IN(20)) { AP; REP(20) { ret_core(F, QKV, PMB, statC); } } SEAM(20);
    if (IN(21)) { AP; REP(21) { pg8::EpiGateC<false> E{YS, 4096, statC, c_g, nullptr}; run_gemm(F, U, DM, Wmi + (size_t)4096 * DM, DM, 2048, DM, E); } } SEAM(21);
    if (IN(22)) { AP; REP(22) { pg8::EpiResid<FUSE_NX> E{out, out, DM, U, ssqH}; run_gemm(F, YS, 4096, Wmo, 2048, DM, 2048, E); } } SEAM(22);
    FFN_PHASES(23, 2);
    if (IN(26)) { AP; REP(26) { cvt_matrix(F, d_w_in, 2048, DM, 2048, 0, Wmi);
#pragma unroll 1
            for (int blk = 0; blk < 4; ++blk) cvt_matrix(F, d_wg + (size_t)blk * 256 * 512, 512, 256, 512, 2, Wg + (size_t)blk * 512 * 256);
            cvt_matrix(F, d_w_out, DM, DM, DM, 0, Wmo); FFN_CVT(3);
        __syncthreads(); norm_phase<false>(F, out, norm_mix + 3 * DM, U, nullptr, nullptr, nullptr); } } SEAM(26);
    if (IN(27)) { AP; REP(27) { pg8::EpiStore<false> E{GX, 2048, nullptr}; run_gemm(F, U, DM, Wmi, DM, 2048, DM, E); } } SEAM(27);
    if (IN(28)) { AP; REP(28) { lru_conv(F, GX, d_cw, d_cb, XC, d_lru, sptab); } } SEAM(28);
    if (IN(29)) { AP; REP(29) { pg8::EpiLru E{XC, LA, BT, d_bg, sptab}; run_gemm(F, XC, DM, Wg, 256, 2048, 256, E, MTOK, 256); } } SEAM(29);
    if (IN(30)) { AP; REP(30) { lru_scan(F, LA, BT, GX, Y); } } SEAM(30);
    if (IN(31)) { AP; REP(31) { pg8::EpiResid<FUSE_NX> E{out, out, DM, U, ssqH}; run_gemm(F, Y, DM, Wmo, DM, DM, DM, E); } } SEAM(31);
    FFN_PHASES(32, 3);
    if (TIMING_MASK != 0ull && blockIdx.x == 0 && threadIdx.x == 0) { const unsigned long long t0_ = __builtin_amdgcn_s_memrealtime(); const unsigned long long tacc_ = TMISC[1]; while (__builtin_amdgcn_s_memrealtime() - t0_ < tacc_) __builtin_amdgcn_s_sleep(8); }
#undef IN
#undef SEAM
#undef XIN
#undef pos
#undef norm_mix
#undef norm_ffn
#undef ffn_w_in
#undef ffn_w_out
#undef out
#undef Wmi
#undef Wmo
#undef Wfi
#undef Wfo
#undef U
#undef BIG
#undef gatesA
#undef ssqA
#undef statC
#undef kmean
#undef sptab
#undef a_w_in
#undef a_b
#undef a_g
#undef a_w_out
#undef b_w_in
#undef b_gq
#undef b_gk
#undef b_w_out
#undef c_w_in
#undef c_g
#undef c_w_out
#undef d_w_in
#undef d_cw
#undef d_cb
#undef d_wg
#undef d_bg
#undef d_lru
#undef d_w_out
#undef GX
#undef XC
#undef LA
#undef BT
#undef Y
#undef Wg
#undef FFN_CVT
#undef OB
#undef CSTB
#undef PMAB
#undef GTB
#undef DENB
#undef PMB
#undef VTB
#undef FFN_PHASES
#undef QKV
#undef HO
#undef YS
#undef ssqH
}

#ifndef MK_ONE_LAUNCH
#define MK_ONE_LAUNCH 1
#endif
extern "C" void kernel_launch(void* const* d_in, const int* in_sizes, int n_in, void* d_out, int out_size, void* d_ws, size_t ws_size, hipStream_t stream) {
    static int grid = 0;
    if (grid == 0) {
        if (n_in != 24 || out_size != MTOK * DM || ws_size < WS_END) { fprintf(stderr, "kernel_launch: unexpected shapes (n_in %d, out %d, ws %zu); nothing launched\n", n_in, out_size, ws_size); grid = -1; return; }
        int dev = 0, cus = 0, per_cu = 0;
        if (hipGetDevice(&dev) != hipSuccess || hipDeviceGetAttribute(&cus, hipDeviceAttributeMultiprocessorCount, dev) != hipSuccess) { grid = -1; return; }
        if (hipFuncSetAttribute((const void*)trunk_fwd, hipFuncAttributeMaxDynamicSharedMemorySize, LDS_BYTES) != hipSuccess) { fprintf(stderr, "kernel_launch: hipFuncSetAttribute failed\n"); grid = -1; return; }
        if (hipOccupancyMaxActiveBlocksPerMultiprocessor(&per_cu, (const void*)trunk_fwd, NTHR, LDS_BYTES) != hipSuccess || per_cu < 1) { fprintf(stderr, "kernel_launch: occupancy query reports %d blocks per CU\n", per_cu); }
        (void)hipGetLastError();
        grid = cus;
    }
    if (grid < 0) return;
    (void)hipMemsetAsync((char*)d_ws + WS_CTL, 0, CTL_ZERO_BYTES, stream);
    Args a{};
    for (int i = 0; i < 24; ++i) a.in[i] = d_in[i];
    a.out = (float*)d_out; a.ws = (unsigned char*)d_ws;
#if MK_ONE_LAUNCH
    a.ph_lo = 0; a.ph_hi = NPHASE;
    hipLaunchKernelGGL(trunk_fwd, dim3(grid), dim3(NTHR), LDS_BYTES, stream, a);
#else
    for (int p = 0; p < NPHASE; ++p) { a.ph_lo = p; a.ph_hi = p + 1; hipLaunchKernelGGL(trunk_fwd, dim3(grid), dim3(NTHR), LDS_BYTES, stream, a); }
#endif
}
```

```cpp
#include <hip/hip_runtime.h>
#include <cstdio>
#include <cstdint>
#include <cmath>
namespace pg8 {
#define PG8_LAS __attribute__((address_space(3)))
typedef unsigned short bf16_t;
typedef short bf16x8 __attribute__((ext_vector_type(8)));
typedef float f32x4 __attribute__((ext_vector_type(4)));
typedef unsigned u32x4 __attribute__((ext_vector_type(4)));
constexpr int BM = 256, BK = 64, HALF = 128, HTB = HALF * BK * 2  , STAGE_BYTES = 8 * HTB, NXCD = 8, WGM = 8;

__host__ __device__ __forceinline__ int lds_byte(int r, int c) { const int st = (r >> 4) * 2 + (c >> 5), rr = r & 15, cc = c & 31, ob = rr * 64 + cc * 2; return st * 1024 + (ob ^ (((ob >> 9) & 1) << 5)); }
__host__ __device__ __forceinline__ void stage_rc(int b, int& R, int& C) { const int st = b / 1024, sb = b % 1024, swz = sb ^ (((sb >> 9) & 1) << 5); R = (st >> 1) * 16 + swz / 64; C = (st & 1) * 32 + (swz % 64) / 2; }
__host__ __device__ __forceinline__ int perm32(int rho) { const int n = rho >> 4, i = rho & 15; return 8 * (i >> 2) + 4 * n + (i & 3); }

struct Unit { int pm, pn; };
struct Gemm { const bf16_t* A; const bf16_t* Bt; int M, N, K, lda, ldb, ablk; };

struct StaticOrder {
    int nM, nN, nwg, G, c, wgm;
    __host__ __device__ void init(int M, int N, int G_, int c_, int wgm_ = WGM) { nM = M / BM; nN = N / BM; nwg = nM * nN; G = G_; c = c_; wgm = wgm_; }
    __host__ __device__ bool next(int i, Unit& u) const {
        const long L = (long)i * G + c; if (L >= nwg) return false;
        int wgid = (int)L; { const int q = nwg / NXCD, r = nwg % NXCD, xcd = wgid % NXCD, off = wgid / NXCD; wgid = (xcd < r ? xcd * (q + 1) : r * (q + 1) + (xcd - r) * q) + off; }
        const int nig = wgm * nN, gid = wgid / nig, fm = gid * wgm, gsz = (nM - fm) < wgm ? (nM - fm) : wgm;
        u.pm = fm + ((wgid % nig) % gsz); u.pn = (wgid % nig) / gsz; return true;
    }
    __device__ __forceinline__ void a_ready(const Unit&) const {}
    __device__ __forceinline__ void done(const Unit&) const {}
};

__device__ __forceinline__ unsigned cvt_pk_bf16(float lo, float hi) { unsigned r; asm volatile("v_cvt_pk_bf16_f32 %0, %1, %2" : "=v"(r) : "v"(lo), "v"(hi)); return r; }
typedef float f32x2 __attribute__((ext_vector_type(2)));

__device__ __forceinline__ float bf2f(unsigned short b) { return __uint_as_float(((unsigned)b) << 16); }
__device__ __forceinline__ float lo_bf(unsigned w) { return __uint_as_float(w << 16); }
__device__ __forceinline__ float hi_bf(unsigned w) { return __uint_as_float(w & 0xffff0000u); }
__device__ __forceinline__ float fast_sigmoid(float x) { return __builtin_amdgcn_rcpf(1.0f + __expf(-x)); }
typedef unsigned u32x2 __attribute__((ext_vector_type(2)));


#ifndef EPI_SC1
#define EPI_SC1 0
#endif
__device__ __forceinline__ void st16(void* p, u32x4 w) {
#if EPI_SC1
    asm volatile("global_store_dwordx4 %0, %1, off sc1" :: "v"(p), "v"(w) : "memory");
#else
    *(u32x4*)p = w;
#endif
}
__device__ __forceinline__ void row_rstd(const float* ssq, int row0, float (&rs)[2][4]) {
#pragma unroll
    for (int ai = 0; ai < 2; ++ai)
#pragma unroll
        for (int m = 0; m < 4; ++m) { const f32x4* p = (const f32x4*)(ssq + (size_t)(row0 + ai * HALF + m * 16) * 16); const f32x4 a = p[0], b = p[1], c = p[2], d = p[3];
            const float t = ((a[0] + a[1]) + (a[2] + a[3])) + ((b[0] + b[1]) + (b[2] + b[3])) + ((c[0] + c[1]) + (c[2] + c[3])) + ((d[0] + d[1]) + (d[2] + d[3]));
            rs[ai][m] = 1.0f / sqrtf(t * (1.0f / 1024.0f) + 1e-6f); }
}
template <bool RS> struct EpiStore {
    static constexpr bool PERM = true, AFTER_DRAIN = false; static constexpr int NST = 16;
    bf16_t* O; int ldc; const float* ssq;
    __device__ __forceinline__ void operator()(const f32x4 (&acc)[2][2][4][2], const Unit& u, int wr, int wc, int fr, int fq) const {
        const int row0 = u.pm * BM + wr * 64 + fr, col0 = u.pn * BM + wc * 32 + 8 * fq;
        float rs[2][4]; if (RS) row_rstd(ssq, row0, rs);
#pragma unroll
        for (int ai = 0; ai < 2; ++ai)
#pragma unroll
            for (int m = 0; m < 4; ++m) { bf16_t* rowp = O + (size_t)(row0 + ai * HALF + m * 16) * ldc + col0; const float sc = RS ? rs[ai][m] : 1.0f;
#pragma unroll
                for (int bj = 0; bj < 2; ++bj) { const f32x4 v0 = acc[ai][bj][m][0] * sc, v1 = acc[ai][bj][m][1] * sc;
                    u32x4 w; w.x = cvt_pk_bf16(v0[0], v0[1]); w.y = cvt_pk_bf16(v0[2], v0[3]); w.z = cvt_pk_bf16(v1[0], v1[1]); w.w = cvt_pk_bf16(v1[2], v1[3]);
                    st16(rowp + bj * HALF, w);
#if defined(GEMM_EXP) && GEMM_EXP == 3
                    asm volatile("" ::: "memory"); *(volatile u32x4*)(rowp + bj * HALF) = w;
#endif
                } }
    }
};

struct EpiStoreRot {
    static constexpr bool PERM = true, AFTER_DRAIN = false; static constexpr int NST = 16;
    bf16_t* O; const float* cst;
    __device__ __forceinline__ void operator()(const f32x4 (&acc)[2][2][4][2], const Unit& u, int wr, int wc, int fr, int fq) const {
        const int row0 = u.pm * BM + wr * 64 + fr, col0 = u.pn * BM + wc * 32 + 8 * fq, d0 = wc * 32 + 8 * fq;
        const bool rot = u.pn < 8; const float sc = (u.pn >= 4 && u.pn < 8) ? 0.0625f : 1.0f;
#pragma unroll
        for (int ai = 0; ai < 2; ++ai)
#pragma unroll
            for (int m = 0; m < 4; ++m) { const int row = row0 + ai * HALF + m * 16; bf16_t* rowp = O + (size_t)row * 4096 + col0;
                f32x4 v[2][2];
#pragma unroll
                for (int bj = 0; bj < 2; ++bj) { v[bj][0] = acc[ai][bj][m][0]; v[bj][1] = acc[ai][bj][m][1]; }
                if (rot) { const float* cp = cst + (size_t)row * 256 + d0;
#pragma unroll
                    for (int n = 0; n < 2; ++n) { const f32x4 c = *(const f32x4*)(cp + 4 * n), sn = *(const f32x4*)(cp + 128 + 4 * n); const f32x4 x1 = v[0][n], x2 = v[1][n];
                        v[0][n] = (x1 * c - x2 * sn) * sc; v[1][n] = (x2 * c + x1 * sn) * sc; } }
#pragma unroll
                for (int bj = 0; bj < 2; ++bj) { u32x4 w; w.x = cvt_pk_bf16(v[bj][0][0], v[bj][0][1]); w.y = cvt_pk_bf16(v[bj][0][2], v[bj][0][3]); w.z = cvt_pk_bf16(v[bj][1][0], v[bj][1][1]); w.w = cvt_pk_bf16(v[bj][1][2], v[bj][1][3]);
                    *(u32x4*)(rowp + bj * HALF) = w; } }
    }
};
template <bool RS> struct EpiSwiGLU {
    static constexpr bool PERM = true, AFTER_DRAIN = false; static constexpr int NST = 8;
    bf16_t* O; int ldc; const float* ssq;
    __device__ __forceinline__ void operator()(const f32x4 (&acc)[2][2][4][2], const Unit& u, int wr, int wc, int fr, int fq) const {
        const int row0 = u.pm * BM + wr * 64 + fr, col0 = u.pn * HALF + wc * 32 + 8 * fq;
        float rs[2][4]; if (RS) row_rstd(ssq, row0, rs);
#pragma unroll
        for (int ai = 0; ai < 2; ++ai)
#pragma unroll
            for (int m = 0; m < 4; ++m) { bf16_t* rowp = O + (size_t)(row0 + ai * HALF + m * 16) * ldc + col0; const float sc = RS ? rs[ai][m] : 1.0f;
                float h[8];
#pragma unroll
                for (int n = 0; n < 2; ++n)
#pragma unroll
                    for (int j = 0; j < 4; ++j) { const float g = acc[ai][0][m][n][j] * sc, up = acc[ai][1][m][n][j] * sc;
#if defined(GEMM_EXP) && GEMM_EXP == 2
                        h[4 * n + j] = g * (0.5f * (fast_sigmoid(g) + (1.0f - fast_sigmoid(-g)))) * up;
#else
                        h[4 * n + j] = g * fast_sigmoid(g) * up;
#endif
                    }
                u32x4 w; w.x = cvt_pk_bf16(h[0], h[1]); w.y = cvt_pk_bf16(h[2], h[3]); w.z = cvt_pk_bf16(h[4], h[5]); w.w = cvt_pk_bf16(h[6], h[7]);

                st16(rowp, w);
                }
    }
};
template <bool NX> struct EpiResid {
    static constexpr bool PERM = false, AFTER_DRAIN = false; static constexpr int NST = 32;
    const float* base; float* out; int ldc; bf16_t* hb; float* ssq;
    __device__ __forceinline__ void operator()(const f32x4 (&acc)[2][2][4][2], const Unit& u, int wr, int wc, int fr, int fq) const {
        const int row0 = u.pm * BM + wr * 64 + fr, col0 = u.pn * BM + wc * 32 + 4 * fq;
        f32x4 rb[3][4];
#define PG8_RLOAD(g, slot) do { const size_t off_ = (size_t)(row0 + ((g) >> 2) * HALF + ((g) & 3) * 16) * ldc + col0; \
            rb[slot][0] = *(const f32x4*)(base + off_); rb[slot][1] = *(const f32x4*)(base + off_ + 16); rb[slot][2] = *(const f32x4*)(base + off_ + HALF); rb[slot][3] = *(const f32x4*)(base + off_ + HALF + 16); } while (0)
        PG8_RLOAD(0, 0); PG8_RLOAD(1, 1);
#pragma unroll
        for (int g = 0; g < 8; ++g) { const int ai = g >> 2, m = g & 3; const size_t off = (size_t)(row0 + ai * HALF + m * 16) * ldc + col0; float q = 0.f;
            if (g + 2 < 8) PG8_RLOAD(g + 2, (g + 2) % 3);
#pragma unroll
            for (int bj = 0; bj < 2; ++bj)
#pragma unroll
                for (int n = 0; n < 2; ++n) { const f32x4 o = rb[g % 3][bj * 2 + n] + acc[ai][bj][m][n]; *(f32x4*)(out + off + bj * HALF + n * 16) = o;
                    if (NX) { q += (o[0] * o[0] + o[1] * o[1]) + (o[2] * o[2] + o[3] * o[3]); u32x2 w; w.x = cvt_pk_bf16(o[0], o[1]); w.y = cvt_pk_bf16(o[2], o[3]); *(u32x2*)(hb + off + bj * HALF + n * 16) = w; } }
            if (NX) { q += __shfl_xor(q, 16); q += __shfl_xor(q, 32); if (fq == 0) ssq[(size_t)(row0 + ai * HALF + m * 16) * 16 + u.pn * 4 + wc] = q; } }
#undef PG8_RLOAD
    }
};
template <bool BF> struct EpiResidB {
    static constexpr bool PERM = true, AFTER_DRAIN = false; static constexpr int NST = 16;
    const void* base; bf16_t* hb;
    __device__ __forceinline__ void operator()(const f32x4 (&acc)[2][2][4][2], const Unit& u, int wr, int wc, int fr, int fq) const {
        const int row0 = u.pm * BM + wr * 64 + fr, col0 = u.pn * BM + wc * 32 + 8 * fq;
        u32x4 hwb[2][2]; f32x4 fb[2][4];
#define PG8_BLOAD(g, slot) do { const size_t o_ = (size_t)(row0 + ((g) >> 2) * HALF + ((g) & 3) * 16) * 1024 + col0; \
            if (BF) { hwb[slot][0] = *(const u32x4*)((const bf16_t*)base + o_); hwb[slot][1] = *(const u32x4*)((const bf16_t*)base + o_ + HALF); } \
            else { const float* b_ = (const float*)base + o_; fb[slot][0] = *(const f32x4*)b_; fb[slot][1] = *(const f32x4*)(b_ + 4); fb[slot][2] = *(const f32x4*)(b_ + HALF); fb[slot][3] = *(const f32x4*)(b_ + HALF + 4); } } while (0)
        PG8_BLOAD(0, 0);
#pragma unroll
        for (int g = 0; g < 8; ++g) { const int ai = g >> 2, m = g & 3, sl = g & 1; bf16_t* rowp = hb + (size_t)(row0 + ai * HALF + m * 16) * 1024 + col0;
            if (g + 1 < 8) PG8_BLOAD(g + 1, (g + 1) & 1);
#pragma unroll
            for (int bj = 0; bj < 2; ++bj) { f32x4 b0, b1;
                if (BF) { const u32x4 hw = hwb[sl][bj]; b0 = (f32x4){lo_bf(hw.x), hi_bf(hw.x), lo_bf(hw.y), hi_bf(hw.y)}; b1 = (f32x4){lo_bf(hw.z), hi_bf(hw.z), lo_bf(hw.w), hi_bf(hw.w)}; }
                else { b0 = fb[sl][2 * bj]; b1 = fb[sl][2 * bj + 1]; }
                const f32x4 o0 = b0 + acc[ai][bj][m][0], o1 = b1 + acc[ai][bj][m][1];
                u32x4 w; w.x = cvt_pk_bf16(o0[0], o0[1]); w.y = cvt_pk_bf16(o0[2], o0[3]); w.z = cvt_pk_bf16(o1[0], o1[1]); w.w = cvt_pk_bf16(o1[2], o1[3]);
                *(u32x4*)(rowp + bj * HALF) = w; } }
#undef PG8_BLOAD
    }
};
struct EpiResidF {
    static constexpr bool PERM = true, AFTER_DRAIN = false; static constexpr int NST = 32;
    const bf16_t* hb; float* out;
    __device__ __forceinline__ void operator()(const f32x4 (&acc)[2][2][4][2], const Unit& u, int wr, int wc, int fr, int fq) const {
        const int row0 = u.pm * BM + wr * 64 + fr, col0 = u.pn * BM + wc * 32 + 8 * fq;
#pragma unroll
        for (int ai = 0; ai < 2; ++ai)
#pragma unroll
            for (int m = 0; m < 4; ++m) { const size_t o_ = (size_t)(row0 + ai * HALF + m * 16) * 1024 + col0;
#pragma unroll
                for (int bj = 0; bj < 2; ++bj) { const u32x4 hw = *(const u32x4*)(hb + o_ + bj * HALF);
                    const f32x4 b0 = (f32x4){lo_bf(hw.x), hi_bf(hw.x), lo_bf(hw.y), hi_bf(hw.y)}, b1 = (f32x4){lo_bf(hw.z), hi_bf(hw.z), lo_bf(hw.w), hi_bf(hw.w)};
                    *(f32x4*)(out + o_ + bj * HALF) = b0 + acc[ai][bj][m][0]; *(f32x4*)(out + o_ + bj * HALF + 4) = b1 + acc[ai][bj][m][1]; } }
    }
};
struct EpiGateA {
    static constexpr bool PERM = true, AFTER_DRAIN = false; static constexpr int NST = 16;
    bf16_t* Y; const float* ssq; const float* gout;
    __device__ __forceinline__ void operator()(const f32x4 (&acc)[2][2][4][2], const Unit& u, int wr, int wc, int fr, int fq) const {
        const int row0 = u.pm * BM + wr * 64 + fr, col0 = u.pn * BM + wc * 32 + 8 * fq;
        f32x4 gv[2][2];
#pragma unroll
        for (int bj = 0; bj < 2; ++bj)
#pragma unroll
            for (int n = 0; n < 2; ++n) gv[bj][n] = *(const f32x4*)(gout + col0 + bj * HALF + 4 * n);
        u32x4 hwb[2][2]; f32x4 spb[2][2];
#define PG8_GLOAD(g, slot) do { const int row_ = row0 + ((g) >> 2) * HALF + ((g) & 3) * 16; const bf16_t* rp_ = Y + (size_t)row_ * 1024 + col0; hwb[slot][0] = *(const u32x4*)rp_; hwb[slot][1] = *(const u32x4*)(rp_ + HALF); \
            spb[slot][0] = *(const f32x4*)(ssq + (size_t)row_ * 32 + u.pn * 8); spb[slot][1] = *(const f32x4*)(ssq + (size_t)row_ * 32 + u.pn * 8 + 4); } while (0)
        PG8_GLOAD(0, 0);
#pragma unroll
        for (int g = 0; g < 8; ++g) { const int ai = g >> 2, m = g & 3, sl = g & 1; const int row = row0 + ai * HALF + m * 16; bf16_t* rowp = Y + (size_t)row * 1024 + col0;
            if (g + 1 < 8) PG8_GLOAD(g + 1, (g + 1) & 1);
            const f32x4 sp = spb[sl][0], sp2 = spb[sl][1];
            const float rstd = 1.0f / sqrtf((((sp[0] + sp[1]) + (sp[2] + sp[3])) + ((sp2[0] + sp2[1]) + (sp2[2] + sp2[3]))) * (1.0f / 256.0f) + 1e-6f);
#pragma unroll
            for (int bj = 0; bj < 2; ++bj) { const u32x4 hw = hwb[sl][bj]; float o[8];
                const unsigned hh[4] = {hw.x, hw.y, hw.z, hw.w};
#pragma unroll
                for (int n = 0; n < 2; ++n)
#pragma unroll
                    for (int j = 0; j < 4; ++j) { const unsigned w = hh[2 * n + (j >> 1)]; const float hv = (j & 1) ? hi_bf(w) : lo_bf(w);
                        o[4 * n + j] = hv * rstd * gv[bj][n][j] * fast_sigmoid(acc[ai][bj][m][n][j]); }
                u32x4 w; w.x = cvt_pk_bf16(o[0], o[1]); w.y = cvt_pk_bf16(o[2], o[3]); w.z = cvt_pk_bf16(o[4], o[5]); w.w = cvt_pk_bf16(o[6], o[7]);
                *(u32x4*)(rowp + bj * HALF) = w; } }
#undef PG8_GLOAD
    }
};
template <bool RS> struct EpiGateC {
    static constexpr bool PERM = true, AFTER_DRAIN = false; static constexpr int NST = 16;
    bf16_t* Y; int ldy; const float* st; const float* gout; const float* hssq;
    __device__ __forceinline__ void operator()(const f32x4 (&acc)[2][2][4][2], const Unit& u, int wr, int wc, int fr, int fq) const {
        const int row0 = u.pm * BM + wr * 64 + fr, col0 = u.pn * BM + wc * 32 + 8 * fq, head = u.pn >> 1;
        float rs[2][4]; if (RS) row_rstd(hssq, row0, rs);
        f32x4 gv[2][2];
#pragma unroll
        for (int bj = 0; bj < 2; ++bj)
#pragma unroll
            for (int n = 0; n < 2; ++n) gv[bj][n] = *(const f32x4*)(gout + col0 + bj * HALF + 4 * n);
        u32x4 hwb[2][2]; f32x4 spb[2][2];
#define PG8_GLOAD(g, slot) do { const int row_ = row0 + ((g) >> 2) * HALF + ((g) & 3) * 16; const bf16_t* rp_ = Y + (size_t)row_ * ldy + col0; hwb[slot][0] = *(const u32x4*)rp_; hwb[slot][1] = *(const u32x4*)(rp_ + HALF); \
            spb[slot][0] = *(const f32x4*)(st + (size_t)row_ * 32 + head * 8); spb[slot][1] = *(const f32x4*)(st + (size_t)row_ * 32 + head * 8 + 4); } while (0)
        PG8_GLOAD(0, 0);
#pragma unroll
        for (int g = 0; g < 8; ++g) { const int ai = g >> 2, m = g & 3, sl = g & 1; const int row = row0 + ai * HALF + m * 16; bf16_t* rowp = Y + (size_t)row * ldy + col0;
            if (g + 1 < 8) PG8_GLOAD(g + 1, (g + 1) & 1);
            const f32x4 s0 = spb[sl][0], s1 = spb[sl][1];
            const float mu = ((s0[0] + s0[2]) + (s1[0] + s1[2])) * (1.0f / 512.0f), ex2 = ((s0[1] + s0[3]) + (s1[1] + s1[3])) * (1.0f / 512.0f);
            const float var = fmaxf(ex2 - mu * mu, 0.f), rstd = 1.0f / sqrtf(var + 1e-6f);
#pragma unroll
            for (int bj = 0; bj < 2; ++bj) { const u32x4 hw = hwb[sl][bj]; float o[8];
                const unsigned hh[4] = {hw.x, hw.y, hw.z, hw.w};
#pragma unroll
                for (int n = 0; n < 2; ++n)
#pragma unroll
                    for (int j = 0; j < 4; ++j) { const unsigned w = hh[2 * n + (j >> 1)]; const float hv = (j & 1) ? hi_bf(w) : lo_bf(w); const float a = RS ? acc[ai][bj][m][n][j] * rs[ai][m] : acc[ai][bj][m][n][j];
                        o[4 * n + j] = (hv - mu) * rstd * gv[bj][n][j] * (a * fast_sigmoid(a)); }
                u32x4 w; w.x = cvt_pk_bf16(o[0], o[1]); w.y = cvt_pk_bf16(o[2], o[3]); w.z = cvt_pk_bf16(o[4], o[5]); w.w = cvt_pk_bf16(o[6], o[7]);
                *(u32x4*)(rowp + bj * HALF) = w; } }
#undef PG8_GLOAD
    }
};
struct EpiLru {
    static constexpr bool PERM = true, AFTER_DRAIN = false; static constexpr int NST = 16;
    const bf16_t* XC; bf16_t* LA; bf16_t* BT; const float* bgall; const float* sp;
    __device__ __forceinline__ void operator()(const f32x4 (&acc)[2][2][4][2], const Unit& u, int wr, int wc, int fr, int fq) const {
        const int blk = u.pn >> 1; const float* bg = bgall + blk * 512;
        const int row0 = u.pm * BM + wr * 64 + fr, cb = (u.pn & 1) * HALF + wc * 32 + 8 * fq, ch0 = blk * 256 + cb;
        u32x4 xwb[2]; xwb[0] = *(const u32x4*)(XC + (size_t)row0 * 1024 + ch0);
#pragma unroll
        for (int g = 0; g < 8; ++g) { const int ai = g >> 2, m = g & 3; const size_t off = (size_t)(row0 + ai * HALF + m * 16) * 1024 + ch0;
                if (g + 1 < 8) xwb[(g + 1) & 1] = *(const u32x4*)(XC + (size_t)(row0 + ((g + 1) >> 2) * HALF + ((g + 1) & 3) * 16) * 1024 + ch0);
                const u32x4 xw = xwb[g & 1]; const unsigned xx[4] = {xw.x, xw.y, xw.z, xw.w};
                unsigned lw[4], bw[4];
#pragma unroll
                for (int n = 0; n < 2; ++n) { const f32x4 br = *(const f32x4*)(bg + cb + 4 * n), bi = *(const f32x4*)(bg + 256 + cb + 4 * n), spv = *(const f32x4*)(sp + ch0 + 4 * n); float la[4], bt[4];
#pragma unroll
                    for (int j = 0; j < 4; ++j) { const int q = 4 * n + j; const unsigned w = xx[q >> 1]; const float xc = (q & 1) ? hi_bf(w) : lo_bf(w);
                        const float r = fast_sigmoid(acc[ai][0][m][n][j] + br[j]), ig = fast_sigmoid(acc[ai][1][m][n][j] + bi[j]);
                        const float l = -8.0f * r * spv[j]; la[j] = l; bt[j] = sqrtf(fmaxf(1.0f - __expf(2.0f * l), 0.f)) * ig * xc; }
                    lw[2 * n] = cvt_pk_bf16(la[0], la[1]); lw[2 * n + 1] = cvt_pk_bf16(la[2], la[3]); bw[2 * n] = cvt_pk_bf16(bt[0], bt[1]); bw[2 * n + 1] = cvt_pk_bf16(bt[2], bt[3]); }
                u32x4 w; w.x = lw[0]; w.y = lw[1]; w.z = lw[2]; w.w = lw[3]; *(u32x4*)(LA + off) = w;
                w.x = bw[0]; w.y = bw[1]; w.z = bw[2]; w.w = bw[3]; *(u32x4*)(BT + off) = w; }
    }
};

template <class Epi, class Sched, bool ALIGN_EPI = false, bool SP2 = false>
__device__ __forceinline__ void gemm_phase(PG8_LAS unsigned char* lds, const Gemm g, const Sched& S, const Epi& E) {
    int tid_ = threadIdx.x; asm volatile("" : "+v"(tid_));
    const int tid = tid_, wid = __builtin_amdgcn_readfirstlane(tid >> 6), lane = tid & 63, wr = wid >> 2, wc = wid & 3, fr = lane & 15, fq = lane >> 4;
    const int K = g.K, nt = K / BK;
    unsigned voffA[2], voffB[2];
#pragma unroll
    for (int i = 0; i < 2; ++i) { int R, C; stage_rc(tid * 16 + i * 8192, R, C); const int Rb = Epi::PERM ? ((R & ~31) + perm32(R & 31)) : R;
        voffA[i] = (unsigned)(R * g.lda + C) * 2u; voffB[i] = (unsigned)(Rb * g.ldb + C) * 2u; }
    const size_t kstep = (size_t)(BK * 2);
    const size_t hstepA = (size_t)HALF * g.lda * 2, hstepB = (size_t)HALF * g.ldb * 2;
    const size_t tstepA = 2 * hstepA, tstepB = 2 * hstepB;
    const unsigned ldsw = (unsigned)wid * 1024u;
    const int aoff = lds_byte(wr * 64 + fr, fq * 8), boff = lds_byte(wc * 32 + fr, fq * 8);
#define PG8_SA(b, h) (((b) * 2 + (h)) * HTB)
#define PG8_SB(b, h) ((4 + (b) * 2 + (h)) * HTB)
#define PG8_STAGE(bufoff, gbase, voff) do { _Pragma("unroll") for (int _i = 0; _i < 2; ++_i) \
        __builtin_amdgcn_global_load_lds((const unsigned*)((const char*)(gbase) + (voff)[_i]), (PG8_LAS unsigned*)(lds + (bufoff) + ldsw + _i * 8192), 16, 0, 0); } while (0)
#define PG8_LDA(dst, b, h) do { _Pragma("unroll") for (int m = 0; m < 4; ++m) _Pragma("unroll") for (int k = 0; k < 2; ++k) dst[m][k] = *(const PG8_LAS bf16x8*)(lds + PG8_SA(b, h) + aoff + m * 2048 + k * 1024); } while (0)
#define PG8_LDB(dst, b, h) do { _Pragma("unroll") for (int n = 0; n < 2; ++n) _Pragma("unroll") for (int k = 0; k < 2; ++k) dst[n][k] = *(const PG8_LAS bf16x8*)(lds + PG8_SB(b, h) + boff + n * 2048 + k * 1024); } while (0)
#define PG8_MMA(ai, bj, At, Bt) do { __builtin_amdgcn_s_setprio(1); _Pragma("unroll") for (int m = 0; m < 4; ++m) _Pragma("unroll") for (int n = 0; n < 2; ++n) _Pragma("unroll") for (int k = 0; k < 2; ++k) \
        acc[ai][bj][m][n] = __builtin_amdgcn_mfma_f32_16x16x32_bf16(Bt[n][k], At[m][k], acc[ai][bj][m][n], 0, 0, 0); __builtin_amdgcn_s_setprio(0); } while (0)
#define PG8_WAIT_V(n) asm volatile("s_waitcnt vmcnt(" #n ")" ::: "memory")
#ifndef PG8_RELAX
#define PG8_RELAX 0
#endif
#define PG8_WAIT_V8F do { if (PG8_RELAX) asm volatile("s_cmp_eq_u32 %0, 0\n\ts_cbranch_scc1 .Lpg8w%=a\n\ts_waitcnt vmcnt(%1)\n\ts_branch .Lpg8w%=b\n.Lpg8w%=a:\n\ts_waitcnt vmcnt(8)\n.Lpg8w%=b:" :: "s"(relax_), "n"(8 + Epi::NST) : "memory", "scc"); else PG8_WAIT_V(8); } while (0)
#define PG8_WAIT_L(n) asm volatile("s_waitcnt lgkmcnt(" #n ")" ::: "memory")
#define PG8_BAR __builtin_amdgcn_s_barrier()
#define PG8_SCHED __builtin_amdgcn_sched_barrier(0)
    Unit cur, nxt; int ui = 0;
    if (!S.next(0, cur)) return;
    f32x4 acc[2][2][4][2];
#pragma unroll
    for (int a = 0; a < 2; ++a)
#pragma unroll
        for (int b = 0; b < 2; ++b)
#pragma unroll
            for (int m = 0; m < 4; ++m)
#pragma unroll
                for (int n = 0; n < 2; ++n) acc[a][b][m][n] = (f32x4){0.f, 0.f, 0.f, 0.f};
    bf16x8 At[4][2], B0[2][2], B1[2][2];
    const char* cA = (const char*)g.A + (size_t)cur.pm * tstepA + (size_t)((cur.pn >> 1) * g.ablk) * 2; const char* cB = (const char*)g.Bt + (size_t)cur.pn * tstepB;
    S.a_ready(cur);
    if constexpr (SP2) {
        PG8_STAGE(PG8_SB(0, 0), cB, voffB); PG8_STAGE(PG8_SB(0, 1), cB + hstepB, voffB); PG8_STAGE(PG8_SA(0, 0), cA, voffA); PG8_STAGE(PG8_SA(0, 1), cA + hstepA, voffA);
        if (wr == 1) PG8_BAR;
        PG8_WAIT_V(2); PG8_BAR;
        PG8_STAGE(PG8_SB(1, 0), cB + kstep, voffB); PG8_STAGE(PG8_SA(1, 0), cA + kstep, voffA); PG8_STAGE(PG8_SB(1, 1), cB + hstepB + kstep, voffB);
        PG8_WAIT_V(6); PG8_BAR;
    } else {
        PG8_STAGE(PG8_SB(0, 0), cB, voffB); PG8_STAGE(PG8_SA(0, 0), cA, voffA); PG8_STAGE(PG8_SB(0, 1), cB + hstepB, voffB); PG8_STAGE(PG8_SA(0, 1), cA + hstepA, voffA);
        if (wr == 1) PG8_BAR;
        PG8_WAIT_V(4); PG8_BAR;
        PG8_STAGE(PG8_SB(1, 0), cB + kstep, voffB); PG8_STAGE(PG8_SA(1, 0), cA + kstep, voffA); PG8_STAGE(PG8_SB(1, 1), cB + hstepB + kstep, voffB);
        PG8_WAIT_V(6); PG8_BAR;
    }
    for (;;) {
        const bool has_next = S.next(ui + 1, nxt);
        const char* nA = has_next ? (const char*)g.A + (size_t)nxt.pm * tstepA + (size_t)((nxt.pn >> 1) * g.ablk) * 2 : cA; const char* nB = has_next ? (const char*)g.Bt + (size_t)nxt.pn * tstepB : cB;
        for (int t = 0; t < nt; t += 2) {
            const bool last = (t == nt - 2);
            const int relax_ = __builtin_amdgcn_readfirstlane((t == 0 && ui > 0) ? 1 : 0);
            const char* a1 = cA + (size_t)(t + 1) * kstep;
            const char* a2 = last ? nA : cA + (size_t)(t + 2) * kstep; const char* b2 = last ? nB : cB + (size_t)(t + 2) * kstep;
            const char* a3 = a2 + kstep; const char* b3 = b2 + kstep;
            if (last && has_next) S.a_ready(nxt);
            if constexpr (SP2) {
            PG8_LDB(B0, 0, 0); PG8_LDB(B1, 0, 1); PG8_SCHED; PG8_LDA(At, 0, 0); PG8_STAGE(PG8_SA(1, 1), a1 + hstepA, voffA);
            PG8_WAIT_V8F; PG8_WAIT_L(0); PG8_BAR; PG8_MMA(0, 0, At, B0); PG8_MMA(0, 1, At, B1); PG8_BAR; PG8_SCHED;
            PG8_LDA(At, 0, 1); PG8_STAGE(PG8_SB(0, 0), b2, voffB); PG8_STAGE(PG8_SB(0, 1), b2 + hstepB, voffB); PG8_STAGE(PG8_SA(0, 0), a2, voffA);
            PG8_WAIT_V8F; PG8_WAIT_L(0); PG8_BAR; PG8_MMA(1, 0, At, B0); PG8_MMA(1, 1, At, B1); PG8_BAR; PG8_SCHED;
            PG8_LDB(B0, 1, 0); PG8_LDB(B1, 1, 1); PG8_SCHED; PG8_LDA(At, 1, 0); PG8_STAGE(PG8_SA(0, 1), a2 + hstepA, voffA);
            PG8_WAIT_V(8); PG8_WAIT_L(0); PG8_BAR; PG8_MMA(0, 0, At, B0); PG8_MMA(0, 1, At, B1); PG8_BAR; PG8_SCHED;
            PG8_LDA(At, 1, 1); PG8_STAGE(PG8_SB(1, 0), b3, voffB); PG8_STAGE(PG8_SB(1, 1), b3 + hstepB, voffB); PG8_STAGE(PG8_SA(1, 0), a3, voffA);
            PG8_WAIT_V(8); PG8_WAIT_L(0); PG8_BAR; PG8_MMA(1, 0, At, B0); PG8_MMA(1, 1, At, B1); PG8_BAR; PG8_SCHED;
            } else {
            PG8_LDB(B0, 0, 0); PG8_SCHED; PG8_LDA(At, 0, 0); PG8_STAGE(PG8_SA(1, 1), a1 + hstepA, voffA);
            PG8_WAIT_L(8); PG8_BAR; PG8_WAIT_L(0); PG8_MMA(0, 0, At, B0); PG8_BAR; PG8_SCHED;
            PG8_LDB(B1, 0, 1); PG8_STAGE(PG8_SB(0, 0), b2, voffB);
            PG8_BAR; PG8_WAIT_L(0); PG8_MMA(0, 1, At, B1); PG8_BAR;
            PG8_LDA(At, 0, 1); PG8_STAGE(PG8_SA(0, 0), a2, voffA);
            PG8_BAR; PG8_WAIT_L(0); PG8_MMA(1, 0, At, B0); PG8_BAR; PG8_SCHED;
            PG8_STAGE(PG8_SB(0, 1), b2 + hstepB, voffB);
            PG8_WAIT_V(6); PG8_BAR; PG8_MMA(1, 1, At, B1); PG8_BAR;
            PG8_LDB(B0, 1, 0); PG8_SCHED; PG8_LDA(At, 1, 0); PG8_STAGE(PG8_SA(0, 1), a2 + hstepA, voffA);
            PG8_WAIT_L(8); PG8_BAR; PG8_WAIT_L(0); PG8_MMA(0, 0, At, B0); PG8_BAR; PG8_SCHED;
            PG8_LDB(B1, 1, 1); PG8_STAGE(PG8_SB(1, 0), b3, voffB);
            PG8_BAR; PG8_WAIT_L(0); PG8_MMA(0, 1, At, B1); PG8_BAR;
            PG8_LDA(At, 1, 1); PG8_STAGE(PG8_SA(1, 0), a3, voffA);
            PG8_BAR; PG8_WAIT_L(0); PG8_MMA(1, 0, At, B0); PG8_BAR; PG8_SCHED;
            PG8_STAGE(PG8_SB(1, 1), b3 + hstepB, voffB);
            PG8_WAIT_V(6); PG8_BAR; PG8_MMA(1, 1, At, B1); PG8_BAR;
            }
        }
        if constexpr (ALIGN_EPI) { if (wr == 0) PG8_BAR; }
        if constexpr (!Epi::AFTER_DRAIN) { E(acc, cur, wr, wc, fr, fq); S.done(cur); }
        if (!has_next) break;
#pragma unroll
        for (int a = 0; a < 2; ++a)
#pragma unroll
            for (int b = 0; b < 2; ++b)
#pragma unroll
                for (int m = 0; m < 4; ++m)
#pragma unroll
                    for (int n = 0; n < 2; ++n) acc[a][b][m][n] = (f32x4){0.f, 0.f, 0.f, 0.f};
        cur = nxt; cA = nA; cB = nB; ++ui;
        if constexpr (ALIGN_EPI) { if (wr == 1) PG8_BAR; }
    }
    PG8_WAIT_V(0);
    if constexpr (!ALIGN_EPI) { if (wr == 0) PG8_BAR; }
    PG8_BAR;
    if constexpr (Epi::AFTER_DRAIN) { E.fused(acc, cur, wr, wc, fr, fq, lds, wid, lane); S.done(cur); }
#undef PG8_SA
#undef PG8_SB
#undef PG8_STAGE
#undef PG8_LDA
#undef PG8_LDB
#undef PG8_MMA
#undef PG8_WAIT_V
#undef PG8_WAIT_V8F
#undef PG8_WAIT_L
#undef PG8_BAR
#undef PG8_SCHED
}
}
#define GAS __attribute__((address_space(1)))
#define LAS __attribute__((address_space(3)))
typedef unsigned short bf16;
typedef unsigned v4u __attribute__((ext_vector_type(4)));
typedef float f32x4 __attribute__((ext_vector_type(4)));
typedef short bf16x8 __attribute__((ext_vector_type(8)));
typedef GAS unsigned gu32;
typedef GAS unsigned long long gu64;
#define RLX_AGENT __ATOMIC_RELAXED, __HIP_MEMORY_SCOPE_AGENT
#define LDS_WAIT() asm volatile("s_waitcnt lgkmcnt(0)" ::: "memory")
#define VM_WAIT() asm volatile("s_waitcnt vmcnt(0)" ::: "memory")
__device__ __forceinline__ unsigned long long rt() { return __builtin_amdgcn_s_memrealtime(); }
__device__ __forceinline__ unsigned f2bf(float f) { unsigned u = __builtin_bit_cast(unsigned, f); return (u + 0x7fffu + ((u >> 16) & 1u)) >> 16; }
__device__ __forceinline__ unsigned pk2(float lo, float hi) { return f2bf(lo) | (f2bf(hi) << 16); }

#define XB_TMO      128
#define XB_XCNT(j)  (256  + 64 * (j))
#define XB_XSUB(j)  (1280 + 64 * (j))
#define XB_XGEN(j)  (2304 + 64 * (j))
#define XB_TOP      3328
#define XB_TOPGEN   3392
#define XCD_BAR_WORDS 3456
#define XB_SPIN_CAP (1u << 18)

__device__ __forceinline__ unsigned xb_ld(unsigned* p)              { return __hip_atomic_load(p, __ATOMIC_RELAXED, __HIP_MEMORY_SCOPE_AGENT); }
__device__ __forceinline__ unsigned xb_add(unsigned* p, unsigned v) { return __hip_atomic_fetch_add(p, v, __ATOMIC_RELAXED, __HIP_MEMORY_SCOPE_AGENT); }
__device__ __forceinline__ unsigned xb_xcc_id() { return (unsigned)__builtin_amdgcn_s_getreg((3 << 11) | 20) & 0xFu; }
#define XB_SPIN(cond, bar) do { unsigned _sp = 0; while (cond) { __builtin_amdgcn_s_sleep(1); \
    if ((++_sp & 255u) == 0u) { if (xb_ld(&(bar)[XB_TMO])) break; if (_sp > XB_SPIN_CAP) { atomicAdd(&(bar)[XB_TMO], 1u); break; } } } } while (0)

struct XcdBarrier {
    unsigned* bar; unsigned x;
    volatile LAS unsigned* st;
};

__device__ __forceinline__ XcdBarrier xcd_barrier_post(unsigned* bar, volatile LAS unsigned* st) {
    XcdBarrier b; b.bar = bar; b.x = xb_xcc_id(); b.st = st;
    if (threadIdx.x == 0) (void)xb_add(&bar[XB_XCNT(b.x)], 1u);
    return b;
}
__device__ __forceinline__ void xcd_barrier_complete(unsigned* bar, unsigned x, unsigned& nloc, unsigned& nx) {
    const unsigned G = gridDim.x * gridDim.y * gridDim.z;
    unsigned sum, cnt, mine, sp = 0u;
    for (;;) {
        sum = 0u; cnt = 0u; mine = 0u;
#pragma unroll
        for (unsigned j = 0; j < 16; ++j) { const unsigned c = xb_ld(&bar[XB_XCNT(j)]); sum += c; cnt += (c > 0u) ? 1u : 0u; mine = (j == x) ? c : mine; }
        if (sum == G) break;
        __builtin_amdgcn_s_sleep(1);
        if ((++sp & 255u) == 0u) { if (xb_ld(&bar[XB_TMO])) break; if (sp > XB_SPIN_CAP) { atomicAdd(&bar[XB_TMO], 1u); break; } }
    }
    nloc = mine > 0u ? mine : 1u; nx = cnt > 0u ? cnt : 1u;
}

__device__ __forceinline__ void xcd_barrier(const XcdBarrier& b) {
    asm volatile("s_waitcnt vmcnt(0)" ::: "memory");
    __syncthreads();
    if (threadIdx.x == 0) {
        unsigned* bar = b.bar;
        __builtin_amdgcn_s_waitcnt(0);
        unsigned nloc = b.st[0], nx = b.st[1];
        if (nloc == 0u) { xcd_barrier_complete(bar, b.x, nloc, nx); b.st[0] = nloc; b.st[1] = nx; }
        const unsigned old = xb_add(&bar[XB_XSUB(b.x)], 1u);
        const unsigned gen = old / nloc;
        if (old + 1u == (gen + 1u) * nloc) {
            __builtin_amdgcn_fence(__ATOMIC_RELEASE, "agent");
            asm volatile("s_waitcnt vmcnt(0)" ::: "memory");
            const unsigned og = xb_add(&bar[XB_TOP], 1u);
            const unsigned tg = og / nx;
            if (og + 1u == (tg + 1u) * nx) xb_add(&bar[XB_TOPGEN], 1u);
            else XB_SPIN(xb_ld(&bar[XB_TOPGEN]) == tg, bar);
            __builtin_amdgcn_fence(__ATOMIC_ACQUIRE, "agent");
            xb_add(&bar[XB_XGEN(b.x)], 1u);
            asm volatile("s_waitcnt vmcnt(0)" ::: "memory");
        } else {
            XB_SPIN(xb_ld(&bar[XB_XGEN(b.x)]) == gen, bar);
            __builtin_amdgcn_fence(__ATOMIC_ACQUIRE, "agent");
            asm volatile("s_waitcnt vmcnt(0)" ::: "memory");
        }
    }
    __syncthreads();
}
namespace mattn {
typedef unsigned short bf16;
constexpr int D = 128, NW = 8, QBLK = 32, KVBLK = 64;
constexpr float SCALE = 0.088388347648318440f, THR = 8.f;
constexpr int LDQ = 3072, LDK = 3072, LDO = 1024;
constexpr size_t SHM_V = KVBLK * D * 2, SHM_K = KVBLK * D * 2, SHM_ATTN = 2 * SHM_V + 2 * SHM_K + NW * 64 * 4;
using bf16x8 = __attribute__((ext_vector_type(8))) short;
using s16x4  = __attribute__((ext_vector_type(4))) short;
using f32x16 = __attribute__((ext_vector_type(16))) float;
using u32x4  = __attribute__((ext_vector_type(4))) unsigned;
#define KSWZ(row, colB) ((row) * 256 + ((colB) ^ (((row) & 7) << 4)))
#define SBAR() __builtin_amdgcn_sched_barrier(0)
__device__ __forceinline__ int crow(int r, int hi) { return (r & 3) + 8 * (r >> 2) + 4 * hi; }
__device__ __forceinline__ unsigned cvtpk(float lo, float hi) { unsigned r; asm volatile("v_cvt_pk_bf16_f32 %0, %1, %2" : "=v"(r) : "v"(lo), "v"(hi)); return r; }
struct Msk { int j; unsigned sel; int qpos; };
__device__ __forceinline__ float sconst(unsigned bits) { return __uint_as_float((unsigned)__builtin_amdgcn_readfirstlane((int)bits)); }
__device__ __forceinline__ void partialSM(f32x16& p0, f32x16& p1, float& m_reg, float& mn, float& alpha, int tile, const Msk& mk, int hi) {
  constexpr float C = SCALE * 1.4426950408889634f;
  const int kb = tile >> 2; const bool own = (kb == mk.j), lsel = own || ((mk.sel >> kb) & 1u);
  float pmax = p0[0];
#pragma unroll
for (int r = 1; r < 16; ++r) pmax = fmaxf(pmax, p0[r]);
#pragma unroll
for (int r = 0; r < 16; ++r) pmax = fmaxf(pmax, p1[r]);
  { auto rr = __builtin_amdgcn_permlane32_swap(__float_as_uint(pmax), __float_as_uint(pmax), false, false);
    pmax = fmaxf(__uint_as_float(rr[0]), __uint_as_float(rr[1])); }
  if (!lsel) pmax = sconst(0xf149f2cau);
  if (__builtin_expect(__all(pmax - m_reg <= THR / SCALE), 1)) { mn = m_reg; alpha = 1.f; }
  else { mn = fmaxf(m_reg, pmax); alpha = __builtin_amdgcn_exp2f((m_reg - mn) * C); m_reg = mn; }
  const float mnC = lsel ? -mn * C : sconst(0xff800000u);
#pragma unroll
for (int r = 0; r < 16; ++r) p0[r] = fmaf(p0[r], C, mnC);
#pragma unroll
for (int r = 0; r < 16; ++r) p1[r] = fmaf(p1[r], C, mnC);
#pragma unroll
for (int r = 0; r < 16; ++r) p0[r] = __builtin_amdgcn_exp2f(p0[r]);
}
__device__ __forceinline__ void finishSM(f32x16& p0, f32x16& p1, float alpha, float& l_reg, bf16x8& pa0, bf16x8& pa1, bf16x8& pa2, bf16x8& pa3) {
#pragma unroll
for (int r = 0; r < 16; ++r) p1[r] = __builtin_amdgcn_exp2f(p1[r]);
  float ps = 0;
#pragma unroll
for (int r = 0; r < 16; ++r) ps += p0[r];
#pragma unroll
for (int r = 0; r < 16; ++r) ps += p1[r];
  { auto rr = __builtin_amdgcn_permlane32_swap(__float_as_uint(ps), __float_as_uint(ps), false, false);
    ps = __uint_as_float(rr[0]) + __uint_as_float(rr[1]); }
  l_reg = l_reg * alpha + ps;
#define PK4(P, BASE, OUT) do { unsigned a0 = cvtpk(P[BASE + 0], P[BASE + 1]), a1 = cvtpk(P[BASE + 2], P[BASE + 3]);   \
    unsigned b0 = cvtpk(P[BASE + 4], P[BASE + 5]), b1 = cvtpk(P[BASE + 6], P[BASE + 7]);                              \
    auto r0 = __builtin_amdgcn_permlane32_swap(a0, b0, false, false); auto r1 = __builtin_amdgcn_permlane32_swap(a1, b1, false, false); \
    u32x4 w = {r0[0], r1[0], r0[1], r1[1]}; OUT = *reinterpret_cast<bf16x8*>(&w); } while (0)
  PK4(p0, 0, pa0); PK4(p0, 8, pa1); PK4(p1, 0, pa2); PK4(p1, 8, pa3);
#undef PK4
}
__device__ __forceinline__ void qkt(f32x16& p0, f32x16& p1, const bf16* Ks, const bf16x8* qr, int r32, int hi, int tile, const Msk& mk) {
  if ((tile >> 2) == mk.j) { const float NEGB = sconst(0xf149f2cau); int qp = mk.qpos - (tile & 3) * 64; asm volatile("" : "+v"(qp));
#pragma unroll
    for (int r = 0; r < 16; ++r) { const int k0 = crow(r, hi); p0[r] = (k0 > qp) ? NEGB : 0.f; p1[r] = (k0 + 32 > qp) ? NEGB : 0.f; } }
  else { p0 = f32x16{}; p1 = f32x16{}; }
#pragma unroll
for (int d0 = 0; d0 < 8; ++d0) { int cb = (d0 * 16 + hi * 8) * 2;
    bf16x8 b0 = *reinterpret_cast<const bf16x8*>((const char*)Ks + KSWZ(r32, cb));
    bf16x8 b1 = *reinterpret_cast<const bf16x8*>((const char*)Ks + KSWZ(32 + r32, cb));
    p0 = __builtin_amdgcn_mfma_f32_32x32x16_bf16(b0, qr[d0], p0, 0, 0, 0);
    p1 = __builtin_amdgcn_mfma_f32_32x32x16_bf16(b1, qr[d0], p1, 0, 0, 0); }
}
__device__ __forceinline__ int v_st(int k, int c) { const int kk = (k & ~0xC) | ((k & 4) << 1) | ((k & 8) >> 1); return ((kk >> 3) * 4 + (c >> 5)) * 512 + ((kk & 7) * 32 + (c & 31)) * 2; }
__device__ __forceinline__ int v_rd_base(int lane) { return ((lane & 3) << 3) | (((lane >> 2) & 3) << 6) | (((lane >> 4) & 1) << 5) | (((lane >> 5) & 1) << 8); }
constexpr int v_rd_off(int d0, int ks, int half) { return d0 * 512 + ks * 4096 + half * 2048; }
template <int OFF> __device__ __forceinline__ s16x4 tr_read(int vb) { s16x4 r; asm volatile("ds_read_b64_tr_b16 %0, %1 offset:%2" : "=&v"(r) : "v"(vb), "i"(OFF) : "memory"); return r; }
template <int D0> __device__ __forceinline__ void pv_one(f32x16& od, int vb, bf16x8 pa0, bf16x8 pa1, bf16x8 pa2, bf16x8 pa3) {
  const s16x4 l0 = tr_read<v_rd_off(D0, 0, 0)>(vb), h0 = tr_read<v_rd_off(D0, 0, 1)>(vb), l1 = tr_read<v_rd_off(D0, 1, 0)>(vb), h1 = tr_read<v_rd_off(D0, 1, 1)>(vb);
  const s16x4 l2 = tr_read<v_rd_off(D0, 2, 0)>(vb), h2 = tr_read<v_rd_off(D0, 2, 1)>(vb), l3 = tr_read<v_rd_off(D0, 3, 0)>(vb), h3 = tr_read<v_rd_off(D0, 3, 1)>(vb);
  asm volatile("s_waitcnt lgkmcnt(0)" ::: "memory"); SBAR();
#define PK(L, H) (bf16x8){L[0], L[1], L[2], L[3], H[0], H[1], H[2], H[3]}
  od = __builtin_amdgcn_mfma_f32_32x32x16_bf16(pa0, PK(l0, h0), od, 0, 0, 0);
  od = __builtin_amdgcn_mfma_f32_32x32x16_bf16(pa1, PK(l1, h1), od, 0, 0, 0);
  od = __builtin_amdgcn_mfma_f32_32x32x16_bf16(pa2, PK(l2, h2), od, 0, 0, 0);
  od = __builtin_amdgcn_mfma_f32_32x32x16_bf16(pa3, PK(l3, h3), od, 0, 0, 0);
#undef PK
}
__device__ __forceinline__ void pv_d0(f32x16* o, int vb, bf16x8 pa0, bf16x8 pa1, bf16x8 pa2, bf16x8 pa3) {
  pv_one<0>(o[0], vb, pa0, pa1, pa2, pa3); pv_one<1>(o[1], vb, pa0, pa1, pa2, pa3); pv_one<2>(o[2], vb, pa0, pa1, pa2, pa3); pv_one<3>(o[3], vb, pa0, pa1, pa2, pa3);
}
__device__ __forceinline__ void body(const bf16x8 (&qr)[8], const bf16* __restrict__ Kh, const bf16* __restrict__ Vh, bf16* __restrict__ Ob, int seq, char* lds, const Msk mk) {
  int tid_ = threadIdx.x; asm volatile("" : "+v"(tid_));
  const int tid = tid_, wid = tid >> 6, lane = tid & 63, r32 = lane & 31, hi = lane >> 5;
  bf16* V_lds = (bf16*)lds; bf16* K_lds = (bf16*)(lds + 2 * SHM_V);
  float* ws = (float*)(lds + 2 * SHM_V + 2 * SHM_K) + wid * 64; float* li_l = ws; float* al_l = ws + 32;
  float m_reg = -1e30f, l_reg = 0; f32x16 o[4] = {};
#define VB0() ({ int l2_ = lane; asm volatile("" : "+v"(l2_)); (int)(uintptr_t)V_lds + v_rd_base(l2_); })
  struct { bf16x8 vs0, vs1, ks0, ks1; } sr_[1];
#define STG_IDX() int t2_ = tid; asm volatile("" : "+v"(t2_)); const int sr = t2_ >> 4, sc = (t2_ & 15) * 8
#define SLOAD(i, k0) do { STG_IDX(); const unsigned goff0 = (unsigned)((sr * LDK + sc) * 2), goff1 = (unsigned)(((32 + sr) * LDK + sc) * 2); \
    const char* vb_ = (const char*)(Vh + (long)(k0) * LDK); const char* kb_ = (const char*)(Kh + (long)(k0) * LDK); \
    sr_[i].vs0 = *(const bf16x8*)(vb_ + goff0); sr_[i].vs1 = *(const bf16x8*)(vb_ + goff1); sr_[i].ks0 = *(const bf16x8*)(kb_ + goff0); sr_[i].ks1 = *(const bf16x8*)(kb_ + goff1); } while (0)
#define SWRITE(b, i) do { STG_IDX(); const int vst0 = v_st(sr, sc), vst1 = v_st(32 + sr, sc); *(bf16x8*)((char*)V_lds + (b) * SHM_V + vst0) = sr_[i].vs0; *(bf16x8*)((char*)V_lds + (b) * SHM_V + vst1) = sr_[i].vs1; int kc = sc * 2; \
    *(bf16x8*)((char*)K_lds + (b) * SHM_K + KSWZ(sr, kc)) = sr_[i].ks0; *(bf16x8*)((char*)K_lds + (b) * SHM_K + KSWZ(32 + sr, kc)) = sr_[i].ks1; } while (0)
#define SWAIT() asm volatile("s_waitcnt vmcnt(0)" ::: "memory")
#define RESC(a) do { if (__any((a) < 1.f)) { if (hi == 0) al_l[r32] = (a); asm volatile("s_waitcnt lgkmcnt(0)" ::: "memory"); \
    _Pragma("unroll") for (int d = 0; d < 4; ++d) _Pragma("unroll") for (int r = 0; r < 16; ++r) o[d][r] *= al_l[crow(r, hi)]; } } while (0)
  f32x16 pA0, pA1, pB0, pB1; float mnA, mnB, alA, alB; bf16x8 pa0, pa1, pa2, pa3; const int NT = seq / KVBLK;
  constexpr int SE = 0, SO = 0;
  SLOAD(SE, 0); asm volatile("s_waitcnt vmcnt(0)" ::: "memory"); SWRITE(0, SE); __syncthreads();
  qkt(pA0, pA1, K_lds, qr, r32, hi, 0, mk); partialSM(pA0, pA1, m_reg, mnA, alA, 0, mk, hi);
  SLOAD(SO, KVBLK);
  SWAIT(); SWRITE(1, SO); __syncthreads();
#pragma unroll 1
  for (int j = 1; j + 1 < NT; j += 2) {
    SBAR(); qkt(pB0, pB1, (bf16*)((char*)K_lds + SHM_K), qr, r32, hi, j, mk);
    finishSM(pA0, pA1, alA, l_reg, pa0, pa1, pa2, pa3); SBAR();
    SLOAD(SO, (j + 1) * KVBLK); SBAR();
    pv_d0(o, VB0(), pa0, pa1, pa2, pa3); partialSM(pB0, pB1, m_reg, mnB, alB, j, mk, hi);
    __syncthreads(); SWAIT(); SWRITE(0, SE);
    RESC(alB); __syncthreads();
    SBAR(); qkt(pA0, pA1, K_lds, qr, r32, hi, j + 1, mk);
    finishSM(pB0, pB1, alB, l_reg, pa0, pa1, pa2, pa3); SBAR();
    SLOAD(SE, (j + 2) * KVBLK); SBAR();
    pv_d0(o, VB0() + (int)SHM_V, pa0, pa1, pa2, pa3); partialSM(pA0, pA1, m_reg, mnA, alA, j + 1, mk, hi);
    __syncthreads(); SWAIT(); SWRITE(1, SO);
    RESC(alA); __syncthreads();
  }
  SBAR(); qkt(pB0, pB1, (bf16*)((char*)K_lds + SHM_K), qr, r32, hi, NT - 1, mk);
  finishSM(pA0, pA1, alA, l_reg, pa0, pa1, pa2, pa3); SBAR();
  pv_d0(o, VB0(), pa0, pa1, pa2, pa3); partialSM(pB0, pB1, m_reg, mnB, alB, NT - 1, mk, hi);
  __syncthreads(); RESC(alB);
  finishSM(pB0, pB1, alB, l_reg, pa0, pa1, pa2, pa3); SBAR();
  pv_d0(o, VB0() + (int)SHM_V, pa0, pa1, pa2, pa3);
  if (hi == 0) li_l[r32] = l_reg; asm volatile("s_waitcnt lgkmcnt(0)" ::: "memory");
  float rli[16];
#pragma unroll
for (int r = 0; r < 16; ++r) rli[r] = __builtin_amdgcn_rcpf(li_l[crow(r, hi)]);
  bf16* Ow = Ob + (long)(wid * QBLK) * LDO;
#pragma unroll
for (int r = 0; r < 16; ++r) { int orow = crow(r, hi);
#pragma unroll
for (int d0 = 0; d0 < 4; ++d0) { const float v = o[d0][r] * rli[r]; unsigned u = __float_as_uint(v); u = (u + 0x7fffu + ((u >> 16) & 1u)) >> 16; Ow[(long)orow * LDO + d0 * 32 + r32] = (bf16)u; } }
#undef SLOAD
#undef VB0
#undef STG_IDX
#undef SWRITE
#undef SWAIT
#undef RESC
}
#undef KSWZ
#undef SBAR
}


constexpr int NWAVES = 8, NTHR = 512;
constexpr int MTOK = 32768, DM = 1024, SEQ = 2048, NB = 16, DFF = 2816;
constexpr size_t MiB = 1u << 20;
constexpr size_t WS_CTL = 0, CTL_ZERO_BYTES = 64 * 1024;
constexpr size_t WS_W_MIXIN = 1 * MiB, WS_W_MIXOUT = 13 * MiB, WS_W_FFNIN = 17 * MiB, WS_W_FFNOUT = 28 * MiB;
constexpr size_t WS_GATESA = 34 * MiB, WS_SSQA = 35 * MiB, WS_STATC = 492 * MiB, WS_KMEAN = 41 * MiB, WS_SSQH = 42 * MiB, WS_SPTAB = 33 * MiB + 512 * 1024;
constexpr size_t WS_U = 44 * MiB, WS_BIG = 108 * MiB, WS_END = 500 * MiB;
constexpr int CW_BAR = 1024;
static_assert((CW_BAR + 3456) * 4 <= (int)CTL_ZERO_BYTES, "ctl");
constexpr int LDS_BYTES = 163840, MISC_OFF = 163584;

typedef unsigned u32x4 __attribute__((ext_vector_type(4)));
typedef unsigned u32x2 __attribute__((ext_vector_type(2)));
typedef float f32x2 __attribute__((ext_vector_type(2)));
struct Frame { LAS unsigned char* lds; int tid, lane, wave, G; };
struct Args { const void* in[24]; float* out; unsigned char* ws; int ph_lo, ph_hi; };

__device__ __forceinline__ float wave_sum(float v) {
#pragma unroll
    for (int o = 1; o < 64; o <<= 1) v += __shfl_xor(v, o);
    return v;
}
__device__ __forceinline__ float bf2f(bf16 b) { return __uint_as_float(((unsigned)b) << 16); }
__device__ __forceinline__ float lo_bf(unsigned w) { return __uint_as_float(w << 16); }
__device__ __forceinline__ float hi_bf(unsigned w) { return __uint_as_float(w & 0xffff0000u); }
__device__ __forceinline__ unsigned cvtpk(float lo, float hi) { return pg8::cvt_pk_bf16(lo, hi); }

typedef short v4s16 __attribute__((ext_vector_type(4)));
template <int LD> __device__ __forceinline__ bf16x8 tr_frag(const LAS bf16* T, int r0, int c0, int lane) {
    const int fr = lane & 15, fq = lane >> 4;
    const LAS bf16* a = T + (r0 + 8 * fq + (fr >> 2)) * LD + c0 + 4 * (fr & 3);
    const v4s16 lo = __builtin_amdgcn_ds_read_tr16_b64_v4i16((LAS v4s16*)a);
    const v4s16 hi = __builtin_amdgcn_ds_read_tr16_b64_v4i16((LAS v4s16*)(a + 4 * LD));
    return __builtin_shufflevector(lo, hi, 0, 1, 2, 3, 4, 5, 6, 7);
}
template <int MT, int NT, int K, int LDA, int LDB, bool TA = false, bool TB = false, bool SB = true>
__device__ __forceinline__ void wgemm(f32x4 (&acc)[MT][NT], const LAS bf16* A, const LAS bf16* Bt, int lane) {
    const int fr = lane & 15, fq = lane >> 4;
    const LAS bf16* ap = A + fr * LDA + 8 * fq;
    const LAS bf16* bp = Bt + fr * LDB + 8 * fq;
#pragma unroll
    for (int k0 = 0; k0 < K; k0 += 32) {
        bf16x8 a[MT], b[NT];
#pragma unroll
        for (int i = 0; i < MT; ++i) a[i] = TA ? tr_frag<LDA>(A, k0, 16 * i, lane) : *(const LAS bf16x8*)(ap + 16 * i * LDA + k0);
#pragma unroll
        for (int j = 0; j < NT; ++j) b[j] = TB ? tr_frag<LDB>(Bt, k0, 16 * j, lane) : *(const LAS bf16x8*)(bp + 16 * j * LDB + k0);
#pragma unroll
        for (int i = 0; i < MT; ++i)
#pragma unroll
            for (int j = 0; j < NT; ++j) acc[i][j] = __builtin_amdgcn_mfma_f32_16x16x32_bf16(a[i], b[j], acc[i][j], 0, 0, 0);
        if (SB && MT * NT >= 4) __builtin_amdgcn_sched_barrier(0);
    }
    if (!SB) __builtin_amdgcn_sched_barrier(0);
}

__device__ __forceinline__ int cvt_src_col(int mode, int g0) {
    if (mode == 0) return g0;
    const int pn = g0 >> 8, r = g0 & 255;
    if (mode == 1) return r < 128 ? 128 * pn + r : DFF + 128 * pn + (r - 128);
    return r < 128 ? 128 * pn + r : 256 + 128 * pn + (r - 128);
}
__device__ __forceinline__ void cvt_matrix(Frame& F, const float* W, int ldw, int K, int Np, int mode, bf16* WT, const float* gain = nullptr) {
    LAS float* scr = (LAS float*)(F.lds + F.wave * 16384);
    const int gw = blockIdx.x * NWAVES + F.wave, NGW = F.G * NWAVES, lane = F.lane;
    const int nblk = Np / 32, nitems = (K / 64) * nblk;
    float v[32], vn[32];
#define CVT_LOAD(dst, it) do { const int kb_ = (it) / nblk, nb_ = (it) % nblk, s0_ = cvt_src_col(mode, 32 * nb_); const float* wp_ = W + (size_t)(64 * kb_ + (lane >> 5)) * ldw + s0_ + (lane & 31); \
        _Pragma("unroll") for (int i = 0; i < 32; ++i) dst[i] = wp_[(size_t)(2 * i) * ldw]; } while (0)
    int item = gw;
    if (item < nitems) CVT_LOAD(v, item);
    for (; item < nitems; item += NGW) {
        const int kb = item / nblk, nb = item % nblk, k0 = 64 * kb, n0 = 32 * nb;
        if (item + NGW < nitems) CVT_LOAD(vn, item + NGW);
        if (gain) {
#pragma unroll
            for (int i = 0; i < 32; ++i) v[i] *= gain[k0 + 2 * i + (lane >> 5)]; }
#pragma unroll
        for (int i = 0; i < 32; ++i) scr[(2 * i + (lane >> 5)) * 33 + (lane & 31)] = v[i];
        LDS_WAIT(); asm volatile("" ::: "memory");
        const int c = lane & 7;
#pragma unroll
        for (int j = 0; j < 4; ++j) { const int n = (lane >> 3) + 8 * j; const LAS float* sp = scr + (8 * c) * 33 + n;
            v4u o; o.x = pk2(sp[0 * 33], sp[1 * 33]); o.y = pk2(sp[2 * 33], sp[3 * 33]); o.z = pk2(sp[4 * 33], sp[5 * 33]); o.w = pk2(sp[6 * 33], sp[7 * 33]);
            *(v4u*)(WT + (size_t)(n0 + n) * K + k0 + 8 * c) = o; }
        LDS_WAIT(); asm volatile("" ::: "memory");
#pragma unroll
        for (int i = 0; i < 32; ++i) v[i] = vn[i];
    }
#undef CVT_LOAD
}

__device__ __forceinline__ void norm_phase_b(Frame& F, const bf16* src, const float* gain, bf16* dst) {
    const int gw = blockIdx.x * NWAVES + F.wave, NGW = F.G * NWAVES, lane = F.lane;
    f32x4 g[4];
#pragma unroll
    for (int j = 0; j < 2; ++j) { g[2 * j] = *(const f32x4*)(gain + 8 * lane + 512 * j); g[2 * j + 1] = *(const f32x4*)(gain + 8 * lane + 512 * j + 4); }
    v4u cur[2], nxt[2];
    if (gw < MTOK) {
#pragma unroll
        for (int j = 0; j < 2; ++j) cur[j] = *(const v4u*)(src + (size_t)gw * DM + 8 * lane + 512 * j); }
    for (int m = gw; m < MTOK; m += NGW) {
        if (m + NGW < MTOK) {
#pragma unroll
            for (int j = 0; j < 2; ++j) nxt[j] = *(const v4u*)(src + (size_t)(m + NGW) * DM + 8 * lane + 512 * j); }
        f32x4 v[4]; float s = 0.f;
#pragma unroll
        for (int j = 0; j < 2; ++j) { v[2 * j] = (f32x4){lo_bf(cur[j].x), hi_bf(cur[j].x), lo_bf(cur[j].y), hi_bf(cur[j].y)}; v[2 * j + 1] = (f32x4){lo_bf(cur[j].z), hi_bf(cur[j].z), lo_bf(cur[j].w), hi_bf(cur[j].w)}; }
#pragma unroll
        for (int k = 0; k < 4; ++k) s += (v[k].x * v[k].x + v[k].y * v[k].y) + (v[k].z * v[k].z + v[k].w * v[k].w);
        const float rstd = 1.0f / sqrtf(wave_sum(s) * (1.0f / DM) + 1e-6f);
#pragma unroll
        for (int j = 0; j < 2; ++j) { const f32x4 a = v[2 * j] * rstd * g[2 * j], b = v[2 * j + 1] * rstd * g[2 * j + 1];
            v4u o; o.x = cvtpk(a.x, a.y); o.y = cvtpk(a.z, a.w); o.z = cvtpk(b.x, b.y); o.w = cvtpk(b.z, b.w);
            *(v4u*)(dst + (size_t)m * DM + 8 * lane + 512 * j) = o; }
        cur[0] = nxt[0]; cur[1] = nxt[1];
    }
}
template <bool GATES>
__device__ __forceinline__ void norm_phase(Frame& F, const float* src, const float* gain, bf16* dst, const float* wA, const float* bA, float* gout) {
    LAS float* wg = (LAS float*)F.lds;
    if (GATES) {
        for (int i = F.tid; i < 1024 * 8; i += NTHR) wg[i] = wA[(size_t)(i >> 3) * 3080 + 3072 + (i & 7)];
        __syncthreads();
    }
    const int gw = blockIdx.x * NWAVES + F.wave, NGW = F.G * NWAVES, lane = F.lane;
    f32x4 g[4];
#pragma unroll
    for (int j = 0; j < 4; ++j) g[j] = ((const f32x4*)gain)[lane + 64 * j];
    for (int m = gw; m < MTOK; m += NGW) {
        const f32x4* xr = (const f32x4*)(src + (size_t)m * DM) + lane;
        f32x4 v[4]; float s = 0.f;
#pragma unroll
        for (int j = 0; j < 4; ++j) { v[j] = xr[64 * j]; s += (v[j].x * v[j].x + v[j].y * v[j].y) + (v[j].z * v[j].z + v[j].w * v[j].w); }
        const float rstd = 1.0f / sqrtf(wave_sum(s) * (1.0f / DM) + 1e-6f);
        unsigned long long* o8 = (unsigned long long*)(dst + (size_t)m * DM) + lane;
#pragma unroll
        for (int j = 0; j < 4; ++j) { v[j] = v[j] * rstd * g[j];
            o8[64 * j] = (unsigned long long)cvtpk(v[j].x, v[j].y) | ((unsigned long long)cvtpk(v[j].z, v[j].w) << 32); }
        if (GATES) {
            float a[8];
#pragma unroll
            for (int q = 0; q < 8; ++q) a[q] = 0.f;
#pragma unroll
            for (int j = 0; j < 4; ++j)
#pragma unroll
                for (int e = 0; e < 4; ++e) { const int k = 4 * lane + 256 * j + e; const f32x4 w0 = *(const LAS f32x4*)(wg + k * 8), w1 = *(const LAS f32x4*)(wg + k * 8 + 4); const float x = v[j][e];
                    a[0] += x * w0.x; a[1] += x * w0.y; a[2] += x * w0.z; a[3] += x * w0.w; a[4] += x * w1.x; a[5] += x * w1.y; a[6] += x * w1.z; a[7] += x * w1.w; }
#pragma unroll
            for (int q = 0; q < 8; ++q) a[q] = wave_sum(a[q]);
            if (lane == 0) {
#pragma unroll
                for (int q = 0; q < 8; ++q) gout[(size_t)m * 8 + q] = a[q] + bA[q]; }
        }
    }
}

__device__ __forceinline__ void mlstm_pre(Frame& F, const float* gates, float* GT) {
    LAS float* sA = (LAS float*)F.lds, *sPM = sA + 2048, *sBC = sPM + 2048, *sBT = sBC + 2048, *sP63 = sBT + 32, *sM = sP63 + 32;
    const int lane = F.lane, w = F.wave;
    for (int item = blockIdx.x; item < 64; item += F.G) {
        const int b = item >> 2, h = item & 3;
        __syncthreads();
        float gi4[4], gf4[4];
#pragma unroll
        for (int i = 0; i < 4; ++i) { const size_t row = (size_t)b * SEQ + (w + 8 * i) * 64 + lane; gi4[i] = gates[row * 8 + h]; gf4[i] = gates[row * 8 + 4 + h]; }
#pragma unroll
        for (int i = 0; i < 4; ++i) { const int c = w + 8 * i;
            const float gi = gi4[i], gf = gf4[i];
            const float fc = fminf(gf, 0.f) - log1pf(__expf(-fabsf(gf)));
            float bc = fc;
#pragma unroll
            for (int o = 1; o < 64; o <<= 1) { const float t = __shfl_up(bc, o); if (lane >= o) bc += t; }
            const float a = gi - bc; float pm = a;
#pragma unroll
            for (int o = 1; o < 64; o <<= 1) { const float t = __shfl_up(pm, o); if (lane >= o) pm = fmaxf(pm, t); }
            sA[c * 64 + lane] = a; sPM[c * 64 + lane] = pm; sBC[c * 64 + lane] = bc; if (lane == 63) { sBT[c] = bc; sP63[c] = pm; } }
        __syncthreads();
        if (F.tid == 0) { float m = 0.f; for (int c = 0; c < 32; ++c) { sM[c] = m; m = sBT[c] + fmaxf(m, sP63[c]); } }
        __syncthreads();
#pragma unroll
        for (int i = 0; i < 4; ++i) { const int c = w + 8 * i; const float mst = sM[c], Mx = fmaxf(mst, sPM[c * 64 + lane]), Mx63 = fmaxf(mst, sP63[c]);
            float* g = GT + ((size_t)(item * 32 + c)) * 320 + lane;
            g[0] = sA[c * 64 + lane]; g[64] = Mx; g[128] = __expf(mst - Mx); g[192] = __expf(-(sBC[c * 64 + lane] + Mx)); g[256] = __expf(sA[c * 64 + lane] - Mx63); }
    }
}
__device__ __forceinline__ void mlstm_pmat(Frame& F, const bf16* QKV, const float* GT, bf16* PMA, float* DENP) {
    constexpr float SCALE = 0.08838834764831845f;
    LAS bf16* Qs = (LAS bf16*)F.lds;
    LAS bf16* Ks = Qs + 64 * 136;
    LAS bf16* Ps = Ks + 64 * 136;
    LAS float* fA = (LAS float*)(Ps + 64 * 72), *fMX = fA + 64;
    const int tid = F.tid, lane = F.lane, w = F.wave, fr = lane & 15, fq = lane >> 4, wh = w >> 1, wl = w & 1;
    const unsigned qoff0 = (unsigned)((((tid >> 4) * 2048) + (tid & 15) * 8) * 2);
    v4u pQ[2], pK[2]; float pg = 0.f;
    int item = blockIdx.x;
    if (item < 2048) { const int bh = item >> 5, c = item & 31; const char* gq = (const char*)(QKV + ((size_t)(bh >> 2) * SEQ + c * 64) * 2048 + (bh & 3) * 128);
#pragma unroll
        for (int i = 0; i < 2; ++i) { pQ[i] = *(const v4u*)(gq + qoff0 + i * (32 * 2048 * 2)); pK[i] = *(const v4u*)(gq + qoff0 + i * (32 * 2048 * 2) + 1024); }
        if (tid < 128) pg = GT[(size_t)item * 320 + tid]; }
    for (; item < 2048; item += F.G) {
        __syncthreads();
#pragma unroll
        for (int i = 0; i < 2; ++i) { const int id = tid + NTHR * i, row = id >> 4, c8 = id & 15; *(LAS v4u*)(Qs + row * 136 + c8 * 8) = pQ[i]; *(LAS v4u*)(Ks + row * 136 + c8 * 8) = pK[i]; }
        if (tid < 128) fA[tid] = pg;
        const int nit = item + F.G;
        if (nit < 2048) { const int bh = nit >> 5, c = nit & 31; const char* gq = (const char*)(QKV + ((size_t)(bh >> 2) * SEQ + c * 64) * 2048 + (bh & 3) * 128);
#pragma unroll
            for (int i = 0; i < 2; ++i) { pQ[i] = *(const v4u*)(gq + qoff0 + i * (32 * 2048 * 2)); pK[i] = *(const v4u*)(gq + qoff0 + i * (32 * 2048 * 2) + 1024); }
            if (tid < 128) pg = GT[(size_t)nit * 320 + tid]; }
        __syncthreads();
        f32x4 sa[1][2]; sa[0][0] = (f32x4){0.f, 0.f, 0.f, 0.f}; sa[0][1] = sa[0][0];
        wgemm<1, 2, 128, 136, 136>(sa, Qs + 16 * wh * 136, Ks + 32 * wl * 136, lane);
        float rs[4] = {0.f, 0.f, 0.f, 0.f};
#pragma unroll
        for (int e = 0; e < 4; ++e) { const int t = 16 * wh + 4 * fq + e; const float mx = fMX[t];
#pragma unroll
            for (int j = 0; j < 2; ++j) { const int sidx = 32 * wl + 16 * j + fr; const float wgt = (sidx <= t) ? SCALE * __expf(fA[sidx] - mx) : 0.f; const float p = sa[0][j][e] * wgt;
                Ps[t * 72 + sidx] = (bf16)f2bf(p); rs[e] += p; } }
#pragma unroll
        for (int e = 0; e < 4; ++e) { float r = rs[e]; r += __shfl_xor(r, 1); r += __shfl_xor(r, 2); r += __shfl_xor(r, 4); r += __shfl_xor(r, 8); if (fr == 0) DENP[(size_t)item * 128 + wl * 64 + 16 * wh + 4 * fq + e] = r; }
        __syncthreads();
        *(v4u*)(PMA + (size_t)item * 4096 + (tid >> 3) * 64 + (tid & 7) * 8) = *(const LAS v4u*)(Ps + (tid >> 3) * 72 + (tid & 7) * 8);
    }
}
__device__ __forceinline__ void mlstm_core(Frame& F, const bf16* QKV, const float* GT, const bf16* PMA, const float* DENP, bf16* hout, float* ssq) {
    constexpr float SCALE = 0.08838834764831845f;
    LAS bf16* Qs = (LAS bf16*)F.lds;
    LAS bf16* Ks = Qs + 64 * 136;
    LAS bf16* Vs = Ks + 64 * 144;
    LAS bf16* VWs = Vs + 64 * 80;
    LAS bf16* Cb = VWs + 64 * 80;
    LAS bf16* Ps = Cb + 80 * 136;
    LAS bf16* Hs = Ps + 64 * 72;
    const int tid = F.tid, lane = F.lane, w = F.wave, fr = lane & 15, fq = lane >> 4, wh = w >> 1, wl = w & 1;
    const unsigned qoff0 = (unsigned)((((tid >> 4) * 2048) + (tid & 15) * 8) * 2), voff0 = (unsigned)((((tid >> 3) * 2048) + (tid & 7) * 8) * 2);
    for (int item = blockIdx.x; item < 256; item += F.G) {
        const int b = item >> 4, h = (item >> 2) & 3, vs = item & 3, bh = b * 4 + h;
        f32x4 Cacc[1][4], Cn[1][1];
#pragma unroll
        for (int j = 0; j < 4; ++j) Cacc[0][j] = (f32x4){0.f, 0.f, 0.f, 0.f};
        Cn[0][0] = (f32x4){0.f, 0.f, 0.f, 0.f};
        const size_t tb = (size_t)b * SEQ;
        v4u pQ[2], pK[2], pV, pP; float pws, pwc, pwi[4], pem[4], pdn[4];
#define MLSTM_FETCH(cc) do { const size_t t0_ = tb + (size_t)(cc) * 64; const char* gq_ = (const char*)(QKV + t0_ * 2048 + h * 128); const char* gv_ = (const char*)(QKV + t0_ * 2048 + 1024 + h * 256 + vs * 64); \
            _Pragma("unroll") for (int i = 0; i < 2; ++i) { pQ[i] = *(const v4u*)(gq_ + qoff0 + i * (32 * 2048 * 2)); pK[i] = *(const v4u*)(gq_ + qoff0 + i * (32 * 2048 * 2) + 1024); } \
            pV = *(const v4u*)(gv_ + voff0); const size_t it_ = (size_t)(bh * 32 + (cc)); pP = *(const v4u*)(PMA + it_ * 4096 + (tid >> 3) * 64 + (tid & 7) * 8); \
            const float* g_ = GT + it_ * 320; pws = g_[256 + (tid >> 3)]; pwc = g_[128 + 63]; \
            _Pragma("unroll") for (int e = 0; e < 4; ++e) { const int t_ = 16 * wh + 4 * fq + e; pwi[e] = g_[128 + t_]; pem[e] = g_[192 + t_]; pdn[e] = DENP[it_ * 128 + t_] + DENP[it_ * 128 + 64 + t_]; } } while (0)
        MLSTM_FETCH(0);
        for (int c = 0; c < 32; ++c) {
            const size_t t0 = tb + c * 64;
            __syncthreads();
            v4u hprev; if (c > 0) hprev = *(const LAS v4u*)(Hs + (tid >> 3) * 72 + (tid & 7) * 8);
#pragma unroll
            for (int j = 0; j < 4; ++j)
#pragma unroll
                for (int e = 0; e < 4; ++e) Cb[(16 * wh + 4 * fq + e) * 136 + 64 * wl + 16 * j + fr] = (bf16)f2bf(Cacc[0][j][e]);
#pragma unroll
            for (int e = 0; e < 4; ++e) Cb[(64 + 4 * fq + e) * 136 + 16 * w + fr] = (bf16)f2bf(Cn[0][0][e]);
#pragma unroll
            for (int i = 0; i < 2; ++i) { const int id = tid + NTHR * i, row = id >> 4, c8 = id & 15; *(LAS v4u*)(Qs + row * 136 + c8 * 8) = pQ[i]; *(LAS v4u*)(Ks + row * 144 + c8 * 8) = pK[i]; }
            { const int srow = tid >> 3, c8 = tid & 7; const float wsv = pws;
                *(LAS v4u*)(Vs + srow * 80 + c8 * 8) = pV;
                v4u o; o.x = cvtpk(lo_bf(pV.x) * wsv, hi_bf(pV.x) * wsv); o.y = cvtpk(lo_bf(pV.y) * wsv, hi_bf(pV.y) * wsv); o.z = cvtpk(lo_bf(pV.z) * wsv, hi_bf(pV.z) * wsv); o.w = cvtpk(lo_bf(pV.w) * wsv, hi_bf(pV.w) * wsv);
                *(LAS v4u*)(VWs + srow * 80 + c8 * 8) = o;
                if (c8 < 2) { v4u one; one.x = c8 == 0 ? 0x3f80u : 0u; one.y = 0u; one.z = 0u; one.w = 0u; *(LAS v4u*)(Vs + srow * 80 + 64 + c8 * 8) = one;
                    v4u wv; wv.x = c8 == 0 ? (cvtpk(wsv, 0.f) & 0xffffu) : 0u; wv.y = 0u; wv.z = 0u; wv.w = 0u; *(LAS v4u*)(VWs + srow * 80 + 64 + c8 * 8) = wv; }
                *(LAS v4u*)(Ps + srow * 72 + c8 * 8) = pP; }
            float wi[4], em[4], dn[4]; const float wc = pwc;
#pragma unroll
            for (int e = 0; e < 4; ++e) { wi[e] = pwi[e]; em[e] = pem[e]; dn[e] = pdn[e]; }
            if (c < 31) MLSTM_FETCH(c + 1);
            if (c > 0) *(v4u*)(hout + (t0 - 64 + (tid >> 3)) * 1024 + h * 256 + vs * 64 + (tid & 7) * 8) = hprev;
            __syncthreads();
            f32x4 ni[1][2], nx[1][2], nq[1][1]; ni[0][0] = (f32x4){0.f, 0.f, 0.f, 0.f}; ni[0][1] = ni[0][0]; nx[0][0] = ni[0][0]; nx[0][1] = ni[0][0]; nq[0][0] = ni[0][0];
            wgemm<1, 2, 64, 72, 80, false, true>(ni, Ps + 16 * wh * 72, Vs + 32 * wl, lane);
            wgemm<1, 2, 128, 136, 136>(nx, Qs + 16 * wh * 136, Cb + 32 * wl * 136, lane);
            wgemm<1, 1, 128, 136, 136>(nq, Qs + 16 * wh * 136, Cb + 64 * 136, lane);
#pragma unroll
            for (int e = 0; e < 4; ++e) { const int t = 16 * wh + 4 * fq + e;
                const float nqt = __shfl(nq[0][0][e], lane & 48);
                const float den = dn[e] + wi[e] * SCALE * nqt; const float inv = 1.0f / fmaxf(fabsf(den), em[e]); float q2 = 0.f;
#pragma unroll
                for (int j = 0; j < 2; ++j) { const float hv = (ni[0][j][e] + SCALE * wi[e] * nx[0][j][e]) * inv; q2 += hv * hv;
                    Hs[t * 72 + 32 * wl + 16 * j + fr] = (bf16)f2bf(hv); }
                q2 += __shfl_xor(q2, 1); q2 += __shfl_xor(q2, 2); q2 += __shfl_xor(q2, 4); q2 += __shfl_xor(q2, 8);
                if (fr == 0) ssq[(t0 + t) * 32 + (h * 4 + vs) * 2 + wl] = q2; }
#pragma unroll
            for (int j = 0; j < 4; ++j) Cacc[0][j] = Cacc[0][j] * wc;
            Cn[0][0] = Cn[0][0] * wc;
            wgemm<1, 4, 64, 80, 144, true, true>(Cacc, VWs + 16 * wh, Ks + 64 * wl, lane);
            wgemm<1, 1, 64, 80, 144, true, true>(Cn, VWs + 64, Ks + 16 * w, lane);
        }
        __syncthreads();
        *(v4u*)(hout + (tb + 31 * 64 + (tid >> 3)) * 1024 + h * 256 + vs * 64 + (tid & 7) * 8) = *(const LAS v4u*)(Hs + (tid >> 3) * 72 + (tid & 7) * 8);
#undef MLSTM_FETCH
    }
}

__device__ __forceinline__ void moba_prep(Frame& F, bf16* QK, const int* pos, const float* gq, const float* gk, float* kpart) {
    LAS float* part = (LAS float*)F.lds;
    const int lane = F.lane, w = F.wave, c = lane & 15;
    float gqv[8], gkv[8], inv[8];
#pragma unroll
    for (int e = 0; e < 8; ++e) { gqv[e] = gq[c * 8 + e]; gkv[e] = gk[c * 8 + e]; inv[e] = exp2f(-(float)(8 * (c & 1) + e) * (18.931568569324174f / 16.0f)); }
    for (int item = blockIdx.x; item < 256; item += F.G) {
        const int b = item >> 4, blk = (item >> 1) & 7, half = item & 1;
        const size_t row0 = (size_t)b * SEQ + blk * 256 + half * 128 + 16 * w;
        float kacc[2][8];
#pragma unroll
        for (int i = 0; i < 2; ++i)
#pragma unroll
            for (int e = 0; e < 8; ++e) kacc[i][e] = 0.f;
        v4u cur[4], nxt[4];
#pragma unroll
        for (int i4 = 0; i4 < 4; ++i4) cur[i4] = *(const v4u*)(QK + row0 * 3072 + (lane + 64 * i4) * 8);
        for (int t = 0; t < 16; ++t) {
            const size_t row = row0 + t;
            if (t < 15) {
#pragma unroll
                for (int i4 = 0; i4 < 4; ++i4) nxt[i4] = *(const v4u*)(QK + (row + 1) * 3072 + (lane + 64 * i4) * 8); }
            float cs[8], sn[8];
            if (c < 4) { const float ps = (float)pos[row];
#pragma unroll
                for (int e = 0; e < 8; ++e) sincosf(ps * inv[e], &sn[e], &cs[e]); }
            else {
#pragma unroll
                for (int e = 0; e < 8; ++e) { cs[e] = 1.f; sn[e] = 0.f; } }
#pragma unroll
            for (int i4 = 0; i4 < 4; ++i4) {
                const unsigned xw[4] = {cur[i4].x, cur[i4].y, cur[i4].z, cur[i4].w}; float y[8]; float ss = 0.f;
#pragma unroll
                for (int e = 0; e < 4; ++e) { y[2 * e] = lo_bf(xw[e]); y[2 * e + 1] = hi_bf(xw[e]); ss += y[2 * e] * y[2 * e] + y[2 * e + 1] * y[2 * e + 1]; }
                ss += __shfl_xor(ss, 1); ss += __shfl_xor(ss, 2); ss += __shfl_xor(ss, 4); ss += __shfl_xor(ss, 8);
                const float rstd = 1.0f / sqrtf(ss * (1.0f / 128.0f) + 1e-6f);
#pragma unroll
                for (int e = 0; e < 8; ++e) { y[e] = y[e] * rstd * (i4 < 2 ? gqv[e] : gkv[e]); }
#pragma unroll
                for (int e = 0; e < 8; ++e) { const float o = __shfl_xor(y[e], 2); y[e] = (c < 2) ? y[e] * cs[e] - o * sn[e] : (c < 4 ? y[e] * cs[e] + o * sn[e] : y[e]); }
                v4u ov; ov.x = cvtpk(y[0], y[1]); ov.y = cvtpk(y[2], y[3]); ov.z = cvtpk(y[4], y[5]); ov.w = cvtpk(y[6], y[7]);
                *(v4u*)(QK + row * 3072 + (lane + 64 * i4) * 8) = ov;
                if (i4 >= 2) {
#pragma unroll
                    for (int e = 0; e < 8; ++e) kacc[i4 - 2][e] += y[e]; }
            }
#pragma unroll
            for (int i4 = 0; i4 < 4; ++i4) cur[i4] = nxt[i4];
        }
        __syncthreads();
#pragma unroll
        for (int i = 0; i < 2; ++i)
#pragma unroll
            for (int e = 0; e < 8; ++e) part[w * 1024 + i * 512 + lane * 8 + e] = kacc[i][e];
        __syncthreads();
        for (int col = F.tid; col < 1024; col += NTHR) { float sacc = 0.f;
#pragma unroll
            for (int ww = 0; ww < 8; ++ww) sacc += part[ww * 1024 + col];
            kpart[((size_t)(b * 8 + blk) * 2 + half) * 1024 + col] = sacc * (1.0f / 256.0f); }
    }
}
__device__ __forceinline__ void moba_attn(Frame& F, const bf16* QKV, const float* kpart, bf16* O) {
    char* ldsg = (char*)F.lds;
    LAS float* kmS = (LAS float*)(F.lds + mattn::SHM_ATTN);
    for (int it = blockIdx.x; it < 1024; it += F.G) {
        int tid_ = threadIdx.x; asm volatile("" : "+v"(tid_));
        const int tid = tid_, lane = tid & 63, w = __builtin_amdgcn_readfirstlane(tid >> 6), r32 = lane & 31, hi = lane >> 5;
        const int c = it & 255, r = it >> 8, bh = c & 127, typ = c >> 7, b = bh >> 3, h = bh & 7;
        const int jb = (r & 1) ? 7 - (r >> 1) : (r >> 1);
        const int j = typ ? ((r & 1) ? jb - 2 : jb + 2) : jb;
        const size_t qrow0 = (size_t)b * SEQ + j * 256;
        __syncthreads();
        for (int i = tid; i < 1024; i += NTHR) { const int kb_ = i >> 7, d_ = i & 127; const float* kp = kpart + ((size_t)(b * 8 + kb_) * 2) * 1024 + h * 128 + d_; kmS[i] = kp[0] + kp[1024]; }
        mattn::bf16x8 qr[8];
        { const bf16* Qw = QKV + (qrow0 + w * 32 + r32) * 3072 + h * 128 + hi * 8;
#pragma unroll
            for (int d0 = 0; d0 < 8; ++d0) qr[d0] = *(const mattn::bf16x8*)(Qw + d0 * 16); }
        __syncthreads();
        unsigned sel = 0u;
        if (j <= 3) sel = (1u << j) - 1u;
        else { float v0 = -INFINITY, v1 = -INFINITY, v2 = -INFINITY; int i0 = 0, i1 = 0, i2 = 0;
#pragma unroll 1
            for (int blk = 0; blk < j; ++blk) { float sdot = 0.f; const LAS float* km = kmS + blk * 128 + hi * 8;
#pragma unroll
                for (int d0 = 0; d0 < 8; ++d0) asm volatile("" : "+v"(qr[d0]));
#pragma unroll
                for (int d0 = 0; d0 < 8; ++d0) {
#pragma unroll
                    for (int e = 0; e < 8; ++e) sdot += __uint_as_float(((unsigned)(unsigned short)qr[d0][e]) << 16) * km[d0 * 16 + e];
                    __builtin_amdgcn_sched_barrier(0); }
                auto rr = __builtin_amdgcn_permlane32_swap(__float_as_uint(sdot), __float_as_uint(sdot), false, false);
                sdot = __uint_as_float(rr[0]) + __uint_as_float(rr[1]);
                if (sdot > v0) { v2 = v1; i2 = i1; v1 = v0; i1 = i0; v0 = sdot; i0 = blk; }
                else if (sdot > v1) { v2 = v1; i2 = i1; v1 = sdot; i1 = blk; }
                else if (sdot > v2) { v2 = sdot; i2 = blk; } }
            sel = (1u << i0) | (1u << i1) | (1u << i2); }
        const mattn::Msk mk{j, sel, w * 32 + r32};
        const bf16* Kh = QKV + ((size_t)b * SEQ) * 3072 + 1024 + h * 128;
        mattn::body(qr, Kh, Kh + 1024, O + qrow0 * 1024 + h * 128, (j + 1) * 256, ldsg, mk);
    }
}

__device__ __forceinline__ void ret_rot_table(Frame& F, const int* pos, float* cst) {
    const int gw = blockIdx.x * NWAVES + F.wave, NGW = F.G * NWAVES, lane = F.lane;
    const float i0 = exp2f(-(float)(2 * lane) * (13.287712379549449f / 128.0f)), i1 = exp2f(-(float)(2 * lane + 1) * (13.287712379549449f / 128.0f));
    for (int m = gw; m < MTOK; m += NGW) {
        const float ps = (float)pos[m]; float s0, c0, s1, c1; sincosf(ps * i0, &s0, &c0); sincosf(ps * i1, &s1, &c1);
        f32x2* cp = (f32x2*)(cst + (size_t)m * 256) + lane; cp[0] = (f32x2){c0, c1}; cp[64] = (f32x2){s0, s1};
    }
}
__device__ __forceinline__ void ret_pmat(Frame& F, const bf16* QKV, bf16* PM) {
    LAS bf16* Qd = (LAS bf16*)F.lds;
    LAS bf16* Kd = Qd + 128 * 72;
    LAS bf16* Ps = Kd + 128 * 72;
    const int tid = F.tid, lane = F.lane, w = F.wave, fr = lane & 15, fq = lane >> 4, wh = w >> 1, wl = w & 1;
    const unsigned off0 = (unsigned)((((tid >> 3) * 4096) + (tid & 7) * 8) * 2);
    for (int item = blockIdx.x; item < 1024; item += F.G) {
        const int b = item >> 6, h = (item >> 4) & 3, c = item & 15;
        const float lgc = log1pf(-exp2f(-5.0f - (float)h)) * 1.4426950408889634f;
        const char* gq = (const char*)(QKV + ((size_t)b * SEQ + c * 128) * 4096 + h * 256);
        v4u pq[2], pkk[2];
#pragma unroll
        for (int i = 0; i < 2; ++i) { const char* src = gq + off0 + i * (64 * 4096 * 2); pq[i] = *(const v4u*)src; pkk[i] = *(const v4u*)(src + 2048); }
        f32x4 S[2][4];
#pragma unroll
        for (int i = 0; i < 2; ++i)
#pragma unroll
            for (int jj = 0; jj < 4; ++jj) S[i][jj] = (f32x4){0.f, 0.f, 0.f, 0.f};
#pragma unroll 1
        for (int dt = 0; dt < 4; ++dt) {
            __syncthreads();
#pragma unroll
            for (int i = 0; i < 2; ++i) { const int id = tid + NTHR * i, row = id >> 3, c8 = id & 7; *(LAS v4u*)(Qd + row * 72 + c8 * 8) = pq[i]; *(LAS v4u*)(Kd + row * 72 + c8 * 8) = pkk[i]; }
            if (dt < 3) {
#pragma unroll
                for (int i = 0; i < 2; ++i) { const char* src = gq + (dt + 1) * 128 + off0 + i * (64 * 4096 * 2); pq[i] = *(const v4u*)src; pkk[i] = *(const v4u*)(src + 2048); } }
            __syncthreads();
            wgemm<2, 4, 64, 72, 72>(S, Qd + 32 * wh * 72, Kd + 64 * wl * 72, lane);
        }
#pragma unroll
        for (int i = 0; i < 2; ++i)
#pragma unroll
            for (int e = 0; e < 4; ++e) { const int t = 32 * wh + 16 * i + 4 * fq + e;
#pragma unroll
                for (int jj = 0; jj < 4; ++jj) { const int sidx = 64 * wl + 16 * jj + fr; const float wgt = (t >= sidx) ? __builtin_amdgcn_exp2f((float)(t - sidx) * lgc) : 0.f;
                    Ps[t * 136 + sidx] = (bf16)f2bf(S[i][jj][e] * wgt); } }
        __syncthreads();
        bf16* dst = PM + (size_t)item * 128 * 128;
#pragma unroll
        for (int i = 0; i < 4; ++i) { const int id = tid + NTHR * i, row = id >> 4, c8 = id & 15; *(v4u*)(dst + row * 128 + c8 * 8) = *(const LAS v4u*)(Ps + row * 136 + c8 * 8); }
    }
}
#ifndef RET_EXP
#define RET_EXP 0
#endif
__device__ __forceinline__ void ret_core(Frame& F, bf16* QKV, const bf16* PM, float* st) {
    constexpr int TSET = 3 * 128 * 72;
    LAS bf16* T0 = (LAS bf16*)F.lds;
    LAS bf16* Vs = T0 + 2 * TSET;
    LAS bf16* Ps = T0;
    LAS bf16* Xs = T0 + TSET;
    LAS float* fST = (LAS float*)(Vs + 128 * 144);
    const int tid = F.tid, lane = F.lane, w = F.wave, fr = lane & 15, fq = lane >> 4, wh = w >> 1, wl = w & 1;
    const unsigned off8 = (unsigned)((((tid >> 3) * 4096) + (tid & 7) * 8) * 2);
    const unsigned off16 = (unsigned)((((tid >> 4) * 4096) + (tid & 15) * 8) * 2);
    for (int item = blockIdx.x; item < 256; item += F.G) {
        const int b = item >> 4, h = (item >> 2) & 3, vs = item & 3;
        const float lg = log1pf(-exp2f(-5.0f - (float)h)), gch = expf(128.0f * lg);
        f32x4 Racc[4][1][4];
#pragma unroll
        for (int dt = 0; dt < 4; ++dt)
#pragma unroll
            for (int jj = 0; jj < 4; ++jj) Racc[dt][0][jj] = (f32x4){0.f, 0.f, 0.f, 0.f};
        const size_t tb = (size_t)b * SEQ;
        __syncthreads();
        v4u pq[2], pkk[2], pv[4];
        { const char* gq0 = (const char*)(QKV + tb * 4096 + h * 256); const char* gv0 = (const char*)(QKV + tb * 4096 + 2048 + h * 512 + vs * 128);
#pragma unroll
            for (int i = 0; i < 2; ++i) { const char* src = gq0 + off8 + i * (64 * 4096 * 2); pq[i] = *(const v4u*)src; pkk[i] = *(const v4u*)(src + 2048); }
#pragma unroll
            for (int i = 0; i < 4; ++i) pv[i] = *(const v4u*)(gv0 + off16 + i * (32 * 4096 * 2)); }
        for (int c = 0; c < 16; ++c) {
            const size_t t0 = tb + c * 128;
            const char* gq = (const char*)(QKV + t0 * 4096 + h * 256);
            char* gy = (char*)(QKV + t0 * 4096 + 2048 + h * 512 + vs * 128);
            const bf16* pmt = PM + ((size_t)((b * 4 + h) * 16 + c)) * 128 * 128;
            float lgc = lg * 1.4426950408889634f; asm volatile("" : "+v"(lgc));
#pragma unroll
            for (int i = 0; i < 4; ++i) { const int id = tid + NTHR * i; *(LAS v4u*)(Vs + (id >> 4) * 144 + (id & 15) * 8) = pv[i]; }
            f32x4 X[2][4];
#pragma unroll
            for (int i = 0; i < 2; ++i)
#pragma unroll
                for (int jj = 0; jj < 4; ++jj) X[i][jj] = (f32x4){0.f, 0.f, 0.f, 0.f};
#pragma unroll 1
            for (int dt = 0; dt < 4; ++dt) {
                LAS bf16* Qd = T0 + (dt & 1) * TSET; LAS bf16* Kz = Qd + 128 * 72; LAS bf16* Rb = Kz + 128 * 72;
#pragma unroll
                for (int i = 0; i < 2; ++i) { const int id = tid + NTHR * i, row = id >> 3, c8 = id & 7; const float z = __builtin_amdgcn_exp2f((float)(127 - row) * lgc);
                    *(LAS v4u*)(Qd + row * 72 + c8 * 8) = pq[i];
                    v4u zo; zo.x = cvtpk(lo_bf(pkk[i].x) * z, hi_bf(pkk[i].x) * z); zo.y = cvtpk(lo_bf(pkk[i].y) * z, hi_bf(pkk[i].y) * z); zo.z = cvtpk(lo_bf(pkk[i].z) * z, hi_bf(pkk[i].z) * z); zo.w = cvtpk(lo_bf(pkk[i].w) * z, hi_bf(pkk[i].w) * z);
                    *(LAS v4u*)(Kz + row * 72 + c8 * 8) = zo; }
#pragma unroll
                for (int jj = 0; jj < 4; ++jj)
#pragma unroll
                    for (int e = 0; e < 4; ++e) Rb[(16 * w + 4 * fq + e) * 72 + 16 * jj + fr] = (bf16)f2bf(Racc[0][0][jj][e]);
#if RET_EXP == 3
                asm volatile("" ::: "memory");
#pragma unroll
                for (int jj = 0; jj < 4; ++jj)
#pragma unroll
                    for (int e = 0; e < 4; ++e) *(volatile LAS bf16*)(Rb + (16 * w + 4 * fq + e) * 72 + 16 * jj + fr) = (bf16)f2bf(Racc[0][0][jj][e]);
#endif
                if (dt < 3 || c < 15) {
                    const char* nb = (dt < 3) ? gq + (dt + 1) * 128 : gq + (size_t)128 * 4096 * 2;
#pragma unroll
                    for (int i = 0; i < 2; ++i) { const char* src = nb + off8 + i * (64 * 4096 * 2); pq[i] = *(const v4u*)src; pkk[i] = *(const v4u*)(src + 2048); } }
                __syncthreads();
                wgemm<2, 4, 64, 72, 72, false, false, false>(X, Qd + 32 * wh * 72, Rb + 64 * wl * 72, lane);
#if RET_EXP == 5
                { f32x4 D_[2][4];
#pragma unroll
                  for (int i = 0; i < 2; ++i)
#pragma unroll
                    for (int jj = 0; jj < 4; ++jj) D_[i][jj] = (f32x4){0.f, 0.f, 0.f, 0.f};
                  wgemm<2, 4, 64, 72, 72>(D_, Qd + 32 * wh * 72, Rb + 64 * wl * 72, lane);
#pragma unroll
                  for (int i = 0; i < 2; ++i)
#pragma unroll
                    for (int jj = 0; jj < 4; ++jj) asm volatile("" :: "v"(D_[i][jj])); }
#endif
#if RET_EXP == 6
                { f32x4 D_[1][4];
#pragma unroll
                    for (int jj = 0; jj < 4; ++jj) D_[0][jj] = (f32x4){0.f, 0.f, 0.f, 0.f};
                  wgemm<1, 4, 128, 136, 72, true, true>(D_, Vs + 16 * w, Kz, lane);
#pragma unroll
                    for (int jj = 0; jj < 4; ++jj) asm volatile("" :: "v"(D_[0][jj])); }
#endif
#pragma unroll
                for (int jj = 0; jj < 4; ++jj) Racc[0][0][jj] = Racc[0][0][jj] * gch;
                wgemm<1, 4, 128, 144, 72, true, true, false>(Racc[0], Vs + 16 * w, Kz, lane);
#pragma unroll
                for (int jj = 0; jj < 4; ++jj) { const f32x4 t_ = Racc[0][0][jj]; Racc[0][0][jj] = Racc[1][0][jj]; Racc[1][0][jj] = Racc[2][0][jj]; Racc[2][0][jj] = Racc[3][0][jj]; Racc[3][0][jj] = t_; }
            }
            v4u pp[4];
#pragma unroll
            for (int i = 0; i < 4; ++i) { const int id = tid + NTHR * i; pp[i] = *(const v4u*)(pmt + (id >> 4) * 128 + (id & 15) * 8); }
#if RET_EXP == 2
            asm volatile("s_waitcnt vmcnt(0)" ::: "memory");
#pragma unroll
            for (int i = 0; i < 4; ++i) { const int id = tid + NTHR * i; v4u q_ = *(const volatile v4u*)(pmt + 64 * 128 * 128 + (id >> 4) * 128 + (id & 15) * 8); asm volatile("" :: "v"(q_.x), "v"(q_.y), "v"(q_.z), "v"(q_.w)); }
            asm volatile("s_waitcnt vmcnt(0)" ::: "memory");
#endif
#pragma unroll
            for (int i = 0; i < 2; ++i)
#pragma unroll
                for (int e = 0; e < 4; ++e) { const int t = 32 * wh + 16 * i + 4 * fq + e; const float xi = __builtin_amdgcn_exp2f((float)(t + 1) * lgc);
#pragma unroll
                    for (int jj = 0; jj < 4; ++jj) X[i][jj][e] *= xi; }
#pragma unroll
            for (int i = 0; i < 4; ++i) { const int id = tid + NTHR * i; *(LAS v4u*)(Ps + (id >> 4) * 136 + (id & 15) * 8) = pp[i]; }
            __syncthreads();
            wgemm<2, 4, 128, 136, 144, false, true, false>(X, Ps + 32 * wh * 136, Vs + 64 * wl, lane);
#pragma unroll
            for (int i = 0; i < 2; ++i)
#pragma unroll
                for (int e = 0; e < 4; ++e) { const int t = 32 * wh + 16 * i + 4 * fq + e; float s1 = 0.f, s2 = 0.f;
#pragma unroll
                    for (int jj = 0; jj < 4; ++jj) { const float y = X[i][jj][e]; s1 += y; s2 += y * y; Xs[t * 136 + 64 * wl + 16 * jj + fr] = (bf16)f2bf(y); }
                    s1 += __shfl_xor(s1, 1); s1 += __shfl_xor(s1, 2); s1 += __shfl_xor(s1, 4); s1 += __shfl_xor(s1, 8);
                    s2 += __shfl_xor(s2, 1); s2 += __shfl_xor(s2, 2); s2 += __shfl_xor(s2, 4); s2 += __shfl_xor(s2, 8);
                    if (fr == 0) { fST[(wl * 128 + t) * 2] = s1; fST[(wl * 128 + t) * 2 + 1] = s2; } }
            if (c < 15) { const char* gvn = gy + (size_t)128 * 4096 * 2;
#pragma unroll
                for (int i = 0; i < 4; ++i) pv[i] = *(const v4u*)(gvn + off16 + i * (32 * 4096 * 2)); }
            __syncthreads();
#pragma unroll
            for (int i = 0; i < 4; ++i) { const int id = tid + NTHR * i, row = id >> 4, c8 = id & 15; *(v4u*)(gy + (unsigned)((row * 4096 + c8 * 8) * 2)) = *(const LAS v4u*)(Xs + row * 136 + c8 * 8); }
            if (tid < 128) { float* sp = st + (t0 + tid) * 32 + (h * 4 + vs) * 2; sp[0] = fST[tid * 2] + fST[(128 + tid) * 2]; sp[1] = fST[tid * 2 + 1] + fST[(128 + tid) * 2 + 1]; }
        }
    }
}

__device__ __forceinline__ void lru_conv(Frame& F, const bf16* GX, const float* cw, const float* cb, bf16* XC, const float* lru, float* sptab) {
    if (blockIdx.x == 0) for (int i = F.tid; i < 1024; i += NTHR) { const float l = -lru[i]; sptab[i] = fmaxf(l, 0.f) + log1pf(expf(-fabsf(l))); }
    const int c8 = F.tid & 127, rsub = F.tid >> 7;
    f32x4 w0[4], w1[4];
#pragma unroll
    for (int wv = 0; wv < 4; ++wv) { w0[wv] = *(const f32x4*)(cw + wv * 1024 + c8 * 8); w1[wv] = *(const f32x4*)(cw + wv * 1024 + c8 * 8 + 4); }
    const f32x4 b0 = *(const f32x4*)(cb + c8 * 8), b1 = *(const f32x4*)(cb + c8 * 8 + 4);
    for (int r0 = blockIdx.x * 16; r0 < MTOK; r0 += F.G * 16) {
        const int rb = r0 + 4 * rsub, t = rb & (SEQ - 1);
        v4u xin[7];
#pragma unroll
        for (int k = 0; k < 7; ++k) { const int rr = rb - 3 + k; xin[k] = (t - 3 + k >= 0) ? *(const v4u*)(GX + (size_t)rr * 2048 + 1024 + c8 * 8) : (v4u){0u, 0u, 0u, 0u}; }
#pragma unroll
        for (int q = 0; q < 4; ++q) { f32x4 a0 = b0, a1 = b1;
#pragma unroll
            for (int wv = 0; wv < 4; ++wv) { const v4u x = xin[q + wv];
                a0 += (f32x4){lo_bf(x.x), hi_bf(x.x), lo_bf(x.y), hi_bf(x.y)} * w0[wv]; a1 += (f32x4){lo_bf(x.z), hi_bf(x.z), lo_bf(x.w), hi_bf(x.w)} * w1[wv]; }
            v4u o; o.x = cvtpk(a0[0], a0[1]); o.y = cvtpk(a0[2], a0[3]); o.z = cvtpk(a1[0], a1[1]); o.w = cvtpk(a1[2], a1[3]);
            *(v4u*)(XC + (size_t)(rb + q) * 1024 + c8 * 8) = o; }
    }
}
__device__ __forceinline__ float gelu_tanh(float x) { const float z = 0.7978845608028654f * (x + 0.044715f * x * x * x); const float e = __expf(2.0f * z); const float th = 1.0f - 2.0f * __builtin_amdgcn_rcpf(e + 1.0f); return 0.5f * x * (1.0f + th); }
__device__ __forceinline__ void lru_scan(Frame& F, const bf16* LA, const bf16* BT, const bf16* GX, bf16* Y) {
    LAS float* segL = (LAS float*)F.lds;
    LAS float* segH = segL + 512;
    const int lane = F.lane, w = F.wave;
    for (int item = blockIdx.x; item < 256; item += F.G) {
        const int b = item >> 4, ch = (item & 15) * 64 + lane;
        const size_t r0 = (size_t)b * SEQ + w * 256;
        const bf16* la_p = LA + r0 * 1024 + ch; const bf16* bt_p = BT + r0 * 1024 + ch; const bf16* gx_p = GX + r0 * 2048 + ch; bf16* y_p = Y + r0 * 1024 + ch;
        float L = 0.f, H = 0.f;
        bf16 la0[16], bt0[16], la1[16], bt1[16];
#pragma unroll
        for (int k = 0; k < 16; ++k) { la0[k] = la_p[(size_t)k * 1024]; bt0[k] = bt_p[(size_t)k * 1024]; }
#pragma unroll 1
        for (int tb = 0; tb < 16; tb += 2) {
#pragma unroll
            for (int k = 0; k < 16; ++k) { la1[k] = la_p[(size_t)((tb + 1) * 16 + k) * 1024]; bt1[k] = bt_p[(size_t)((tb + 1) * 16 + k) * 1024]; }
#pragma unroll
            for (int k = 0; k < 16; ++k) { const float la = bf2f(la0[k]); L += la; H = __expf(la) * H + bf2f(bt0[k]); }
            if (tb + 2 < 16) {
#pragma unroll
                for (int k = 0; k < 16; ++k) { la0[k] = la_p[(size_t)((tb + 2) * 16 + k) * 1024]; bt0[k] = bt_p[(size_t)((tb + 2) * 16 + k) * 1024]; } }
#pragma unroll
            for (int k = 0; k < 16; ++k) { const float la = bf2f(la1[k]); L += la; H = __expf(la) * H + bf2f(bt1[k]); }
        }
        __syncthreads();
        segL[w * 64 + lane] = L; segH[w * 64 + lane] = H;
        __syncthreads();
        float hc = 0.f;
        for (int sg = 0; sg < w; ++sg) hc = __expf(segL[sg * 64 + lane]) * hc + segH[sg * 64 + lane];
        bf16 g0[16], g1[16];
#pragma unroll
        for (int k = 0; k < 16; ++k) { la0[k] = la_p[(size_t)k * 1024]; bt0[k] = bt_p[(size_t)k * 1024]; g0[k] = gx_p[(size_t)k * 2048]; }
#pragma unroll
        for (int k = 0; k < 16; ++k) { const size_t t = (size_t)(16 + k); la1[k] = la_p[t * 1024]; bt1[k] = bt_p[t * 1024]; g1[k] = gx_p[t * 2048]; }
#pragma unroll 1
        for (int tb = 0; tb < 16; tb += 2) {
            bf16 yv[16];
#pragma unroll
            for (int k = 0; k < 16; ++k) { hc = __expf(bf2f(la0[k])) * hc + bf2f(bt0[k]); yv[k] = (bf16)f2bf(hc * gelu_tanh(bf2f(g0[k]))); }
            if (tb + 2 < 16) {
#pragma unroll
                for (int k = 0; k < 16; ++k) { const size_t t = (size_t)((tb + 2) * 16 + k); la0[k] = la_p[t * 1024]; bt0[k] = bt_p[t * 1024]; g0[k] = gx_p[t * 2048]; } }
#pragma unroll
            for (int k = 0; k < 16; ++k) y_p[(size_t)(tb * 16 + k) * 1024] = yv[k];
#pragma unroll
            for (int k = 0; k < 16; ++k) { hc = __expf(bf2f(la1[k])) * hc + bf2f(bt1[k]); yv[k] = (bf16)f2bf(hc * gelu_tanh(bf2f(g1[k]))); }
            if (tb + 3 < 16) {
#pragma unroll
                for (int k = 0; k < 16; ++k) { const size_t t = (size_t)((tb + 3) * 16 + k); la1[k] = la_p[t * 1024]; bt1[k] = bt_p[t * 1024]; g1[k] = gx_p[t * 2048]; } }
#pragma unroll
            for (int k = 0; k < 16; ++k) y_p[(size_t)((tb + 1) * 16 + k) * 1024] = yv[k];
        }
    }
}

#ifndef WGM_BIG
#define WGM_BIG 8
#endif
#ifndef WGM_N4
#define WGM_N4 4
#endif
#ifndef WGM_MID
#define WGM_MID 8
#endif
template <class Epi>
__device__ __forceinline__ void run_gemm(Frame& F, const bf16* A, int lda, const bf16* Bt, int ldb, int N, int K, const Epi& E, int M = MTOK, int ablk = 0) {
    pg8::Gemm g{A, Bt, M, N, K, lda, ldb, ablk}; pg8::StaticOrder S; S.init(M, N, F.G, (int)blockIdx.x, (N >= 4096) ? WGM_BIG : (N <= 1024 ? WGM_N4 : WGM_MID));
#ifndef STAGGER_NG
#define STAGGER_NG 1
#endif
#ifndef STAGGER_STEP
#define STAGGER_STEP 300
#endif
    if (STAGGER_NG > 1 && N >= 4096 && M == MTOK) {
        const unsigned grp = (((unsigned)blockIdx.x >> 3) & 7u) / (8 / STAGGER_NG);
        if (grp) { const unsigned long long t0 = __builtin_amdgcn_s_memrealtime(), dl = (unsigned long long)grp * STAGGER_STEP;
            while (__builtin_amdgcn_s_memrealtime() - t0 < dl) __builtin_amdgcn_s_sleep(8); }
    }
#ifndef FUSE_NX
#define FUSE_NX false
#endif
#ifndef GEMM_ALIGN
#define GEMM_ALIGN true
#endif
#ifndef GEMM_SP2
#define GEMM_SP2 true
#endif
    pg8::gemm_phase<Epi, pg8::StaticOrder, GEMM_ALIGN, GEMM_SP2>(F.lds, g, S, E);
}

typedef const __attribute__((address_space(4))) struct Args* ArgsP;
constexpr int NPHASE = 35;
__device__ __forceinline__ ArgsP get_args() { ArgsP p = (ArgsP)__builtin_amdgcn_kernarg_segment_ptr(); asm volatile("" : "+s"(p)); return p; }
__device__ __forceinline__ bool in_phase(int k) { ArgsP a = get_args(); return a->ph_lo <= k && k < a->ph_hi; }
#ifndef DUP_PHASE
#define DUP_PHASE -1
#endif
#ifndef BAR_EXP
#define BAR_EXP 0
#endif
#ifndef TIMING_MASK
#define TIMING_MASK 0ull
#endif
#define TMISC ((volatile LAS unsigned long long*)((LAS unsigned char*)lds_raw + MISC_OFF))
#define TB(k) do { if (((TIMING_MASK >> (k)) & 1ull) && blockIdx.x == 0 && threadIdx.x == 0) TMISC[0] = __builtin_amdgcn_s_memrealtime(); } while (0)
#define TE(k) do { if (((TIMING_MASK >> (k)) & 1ull) && blockIdx.x == 0 && threadIdx.x == 0) TMISC[1] = TMISC[1] + (__builtin_amdgcn_s_memrealtime() - TMISC[0]); } while (0)
#define REP(k) TB(k); for (int rep_ = 0; rep_ < ((k) == DUP_PHASE ? 2 : 1); ++rep_)
#define AP ArgsP ap = get_args(); { int t_ = threadIdx.x; asm volatile("" : "+v"(t_)); F.tid = t_; F.lane = t_ & 63; F.wave = __builtin_amdgcn_readfirstlane(t_ >> 6); F.G = gridDim.x; F.lds = (LAS unsigned char*)lds_raw; }
__global__ void __launch_bounds__(NTHR, 2) trunk_fwd(Args args) {
    extern __shared__ __attribute__((aligned(16))) unsigned char lds_raw[];
    Frame F; F.lds = (LAS unsigned char*)lds_raw; F.tid = threadIdx.x; F.lane = F.tid & 63; F.wave = __builtin_amdgcn_readfirstlane(F.tid >> 6); F.G = gridDim.x;
    volatile LAS unsigned* MISC = (volatile LAS unsigned*)(F.lds + MISC_OFF);
    if (F.tid < 16) MISC[F.tid] = 0u;
    __syncthreads();
    if (args.ph_hi - args.ph_lo > 1) (void)xcd_barrier_post((unsigned*)(args.ws + WS_CTL) + CW_BAR, MISC + 8);
#ifndef ONLY_PHASE
#define ONLY_PHASE -1
#endif
#define IN(k) ((ONLY_PHASE < 0 || (k) == ONLY_PHASE) && in_phase(k))
#define SEAM(k) do { if (IN(k) && IN((k) + 1)) { XcdBarrier bb; bb.bar = (unsigned*)(get_args()->ws + WS_CTL) + CW_BAR; bb.x = xb_xcc_id(); bb.st = (volatile LAS unsigned*)((LAS unsigned char*)lds_raw + MISC_OFF) + 8; xcd_barrier(bb); if (BAR_EXP) xcd_barrier(bb); } if (IN(k)) TE(k); } while (0)
#define XIN ((const float*)ap->in[0])
#define pos ((const int*)ap->in[1])
#define norm_mix ((const float*)ap->in[2])
#define norm_ffn ((const float*)ap->in[3])
#define ffn_w_in ((const float*)ap->in[4])
#define ffn_w_out ((const float*)ap->in[5])
#define out (ap->out)
#define Wmi ((bf16*)(ap->ws + WS_W_MIXIN))
#define Wmo ((bf16*)(ap->ws + WS_W_MIXOUT))
#define Wfi ((bf16*)(ap->ws + WS_W_FFNIN))
#define Wfo ((bf16*)(ap->ws + WS_W_FFNOUT))
#define U ((bf16*)(ap->ws + WS_U))
#define BIG ((bf16*)(ap->ws + WS_BIG))
#define gatesA ((float*)(ap->ws + WS_GATESA))
#define ssqA ((float*)(ap->ws + WS_SSQA))
#define statC ((float*)(ap->ws + WS_STATC))
#define kmean ((float*)(ap->ws + WS_KMEAN))
#define sptab ((float*)(ap->ws + WS_SPTAB))
#define ssqH ((float*)(ap->ws + WS_SSQH))

#define a_w_in ((const float*)ap->in[6])
#define a_b ((const float*)ap->in[7])
#define a_g ((const float*)ap->in[8])
#define a_w_out ((const float*)ap->in[9])
#define b_w_in ((const float*)ap->in[10])
#define b_gq ((const float*)ap->in[11])
#define b_gk ((const float*)ap->in[12])
#define b_w_out ((const float*)ap->in[13])
#define c_w_in ((const float*)ap->in[14])
#define c_g ((const float*)ap->in[15])
#define c_w_out ((const float*)ap->in[16])
#define d_w_in ((const float*)ap->in[17])
#define d_cw ((const float*)ap->in[18])
#define d_cb ((const float*)ap->in[19])
#define d_wg ((const float*)ap->in[20])
#define d_bg ((const float*)ap->in[21])
#define d_lru ((const float*)ap->in[22])
#define d_w_out ((const float*)ap->in[23])
#define GX BIG
#define XC (BIG + (size_t)MTOK * 2048)
#define LA (BIG + (size_t)MTOK * 3072)
#define BT (BIG + (size_t)MTOK * 4096)
#define Y (BIG + (size_t)MTOK * 3072)
#define HB (BIG + (size_t)MTOK * 5120)
#define Wg (Wmi + (size_t)2048 * DM)
#define FFN_CVT(l) do { cvt_matrix(F, ffn_w_in + (size_t)(l) * DM * 2 * DFF, 2 * DFF, DM, 2 * DFF, 1, Wfi); cvt_matrix(F, ffn_w_out + (size_t)(l) * DFF * DM, DM, DFF, DM, 0, Wfo); } while (0)
#define FFN_PHASES(p0, l) do { \
    if (IN(p0)) { AP; REP(p0) { norm_phase_b(F, HB, norm_ffn + (l) * DM, U); } } SEAM(p0); \
    if (IN((p0) + 1)) { AP; REP((p0) + 1) { pg8::EpiSwiGLU<false> E{BIG, DFF, nullptr}; run_gemm(F, U, DM, Wfi, DM, 2 * DFF, DM, E); } } SEAM((p0) + 1); \
    if (IN((p0) + 2)) { AP; REP((p0) + 2) { if ((l) < 3) { pg8::EpiResidB<true> E{HB, HB}; run_gemm(F, BIG, DFF, Wfo, DFF, DM, DFF, E); } else { pg8::EpiResidF E{HB, out}; run_gemm(F, BIG, DFF, Wfo, DFF, DM, DFF, E); } } } SEAM((p0) + 2); } while (0)
#define QKV BIG
#define HO (BIG + (size_t)MTOK * 2048)
#define PMAB (BIG + (size_t)MTOK * 3072)
#define GTB ((float*)(BIG + (size_t)MTOK * 3584))
#define DENB ((float*)(BIG + (size_t)MTOK * 3584) + 2048 * 320)
    if (IN(0)) { AP; REP(0) { cvt_matrix(F, a_w_in, 3080, DM, 3072, 0, Wmi); cvt_matrix(F, a_w_out, DM, DM, DM, 0, Wmo); FFN_CVT(0);
        __syncthreads(); norm_phase<true>(F, XIN, norm_mix, U, a_w_in, a_b, gatesA); } } SEAM(0);
    if (IN(1)) { AP; REP(1) { mlstm_pre(F, gatesA, GTB); __syncthreads(); pg8::EpiStore<false> E{QKV, 2048, nullptr}; run_gemm(F, U, DM, Wmi, DM, 2048, DM, E); } } SEAM(1);
    if (IN(2)) { AP; REP(2) { mlstm_pmat(F, QKV, GTB, PMAB, DENB); } } SEAM(2);
    if (IN(3)) { AP; REP(3) { mlstm_core(F, QKV, GTB, PMAB, DENB, HO, ssqA); } } SEAM(3);
    if (IN(4)) { AP; REP(4) { pg8::EpiGateA E{HO, ssqA, a_g}; run_gemm(F, U, DM, Wmi + (size_t)2048 * DM, DM, DM, DM, E); } } SEAM(4);
    if (IN(5)) { AP; REP(5) { pg8::EpiResidB<false> E{XIN, HB}; run_gemm(F, HO, DM, Wmo, DM, DM, DM, E); } } SEAM(5);
    FFN_PHASES(6, 0);
#define OB (BIG + (size_t)MTOK * 3072)
#define VTB (BIG + (size_t)MTOK * 2048)
    if (IN(9)) { AP; REP(9) { cvt_matrix(F, b_w_in, 3072, DM, 3072, 0, Wmi); cvt_matrix(F, b_w_out, DM, DM, DM, 0, Wmo); FFN_CVT(1);
        __syncthreads(); norm_phase_b(F, HB, norm_mix + DM, U); } } SEAM(9);
    if (IN(10)) { AP; REP(10) { pg8::EpiStore<false> E{QKV, 3072, nullptr}; run_gemm(F, U, DM, Wmi, DM, 3072, DM, E); } } SEAM(10);
    if (IN(11)) { AP; REP(11) { moba_prep(F, QKV, pos, b_gq, b_gk, kmean); } } SEAM(11);
    if (IN(12)) { AP; REP(12) { moba_attn(F, QKV, kmean, OB); } } SEAM(12);
    if (IN(13)) { AP; REP(13) { pg8::EpiResidB<true> E{HB, HB}; run_gemm(F, OB, DM, Wmo, DM, DM, DM, E); } } SEAM(13);
    FFN_PHASES(14, 1);
#define YS (BIG + 2048)
#define PMB (BIG + (size_t)MTOK * 4096)
#define CSTB ((float*)(BIG + (size_t)MTOK * 4096 + (size_t)16 * 1024 * 1024))
    if (IN(17)) { AP; REP(17) { cvt_matrix(F, c_w_in, 6144, DM, 6144, 0, Wmi); cvt_matrix(F, c_w_out, DM, 2048, DM, 0, Wmo); FFN_CVT(2);
        __syncthreads(); norm_phase_b(F, HB, norm_mix + 2 * DM, U); ret_rot_table(F, pos, CSTB); } } SEAM(17);
    if (IN(18)) { AP; REP(18) { pg8::EpiStoreRot E{QKV, CSTB}; run_gemm(F, U, DM, Wmi, DM, 4096, DM, E); } } SEAM(18);
    if (IN(19)) { AP; REP(19) { ret_pmat(F, QKV, PMB); } } SEAM(19);
    if (IN(20)) { AP; REP(20) { ret_core(F, QKV, PMB, statC); } } SEAM(20);
    if (IN(21)) { AP; REP(21) { pg8::EpiGateC<false> E{YS, 4096, statC, c_g, nullptr}; run_gemm(F, U, DM, Wmi + (size_t)4096 * DM, DM, 2048, DM, E); } } SEAM(21);
    if (IN(22)) { AP; REP(22) { pg8::EpiResidB<true> E{HB, HB}; run_gemm(F, YS, 4096, Wmo, 2048, DM, 2048, E); } } SEAM(22);
    FFN_PHASES(23, 2);
    if (IN(26)) { AP; REP(26) { cvt_matrix(F, d_w_in, 2048, DM, 2048, 0, Wmi);
#pragma unroll 1
            for (int blk = 0; blk < 4; ++blk) cvt_matrix(F, d_wg + (size_t)blk * 256 * 512, 512, 256, 512, 2, Wg + (size_t)blk * 512 * 256);
            cvt_matrix(F, d_w_out, DM, DM, DM, 0, Wmo); FFN_CVT(3);
        __syncthreads(); norm_phase_b(F, HB, norm_mix + 3 * DM, U); } } SEAM(26);
    if (IN(27)) { AP; REP(27) { pg8::EpiStore<false> E{GX, 2048, nullptr}; run_gemm(F, U, DM, Wmi, DM, 2048, DM, E); } } SEAM(27);
    if (IN(28)) { AP; REP(28) { lru_conv(F, GX, d_cw, d_cb, XC, d_lru, sptab); } } SEAM(28);
    if (IN(29)) { AP; REP(29) { pg8::EpiLru E{XC, LA, BT, d_bg, sptab}; run_gemm(F, XC, DM, Wg, 256, 2048, 256, E, MTOK, 256); } } SEAM(29);
    if (IN(30)) { AP; REP(30) { lru_scan(F, LA, BT, GX, Y); } } SEAM(30);
    if (IN(31)) { AP; REP(31) { pg8::EpiResidB<true> E{HB, HB}; run_gemm(F, Y, DM, Wmo, DM, DM, DM, E); } } SEAM(31);
    FFN_PHASES(32, 3);
    if (TIMING_MASK != 0ull && blockIdx.x == 0 && threadIdx.x == 0) { const unsigned long long t0_ = __builtin_amdgcn_s_memrealtime(); const unsigned long long tacc_ = TMISC[1]; while (__builtin_amdgcn_s_memrealtime() - t0_ < tacc_) __builtin_amdgcn_s_sleep(8); }
#undef IN
#undef SEAM
#undef XIN
#undef pos
#undef norm_mix
#undef norm_ffn
#undef ffn_w_in
#undef ffn_w_out
#undef out
#undef Wmi
#undef Wmo
#undef Wfi
#undef Wfo
#undef U
#undef BIG
#undef gatesA
#undef ssqA
#undef statC
#undef kmean
#undef sptab
#undef a_w_in
#undef a_b
#undef a_g
#undef a_w_out
#undef b_w_in
#undef b_gq
#undef b_gk
#undef b_w_out
#undef c_w_in
#undef c_g
#undef c_w_out
#undef d_w_in
#undef d_cw
#undef d_cb
#undef d_wg
#undef d_bg
#undef d_lru
#undef d_w_out
#undef GX
#undef XC
#undef LA
#undef BT
#undef Y
#undef Wg
#undef FFN_CVT
#undef OB
#undef HB
#undef CSTB
#undef PMAB
#undef GTB
#undef DENB
#undef PMB
#undef VTB
#undef FFN_PHASES
#undef QKV
#undef HO
#undef YS
#undef ssqH
}

#ifndef MK_ONE_LAUNCH
#define MK_ONE_LAUNCH 1
#endif
extern "C" void kernel_launch(void* const* d_in, const int* in_sizes, int n_in, void* d_out, int out_size, void* d_ws, size_t ws_size, hipStream_t stream) {
    static int grid = 0;
    if (grid == 0) {
        if (n_in != 24 || out_size != MTOK * DM || ws_size < WS_END) { fprintf(stderr, "kernel_launch: unexpected shapes (n_in %d, out %d, ws %zu); nothing launched\n", n_in, out_size, ws_size); grid = -1; return; }
        int dev = 0, cus = 0, per_cu = 0;
        if (hipGetDevice(&dev) != hipSuccess || hipDeviceGetAttribute(&cus, hipDeviceAttributeMultiprocessorCount, dev) != hipSuccess) { grid = -1; return; }
        if (hipFuncSetAttribute((const void*)trunk_fwd, hipFuncAttributeMaxDynamicSharedMemorySize, LDS_BYTES) != hipSuccess) { fprintf(stderr, "kernel_launch: hipFuncSetAttribute failed\n"); grid = -1; return; }
        if (hipOccupancyMaxActiveBlocksPerMultiprocessor(&per_cu, (const void*)trunk_fwd, NTHR, LDS_BYTES) != hipSuccess || per_cu < 1) { fprintf(stderr, "kernel_launch: occupancy query reports %d blocks per CU\n", per_cu); }
        (void)hipGetLastError();
        grid = cus;
    }
    if (grid < 0) return;
    (void)hipMemsetAsync((char*)d_ws + WS_CTL, 0, CTL_ZERO_BYTES, stream);
    Args a{};
    for (int i = 0; i < 24; ++i) a.in[i] = d_in[i];
    a.out = (float*)d_out; a.ws = (unsigned char*)d_ws;
#if MK_ONE_LAUNCH
    a.ph_lo = 0; a.ph_hi = NPHASE;
    hipLaunchKernelGGL(trunk_fwd, dim3(grid), dim3(NTHR), LDS_BYTES, stream, a);
#else
    for (int p = 0; p < NPHASE; ++p) { a.ph_lo = p; a.ph_hi = p + 1; hipLaunchKernelGGL(trunk_fwd, dim3(grid), dim3(NTHR), LDS_BYTES, stream, a); }
#endif
}
```

```cpp
#include <hip/hip_runtime.h>
#include <cstdio>
#include <cstdint>
#include <cmath>
namespace pg8 {
#define PG8_LAS __attribute__((address_space(3)))
typedef unsigned short bf16_t;
typedef short bf16x8 __attribute__((ext_vector_type(8)));
typedef float f32x4 __attribute__((ext_vector_type(4)));
typedef unsigned u32x4 __attribute__((ext_vector_type(4)));
constexpr int BM = 256, BK = 64, HALF = 128, HTB = HALF * BK * 2  , STAGE_BYTES = 8 * HTB, NXCD = 8, WGM = 8;

__host__ __device__ __forceinline__ int lds_byte(int r, int c) { const int st = (r >> 4) * 2 + (c >> 5), rr = r & 15, cc = c & 31, ob = rr * 64 + cc * 2; return st * 1024 + (ob ^ (((ob >> 9) & 1) << 5)); }
__host__ __device__ __forceinline__ void stage_rc(int b, int& R, int& C) { const int st = b / 1024, sb = b % 1024, swz = sb ^ (((sb >> 9) & 1) << 5); R = (st >> 1) * 16 + swz / 64; C = (st & 1) * 32 + (swz % 64) / 2; }
__host__ __device__ __forceinline__ int perm32(int rho) { const int n = rho >> 4, i = rho & 15; return 8 * (i >> 2) + 4 * n + (i & 3); }

struct Unit { int pm, pn; };
struct Gemm { const bf16_t* A; const bf16_t* Bt; int M, N, K, lda, ldb, ablk; };

struct StaticOrder {
    int nM, nN, nwg, G, c, wgm;
    __host__ __device__ void init(int M, int N, int G_, int c_, int wgm_ = WGM) { nM = M / BM; nN = N / BM; nwg = nM * nN; G = G_; c = c_; wgm = wgm_; }
    __host__ __device__ bool next(int i, Unit& u) const {
        const long L = (long)i * G + c; if (L >= nwg) return false;
        int wgid = (int)L; { const int q = nwg / NXCD, r = nwg % NXCD, xcd = wgid % NXCD, off = wgid / NXCD; wgid = (xcd < r ? xcd * (q + 1) : r * (q + 1) + (xcd - r) * q) + off; }
        const int nig = wgm * nN, gid = wgid / nig, fm = gid * wgm, gsz = (nM - fm) < wgm ? (nM - fm) : wgm;
        u.pm = fm + ((wgid % nig) % gsz); u.pn = (wgid % nig) / gsz; return true;
    }
    __device__ __forceinline__ void a_ready(const Unit&) const {}
    __device__ __forceinline__ void done(const Unit&) const {}
};

__device__ __forceinline__ unsigned cvt_pk_bf16(float lo, float hi) { unsigned r; asm volatile("v_cvt_pk_bf16_f32 %0, %1, %2" : "=v"(r) : "v"(lo), "v"(hi)); return r; }
typedef float f32x2 __attribute__((ext_vector_type(2)));

__device__ __forceinline__ float bf2f(unsigned short b) { return __uint_as_float(((unsigned)b) << 16); }
__device__ __forceinline__ float lo_bf(unsigned w) { return __uint_as_float(w << 16); }
__device__ __forceinline__ float hi_bf(unsigned w) { return __uint_as_float(w & 0xffff0000u); }
__device__ __forceinline__ float fast_sigmoid(float x) { return __builtin_amdgcn_rcpf(1.0f + __expf(-x)); }
typedef unsigned u32x2 __attribute__((ext_vector_type(2)));


#ifndef EPI_SC1
#define EPI_SC1 0
#endif
__device__ __forceinline__ void st16(void* p, u32x4 w) {
#if EPI_SC1
    asm volatile("global_store_dwordx4 %0, %1, off sc1" :: "v"(p), "v"(w) : "memory");
#else
    *(u32x4*)p = w;
#endif
}
__device__ __forceinline__ void row_rstd(const float* ssq, int row0, float (&rs)[2][4]) {
#pragma unroll
    for (int ai = 0; ai < 2; ++ai)
#pragma unroll
        for (int m = 0; m < 4; ++m) { const f32x4 a = *(const f32x4*)(ssq + (size_t)(row0 + ai * HALF + m * 16) * 4);
            rs[ai][m] = 1.0f / sqrtf(((a[0] + a[1]) + (a[2] + a[3])) * (1.0f / 1024.0f) + 1e-6f); }
}
template <bool RS> struct EpiStore {
    static constexpr bool PERM = true, AFTER_DRAIN = false; static constexpr int NST = 16;
    bf16_t* O; int ldc; const float* ssq;
    __device__ __forceinline__ void operator()(const f32x4 (&acc)[2][2][4][2], const Unit& u, int wr, int wc, int fr, int fq) const {
        const int row0 = u.pm * BM + wr * 64 + fr, col0 = u.pn * BM + wc * 32 + 8 * fq;
        float rs[2][4]; if (RS) row_rstd(ssq, row0, rs);
#pragma unroll
        for (int ai = 0; ai < 2; ++ai)
#pragma unroll
            for (int m = 0; m < 4; ++m) { bf16_t* rowp = O + (size_t)(row0 + ai * HALF + m * 16) * ldc + col0; const float sc = RS ? rs[ai][m] : 1.0f;
#pragma unroll
                for (int bj = 0; bj < 2; ++bj) { const f32x4 v0 = acc[ai][bj][m][0] * sc, v1 = acc[ai][bj][m][1] * sc;
                    u32x4 w; w.x = cvt_pk_bf16(v0[0], v0[1]); w.y = cvt_pk_bf16(v0[2], v0[3]); w.z = cvt_pk_bf16(v1[0], v1[1]); w.w = cvt_pk_bf16(v1[2], v1[3]);
                    st16(rowp + bj * HALF, w);
#if defined(GEMM_EXP) && GEMM_EXP == 3
                    asm volatile("" ::: "memory"); *(volatile u32x4*)(rowp + bj * HALF) = w;
#endif
                } }
    }
};

template <bool RS> struct EpiStoreRot {
    static constexpr bool PERM = true, AFTER_DRAIN = false; static constexpr int NST = 16;
    bf16_t* O; const float* cst; const float* ssq;
    __device__ __forceinline__ void operator()(const f32x4 (&acc)[2][2][4][2], const Unit& u, int wr, int wc, int fr, int fq) const {
        const int row0 = u.pm * BM + wr * 64 + fr, col0 = u.pn * BM + wc * 32 + 8 * fq, d0 = wc * 32 + 8 * fq;
        const bool rot = u.pn < 8; const float sc = (u.pn >= 4 && u.pn < 8) ? 0.0625f : 1.0f;
        float rs[2][4]; if (RS) row_rstd(ssq, row0, rs);
#pragma unroll
        for (int ai = 0; ai < 2; ++ai)
#pragma unroll
            for (int m = 0; m < 4; ++m) { const int row = row0 + ai * HALF + m * 16; bf16_t* rowp = O + (size_t)row * 4096 + col0; const float rsc = RS ? rs[ai][m] : 1.0f;
                f32x4 v[2][2];
#pragma unroll
                for (int bj = 0; bj < 2; ++bj) { v[bj][0] = acc[ai][bj][m][0] * rsc; v[bj][1] = acc[ai][bj][m][1] * rsc; }
                if (rot) { const float* cp = cst + (size_t)row * 256 + d0;
#pragma unroll
                    for (int n = 0; n < 2; ++n) { const f32x4 c = *(const f32x4*)(cp + 4 * n), sn = *(const f32x4*)(cp + 128 + 4 * n); const f32x4 x1 = v[0][n], x2 = v[1][n];
                        v[0][n] = (x1 * c - x2 * sn) * sc; v[1][n] = (x2 * c + x1 * sn) * sc; } }
#pragma unroll
                for (int bj = 0; bj < 2; ++bj) { u32x4 w; w.x = cvt_pk_bf16(v[bj][0][0], v[bj][0][1]); w.y = cvt_pk_bf16(v[bj][0][2], v[bj][0][3]); w.z = cvt_pk_bf16(v[bj][1][0], v[bj][1][1]); w.w = cvt_pk_bf16(v[bj][1][2], v[bj][1][3]);
                    *(u32x4*)(rowp + bj * HALF) = w; } }
    }
};
template <bool RS> struct EpiSwiGLU {
    static constexpr bool PERM = true, AFTER_DRAIN = false; static constexpr int NST = 8;
    bf16_t* O; int ldc; const float* ssq;
    __device__ __forceinline__ void operator()(const f32x4 (&acc)[2][2][4][2], const Unit& u, int wr, int wc, int fr, int fq) const {
        const int row0 = u.pm * BM + wr * 64 + fr, col0 = u.pn * HALF + wc * 32 + 8 * fq;
        float rs[2][4]; if (RS) row_rstd(ssq, row0, rs);
#pragma unroll
        for (int ai = 0; ai < 2; ++ai)
#pragma unroll
            for (int m = 0; m < 4; ++m) { bf16_t* rowp = O + (size_t)(row0 + ai * HALF + m * 16) * ldc + col0; const float sc = RS ? rs[ai][m] : 1.0f;
                float h[8];
#pragma unroll
                for (int n = 0; n < 2; ++n)
#pragma unroll
                    for (int j = 0; j < 4; ++j) { const float g = acc[ai][0][m][n][j] * sc, up = acc[ai][1][m][n][j] * sc;
#if defined(GEMM_EXP) && GEMM_EXP == 2
                        h[4 * n + j] = g * (0.5f * (fast_sigmoid(g) + (1.0f - fast_sigmoid(-g)))) * up;
#else
                        h[4 * n + j] = g * fast_sigmoid(g) * up;
#endif
                    }
                u32x4 w; w.x = cvt_pk_bf16(h[0], h[1]); w.y = cvt_pk_bf16(h[2], h[3]); w.z = cvt_pk_bf16(h[4], h[5]); w.w = cvt_pk_bf16(h[6], h[7]);

                st16(rowp, w);
                }
    }
};
template <bool NX> struct EpiResid {
    static constexpr bool PERM = false, AFTER_DRAIN = false; static constexpr int NST = 32;
    const float* base; float* out; int ldc; bf16_t* hb; float* ssq;
    __device__ __forceinline__ void operator()(const f32x4 (&acc)[2][2][4][2], const Unit& u, int wr, int wc, int fr, int fq) const {
        const int row0 = u.pm * BM + wr * 64 + fr, col0 = u.pn * BM + wc * 32 + 4 * fq;
        f32x4 rb[3][4];
#define PG8_RLOAD(g, slot) do { const size_t off_ = (size_t)(row0 + ((g) >> 2) * HALF + ((g) & 3) * 16) * ldc + col0; \
            rb[slot][0] = *(const f32x4*)(base + off_); rb[slot][1] = *(const f32x4*)(base + off_ + 16); rb[slot][2] = *(const f32x4*)(base + off_ + HALF); rb[slot][3] = *(const f32x4*)(base + off_ + HALF + 16); } while (0)
        PG8_RLOAD(0, 0); PG8_RLOAD(1, 1);
#pragma unroll
        for (int g = 0; g < 8; ++g) { const int ai = g >> 2, m = g & 3; const size_t off = (size_t)(row0 + ai * HALF + m * 16) * ldc + col0; float q = 0.f;
            if (g + 2 < 8) PG8_RLOAD(g + 2, (g + 2) % 3);
#pragma unroll
            for (int bj = 0; bj < 2; ++bj)
#pragma unroll
                for (int n = 0; n < 2; ++n) { const f32x4 o = rb[g % 3][bj * 2 + n] + acc[ai][bj][m][n]; *(f32x4*)(out + off + bj * HALF + n * 16) = o;
                    if (NX) { q += (o[0] * o[0] + o[1] * o[1]) + (o[2] * o[2] + o[3] * o[3]); u32x2 w; w.x = cvt_pk_bf16(o[0], o[1]); w.y = cvt_pk_bf16(o[2], o[3]); *(u32x2*)(hb + off + bj * HALF + n * 16) = w; } }
            if (NX) { q += __shfl_xor(q, 16); q += __shfl_xor(q, 32); if (fq == 0) ssq[(size_t)(row0 + ai * HALF + m * 16) * 16 + u.pn * 4 + wc] = q; } }
#undef PG8_RLOAD
    }
};
template <bool BF, bool NX> struct EpiResidB {
    static constexpr bool PERM = true, AFTER_DRAIN = false; static constexpr int NST = 16;
    const void* base; bf16_t* hb; float* ssq; PG8_LAS float* red;
    __device__ __forceinline__ void operator()(const f32x4 (&acc)[2][2][4][2], const Unit& u, int wr, int wc, int fr, int fq) const {
        const int row0 = u.pm * BM + wr * 64 + fr, col0 = u.pn * BM + wc * 32 + 8 * fq;
        u32x4 hwb[2][2]; f32x4 fb[2][4];
#define PG8_BLOAD(g, slot) do { const size_t o_ = (size_t)(row0 + ((g) >> 2) * HALF + ((g) & 3) * 16) * 1024 + col0; \
            if (BF) { hwb[slot][0] = *(const u32x4*)((const bf16_t*)base + o_); hwb[slot][1] = *(const u32x4*)((const bf16_t*)base + o_ + HALF); } \
            else { const float* b_ = (const float*)base + o_; fb[slot][0] = *(const f32x4*)b_; fb[slot][1] = *(const f32x4*)(b_ + 4); fb[slot][2] = *(const f32x4*)(b_ + HALF); fb[slot][3] = *(const f32x4*)(b_ + HALF + 4); } } while (0)
        PG8_BLOAD(0, 0); float qs[8];
#pragma unroll
        for (int g = 0; g < 8; ++g) { const int ai = g >> 2, m = g & 3, sl = g & 1; bf16_t* rowp = hb + (size_t)(row0 + ai * HALF + m * 16) * 1024 + col0; qs[g] = 0.f;
            if (g + 1 < 8) PG8_BLOAD(g + 1, (g + 1) & 1);
#pragma unroll
            for (int bj = 0; bj < 2; ++bj) { f32x4 b0, b1;
                if (BF) { const u32x4 hw = hwb[sl][bj]; b0 = (f32x4){lo_bf(hw.x), hi_bf(hw.x), lo_bf(hw.y), hi_bf(hw.y)}; b1 = (f32x4){lo_bf(hw.z), hi_bf(hw.z), lo_bf(hw.w), hi_bf(hw.w)}; }
                else { b0 = fb[sl][2 * bj]; b1 = fb[sl][2 * bj + 1]; }
                const f32x4 o0 = b0 + acc[ai][bj][m][0], o1 = b1 + acc[ai][bj][m][1];
                u32x4 w; w.x = cvt_pk_bf16(o0[0], o0[1]); w.y = cvt_pk_bf16(o0[2], o0[3]); w.z = cvt_pk_bf16(o1[0], o1[1]); w.w = cvt_pk_bf16(o1[2], o1[3]);
                if (NX) qs[g] += ((o0[0] * o0[0] + o0[1] * o0[1]) + (o0[2] * o0[2] + o0[3] * o0[3])) + ((o1[0] * o1[0] + o1[1] * o1[1]) + (o1[2] * o1[2] + o1[3] * o1[3]));
                *(u32x4*)(rowp + bj * HALF) = w; } }
#undef PG8_BLOAD
        if (NX) {
#pragma unroll
            for (int g = 0; g < 8; ++g) { float q = qs[g]; q += __shfl_xor(q, 16); q += __shfl_xor(q, 32); if (fq == 0) red[wc * 256 + wr * 64 + (g >> 2) * HALF + (g & 3) * 16 + fr] = q; }
            __syncthreads();
            const int t = wr * 256 + wc * 64 + fq * 16 + fr;
            if (t < 256) ssq[(size_t)(u.pm * BM + t) * 4 + u.pn] = (red[t] + red[256 + t]) + (red[512 + t] + red[768 + t]);
        }
    }
};
struct EpiResidF {
    static constexpr bool PERM = true, AFTER_DRAIN = false; static constexpr int NST = 32;
    const bf16_t* hb; float* out;
    __device__ __forceinline__ void operator()(const f32x4 (&acc)[2][2][4][2], const Unit& u, int wr, int wc, int fr, int fq) const {
        const int row0 = u.pm * BM + wr * 64 + fr, col0 = u.pn * BM + wc * 32 + 8 * fq;
#pragma unroll
        for (int ai = 0; ai < 2; ++ai)
#pragma unroll
            for (int m = 0; m < 4; ++m) { const size_t o_ = (size_t)(row0 + ai * HALF + m * 16) * 1024 + col0;
#pragma unroll
                for (int bj = 0; bj < 2; ++bj) { const u32x4 hw = *(const u32x4*)(hb + o_ + bj * HALF);
                    const f32x4 b0 = (f32x4){lo_bf(hw.x), hi_bf(hw.x), lo_bf(hw.y), hi_bf(hw.y)}, b1 = (f32x4){lo_bf(hw.z), hi_bf(hw.z), lo_bf(hw.w), hi_bf(hw.w)};
                    *(f32x4*)(out + o_ + bj * HALF) = b0 + acc[ai][bj][m][0]; *(f32x4*)(out + o_ + bj * HALF + 4) = b1 + acc[ai][bj][m][1]; } }
    }
};
struct EpiGateA {
    static constexpr bool PERM = true, AFTER_DRAIN = false; static constexpr int NST = 16;
    bf16_t* Y; const float* ssq; const float* gout;
    __device__ __forceinline__ void operator()(const f32x4 (&acc)[2][2][4][2], const Unit& u, int wr, int wc, int fr, int fq) const {
        const int row0 = u.pm * BM + wr * 64 + fr, col0 = u.pn * BM + wc * 32 + 8 * fq;
        f32x4 gv[2][2];
#pragma unroll
        for (int bj = 0; bj < 2; ++bj)
#pragma unroll
            for (int n = 0; n < 2; ++n) gv[bj][n] = *(const f32x4*)(gout + col0 + bj * HALF + 4 * n);
        u32x4 hwb[2][2]; f32x4 spb[2][2];
#define PG8_GLOAD(g, slot) do { const int row_ = row0 + ((g) >> 2) * HALF + ((g) & 3) * 16; const bf16_t* rp_ = Y + (size_t)row_ * 1024 + col0; hwb[slot][0] = *(const u32x4*)rp_; hwb[slot][1] = *(const u32x4*)(rp_ + HALF); \
            spb[slot][0] = *(const f32x4*)(ssq + (size_t)row_ * 32 + u.pn * 8); spb[slot][1] = *(const f32x4*)(ssq + (size_t)row_ * 32 + u.pn * 8 + 4); } while (0)
        PG8_GLOAD(0, 0);
#pragma unroll
        for (int g = 0; g < 8; ++g) { const int ai = g >> 2, m = g & 3, sl = g & 1; const int row = row0 + ai * HALF + m * 16; bf16_t* rowp = Y + (size_t)row * 1024 + col0;
            if (g + 1 < 8) PG8_GLOAD(g + 1, (g + 1) & 1);
            const f32x4 sp = spb[sl][0], sp2 = spb[sl][1];
            const float rstd = 1.0f / sqrtf((((sp[0] + sp[1]) + (sp[2] + sp[3])) + ((sp2[0] + sp2[1]) + (sp2[2] + sp2[3]))) * (1.0f / 256.0f) + 1e-6f);
#pragma unroll
            for (int bj = 0; bj < 2; ++bj) { const u32x4 hw = hwb[sl][bj]; float o[8];
                const unsigned hh[4] = {hw.x, hw.y, hw.z, hw.w};
#pragma unroll
                for (int n = 0; n < 2; ++n)
#pragma unroll
                    for (int j = 0; j < 4; ++j) { const unsigned w = hh[2 * n + (j >> 1)]; const float hv = (j & 1) ? hi_bf(w) : lo_bf(w);
                        o[4 * n + j] = hv * rstd * gv[bj][n][j] * fast_sigmoid(acc[ai][bj][m][n][j]); }
                u32x4 w; w.x = cvt_pk_bf16(o[0], o[1]); w.y = cvt_pk_bf16(o[2], o[3]); w.z = cvt_pk_bf16(o[4], o[5]); w.w = cvt_pk_bf16(o[6], o[7]);
                *(u32x4*)(rowp + bj * HALF) = w; } }
#undef PG8_GLOAD
    }
};
template <bool RS> struct EpiGateC {
    static constexpr bool PERM = true, AFTER_DRAIN = false; static constexpr int NST = 16;
    bf16_t* Y; int ldy; const float* st; const float* gout; const float* hssq;
    __device__ __forceinline__ void operator()(const f32x4 (&acc)[2][2][4][2], const Unit& u, int wr, int wc, int fr, int fq) const {
        const int row0 = u.pm * BM + wr * 64 + fr, col0 = u.pn * BM + wc * 32 + 8 * fq, head = u.pn >> 1;
        float rs[2][4]; if (RS) row_rstd(hssq, row0, rs);
        f32x4 gv[2][2];
#pragma unroll
        for (int bj = 0; bj < 2; ++bj)
#pragma unroll
            for (int n = 0; n < 2; ++n) gv[bj][n] = *(const f32x4*)(gout + col0 + bj * HALF + 4 * n);
        u32x4 hwb[2][2]; f32x4 spb[2][2];
#define PG8_GLOAD(g, slot) do { const int row_ = row0 + ((g) >> 2) * HALF + ((g) & 3) * 16; const bf16_t* rp_ = Y + (size_t)row_ * ldy + col0; hwb[slot][0] = *(const u32x4*)rp_; hwb[slot][1] = *(const u32x4*)(rp_ + HALF); \
            spb[slot][0] = *(const f32x4*)(st + (size_t)row_ * 32 + head * 8); spb[slot][1] = *(const f32x4*)(st + (size_t)row_ * 32 + head * 8 + 4); } while (0)
        PG8_GLOAD(0, 0);
#pragma unroll
        for (int g = 0; g < 8; ++g) { const int ai = g >> 2, m = g & 3, sl = g & 1; const int row = row0 + ai * HALF + m * 16; bf16_t* rowp = Y + (size_t)row * ldy + col0;
            if (g + 1 < 8) PG8_GLOAD(g + 1, (g + 1) & 1);
            const f32x4 s0 = spb[sl][0], s1 = spb[sl][1];
            const float mu = ((s0[0] + s0[2]) + (s1[0] + s1[2])) * (1.0f / 512.0f), ex2 = ((s0[1] + s0[3]) + (s1[1] + s1[3])) * (1.0f / 512.0f);
            const float var = fmaxf(ex2 - mu * mu, 0.f), rstd = 1.0f / sqrtf(var + 1e-6f);
#pragma unroll
            for (int bj = 0; bj < 2; ++bj) { const u32x4 hw = hwb[sl][bj]; float o[8];
                const unsigned hh[4] = {hw.x, hw.y, hw.z, hw.w};
#pragma unroll
                for (int n = 0; n < 2; ++n)
#pragma unroll
                    for (int j = 0; j < 4; ++j) { const unsigned w = hh[2 * n + (j >> 1)]; const float hv = (j & 1) ? hi_bf(w) : lo_bf(w); const float a = RS ? acc[ai][bj][m][n][j] * rs[ai][m] : acc[ai][bj][m][n][j];
                        o[4 * n + j] = (hv - mu) * rstd * gv[bj][n][j] * (a * fast_sigmoid(a)); }
                u32x4 w; w.x = cvt_pk_bf16(o[0], o[1]); w.y = cvt_pk_bf16(o[2], o[3]); w.z = cvt_pk_bf16(o[4], o[5]); w.w = cvt_pk_bf16(o[6], o[7]);
                *(u32x4*)(rowp + bj * HALF) = w; } }
#undef PG8_GLOAD
    }
};
struct EpiLru {
    static constexpr bool PERM = true, AFTER_DRAIN = false; static constexpr int NST = 16;
    const bf16_t* XC; bf16_t* LA; bf16_t* BT; const float* bgall; const float* sp;
    __device__ __forceinline__ void operator()(const f32x4 (&acc)[2][2][4][2], const Unit& u, int wr, int wc, int fr, int fq) const {
        const int blk = u.pn >> 1; const float* bg = bgall + blk * 512;
        const int row0 = u.pm * BM + wr * 64 + fr, cb = (u.pn & 1) * HALF + wc * 32 + 8 * fq, ch0 = blk * 256 + cb;
        u32x4 xwb[2]; xwb[0] = *(const u32x4*)(XC + (size_t)row0 * 1024 + ch0);
#pragma unroll
        for (int g = 0; g < 8; ++g) { const int ai = g >> 2, m = g & 3; const size_t off = (size_t)(row0 + ai * HALF + m * 16) * 1024 + ch0;
                if (g + 1 < 8) xwb[(g + 1) & 1] = *(const u32x4*)(XC + (size_t)(row0 + ((g + 1) >> 2) * HALF + ((g + 1) & 3) * 16) * 1024 + ch0);
                const u32x4 xw = xwb[g & 1]; const unsigned xx[4] = {xw.x, xw.y, xw.z, xw.w};
                unsigned lw[4], bw[4];
#pragma unroll
                for (int n = 0; n < 2; ++n) { const f32x4 br = *(const f32x4*)(bg + cb + 4 * n), bi = *(const f32x4*)(bg + 256 + cb + 4 * n), spv = *(const f32x4*)(sp + ch0 + 4 * n); float la[4], bt[4];
#pragma unroll
                    for (int j = 0; j < 4; ++j) { const int q = 4 * n + j; const unsigned w = xx[q >> 1]; const float xc = (q & 1) ? hi_bf(w) : lo_bf(w);
                        const float r = fast_sigmoid(acc[ai][0][m][n][j] + br[j]), ig = fast_sigmoid(acc[ai][1][m][n][j] + bi[j]);
                        const float l = -8.0f * r * spv[j]; la[j] = l; bt[j] = sqrtf(fmaxf(1.0f - __expf(2.0f * l), 0.f)) * ig * xc; }
                    lw[2 * n] = cvt_pk_bf16(la[0], la[1]); lw[2 * n + 1] = cvt_pk_bf16(la[2], la[3]); bw[2 * n] = cvt_pk_bf16(bt[0], bt[1]); bw[2 * n + 1] = cvt_pk_bf16(bt[2], bt[3]); }
                u32x4 w; w.x = lw[0]; w.y = lw[1]; w.z = lw[2]; w.w = lw[3]; *(u32x4*)(LA + off) = w;
                w.x = bw[0]; w.y = bw[1]; w.z = bw[2]; w.w = bw[3]; *(u32x4*)(BT + off) = w; }
    }
};

template <class Epi, class Sched, bool ALIGN_EPI = false, bool SP2 = false>
__device__ __forceinline__ void gemm_phase(PG8_LAS unsigned char* lds, const Gemm g, const Sched& S, const Epi& E) {
    int tid_ = threadIdx.x; asm volatile("" : "+v"(tid_));
    const int tid = tid_, wid = __builtin_amdgcn_readfirstlane(tid >> 6), lane = tid & 63, wr = wid >> 2, wc = wid & 3, fr = lane & 15, fq = lane >> 4;
    const int K = g.K, nt = K / BK;
    unsigned voffA[2], voffB[2];
#pragma unroll
    for (int i = 0; i < 2; ++i) { int R, C; stage_rc(tid * 16 + i * 8192, R, C); const int Rb = Epi::PERM ? ((R & ~31) + perm32(R & 31)) : R;
        voffA[i] = (unsigned)(R * g.lda + C) * 2u; voffB[i] = (unsigned)(Rb * g.ldb + C) * 2u; }
    const size_t kstep = (size_t)(BK * 2);
    const size_t hstepA = (size_t)HALF * g.lda * 2, hstepB = (size_t)HALF * g.ldb * 2;
    const size_t tstepA = 2 * hstepA, tstepB = 2 * hstepB;
    const unsigned ldsw = (unsigned)wid * 1024u;
    const int aoff = lds_byte(wr * 64 + fr, fq * 8), boff = lds_byte(wc * 32 + fr, fq * 8);
#define PG8_SA(b, h) (((b) * 2 + (h)) * HTB)
#define PG8_SB(b, h) ((4 + (b) * 2 + (h)) * HTB)
#define PG8_STAGE(bufoff, gbase, voff) do { _Pragma("unroll") for (int _i = 0; _i < 2; ++_i) \
        __builtin_amdgcn_global_load_lds((const unsigned*)((const char*)(gbase) + (voff)[_i]), (PG8_LAS unsigned*)(lds + (bufoff) + ldsw + _i * 8192), 16, 0, 0); } while (0)
#define PG8_LDA(dst, b, h) do { _Pragma("unroll") for (int m = 0; m < 4; ++m) _Pragma("unroll") for (int k = 0; k < 2; ++k) dst[m][k] = *(const PG8_LAS bf16x8*)(lds + PG8_SA(b, h) + aoff + m * 2048 + k * 1024); } while (0)
#define PG8_LDB(dst, b, h) do { _Pragma("unroll") for (int n = 0; n < 2; ++n) _Pragma("unroll") for (int k = 0; k < 2; ++k) dst[n][k] = *(const PG8_LAS bf16x8*)(lds + PG8_SB(b, h) + boff + n * 2048 + k * 1024); } while (0)
#define PG8_MMA(ai, bj, At, Bt) do { __builtin_amdgcn_s_setprio(1); _Pragma("unroll") for (int m = 0; m < 4; ++m) _Pragma("unroll") for (int n = 0; n < 2; ++n) _Pragma("unroll") for (int k = 0; k < 2; ++k) \
        acc[ai][bj][m][n] = __builtin_amdgcn_mfma_f32_16x16x32_bf16(Bt[n][k], At[m][k], acc[ai][bj][m][n], 0, 0, 0); __builtin_amdgcn_s_setprio(0); } while (0)
#define PG8_WAIT_V(n) asm volatile("s_waitcnt vmcnt(" #n ")" ::: "memory")
#ifndef PG8_RELAX
#define PG8_RELAX 0
#endif
#define PG8_WAIT_V8F do { if (PG8_RELAX) asm volatile("s_cmp_eq_u32 %0, 0\n\ts_cbranch_scc1 .Lpg8w%=a\n\ts_waitcnt vmcnt(%1)\n\ts_branch .Lpg8w%=b\n.Lpg8w%=a:\n\ts_waitcnt vmcnt(8)\n.Lpg8w%=b:" :: "s"(relax_), "n"(8 + Epi::NST) : "memory", "scc"); else PG8_WAIT_V(8); } while (0)
#define PG8_WAIT_L(n) asm volatile("s_waitcnt lgkmcnt(" #n ")" ::: "memory")
#define PG8_BAR __builtin_amdgcn_s_barrier()
#define PG8_SCHED __builtin_amdgcn_sched_barrier(0)
    Unit cur, nxt; int ui = 0;
    if (!S.next(0, cur)) return;
    f32x4 acc[2][2][4][2];
#pragma unroll
    for (int a = 0; a < 2; ++a)
#pragma unroll
        for (int b = 0; b < 2; ++b)
#pragma unroll
            for (int m = 0; m < 4; ++m)
#pragma unroll
                for (int n = 0; n < 2; ++n) acc[a][b][m][n] = (f32x4){0.f, 0.f, 0.f, 0.f};
    bf16x8 At[4][2], B0[2][2], B1[2][2];
    const char* cA = (const char*)g.A + (size_t)cur.pm * tstepA + (size_t)((cur.pn >> 1) * g.ablk) * 2; const char* cB = (const char*)g.Bt + (size_t)cur.pn * tstepB;
    S.a_ready(cur);
    if constexpr (SP2) {
        PG8_STAGE(PG8_SB(0, 0), cB, voffB); PG8_STAGE(PG8_SB(0, 1), cB + hstepB, voffB); PG8_STAGE(PG8_SA(0, 0), cA, voffA); PG8_STAGE(PG8_SA(0, 1), cA + hstepA, voffA);
        if (wr == 1) PG8_BAR;
        PG8_WAIT_V(2); PG8_BAR;
        PG8_STAGE(PG8_SB(1, 0), cB + kstep, voffB); PG8_STAGE(PG8_SA(1, 0), cA + kstep, voffA); PG8_STAGE(PG8_SB(1, 1), cB + hstepB + kstep, voffB);
        PG8_WAIT_V(6); PG8_BAR;
    } else {
        PG8_STAGE(PG8_SB(0, 0), cB, voffB); PG8_STAGE(PG8_SA(0, 0), cA, voffA); PG8_STAGE(PG8_SB(0, 1), cB + hstepB, voffB); PG8_STAGE(PG8_SA(0, 1), cA + hstepA, voffA);
        if (wr == 1) PG8_BAR;
        PG8_WAIT_V(4); PG8_BAR;
        PG8_STAGE(PG8_SB(1, 0), cB + kstep, voffB); PG8_STAGE(PG8_SA(1, 0), cA + kstep, voffA); PG8_STAGE(PG8_SB(1, 1), cB + hstepB + kstep, voffB);
        PG8_WAIT_V(6); PG8_BAR;
    }
    for (;;) {
        const bool has_next = S.next(ui + 1, nxt);
        const char* nA = has_next ? (const char*)g.A + (size_t)nxt.pm * tstepA + (size_t)((nxt.pn >> 1) * g.ablk) * 2 : cA; const char* nB = has_next ? (const char*)g.Bt + (size_t)nxt.pn * tstepB : cB;
        for (int t = 0; t < nt; t += 2) {
            const bool last = (t == nt - 2);
            const int relax_ = __builtin_amdgcn_readfirstlane((t == 0 && ui > 0) ? 1 : 0);
            const char* a1 = cA + (size_t)(t + 1) * kstep;
            const char* a2 = last ? nA : cA + (size_t)(t + 2) * kstep; const char* b2 = last ? nB : cB + (size_t)(t + 2) * kstep;
            const char* a3 = a2 + kstep; const char* b3 = b2 + kstep;
            if (last && has_next) S.a_ready(nxt);
            if constexpr (SP2) {
            PG8_LDB(B0, 0, 0); PG8_LDB(B1, 0, 1); PG8_SCHED; PG8_LDA(At, 0, 0); PG8_STAGE(PG8_SA(1, 1), a1 + hstepA, voffA);
            PG8_WAIT_V8F; PG8_WAIT_L(0); PG8_BAR; PG8_MMA(0, 0, At, B0); PG8_MMA(0, 1, At, B1); PG8_BAR; PG8_SCHED;
            PG8_LDA(At, 0, 1); PG8_STAGE(PG8_SB(0, 0), b2, voffB); PG8_STAGE(PG8_SB(0, 1), b2 + hstepB, voffB); PG8_STAGE(PG8_SA(0, 0), a2, voffA);
            PG8_WAIT_V8F; PG8_WAIT_L(0); PG8_BAR; PG8_MMA(1, 0, At, B0); PG8_MMA(1, 1, At, B1); PG8_BAR; PG8_SCHED;
            PG8_LDB(B0, 1, 0); PG8_LDB(B1, 1, 1); PG8_SCHED; PG8_LDA(At, 1, 0); PG8_STAGE(PG8_SA(0, 1), a2 + hstepA, voffA);
            PG8_WAIT_V(8); PG8_WAIT_L(0); PG8_BAR; PG8_MMA(0, 0, At, B0); PG8_MMA(0, 1, At, B1); PG8_BAR; PG8_SCHED;
            PG8_LDA(At, 1, 1); PG8_STAGE(PG8_SB(1, 0), b3, voffB); PG8_STAGE(PG8_SB(1, 1), b3 + hstepB, voffB); PG8_STAGE(PG8_SA(1, 0), a3, voffA);
            PG8_WAIT_V(8); PG8_WAIT_L(0); PG8_BAR; PG8_MMA(1, 0, At, B0); PG8_MMA(1, 1, At, B1); PG8_BAR; PG8_SCHED;
            } else {
            PG8_LDB(B0, 0, 0); PG8_SCHED; PG8_LDA(At, 0, 0); PG8_STAGE(PG8_SA(1, 1), a1 + hstepA, voffA);
            PG8_WAIT_L(8); PG8_BAR; PG8_WAIT_L(0); PG8_MMA(0, 0, At, B0); PG8_BAR; PG8_SCHED;
            PG8_LDB(B1, 0, 1); PG8_STAGE(PG8_SB(0, 0), b2, voffB);
            PG8_BAR; PG8_WAIT_L(0); PG8_MMA(0, 1, At, B1); PG8_BAR;
            PG8_LDA(At, 0, 1); PG8_STAGE(PG8_SA(0, 0), a2, voffA);
            PG8_BAR; PG8_WAIT_L(0); PG8_MMA(1, 0, At, B0); PG8_BAR; PG8_SCHED;
            PG8_STAGE(PG8_SB(0, 1), b2 + hstepB, voffB);
            PG8_WAIT_V(6); PG8_BAR; PG8_MMA(1, 1, At, B1); PG8_BAR;
            PG8_LDB(B0, 1, 0); PG8_SCHED; PG8_LDA(At, 1, 0); PG8_STAGE(PG8_SA(0, 1), a2 + hstepA, voffA);
            PG8_WAIT_L(8); PG8_BAR; PG8_WAIT_L(0); PG8_MMA(0, 0, At, B0); PG8_BAR; PG8_SCHED;
            PG8_LDB(B1, 1, 1); PG8_STAGE(PG8_SB(1, 0), b3, voffB);
            PG8_BAR; PG8_WAIT_L(0); PG8_MMA(0, 1, At, B1); PG8_BAR;
            PG8_LDA(At, 1, 1); PG8_STAGE(PG8_SA(1, 0), a3, voffA);
            PG8_BAR; PG8_WAIT_L(0); PG8_MMA(1, 0, At, B0); PG8_BAR; PG8_SCHED;
            PG8_STAGE(PG8_SB(1, 1), b3 + hstepB, voffB);
            PG8_WAIT_V(6); PG8_BAR; PG8_MMA(1, 1, At, B1); PG8_BAR;
            }
        }
        if constexpr (ALIGN_EPI) { if (wr == 0) PG8_BAR; }
        if constexpr (!Epi::AFTER_DRAIN) { E(acc, cur, wr, wc, fr, fq); S.done(cur); }
        if (!has_next) break;
#pragma unroll
        for (int a = 0; a < 2; ++a)
#pragma unroll
            for (int b = 0; b < 2; ++b)
#pragma unroll
                for (int m = 0; m < 4; ++m)
#pragma unroll
                    for (int n = 0; n < 2; ++n) acc[a][b][m][n] = (f32x4){0.f, 0.f, 0.f, 0.f};
        cur = nxt; cA = nA; cB = nB; ++ui;
        if constexpr (ALIGN_EPI) { if (wr == 1) PG8_BAR; }
    }
    PG8_WAIT_V(0);
    if constexpr (!ALIGN_EPI) { if (wr == 0) PG8_BAR; }
    PG8_BAR;
    if constexpr (Epi::AFTER_DRAIN) { E.fused(acc, cur, wr, wc, fr, fq, lds, wid, lane); S.done(cur); }
#undef PG8_SA
#undef PG8_SB
#undef PG8_STAGE
#undef PG8_LDA
#undef PG8_LDB
#undef PG8_MMA
#undef PG8_WAIT_V
#undef PG8_WAIT_V8F
#undef PG8_WAIT_L
#undef PG8_BAR
#undef PG8_SCHED
}
}
#define GAS __attribute__((address_space(1)))
#define LAS __attribute__((address_space(3)))
typedef unsigned short bf16;
typedef unsigned v4u __attribute__((ext_vector_type(4)));
typedef float f32x4 __attribute__((ext_vector_type(4)));
typedef short bf16x8 __attribute__((ext_vector_type(8)));
typedef GAS unsigned gu32;
typedef GAS unsigned long long gu64;
#define RLX_AGENT __ATOMIC_RELAXED, __HIP_MEMORY_SCOPE_AGENT
#define LDS_WAIT() asm volatile("s_waitcnt lgkmcnt(0)" ::: "memory")
#define VM_WAIT() asm volatile("s_waitcnt vmcnt(0)" ::: "memory")
__device__ __forceinline__ unsigned long long rt() { return __builtin_amdgcn_s_memrealtime(); }
__device__ __forceinline__ unsigned f2bf(float f) { unsigned u = __builtin_bit_cast(unsigned, f); return (u + 0x7fffu + ((u >> 16) & 1u)) >> 16; }
__device__ __forceinline__ unsigned pk2(float lo, float hi) { return f2bf(lo) | (f2bf(hi) << 16); }

#define XB_TMO      128
#define XB_XCNT(j)  (256  + 64 * (j))
#define XB_XSUB(j)  (1280 + 64 * (j))
#define XB_XGEN(j)  (2304 + 64 * (j))
#define XB_TOP      3328
#define XB_TOPGEN   3392
#define XCD_BAR_WORDS 3456
#define XB_SPIN_CAP (1u << 18)

__device__ __forceinline__ unsigned xb_ld(unsigned* p)              { return __hip_atomic_load(p, __ATOMIC_RELAXED, __HIP_MEMORY_SCOPE_AGENT); }
__device__ __forceinline__ unsigned xb_add(unsigned* p, unsigned v) { return __hip_atomic_fetch_add(p, v, __ATOMIC_RELAXED, __HIP_MEMORY_SCOPE_AGENT); }
__device__ __forceinline__ unsigned xb_xcc_id() { return (unsigned)__builtin_amdgcn_s_getreg((3 << 11) | 20) & 0xFu; }
#define XB_SPIN(cond, bar) do { unsigned _sp = 0; while (cond) { __builtin_amdgcn_s_sleep(1); \
    if ((++_sp & 255u) == 0u) { if (xb_ld(&(bar)[XB_TMO])) break; if (_sp > XB_SPIN_CAP) { atomicAdd(&(bar)[XB_TMO], 1u); break; } } } } while (0)

struct XcdBarrier {
    unsigned* bar; unsigned x;
    volatile LAS unsigned* st;
};

__device__ __forceinline__ XcdBarrier xcd_barrier_post(unsigned* bar, volatile LAS unsigned* st) {
    XcdBarrier b; b.bar = bar; b.x = xb_xcc_id(); b.st = st;
    if (threadIdx.x == 0) (void)xb_add(&bar[XB_XCNT(b.x)], 1u);
    return b;
}
__device__ __forceinline__ void xcd_barrier_complete(unsigned* bar, unsigned x, unsigned& nloc, unsigned& nx) {
    const unsigned G = gridDim.x * gridDim.y * gridDim.z;
    unsigned sum, cnt, mine, sp = 0u;
    for (;;) {
        sum = 0u; cnt = 0u; mine = 0u;
#pragma unroll
        for (unsigned j = 0; j < 16; ++j) { const unsigned c = xb_ld(&bar[XB_XCNT(j)]); sum += c; cnt += (c > 0u) ? 1u : 0u; mine = (j == x) ? c : mine; }
        if (sum == G) break;
        __builtin_amdgcn_s_sleep(1);
        if ((++sp & 255u) == 0u) { if (xb_ld(&bar[XB_TMO])) break; if (sp > XB_SPIN_CAP) { atomicAdd(&bar[XB_TMO], 1u); break; } }
    }
    nloc = mine > 0u ? mine : 1u; nx = cnt > 0u ? cnt : 1u;
}

__device__ __forceinline__ void xcd_barrier(const XcdBarrier& b) {
    asm volatile("s_waitcnt vmcnt(0)" ::: "memory");
    __syncthreads();
    if (threadIdx.x == 0) {
        unsigned* bar = b.bar;
        __builtin_amdgcn_s_waitcnt(0);
        unsigned nloc = b.st[0], nx = b.st[1];
        if (nloc == 0u) { xcd_barrier_complete(bar, b.x, nloc, nx); b.st[0] = nloc; b.st[1] = nx; }
        const unsigned old = xb_add(&bar[XB_XSUB(b.x)], 1u);
        const unsigned gen = old / nloc;
        if (old + 1u == (gen + 1u) * nloc) {
            __builtin_amdgcn_fence(__ATOMIC_RELEASE, "agent");
            asm volatile("s_waitcnt vmcnt(0)" ::: "memory");
            const unsigned og = xb_add(&bar[XB_TOP], 1u);
            const unsigned tg = og / nx;
            if (og + 1u == (tg + 1u) * nx) xb_add(&bar[XB_TOPGEN], 1u);
            else XB_SPIN(xb_ld(&bar[XB_TOPGEN]) == tg, bar);
            __builtin_amdgcn_fence(__ATOMIC_ACQUIRE, "agent");
            xb_add(&bar[XB_XGEN(b.x)], 1u);
            asm volatile("s_waitcnt vmcnt(0)" ::: "memory");
        } else {
            XB_SPIN(xb_ld(&bar[XB_XGEN(b.x)]) == gen, bar);
            __builtin_amdgcn_fence(__ATOMIC_ACQUIRE, "agent");
            asm volatile("s_waitcnt vmcnt(0)" ::: "memory");
        }
    }
    __syncthreads();
}
namespace mattn {
typedef unsigned short bf16;
constexpr int D = 128, NW = 8, QBLK = 32, KVBLK = 64;
constexpr float SCALE = 0.088388347648318440f, THR = 8.f;
constexpr int LDQ = 3072, LDK = 3072, LDO = 1024;
constexpr size_t SHM_V = KVBLK * D * 2, SHM_K = KVBLK * D * 2, SHM_ATTN = 2 * SHM_V + 2 * SHM_K + NW * 64 * 4;
using bf16x8 = __attribute__((ext_vector_type(8))) short;
using s16x4  = __attribute__((ext_vector_type(4))) short;
using f32x16 = __attribute__((ext_vector_type(16))) float;
using u32x4  = __attribute__((ext_vector_type(4))) unsigned;
#define KSWZ(row, colB) ((row) * 256 + ((colB) ^ (((row) & 7) << 4)))
#define SBAR() __builtin_amdgcn_sched_barrier(0)
__device__ __forceinline__ int crow(int r, int hi) { return (r & 3) + 8 * (r >> 2) + 4 * hi; }
__device__ __forceinline__ unsigned cvtpk(float lo, float hi) { unsigned r; asm volatile("v_cvt_pk_bf16_f32 %0, %1, %2" : "=v"(r) : "v"(lo), "v"(hi)); return r; }
struct Msk { int j; unsigned sel; int qpos; };
__device__ __forceinline__ float sconst(unsigned bits) { return __uint_as_float((unsigned)__builtin_amdgcn_readfirstlane((int)bits)); }
__device__ __forceinline__ void partialSM(f32x16& p0, f32x16& p1, float& m_reg, float& mn, float& alpha, int tile, const Msk& mk, int hi) {
  constexpr float C = SCALE * 1.4426950408889634f;
  const int kb = tile >> 2; const bool own = (kb == mk.j), lsel = own || ((mk.sel >> kb) & 1u);
  float pmax = p0[0];
#pragma unroll
for (int r = 1; r < 16; ++r) pmax = fmaxf(pmax, p0[r]);
#pragma unroll
for (int r = 0; r < 16; ++r) pmax = fmaxf(pmax, p1[r]);
  { auto rr = __builtin_amdgcn_permlane32_swap(__float_as_uint(pmax), __float_as_uint(pmax), false, false);
    pmax = fmaxf(__uint_as_float(rr[0]), __uint_as_float(rr[1])); }
  if (!lsel) pmax = sconst(0xf149f2cau);
  if (__builtin_expect(__all(pmax - m_reg <= THR / SCALE), 1)) { mn = m_reg; alpha = 1.f; }
  else { mn = fmaxf(m_reg, pmax); alpha = __builtin_amdgcn_exp2f((m_reg - mn) * C); m_reg = mn; }
  const float mnC = lsel ? -mn * C : sconst(0xff800000u);
#pragma unroll
for (int r = 0; r < 16; ++r) p0[r] = fmaf(p0[r], C, mnC);
#pragma unroll
for (int r = 0; r < 16; ++r) p1[r] = fmaf(p1[r], C, mnC);
#pragma unroll
for (int r = 0; r < 16; ++r) p0[r] = __builtin_amdgcn_exp2f(p0[r]);
}
__device__ __forceinline__ void finishSM(f32x16& p0, f32x16& p1, float alpha, float& l_reg, bf16x8& pa0, bf16x8& pa1, bf16x8& pa2, bf16x8& pa3) {
#pragma unroll
for (int r = 0; r < 16; ++r) p1[r] = __builtin_amdgcn_exp2f(p1[r]);
  float ps = 0;
#pragma unroll
for (int r = 0; r < 16; ++r) ps += p0[r];
#pragma unroll
for (int r = 0; r < 16; ++r) ps += p1[r];
  { auto rr = __builtin_amdgcn_permlane32_swap(__float_as_uint(ps), __float_as_uint(ps), false, false);
    ps = __uint_as_float(rr[0]) + __uint_as_float(rr[1]); }
  l_reg = l_reg * alpha + ps;
#define PK4(P, BASE, OUT) do { unsigned a0 = cvtpk(P[BASE + 0], P[BASE + 1]), a1 = cvtpk(P[BASE + 2], P[BASE + 3]);   \
    unsigned b0 = cvtpk(P[BASE + 4], P[BASE + 5]), b1 = cvtpk(P[BASE + 6], P[BASE + 7]);                              \
    auto r0 = __builtin_amdgcn_permlane32_swap(a0, b0, false, false); auto r1 = __builtin_amdgcn_permlane32_swap(a1, b1, false, false); \
    u32x4 w = {r0[0], r1[0], r0[1], r1[1]}; OUT = *reinterpret_cast<bf16x8*>(&w); } while (0)
  PK4(p0, 0, pa0); PK4(p0, 8, pa1); PK4(p1, 0, pa2); PK4(p1, 8, pa3);
#undef PK4
}
__device__ __forceinline__ void qkt(f32x16& p0, f32x16& p1, const bf16* Ks, const bf16x8* qr, int r32, int hi, int tile, const Msk& mk) {
  if ((tile >> 2) == mk.j) { const float NEGB = sconst(0xf149f2cau); int qp = mk.qpos - (tile & 3) * 64; asm volatile("" : "+v"(qp));
#pragma unroll
    for (int r = 0; r < 16; ++r) { const int k0 = crow(r, hi); p0[r] = (k0 > qp) ? NEGB : 0.f; p1[r] = (k0 + 32 > qp) ? NEGB : 0.f; } }
  else { p0 = f32x16{}; p1 = f32x16{}; }
#pragma unroll
for (int d0 = 0; d0 < 8; ++d0) { int cb = (d0 * 16 + hi * 8) * 2;
    bf16x8 b0 = *reinterpret_cast<const bf16x8*>((const char*)Ks + KSWZ(r32, cb));
    bf16x8 b1 = *reinterpret_cast<const bf16x8*>((const char*)Ks + KSWZ(32 + r32, cb));
    p0 = __builtin_amdgcn_mfma_f32_32x32x16_bf16(b0, qr[d0], p0, 0, 0, 0);
    p1 = __builtin_amdgcn_mfma_f32_32x32x16_bf16(b1, qr[d0], p1, 0, 0, 0); }
}
__device__ __forceinline__ int v_st(int k, int c) { const int kk = (k & ~0xC) | ((k & 4) << 1) | ((k & 8) >> 1); return ((kk >> 3) * 4 + (c >> 5)) * 512 + ((kk & 7) * 32 + (c & 31)) * 2; }
__device__ __forceinline__ int v_rd_base(int lane) { return ((lane & 3) << 3) | (((lane >> 2) & 3) << 6) | (((lane >> 4) & 1) << 5) | (((lane >> 5) & 1) << 8); }
constexpr int v_rd_off(int d0, int ks, int half) { return d0 * 512 + ks * 4096 + half * 2048; }
template <int OFF> __device__ __forceinline__ s16x4 tr_read(int vb) { s16x4 r; asm volatile("ds_read_b64_tr_b16 %0, %1 offset:%2" : "=&v"(r) : "v"(vb), "i"(OFF) : "memory"); return r; }
template <int D0> __device__ __forceinline__ void pv_one(f32x16& od, int vb, bf16x8 pa0, bf16x8 pa1, bf16x8 pa2, bf16x8 pa3) {
  const s16x4 l0 = tr_read<v_rd_off(D0, 0, 0)>(vb), h0 = tr_read<v_rd_off(D0, 0, 1)>(vb), l1 = tr_read<v_rd_off(D0, 1, 0)>(vb), h1 = tr_read<v_rd_off(D0, 1, 1)>(vb);
  const s16x4 l2 = tr_read<v_rd_off(D0, 2, 0)>(vb), h2 = tr_read<v_rd_off(D0, 2, 1)>(vb), l3 = tr_read<v_rd_off(D0, 3, 0)>(vb), h3 = tr_read<v_rd_off(D0, 3, 1)>(vb);
  asm volatile("s_waitcnt lgkmcnt(0)" ::: "memory"); SBAR();
#define PK(L, H) (bf16x8){L[0], L[1], L[2], L[3], H[0], H[1], H[2], H[3]}
  od = __builtin_amdgcn_mfma_f32_32x32x16_bf16(pa0, PK(l0, h0), od, 0, 0, 0);
  od = __builtin_amdgcn_mfma_f32_32x32x16_bf16(pa1, PK(l1, h1), od, 0, 0, 0);
  od = __builtin_amdgcn_mfma_f32_32x32x16_bf16(pa2, PK(l2, h2), od, 0, 0, 0);
  od = __builtin_amdgcn_mfma_f32_32x32x16_bf16(pa3, PK(l3, h3), od, 0, 0, 0);
#undef PK
}
__device__ __forceinline__ void pv_d0(f32x16* o, int vb, bf16x8 pa0, bf16x8 pa1, bf16x8 pa2, bf16x8 pa3) {
  pv_one<0>(o[0], vb, pa0, pa1, pa2, pa3); pv_one<1>(o[1], vb, pa0, pa1, pa2, pa3); pv_one<2>(o[2], vb, pa0, pa1, pa2, pa3); pv_one<3>(o[3], vb, pa0, pa1, pa2, pa3);
}
__device__ __forceinline__ void body(const bf16x8 (&qr)[8], const bf16* __restrict__ Kh, const bf16* __restrict__ Vh, bf16* __restrict__ Ob, int seq, char* lds, const Msk mk) {
  int tid_ = threadIdx.x; asm volatile("" : "+v"(tid_));
  const int tid = tid_, wid = tid >> 6, lane = tid & 63, r32 = lane & 31, hi = lane >> 5;
  bf16* V_lds = (bf16*)lds; bf16* K_lds = (bf16*)(lds + 2 * SHM_V);
  float* ws = (float*)(lds + 2 * SHM_V + 2 * SHM_K) + wid * 64; float* li_l = ws; float* al_l = ws + 32;
  float m_reg = -1e30f, l_reg = 0; f32x16 o[4] = {};
#define VB0() ({ int l2_ = lane; asm volatile("" : "+v"(l2_)); (int)(uintptr_t)V_lds + v_rd_base(l2_); })
  struct { bf16x8 vs0, vs1, ks0, ks1; } sr_[1];
#define STG_IDX() int t2_ = tid; asm volatile("" : "+v"(t2_)); const int sr = t2_ >> 4, sc = (t2_ & 15) * 8
#define SLOAD(i, k0) do { STG_IDX(); const unsigned goff0 = (unsigned)((sr * LDK + sc) * 2), goff1 = (unsigned)(((32 + sr) * LDK + sc) * 2); \
    const char* vb_ = (const char*)(Vh + (long)(k0) * LDK); const char* kb_ = (const char*)(Kh + (long)(k0) * LDK); \
    sr_[i].vs0 = *(const bf16x8*)(vb_ + goff0); sr_[i].vs1 = *(const bf16x8*)(vb_ + goff1); sr_[i].ks0 = *(const bf16x8*)(kb_ + goff0); sr_[i].ks1 = *(const bf16x8*)(kb_ + goff1); } while (0)
#define SWRITE(b, i) do { STG_IDX(); const int vst0 = v_st(sr, sc), vst1 = v_st(32 + sr, sc); *(bf16x8*)((char*)V_lds + (b) * SHM_V + vst0) = sr_[i].vs0; *(bf16x8*)((char*)V_lds + (b) * SHM_V + vst1) = sr_[i].vs1; int kc = sc * 2; \
    *(bf16x8*)((char*)K_lds + (b) * SHM_K + KSWZ(sr, kc)) = sr_[i].ks0; *(bf16x8*)((char*)K_lds + (b) * SHM_K + KSWZ(32 + sr, kc)) = sr_[i].ks1; } while (0)
#define SWAIT() asm volatile("s_waitcnt vmcnt(0)" ::: "memory")
#define RESC(a) do { if (__any((a) < 1.f)) { if (hi == 0) al_l[r32] = (a); asm volatile("s_waitcnt lgkmcnt(0)" ::: "memory"); \
    _Pragma("unroll") for (int d = 0; d < 4; ++d) _Pragma("unroll") for (int r = 0; r < 16; ++r) o[d][r] *= al_l[crow(r, hi)]; } } while (0)
  f32x16 pA0, pA1, pB0, pB1; float mnA, mnB, alA, alB; bf16x8 pa0, pa1, pa2, pa3; const int NT = seq / KVBLK;
  constexpr int SE = 0, SO = 0;
  SLOAD(SE, 0); asm volatile("s_waitcnt vmcnt(0)" ::: "memory"); SWRITE(0, SE); __syncthreads();
  qkt(pA0, pA1, K_lds, qr, r32, hi, 0, mk); partialSM(pA0, pA1, m_reg, mnA, alA, 0, mk, hi);
  SLOAD(SO, KVBLK);
  SWAIT(); SWRITE(1, SO); __syncthreads();
#pragma unroll 1
  for (int j = 1; j + 1 < NT; j += 2) {
    SBAR(); qkt(pB0, pB1, (bf16*)((char*)K_lds + SHM_K), qr, r32, hi, j, mk);
    finishSM(pA0, pA1, alA, l_reg, pa0, pa1, pa2, pa3); SBAR();
    SLOAD(SO, (j + 1) * KVBLK); SBAR();
    pv_d0(o, VB0(), pa0, pa1, pa2, pa3); partialSM(pB0, pB1, m_reg, mnB, alB, j, mk, hi);
    __syncthreads(); SWAIT(); SWRITE(0, SE);
    RESC(alB); __syncthreads();
    SBAR(); qkt(pA0, pA1, K_lds, qr, r32, hi, j + 1, mk);
    finishSM(pB0, pB1, alB, l_reg, pa0, pa1, pa2, pa3); SBAR();
    SLOAD(SE, (j + 2) * KVBLK); SBAR();
    pv_d0(o, VB0() + (int)SHM_V, pa0, pa1, pa2, pa3); partialSM(pA0, pA1, m_reg, mnA, alA, j + 1, mk, hi);
    __syncthreads(); SWAIT(); SWRITE(1, SO);
    RESC(alA); __syncthreads();
  }
  SBAR(); qkt(pB0, pB1, (bf16*)((char*)K_lds + SHM_K), qr, r32, hi, NT - 1, mk);
  finishSM(pA0, pA1, alA, l_reg, pa0, pa1, pa2, pa3); SBAR();
  pv_d0(o, VB0(), pa0, pa1, pa2, pa3); partialSM(pB0, pB1, m_reg, mnB, alB, NT - 1, mk, hi);
  __syncthreads(); RESC(alB);
  finishSM(pB0, pB1, alB, l_reg, pa0, pa1, pa2, pa3); SBAR();
  pv_d0(o, VB0() + (int)SHM_V, pa0, pa1, pa2, pa3);
  if (hi == 0) li_l[r32] = l_reg; asm volatile("s_waitcnt lgkmcnt(0)" ::: "memory");
  float rli[16];
#pragma unroll
for (int r = 0; r < 16; ++r) rli[r] = __builtin_amdgcn_rcpf(li_l[crow(r, hi)]);
  bf16* Ow = Ob + (long)(wid * QBLK) * LDO;
#pragma unroll
for (int r = 0; r < 16; ++r) { int orow = crow(r, hi);
#pragma unroll
for (int d0 = 0; d0 < 4; ++d0) { const float v = o[d0][r] * rli[r]; unsigned u = __float_as_uint(v); u = (u + 0x7fffu + ((u >> 16) & 1u)) >> 16; Ow[(long)orow * LDO + d0 * 32 + r32] = (bf16)u; } }
#undef SLOAD
#undef VB0
#undef STG_IDX
#undef SWRITE
#undef SWAIT
#undef RESC
}
#undef KSWZ
#undef SBAR
}


constexpr int NWAVES = 8, NTHR = 512;
constexpr int MTOK = 32768, DM = 1024, SEQ = 2048, NB = 16, DFF = 2816;
constexpr size_t MiB = 1u << 20;
constexpr size_t WS_CTL = 0, CTL_ZERO_BYTES = 64 * 1024;
constexpr size_t WS_W_MIXIN = 1 * MiB, WS_W_MIXOUT = 13 * MiB, WS_W_FFNIN = 17 * MiB, WS_W_FFNOUT = 28 * MiB;
constexpr size_t WS_GATESA = 34 * MiB, WS_SSQA = 35 * MiB, WS_STATC = 492 * MiB, WS_KMEAN = 41 * MiB, WS_SSQH = 42 * MiB, WS_SPTAB = 33 * MiB + 512 * 1024;
constexpr size_t WS_U = 44 * MiB, WS_BIG = 108 * MiB, WS_END = 500 * MiB;
constexpr int CW_BAR = 1024;
static_assert((CW_BAR + 3456) * 4 <= (int)CTL_ZERO_BYTES, "ctl");
constexpr int LDS_BYTES = 163840, MISC_OFF = 163584;

typedef unsigned u32x4 __attribute__((ext_vector_type(4)));
typedef unsigned u32x2 __attribute__((ext_vector_type(2)));
typedef float f32x2 __attribute__((ext_vector_type(2)));
struct Frame { LAS unsigned char* lds; int tid, lane, wave, G; };
struct Args { const void* in[24]; float* out; unsigned char* ws; int ph_lo, ph_hi; };

__device__ __forceinline__ float wave_sum(float v) {
#pragma unroll
    for (int o = 1; o < 64; o <<= 1) v += __shfl_xor(v, o);
    return v;
}
__device__ __forceinline__ float bf2f(bf16 b) { return __uint_as_float(((unsigned)b) << 16); }
__device__ __forceinline__ float lo_bf(unsigned w) { return __uint_as_float(w << 16); }
__device__ __forceinline__ float hi_bf(unsigned w) { return __uint_as_float(w & 0xffff0000u); }
__device__ __forceinline__ unsigned cvtpk(float lo, float hi) { return pg8::cvt_pk_bf16(lo, hi); }

typedef short v4s16 __attribute__((ext_vector_type(4)));
template <int LD> __device__ __forceinline__ bf16x8 tr_frag(const LAS bf16* T, int r0, int c0, int lane) {
    const int fr = lane & 15, fq = lane >> 4;
    const LAS bf16* a = T + (r0 + 8 * fq + (fr >> 2)) * LD + c0 + 4 * (fr & 3);
    const v4s16 lo = __builtin_amdgcn_ds_read_tr16_b64_v4i16((LAS v4s16*)a);
    const v4s16 hi = __builtin_amdgcn_ds_read_tr16_b64_v4i16((LAS v4s16*)(a + 4 * LD));
    return __builtin_shufflevector(lo, hi, 0, 1, 2, 3, 4, 5, 6, 7);
}
template <int MT, int NT, int K, int LDA, int LDB, bool TA = false, bool TB = false, bool SB = true>
__device__ __forceinline__ void wgemm(f32x4 (&acc)[MT][NT], const LAS bf16* A, const LAS bf16* Bt, int lane) {
    const int fr = lane & 15, fq = lane >> 4;
    const LAS bf16* ap = A + fr * LDA + 8 * fq;
    const LAS bf16* bp = Bt + fr * LDB + 8 * fq;
#pragma unroll
    for (int k0 = 0; k0 < K; k0 += 32) {
        bf16x8 a[MT], b[NT];
#pragma unroll
        for (int i = 0; i < MT; ++i) a[i] = TA ? tr_frag<LDA>(A, k0, 16 * i, lane) : *(const LAS bf16x8*)(ap + 16 * i * LDA + k0);
#pragma unroll
        for (int j = 0; j < NT; ++j) b[j] = TB ? tr_frag<LDB>(Bt, k0, 16 * j, lane) : *(const LAS bf16x8*)(bp + 16 * j * LDB + k0);
#pragma unroll
        for (int i = 0; i < MT; ++i)
#pragma unroll
            for (int j = 0; j < NT; ++j) acc[i][j] = __builtin_amdgcn_mfma_f32_16x16x32_bf16(a[i], b[j], acc[i][j], 0, 0, 0);
        if (SB && MT * NT >= 4) __builtin_amdgcn_sched_barrier(0);
    }
    if (!SB) __builtin_amdgcn_sched_barrier(0);
}

__device__ __forceinline__ int cvt_src_col(int mode, int g0) {
    if (mode == 0) return g0;
    const int pn = g0 >> 8, r = g0 & 255;
    if (mode == 1) return r < 128 ? 128 * pn + r : DFF + 128 * pn + (r - 128);
    return r < 128 ? 128 * pn + r : 256 + 128 * pn + (r - 128);
}
__device__ __forceinline__ void cvt_matrix(Frame& F, const float* W, int ldw, int K, int Np, int mode, bf16* WT, const float* gain = nullptr) {
    LAS float* scr = (LAS float*)(F.lds + F.wave * 16384);
    const int gw = blockIdx.x * NWAVES + F.wave, NGW = F.G * NWAVES, lane = F.lane;
    const int nblk = Np / 32, nitems = (K / 64) * nblk;
    float v[32], vn[32];
#define CVT_LOAD(dst, it) do { const int kb_ = (it) / nblk, nb_ = (it) % nblk, s0_ = cvt_src_col(mode, 32 * nb_); const float* wp_ = W + (size_t)(64 * kb_ + (lane >> 5)) * ldw + s0_ + (lane & 31); \
        _Pragma("unroll") for (int i = 0; i < 32; ++i) dst[i] = wp_[(size_t)(2 * i) * ldw]; } while (0)
    int item = gw;
    if (item < nitems) CVT_LOAD(v, item);
    for (; item < nitems; item += NGW) {
        const int kb = item / nblk, nb = item % nblk, k0 = 64 * kb, n0 = 32 * nb;
        if (item + NGW < nitems) CVT_LOAD(vn, item + NGW);
        if (gain) {
#pragma unroll
            for (int i = 0; i < 32; ++i) v[i] *= gain[k0 + 2 * i + (lane >> 5)]; }
#pragma unroll
        for (int i = 0; i < 32; ++i) scr[(2 * i + (lane >> 5)) * 33 + (lane & 31)] = v[i];
        LDS_WAIT(); asm volatile("" ::: "memory");
        const int c = lane & 7;
#pragma unroll
        for (int j = 0; j < 4; ++j) { const int n = (lane >> 3) + 8 * j; const LAS float* sp = scr + (8 * c) * 33 + n;
            v4u o; o.x = pk2(sp[0 * 33], sp[1 * 33]); o.y = pk2(sp[2 * 33], sp[3 * 33]); o.z = pk2(sp[4 * 33], sp[5 * 33]); o.w = pk2(sp[6 * 33], sp[7 * 33]);
            *(v4u*)(WT + (size_t)(n0 + n) * K + k0 + 8 * c) = o; }
        LDS_WAIT(); asm volatile("" ::: "memory");
#pragma unroll
        for (int i = 0; i < 32; ++i) v[i] = vn[i];
    }
#undef CVT_LOAD
}

__device__ __forceinline__ void norm_phase_b(Frame& F, const bf16* src, const float* gain, bf16* dst) {
    const int gw = blockIdx.x * NWAVES + F.wave, NGW = F.G * NWAVES, lane = F.lane;
    f32x4 g[4];
#pragma unroll
    for (int j = 0; j < 2; ++j) { g[2 * j] = *(const f32x4*)(gain + 8 * lane + 512 * j); g[2 * j + 1] = *(const f32x4*)(gain + 8 * lane + 512 * j + 4); }
    v4u cur[2], nxt[2];
    if (gw < MTOK) {
#pragma unroll
        for (int j = 0; j < 2; ++j) cur[j] = *(const v4u*)(src + (size_t)gw * DM + 8 * lane + 512 * j); }
    for (int m = gw; m < MTOK; m += NGW) {
        if (m + NGW < MTOK) {
#pragma unroll
            for (int j = 0; j < 2; ++j) nxt[j] = *(const v4u*)(src + (size_t)(m + NGW) * DM + 8 * lane + 512 * j); }
        f32x4 v[4]; float s = 0.f;
#pragma unroll
        for (int j = 0; j < 2; ++j) { v[2 * j] = (f32x4){lo_bf(cur[j].x), hi_bf(cur[j].x), lo_bf(cur[j].y), hi_bf(cur[j].y)}; v[2 * j + 1] = (f32x4){lo_bf(cur[j].z), hi_bf(cur[j].z), lo_bf(cur[j].w), hi_bf(cur[j].w)}; }
#pragma unroll
        for (int k = 0; k < 4; ++k) s += (v[k].x * v[k].x + v[k].y * v[k].y) + (v[k].z * v[k].z + v[k].w * v[k].w);
        const float rstd = 1.0f / sqrtf(wave_sum(s) * (1.0f / DM) + 1e-6f);
#pragma unroll
        for (int j = 0; j < 2; ++j) { const f32x4 a = v[2 * j] * rstd * g[2 * j], b = v[2 * j + 1] * rstd * g[2 * j + 1];
            v4u o; o.x = cvtpk(a.x, a.y); o.y = cvtpk(a.z, a.w); o.z = cvtpk(b.x, b.y); o.w = cvtpk(b.z, b.w);
            *(v4u*)(dst + (size_t)m * DM + 8 * lane + 512 * j) = o; }
        cur[0] = nxt[0]; cur[1] = nxt[1];
    }
}
template <bool GATES>
__device__ __forceinline__ void norm_phase(Frame& F, const float* src, const float* gain, bf16* dst, const float* wA, const float* bA, float* gout) {
    LAS float* wg = (LAS float*)F.lds;
    if (GATES) {
        for (int i = F.tid; i < 1024 * 8; i += NTHR) wg[i] = wA[(size_t)(i >> 3) * 3080 + 3072 + (i & 7)];
        __syncthreads();
    }
    const int gw = blockIdx.x * NWAVES + F.wave, NGW = F.G * NWAVES, lane = F.lane;
    f32x4 g[4];
#pragma unroll
    for (int j = 0; j < 4; ++j) g[j] = ((const f32x4*)gain)[lane + 64 * j];
    for (int m = gw; m < MTOK; m += NGW) {
        const f32x4* xr = (const f32x4*)(src + (size_t)m * DM) + lane;
        f32x4 v[4]; float s = 0.f;
#pragma unroll
        for (int j = 0; j < 4; ++j) { v[j] = xr[64 * j]; s += (v[j].x * v[j].x + v[j].y * v[j].y) + (v[j].z * v[j].z + v[j].w * v[j].w); }
        const float rstd = 1.0f / sqrtf(wave_sum(s) * (1.0f / DM) + 1e-6f);
        unsigned long long* o8 = (unsigned long long*)(dst + (size_t)m * DM) + lane;
#pragma unroll
        for (int j = 0; j < 4; ++j) { v[j] = v[j] * rstd * g[j];
            o8[64 * j] = (unsigned long long)cvtpk(v[j].x, v[j].y) | ((unsigned long long)cvtpk(v[j].z, v[j].w) << 32); }
        if (GATES) {
            float a[8];
#pragma unroll
            for (int q = 0; q < 8; ++q) a[q] = 0.f;
#pragma unroll
            for (int j = 0; j < 4; ++j)
#pragma unroll
                for (int e = 0; e < 4; ++e) { const int k = 4 * lane + 256 * j + e; const f32x4 w0 = *(const LAS f32x4*)(wg + k * 8), w1 = *(const LAS f32x4*)(wg + k * 8 + 4); const float x = v[j][e];
                    a[0] += x * w0.x; a[1] += x * w0.y; a[2] += x * w0.z; a[3] += x * w0.w; a[4] += x * w1.x; a[5] += x * w1.y; a[6] += x * w1.z; a[7] += x * w1.w; }
#pragma unroll
            for (int q = 0; q < 8; ++q) a[q] = wave_sum(a[q]);
            if (lane == 0) {
#pragma unroll
                for (int q = 0; q < 8; ++q) gout[(size_t)m * 8 + q] = a[q] + bA[q]; }
        }
    }
}

__device__ __forceinline__ void mlstm_pre(Frame& F, const float* gates, float* GT) {
    LAS float* sA = (LAS float*)F.lds, *sPM = sA + 2048, *sBC = sPM + 2048, *sBT = sBC + 2048, *sP63 = sBT + 32, *sM = sP63 + 32;
    const int lane = F.lane, w = F.wave;
    for (int item = blockIdx.x; item < 64; item += F.G) {
        const int b = item >> 2, h = item & 3;
        __syncthreads();
        float gi4[4], gf4[4];
#pragma unroll
        for (int i = 0; i < 4; ++i) { const size_t row = (size_t)b * SEQ + (w + 8 * i) * 64 + lane; gi4[i] = gates[row * 8 + h]; gf4[i] = gates[row * 8 + 4 + h]; }
#pragma unroll
        for (int i = 0; i < 4; ++i) { const int c = w + 8 * i;
            const float gi = gi4[i], gf = gf4[i];
            const float fc = fminf(gf, 0.f) - log1pf(__expf(-fabsf(gf)));
            float bc = fc;
#pragma unroll
            for (int o = 1; o < 64; o <<= 1) { const float t = __shfl_up(bc, o); if (lane >= o) bc += t; }
            const float a = gi - bc; float pm = a;
#pragma unroll
            for (int o = 1; o < 64; o <<= 1) { const float t = __shfl_up(pm, o); if (lane >= o) pm = fmaxf(pm, t); }
            sA[c * 64 + lane] = a; sPM[c * 64 + lane] = pm; sBC[c * 64 + lane] = bc; if (lane == 63) { sBT[c] = bc; sP63[c] = pm; } }
        __syncthreads();
        if (F.tid == 0) { float m = 0.f; for (int c = 0; c < 32; ++c) { sM[c] = m; m = sBT[c] + fmaxf(m, sP63[c]); } }
        __syncthreads();
#pragma unroll
        for (int i = 0; i < 4; ++i) { const int c = w + 8 * i; const float mst = sM[c], Mx = fmaxf(mst, sPM[c * 64 + lane]), Mx63 = fmaxf(mst, sP63[c]);
            float* g = GT + ((size_t)(item * 32 + c)) * 320 + lane;
            g[0] = sA[c * 64 + lane]; g[64] = Mx; g[128] = __expf(mst - Mx); g[192] = __expf(-(sBC[c * 64 + lane] + Mx)); g[256] = __expf(sA[c * 64 + lane] - Mx63); }
    }
}
__device__ __forceinline__ void mlstm_pmat(Frame& F, const bf16* QKV, const float* GT, bf16* PMA, float* DENP) {
    constexpr float SCALE = 0.08838834764831845f;
    LAS bf16* Qs = (LAS bf16*)F.lds;
    LAS bf16* Ks = Qs + 64 * 136;
    LAS bf16* Ps = Ks + 64 * 136;
    LAS float* fA = (LAS float*)(Ps + 64 * 72), *fMX = fA + 64;
    const int tid = F.tid, lane = F.lane, w = F.wave, fr = lane & 15, fq = lane >> 4, wh = w >> 1, wl = w & 1;
    const unsigned qoff0 = (unsigned)((((tid >> 4) * 2048) + (tid & 15) * 8) * 2);
    v4u pQ[2], pK[2]; float pg = 0.f;
    int item = blockIdx.x;
    if (item < 2048) { const int bh = item >> 5, c = item & 31; const char* gq = (const char*)(QKV + ((size_t)(bh >> 2) * SEQ + c * 64) * 2048 + (bh & 3) * 128);
#pragma unroll
        for (int i = 0; i < 2; ++i) { pQ[i] = *(const v4u*)(gq + qoff0 + i * (32 * 2048 * 2)); pK[i] = *(const v4u*)(gq + qoff0 + i * (32 * 2048 * 2) + 1024); }
        if (tid < 128) pg = GT[(size_t)item * 320 + tid]; }
    for (; item < 2048; item += F.G) {
        __syncthreads();
#pragma unroll
        for (int i = 0; i < 2; ++i) { const int id = tid + NTHR * i, row = id >> 4, c8 = id & 15; *(LAS v4u*)(Qs + row * 136 + c8 * 8) = pQ[i]; *(LAS v4u*)(Ks + row * 136 + c8 * 8) = pK[i]; }
        if (tid < 128) fA[tid] = pg;
        const int nit = item + F.G;
        if (nit < 2048) { const int bh = nit >> 5, c = nit & 31; const char* gq = (const char*)(QKV + ((size_t)(bh >> 2) * SEQ + c * 64) * 2048 + (bh & 3) * 128);
#pragma unroll
            for (int i = 0; i < 2; ++i) { pQ[i] = *(const v4u*)(gq + qoff0 + i * (32 * 2048 * 2)); pK[i] = *(const v4u*)(gq + qoff0 + i * (32 * 2048 * 2) + 1024); }
            if (tid < 128) pg = GT[(size_t)nit * 320 + tid]; }
        __syncthreads();
        f32x4 sa[1][2]; sa[0][0] = (f32x4){0.f, 0.f, 0.f, 0.f}; sa[0][1] = sa[0][0];
        wgemm<1, 2, 128, 136, 136>(sa, Qs + 16 * wh * 136, Ks + 32 * wl * 136, lane);
        float rs[4] = {0.f, 0.f, 0.f, 0.f};
#pragma unroll
        for (int e = 0; e < 4; ++e) { const int t = 16 * wh + 4 * fq + e; const float mx = fMX[t];
#pragma unroll
            for (int j = 0; j < 2; ++j) { const int sidx = 32 * wl + 16 * j + fr; const float wgt = (sidx <= t) ? SCALE * __expf(fA[sidx] - mx) : 0.f; const float p = sa[0][j][e] * wgt;
                Ps[t * 72 + sidx] = (bf16)f2bf(p); rs[e] += p; } }
#pragma unroll
        for (int e = 0; e < 4; ++e) { float r = rs[e]; r += __shfl_xor(r, 1); r += __shfl_xor(r, 2); r += __shfl_xor(r, 4); r += __shfl_xor(r, 8); if (fr == 0) DENP[(size_t)item * 128 + wl * 64 + 16 * wh + 4 * fq + e] = r; }
        __syncthreads();
        *(v4u*)(PMA + (size_t)item * 4096 + (tid >> 3) * 64 + (tid & 7) * 8) = *(const LAS v4u*)(Ps + (tid >> 3) * 72 + (tid & 7) * 8);
    }
}
__device__ __forceinline__ void mlstm_core(Frame& F, const bf16* QKV, const float* GT, const bf16* PMA, const float* DENP, bf16* hout, float* ssq) {
    constexpr float SCALE = 0.08838834764831845f;
    LAS bf16* Qs = (LAS bf16*)F.lds;
    LAS bf16* Ks = Qs + 64 * 136;
    LAS bf16* Vs = Ks + 64 * 144;
    LAS bf16* VWs = Vs + 64 * 80;
    LAS bf16* Cb = VWs + 64 * 80;
    LAS bf16* Ps = Cb + 80 * 136;
    LAS bf16* Hs = Ps + 64 * 72;
    const int tid = F.tid, lane = F.lane, w = F.wave, fr = lane & 15, fq = lane >> 4, wh = w >> 1, wl = w & 1;
    const unsigned qoff0 = (unsigned)((((tid >> 4) * 2048) + (tid & 15) * 8) * 2), voff0 = (unsigned)((((tid >> 3) * 2048) + (tid & 7) * 8) * 2);
    for (int item = blockIdx.x; item < 256; item += F.G) {
        const int b = item >> 4, h = (item >> 2) & 3, vs = item & 3, bh = b * 4 + h;
        f32x4 Cacc[1][4], Cn[1][1];
#pragma unroll
        for (int j = 0; j < 4; ++j) Cacc[0][j] = (f32x4){0.f, 0.f, 0.f, 0.f};
        Cn[0][0] = (f32x4){0.f, 0.f, 0.f, 0.f};
        const size_t tb = (size_t)b * SEQ;
        v4u pQ[2], pK[2], pV, pP; float pws, pwc, pwi[4], pem[4], pdn[4];
#define MLSTM_FETCH(cc) do { const size_t t0_ = tb + (size_t)(cc) * 64; const char* gq_ = (const char*)(QKV + t0_ * 2048 + h * 128); const char* gv_ = (const char*)(QKV + t0_ * 2048 + 1024 + h * 256 + vs * 64); \
            _Pragma("unroll") for (int i = 0; i < 2; ++i) { pQ[i] = *(const v4u*)(gq_ + qoff0 + i * (32 * 2048 * 2)); pK[i] = *(const v4u*)(gq_ + qoff0 + i * (32 * 2048 * 2) + 1024); } \
            pV = *(const v4u*)(gv_ + voff0); const size_t it_ = (size_t)(bh * 32 + (cc)); pP = *(const v4u*)(PMA + it_ * 4096 + (tid >> 3) * 64 + (tid & 7) * 8); \
            const float* g_ = GT + it_ * 320; pws = g_[256 + (tid >> 3)]; pwc = g_[128 + 63]; \
            _Pragma("unroll") for (int e = 0; e < 4; ++e) { const int t_ = 16 * wh + 4 * fq + e; pwi[e] = g_[128 + t_]; pem[e] = g_[192 + t_]; pdn[e] = DENP[it_ * 128 + t_] + DENP[it_ * 128 + 64 + t_]; } } while (0)
        MLSTM_FETCH(0);
        for (int c = 0; c < 32; ++c) {
            const size_t t0 = tb + c * 64;
            __syncthreads();
            v4u hprev; if (c > 0) hprev = *(const LAS v4u*)(Hs + (tid >> 3) * 72 + (tid & 7) * 8);
#pragma unroll
            for (int j = 0; j < 4; ++j)
#pragma unroll
                for (int e = 0; e < 4; ++e) Cb[(16 * wh + 4 * fq + e) * 136 + 64 * wl + 16 * j + fr] = (bf16)f2bf(Cacc[0][j][e]);
#pragma unroll
            for (int e = 0; e < 4; ++e) Cb[(64 + 4 * fq + e) * 136 + 16 * w + fr] = (bf16)f2bf(Cn[0][0][e]);
#pragma unroll
            for (int i = 0; i < 2; ++i) { const int id = tid + NTHR * i, row = id >> 4, c8 = id & 15; *(LAS v4u*)(Qs + row * 136 + c8 * 8) = pQ[i]; *(LAS v4u*)(Ks + row * 144 + c8 * 8) = pK[i]; }
            { const int srow = tid >> 3, c8 = tid & 7; const float wsv = pws;
                *(LAS v4u*)(Vs + srow * 80 + c8 * 8) = pV;
                v4u o; o.x = cvtpk(lo_bf(pV.x) * wsv, hi_bf(pV.x) * wsv); o.y = cvtpk(lo_bf(pV.y) * wsv, hi_bf(pV.y) * wsv); o.z = cvtpk(lo_bf(pV.z) * wsv, hi_bf(pV.z) * wsv); o.w = cvtpk(lo_bf(pV.w) * wsv, hi_bf(pV.w) * wsv);
                *(LAS v4u*)(VWs + srow * 80 + c8 * 8) = o;
                if (c8 < 2) { v4u one; one.x = c8 == 0 ? 0x3f80u : 0u; one.y = 0u; one.z = 0u; one.w = 0u; *(LAS v4u*)(Vs + srow * 80 + 64 + c8 * 8) = one;
                    v4u wv; wv.x = c8 == 0 ? (cvtpk(wsv, 0.f) & 0xffffu) : 0u; wv.y = 0u; wv.z = 0u; wv.w = 0u; *(LAS v4u*)(VWs + srow * 80 + 64 + c8 * 8) = wv; }
                *(LAS v4u*)(Ps + srow * 72 + c8 * 8) = pP; }
            float wi[4], em[4], dn[4]; const float wc = pwc;
#pragma unroll
            for (int e = 0; e < 4; ++e) { wi[e] = pwi[e]; em[e] = pem[e]; dn[e] = pdn[e]; }
            if (c < 31) MLSTM_FETCH(c + 1);
            if (c > 0) *(v4u*)(hout + (t0 - 64 + (tid >> 3)) * 1024 + h * 256 + vs * 64 + (tid & 7) * 8) = hprev;
            __syncthreads();
            f32x4 ni[1][2], nx[1][2], nq[1][1]; ni[0][0] = (f32x4){0.f, 0.f, 0.f, 0.f}; ni[0][1] = ni[0][0]; nx[0][0] = ni[0][0]; nx[0][1] = ni[0][0]; nq[0][0] = ni[0][0];
            wgemm<1, 2, 64, 72, 80, false, true>(ni, Ps + 16 * wh * 72, Vs + 32 * wl, lane);
            wgemm<1, 2, 128, 136, 136>(nx, Qs + 16 * wh * 136, Cb + 32 * wl * 136, lane);
            wgemm<1, 1, 128, 136, 136>(nq, Qs + 16 * wh * 136, Cb + 64 * 136, lane);
#pragma unroll
            for (int e = 0; e < 4; ++e) { const int t = 16 * wh + 4 * fq + e;
                const float nqt = __shfl(nq[0][0][e], lane & 48);
                const float den = dn[e] + wi[e] * SCALE * nqt; const float inv = 1.0f / fmaxf(fabsf(den), em[e]); float q2 = 0.f;
#pragma unroll
                for (int j = 0; j < 2; ++j) { const float hv = (ni[0][j][e] + SCALE * wi[e] * nx[0][j][e]) * inv; q2 += hv * hv;
                    Hs[t * 72 + 32 * wl + 16 * j + fr] = (bf16)f2bf(hv); }
                q2 += __shfl_xor(q2, 1); q2 += __shfl_xor(q2, 2); q2 += __shfl_xor(q2, 4); q2 += __shfl_xor(q2, 8);
                if (fr == 0) ssq[(t0 + t) * 32 + (h * 4 + vs) * 2 + wl] = q2; }
#pragma unroll
            for (int j = 0; j < 4; ++j) Cacc[0][j] = Cacc[0][j] * wc;
            Cn[0][0] = Cn[0][0] * wc;
            wgemm<1, 4, 64, 80, 144, true, true>(Cacc, VWs + 16 * wh, Ks + 64 * wl, lane);
            wgemm<1, 1, 64, 80, 144, true, true>(Cn, VWs + 64, Ks + 16 * w, lane);
        }
        __syncthreads();
        *(v4u*)(hout + (tb + 31 * 64 + (tid >> 3)) * 1024 + h * 256 + vs * 64 + (tid & 7) * 8) = *(const LAS v4u*)(Hs + (tid >> 3) * 72 + (tid & 7) * 8);
#undef MLSTM_FETCH
    }
}

__device__ __forceinline__ void moba_prep(Frame& F, bf16* QK, const int* pos, const float* gq, const float* gk, float* kpart) {
    LAS float* part = (LAS float*)F.lds;
    const int lane = F.lane, w = F.wave, c = lane & 15;
    float gqv[8], gkv[8], inv[8];
#pragma unroll
    for (int e = 0; e < 8; ++e) { gqv[e] = gq[c * 8 + e]; gkv[e] = gk[c * 8 + e]; inv[e] = exp2f(-(float)(8 * (c & 1) + e) * (18.931568569324174f / 16.0f)); }
    for (int item = blockIdx.x; item < 256; item += F.G) {
        const int b = item >> 4, blk = (item >> 1) & 7, half = item & 1;
        const size_t row0 = (size_t)b * SEQ + blk * 256 + half * 128 + 16 * w;
        float kacc[2][8];
#pragma unroll
        for (int i = 0; i < 2; ++i)
#pragma unroll
            for (int e = 0; e < 8; ++e) kacc[i][e] = 0.f;
        v4u cur[4], nxt[4];
#pragma unroll
        for (int i4 = 0; i4 < 4; ++i4) cur[i4] = *(const v4u*)(QK + row0 * 3072 + (lane + 64 * i4) * 8);
        for (int t = 0; t < 16; ++t) {
            const size_t row = row0 + t;
            if (t < 15) {
#pragma unroll
                for (int i4 = 0; i4 < 4; ++i4) nxt[i4] = *(const v4u*)(QK + (row + 1) * 3072 + (lane + 64 * i4) * 8); }
            float cs[8], sn[8];
            if (c < 4) { const float ps = (float)pos[row];
#pragma unroll
                for (int e = 0; e < 8; ++e) sincosf(ps * inv[e], &sn[e], &cs[e]); }
            else {
#pragma unroll
                for (int e = 0; e < 8; ++e) { cs[e] = 1.f; sn[e] = 0.f; } }
#pragma unroll
            for (int i4 = 0; i4 < 4; ++i4) {
                const unsigned xw[4] = {cur[i4].x, cur[i4].y, cur[i4].z, cur[i4].w}; float y[8]; float ss = 0.f;
#pragma unroll
                for (int e = 0; e < 4; ++e) { y[2 * e] = lo_bf(xw[e]); y[2 * e + 1] = hi_bf(xw[e]); ss += y[2 * e] * y[2 * e] + y[2 * e + 1] * y[2 * e + 1]; }
                ss += __shfl_xor(ss, 1); ss += __shfl_xor(ss, 2); ss += __shfl_xor(ss, 4); ss += __shfl_xor(ss, 8);
                const float rstd = 1.0f / sqrtf(ss * (1.0f / 128.0f) + 1e-6f);
#pragma unroll
                for (int e = 0; e < 8; ++e) { y[e] = y[e] * rstd * (i4 < 2 ? gqv[e] : gkv[e]); }
#pragma unroll
                for (int e = 0; e < 8; ++e) { const float o = __shfl_xor(y[e], 2); y[e] = (c < 2) ? y[e] * cs[e] - o * sn[e] : (c < 4 ? y[e] * cs[e] + o * sn[e] : y[e]); }
                v4u ov; ov.x = cvtpk(y[0], y[1]); ov.y = cvtpk(y[2], y[3]); ov.z = cvtpk(y[4], y[5]); ov.w = cvtpk(y[6], y[7]);
                *(v4u*)(QK + row * 3072 + (lane + 64 * i4) * 8) = ov;
                if (i4 >= 2) {
#pragma unroll
                    for (int e = 0; e < 8; ++e) kacc[i4 - 2][e] += y[e]; }
            }
#pragma unroll
            for (int i4 = 0; i4 < 4; ++i4) cur[i4] = nxt[i4];
        }
        __syncthreads();
#pragma unroll
        for (int i = 0; i < 2; ++i)
#pragma unroll
            for (int e = 0; e < 8; ++e) part[w * 1024 + i * 512 + lane * 8 + e] = kacc[i][e];
        __syncthreads();
        for (int col = F.tid; col < 1024; col += NTHR) { float sacc = 0.f;
#pragma unroll
            for (int ww = 0; ww < 8; ++ww) sacc += part[ww * 1024 + col];
            kpart[((size_t)(b * 8 + blk) * 2 + half) * 1024 + col] = sacc * (1.0f / 256.0f); }
    }
}
__device__ __forceinline__ void moba_attn(Frame& F, const bf16* QKV, const float* kpart, bf16* O) {
    char* ldsg = (char*)F.lds;
    LAS float* kmS = (LAS float*)(F.lds + mattn::SHM_ATTN);
    for (int it = blockIdx.x; it < 1024; it += F.G) {
        int tid_ = threadIdx.x; asm volatile("" : "+v"(tid_));
        const int tid = tid_, lane = tid & 63, w = __builtin_amdgcn_readfirstlane(tid >> 6), r32 = lane & 31, hi = lane >> 5;
        const int c = it & 255, r = it >> 8, bh = c & 127, typ = c >> 7, b = bh >> 3, h = bh & 7;
        const int jb = (r & 1) ? 7 - (r >> 1) : (r >> 1);
        const int j = typ ? ((r & 1) ? jb - 2 : jb + 2) : jb;
        const size_t qrow0 = (size_t)b * SEQ + j * 256;
        __syncthreads();
        for (int i = tid; i < 1024; i += NTHR) { const int kb_ = i >> 7, d_ = i & 127; const float* kp = kpart + ((size_t)(b * 8 + kb_) * 2) * 1024 + h * 128 + d_; kmS[i] = kp[0] + kp[1024]; }
        mattn::bf16x8 qr[8];
        { const bf16* Qw = QKV + (qrow0 + w * 32 + r32) * 3072 + h * 128 + hi * 8;
#pragma unroll
            for (int d0 = 0; d0 < 8; ++d0) qr[d0] = *(const mattn::bf16x8*)(Qw + d0 * 16); }
        __syncthreads();
        unsigned sel = 0u;
        if (j <= 3) sel = (1u << j) - 1u;
        else { float v0 = -INFINITY, v1 = -INFINITY, v2 = -INFINITY; int i0 = 0, i1 = 0, i2 = 0;
#pragma unroll 1
            for (int blk = 0; blk < j; ++blk) { float sdot = 0.f; const LAS float* km = kmS + blk * 128 + hi * 8;
#pragma unroll
                for (int d0 = 0; d0 < 8; ++d0) asm volatile("" : "+v"(qr[d0]));
#pragma unroll
                for (int d0 = 0; d0 < 8; ++d0) {
#pragma unroll
                    for (int e = 0; e < 8; ++e) sdot += __uint_as_float(((unsigned)(unsigned short)qr[d0][e]) << 16) * km[d0 * 16 + e];
                    __builtin_amdgcn_sched_barrier(0); }
                auto rr = __builtin_amdgcn_permlane32_swap(__float_as_uint(sdot), __float_as_uint(sdot), false, false);
                sdot = __uint_as_float(rr[0]) + __uint_as_float(rr[1]);
                if (sdot > v0) { v2 = v1; i2 = i1; v1 = v0; i1 = i0; v0 = sdot; i0 = blk; }
                else if (sdot > v1) { v2 = v1; i2 = i1; v1 = sdot; i1 = blk; }
                else if (sdot > v2) { v2 = sdot; i2 = blk; } }
            sel = (1u << i0) | (1u << i1) | (1u << i2); }
        const mattn::Msk mk{j, sel, w * 32 + r32};
        const bf16* Kh = QKV + ((size_t)b * SEQ) * 3072 + 1024 + h * 128;
        mattn::body(qr, Kh, Kh + 1024, O + qrow0 * 1024 + h * 128, (j + 1) * 256, ldsg, mk);
    }
}

__device__ __forceinline__ void ret_rot_table(Frame& F, const int* pos, float* cst) {
    const int gw = blockIdx.x * NWAVES + F.wave, NGW = F.G * NWAVES, lane = F.lane;
    const float i0 = exp2f(-(float)(2 * lane) * (13.287712379549449f / 128.0f)), i1 = exp2f(-(float)(2 * lane + 1) * (13.287712379549449f / 128.0f));
    for (int m = gw; m < MTOK; m += NGW) {
        const float ps = (float)pos[m]; float s0, c0, s1, c1; sincosf(ps * i0, &s0, &c0); sincosf(ps * i1, &s1, &c1);
        f32x2* cp = (f32x2*)(cst + (size_t)m * 256) + lane; cp[0] = (f32x2){c0, c1}; cp[64] = (f32x2){s0, s1};
    }
}
__device__ __forceinline__ void ret_pmat(Frame& F, const bf16* QKV, bf16* PM) {
    LAS bf16* Qd = (LAS bf16*)F.lds;
    LAS bf16* Kd = Qd + 128 * 72;
    LAS bf16* Ps = Kd + 128 * 72;
    const int tid = F.tid, lane = F.lane, w = F.wave, fr = lane & 15, fq = lane >> 4, wh = w >> 1, wl = w & 1;
    const unsigned off0 = (unsigned)((((tid >> 3) * 4096) + (tid & 7) * 8) * 2);
    for (int item = blockIdx.x; item < 1024; item += F.G) {
        const int b = item >> 6, h = (item >> 4) & 3, c = item & 15;
        const float lgc = log1pf(-exp2f(-5.0f - (float)h)) * 1.4426950408889634f;
        const char* gq = (const char*)(QKV + ((size_t)b * SEQ + c * 128) * 4096 + h * 256);
        v4u pq[2], pkk[2];
#pragma unroll
        for (int i = 0; i < 2; ++i) { const char* src = gq + off0 + i * (64 * 4096 * 2); pq[i] = *(const v4u*)src; pkk[i] = *(const v4u*)(src + 2048); }
        f32x4 S[2][4];
#pragma unroll
        for (int i = 0; i < 2; ++i)
#pragma unroll
            for (int jj = 0; jj < 4; ++jj) S[i][jj] = (f32x4){0.f, 0.f, 0.f, 0.f};
#pragma unroll 1
        for (int dt = 0; dt < 4; ++dt) {
            __syncthreads();
#pragma unroll
            for (int i = 0; i < 2; ++i) { const int id = tid + NTHR * i, row = id >> 3, c8 = id & 7; *(LAS v4u*)(Qd + row * 72 + c8 * 8) = pq[i]; *(LAS v4u*)(Kd + row * 72 + c8 * 8) = pkk[i]; }
            if (dt < 3) {
#pragma unroll
                for (int i = 0; i < 2; ++i) { const char* src = gq + (dt + 1) * 128 + off0 + i * (64 * 4096 * 2); pq[i] = *(const v4u*)src; pkk[i] = *(const v4u*)(src + 2048); } }
            __syncthreads();
            wgemm<2, 4, 64, 72, 72>(S, Qd + 32 * wh * 72, Kd + 64 * wl * 72, lane);
        }
#pragma unroll
        for (int i = 0; i < 2; ++i)
#pragma unroll
            for (int e = 0; e < 4; ++e) { const int t = 32 * wh + 16 * i + 4 * fq + e;
#pragma unroll
                for (int jj = 0; jj < 4; ++jj) { const int sidx = 64 * wl + 16 * jj + fr; const float wgt = (t >= sidx) ? __builtin_amdgcn_exp2f((float)(t - sidx) * lgc) : 0.f;
                    Ps[t * 136 + sidx] = (bf16)f2bf(S[i][jj][e] * wgt); } }
        __syncthreads();
        bf16* dst = PM + (size_t)item * 128 * 128;
#pragma unroll
        for (int i = 0; i < 4; ++i) { const int id = tid + NTHR * i, row = id >> 4, c8 = id & 15; *(v4u*)(dst + row * 128 + c8 * 8) = *(const LAS v4u*)(Ps + row * 136 + c8 * 8); }
    }
}
#ifndef RET_EXP
#define RET_EXP 0
#endif
__device__ __forceinline__ void ret_core(Frame& F, bf16* QKV, const bf16* PM, float* st) {
    constexpr int TSET = 3 * 128 * 72;
    LAS bf16* T0 = (LAS bf16*)F.lds;
    LAS bf16* Vs = T0 + 2 * TSET;
    LAS bf16* Ps = T0;
    LAS bf16* Xs = T0 + TSET;
    LAS float* fST = (LAS float*)(Vs + 128 * 144);
    const int tid = F.tid, lane = F.lane, w = F.wave, fr = lane & 15, fq = lane >> 4, wh = w >> 1, wl = w & 1;
    const unsigned off8 = (unsigned)((((tid >> 3) * 4096) + (tid & 7) * 8) * 2);
    const unsigned off16 = (unsigned)((((tid >> 4) * 4096) + (tid & 15) * 8) * 2);
    for (int item = blockIdx.x; item < 256; item += F.G) {
        const int b = item >> 4, h = (item >> 2) & 3, vs = item & 3;
        const float lg = log1pf(-exp2f(-5.0f - (float)h)), gch = expf(128.0f * lg);
        f32x4 Racc[4][1][4];
#pragma unroll
        for (int dt = 0; dt < 4; ++dt)
#pragma unroll
            for (int jj = 0; jj < 4; ++jj) Racc[dt][0][jj] = (f32x4){0.f, 0.f, 0.f, 0.f};
        const size_t tb = (size_t)b * SEQ;
        __syncthreads();
        v4u pq[2], pkk[2], pv[4];
        { const char* gq0 = (const char*)(QKV + tb * 4096 + h * 256); const char* gv0 = (const char*)(QKV + tb * 4096 + 2048 + h * 512 + vs * 128);
#pragma unroll
            for (int i = 0; i < 2; ++i) { const char* src = gq0 + off8 + i * (64 * 4096 * 2); pq[i] = *(const v4u*)src; pkk[i] = *(const v4u*)(src + 2048); }
#pragma unroll
            for (int i = 0; i < 4; ++i) pv[i] = *(const v4u*)(gv0 + off16 + i * (32 * 4096 * 2)); }
        for (int c = 0; c < 16; ++c) {
            const size_t t0 = tb + c * 128;
            const char* gq = (const char*)(QKV + t0 * 4096 + h * 256);
            char* gy = (char*)(QKV + t0 * 4096 + 2048 + h * 512 + vs * 128);
            const bf16* pmt = PM + ((size_t)((b * 4 + h) * 16 + c)) * 128 * 128;
            float lgc = lg * 1.4426950408889634f; asm volatile("" : "+v"(lgc));
#pragma unroll
            for (int i = 0; i < 4; ++i) { const int id = tid + NTHR * i; *(LAS v4u*)(Vs + (id >> 4) * 144 + (id & 15) * 8) = pv[i]; }
            f32x4 X[2][4];
#pragma unroll
            for (int i = 0; i < 2; ++i)
#pragma unroll
                for (int jj = 0; jj < 4; ++jj) X[i][jj] = (f32x4){0.f, 0.f, 0.f, 0.f};
#pragma unroll 1
            for (int dt = 0; dt < 4; ++dt) {
                LAS bf16* Qd = T0 + (dt & 1) * TSET; LAS bf16* Kz = Qd + 128 * 72; LAS bf16* Rb = Kz + 128 * 72;
#pragma unroll
                for (int i = 0; i < 2; ++i) { const int id = tid + NTHR * i, row = id >> 3, c8 = id & 7; const float z = __builtin_amdgcn_exp2f((float)(127 - row) * lgc);
                    *(LAS v4u*)(Qd + row * 72 + c8 * 8) = pq[i];
                    v4u zo; zo.x = cvtpk(lo_bf(pkk[i].x) * z, hi_bf(pkk[i].x) * z); zo.y = cvtpk(lo_bf(pkk[i].y) * z, hi_bf(pkk[i].y) * z); zo.z = cvtpk(lo_bf(pkk[i].z) * z, hi_bf(pkk[i].z) * z); zo.w = cvtpk(lo_bf(pkk[i].w) * z, hi_bf(pkk[i].w) * z);
                    *(LAS v4u*)(Kz + row * 72 + c8 * 8) = zo; }
#pragma unroll
                for (int jj = 0; jj < 4; ++jj)
#pragma unroll
                    for (int e = 0; e < 4; ++e) Rb[(16 * w + 4 * fq + e) * 72 + 16 * jj + fr] = (bf16)f2bf(Racc[0][0][jj][e]);
#if RET_EXP == 3
                asm volatile("" ::: "memory");
#pragma unroll
                for (int jj = 0; jj < 4; ++jj)
#pragma unroll
                    for (int e = 0; e < 4; ++e) *(volatile LAS bf16*)(Rb + (16 * w + 4 * fq + e) * 72 + 16 * jj + fr) = (bf16)f2bf(Racc[0][0][jj][e]);
#endif
                if (dt < 3 || c < 15) {
                    const char* nb = (dt < 3) ? gq + (dt + 1) * 128 : gq + (size_t)128 * 4096 * 2;
#pragma unroll
                    for (int i = 0; i < 2; ++i) { const char* src = nb + off8 + i * (64 * 4096 * 2); pq[i] = *(const v4u*)src; pkk[i] = *(const v4u*)(src + 2048); } }
                __syncthreads();
                wgemm<2, 4, 64, 72, 72, false, false, false>(X, Qd + 32 * wh * 72, Rb + 64 * wl * 72, lane);
#if RET_EXP == 5
                { f32x4 D_[2][4];
#pragma unroll
                  for (int i = 0; i < 2; ++i)
#pragma unroll
                    for (int jj = 0; jj < 4; ++jj) D_[i][jj] = (f32x4){0.f, 0.f, 0.f, 0.f};
                  wgemm<2, 4, 64, 72, 72>(D_, Qd + 32 * wh * 72, Rb + 64 * wl * 72, lane);
#pragma unroll
                  for (int i = 0; i < 2; ++i)
#pragma unroll
                    for (int jj = 0; jj < 4; ++jj) asm volatile("" :: "v"(D_[i][jj])); }
#endif
#if RET_EXP == 6
                { f32x4 D_[1][4];
#pragma unroll
                    for (int jj = 0; jj < 4; ++jj) D_[0][jj] = (f32x4){0.f, 0.f, 0.f, 0.f};
                  wgemm<1, 4, 128, 136, 72, true, true>(D_, Vs + 16 * w, Kz, lane);
#pragma unroll
                    for (int jj = 0; jj < 4; ++jj) asm volatile("" :: "v"(D_[0][jj])); }
#endif
#pragma unroll
                for (int jj = 0; jj < 4; ++jj) Racc[0][0][jj] = Racc[0][0][jj] * gch;
                wgemm<1, 4, 128, 144, 72, true, true, false>(Racc[0], Vs + 16 * w, Kz, lane);
#pragma unroll
                for (int jj = 0; jj < 4; ++jj) { const f32x4 t_ = Racc[0][0][jj]; Racc[0][0][jj] = Racc[1][0][jj]; Racc[1][0][jj] = Racc[2][0][jj]; Racc[2][0][jj] = Racc[3][0][jj]; Racc[3][0][jj] = t_; }
            }
            v4u pp[4];
#pragma unroll
            for (int i = 0; i < 4; ++i) { const int id = tid + NTHR * i; pp[i] = *(const v4u*)(pmt + (id >> 4) * 128 + (id & 15) * 8); }
#if RET_EXP == 2
            asm volatile("s_waitcnt vmcnt(0)" ::: "memory");
#pragma unroll
            for (int i = 0; i < 4; ++i) { const int id = tid + NTHR * i; v4u q_ = *(const volatile v4u*)(pmt + 64 * 128 * 128 + (id >> 4) * 128 + (id & 15) * 8); asm volatile("" :: "v"(q_.x), "v"(q_.y), "v"(q_.z), "v"(q_.w)); }
            asm volatile("s_waitcnt vmcnt(0)" ::: "memory");
#endif
#pragma unroll
            for (int i = 0; i < 2; ++i)
#pragma unroll
                for (int e = 0; e < 4; ++e) { const int t = 32 * wh + 16 * i + 4 * fq + e; const float xi = __builtin_amdgcn_exp2f((float)(t + 1) * lgc);
#pragma unroll
                    for (int jj = 0; jj < 4; ++jj) X[i][jj][e] *= xi; }
#pragma unroll
            for (int i = 0; i < 4; ++i) { const int id = tid + NTHR * i; *(LAS v4u*)(Ps + (id >> 4) * 136 + (id & 15) * 8) = pp[i]; }
            __syncthreads();
            wgemm<2, 4, 128, 136, 144, false, true, false>(X, Ps + 32 * wh * 136, Vs + 64 * wl, lane);
#pragma unroll
            for (int i = 0; i < 2; ++i)
#pragma unroll
                for (int e = 0; e < 4; ++e) { const int t = 32 * wh + 16 * i + 4 * fq + e; float s1 = 0.f, s2 = 0.f;
#pragma unroll
                    for (int jj = 0; jj < 4; ++jj) { const float y = X[i][jj][e]; s1 += y; s2 += y * y; Xs[t * 136 + 64 * wl + 16 * jj + fr] = (bf16)f2bf(y); }
                    s1 += __shfl_xor(s1, 1); s1 += __shfl_xor(s1, 2); s1 += __shfl_xor(s1, 4); s1 += __shfl_xor(s1, 8);
                    s2 += __shfl_xor(s2, 1); s2 += __shfl_xor(s2, 2); s2 += __shfl_xor(s2, 4); s2 += __shfl_xor(s2, 8);
                    if (fr == 0) { fST[(wl * 128 + t) * 2] = s1; fST[(wl * 128 + t) * 2 + 1] = s2; } }
            if (c < 15) { const char* gvn = gy + (size_t)128 * 4096 * 2;
#pragma unroll
                for (int i = 0; i < 4; ++i) pv[i] = *(const v4u*)(gvn + off16 + i * (32 * 4096 * 2)); }
            __syncthreads();
#pragma unroll
            for (int i = 0; i < 4; ++i) { const int id = tid + NTHR * i, row = id >> 4, c8 = id & 15; *(v4u*)(gy + (unsigned)((row * 4096 + c8 * 8) * 2)) = *(const LAS v4u*)(Xs + row * 136 + c8 * 8); }
            if (tid < 128) { float* sp = st + (t0 + tid) * 32 + (h * 4 + vs) * 2; sp[0] = fST[tid * 2] + fST[(128 + tid) * 2]; sp[1] = fST[tid * 2 + 1] + fST[(128 + tid) * 2 + 1]; }
        }
    }
}

__device__ __forceinline__ void lru_conv(Frame& F, const bf16* GX, const float* cw, const float* cb, bf16* XC, const float* lru, float* sptab) {
    if (blockIdx.x == 0) for (int i = F.tid; i < 1024; i += NTHR) { const float l = -lru[i]; sptab[i] = fmaxf(l, 0.f) + log1pf(expf(-fabsf(l))); }
    const int c8 = F.tid & 127, rsub = F.tid >> 7;
    f32x4 w0[4], w1[4];
#pragma unroll
    for (int wv = 0; wv < 4; ++wv) { w0[wv] = *(const f32x4*)(cw + wv * 1024 + c8 * 8); w1[wv] = *(const f32x4*)(cw + wv * 1024 + c8 * 8 + 4); }
    const f32x4 b0 = *(const f32x4*)(cb + c8 * 8), b1 = *(const f32x4*)(cb + c8 * 8 + 4);
    for (int r0 = blockIdx.x * 16; r0 < MTOK; r0 += F.G * 16) {
        const int rb = r0 + 4 * rsub, t = rb & (SEQ - 1);
        v4u xin[7];
#pragma unroll
        for (int k = 0; k < 7; ++k) { const int rr = rb - 3 + k; xin[k] = (t - 3 + k >= 0) ? *(const v4u*)(GX + (size_t)rr * 2048 + 1024 + c8 * 8) : (v4u){0u, 0u, 0u, 0u}; }
#pragma unroll
        for (int q = 0; q < 4; ++q) { f32x4 a0 = b0, a1 = b1;
#pragma unroll
            for (int wv = 0; wv < 4; ++wv) { const v4u x = xin[q + wv];
                a0 += (f32x4){lo_bf(x.x), hi_bf(x.x), lo_bf(x.y), hi_bf(x.y)} * w0[wv]; a1 += (f32x4){lo_bf(x.z), hi_bf(x.z), lo_bf(x.w), hi_bf(x.w)} * w1[wv]; }
            v4u o; o.x = cvtpk(a0[0], a0[1]); o.y = cvtpk(a0[2], a0[3]); o.z = cvtpk(a1[0], a1[1]); o.w = cvtpk(a1[2], a1[3]);
            *(v4u*)(XC + (size_t)(rb + q) * 1024 + c8 * 8) = o; }
    }
}
__device__ __forceinline__ float gelu_tanh(float x) { const float z = 0.7978845608028654f * (x + 0.044715f * x * x * x); const float e = __expf(2.0f * z); const float th = 1.0f - 2.0f * __builtin_amdgcn_rcpf(e + 1.0f); return 0.5f * x * (1.0f + th); }
__device__ __forceinline__ void lru_scan(Frame& F, const bf16* LA, const bf16* BT, const bf16* GX, bf16* Y) {
    LAS float* segL = (LAS float*)F.lds;
    LAS float* segH = segL + 512;
    const int lane = F.lane, w = F.wave;
    for (int item = blockIdx.x; item < 256; item += F.G) {
        const int b = item >> 4, ch = (item & 15) * 64 + lane;
        const size_t r0 = (size_t)b * SEQ + w * 256;
        const bf16* la_p = LA + r0 * 1024 + ch; const bf16* bt_p = BT + r0 * 1024 + ch; const bf16* gx_p = GX + r0 * 2048 + ch; bf16* y_p = Y + r0 * 1024 + ch;
        float L = 0.f, H = 0.f;
        bf16 la0[16], bt0[16], la1[16], bt1[16];
#pragma unroll
        for (int k = 0; k < 16; ++k) { la0[k] = la_p[(size_t)k * 1024]; bt0[k] = bt_p[(size_t)k * 1024]; }
#pragma unroll 1
        for (int tb = 0; tb < 16; tb += 2) {
#pragma unroll
            for (int k = 0; k < 16; ++k) { la1[k] = la_p[(size_t)((tb + 1) * 16 + k) * 1024]; bt1[k] = bt_p[(size_t)((tb + 1) * 16 + k) * 1024]; }
#pragma unroll
            for (int k = 0; k < 16; ++k) { const float la = bf2f(la0[k]); L += la; H = __expf(la) * H + bf2f(bt0[k]); }
            if (tb + 2 < 16) {
#pragma unroll
                for (int k = 0; k < 16; ++k) { la0[k] = la_p[(size_t)((tb + 2) * 16 + k) * 1024]; bt0[k] = bt_p[(size_t)((tb + 2) * 16 + k) * 1024]; } }
#pragma unroll
            for (int k = 0; k < 16; ++k) { const float la = bf2f(la1[k]); L += la; H = __expf(la) * H + bf2f(bt1[k]); }
        }
        __syncthreads();
        segL[w * 64 + lane] = L; segH[w * 64 + lane] = H;
        __syncthreads();
        float hc = 0.f;
        for (int sg = 0; sg < w; ++sg) hc = __expf(segL[sg * 64 + lane]) * hc + segH[sg * 64 + lane];
        bf16 g0[16], g1[16];
#pragma unroll
        for (int k = 0; k < 16; ++k) { la0[k] = la_p[(size_t)k * 1024]; bt0[k] = bt_p[(size_t)k * 1024]; g0[k] = gx_p[(size_t)k * 2048]; }
#pragma unroll
        for (int k = 0; k < 16; ++k) { const size_t t = (size_t)(16 + k); la1[k] = la_p[t * 1024]; bt1[k] = bt_p[t * 1024]; g1[k] = gx_p[t * 2048]; }
#pragma unroll 1
        for (int tb = 0; tb < 16; tb += 2) {
            bf16 yv[16];
#pragma unroll
            for (int k = 0; k < 16; ++k) { hc = __expf(bf2f(la0[k])) * hc + bf2f(bt0[k]); yv[k] = (bf16)f2bf(hc * gelu_tanh(bf2f(g0[k]))); }
            if (tb + 2 < 16) {
#pragma unroll
                for (int k = 0; k < 16; ++k) { const size_t t = (size_t)((tb + 2) * 16 + k); la0[k] = la_p[t * 1024]; bt0[k] = bt_p[t * 1024]; g0[k] = gx_p[t * 2048]; } }
#pragma unroll
            for (int k = 0; k < 16; ++k) y_p[(size_t)(tb * 16 + k) * 1024] = yv[k];
#pragma unroll
            for (int k = 0; k < 16; ++k) { hc = __expf(bf2f(la1[k])) * hc + bf2f(bt1[k]); yv[k] = (bf16)f2bf(hc * gelu_tanh(bf2f(g1[k]))); }
            if (tb + 3 < 16) {
#pragma unroll
                for (int k = 0; k < 16; ++k) { const size_t t = (size_t)((tb + 3) * 16 + k); la1[k] = la_p[t * 1024]; bt1[k] = bt_p[t * 1024]; g1[k] = gx_p[t * 2048]; } }
#pragma unroll
            for (int k = 0; k < 16; ++k) y_p[(size_t)((tb + 1) * 16 + k) * 1024] = yv[k];
        }
    }
}

#ifndef WGM_BIG
#define WGM_BIG 8
#endif
#ifndef WGM_N4
#define WGM_N4 4
#endif
#ifndef WGM_MID
#define WGM_MID 8
#endif
template <class Epi>
__device__ __forceinline__ void run_gemm(Frame& F, const bf16* A, int lda, const bf16* Bt, int ldb, int N, int K, const Epi& E, int M = MTOK, int ablk = 0) {
    pg8::Gemm g{A, Bt, M, N, K, lda, ldb, ablk}; pg8::StaticOrder S; S.init(M, N, F.G, (int)blockIdx.x, (N >= 4096) ? WGM_BIG : (N <= 1024 ? WGM_N4 : WGM_MID));
#ifndef STAGGER_NG
#define STAGGER_NG 1
#endif
#ifndef STAGGER_STEP
#define STAGGER_STEP 300
#endif
    if (STAGGER_NG > 1 && N >= 4096 && M == MTOK) {
        const unsigned grp = (((unsigned)blockIdx.x >> 3) & 7u) / (8 / STAGGER_NG);
        if (grp) { const unsigned long long t0 = __builtin_amdgcn_s_memrealtime(), dl = (unsigned long long)grp * STAGGER_STEP;
            while (__builtin_amdgcn_s_memrealtime() - t0 < dl) __builtin_amdgcn_s_sleep(8); }
    }
#ifndef FUSE_NX
#define FUSE_NX false
#endif
#ifndef GEMM_ALIGN
#define GEMM_ALIGN true
#endif
#ifndef GEMM_SP2
#define GEMM_SP2 true
#endif
    pg8::gemm_phase<Epi, pg8::StaticOrder, GEMM_ALIGN, GEMM_SP2>(F.lds, g, S, E);
}

typedef const __attribute__((address_space(4))) struct Args* ArgsP;
constexpr int NPHASE = 35;
__device__ __forceinline__ ArgsP get_args() { ArgsP p = (ArgsP)__builtin_amdgcn_kernarg_segment_ptr(); asm volatile("" : "+s"(p)); return p; }
__device__ __forceinline__ bool in_phase(int k) { ArgsP a = get_args(); return a->ph_lo <= k && k < a->ph_hi; }
#ifndef DUP_PHASE
#define DUP_PHASE -1
#endif
#ifndef BAR_EXP
#define BAR_EXP 0
#endif
#ifndef TIMING_MASK
#define TIMING_MASK 0ull
#endif
#define TMISC ((volatile LAS unsigned long long*)((LAS unsigned char*)lds_raw + MISC_OFF))
#define TB(k) do { if (((TIMING_MASK >> (k)) & 1ull) && blockIdx.x == 0 && threadIdx.x == 0) TMISC[0] = __builtin_amdgcn_s_memrealtime(); } while (0)
#define TE(k) do { if (((TIMING_MASK >> (k)) & 1ull) && blockIdx.x == 0 && threadIdx.x == 0) TMISC[1] = TMISC[1] + (__builtin_amdgcn_s_memrealtime() - TMISC[0]); } while (0)
#define REP(k) TB(k); for (int rep_ = 0; rep_ < ((k) == DUP_PHASE ? 2 : 1); ++rep_)
#define AP ArgsP ap = get_args(); { int t_ = threadIdx.x; asm volatile("" : "+v"(t_)); F.tid = t_; F.lane = t_ & 63; F.wave = __builtin_amdgcn_readfirstlane(t_ >> 6); F.G = gridDim.x; F.lds = (LAS unsigned char*)lds_raw; }
__global__ void __launch_bounds__(NTHR, 2) trunk_fwd(Args args) {
    extern __shared__ __attribute__((aligned(16))) unsigned char lds_raw[];
    Frame F; F.lds = (LAS unsigned char*)lds_raw; F.tid = threadIdx.x; F.lane = F.tid & 63; F.wave = __builtin_amdgcn_readfirstlane(F.tid >> 6); F.G = gridDim.x;
    volatile LAS unsigned* MISC = (volatile LAS unsigned*)(F.lds + MISC_OFF);
    if (F.tid < 16) MISC[F.tid] = 0u;
    __syncthreads();
    if (args.ph_hi - args.ph_lo > 1) (void)xcd_barrier_post((unsigned*)(args.ws + WS_CTL) + CW_BAR, MISC + 8);
#ifndef ONLY_PHASE
#define ONLY_PHASE -1
#endif
#define IN(k) ((ONLY_PHASE < 0 || (k) == ONLY_PHASE) && in_phase(k))
#define SEAM(k) do { if (IN(k) && IN((k) + 1)) { XcdBarrier bb; bb.bar = (unsigned*)(get_args()->ws + WS_CTL) + CW_BAR; bb.x = xb_xcc_id(); bb.st = (volatile LAS unsigned*)((LAS unsigned char*)lds_raw + MISC_OFF) + 8; xcd_barrier(bb); if (BAR_EXP) xcd_barrier(bb); } if (IN(k)) TE(k); } while (0)
#define XIN ((const float*)ap->in[0])
#define pos ((const int*)ap->in[1])
#define norm_mix ((const float*)ap->in[2])
#define norm_ffn ((const float*)ap->in[3])
#define ffn_w_in ((const float*)ap->in[4])
#define ffn_w_out ((const float*)ap->in[5])
#define out (ap->out)
#define Wmi ((bf16*)(ap->ws + WS_W_MIXIN))
#define Wmo ((bf16*)(ap->ws + WS_W_MIXOUT))
#define Wfi ((bf16*)(ap->ws + WS_W_FFNIN))
#define Wfo ((bf16*)(ap->ws + WS_W_FFNOUT))
#define U ((bf16*)(ap->ws + WS_U))
#define BIG ((bf16*)(ap->ws + WS_BIG))
#define gatesA ((float*)(ap->ws + WS_GATESA))
#define ssqA ((float*)(ap->ws + WS_SSQA))
#define statC ((float*)(ap->ws + WS_STATC))
#define kmean ((float*)(ap->ws + WS_KMEAN))
#define sptab ((float*)(ap->ws + WS_SPTAB))
#define ssqH ((float*)(ap->ws + WS_SSQH))

#define a_w_in ((const float*)ap->in[6])
#define a_b ((const float*)ap->in[7])
#define a_g ((const float*)ap->in[8])
#define a_w_out ((const float*)ap->in[9])
#define b_w_in ((const float*)ap->in[10])
#define b_gq ((const float*)ap->in[11])
#define b_gk ((const float*)ap->in[12])
#define b_w_out ((const float*)ap->in[13])
#define c_w_in ((const float*)ap->in[14])
#define c_g ((const float*)ap->in[15])
#define c_w_out ((const float*)ap->in[16])
#define d_w_in ((const float*)ap->in[17])
#define d_cw ((const float*)ap->in[18])
#define d_cb ((const float*)ap->in[19])
#define d_wg ((const float*)ap->in[20])
#define d_bg ((const float*)ap->in[21])
#define d_lru ((const float*)ap->in[22])
#define d_w_out ((const float*)ap->in[23])
#define GX BIG
#define XC (BIG + (size_t)MTOK * 2048)
#define LA (BIG + (size_t)MTOK * 3072)
#define BT (BIG + (size_t)MTOK * 4096)
#define Y (BIG + (size_t)MTOK * 3072)
#define HB (BIG + (size_t)MTOK * 5120)
#define Wg (Wmi + (size_t)2048 * DM)
#define FFN_CVT(l) do { cvt_matrix(F, ffn_w_in + (size_t)(l) * DM * 2 * DFF, 2 * DFF, DM, 2 * DFF, 1, Wfi, norm_ffn + (l) * DM); cvt_matrix(F, ffn_w_out + (size_t)(l) * DFF * DM, DM, DFF, DM, 0, Wfo); } while (0)
#define RED ((PG8_LAS float*)(F.lds + 131072))
#define FFN_PHASES(p0, l) do { \
    if (IN((p0) + 1)) { AP; REP((p0) + 1) { pg8::EpiSwiGLU<true> E{BIG, DFF, ssqH}; run_gemm(F, HB, DM, Wfi, DM, 2 * DFF, DM, E); } } SEAM((p0) + 1); \
    if (IN((p0) + 2)) { AP; REP((p0) + 2) { if ((l) < 3) { pg8::EpiResidB<true, true> E{HB, HB, ssqH, RED}; run_gemm(F, BIG, DFF, Wfo, DFF, DM, DFF, E); } else { pg8::EpiResidF E{HB, out}; run_gemm(F, BIG, DFF, Wfo, DFF, DM, DFF, E); } } } SEAM((p0) + 2); } while (0)
#define QKV BIG
#define HO (BIG + (size_t)MTOK * 2048)
#define PMAB (BIG + (size_t)MTOK * 3072)
#define GTB ((float*)(BIG + (size_t)MTOK * 3584))
#define DENB ((float*)(BIG + (size_t)MTOK * 3584) + 2048 * 320)
    if (IN(0)) { AP; REP(0) { cvt_matrix(F, a_w_in, 3080, DM, 3072, 0, Wmi); cvt_matrix(F, a_w_out, DM, DM, DM, 0, Wmo); FFN_CVT(0);
        __syncthreads(); norm_phase<true>(F, XIN, norm_mix, U, a_w_in, a_b, gatesA); } } SEAM(0);
    if (IN(1)) { AP; REP(1) { mlstm_pre(F, gatesA, GTB); __syncthreads(); pg8::EpiStore<false> E{QKV, 2048, nullptr}; run_gemm(F, U, DM, Wmi, DM, 2048, DM, E); } } SEAM(1);
    if (IN(2)) { AP; REP(2) { mlstm_pmat(F, QKV, GTB, PMAB, DENB); } } SEAM(2);
    if (IN(3)) { AP; REP(3) { mlstm_core(F, QKV, GTB, PMAB, DENB, HO, ssqA); } } SEAM(3);
    if (IN(4)) { AP; REP(4) { pg8::EpiGateA E{HO, ssqA, a_g}; run_gemm(F, U, DM, Wmi + (size_t)2048 * DM, DM, DM, DM, E); } } SEAM(4);
    if (IN(5)) { AP; REP(5) { pg8::EpiResidB<false, true> E{XIN, HB, ssqH, RED}; run_gemm(F, HO, DM, Wmo, DM, DM, DM, E); } } SEAM(5);
    FFN_PHASES(6, 0);
#define OB (BIG + (size_t)MTOK * 3072)
#define VTB (BIG + (size_t)MTOK * 2048)
    if (IN(9)) { AP; REP(9) { cvt_matrix(F, b_w_in, 3072, DM, 3072, 0, Wmi, norm_mix + DM); cvt_matrix(F, b_w_out, DM, DM, DM, 0, Wmo); FFN_CVT(1); } } SEAM(9);
    if (IN(10)) { AP; REP(10) { pg8::EpiStore<true> E{QKV, 3072, ssqH}; run_gemm(F, HB, DM, Wmi, DM, 3072, DM, E); } } SEAM(10);
    if (IN(11)) { AP; REP(11) { moba_prep(F, QKV, pos, b_gq, b_gk, kmean); } } SEAM(11);
    if (IN(12)) { AP; REP(12) { moba_attn(F, QKV, kmean, OB); } } SEAM(12);
    if (IN(13)) { AP; REP(13) { pg8::EpiResidB<true, true> E{HB, HB, ssqH, RED}; run_gemm(F, OB, DM, Wmo, DM, DM, DM, E); } } SEAM(13);
    FFN_PHASES(14, 1);
#define YS (BIG + 2048)
#define PMB (BIG + (size_t)MTOK * 4096)
#define CSTB ((float*)(BIG + (size_t)MTOK * 4096 + (size_t)16 * 1024 * 1024))
    if (IN(17)) { AP; REP(17) { cvt_matrix(F, c_w_in, 6144, DM, 6144, 0, Wmi, norm_mix + 2 * DM); cvt_matrix(F, c_w_out, DM, 2048, DM, 0, Wmo); FFN_CVT(2);
        ret_rot_table(F, pos, CSTB); } } SEAM(17);
    if (IN(18)) { AP; REP(18) { pg8::EpiStoreRot<true> E{QKV, CSTB, ssqH}; run_gemm(F, HB, DM, Wmi, DM, 4096, DM, E); } } SEAM(18);
    if (IN(19)) { AP; REP(19) { ret_pmat(F, QKV, PMB); } } SEAM(19);
    if (IN(20)) { AP; REP(20) { ret_core(F, QKV, PMB, statC); } } SEAM(20);
    if (IN(21)) { AP; REP(21) { pg8::EpiGateC<true> E{YS, 4096, statC, c_g, ssqH}; run_gemm(F, HB, DM, Wmi + (size_t)4096 * DM, DM, 2048, DM, E); } } SEAM(21);
    if (IN(22)) { AP; REP(22) { pg8::EpiResidB<true, true> E{HB, HB, ssqH, RED}; run_gemm(F, YS, 4096, Wmo, 2048, DM, 2048, E); } } SEAM(22);
    FFN_PHASES(23, 2);
    if (IN(26)) { AP; REP(26) { cvt_matrix(F, d_w_in, 2048, DM, 2048, 0, Wmi, norm_mix + 3 * DM);
#pragma unroll 1
            for (int blk = 0; blk < 4; ++blk) cvt_matrix(F, d_wg + (size_t)blk * 256 * 512, 512, 256, 512, 2, Wg + (size_t)blk * 512 * 256);
            cvt_matrix(F, d_w_out, DM, DM, DM, 0, Wmo); FFN_CVT(3); } } SEAM(26);
    if (IN(27)) { AP; REP(27) { pg8::EpiStore<true> E{GX, 2048, ssqH}; run_gemm(F, HB, DM, Wmi, DM, 2048, DM, E); } } SEAM(27);
    if (IN(28)) { AP; REP(28) { lru_conv(F, GX, d_cw, d_cb, XC, d_lru, sptab); } } SEAM(28);
    if (IN(29)) { AP; REP(29) { pg8::EpiLru E{XC, LA, BT, d_bg, sptab}; run_gemm(F, XC, DM, Wg, 256, 2048, 256, E, MTOK, 256); } } SEAM(29);
    if (IN(30)) { AP; REP(30) { lru_scan(F, LA, BT, GX, Y); } } SEAM(30);
    if (IN(31)) { AP; REP(31) { pg8::EpiResidB<true, true> E{HB, HB, ssqH, RED}; run_gemm(F, Y, DM, Wmo, DM, DM, DM, E); } } SEAM(31);
    FFN_PHASES(32, 3);
    if (TIMING_MASK != 0ull && blockIdx.x == 0 && threadIdx.x == 0) { const unsigned long long t0_ = __builtin_amdgcn_s_memrealtime(); const unsigned long long tacc_ = TMISC[1]; while (__builtin_amdgcn_s_memrealtime() - t0_ < tacc_) __builtin_amdgcn_s_sleep(8); }
#undef IN
#undef SEAM
#undef XIN
#undef pos
#undef norm_mix
#undef norm_ffn
#undef ffn_w_in
#undef ffn_w_out
#undef out
#undef Wmi
#undef Wmo
#undef Wfi
#undef Wfo
#undef U
#undef BIG
#undef gatesA
#undef ssqA
#undef statC
#undef kmean
#undef sptab
#undef a_w_in
#undef a_b
#undef a_g
#undef a_w_out
#undef b_w_in
#undef b_gq
#undef b_gk
#undef b_w_out
#undef c_w_in
#undef c_g
#undef c_w_out
#undef d_w_in
#undef d_cw
#undef d_cb
#undef d_wg
#undef d_bg
#undef d_lru
#undef d_w_out
#undef GX
#undef XC
#undef LA
#undef BT
#undef Y
#undef Wg
#undef FFN_CVT
#undef OB
#undef HB
#undef RED
#undef CSTB
#undef PMAB
#undef GTB
#undef DENB
#undef PMB
#undef VTB
#undef FFN_PHASES
#undef QKV
#undef HO
#undef YS
#undef ssqH
}

#ifndef MK_ONE_LAUNCH
#define MK_ONE_LAUNCH 1
#endif
extern "C" void kernel_launch(void* const* d_in, const int* in_sizes, int n_in, void* d_out, int out_size, void* d_ws, size_t ws_size, hipStream_t stream) {
    static int grid = 0;
    if (grid == 0) {
        if (n_in != 24 || out_size != MTOK * DM || ws_size < WS_END) { fprintf(stderr, "kernel_launch: unexpected shapes (n_in %d, out %d, ws %zu); nothing launched\n", n_in, out_size, ws_size); grid = -1; return; }
        int dev = 0, cus = 0, per_cu = 0;
        if (hipGetDevice(&dev) != hipSuccess || hipDeviceGetAttribute(&cus, hipDeviceAttributeMultiprocessorCount, dev) != hipSuccess) { grid = -1; return; }
        if (hipFuncSetAttribute((const void*)trunk_fwd, hipFuncAttributeMaxDynamicSharedMemorySize, LDS_BYTES) != hipSuccess) { fprintf(stderr, "kernel_launch: hipFuncSetAttribute failed\n"); grid = -1; return; }
        if (hipOccupancyMaxActiveBlocksPerMultiprocessor(&per_cu, (const void*)trunk_fwd, NTHR, LDS_BYTES) != hipSuccess || per_cu < 1) { fprintf(stderr, "kernel_launch: occupancy query reports %d blocks per CU\n", per_cu); }
        (void)hipGetLastError();
        grid = cus;
    }
    if (grid < 0) return;
    (void)hipMemsetAsync((char*)d_ws + WS_CTL, 0, CTL_ZERO_BYTES, stream);
    Args a{};
    for (int i = 0; i < 24; ++i) a.in[i] = d_in[i];
    a.out = (float*)d_out; a.ws = (unsigned char*)d_ws;
#if MK_ONE_LAUNCH
    a.ph_lo = 0; a.ph_hi = NPHASE;
    hipLaunchKernelGGL(trunk_fwd, dim3(grid), dim3(NTHR), LDS_BYTES, stream, a);
#else
    for (int p = 0; p < NPHASE; ++p) { a.ph_lo = p; a.ph_hi = p + 1; hipLaunchKernelGGL(trunk_fwd, dim3(grid), dim3(NTHR), LDS_BYTES, stream, a); }
#endif
}
```

```cpp
#include <hip/hip_runtime.h>
#include <cstdio>
#include <cstdint>
#include <cmath>
namespace pg8 {
#define PG8_LAS __attribute__((address_space(3)))
typedef unsigned short bf16_t;
typedef short bf16x8 __attribute__((ext_vector_type(8)));
typedef float f32x4 __attribute__((ext_vector_type(4)));
typedef unsigned u32x4 __attribute__((ext_vector_type(4)));
constexpr int BM = 256, BK = 64, HALF = 128, HTB = HALF * BK * 2  , STAGE_BYTES = 8 * HTB, NXCD = 8, WGM = 8;

__host__ __device__ __forceinline__ int lds_byte(int r, int c) { const int st = (r >> 4) * 2 + (c >> 5), rr = r & 15, cc = c & 31, ob = rr * 64 + cc * 2; return st * 1024 + (ob ^ (((ob >> 9) & 1) << 5)); }
__host__ __device__ __forceinline__ void stage_rc(int b, int& R, int& C) { const int st = b / 1024, sb = b % 1024, swz = sb ^ (((sb >> 9) & 1) << 5); R = (st >> 1) * 16 + swz / 64; C = (st & 1) * 32 + (swz % 64) / 2; }
__host__ __device__ __forceinline__ int perm32(int rho) { const int n = rho >> 4, i = rho & 15; return 8 * (i >> 2) + 4 * n + (i & 3); }

struct Unit { int pm, pn; };
struct Gemm { const bf16_t* A; const bf16_t* Bt; int M, N, K, lda, ldb, ablk; };

struct StaticOrder {
    int nM, nN, nwg, G, c, wgm;
    __host__ __device__ void init(int M, int N, int G_, int c_, int wgm_ = WGM) { nM = M / BM; nN = N / BM; nwg = nM * nN; G = G_; c = c_; wgm = wgm_; }
    __host__ __device__ bool next(int i, Unit& u) const {
        const long L = (long)i * G + c; if (L >= nwg) return false;
        int wgid = (int)L; { const int q = nwg / NXCD, r = nwg % NXCD, xcd = wgid % NXCD, off = wgid / NXCD; wgid = (xcd < r ? xcd * (q + 1) : r * (q + 1) + (xcd - r) * q) + off; }
        const int nig = wgm * nN, gid = wgid / nig, fm = gid * wgm, gsz = (nM - fm) < wgm ? (nM - fm) : wgm;
        u.pm = fm + ((wgid % nig) % gsz); u.pn = (wgid % nig) / gsz; return true;
    }
    __device__ __forceinline__ void a_ready(const Unit&) const {}
    __device__ __forceinline__ void done(const Unit&) const {}
};

__device__ __forceinline__ unsigned cvt_pk_bf16(float lo, float hi) { unsigned r; asm volatile("v_cvt_pk_bf16_f32 %0, %1, %2" : "=v"(r) : "v"(lo), "v"(hi)); return r; }
typedef float f32x2 __attribute__((ext_vector_type(2)));

__device__ __forceinline__ float bf2f(unsigned short b) { return __uint_as_float(((unsigned)b) << 16); }
__device__ __forceinline__ float lo_bf(unsigned w) { return __uint_as_float(w << 16); }
__device__ __forceinline__ float hi_bf(unsigned w) { return __uint_as_float(w & 0xffff0000u); }
__device__ __forceinline__ float fast_sigmoid(float x) { return __builtin_amdgcn_rcpf(1.0f + __expf(-x)); }
typedef unsigned u32x2 __attribute__((ext_vector_type(2)));


#ifndef EPI_SC1
#define EPI_SC1 0
#endif
__device__ __forceinline__ void st16(void* p, u32x4 w) {
#if EPI_SC1
    asm volatile("global_store_dwordx4 %0, %1, off sc1" :: "v"(p), "v"(w) : "memory");
#else
    *(u32x4*)p = w;
#endif
}
__device__ __forceinline__ void row_rstd(const float* ssq, int row0, float (&rs)[2][4]) {
#pragma unroll
    for (int ai = 0; ai < 2; ++ai)
#pragma unroll
        for (int m = 0; m < 4; ++m) { const f32x4 a = *(const f32x4*)(ssq + (size_t)(row0 + ai * HALF + m * 16) * 4);
            rs[ai][m] = 1.0f / sqrtf(((a[0] + a[1]) + (a[2] + a[3])) * (1.0f / 1024.0f) + 1e-6f); }
}
__device__ __forceinline__ void rstd_pre_load(const float* ssq, const Unit& u, int wr, int lane, f32x4& a, f32x4& b) {
    int r = u.pm * BM + wr * 64 + lane; asm volatile("" : "+v"(r));
    a = *(const f32x4*)(ssq + (size_t)r * 4); b = *(const f32x4*)(ssq + (size_t)(r + HALF) * 4);
}
__device__ __forceinline__ void rstd_pre_fin(const f32x4& a, const f32x4& b, float& p0, float& p1) {
    p0 = 1.0f / sqrtf(((a[0] + a[1]) + (a[2] + a[3])) * (1.0f / 1024.0f) + 1e-6f); p1 = 1.0f / sqrtf(((b[0] + b[1]) + (b[2] + b[3])) * (1.0f / 1024.0f) + 1e-6f);
}
__device__ __forceinline__ void lane_rstd(float p0, float p1, int fr, float (&rs)[2][4]) {
#pragma unroll
    for (int m = 0; m < 4; ++m) { rs[0][m] = __shfl(p0, fr + 16 * m); rs[1][m] = __shfl(p1, fr + 16 * m); }
}
template <bool RS> struct EpiStore {
    static constexpr bool PERM = true, AFTER_DRAIN = false; static constexpr int NST = 16; static constexpr bool PRE = RS;
    bf16_t* O; int ldc; const float* ssq;
        __device__ __forceinline__ void pre_load(const Unit& u, int wr, int lane, f32x4& a, f32x4& b) const { rstd_pre_load(ssq, u, wr, lane, a, b); }
    __device__ __forceinline__ void pre_fin(const f32x4& a, const f32x4& b, float& p0, float& p1) const { rstd_pre_fin(a, b, p0, p1); }
    __device__ __forceinline__ void operator()(const f32x4 (&acc)[2][2][4][2], const Unit& u, int wr, int wc, int fr, int fq, float pr0 = 1.0f, float pr1 = 1.0f) const {
        const int row0 = u.pm * BM + wr * 64 + fr, col0 = u.pn * BM + wc * 32 + 8 * fq;
        float rs[2][4]; if (RS) lane_rstd(pr0, pr1, fr, rs);
#pragma unroll
        for (int ai = 0; ai < 2; ++ai)
#pragma unroll
            for (int m = 0; m < 4; ++m) { bf16_t* rowp = O + (size_t)(row0 + ai * HALF + m * 16) * ldc + col0; const float sc = RS ? rs[ai][m] : 1.0f;
#pragma unroll
                for (int bj = 0; bj < 2; ++bj) { const f32x4 v0 = acc[ai][bj][m][0] * sc, v1 = acc[ai][bj][m][1] * sc;
                    u32x4 w; w.x = cvt_pk_bf16(v0[0], v0[1]); w.y = cvt_pk_bf16(v0[2], v0[3]); w.z = cvt_pk_bf16(v1[0], v1[1]); w.w = cvt_pk_bf16(v1[2], v1[3]);
                    st16(rowp + bj * HALF, w);
#if defined(GEMM_EXP) && GEMM_EXP == 3
                    asm volatile("" ::: "memory"); *(volatile u32x4*)(rowp + bj * HALF) = w;
#endif
                } }
    }
};

template <bool RS> struct EpiStoreRot {
    static constexpr bool PERM = true, AFTER_DRAIN = false; static constexpr int NST = 16; static constexpr bool PRE = RS;
    bf16_t* O; const float* cst; const float* ssq;
        __device__ __forceinline__ void pre_load(const Unit& u, int wr, int lane, f32x4& a, f32x4& b) const { rstd_pre_load(ssq, u, wr, lane, a, b); }
    __device__ __forceinline__ void pre_fin(const f32x4& a, const f32x4& b, float& p0, float& p1) const { rstd_pre_fin(a, b, p0, p1); }
    __device__ __forceinline__ void operator()(const f32x4 (&acc)[2][2][4][2], const Unit& u, int wr, int wc, int fr, int fq, float pr0 = 1.0f, float pr1 = 1.0f) const {
        const int row0 = u.pm * BM + wr * 64 + fr, col0 = u.pn * BM + wc * 32 + 8 * fq, d0 = wc * 32 + 8 * fq;
        const bool rot = u.pn < 8; const float sc = (u.pn >= 4 && u.pn < 8) ? 0.0625f : 1.0f;
        float rs[2][4]; if (RS) lane_rstd(pr0, pr1, fr, rs);
#pragma unroll
        for (int ai = 0; ai < 2; ++ai)
#pragma unroll
            for (int m = 0; m < 4; ++m) { const int row = row0 + ai * HALF + m * 16; bf16_t* rowp = O + (size_t)row * 4096 + col0; const float rsc = RS ? rs[ai][m] : 1.0f;
                f32x4 v[2][2];
#pragma unroll
                for (int bj = 0; bj < 2; ++bj) { v[bj][0] = acc[ai][bj][m][0] * rsc; v[bj][1] = acc[ai][bj][m][1] * rsc; }
                if (rot) { const float* cp = cst + (size_t)row * 256 + d0;
#pragma unroll
                    for (int n = 0; n < 2; ++n) { const f32x4 c = *(const f32x4*)(cp + 4 * n), sn = *(const f32x4*)(cp + 128 + 4 * n); const f32x4 x1 = v[0][n], x2 = v[1][n];
                        v[0][n] = (x1 * c - x2 * sn) * sc; v[1][n] = (x2 * c + x1 * sn) * sc; } }
#pragma unroll
                for (int bj = 0; bj < 2; ++bj) { u32x4 w; w.x = cvt_pk_bf16(v[bj][0][0], v[bj][0][1]); w.y = cvt_pk_bf16(v[bj][0][2], v[bj][0][3]); w.z = cvt_pk_bf16(v[bj][1][0], v[bj][1][1]); w.w = cvt_pk_bf16(v[bj][1][2], v[bj][1][3]);
                    *(u32x4*)(rowp + bj * HALF) = w; } }
    }
};
template <bool RS> struct EpiSwiGLU {
    static constexpr bool PERM = true, AFTER_DRAIN = false; static constexpr int NST = 8; static constexpr bool PRE = RS;
    bf16_t* O; int ldc; const float* ssq;
        __device__ __forceinline__ void pre_load(const Unit& u, int wr, int lane, f32x4& a, f32x4& b) const { rstd_pre_load(ssq, u, wr, lane, a, b); }
    __device__ __forceinline__ void pre_fin(const f32x4& a, const f32x4& b, float& p0, float& p1) const { rstd_pre_fin(a, b, p0, p1); }
    __device__ __forceinline__ void operator()(const f32x4 (&acc)[2][2][4][2], const Unit& u, int wr, int wc, int fr, int fq, float pr0 = 1.0f, float pr1 = 1.0f) const {
        const int row0 = u.pm * BM + wr * 64 + fr, col0 = u.pn * HALF + wc * 32 + 8 * fq;
        float rs[2][4]; if (RS) lane_rstd(pr0, pr1, fr, rs);
#pragma unroll
        for (int ai = 0; ai < 2; ++ai)
#pragma unroll
            for (int m = 0; m < 4; ++m) { bf16_t* rowp = O + (size_t)(row0 + ai * HALF + m * 16) * ldc + col0; const float sc = RS ? rs[ai][m] : 1.0f;
                float h[8];
#pragma unroll
                for (int n = 0; n < 2; ++n)
#pragma unroll
                    for (int j = 0; j < 4; ++j) { const float g = acc[ai][0][m][n][j] * sc, up = acc[ai][1][m][n][j] * sc;
#if defined(GEMM_EXP) && GEMM_EXP == 2
                        h[4 * n + j] = g * (0.5f * (fast_sigmoid(g) + (1.0f - fast_sigmoid(-g)))) * up;
#else
                        h[4 * n + j] = g * fast_sigmoid(g) * up;
#endif
                    }
                u32x4 w; w.x = cvt_pk_bf16(h[0], h[1]); w.y = cvt_pk_bf16(h[2], h[3]); w.z = cvt_pk_bf16(h[4], h[5]); w.w = cvt_pk_bf16(h[6], h[7]);

                st16(rowp, w);
                }
    }
};
template <bool NX> struct EpiResid {
    static constexpr bool PERM = false, AFTER_DRAIN = false; static constexpr int NST = 32; static constexpr bool PRE = false;
    const float* base; float* out; int ldc; bf16_t* hb; float* ssq;
    __device__ __forceinline__ void operator()(const f32x4 (&acc)[2][2][4][2], const Unit& u, int wr, int wc, int fr, int fq) const {
        const int row0 = u.pm * BM + wr * 64 + fr, col0 = u.pn * BM + wc * 32 + 4 * fq;
        f32x4 rb[3][4];
#define PG8_RLOAD(g, slot) do { const size_t off_ = (size_t)(row0 + ((g) >> 2) * HALF + ((g) & 3) * 16) * ldc + col0; \
            rb[slot][0] = *(const f32x4*)(base + off_); rb[slot][1] = *(const f32x4*)(base + off_ + 16); rb[slot][2] = *(const f32x4*)(base + off_ + HALF); rb[slot][3] = *(const f32x4*)(base + off_ + HALF + 16); } while (0)
        PG8_RLOAD(0, 0); PG8_RLOAD(1, 1);
#pragma unroll
        for (int g = 0; g < 8; ++g) { const int ai = g >> 2, m = g & 3; const size_t off = (size_t)(row0 + ai * HALF + m * 16) * ldc + col0; float q = 0.f;
            if (g + 2 < 8) PG8_RLOAD(g + 2, (g + 2) % 3);
#pragma unroll
            for (int bj = 0; bj < 2; ++bj)
#pragma unroll
                for (int n = 0; n < 2; ++n) { const f32x4 o = rb[g % 3][bj * 2 + n] + acc[ai][bj][m][n]; *(f32x4*)(out + off + bj * HALF + n * 16) = o;
                    if (NX) { q += (o[0] * o[0] + o[1] * o[1]) + (o[2] * o[2] + o[3] * o[3]); u32x2 w; w.x = cvt_pk_bf16(o[0], o[1]); w.y = cvt_pk_bf16(o[2], o[3]); *(u32x2*)(hb + off + bj * HALF + n * 16) = w; } }
            if (NX) { q += __shfl_xor(q, 16); q += __shfl_xor(q, 32); if (fq == 0) ssq[(size_t)(row0 + ai * HALF + m * 16) * 16 + u.pn * 4 + wc] = q; } }
#undef PG8_RLOAD
    }
};
template <bool BF, bool NX> struct EpiResidB {
    static constexpr bool PERM = true, AFTER_DRAIN = false; static constexpr int NST = 16; static constexpr bool PRE = false;
    const void* base; bf16_t* hb; float* ssq; PG8_LAS float* red;
    __device__ __forceinline__ void operator()(const f32x4 (&acc)[2][2][4][2], const Unit& u, int wr, int wc, int fr, int fq) const {
        const int row0 = u.pm * BM + wr * 64 + fr, col0 = u.pn * BM + wc * 32 + 8 * fq;
        u32x4 hwb[2][2]; f32x4 fb[2][4];
#define PG8_BLOAD(g, slot) do { const size_t o_ = (size_t)(row0 + ((g) >> 2) * HALF + ((g) & 3) * 16) * 1024 + col0; \
            if (BF) { hwb[slot][0] = *(const u32x4*)((const bf16_t*)base + o_); hwb[slot][1] = *(const u32x4*)((const bf16_t*)base + o_ + HALF); } \
            else { const float* b_ = (const float*)base + o_; fb[slot][0] = *(const f32x4*)b_; fb[slot][1] = *(const f32x4*)(b_ + 4); fb[slot][2] = *(const f32x4*)(b_ + HALF); fb[slot][3] = *(const f32x4*)(b_ + HALF + 4); } } while (0)
        PG8_BLOAD(0, 0); float qs[8];
#pragma unroll
        for (int g = 0; g < 8; ++g) { const int ai = g >> 2, m = g & 3, sl = g & 1; bf16_t* rowp = hb + (size_t)(row0 + ai * HALF + m * 16) * 1024 + col0; qs[g] = 0.f;
            if (g + 1 < 8) PG8_BLOAD(g + 1, (g + 1) & 1);
#pragma unroll
            for (int bj = 0; bj < 2; ++bj) { f32x4 b0, b1;
                if (BF) { const u32x4 hw = hwb[sl][bj]; b0 = (f32x4){lo_bf(hw.x), hi_bf(hw.x), lo_bf(hw.y), hi_bf(hw.y)}; b1 = (f32x4){lo_bf(hw.z), hi_bf(hw.z), lo_bf(hw.w), hi_bf(hw.w)}; }
                else { b0 = fb[sl][2 * bj]; b1 = fb[sl][2 * bj + 1]; }
                const f32x4 o0 = b0 + acc[ai][bj][m][0], o1 = b1 + acc[ai][bj][m][1];
                u32x4 w; w.x = cvt_pk_bf16(o0[0], o0[1]); w.y = cvt_pk_bf16(o0[2], o0[3]); w.z = cvt_pk_bf16(o1[0], o1[1]); w.w = cvt_pk_bf16(o1[2], o1[3]);
                if (NX) qs[g] += ((o0[0] * o0[0] + o0[1] * o0[1]) + (o0[2] * o0[2] + o0[3] * o0[3])) + ((o1[0] * o1[0] + o1[1] * o1[1]) + (o1[2] * o1[2] + o1[3] * o1[3]));
                *(u32x4*)(rowp + bj * HALF) = w; } }
#undef PG8_BLOAD
        if (NX) {
#pragma unroll
            for (int g = 0; g < 8; ++g) { float q = qs[g]; q += __shfl_xor(q, 16); q += __shfl_xor(q, 32); if (fq == 0) red[wc * 256 + wr * 64 + (g >> 2) * HALF + (g & 3) * 16 + fr] = q; }
            __syncthreads();
            const int t = wr * 256 + wc * 64 + fq * 16 + fr;
            if (t < 256) ssq[(size_t)(u.pm * BM + t) * 4 + u.pn] = (red[t] + red[256 + t]) + (red[512 + t] + red[768 + t]);
        }
    }
};
struct EpiResidF {
    static constexpr bool PERM = true, AFTER_DRAIN = false; static constexpr int NST = 32; static constexpr bool PRE = false;
    const bf16_t* hb; float* out;
    __device__ __forceinline__ void operator()(const f32x4 (&acc)[2][2][4][2], const Unit& u, int wr, int wc, int fr, int fq) const {
        const int row0 = u.pm * BM + wr * 64 + fr, col0 = u.pn * BM + wc * 32 + 8 * fq;
#pragma unroll
        for (int ai = 0; ai < 2; ++ai)
#pragma unroll
            for (int m = 0; m < 4; ++m) { const size_t o_ = (size_t)(row0 + ai * HALF + m * 16) * 1024 + col0;
#pragma unroll
                for (int bj = 0; bj < 2; ++bj) { const u32x4 hw = *(const u32x4*)(hb + o_ + bj * HALF);
                    const f32x4 b0 = (f32x4){lo_bf(hw.x), hi_bf(hw.x), lo_bf(hw.y), hi_bf(hw.y)}, b1 = (f32x4){lo_bf(hw.z), hi_bf(hw.z), lo_bf(hw.w), hi_bf(hw.w)};
                    *(f32x4*)(out + o_ + bj * HALF) = b0 + acc[ai][bj][m][0]; *(f32x4*)(out + o_ + bj * HALF + 4) = b1 + acc[ai][bj][m][1]; } }
    }
};
struct EpiGateA {
    static constexpr bool PERM = true, AFTER_DRAIN = false; static constexpr int NST = 16; static constexpr bool PRE = false;
    bf16_t* Y; const float* ssq; const float* gout;
    __device__ __forceinline__ void operator()(const f32x4 (&acc)[2][2][4][2], const Unit& u, int wr, int wc, int fr, int fq) const {
        const int row0 = u.pm * BM + wr * 64 + fr, col0 = u.pn * BM + wc * 32 + 8 * fq;
        f32x4 gv[2][2];
#pragma unroll
        for (int bj = 0; bj < 2; ++bj)
#pragma unroll
            for (int n = 0; n < 2; ++n) gv[bj][n] = *(const f32x4*)(gout + col0 + bj * HALF + 4 * n);
        u32x4 hwb[2][2]; f32x4 spb[2][2];
#define PG8_GLOAD(g, slot) do { const int row_ = row0 + ((g) >> 2) * HALF + ((g) & 3) * 16; const bf16_t* rp_ = Y + (size_t)row_ * 1024 + col0; hwb[slot][0] = *(const u32x4*)rp_; hwb[slot][1] = *(const u32x4*)(rp_ + HALF); \
            spb[slot][0] = *(const f32x4*)(ssq + (size_t)row_ * 32 + u.pn * 8); spb[slot][1] = *(const f32x4*)(ssq + (size_t)row_ * 32 + u.pn * 8 + 4); } while (0)
        PG8_GLOAD(0, 0);
#pragma unroll
        for (int g = 0; g < 8; ++g) { const int ai = g >> 2, m = g & 3, sl = g & 1; const int row = row0 + ai * HALF + m * 16; bf16_t* rowp = Y + (size_t)row * 1024 + col0;
            if (g + 1 < 8) PG8_GLOAD(g + 1, (g + 1) & 1);
            const f32x4 sp = spb[sl][0], sp2 = spb[sl][1];
            const float rstd = 1.0f / sqrtf((((sp[0] + sp[1]) + (sp[2] + sp[3])) + ((sp2[0] + sp2[1]) + (sp2[2] + sp2[3]))) * (1.0f / 256.0f) + 1e-6f);
#pragma unroll
            for (int bj = 0; bj < 2; ++bj) { const u32x4 hw = hwb[sl][bj]; float o[8];
                const unsigned hh[4] = {hw.x, hw.y, hw.z, hw.w};
#pragma unroll
                for (int n = 0; n < 2; ++n)
#pragma unroll
                    for (int j = 0; j < 4; ++j) { const unsigned w = hh[2 * n + (j >> 1)]; const float hv = (j & 1) ? hi_bf(w) : lo_bf(w);
                        o[4 * n + j] = hv * rstd * gv[bj][n][j] * fast_sigmoid(acc[ai][bj][m][n][j]); }
                u32x4 w; w.x = cvt_pk_bf16(o[0], o[1]); w.y = cvt_pk_bf16(o[2], o[3]); w.z = cvt_pk_bf16(o[4], o[5]); w.w = cvt_pk_bf16(o[6], o[7]);
                *(u32x4*)(rowp + bj * HALF) = w; } }
#undef PG8_GLOAD
    }
};
template <bool RS> struct EpiGateC {
    static constexpr bool PERM = true, AFTER_DRAIN = false; static constexpr int NST = 16; static constexpr bool PRE = RS;
    bf16_t* Y; int ldy; const float* st; const float* gout; const float* hssq;
        __device__ __forceinline__ void pre_load(const Unit& u, int wr, int lane, f32x4& a, f32x4& b) const { rstd_pre_load(hssq, u, wr, lane, a, b); }
    __device__ __forceinline__ void pre_fin(const f32x4& a, const f32x4& b, float& p0, float& p1) const { rstd_pre_fin(a, b, p0, p1); }
    __device__ __forceinline__ void operator()(const f32x4 (&acc)[2][2][4][2], const Unit& u, int wr, int wc, int fr, int fq, float pr0 = 1.0f, float pr1 = 1.0f) const {
        const int row0 = u.pm * BM + wr * 64 + fr, col0 = u.pn * BM + wc * 32 + 8 * fq, head = u.pn >> 1;
        float rs[2][4]; if (RS) lane_rstd(pr0, pr1, fr, rs);
        f32x4 gv[2][2];
#pragma unroll
        for (int bj = 0; bj < 2; ++bj)
#pragma unroll
            for (int n = 0; n < 2; ++n) gv[bj][n] = *(const f32x4*)(gout + col0 + bj * HALF + 4 * n);
        u32x4 hwb[2][2]; f32x4 spb[2][2];
#define PG8_GLOAD(g, slot) do { const int row_ = row0 + ((g) >> 2) * HALF + ((g) & 3) * 16; const bf16_t* rp_ = Y + (size_t)row_ * ldy + col0; hwb[slot][0] = *(const u32x4*)rp_; hwb[slot][1] = *(const u32x4*)(rp_ + HALF); \
            spb[slot][0] = *(const f32x4*)(st + (size_t)row_ * 32 + head * 8); spb[slot][1] = *(const f32x4*)(st + (size_t)row_ * 32 + head * 8 + 4); } while (0)
        PG8_GLOAD(0, 0);
#pragma unroll
        for (int g = 0; g < 8; ++g) { const int ai = g >> 2, m = g & 3, sl = g & 1; const int row = row0 + ai * HALF + m * 16; bf16_t* rowp = Y + (size_t)row * ldy + col0;
            if (g + 1 < 8) PG8_GLOAD(g + 1, (g + 1) & 1);
            const f32x4 s0 = spb[sl][0], s1 = spb[sl][1];
            const float mu = ((s0[0] + s0[2]) + (s1[0] + s1[2])) * (1.0f / 512.0f), ex2 = ((s0[1] + s0[3]) + (s1[1] + s1[3])) * (1.0f / 512.0f);
            const float var = fmaxf(ex2 - mu * mu, 0.f), rstd = 1.0f / sqrtf(var + 1e-6f);
#pragma unroll
            for (int bj = 0; bj < 2; ++bj) { const u32x4 hw = hwb[sl][bj]; float o[8];
                const unsigned hh[4] = {hw.x, hw.y, hw.z, hw.w};
#pragma unroll
                for (int n = 0; n < 2; ++n)
#pragma unroll
                    for (int j = 0; j < 4; ++j) { const unsigned w = hh[2 * n + (j >> 1)]; const float hv = (j & 1) ? hi_bf(w) : lo_bf(w); const float a = RS ? acc[ai][bj][m][n][j] * rs[ai][m] : acc[ai][bj][m][n][j];
                        o[4 * n + j] = (hv - mu) * rstd * gv[bj][n][j] * (a * fast_sigmoid(a)); }
                u32x4 w; w.x = cvt_pk_bf16(o[0], o[1]); w.y = cvt_pk_bf16(o[2], o[3]); w.z = cvt_pk_bf16(o[4], o[5]); w.w = cvt_pk_bf16(o[6], o[7]);
                *(u32x4*)(rowp + bj * HALF) = w; } }
#undef PG8_GLOAD
    }
};
struct EpiLru {
    static constexpr bool PERM = true, AFTER_DRAIN = false; static constexpr int NST = 16; static constexpr bool PRE = false;
    const bf16_t* XC; bf16_t* LA; bf16_t* BT; const float* bgall; const float* sp;
    __device__ __forceinline__ void operator()(const f32x4 (&acc)[2][2][4][2], const Unit& u, int wr, int wc, int fr, int fq) const {
        const int blk = u.pn >> 1; const float* bg = bgall + blk * 512;
        const int row0 = u.pm * BM + wr * 64 + fr, cb = (u.pn & 1) * HALF + wc * 32 + 8 * fq, ch0 = blk * 256 + cb;
        u32x4 xwb[2]; xwb[0] = *(const u32x4*)(XC + (size_t)row0 * 1024 + ch0);
#pragma unroll
        for (int g = 0; g < 8; ++g) { const int ai = g >> 2, m = g & 3; const size_t off = (size_t)(row0 + ai * HALF + m * 16) * 1024 + ch0;
                if (g + 1 < 8) xwb[(g + 1) & 1] = *(const u32x4*)(XC + (size_t)(row0 + ((g + 1) >> 2) * HALF + ((g + 1) & 3) * 16) * 1024 + ch0);
                const u32x4 xw = xwb[g & 1]; const unsigned xx[4] = {xw.x, xw.y, xw.z, xw.w};
                unsigned lw[4], bw[4];
#pragma unroll
                for (int n = 0; n < 2; ++n) { const f32x4 br = *(const f32x4*)(bg + cb + 4 * n), bi = *(const f32x4*)(bg + 256 + cb + 4 * n), spv = *(const f32x4*)(sp + ch0 + 4 * n); float la[4], bt[4];
#pragma unroll
                    for (int j = 0; j < 4; ++j) { const int q = 4 * n + j; const unsigned w = xx[q >> 1]; const float xc = (q & 1) ? hi_bf(w) : lo_bf(w);
                        const float r = fast_sigmoid(acc[ai][0][m][n][j] + br[j]), ig = fast_sigmoid(acc[ai][1][m][n][j] + bi[j]);
                        const float l = -8.0f * r * spv[j]; la[j] = l; bt[j] = sqrtf(fmaxf(1.0f - __expf(2.0f * l), 0.f)) * ig * xc; }
                    lw[2 * n] = cvt_pk_bf16(la[0], la[1]); lw[2 * n + 1] = cvt_pk_bf16(la[2], la[3]); bw[2 * n] = cvt_pk_bf16(bt[0], bt[1]); bw[2 * n + 1] = cvt_pk_bf16(bt[2], bt[3]); }
                u32x4 w; w.x = lw[0]; w.y = lw[1]; w.z = lw[2]; w.w = lw[3]; *(u32x4*)(LA + off) = w;
                w.x = bw[0]; w.y = bw[1]; w.z = bw[2]; w.w = bw[3]; *(u32x4*)(BT + off) = w; }
    }
};

template <class Epi, class Sched, bool ALIGN_EPI = false, bool SP2 = false>
__device__ __forceinline__ void gemm_phase(PG8_LAS unsigned char* lds, const Gemm g, const Sched& S, const Epi& E) {
    int tid_ = threadIdx.x; asm volatile("" : "+v"(tid_));
    const int tid = tid_, wid = __builtin_amdgcn_readfirstlane(tid >> 6), lane = tid & 63, wr = wid >> 2, wc = wid & 3, fr = lane & 15, fq = lane >> 4;
    const int K = g.K, nt = K / BK;
    unsigned voffA[2], voffB[2];
#pragma unroll
    for (int i = 0; i < 2; ++i) { int R, C; stage_rc(tid * 16 + i * 8192, R, C); const int Rb = Epi::PERM ? ((R & ~31) + perm32(R & 31)) : R;
        voffA[i] = (unsigned)(R * g.lda + C) * 2u; voffB[i] = (unsigned)(Rb * g.ldb + C) * 2u; }
    const size_t kstep = (size_t)(BK * 2);
    const size_t hstepA = (size_t)HALF * g.lda * 2, hstepB = (size_t)HALF * g.ldb * 2;
    const size_t tstepA = 2 * hstepA, tstepB = 2 * hstepB;
    const unsigned ldsw = (unsigned)wid * 1024u;
    const int aoff = lds_byte(wr * 64 + fr, fq * 8), boff = lds_byte(wc * 32 + fr, fq * 8);
#define PG8_SA(b, h) (((b) * 2 + (h)) * HTB)
#define PG8_SB(b, h) ((4 + (b) * 2 + (h)) * HTB)
#define PG8_STAGE(bufoff, gbase, voff) do { _Pragma("unroll") for (int _i = 0; _i < 2; ++_i) \
        __builtin_amdgcn_global_load_lds((const unsigned*)((const char*)(gbase) + (voff)[_i]), (PG8_LAS unsigned*)(lds + (bufoff) + ldsw + _i * 8192), 16, 0, 0); } while (0)
#define PG8_LDA(dst, b, h) do { _Pragma("unroll") for (int m = 0; m < 4; ++m) _Pragma("unroll") for (int k = 0; k < 2; ++k) dst[m][k] = *(const PG8_LAS bf16x8*)(lds + PG8_SA(b, h) + aoff + m * 2048 + k * 1024); } while (0)
#define PG8_LDB(dst, b, h) do { _Pragma("unroll") for (int n = 0; n < 2; ++n) _Pragma("unroll") for (int k = 0; k < 2; ++k) dst[n][k] = *(const PG8_LAS bf16x8*)(lds + PG8_SB(b, h) + boff + n * 2048 + k * 1024); } while (0)
#define PG8_MMA(ai, bj, At, Bt) do { __builtin_amdgcn_s_setprio(1); _Pragma("unroll") for (int m = 0; m < 4; ++m) _Pragma("unroll") for (int n = 0; n < 2; ++n) _Pragma("unroll") for (int k = 0; k < 2; ++k) \
        acc[ai][bj][m][n] = __builtin_amdgcn_mfma_f32_16x16x32_bf16(Bt[n][k], At[m][k], acc[ai][bj][m][n], 0, 0, 0); __builtin_amdgcn_s_setprio(0); } while (0)
#define PG8_WAIT_V(n) asm volatile("s_waitcnt vmcnt(" #n ")" ::: "memory")
#ifndef PG8_RELAX
#define PG8_RELAX 0
#endif
#define PG8_WAIT_V8F do { if (PG8_RELAX) asm volatile("s_cmp_eq_u32 %0, 0\n\ts_cbranch_scc1 .Lpg8w%=a\n\ts_waitcnt vmcnt(%1)\n\ts_branch .Lpg8w%=b\n.Lpg8w%=a:\n\ts_waitcnt vmcnt(8)\n.Lpg8w%=b:" :: "s"(relax_), "n"(8 + Epi::NST) : "memory", "scc"); else PG8_WAIT_V(8); } while (0)
#define PG8_WAIT_L(n) asm volatile("s_waitcnt lgkmcnt(" #n ")" ::: "memory")
#define PG8_BAR __builtin_amdgcn_s_barrier()
#define PG8_SCHED __builtin_amdgcn_sched_barrier(0)
    Unit cur, nxt; int ui = 0;
    if (!S.next(0, cur)) return;
    f32x4 acc[2][2][4][2];
#pragma unroll
    for (int a = 0; a < 2; ++a)
#pragma unroll
        for (int b = 0; b < 2; ++b)
#pragma unroll
            for (int m = 0; m < 4; ++m)
#pragma unroll
                for (int n = 0; n < 2; ++n) acc[a][b][m][n] = (f32x4){0.f, 0.f, 0.f, 0.f};
    bf16x8 At[4][2], B0[2][2], B1[2][2];
    float pr0 = 1.0f, pr1 = 1.0f;
    const char* cA = (const char*)g.A + (size_t)cur.pm * tstepA + (size_t)((cur.pn >> 1) * g.ablk) * 2; const char* cB = (const char*)g.Bt + (size_t)cur.pn * tstepB;
    S.a_ready(cur);
    if constexpr (SP2) {
        PG8_STAGE(PG8_SB(0, 0), cB, voffB); PG8_STAGE(PG8_SB(0, 1), cB + hstepB, voffB); PG8_STAGE(PG8_SA(0, 0), cA, voffA); PG8_STAGE(PG8_SA(0, 1), cA + hstepA, voffA);
        if (wr == 1) PG8_BAR;
        PG8_WAIT_V(2); PG8_BAR;
        PG8_STAGE(PG8_SB(1, 0), cB + kstep, voffB); PG8_STAGE(PG8_SA(1, 0), cA + kstep, voffA); PG8_STAGE(PG8_SB(1, 1), cB + hstepB + kstep, voffB);
        PG8_WAIT_V(6); PG8_BAR;
    } else {
        PG8_STAGE(PG8_SB(0, 0), cB, voffB); PG8_STAGE(PG8_SA(0, 0), cA, voffA); PG8_STAGE(PG8_SB(0, 1), cB + hstepB, voffB); PG8_STAGE(PG8_SA(0, 1), cA + hstepA, voffA);
        if (wr == 1) PG8_BAR;
        PG8_WAIT_V(4); PG8_BAR;
        PG8_STAGE(PG8_SB(1, 0), cB + kstep, voffB); PG8_STAGE(PG8_SA(1, 0), cA + kstep, voffA); PG8_STAGE(PG8_SB(1, 1), cB + hstepB + kstep, voffB);
        PG8_WAIT_V(6); PG8_BAR;
    }
    for (;;) {
        const bool has_next = S.next(ui + 1, nxt);
        const char* nA = has_next ? (const char*)g.A + (size_t)nxt.pm * tstepA + (size_t)((nxt.pn >> 1) * g.ablk) * 2 : cA; const char* nB = has_next ? (const char*)g.Bt + (size_t)nxt.pn * tstepB : cB;
        for (int t = 0; t < nt; t += 2) {
            const bool last = (t == nt - 2);
            const int relax_ = __builtin_amdgcn_readfirstlane((t == 0 && ui > 0) ? 1 : 0);
            const char* a1 = cA + (size_t)(t + 1) * kstep;
            const char* a2 = last ? nA : cA + (size_t)(t + 2) * kstep; const char* b2 = last ? nB : cB + (size_t)(t + 2) * kstep;
            const char* a3 = a2 + kstep; const char* b3 = b2 + kstep;
            if (last && has_next) S.a_ready(nxt);
            f32x4 pq0, pq1;
            if constexpr (SP2) {
            PG8_LDB(B0, 0, 0); PG8_LDB(B1, 0, 1); PG8_SCHED; PG8_LDA(At, 0, 0); PG8_STAGE(PG8_SA(1, 1), a1 + hstepA, voffA);
            PG8_WAIT_V8F; PG8_WAIT_L(0); PG8_BAR; PG8_MMA(0, 0, At, B0); PG8_MMA(0, 1, At, B1); PG8_BAR; PG8_SCHED;
            PG8_LDA(At, 0, 1); PG8_STAGE(PG8_SB(0, 0), b2, voffB); PG8_STAGE(PG8_SB(0, 1), b2 + hstepB, voffB); PG8_STAGE(PG8_SA(0, 0), a2, voffA);
            PG8_WAIT_V8F; PG8_WAIT_L(0); PG8_BAR; PG8_MMA(1, 0, At, B0); PG8_MMA(1, 1, At, B1); PG8_BAR; PG8_SCHED;
            if constexpr (Epi::PRE) { E.pre_load(cur, wr, lane, pq0, pq1); }
            PG8_LDB(B0, 1, 0); PG8_LDB(B1, 1, 1); PG8_SCHED; PG8_LDA(At, 1, 0); PG8_STAGE(PG8_SA(0, 1), a2 + hstepA, voffA);
            if constexpr (Epi::PRE) PG8_WAIT_V(10); else PG8_WAIT_V(8);
            PG8_WAIT_L(0); PG8_BAR; PG8_MMA(0, 0, At, B0); PG8_MMA(0, 1, At, B1); PG8_BAR; PG8_SCHED;
            PG8_LDA(At, 1, 1); PG8_STAGE(PG8_SB(1, 0), b3, voffB); PG8_STAGE(PG8_SB(1, 1), b3 + hstepB, voffB); PG8_STAGE(PG8_SA(1, 0), a3, voffA);
            PG8_WAIT_V(8); PG8_WAIT_L(0); PG8_BAR; PG8_MMA(1, 0, At, B0); PG8_MMA(1, 1, At, B1); PG8_BAR; PG8_SCHED;
            if constexpr (Epi::PRE) { E.pre_fin(pq0, pq1, pr0, pr1); }
            } else {
            PG8_LDB(B0, 0, 0); PG8_SCHED; PG8_LDA(At, 0, 0); PG8_STAGE(PG8_SA(1, 1), a1 + hstepA, voffA);
            PG8_WAIT_L(8); PG8_BAR; PG8_WAIT_L(0); PG8_MMA(0, 0, At, B0); PG8_BAR; PG8_SCHED;
            PG8_LDB(B1, 0, 1); PG8_STAGE(PG8_SB(0, 0), b2, voffB);
            PG8_BAR; PG8_WAIT_L(0); PG8_MMA(0, 1, At, B1); PG8_BAR;
            PG8_LDA(At, 0, 1); PG8_STAGE(PG8_SA(0, 0), a2, voffA);
            PG8_BAR; PG8_WAIT_L(0); PG8_MMA(1, 0, At, B0); PG8_BAR; PG8_SCHED;
            PG8_STAGE(PG8_SB(0, 1), b2 + hstepB, voffB);
            PG8_WAIT_V(6); PG8_BAR; PG8_MMA(1, 1, At, B1); PG8_BAR;
            PG8_LDB(B0, 1, 0); PG8_SCHED; PG8_LDA(At, 1, 0); PG8_STAGE(PG8_SA(0, 1), a2 + hstepA, voffA);
            PG8_WAIT_L(8); PG8_BAR; PG8_WAIT_L(0); PG8_MMA(0, 0, At, B0); PG8_BAR; PG8_SCHED;
            PG8_LDB(B1, 1, 1); PG8_STAGE(PG8_SB(1, 0), b3, voffB);
            PG8_BAR; PG8_WAIT_L(0); PG8_MMA(0, 1, At, B1); PG8_BAR;
            PG8_LDA(At, 1, 1); PG8_STAGE(PG8_SA(1, 0), a3, voffA);
            PG8_BAR; PG8_WAIT_L(0); PG8_MMA(1, 0, At, B0); PG8_BAR; PG8_SCHED;
            PG8_STAGE(PG8_SB(1, 1), b3 + hstepB, voffB);
            PG8_WAIT_V(6); PG8_BAR; PG8_MMA(1, 1, At, B1); PG8_BAR;
            }
        }
        if constexpr (ALIGN_EPI) { if (wr == 0) PG8_BAR; }
        if constexpr (!Epi::AFTER_DRAIN) { if constexpr (Epi::PRE) E(acc, cur, wr, wc, fr, fq, pr0, pr1); else E(acc, cur, wr, wc, fr, fq); S.done(cur); }
        if (!has_next) break;
#pragma unroll
        for (int a = 0; a < 2; ++a)
#pragma unroll
            for (int b = 0; b < 2; ++b)
#pragma unroll
                for (int m = 0; m < 4; ++m)
#pragma unroll
                    for (int n = 0; n < 2; ++n) acc[a][b][m][n] = (f32x4){0.f, 0.f, 0.f, 0.f};
        cur = nxt; cA = nA; cB = nB; ++ui;
        if constexpr (ALIGN_EPI) { if (wr == 1) PG8_BAR; }
    }
    PG8_WAIT_V(0);
    if constexpr (!ALIGN_EPI) { if (wr == 0) PG8_BAR; }
    PG8_BAR;
    if constexpr (Epi::AFTER_DRAIN) { E.fused(acc, cur, wr, wc, fr, fq, lds, wid, lane); S.done(cur); }
#undef PG8_SA
#undef PG8_SB
#undef PG8_STAGE
#undef PG8_LDA
#undef PG8_LDB
#undef PG8_MMA
#undef PG8_WAIT_V
#undef PG8_WAIT_V8F
#undef PG8_WAIT_L
#undef PG8_BAR
#undef PG8_SCHED
}
}
#define GAS __attribute__((address_space(1)))
#define LAS __attribute__((address_space(3)))
typedef unsigned short bf16;
typedef unsigned v4u __attribute__((ext_vector_type(4)));
typedef float f32x4 __attribute__((ext_vector_type(4)));
typedef short bf16x8 __attribute__((ext_vector_type(8)));
typedef GAS unsigned gu32;
typedef GAS unsigned long long gu64;
#define RLX_AGENT __ATOMIC_RELAXED, __HIP_MEMORY_SCOPE_AGENT
#define LDS_WAIT() asm volatile("s_waitcnt lgkmcnt(0)" ::: "memory")
#define VM_WAIT() asm volatile("s_waitcnt vmcnt(0)" ::: "memory")
__device__ __forceinline__ unsigned long long rt() { return __builtin_amdgcn_s_memrealtime(); }
__device__ __forceinline__ unsigned f2bf(float f) { unsigned u = __builtin_bit_cast(unsigned, f); return (u + 0x7fffu + ((u >> 16) & 1u)) >> 16; }
__device__ __forceinline__ unsigned pk2(float lo, float hi) { return f2bf(lo) | (f2bf(hi) << 16); }

#define XB_TMO      128
#define XB_XCNT(j)  (256  + 64 * (j))
#define XB_XSUB(j)  (1280 + 64 * (j))
#define XB_XGEN(j)  (2304 + 64 * (j))
#define XB_TOP      3328
#define XB_TOPGEN   3392
#define XCD_BAR_WORDS 3456
#define XB_SPIN_CAP (1u << 18)

__device__ __forceinline__ unsigned xb_ld(unsigned* p)              { return __hip_atomic_load(p, __ATOMIC_RELAXED, __HIP_MEMORY_SCOPE_AGENT); }
__device__ __forceinline__ unsigned xb_add(unsigned* p, unsigned v) { return __hip_atomic_fetch_add(p, v, __ATOMIC_RELAXED, __HIP_MEMORY_SCOPE_AGENT); }
__device__ __forceinline__ unsigned xb_xcc_id() { return (unsigned)__builtin_amdgcn_s_getreg((3 << 11) | 20) & 0xFu; }
#define XB_SPIN(cond, bar) do { unsigned _sp = 0; while (cond) { __builtin_amdgcn_s_sleep(1); \
    if ((++_sp & 255u) == 0u) { if (xb_ld(&(bar)[XB_TMO])) break; if (_sp > XB_SPIN_CAP) { atomicAdd(&(bar)[XB_TMO], 1u); break; } } } } while (0)

struct XcdBarrier {
    unsigned* bar; unsigned x;
    volatile LAS unsigned* st;
};

__device__ __forceinline__ XcdBarrier xcd_barrier_post(unsigned* bar, volatile LAS unsigned* st) {
    XcdBarrier b; b.bar = bar; b.x = xb_xcc_id(); b.st = st;
    if (threadIdx.x == 0) (void)xb_add(&bar[XB_XCNT(b.x)], 1u);
    return b;
}
__device__ __forceinline__ void xcd_barrier_complete(unsigned* bar, unsigned x, unsigned& nloc, unsigned& nx) {
    const unsigned G = gridDim.x * gridDim.y * gridDim.z;
    unsigned sum, cnt, mine, sp = 0u;
    for (;;) {
        sum = 0u; cnt = 0u; mine = 0u;
#pragma unroll
        for (unsigned j = 0; j < 16; ++j) { const unsigned c = xb_ld(&bar[XB_XCNT(j)]); sum += c; cnt += (c > 0u) ? 1u : 0u; mine = (j == x) ? c : mine; }
        if (sum == G) break;
        __builtin_amdgcn_s_sleep(1);
        if ((++sp & 255u) == 0u) { if (xb_ld(&bar[XB_TMO])) break; if (sp > XB_SPIN_CAP) { atomicAdd(&bar[XB_TMO], 1u); break; } }
    }
    nloc = mine > 0u ? mine : 1u; nx = cnt > 0u ? cnt : 1u;
}

__device__ __forceinline__ void xcd_barrier(const XcdBarrier& b) {
    asm volatile("s_waitcnt vmcnt(0)" ::: "memory");
    __syncthreads();
    if (threadIdx.x == 0) {
        unsigned* bar = b.bar;
        __builtin_amdgcn_s_waitcnt(0);
        unsigned nloc = b.st[0], nx = b.st[1];
        if (nloc == 0u) { xcd_barrier_complete(bar, b.x, nloc, nx); b.st[0] = nloc; b.st[1] = nx; }
        const unsigned old = xb_add(&bar[XB_XSUB(b.x)], 1u);
        const unsigned gen = old / nloc;
        if (old + 1u == (gen + 1u) * nloc) {
            __builtin_amdgcn_fence(__ATOMIC_RELEASE, "agent");
            asm volatile("s_waitcnt vmcnt(0)" ::: "memory");
            const unsigned og = xb_add(&bar[XB_TOP], 1u);
            const unsigned tg = og / nx;
            if (og + 1u == (tg + 1u) * nx) xb_add(&bar[XB_TOPGEN], 1u);
            else XB_SPIN(xb_ld(&bar[XB_TOPGEN]) == tg, bar);
            __builtin_amdgcn_fence(__ATOMIC_ACQUIRE, "agent");
            xb_add(&bar[XB_XGEN(b.x)], 1u);
            asm volatile("s_waitcnt vmcnt(0)" ::: "memory");
        } else {
            XB_SPIN(xb_ld(&bar[XB_XGEN(b.x)]) == gen, bar);
            __builtin_amdgcn_fence(__ATOMIC_ACQUIRE, "agent");
            asm volatile("s_waitcnt vmcnt(0)" ::: "memory");
        }
    }
    __syncthreads();
}
namespace mattn {
typedef unsigned short bf16;
constexpr int D = 128, NW = 8, QBLK = 32, KVBLK = 64;
constexpr float SCALE = 0.088388347648318440f, THR = 8.f;
constexpr int LDQ = 3072, LDK = 3072, LDO = 1024;
constexpr size_t SHM_V = KVBLK * D * 2, SHM_K = KVBLK * D * 2, SHM_ATTN = 2 * SHM_V + 2 * SHM_K + NW * 64 * 4;
using bf16x8 = __attribute__((ext_vector_type(8))) short;
using s16x4  = __attribute__((ext_vector_type(4))) short;
using f32x16 = __attribute__((ext_vector_type(16))) float;
using u32x4  = __attribute__((ext_vector_type(4))) unsigned;
#define KSWZ(row, colB) ((row) * 256 + ((colB) ^ (((row) & 7) << 4)))
#define SBAR() __builtin_amdgcn_sched_barrier(0)
__device__ __forceinline__ int crow(int r, int hi) { return (r & 3) + 8 * (r >> 2) + 4 * hi; }
__device__ __forceinline__ unsigned cvtpk(float lo, float hi) { unsigned r; asm volatile("v_cvt_pk_bf16_f32 %0, %1, %2" : "=v"(r) : "v"(lo), "v"(hi)); return r; }
struct Msk { int j; unsigned sel; int qpos; };
__device__ __forceinline__ float sconst(unsigned bits) { return __uint_as_float((unsigned)__builtin_amdgcn_readfirstlane((int)bits)); }
__device__ __forceinline__ void partialSM(f32x16& p0, f32x16& p1, float& m_reg, float& mn, float& alpha, int tile, const Msk& mk, int hi) {
  constexpr float C = SCALE * 1.4426950408889634f;
  const int kb = tile >> 2; const bool own = (kb == mk.j), lsel = own || ((mk.sel >> kb) & 1u);
  float pmax = p0[0];
#pragma unroll
for (int r = 1; r < 16; ++r) pmax = fmaxf(pmax, p0[r]);
#pragma unroll
for (int r = 0; r < 16; ++r) pmax = fmaxf(pmax, p1[r]);
  { auto rr = __builtin_amdgcn_permlane32_swap(__float_as_uint(pmax), __float_as_uint(pmax), false, false);
    pmax = fmaxf(__uint_as_float(rr[0]), __uint_as_float(rr[1])); }
  if (!lsel) pmax = sconst(0xf149f2cau);
  if (__builtin_expect(__all(pmax - m_reg <= THR / SCALE), 1)) { mn = m_reg; alpha = 1.f; }
  else { mn = fmaxf(m_reg, pmax); alpha = __builtin_amdgcn_exp2f((m_reg - mn) * C); m_reg = mn; }
  const float mnC = lsel ? -mn * C : sconst(0xff800000u);
#pragma unroll
for (int r = 0; r < 16; ++r) p0[r] = fmaf(p0[r], C, mnC);
#pragma unroll
for (int r = 0; r < 16; ++r) p1[r] = fmaf(p1[r], C, mnC);
#pragma unroll
for (int r = 0; r < 16; ++r) p0[r] = __builtin_amdgcn_exp2f(p0[r]);
}
__device__ __forceinline__ void finishSM(f32x16& p0, f32x16& p1, float alpha, float& l_reg, bf16x8& pa0, bf16x8& pa1, bf16x8& pa2, bf16x8& pa3) {
#pragma unroll
for (int r = 0; r < 16; ++r) p1[r] = __builtin_amdgcn_exp2f(p1[r]);
  float ps = 0;
#pragma unroll
for (int r = 0; r < 16; ++r) ps += p0[r];
#pragma unroll
for (int r = 0; r < 16; ++r) ps += p1[r];
  { auto rr = __builtin_amdgcn_permlane32_swap(__float_as_uint(ps), __float_as_uint(ps), false, false);
    ps = __uint_as_float(rr[0]) + __uint_as_float(rr[1]); }
  l_reg = l_reg * alpha + ps;
#define PK4(P, BASE, OUT) do { unsigned a0 = cvtpk(P[BASE + 0], P[BASE + 1]), a1 = cvtpk(P[BASE + 2], P[BASE + 3]);   \
    unsigned b0 = cvtpk(P[BASE + 4], P[BASE + 5]), b1 = cvtpk(P[BASE + 6], P[BASE + 7]);                              \
    auto r0 = __builtin_amdgcn_permlane32_swap(a0, b0, false, false); auto r1 = __builtin_amdgcn_permlane32_swap(a1, b1, false, false); \
    u32x4 w = {r0[0], r1[0], r0[1], r1[1]}; OUT = *reinterpret_cast<bf16x8*>(&w); } while (0)
  PK4(p0, 0, pa0); PK4(p0, 8, pa1); PK4(p1, 0, pa2); PK4(p1, 8, pa3);
#undef PK4
}
__device__ __forceinline__ void qkt(f32x16& p0, f32x16& p1, const bf16* Ks, const bf16x8* qr, int r32, int hi, int tile, const Msk& mk) {
  if ((tile >> 2) == mk.j) { const float NEGB = sconst(0xf149f2cau); int qp = mk.qpos - (tile & 3) * 64; asm volatile("" : "+v"(qp));
#pragma unroll
    for (int r = 0; r < 16; ++r) { const int k0 = crow(r, hi); p0[r] = (k0 > qp) ? NEGB : 0.f; p1[r] = (k0 + 32 > qp) ? NEGB : 0.f; } }
  else { p0 = f32x16{}; p1 = f32x16{}; }
#pragma unroll
for (int d0 = 0; d0 < 8; ++d0) { int cb = (d0 * 16 + hi * 8) * 2;
    bf16x8 b0 = *reinterpret_cast<const bf16x8*>((const char*)Ks + KSWZ(r32, cb));
    bf16x8 b1 = *reinterpret_cast<const bf16x8*>((const char*)Ks + KSWZ(32 + r32, cb));
    p0 = __builtin_amdgcn_mfma_f32_32x32x16_bf16(b0, qr[d0], p0, 0, 0, 0);
    p1 = __builtin_amdgcn_mfma_f32_32x32x16_bf16(b1, qr[d0], p1, 0, 0, 0); }
}
__device__ __forceinline__ int v_st(int k, int c) { const int kk = (k & ~0xC) | ((k & 4) << 1) | ((k & 8) >> 1); return ((kk >> 3) * 4 + (c >> 5)) * 512 + ((kk & 7) * 32 + (c & 31)) * 2; }
__device__ __forceinline__ int v_rd_base(int lane) { return ((lane & 3) << 3) | (((lane >> 2) & 3) << 6) | (((lane >> 4) & 1) << 5) | (((lane >> 5) & 1) << 8); }
constexpr int v_rd_off(int d0, int ks, int half) { return d0 * 512 + ks * 4096 + half * 2048; }
template <int OFF> __device__ __forceinline__ s16x4 tr_read(int vb) { s16x4 r; asm volatile("ds_read_b64_tr_b16 %0, %1 offset:%2" : "=&v"(r) : "v"(vb), "i"(OFF) : "memory"); return r; }
template <int D0> __device__ __forceinline__ void pv_one(f32x16& od, int vb, bf16x8 pa0, bf16x8 pa1, bf16x8 pa2, bf16x8 pa3) {
  const s16x4 l0 = tr_read<v_rd_off(D0, 0, 0)>(vb), h0 = tr_read<v_rd_off(D0, 0, 1)>(vb), l1 = tr_read<v_rd_off(D0, 1, 0)>(vb), h1 = tr_read<v_rd_off(D0, 1, 1)>(vb);
  const s16x4 l2 = tr_read<v_rd_off(D0, 2, 0)>(vb), h2 = tr_read<v_rd_off(D0, 2, 1)>(vb), l3 = tr_read<v_rd_off(D0, 3, 0)>(vb), h3 = tr_read<v_rd_off(D0, 3, 1)>(vb);
  asm volatile("s_waitcnt lgkmcnt(0)" ::: "memory"); SBAR();
#define PK(L, H) (bf16x8){L[0], L[1], L[2], L[3], H[0], H[1], H[2], H[3]}
  od = __builtin_amdgcn_mfma_f32_32x32x16_bf16(pa0, PK(l0, h0), od, 0, 0, 0);
  od = __builtin_amdgcn_mfma_f32_32x32x16_bf16(pa1, PK(l1, h1), od, 0, 0, 0);
  od = __builtin_amdgcn_mfma_f32_32x32x16_bf16(pa2, PK(l2, h2), od, 0, 0, 0);
  od = __builtin_amdgcn_mfma_f32_32x32x16_bf16(pa3, PK(l3, h3), od, 0, 0, 0);
#undef PK
}
__device__ __forceinline__ void pv_d0(f32x16* o, int vb, bf16x8 pa0, bf16x8 pa1, bf16x8 pa2, bf16x8 pa3) {
  pv_one<0>(o[0], vb, pa0, pa1, pa2, pa3); pv_one<1>(o[1], vb, pa0, pa1, pa2, pa3); pv_one<2>(o[2], vb, pa0, pa1, pa2, pa3); pv_one<3>(o[3], vb, pa0, pa1, pa2, pa3);
}
__device__ __forceinline__ void body(const bf16x8 (&qr)[8], const bf16* __restrict__ Kh, const bf16* __restrict__ Vh, bf16* __restrict__ Ob, int seq, char* lds, const Msk mk) {
  int tid_ = threadIdx.x; asm volatile("" : "+v"(tid_));
  const int tid = tid_, wid = tid >> 6, lane = tid & 63, r32 = lane & 31, hi = lane >> 5;
  bf16* V_lds = (bf16*)lds; bf16* K_lds = (bf16*)(lds + 2 * SHM_V);
  float* ws = (float*)(lds + 2 * SHM_V + 2 * SHM_K) + wid * 64; float* li_l = ws; float* al_l = ws + 32;
  float m_reg = -1e30f, l_reg = 0; f32x16 o[4] = {};
#define VB0() ({ int l2_ = lane; asm volatile("" : "+v"(l2_)); (int)(uintptr_t)V_lds + v_rd_base(l2_); })
  struct { bf16x8 vs0, vs1, ks0, ks1; } sr_[1];
#define STG_IDX() int t2_ = tid; asm volatile("" : "+v"(t2_)); const int sr = t2_ >> 4, sc = (t2_ & 15) * 8
#define SLOAD(i, k0) do { STG_IDX(); const unsigned goff0 = (unsigned)((sr * LDK + sc) * 2), goff1 = (unsigned)(((32 + sr) * LDK + sc) * 2); \
    const char* vb_ = (const char*)(Vh + (long)(k0) * LDK); const char* kb_ = (const char*)(Kh + (long)(k0) * LDK); \
    sr_[i].vs0 = *(const bf16x8*)(vb_ + goff0); sr_[i].vs1 = *(const bf16x8*)(vb_ + goff1); sr_[i].ks0 = *(const bf16x8*)(kb_ + goff0); sr_[i].ks1 = *(const bf16x8*)(kb_ + goff1); } while (0)
#define SWRITE(b, i) do { STG_IDX(); const int vst0 = v_st(sr, sc), vst1 = v_st(32 + sr, sc); *(bf16x8*)((char*)V_lds + (b) * SHM_V + vst0) = sr_[i].vs0; *(bf16x8*)((char*)V_lds + (b) * SHM_V + vst1) = sr_[i].vs1; int kc = sc * 2; \
    *(bf16x8*)((char*)K_lds + (b) * SHM_K + KSWZ(sr, kc)) = sr_[i].ks0; *(bf16x8*)((char*)K_lds + (b) * SHM_K + KSWZ(32 + sr, kc)) = sr_[i].ks1; } while (0)
#define SWAIT() asm volatile("s_waitcnt vmcnt(0)" ::: "memory")
#define RESC(a) do { if (__any((a) < 1.f)) { if (hi == 0) al_l[r32] = (a); asm volatile("s_waitcnt lgkmcnt(0)" ::: "memory"); \
    _Pragma("unroll") for (int d = 0; d < 4; ++d) _Pragma("unroll") for (int r = 0; r < 16; ++r) o[d][r] *= al_l[crow(r, hi)]; } } while (0)
  f32x16 pA0, pA1, pB0, pB1; float mnA, mnB, alA, alB; bf16x8 pa0, pa1, pa2, pa3; const int NT = seq / KVBLK;
  constexpr int SE = 0, SO = 0;
  SLOAD(SE, 0); asm volatile("s_waitcnt vmcnt(0)" ::: "memory"); SWRITE(0, SE); __syncthreads();
  qkt(pA0, pA1, K_lds, qr, r32, hi, 0, mk); partialSM(pA0, pA1, m_reg, mnA, alA, 0, mk, hi);
  SLOAD(SO, KVBLK);
  SWAIT(); SWRITE(1, SO); __syncthreads();
#pragma unroll 1
  for (int j = 1; j + 1 < NT; j += 2) {
    SBAR(); qkt(pB0, pB1, (bf16*)((char*)K_lds + SHM_K), qr, r32, hi, j, mk);
    finishSM(pA0, pA1, alA, l_reg, pa0, pa1, pa2, pa3); SBAR();
    SLOAD(SO, (j + 1) * KVBLK); SBAR();
    pv_d0(o, VB0(), pa0, pa1, pa2, pa3); partialSM(pB0, pB1, m_reg, mnB, alB, j, mk, hi);
    __syncthreads(); SWAIT(); SWRITE(0, SE);
    RESC(alB); __syncthreads();
    SBAR(); qkt(pA0, pA1, K_lds, qr, r32, hi, j + 1, mk);
    finishSM(pB0, pB1, alB, l_reg, pa0, pa1, pa2, pa3); SBAR();
    SLOAD(SE, (j + 2) * KVBLK); SBAR();
    pv_d0(o, VB0() + (int)SHM_V, pa0, pa1, pa2, pa3); partialSM(pA0, pA1, m_reg, mnA, alA, j + 1, mk, hi);
    __syncthreads(); SWAIT(); SWRITE(1, SO);
    RESC(alA); __syncthreads();
  }
  SBAR(); qkt(pB0, pB1, (bf16*)((char*)K_lds + SHM_K), qr, r32, hi, NT - 1, mk);
  finishSM(pA0, pA1, alA, l_reg, pa0, pa1, pa2, pa3); SBAR();
  pv_d0(o, VB0(), pa0, pa1, pa2, pa3); partialSM(pB0, pB1, m_reg, mnB, alB, NT - 1, mk, hi);
  __syncthreads(); RESC(alB);
  finishSM(pB0, pB1, alB, l_reg, pa0, pa1, pa2, pa3); SBAR();
  pv_d0(o, VB0() + (int)SHM_V, pa0, pa1, pa2, pa3);
  if (hi == 0) li_l[r32] = l_reg; asm volatile("s_waitcnt lgkmcnt(0)" ::: "memory");
  float rli[16];
#pragma unroll
for (int r = 0; r < 16; ++r) rli[r] = __builtin_amdgcn_rcpf(li_l[crow(r, hi)]);
  bf16* Ow = Ob + (long)(wid * QBLK) * LDO;
#pragma unroll
for (int r = 0; r < 16; ++r) { int orow = crow(r, hi);
#pragma unroll
for (int d0 = 0; d0 < 4; ++d0) { const float v = o[d0][r] * rli[r]; unsigned u = __float_as_uint(v); u = (u + 0x7fffu + ((u >> 16) & 1u)) >> 16; Ow[(long)orow * LDO + d0 * 32 + r32] = (bf16)u; } }
#undef SLOAD
#undef VB0
#undef STG_IDX
#undef SWRITE
#undef SWAIT
#undef RESC
}
#undef KSWZ
#undef SBAR
}


constexpr int NWAVES = 8, NTHR = 512;
constexpr int MTOK = 32768, DM = 1024, SEQ = 2048, NB = 16, DFF = 2816;
constexpr size_t MiB = 1u << 20;
constexpr size_t WS_CTL = 0, CTL_ZERO_BYTES = 64 * 1024;
constexpr size_t WS_W_MIXIN = 1 * MiB, WS_W_MIXOUT = 13 * MiB, WS_W_FFNIN = 17 * MiB, WS_W_FFNOUT = 28 * MiB;
constexpr size_t WS_GATESA = 34 * MiB, WS_SSQA = 35 * MiB, WS_STATC = 492 * MiB, WS_KMEAN = 41 * MiB, WS_SSQH = 42 * MiB, WS_SPTAB = 33 * MiB + 512 * 1024;
constexpr size_t WS_U = 44 * MiB, WS_BIG = 108 * MiB, WS_END = 500 * MiB;
constexpr int CW_BAR = 1024;
static_assert((CW_BAR + 3456) * 4 <= (int)CTL_ZERO_BYTES, "ctl");
constexpr int LDS_BYTES = 163840, MISC_OFF = 163584;

typedef unsigned u32x4 __attribute__((ext_vector_type(4)));
typedef unsigned u32x2 __attribute__((ext_vector_type(2)));
typedef float f32x2 __attribute__((ext_vector_type(2)));
struct Frame { LAS unsigned char* lds; int tid, lane, wave, G; };
struct Args { const void* in[24]; float* out; unsigned char* ws; int ph_lo, ph_hi; };

__device__ __forceinline__ float wave_sum(float v) {
#pragma unroll
    for (int o = 1; o < 64; o <<= 1) v += __shfl_xor(v, o);
    return v;
}
__device__ __forceinline__ float bf2f(bf16 b) { return __uint_as_float(((unsigned)b) << 16); }
__device__ __forceinline__ float lo_bf(unsigned w) { return __uint_as_float(w << 16); }
__device__ __forceinline__ float hi_bf(unsigned w) { return __uint_as_float(w & 0xffff0000u); }
__device__ __forceinline__ unsigned cvtpk(float lo, float hi) { return pg8::cvt_pk_bf16(lo, hi); }

typedef short v4s16 __attribute__((ext_vector_type(4)));
template <int LD> __device__ __forceinline__ bf16x8 tr_frag(const LAS bf16* T, int r0, int c0, int lane) {
    const int fr = lane & 15, fq = lane >> 4;
    const LAS bf16* a = T + (r0 + 8 * fq + (fr >> 2)) * LD + c0 + 4 * (fr & 3);
    const v4s16 lo = __builtin_amdgcn_ds_read_tr16_b64_v4i16((LAS v4s16*)a);
    const v4s16 hi = __builtin_amdgcn_ds_read_tr16_b64_v4i16((LAS v4s16*)(a + 4 * LD));
    return __builtin_shufflevector(lo, hi, 0, 1, 2, 3, 4, 5, 6, 7);
}
template <int MT, int NT, int K, int LDA, int LDB, bool TA = false, bool TB = false, bool SB = true>
__device__ __forceinline__ void wgemm(f32x4 (&acc)[MT][NT], const LAS bf16* A, const LAS bf16* Bt, int lane) {
    const int fr = lane & 15, fq = lane >> 4;
    const LAS bf16* ap = A + fr * LDA + 8 * fq;
    const LAS bf16* bp = Bt + fr * LDB + 8 * fq;
#pragma unroll
    for (int k0 = 0; k0 < K; k0 += 32) {
        bf16x8 a[MT], b[NT];
#pragma unroll
        for (int i = 0; i < MT; ++i) a[i] = TA ? tr_frag<LDA>(A, k0, 16 * i, lane) : *(const LAS bf16x8*)(ap + 16 * i * LDA + k0);
#pragma unroll
        for (int j = 0; j < NT; ++j) b[j] = TB ? tr_frag<LDB>(Bt, k0, 16 * j, lane) : *(const LAS bf16x8*)(bp + 16 * j * LDB + k0);
#pragma unroll
        for (int i = 0; i < MT; ++i)
#pragma unroll
            for (int j = 0; j < NT; ++j) acc[i][j] = __builtin_amdgcn_mfma_f32_16x16x32_bf16(a[i], b[j], acc[i][j], 0, 0, 0);
        if (SB && MT * NT >= 4) __builtin_amdgcn_sched_barrier(0);
    }
    if (!SB) __builtin_amdgcn_sched_barrier(0);
}

__device__ __forceinline__ int cvt_src_col(int mode, int g0) {
    if (mode == 0) return g0;
    const int pn = g0 >> 8, r = g0 & 255;
    if (mode == 1) return r < 128 ? 128 * pn + r : DFF + 128 * pn + (r - 128);
    return r < 128 ? 128 * pn + r : 256 + 128 * pn + (r - 128);
}
__device__ __forceinline__ void cvt_matrix(Frame& F, const float* W, int ldw, int K, int Np, int mode, bf16* WT, const float* gain = nullptr) {
    LAS float* scr = (LAS float*)(F.lds + F.wave * 16384);
    const int gw = blockIdx.x * NWAVES + F.wave, NGW = F.G * NWAVES, lane = F.lane;
    const int nblk = Np / 32, nitems = (K / 64) * nblk;
    float v[32], vn[32];
#define CVT_LOAD(dst, it) do { const int kb_ = (it) / nblk, nb_ = (it) % nblk, s0_ = cvt_src_col(mode, 32 * nb_); const float* wp_ = W + (size_t)(64 * kb_ + (lane >> 5)) * ldw + s0_ + (lane & 31); \
        _Pragma("unroll") for (int i = 0; i < 32; ++i) dst[i] = wp_[(size_t)(2 * i) * ldw]; } while (0)
    int item = gw;
    if (item < nitems) CVT_LOAD(v, item);
    for (; item < nitems; item += NGW) {
        const int kb = item / nblk, nb = item % nblk, k0 = 64 * kb, n0 = 32 * nb;
        if (item + NGW < nitems) CVT_LOAD(vn, item + NGW);
        if (gain) {
#pragma unroll
            for (int i = 0; i < 32; ++i) v[i] *= gain[k0 + 2 * i + (lane >> 5)]; }
#pragma unroll
        for (int i = 0; i < 32; ++i) scr[(2 * i + (lane >> 5)) * 33 + (lane & 31)] = v[i];
        LDS_WAIT(); asm volatile("" ::: "memory");
        const int c = lane & 7;
#pragma unroll
        for (int j = 0; j < 4; ++j) { const int n = (lane >> 3) + 8 * j; const LAS float* sp = scr + (8 * c) * 33 + n;
            v4u o; o.x = pk2(sp[0 * 33], sp[1 * 33]); o.y = pk2(sp[2 * 33], sp[3 * 33]); o.z = pk2(sp[4 * 33], sp[5 * 33]); o.w = pk2(sp[6 * 33], sp[7 * 33]);
            *(v4u*)(WT + (size_t)(n0 + n) * K + k0 + 8 * c) = o; }
        LDS_WAIT(); asm volatile("" ::: "memory");
#pragma unroll
        for (int i = 0; i < 32; ++i) v[i] = vn[i];
    }
#undef CVT_LOAD
}

__device__ __forceinline__ void norm_phase_b(Frame& F, const bf16* src, const float* gain, bf16* dst) {
    const int gw = blockIdx.x * NWAVES + F.wave, NGW = F.G * NWAVES, lane = F.lane;
    f32x4 g[4];
#pragma unroll
    for (int j = 0; j < 2; ++j) { g[2 * j] = *(const f32x4*)(gain + 8 * lane + 512 * j); g[2 * j + 1] = *(const f32x4*)(gain + 8 * lane + 512 * j + 4); }
    v4u cur[2], nxt[2];
    if (gw < MTOK) {
#pragma unroll
        for (int j = 0; j < 2; ++j) cur[j] = *(const v4u*)(src + (size_t)gw * DM + 8 * lane + 512 * j); }
    for (int m = gw; m < MTOK; m += NGW) {
        if (m + NGW < MTOK) {
#pragma unroll
            for (int j = 0; j < 2; ++j) nxt[j] = *(const v4u*)(src + (size_t)(m + NGW) * DM + 8 * lane + 512 * j); }
        f32x4 v[4]; float s = 0.f;
#pragma unroll
        for (int j = 0; j < 2; ++j) { v[2 * j] = (f32x4){lo_bf(cur[j].x), hi_bf(cur[j].x), lo_bf(cur[j].y), hi_bf(cur[j].y)}; v[2 * j + 1] = (f32x4){lo_bf(cur[j].z), hi_bf(cur[j].z), lo_bf(cur[j].w), hi_bf(cur[j].w)}; }
#pragma unroll
        for (int k = 0; k < 4; ++k) s += (v[k].x * v[k].x + v[k].y * v[k].y) + (v[k].z * v[k].z + v[k].w * v[k].w);
        const float rstd = 1.0f / sqrtf(wave_sum(s) * (1.0f / DM) + 1e-6f);
#pragma unroll
        for (int j = 0; j < 2; ++j) { const f32x4 a = v[2 * j] * rstd * g[2 * j], b = v[2 * j + 1] * rstd * g[2 * j + 1];
            v4u o; o.x = cvtpk(a.x, a.y); o.y = cvtpk(a.z, a.w); o.z = cvtpk(b.x, b.y); o.w = cvtpk(b.z, b.w);
            *(v4u*)(dst + (size_t)m * DM + 8 * lane + 512 * j) = o; }
        cur[0] = nxt[0]; cur[1] = nxt[1];
    }
}
template <bool GATES>
__device__ __forceinline__ void norm_phase(Frame& F, const float* src, const float* gain, bf16* dst, const float* wA, const float* bA, float* gout) {
    LAS float* wg = (LAS float*)F.lds;
    if (GATES) {
        for (int i = F.tid; i < 1024 * 8; i += NTHR) wg[i] = wA[(size_t)(i >> 3) * 3080 + 3072 + (i & 7)];
        __syncthreads();
    }
    const int gw = blockIdx.x * NWAVES + F.wave, NGW = F.G * NWAVES, lane = F.lane;
    f32x4 g[4];
#pragma unroll
    for (int j = 0; j < 4; ++j) g[j] = ((const f32x4*)gain)[lane + 64 * j];
    for (int m = gw; m < MTOK; m += NGW) {
        const f32x4* xr = (const f32x4*)(src + (size_t)m * DM) + lane;
        f32x4 v[4]; float s = 0.f;
#pragma unroll
        for (int j = 0; j < 4; ++j) { v[j] = xr[64 * j]; s += (v[j].x * v[j].x + v[j].y * v[j].y) + (v[j].z * v[j].z + v[j].w * v[j].w); }
        const float rstd = 1.0f / sqrtf(wave_sum(s) * (1.0f / DM) + 1e-6f);
        unsigned long long* o8 = (unsigned long long*)(dst + (size_t)m * DM) + lane;
#pragma unroll
        for (int j = 0; j < 4; ++j) { v[j] = v[j] * rstd * g[j];
            o8[64 * j] = (unsigned long long)cvtpk(v[j].x, v[j].y) | ((unsigned long long)cvtpk(v[j].z, v[j].w) << 32); }
        if (GATES) {
            float a[8];
#pragma unroll
            for (int q = 0; q < 8; ++q) a[q] = 0.f;
#pragma unroll
            for (int j = 0; j < 4; ++j)
#pragma unroll
                for (int e = 0; e < 4; ++e) { const int k = 4 * lane + 256 * j + e; const f32x4 w0 = *(const LAS f32x4*)(wg + k * 8), w1 = *(const LAS f32x4*)(wg + k * 8 + 4); const float x = v[j][e];
                    a[0] += x * w0.x; a[1] += x * w0.y; a[2] += x * w0.z; a[3] += x * w0.w; a[4] += x * w1.x; a[5] += x * w1.y; a[6] += x * w1.z; a[7] += x * w1.w; }
#pragma unroll
            for (int q = 0; q < 8; ++q) a[q] = wave_sum(a[q]);
            if (lane == 0) {
#pragma unroll
                for (int q = 0; q < 8; ++q) gout[(size_t)m * 8 + q] = a[q] + bA[q]; }
        }
    }
}

__device__ __forceinline__ void mlstm_pre(Frame& F, const float* gates, float* GT) {
    LAS float* sA = (LAS float*)F.lds, *sPM = sA + 2048, *sBC = sPM + 2048, *sBT = sBC + 2048, *sP63 = sBT + 32, *sM = sP63 + 32;
    const int lane = F.lane, w = F.wave;
    for (int item = blockIdx.x; item < 64; item += F.G) {
        const int b = item >> 2, h = item & 3;
        __syncthreads();
        float gi4[4], gf4[4];
#pragma unroll
        for (int i = 0; i < 4; ++i) { const size_t row = (size_t)b * SEQ + (w + 8 * i) * 64 + lane; gi4[i] = gates[row * 8 + h]; gf4[i] = gates[row * 8 + 4 + h]; }
#pragma unroll
        for (int i = 0; i < 4; ++i) { const int c = w + 8 * i;
            const float gi = gi4[i], gf = gf4[i];
            const float fc = fminf(gf, 0.f) - log1pf(__expf(-fabsf(gf)));
            float bc = fc;
#pragma unroll
            for (int o = 1; o < 64; o <<= 1) { const float t = __shfl_up(bc, o); if (lane >= o) bc += t; }
            const float a = gi - bc; float pm = a;
#pragma unroll
            for (int o = 1; o < 64; o <<= 1) { const float t = __shfl_up(pm, o); if (lane >= o) pm = fmaxf(pm, t); }
            sA[c * 64 + lane] = a; sPM[c * 64 + lane] = pm; sBC[c * 64 + lane] = bc; if (lane == 63) { sBT[c] = bc; sP63[c] = pm; } }
        __syncthreads();
        if (F.tid == 0) { float m = 0.f; for (int c = 0; c < 32; ++c) { sM[c] = m; m = sBT[c] + fmaxf(m, sP63[c]); } }
        __syncthreads();
#pragma unroll
        for (int i = 0; i < 4; ++i) { const int c = w + 8 * i; const float mst = sM[c], Mx = fmaxf(mst, sPM[c * 64 + lane]), Mx63 = fmaxf(mst, sP63[c]);
            float* g = GT + ((size_t)(item * 32 + c)) * 320 + lane;
            g[0] = sA[c * 64 + lane]; g[64] = Mx; g[128] = __expf(mst - Mx); g[192] = __expf(-(sBC[c * 64 + lane] + Mx)); g[256] = __expf(sA[c * 64 + lane] - Mx63); }
    }
}
__device__ __forceinline__ void mlstm_pmat(Frame& F, const bf16* QKV, const float* GT, bf16* PMA, float* DENP) {
    constexpr float SCALE = 0.08838834764831845f;
    LAS bf16* Qs = (LAS bf16*)F.lds;
    LAS bf16* Ks = Qs + 64 * 136;
    LAS bf16* Ps = Ks + 64 * 136;
    LAS float* fA = (LAS float*)(Ps + 64 * 72), *fMX = fA + 64;
    const int tid = F.tid, lane = F.lane, w = F.wave, fr = lane & 15, fq = lane >> 4, wh = w >> 1, wl = w & 1;
    const unsigned qoff0 = (unsigned)((((tid >> 4) * 2048) + (tid & 15) * 8) * 2);
    v4u pQ[2], pK[2]; float pg = 0.f;
    int item = blockIdx.x;
    if (item < 2048) { const int bh = item >> 5, c = item & 31; const char* gq = (const char*)(QKV + ((size_t)(bh >> 2) * SEQ + c * 64) * 2048 + (bh & 3) * 128);
#pragma unroll
        for (int i = 0; i < 2; ++i) { pQ[i] = *(const v4u*)(gq + qoff0 + i * (32 * 2048 * 2)); pK[i] = *(const v4u*)(gq + qoff0 + i * (32 * 2048 * 2) + 1024); }
        if (tid < 128) pg = GT[(size_t)item * 320 + tid]; }
    for (; item < 2048; item += F.G) {
        __syncthreads();
#pragma unroll
        for (int i = 0; i < 2; ++i) { const int id = tid + NTHR * i, row = id >> 4, c8 = id & 15; *(LAS v4u*)(Qs + row * 136 + c8 * 8) = pQ[i]; *(LAS v4u*)(Ks + row * 136 + c8 * 8) = pK[i]; }
        if (tid < 128) fA[tid] = pg;
        const int nit = item + F.G;
        if (nit < 2048) { const int bh = nit >> 5, c = nit & 31; const char* gq = (const char*)(QKV + ((size_t)(bh >> 2) * SEQ + c * 64) * 2048 + (bh & 3) * 128);
#pragma unroll
            for (int i = 0; i < 2; ++i) { pQ[i] = *(const v4u*)(gq + qoff0 + i * (32 * 2048 * 2)); pK[i] = *(const v4u*)(gq + qoff0 + i * (32 * 2048 * 2) + 1024); }
            if (tid < 128) pg = GT[(size_t)nit * 320 + tid]; }
        __syncthreads();
        f32x4 sa[1][2]; sa[0][0] = (f32x4){0.f, 0.f, 0.f, 0.f}; sa[0][1] = sa[0][0];
        wgemm<1, 2, 128, 136, 136>(sa, Qs + 16 * wh * 136, Ks + 32 * wl * 136, lane);
        float rs[4] = {0.f, 0.f, 0.f, 0.f};
#pragma unroll
        for (int e = 0; e < 4; ++e) { const int t = 16 * wh + 4 * fq + e; const float mx = fMX[t];
#pragma unroll
            for (int j = 0; j < 2; ++j) { const int sidx = 32 * wl + 16 * j + fr; const float wgt = (sidx <= t) ? SCALE * __expf(fA[sidx] - mx) : 0.f; const float p = sa[0][j][e] * wgt;
                Ps[t * 72 + sidx] = (bf16)f2bf(p); rs[e] += p; } }
#pragma unroll
        for (int e = 0; e < 4; ++e) { float r = rs[e]; r += __shfl_xor(r, 1); r += __shfl_xor(r, 2); r += __shfl_xor(r, 4); r += __shfl_xor(r, 8); if (fr == 0) DENP[(size_t)item * 128 + wl * 64 + 16 * wh + 4 * fq + e] = r; }
        __syncthreads();
        *(v4u*)(PMA + (size_t)item * 4096 + (tid >> 3) * 64 + (tid & 7) * 8) = *(const LAS v4u*)(Ps + (tid >> 3) * 72 + (tid & 7) * 8);
    }
}
__device__ __forceinline__ void mlstm_core(Frame& F, const bf16* QKV, const float* GT, const bf16* PMA, const float* DENP, bf16* hout, float* ssq) {
    constexpr float SCALE = 0.08838834764831845f;
    LAS bf16* Qs = (LAS bf16*)F.lds;
    LAS bf16* Ks = Qs + 64 * 136;
    LAS bf16* Vs = Ks + 64 * 144;
    LAS bf16* VWs = Vs + 64 * 80;
    LAS bf16* Cb = VWs + 64 * 80;
    LAS bf16* Ps = Cb + 80 * 136;
    LAS bf16* Hs = Ps + 64 * 72;
    const int tid = F.tid, lane = F.lane, w = F.wave, fr = lane & 15, fq = lane >> 4, wh = w >> 1, wl = w & 1;
    const unsigned qoff0 = (unsigned)((((tid >> 4) * 2048) + (tid & 15) * 8) * 2), voff0 = (unsigned)((((tid >> 3) * 2048) + (tid & 7) * 8) * 2);
    for (int item = blockIdx.x; item < 256; item += F.G) {
        const int b = item >> 4, h = (item >> 2) & 3, vs = item & 3, bh = b * 4 + h;
        f32x4 Cacc[1][4], Cn[1][1];
#pragma unroll
        for (int j = 0; j < 4; ++j) Cacc[0][j] = (f32x4){0.f, 0.f, 0.f, 0.f};
        Cn[0][0] = (f32x4){0.f, 0.f, 0.f, 0.f};
        const size_t tb = (size_t)b * SEQ;
        v4u pQ[2], pK[2], pV, pP; float pws, pwc, pwi[4], pem[4], pdn[4];
#define MLSTM_FETCH(cc) do { const size_t t0_ = tb + (size_t)(cc) * 64; const char* gq_ = (const char*)(QKV + t0_ * 2048 + h * 128); const char* gv_ = (const char*)(QKV + t0_ * 2048 + 1024 + h * 256 + vs * 64); \
            _Pragma("unroll") for (int i = 0; i < 2; ++i) { pQ[i] = *(const v4u*)(gq_ + qoff0 + i * (32 * 2048 * 2)); pK[i] = *(const v4u*)(gq_ + qoff0 + i * (32 * 2048 * 2) + 1024); } \
            pV = *(const v4u*)(gv_ + voff0); const size_t it_ = (size_t)(bh * 32 + (cc)); pP = *(const v4u*)(PMA + it_ * 4096 + (tid >> 3) * 64 + (tid & 7) * 8); \
            const float* g_ = GT + it_ * 320; pws = g_[256 + (tid >> 3)]; pwc = g_[128 + 63]; \
            _Pragma("unroll") for (int e = 0; e < 4; ++e) { const int t_ = 16 * wh + 4 * fq + e; pwi[e] = g_[128 + t_]; pem[e] = g_[192 + t_]; pdn[e] = DENP[it_ * 128 + t_] + DENP[it_ * 128 + 64 + t_]; } } while (0)
        MLSTM_FETCH(0);
        for (int c = 0; c < 32; ++c) {
            const size_t t0 = tb + c * 64;
            __syncthreads();
            v4u hprev; if (c > 0) hprev = *(const LAS v4u*)(Hs + (tid >> 3) * 72 + (tid & 7) * 8);
#pragma unroll
            for (int j = 0; j < 4; ++j)
#pragma unroll
                for (int e = 0; e < 4; ++e) Cb[(16 * wh + 4 * fq + e) * 136 + 64 * wl + 16 * j + fr] = (bf16)f2bf(Cacc[0][j][e]);
#pragma unroll
            for (int e = 0; e < 4; ++e) Cb[(64 + 4 * fq + e) * 136 + 16 * w + fr] = (bf16)f2bf(Cn[0][0][e]);
#pragma unroll
            for (int i = 0; i < 2; ++i) { const int id = tid + NTHR * i, row = id >> 4, c8 = id & 15; *(LAS v4u*)(Qs + row * 136 + c8 * 8) = pQ[i]; *(LAS v4u*)(Ks + row * 144 + c8 * 8) = pK[i]; }
            { const int srow = tid >> 3, c8 = tid & 7; const float wsv = pws;
                *(LAS v4u*)(Vs + srow * 80 + c8 * 8) = pV;
                v4u o; o.x = cvtpk(lo_bf(pV.x) * wsv, hi_bf(pV.x) * wsv); o.y = cvtpk(lo_bf(pV.y) * wsv, hi_bf(pV.y) * wsv); o.z = cvtpk(lo_bf(pV.z) * wsv, hi_bf(pV.z) * wsv); o.w = cvtpk(lo_bf(pV.w) * wsv, hi_bf(pV.w) * wsv);
                *(LAS v4u*)(VWs + srow * 80 + c8 * 8) = o;
                if (c8 < 2) { v4u one; one.x = c8 == 0 ? 0x3f80u : 0u; one.y = 0u; one.z = 0u; one.w = 0u; *(LAS v4u*)(Vs + srow * 80 + 64 + c8 * 8) = one;
                    v4u wv; wv.x = c8 == 0 ? (cvtpk(wsv, 0.f) & 0xffffu) : 0u; wv.y = 0u; wv.z = 0u; wv.w = 0u; *(LAS v4u*)(VWs + srow * 80 + 64 + c8 * 8) = wv; }
                *(LAS v4u*)(Ps + srow * 72 + c8 * 8) = pP; }
            float wi[4], em[4], dn[4]; const float wc = pwc;
#pragma unroll
            for (int e = 0; e < 4; ++e) { wi[e] = pwi[e]; em[e] = pem[e]; dn[e] = pdn[e]; }
            if (c < 31) MLSTM_FETCH(c + 1);
            if (c > 0) *(v4u*)(hout + (t0 - 64 + (tid >> 3)) * 1024 + h * 256 + vs * 64 + (tid & 7) * 8) = hprev;
            __syncthreads();
            f32x4 ni[1][2], nx[1][2], nq[1][1]; ni[0][0] = (f32x4){0.f, 0.f, 0.f, 0.f}; ni[0][1] = ni[0][0]; nx[0][0] = ni[0][0]; nx[0][1] = ni[0][0]; nq[0][0] = ni[0][0];
            wgemm<1, 2, 64, 72, 80, false, true>(ni, Ps + 16 * wh * 72, Vs + 32 * wl, lane);
            wgemm<1, 2, 128, 136, 136>(nx, Qs + 16 * wh * 136, Cb + 32 * wl * 136, lane);
            wgemm<1, 1, 128, 136, 136>(nq, Qs + 16 * wh * 136, Cb + 64 * 136, lane);
#pragma unroll
            for (int e = 0; e < 4; ++e) { const int t = 16 * wh + 4 * fq + e;
                const float nqt = __shfl(nq[0][0][e], lane & 48);
                const float den = dn[e] + wi[e] * SCALE * nqt; const float inv = 1.0f / fmaxf(fabsf(den), em[e]); float q2 = 0.f;
#pragma unroll
                for (int j = 0; j < 2; ++j) { const float hv = (ni[0][j][e] + SCALE * wi[e] * nx[0][j][e]) * inv; q2 += hv * hv;
                    Hs[t * 72 + 32 * wl + 16 * j + fr] = (bf16)f2bf(hv); }
                q2 += __shfl_xor(q2, 1); q2 += __shfl_xor(q2, 2); q2 += __shfl_xor(q2, 4); q2 += __shfl_xor(q2, 8);
                if (fr == 0) ssq[(t0 + t) * 32 + (h * 4 + vs) * 2 + wl] = q2; }
#pragma unroll
            for (int j = 0; j < 4; ++j) Cacc[0][j] = Cacc[0][j] * wc;
            Cn[0][0] = Cn[0][0] * wc;
            wgemm<1, 4, 64, 80, 144, true, true>(Cacc, VWs + 16 * wh, Ks + 64 * wl, lane);
            wgemm<1, 1, 64, 80, 144, true, true>(Cn, VWs + 64, Ks + 16 * w, lane);
        }
        __syncthreads();
        *(v4u*)(hout + (tb + 31 * 64 + (tid >> 3)) * 1024 + h * 256 + vs * 64 + (tid & 7) * 8) = *(const LAS v4u*)(Hs + (tid >> 3) * 72 + (tid & 7) * 8);
#undef MLSTM_FETCH
    }
}

__device__ __forceinline__ void moba_prep(Frame& F, bf16* QK, const int* pos, const float* gq, const float* gk, float* kpart) {
    LAS float* part = (LAS float*)F.lds;
    const int lane = F.lane, w = F.wave, c = lane & 15;
    float gqv[8], gkv[8], inv[8];
#pragma unroll
    for (int e = 0; e < 8; ++e) { gqv[e] = gq[c * 8 + e]; gkv[e] = gk[c * 8 + e]; inv[e] = exp2f(-(float)(8 * (c & 1) + e) * (18.931568569324174f / 16.0f)); }
    for (int item = blockIdx.x; item < 256; item += F.G) {
        const int b = item >> 4, blk = (item >> 1) & 7, half = item & 1;
        const size_t row0 = (size_t)b * SEQ + blk * 256 + half * 128 + 16 * w;
        float kacc[2][8];
#pragma unroll
        for (int i = 0; i < 2; ++i)
#pragma unroll
            for (int e = 0; e < 8; ++e) kacc[i][e] = 0.f;
        v4u cur[4], nxt[4];
#pragma unroll
        for (int i4 = 0; i4 < 4; ++i4) cur[i4] = *(const v4u*)(QK + row0 * 3072 + (lane + 64 * i4) * 8);
        for (int t = 0; t < 16; ++t) {
            const size_t row = row0 + t;
            if (t < 15) {
#pragma unroll
                for (int i4 = 0; i4 < 4; ++i4) nxt[i4] = *(const v4u*)(QK + (row + 1) * 3072 + (lane + 64 * i4) * 8); }
            float cs[8], sn[8];
            if (c < 4) { const float ps = (float)pos[row];
#pragma unroll
                for (int e = 0; e < 8; ++e) sincosf(ps * inv[e], &sn[e], &cs[e]); }
            else {
#pragma unroll
                for (int e = 0; e < 8; ++e) { cs[e] = 1.f; sn[e] = 0.f; } }
#pragma unroll
            for (int i4 = 0; i4 < 4; ++i4) {
                const unsigned xw[4] = {cur[i4].x, cur[i4].y, cur[i4].z, cur[i4].w}; float y[8]; float ss = 0.f;
#pragma unroll
                for (int e = 0; e < 4; ++e) { y[2 * e] = lo_bf(xw[e]); y[2 * e + 1] = hi_bf(xw[e]); ss += y[2 * e] * y[2 * e] + y[2 * e + 1] * y[2 * e + 1]; }
                ss += __shfl_xor(ss, 1); ss += __shfl_xor(ss, 2); ss += __shfl_xor(ss, 4); ss += __shfl_xor(ss, 8);
                const float rstd = 1.0f / sqrtf(ss * (1.0f / 128.0f) + 1e-6f);
#pragma unroll
                for (int e = 0; e < 8; ++e) { y[e] = y[e] * rstd * (i4 < 2 ? gqv[e] : gkv[e]); }
#pragma unroll
                for (int e = 0; e < 8; ++e) { const float o = __shfl_xor(y[e], 2); y[e] = (c < 2) ? y[e] * cs[e] - o * sn[e] : (c < 4 ? y[e] * cs[e] + o * sn[e] : y[e]); }
                v4u ov; ov.x = cvtpk(y[0], y[1]); ov.y = cvtpk(y[2], y[3]); ov.z = cvtpk(y[4], y[5]); ov.w = cvtpk(y[6], y[7]);
                *(v4u*)(QK + row * 3072 + (lane + 64 * i4) * 8) = ov;
                if (i4 >= 2) {
#pragma unroll
                    for (int e = 0; e < 8; ++e) kacc[i4 - 2][e] += y[e]; }
            }
#pragma unroll
            for (int i4 = 0; i4 < 4; ++i4) cur[i4] = nxt[i4];
        }
        __syncthreads();
#pragma unroll
        for (int i = 0; i < 2; ++i)
#pragma unroll
            for (int e = 0; e < 8; ++e) part[w * 1024 + i * 512 + lane * 8 + e] = kacc[i][e];
        __syncthreads();
        for (int col = F.tid; col < 1024; col += NTHR) { float sacc = 0.f;
#pragma unroll
            for (int ww = 0; ww < 8; ++ww) sacc += part[ww * 1024 + col];
            kpart[((size_t)(b * 8 + blk) * 2 + half) * 1024 + col] = sacc * (1.0f / 256.0f); }
    }
}
__device__ __forceinline__ void moba_attn(Frame& F, const bf16* QKV, const float* kpart, bf16* O) {
    char* ldsg = (char*)F.lds;
    LAS float* kmS = (LAS float*)(F.lds + mattn::SHM_ATTN);
    for (int it = blockIdx.x; it < 1024; it += F.G) {
        int tid_ = threadIdx.x; asm volatile("" : "+v"(tid_));
        const int tid = tid_, lane = tid & 63, w = __builtin_amdgcn_readfirstlane(tid >> 6), r32 = lane & 31, hi = lane >> 5;
        const int c = it & 255, r = it >> 8, bh = c & 127, typ = c >> 7, b = bh >> 3, h = bh & 7;
        const int jb = (r & 1) ? 7 - (r >> 1) : (r >> 1);
        const int j = typ ? ((r & 1) ? jb - 2 : jb + 2) : jb;
        const size_t qrow0 = (size_t)b * SEQ + j * 256;
        __syncthreads();
        for (int i = tid; i < 1024; i += NTHR) { const int kb_ = i >> 7, d_ = i & 127; const float* kp = kpart + ((size_t)(b * 8 + kb_) * 2) * 1024 + h * 128 + d_; kmS[i] = kp[0] + kp[1024]; }
        mattn::bf16x8 qr[8];
        { const bf16* Qw = QKV + (qrow0 + w * 32 + r32) * 3072 + h * 128 + hi * 8;
#pragma unroll
            for (int d0 = 0; d0 < 8; ++d0) qr[d0] = *(const mattn::bf16x8*)(Qw + d0 * 16); }
        __syncthreads();
        unsigned sel = 0u;
        if (j <= 3) sel = (1u << j) - 1u;
        else { float v0 = -INFINITY, v1 = -INFINITY, v2 = -INFINITY; int i0 = 0, i1 = 0, i2 = 0;
#pragma unroll 1
            for (int blk = 0; blk < j; ++blk) { float sdot = 0.f; const LAS float* km = kmS + blk * 128 + hi * 8;
#pragma unroll
                for (int d0 = 0; d0 < 8; ++d0) asm volatile("" : "+v"(qr[d0]));
#pragma unroll
                for (int d0 = 0; d0 < 8; ++d0) {
#pragma unroll
                    for (int e = 0; e < 8; ++e) sdot += __uint_as_float(((unsigned)(unsigned short)qr[d0][e]) << 16) * km[d0 * 16 + e];
                    __builtin_amdgcn_sched_barrier(0); }
                auto rr = __builtin_amdgcn_permlane32_swap(__float_as_uint(sdot), __float_as_uint(sdot), false, false);
                sdot = __uint_as_float(rr[0]) + __uint_as_float(rr[1]);
                if (sdot > v0) { v2 = v1; i2 = i1; v1 = v0; i1 = i0; v0 = sdot; i0 = blk; }
                else if (sdot > v1) { v2 = v1; i2 = i1; v1 = sdot; i1 = blk; }
                else if (sdot > v2) { v2 = sdot; i2 = blk; } }
            sel = (1u << i0) | (1u << i1) | (1u << i2); }
        const mattn::Msk mk{j, sel, w * 32 + r32};
        const bf16* Kh = QKV + ((size_t)b * SEQ) * 3072 + 1024 + h * 128;
        mattn::body(qr, Kh, Kh + 1024, O + qrow0 * 1024 + h * 128, (j + 1) * 256, ldsg, mk);
    }
}

__device__ __forceinline__ void ret_rot_table(Frame& F, const int* pos, float* cst) {
    const int gw = blockIdx.x * NWAVES + F.wave, NGW = F.G * NWAVES, lane = F.lane;
    const float i0 = exp2f(-(float)(2 * lane) * (13.287712379549449f / 128.0f)), i1 = exp2f(-(float)(2 * lane + 1) * (13.287712379549449f / 128.0f));
    for (int m = gw; m < MTOK; m += NGW) {
        const float ps = (float)pos[m]; float s0, c0, s1, c1; sincosf(ps * i0, &s0, &c0); sincosf(ps * i1, &s1, &c1);
        f32x2* cp = (f32x2*)(cst + (size_t)m * 256) + lane; cp[0] = (f32x2){c0, c1}; cp[64] = (f32x2){s0, s1};
    }
}
__device__ __forceinline__ void ret_pmat(Frame& F, const bf16* QKV, bf16* PM) {
    LAS bf16* Qd = (LAS bf16*)F.lds;
    LAS bf16* Kd = Qd + 128 * 72;
    LAS bf16* Ps = Kd + 128 * 72;
    const int tid = F.tid, lane = F.lane, w = F.wave, fr = lane & 15, fq = lane >> 4, wh = w >> 1, wl = w & 1;
    const unsigned off0 = (unsigned)((((tid >> 3) * 4096) + (tid & 7) * 8) * 2);
    for (int item = blockIdx.x; item < 1024; item += F.G) {
        const int b = item >> 6, h = (item >> 4) & 3, c = item & 15;
        const float lgc = log1pf(-exp2f(-5.0f - (float)h)) * 1.4426950408889634f;
        const char* gq = (const char*)(QKV + ((size_t)b * SEQ + c * 128) * 4096 + h * 256);
        v4u pq[2], pkk[2];
#pragma unroll
        for (int i = 0; i < 2; ++i) { const char* src = gq + off0 + i * (64 * 4096 * 2); pq[i] = *(const v4u*)src; pkk[i] = *(const v4u*)(src + 2048); }
        f32x4 S[2][4];
#pragma unroll
        for (int i = 0; i < 2; ++i)
#pragma unroll
            for (int jj = 0; jj < 4; ++jj) S[i][jj] = (f32x4){0.f, 0.f, 0.f, 0.f};
#pragma unroll 1
        for (int dt = 0; dt < 4; ++dt) {
            __syncthreads();
#pragma unroll
            for (int i = 0; i < 2; ++i) { const int id = tid + NTHR * i, row = id >> 3, c8 = id & 7; *(LAS v4u*)(Qd + row * 72 + c8 * 8) = pq[i]; *(LAS v4u*)(Kd + row * 72 + c8 * 8) = pkk[i]; }
            if (dt < 3) {
#pragma unroll
                for (int i = 0; i < 2; ++i) { const char* src = gq + (dt + 1) * 128 + off0 + i * (64 * 4096 * 2); pq[i] = *(const v4u*)src; pkk[i] = *(const v4u*)(src + 2048); } }
            __syncthreads();
            wgemm<2, 4, 64, 72, 72>(S, Qd + 32 * wh * 72, Kd + 64 * wl * 72, lane);
        }
#pragma unroll
        for (int i = 0; i < 2; ++i)
#pragma unroll
            for (int e = 0; e < 4; ++e) { const int t = 32 * wh + 16 * i + 4 * fq + e;
#pragma unroll
                for (int jj = 0; jj < 4; ++jj) { const int sidx = 64 * wl + 16 * jj + fr; const float wgt = (t >= sidx) ? __builtin_amdgcn_exp2f((float)(t - sidx) * lgc) : 0.f;
                    Ps[t * 136 + sidx] = (bf16)f2bf(S[i][jj][e] * wgt); } }
        __syncthreads();
        bf16* dst = PM + (size_t)item * 128 * 128;
#pragma unroll
        for (int i = 0; i < 4; ++i) { const int id = tid + NTHR * i, row = id >> 4, c8 = id & 15; *(v4u*)(dst + row * 128 + c8 * 8) = *(const LAS v4u*)(Ps + row * 136 + c8 * 8); }
    }
}
#ifndef RET_EXP
#define RET_EXP 0
#endif
__device__ __forceinline__ void ret_core(Frame& F, bf16* QKV, const bf16* PM, float* st) {
    constexpr int TSET = 3 * 128 * 72;
    LAS bf16* T0 = (LAS bf16*)F.lds;
    LAS bf16* Vs = T0 + 2 * TSET;
    LAS bf16* Ps = T0;
    LAS bf16* Xs = T0 + TSET;
    LAS float* fST = (LAS float*)(Vs + 128 * 144);
    const int tid = F.tid, lane = F.lane, w = F.wave, fr = lane & 15, fq = lane >> 4, wh = w >> 1, wl = w & 1;
    const unsigned off8 = (unsigned)((((tid >> 3) * 4096) + (tid & 7) * 8) * 2);
    const unsigned off16 = (unsigned)((((tid >> 4) * 4096) + (tid & 15) * 8) * 2);
    for (int item = blockIdx.x; item < 256; item += F.G) {
        const int b = item >> 4, h = (item >> 2) & 3, vs = item & 3;
        const float lg = log1pf(-exp2f(-5.0f - (float)h)), gch = expf(128.0f * lg);
        f32x4 Racc[4][1][4];
#pragma unroll
        for (int dt = 0; dt < 4; ++dt)
#pragma unroll
            for (int jj = 0; jj < 4; ++jj) Racc[dt][0][jj] = (f32x4){0.f, 0.f, 0.f, 0.f};
        const size_t tb = (size_t)b * SEQ;
        __syncthreads();
        v4u pq[2], pkk[2], pv[4];
        { const char* gq0 = (const char*)(QKV + tb * 4096 + h * 256); const char* gv0 = (const char*)(QKV + tb * 4096 + 2048 + h * 512 + vs * 128);
#pragma unroll
            for (int i = 0; i < 2; ++i) { const char* src = gq0 + off8 + i * (64 * 4096 * 2); pq[i] = *(const v4u*)src; pkk[i] = *(const v4u*)(src + 2048); }
#pragma unroll
            for (int i = 0; i < 4; ++i) pv[i] = *(const v4u*)(gv0 + off16 + i * (32 * 4096 * 2)); }
        for (int c = 0; c < 16; ++c) {
            const size_t t0 = tb + c * 128;
            const char* gq = (const char*)(QKV + t0 * 4096 + h * 256);
            char* gy = (char*)(QKV + t0 * 4096 + 2048 + h * 512 + vs * 128);
            const bf16* pmt = PM + ((size_t)((b * 4 + h) * 16 + c)) * 128 * 128;
            float lgc = lg * 1.4426950408889634f; asm volatile("" : "+v"(lgc));
#pragma unroll
            for (int i = 0; i < 4; ++i) { const int id = tid + NTHR * i; *(LAS v4u*)(Vs + (id >> 4) * 144 + (id & 15) * 8) = pv[i]; }
            f32x4 X[2][4];
#pragma unroll
            for (int i = 0; i < 2; ++i)
#pragma unroll
                for (int jj = 0; jj < 4; ++jj) X[i][jj] = (f32x4){0.f, 0.f, 0.f, 0.f};
#pragma unroll 1
            for (int dt = 0; dt < 4; ++dt) {
                LAS bf16* Qd = T0 + (dt & 1) * TSET; LAS bf16* Kz = Qd + 128 * 72; LAS bf16* Rb = Kz + 128 * 72;
#pragma unroll
                for (int i = 0; i < 2; ++i) { const int id = tid + NTHR * i, row = id >> 3, c8 = id & 7; const float z = __builtin_amdgcn_exp2f((float)(127 - row) * lgc);
                    *(LAS v4u*)(Qd + row * 72 + c8 * 8) = pq[i];
                    v4u zo; zo.x = cvtpk(lo_bf(pkk[i].x) * z, hi_bf(pkk[i].x) * z); zo.y = cvtpk(lo_bf(pkk[i].y) * z, hi_bf(pkk[i].y) * z); zo.z = cvtpk(lo_bf(pkk[i].z) * z, hi_bf(pkk[i].z) * z); zo.w = cvtpk(lo_bf(pkk[i].w) * z, hi_bf(pkk[i].w) * z);
                    *(LAS v4u*)(Kz + row * 72 + c8 * 8) = zo; }
#pragma unroll
                for (int jj = 0; jj < 4; ++jj)
#pragma unroll
                    for (int e = 0; e < 4; ++e) Rb[(16 * w + 4 * fq + e) * 72 + 16 * jj + fr] = (bf16)f2bf(Racc[0][0][jj][e]);
#if RET_EXP == 3
                asm volatile("" ::: "memory");
#pragma unroll
                for (int jj = 0; jj < 4; ++jj)
#pragma unroll
                    for (int e = 0; e < 4; ++e) *(volatile LAS bf16*)(Rb + (16 * w + 4 * fq + e) * 72 + 16 * jj + fr) = (bf16)f2bf(Racc[0][0][jj][e]);
#endif
                if (dt < 3 || c < 15) {
                    const char* nb = (dt < 3) ? gq + (dt + 1) * 128 : gq + (size_t)128 * 4096 * 2;
#pragma unroll
                    for (int i = 0; i < 2; ++i) { const char* src = nb + off8 + i * (64 * 4096 * 2); pq[i] = *(const v4u*)src; pkk[i] = *(const v4u*)(src + 2048); } }
                __syncthreads();
                wgemm<2, 4, 64, 72, 72, false, false, false>(X, Qd + 32 * wh * 72, Rb + 64 * wl * 72, lane);
#if RET_EXP == 5
                { f32x4 D_[2][4];
#pragma unroll
                  for (int i = 0; i < 2; ++i)
#pragma unroll
                    for (int jj = 0; jj < 4; ++jj) D_[i][jj] = (f32x4){0.f, 0.f, 0.f, 0.f};
                  wgemm<2, 4, 64, 72, 72>(D_, Qd + 32 * wh * 72, Rb + 64 * wl * 72, lane);
#pragma unroll
                  for (int i = 0; i < 2; ++i)
#pragma unroll
                    for (int jj = 0; jj < 4; ++jj) asm volatile("" :: "v"(D_[i][jj])); }
#endif
#if RET_EXP == 6
                { f32x4 D_[1][4];
#pragma unroll
                    for (int jj = 0; jj < 4; ++jj) D_[0][jj] = (f32x4){0.f, 0.f, 0.f, 0.f};
                  wgemm<1, 4, 128, 136, 72, true, true>(D_, Vs + 16 * w, Kz, lane);
#pragma unroll
                    for (int jj = 0; jj < 4; ++jj) asm volatile("" :: "v"(D_[0][jj])); }
#endif
#pragma unroll
                for (int jj = 0; jj < 4; ++jj) Racc[0][0][jj] = Racc[0][0][jj] * gch;
                wgemm<1, 4, 128, 144, 72, true, true, false>(Racc[0], Vs + 16 * w, Kz, lane);
#pragma unroll
                for (int jj = 0; jj < 4; ++jj) { const f32x4 t_ = Racc[0][0][jj]; Racc[0][0][jj] = Racc[1][0][jj]; Racc[1][0][jj] = Racc[2][0][jj]; Racc[2][0][jj] = Racc[3][0][jj]; Racc[3][0][jj] = t_; }
            }
            v4u pp[4];
#pragma unroll
            for (int i = 0; i < 4; ++i) { const int id = tid + NTHR * i; pp[i] = *(const v4u*)(pmt + (id >> 4) * 128 + (id & 15) * 8); }
#if RET_EXP == 2
            asm volatile("s_waitcnt vmcnt(0)" ::: "memory");
#pragma unroll
            for (int i = 0; i < 4; ++i) { const int id = tid + NTHR * i; v4u q_ = *(const volatile v4u*)(pmt + 64 * 128 * 128 + (id >> 4) * 128 + (id & 15) * 8); asm volatile("" :: "v"(q_.x), "v"(q_.y), "v"(q_.z), "v"(q_.w)); }
            asm volatile("s_waitcnt vmcnt(0)" ::: "memory");
#endif
#pragma unroll
            for (int i = 0; i < 2; ++i)
#pragma unroll
                for (int e = 0; e < 4; ++e) { const int t = 32 * wh + 16 * i + 4 * fq + e; const float xi = __builtin_amdgcn_exp2f((float)(t + 1) * lgc);
#pragma unroll
                    for (int jj = 0; jj < 4; ++jj) X[i][jj][e] *= xi; }
#pragma unroll
            for (int i = 0; i < 4; ++i) { const int id = tid + NTHR * i; *(LAS v4u*)(Ps + (id >> 4) * 136 + (id & 15) * 8) = pp[i]; }
            __syncthreads();
            wgemm<2, 4, 128, 136, 144, false, true, false>(X, Ps + 32 * wh * 136, Vs + 64 * wl, lane);
#pragma unroll
            for (int i = 0; i < 2; ++i)
#pragma unroll
                for (int e = 0; e < 4; ++e) { const int t = 32 * wh + 16 * i + 4 * fq + e; float s1 = 0.f, s2 = 0.f;
#pragma unroll
                    for (int jj = 0; jj < 4; ++jj) { const float y = X[i][jj][e]; s1 += y; s2 += y * y; Xs[t * 136 + 64 * wl + 16 * jj + fr] = (bf16)f2bf(y); }
                    s1 += __shfl_xor(s1, 1); s1 += __shfl_xor(s1, 2); s1 += __shfl_xor(s1, 4); s1 += __shfl_xor(s1, 8);
                    s2 += __shfl_xor(s2, 1); s2 += __shfl_xor(s2, 2); s2 += __shfl_xor(s2, 4); s2 += __shfl_xor(s2, 8);
                    if (fr == 0) { fST[(wl * 128 + t) * 2] = s1; fST[(wl * 128 + t) * 2 + 1] = s2; } }
            if (c < 15) { const char* gvn = gy + (size_t)128 * 4096 * 2;
#pragma unroll
                for (int i = 0; i < 4; ++i) pv[i] = *(const v4u*)(gvn + off16 + i * (32 * 4096 * 2)); }
            __syncthreads();
#pragma unroll
            for (int i = 0; i < 4; ++i) { const int id = tid + NTHR * i, row = id >> 4, c8 = id & 15; *(v4u*)(gy + (unsigned)((row * 4096 + c8 * 8) * 2)) = *(const LAS v4u*)(Xs + row * 136 + c8 * 8); }
            if (tid < 128) { float* sp = st + (t0 + tid) * 32 + (h * 4 + vs) * 2; sp[0] = fST[tid * 2] + fST[(128 + tid) * 2]; sp[1] = fST[tid * 2 + 1] + fST[(128 + tid) * 2 + 1]; }
        }
    }
}

__device__ __forceinline__ void lru_conv(Frame& F, const bf16* GX, const float* cw, const float* cb, bf16* XC, const float* lru, float* sptab) {
    if (blockIdx.x == 0) for (int i = F.tid; i < 1024; i += NTHR) { const float l = -lru[i]; sptab[i] = fmaxf(l, 0.f) + log1pf(expf(-fabsf(l))); }
    const int c8 = F.tid & 127, rsub = F.tid >> 7;
    f32x4 w0[4], w1[4];
#pragma unroll
    for (int wv = 0; wv < 4; ++wv) { w0[wv] = *(const f32x4*)(cw + wv * 1024 + c8 * 8); w1[wv] = *(const f32x4*)(cw + wv * 1024 + c8 * 8 + 4); }
    const f32x4 b0 = *(const f32x4*)(cb + c8 * 8), b1 = *(const f32x4*)(cb + c8 * 8 + 4);
    for (int r0 = blockIdx.x * 16; r0 < MTOK; r0 += F.G * 16) {
        const int rb = r0 + 4 * rsub, t = rb & (SEQ - 1);
        v4u xin[7];
#pragma unroll
        for (int k = 0; k < 7; ++k) { const int rr = rb - 3 + k; xin[k] = (t - 3 + k >= 0) ? *(const v4u*)(GX + (size_t)rr * 2048 + 1024 + c8 * 8) : (v4u){0u, 0u, 0u, 0u}; }
#pragma unroll
        for (int q = 0; q < 4; ++q) { f32x4 a0 = b0, a1 = b1;
#pragma unroll
            for (int wv = 0; wv < 4; ++wv) { const v4u x = xin[q + wv];
                a0 += (f32x4){lo_bf(x.x), hi_bf(x.x), lo_bf(x.y), hi_bf(x.y)} * w0[wv]; a1 += (f32x4){lo_bf(x.z), hi_bf(x.z), lo_bf(x.w), hi_bf(x.w)} * w1[wv]; }
            v4u o; o.x = cvtpk(a0[0], a0[1]); o.y = cvtpk(a0[2], a0[3]); o.z = cvtpk(a1[0], a1[1]); o.w = cvtpk(a1[2], a1[3]);
            *(v4u*)(XC + (size_t)(rb + q) * 1024 + c8 * 8) = o; }
    }
}
__device__ __forceinline__ float gelu_tanh(float x) { const float z = 0.7978845608028654f * (x + 0.044715f * x * x * x); const float e = __expf(2.0f * z); const float th = 1.0f - 2.0f * __builtin_amdgcn_rcpf(e + 1.0f); return 0.5f * x * (1.0f + th); }
__device__ __forceinline__ void lru_scan(Frame& F, const bf16* LA, const bf16* BT, const bf16* GX, bf16* Y) {
    LAS float* segL = (LAS float*)F.lds;
    LAS float* segH = segL + 512;
    const int lane = F.lane, w = F.wave;
    for (int item = blockIdx.x; item < 256; item += F.G) {
        const int b = item >> 4, ch = (item & 15) * 64 + lane;
        const size_t r0 = (size_t)b * SEQ + w * 256;
        const bf16* la_p = LA + r0 * 1024 + ch; const bf16* bt_p = BT + r0 * 1024 + ch; const bf16* gx_p = GX + r0 * 2048 + ch; bf16* y_p = Y + r0 * 1024 + ch;
        float L = 0.f, H = 0.f;
        bf16 la0[16], bt0[16], la1[16], bt1[16];
#pragma unroll
        for (int k = 0; k < 16; ++k) { la0[k] = la_p[(size_t)k * 1024]; bt0[k] = bt_p[(size_t)k * 1024]; }
#pragma unroll 1
        for (int tb = 0; tb < 16; tb += 2) {
#pragma unroll
            for (int k = 0; k < 16; ++k) { la1[k] = la_p[(size_t)((tb + 1) * 16 + k) * 1024]; bt1[k] = bt_p[(size_t)((tb + 1) * 16 + k) * 1024]; }
#pragma unroll
            for (int k = 0; k < 16; ++k) { const float la = bf2f(la0[k]); L += la; H = __expf(la) * H + bf2f(bt0[k]); }
            if (tb + 2 < 16) {
#pragma unroll
                for (int k = 0; k < 16; ++k) { la0[k] = la_p[(size_t)((tb + 2) * 16 + k) * 1024]; bt0[k] = bt_p[(size_t)((tb + 2) * 16 + k) * 1024]; } }
#pragma unroll
            for (int k = 0; k < 16; ++k) { const float la = bf2f(la1[k]); L += la; H = __expf(la) * H + bf2f(bt1[k]); }
        }
        __syncthreads();
        segL[w * 64 + lane] = L; segH[w * 64 + lane] = H;
        __syncthreads();
        float hc = 0.f;
        for (int sg = 0; sg < w; ++sg) hc = __expf(segL[sg * 64 + lane]) * hc + segH[sg * 64 + lane];
        bf16 g0[16], g1[16];
#pragma unroll
        for (int k = 0; k < 16; ++k) { la0[k] = la_p[(size_t)k * 1024]; bt0[k] = bt_p[(size_t)k * 1024]; g0[k] = gx_p[(size_t)k * 2048]; }
#pragma unroll
        for (int k = 0; k < 16; ++k) { const size_t t = (size_t)(16 + k); la1[k] = la_p[t * 1024]; bt1[k] = bt_p[t * 1024]; g1[k] = gx_p[t * 2048]; }
#pragma unroll 1
        for (int tb = 0; tb < 16; tb += 2) {
            bf16 yv[16];
#pragma unroll
            for (int k = 0; k < 16; ++k) { hc = __expf(bf2f(la0[k])) * hc + bf2f(bt0[k]); yv[k] = (bf16)f2bf(hc * gelu_tanh(bf2f(g0[k]))); }
            if (tb + 2 < 16) {
#pragma unroll
                for (int k = 0; k < 16; ++k) { const size_t t = (size_t)((tb + 2) * 16 + k); la0[k] = la_p[t * 1024]; bt0[k] = bt_p[t * 1024]; g0[k] = gx_p[t * 2048]; } }
#pragma unroll
            for (int k = 0; k < 16; ++k) y_p[(size_t)(tb * 16 + k) * 1024] = yv[k];
#pragma unroll
            for (int k = 0; k < 16; ++k) { hc = __expf(bf2f(la1[k])) * hc + bf2f(bt1[k]); yv[k] = (bf16)f2bf(hc * gelu_tanh(bf2f(g1[k]))); }
            if (tb + 3 < 16) {
#pragma unroll
                for (int k = 0; k < 16; ++k) { const size_t t = (size_t)((tb + 3) * 16 + k); la1[k] = la_p[t * 1024]; bt1[k] = bt_p[t * 1024]; g1[k] = gx_p[t * 2048]; } }
#pragma unroll
            for (int k = 0; k < 16; ++k) y_p[(size_t)((tb + 1) * 16 + k) * 1024] = yv[k];
        }
    }
}

#ifndef WGM_BIG
#define WGM_BIG 8
#endif
#ifndef WGM_N4
#define WGM_N4 4
#endif
#ifndef WGM_MID
#define WGM_MID 8
#endif
template <class Epi>
__device__ __forceinline__ void run_gemm(Frame& F, const bf16* A, int lda, const bf16* Bt, int ldb, int N, int K, const Epi& E, int M = MTOK, int ablk = 0) {
    pg8::Gemm g{A, Bt, M, N, K, lda, ldb, ablk}; pg8::StaticOrder S; S.init(M, N, F.G, (int)blockIdx.x, (N >= 4096) ? WGM_BIG : (N <= 1024 ? WGM_N4 : WGM_MID));
#ifndef STAGGER_NG
#define STAGGER_NG 1
#endif
#ifndef STAGGER_STEP
#define STAGGER_STEP 300
#endif
    if (STAGGER_NG > 1 && N >= 4096 && M == MTOK) {
        const unsigned grp = (((unsigned)blockIdx.x >> 3) & 7u) / (8 / STAGGER_NG);
        if (grp) { const unsigned long long t0 = __builtin_amdgcn_s_memrealtime(), dl = (unsigned long long)grp * STAGGER_STEP;
            while (__builtin_amdgcn_s_memrealtime() - t0 < dl) __builtin_amdgcn_s_sleep(8); }
    }
#ifndef FUSE_NX
#define FUSE_NX false
#endif
#ifndef GEMM_ALIGN
#define GEMM_ALIGN true
#endif
#ifndef GEMM_SP2
#define GEMM_SP2 true
#endif
    pg8::gemm_phase<Epi, pg8::StaticOrder, GEMM_ALIGN, GEMM_SP2>(F.lds, g, S, E);
}

typedef const __attribute__((address_space(4))) struct Args* ArgsP;
constexpr int NPHASE = 35;
__device__ __forceinline__ ArgsP get_args() { ArgsP p = (ArgsP)__builtin_amdgcn_kernarg_segment_ptr(); asm volatile("" : "+s"(p)); return p; }
__device__ __forceinline__ bool in_phase(int k) { ArgsP a = get_args(); return a->ph_lo <= k && k < a->ph_hi; }
#ifndef DUP_PHASE
#define DUP_PHASE -1
#endif
#ifndef BAR_EXP
#define BAR_EXP 0
#endif
#ifndef TIMING_MASK
#define TIMING_MASK 0ull
#endif
#define TMISC ((volatile LAS unsigned long long*)((LAS unsigned char*)lds_raw + MISC_OFF))
#define TB(k) do { if (((TIMING_MASK >> (k)) & 1ull) && blockIdx.x == 0 && threadIdx.x == 0) TMISC[0] = __builtin_amdgcn_s_memrealtime(); } while (0)
#define TE(k) do { if (((TIMING_MASK >> (k)) & 1ull) && blockIdx.x == 0 && threadIdx.x == 0) TMISC[1] = TMISC[1] + (__builtin_amdgcn_s_memrealtime() - TMISC[0]); } while (0)
#define REP(k) TB(k); for (int rep_ = 0; rep_ < ((k) == DUP_PHASE ? 2 : 1); ++rep_)
#define AP ArgsP ap = get_args(); { int t_ = threadIdx.x; asm volatile("" : "+v"(t_)); F.tid = t_; F.lane = t_ & 63; F.wave = __builtin_amdgcn_readfirstlane(t_ >> 6); F.G = gridDim.x; F.lds = (LAS unsigned char*)lds_raw; }
__global__ void __launch_bounds__(NTHR, 2) trunk_fwd(Args args) {
    extern __shared__ __attribute__((aligned(16))) unsigned char lds_raw[];
    Frame F; F.lds = (LAS unsigned char*)lds_raw; F.tid = threadIdx.x; F.lane = F.tid & 63; F.wave = __builtin_amdgcn_readfirstlane(F.tid >> 6); F.G = gridDim.x;
    volatile LAS unsigned* MISC = (volatile LAS unsigned*)(F.lds + MISC_OFF);
    if (F.tid < 16) MISC[F.tid] = 0u;
    __syncthreads();
    if (args.ph_hi - args.ph_lo > 1) (void)xcd_barrier_post((unsigned*)(args.ws + WS_CTL) + CW_BAR, MISC + 8);
#ifndef ONLY_PHASE
#define ONLY_PHASE -1
#endif
#define IN(k) ((ONLY_PHASE < 0 || (k) == ONLY_PHASE) && in_phase(k))
#define SEAM(k) do { if (IN(k) && IN((k) + 1)) { XcdBarrier bb; bb.bar = (unsigned*)(get_args()->ws + WS_CTL) + CW_BAR; bb.x = xb_xcc_id(); bb.st = (volatile LAS unsigned*)((LAS unsigned char*)lds_raw + MISC_OFF) + 8; xcd_barrier(bb); if (BAR_EXP) xcd_barrier(bb); } if (IN(k)) TE(k); } while (0)
#define XIN ((const float*)ap->in[0])
#define pos ((const int*)ap->in[1])
#define norm_mix ((const float*)ap->in[2])
#define norm_ffn ((const float*)ap->in[3])
#define ffn_w_in ((const float*)ap->in[4])
#define ffn_w_out ((const float*)ap->in[5])
#define out (ap->out)
#define Wmi ((bf16*)(ap->ws + WS_W_MIXIN))
#define Wmo ((bf16*)(ap->ws + WS_W_MIXOUT))
#define Wfi ((bf16*)(ap->ws + WS_W_FFNIN))
#define Wfo ((bf16*)(ap->ws + WS_W_FFNOUT))
#define U ((bf16*)(ap->ws + WS_U))
#define BIG ((bf16*)(ap->ws + WS_BIG))
#define gatesA ((float*)(ap->ws + WS_GATESA))
#define ssqA ((float*)(ap->ws + WS_SSQA))
#define statC ((float*)(ap->ws + WS_STATC))
#define kmean ((float*)(ap->ws + WS_KMEAN))
#define sptab ((float*)(ap->ws + WS_SPTAB))
#define ssqH ((float*)(ap->ws + WS_SSQH))

#define a_w_in ((const float*)ap->in[6])
#define a_b ((const float*)ap->in[7])
#define a_g ((const float*)ap->in[8])
#define a_w_out ((const float*)ap->in[9])
#define b_w_in ((const float*)ap->in[10])
#define b_gq ((const float*)ap->in[11])
#define b_gk ((const float*)ap->in[12])
#define b_w_out ((const float*)ap->in[13])
#define c_w_in ((const float*)ap->in[14])
#define c_g ((const float*)ap->in[15])
#define c_w_out ((const float*)ap->in[16])
#define d_w_in ((const float*)ap->in[17])
#define d_cw ((const float*)ap->in[18])
#define d_cb ((const float*)ap->in[19])
#define d_wg ((const float*)ap->in[20])
#define d_bg ((const float*)ap->in[21])
#define d_lru ((const float*)ap->in[22])
#define d_w_out ((const float*)ap->in[23])
#define GX BIG
#define XC (BIG + (size_t)MTOK * 2048)
#define LA (BIG + (size_t)MTOK * 3072)
#define BT (BIG + (size_t)MTOK * 4096)
#define Y (BIG + (size_t)MTOK * 3072)
#define HB (BIG + (size_t)MTOK * 5120)
#define Wg (Wmi + (size_t)2048 * DM)
#define FFN_CVT(l) do { cvt_matrix(F, ffn_w_in + (size_t)(l) * DM * 2 * DFF, 2 * DFF, DM, 2 * DFF, 1, Wfi, norm_ffn + (l) * DM); cvt_matrix(F, ffn_w_out + (size_t)(l) * DFF * DM, DM, DFF, DM, 0, Wfo); } while (0)
#define RED ((PG8_LAS float*)(F.lds + 131072))
#define FFN_PHASES(p0, l) do { \
    if (IN((p0) + 1)) { AP; REP((p0) + 1) { pg8::EpiSwiGLU<true> E{BIG, DFF, ssqH}; run_gemm(F, HB, DM, Wfi, DM, 2 * DFF, DM, E); } } SEAM((p0) + 1); \
    if (IN((p0) + 2)) { AP; REP((p0) + 2) { if ((l) < 3) { pg8::EpiResidB<true, true> E{HB, HB, ssqH, RED}; run_gemm(F, BIG, DFF, Wfo, DFF, DM, DFF, E); } else { pg8::EpiResidF E{HB, out}; run_gemm(F, BIG, DFF, Wfo, DFF, DM, DFF, E); } } } SEAM((p0) + 2); } while (0)
#define QKV BIG
#define HO (BIG + (size_t)MTOK * 2048)
#define PMAB (BIG + (size_t)MTOK * 3072)
#define GTB ((float*)(BIG + (size_t)MTOK * 3584))
#define DENB ((float*)(BIG + (size_t)MTOK * 3584) + 2048 * 320)
    if (IN(0)) { AP; REP(0) { cvt_matrix(F, a_w_in, 3080, DM, 3072, 0, Wmi); cvt_matrix(F, a_w_out, DM, DM, DM, 0, Wmo); FFN_CVT(0);
        __syncthreads(); norm_phase<true>(F, XIN, norm_mix, U, a_w_in, a_b, gatesA); } } SEAM(0);
    if (IN(1)) { AP; REP(1) { mlstm_pre(F, gatesA, GTB); __syncthreads(); pg8::EpiStore<false> E{QKV, 2048, nullptr}; run_gemm(F, U, DM, Wmi, DM, 2048, DM, E); } } SEAM(1);
    if (IN(2)) { AP; REP(2) { mlstm_pmat(F, QKV, GTB, PMAB, DENB); } } SEAM(2);
    if (IN(3)) { AP; REP(3) { mlstm_core(F, QKV, GTB, PMAB, DENB, HO, ssqA); } } SEAM(3);
    if (IN(4)) { AP; REP(4) { pg8::EpiGateA E{HO, ssqA, a_g}; run_gemm(F, U, DM, Wmi + (size_t)2048 * DM, DM, DM, DM, E); } } SEAM(4);
    if (IN(5)) { AP; REP(5) { pg8::EpiResidB<false, true> E{XIN, HB, ssqH, RED}; run_gemm(F, HO, DM, Wmo, DM, DM, DM, E); } } SEAM(5);
    FFN_PHASES(6, 0);
#define OB (BIG + (size_t)MTOK * 3072)
#define VTB (BIG + (size_t)MTOK * 2048)
    if (IN(9)) { AP; REP(9) { cvt_matrix(F, b_w_in, 3072, DM, 3072, 0, Wmi, norm_mix + DM); cvt_matrix(F, b_w_out, DM, DM, DM, 0, Wmo); FFN_CVT(1); } } SEAM(9);
    if (IN(10)) { AP; REP(10) { pg8::EpiStore<true> E{QKV, 3072, ssqH}; run_gemm(F, HB, DM, Wmi, DM, 3072, DM, E); } } SEAM(10);
    if (IN(11)) { AP; REP(11) { moba_prep(F, QKV, pos, b_gq, b_gk, kmean); } } SEAM(11);
    if (IN(12)) { AP; REP(12) { moba_attn(F, QKV, kmean, OB); } } SEAM(12);
    if (IN(13)) { AP; REP(13) { pg8::EpiResidB<true, true> E{HB, HB, ssqH, RED}; run_gemm(F, OB, DM, Wmo, DM, DM, DM, E); } } SEAM(13);
    FFN_PHASES(14, 1);
#define YS (BIG + 2048)
#define PMB (BIG + (size_t)MTOK * 4096)
#define CSTB ((float*)(BIG + (size_t)MTOK * 4096 + (size_t)16 * 1024 * 1024))
    if (IN(17)) { AP; REP(17) { cvt_matrix(F, c_w_in, 6144, DM, 6144, 0, Wmi, norm_mix + 2 * DM); cvt_matrix(F, c_w_out, DM, 2048, DM, 0, Wmo); FFN_CVT(2);
        ret_rot_table(F, pos, CSTB); } } SEAM(17);
    if (IN(18)) { AP; REP(18) { pg8::EpiStoreRot<true> E{QKV, CSTB, ssqH}; run_gemm(F, HB, DM, Wmi, DM, 4096, DM, E); } } SEAM(18);
    if (IN(19)) { AP; REP(19) { ret_pmat(F, QKV, PMB); } } SEAM(19);
    if (IN(20)) { AP; REP(20) { ret_core(F, QKV, PMB, statC); } } SEAM(20);
    if (IN(21)) { AP; REP(21) { pg8::EpiGateC<true> E{YS, 4096, statC, c_g, ssqH}; run_gemm(F, HB, DM, Wmi + (size_t)4096 * DM, DM, 2048, DM, E); } } SEAM(21);
    if (IN(22)) { AP; REP(22) { pg8::EpiResidB<true, true> E{HB, HB, ssqH, RED}; run_gemm(F, YS, 4096, Wmo, 2048, DM, 2048, E); } } SEAM(22);
    FFN_PHASES(23, 2);
    if (IN(26)) { AP; REP(26) { cvt_matrix(F, d_w_in, 2048, DM, 2048, 0, Wmi, norm_mix + 3 * DM);
#pragma unroll 1
            for (int blk = 0; blk < 4; ++blk) cvt_matrix(F, d_wg + (size_t)blk * 256 * 512, 512, 256, 512, 2, Wg + (size_t)blk * 512 * 256);
            cvt_matrix(F, d_w_out, DM, DM, DM, 0, Wmo); FFN_CVT(3); } } SEAM(26);
    if (IN(27)) { AP; REP(27) { pg8::EpiStore<true> E{GX, 2048, ssqH}; run_gemm(F, HB, DM, Wmi, DM, 2048, DM, E); } } SEAM(27);
    if (IN(28)) { AP; REP(28) { lru_conv(F, GX, d_cw, d_cb, XC, d_lru, sptab); } } SEAM(28);
    if (IN(29)) { AP; REP(29) { pg8::EpiLru E{XC, LA, BT, d_bg, sptab}; run_gemm(F, XC, DM, Wg, 256, 2048, 256, E, MTOK, 256); } } SEAM(29);
    if (IN(30)) { AP; REP(30) { lru_scan(F, LA, BT, GX, Y); } } SEAM(30);
    if (IN(31)) { AP; REP(31) { pg8::EpiResidB<true, true> E{HB, HB, ssqH, RED}; run_gemm(F, Y, DM, Wmo, DM, DM, DM, E); } } SEAM(31);
    FFN_PHASES(32, 3);
    if (TIMING_MASK != 0ull && blockIdx.x == 0 && threadIdx.x == 0) { const unsigned long long t0_ = __builtin_amdgcn_s_memrealtime(); const unsigned long long tacc_ = TMISC[1]; while (__builtin_amdgcn_s_memrealtime() - t0_ < tacc_) __builtin_amdgcn_s_sleep(8); }
#undef IN
#undef SEAM
#undef XIN
#undef pos
#undef norm_mix
#undef norm_ffn
#undef ffn_w_in
#undef ffn_w_out
#undef out
#undef Wmi
#undef Wmo
#undef Wfi
#undef Wfo
#undef U
#undef BIG
#undef gatesA
#undef ssqA
#undef statC
#undef kmean
#undef sptab
#undef a_w_in
#undef a_b
#undef a_g
#undef a_w_out
#undef b_w_in
#undef b_gq
#undef b_gk
#undef b_w_out
#undef c_w_in
#undef c_g
#undef c_w_out
#undef d_w_in
#undef d_cw
#undef d_cb
#undef d_wg
#undef d_bg
#undef d_lru
#undef d_w_out
#undef GX
#undef XC
#undef LA
#undef BT
#undef Y
#undef Wg
#undef FFN_CVT
#undef OB
#undef HB
#undef RED
#undef CSTB
#undef PMAB
#undef GTB
#undef DENB
#undef PMB
#undef VTB
#undef FFN_PHASES
#undef QKV
#undef HO
#undef YS
#undef ssqH
}

#ifndef MK_ONE_LAUNCH
#define MK_ONE_LAUNCH 1
#endif
extern "C" void kernel_launch(void* const* d_in, const int* in_sizes, int n_in, void* d_out, int out_size, void* d_ws, size_t ws_size, hipStream_t stream) {
    static int grid = 0;
    if (grid == 0) {
        if (n_in != 24 || out_size != MTOK * DM || ws_size < WS_END) { fprintf(stderr, "kernel_launch: unexpected shapes (n_in %d, out %d, ws %zu); nothing launched\n", n_in, out_size, ws_size); grid = -1; return; }
        int dev = 0, cus = 0, per_cu = 0;
        if (hipGetDevice(&dev) != hipSuccess || hipDeviceGetAttribute(&cus, hipDeviceAttributeMultiprocessorCount, dev) != hipSuccess) { grid = -1; return; }
        if (hipFuncSetAttribute((const void*)trunk_fwd, hipFuncAttributeMaxDynamicSharedMemorySize, LDS_BYTES) != hipSuccess) { fprintf(stderr, "kernel_launch: hipFuncSetAttribute failed\n"); grid = -1; return; }
        if (hipOccupancyMaxActiveBlocksPerMultiprocessor(&per_cu, (const void*)trunk_fwd, NTHR, LDS_BYTES) != hipSuccess || per_cu < 1) { fprintf(stderr, "kernel_launch: occupancy query reports %d blocks per CU\n", per_cu); }
        (void)hipGetLastError();
        grid = cus;
    }
    if (grid < 0) return;
    (void)hipMemsetAsync((char*)d_ws + WS_CTL, 0, CTL_ZERO_BYTES, stream);
    Args a{};
    for (int i = 0; i < 24; ++i) a.in[i] = d_in[i];
    a.out = (float*)d_out; a.ws = (unsigned char*)d_ws;
#if MK_ONE_LAUNCH
    a.ph_lo = 0; a.ph_hi = NPHASE;
    hipLaunchKernelGGL(trunk_fwd, dim3(grid), dim3(NTHR), LDS_BYTES, stream, a);
#else
    for (int p = 0; p < NPHASE; ++p) { a.ph_lo = p; a.ph_hi = p + 1; hipLaunchKernelGGL(trunk_fwd, dim3(grid), dim3(NTHR), LDS_BYTES, stream, a); }
#endif
}
```

```cpp
#include <hip/hip_runtime.h>
#include <cstdio>
#include <cstdint>
#include <cmath>
namespace pg8 {
#define PG8_LAS __attribute__((address_space(3)))
typedef unsigned short bf16_t;
typedef short bf16x8 __attribute__((ext_vector_type(8)));
typedef float f32x4 __attribute__((ext_vector_type(4)));
typedef unsigned u32x4 __attribute__((ext_vector_type(4)));
constexpr int BM = 256, BK = 64, HALF = 128, HTB = HALF * BK * 2  , STAGE_BYTES = 8 * HTB, NXCD = 8, WGM = 8;

__host__ __device__ __forceinline__ int lds_byte(int r, int c) { const int st = (r >> 4) * 2 + (c >> 5), rr = r & 15, cc = c & 31, ob = rr * 64 + cc * 2; return st * 1024 + (ob ^ (((ob >> 9) & 1) << 5)); }
__host__ __device__ __forceinline__ void stage_rc(int b, int& R, int& C) { const int st = b / 1024, sb = b % 1024, swz = sb ^ (((sb >> 9) & 1) << 5); R = (st >> 1) * 16 + swz / 64; C = (st & 1) * 32 + (swz % 64) / 2; }
__host__ __device__ __forceinline__ int perm32(int rho) { const int n = rho >> 4, i = rho & 15; return 8 * (i >> 2) + 4 * n + (i & 3); }

struct Unit { int pm, pn; };
struct Gemm { const bf16_t* A; const bf16_t* Bt; int M, N, K, lda, ldb, ablk; };

struct StaticOrder {
    int nM, nN, nwg, G, c, wgm;
    __host__ __device__ void init(int M, int N, int G_, int c_, int wgm_ = WGM) { nM = M / BM; nN = N / BM; nwg = nM * nN; G = G_; c = c_; wgm = wgm_; }
    __host__ __device__ bool next(int i, Unit& u) const {
        const long L = (long)i * G + c; if (L >= nwg) return false;
        int wgid = (int)L; { const int q = nwg / NXCD, r = nwg % NXCD, xcd = wgid % NXCD, off = wgid / NXCD; wgid = (xcd < r ? xcd * (q + 1) : r * (q + 1) + (xcd - r) * q) + off; }
        const int nig = wgm * nN, gid = wgid / nig, fm = gid * wgm, gsz = (nM - fm) < wgm ? (nM - fm) : wgm;
        u.pm = fm + ((wgid % nig) % gsz); u.pn = (wgid % nig) / gsz; return true;
    }
    __device__ __forceinline__ void a_ready(const Unit&) const {}
    __device__ __forceinline__ void done(const Unit&) const {}
};

__device__ __forceinline__ unsigned cvt_pk_bf16(float lo, float hi) { unsigned r; asm volatile("v_cvt_pk_bf16_f32 %0, %1, %2" : "=v"(r) : "v"(lo), "v"(hi)); return r; }
typedef float f32x2 __attribute__((ext_vector_type(2)));

__device__ __forceinline__ float bf2f(unsigned short b) { return __uint_as_float(((unsigned)b) << 16); }
__device__ __forceinline__ float lo_bf(unsigned w) { return __uint_as_float(w << 16); }
__device__ __forceinline__ float hi_bf(unsigned w) { return __uint_as_float(w & 0xffff0000u); }
__device__ __forceinline__ float fast_sigmoid(float x) { return __builtin_amdgcn_rcpf(1.0f + __expf(-x)); }
typedef unsigned u32x2 __attribute__((ext_vector_type(2)));


#ifndef EPI_SC1
#define EPI_SC1 0
#endif
__device__ __forceinline__ void st16(void* p, u32x4 w) {
#if EPI_SC1
    asm volatile("global_store_dwordx4 %0, %1, off sc1" :: "v"(p), "v"(w) : "memory");
#else
    *(u32x4*)p = w;
#endif
}
__device__ __forceinline__ void row_rstd(const float* ssq, int row0, float (&rs)[2][4]) {
#pragma unroll
    for (int ai = 0; ai < 2; ++ai)
#pragma unroll
        for (int m = 0; m < 4; ++m) { const f32x4 a = *(const f32x4*)(ssq + (size_t)(row0 + ai * HALF + m * 16) * 4);
            rs[ai][m] = 1.0f / sqrtf(((a[0] + a[1]) + (a[2] + a[3])) * (1.0f / 1024.0f) + 1e-6f); }
}
__device__ __forceinline__ void rstd_pre_load(const float* ssq, const Unit& u, int wr, int lane, f32x4& a, f32x4& b) {
    int r = u.pm * BM + wr * 64 + lane; asm volatile("" : "+v"(r));
    a = *(const f32x4*)(ssq + (size_t)r * 4); b = *(const f32x4*)(ssq + (size_t)(r + HALF) * 4);
}
__device__ __forceinline__ void rstd_pre_fin(const f32x4& a, const f32x4& b, float& p0, float& p1) {
    p0 = 1.0f / sqrtf(((a[0] + a[1]) + (a[2] + a[3])) * (1.0f / 1024.0f) + 1e-6f); p1 = 1.0f / sqrtf(((b[0] + b[1]) + (b[2] + b[3])) * (1.0f / 1024.0f) + 1e-6f);
}
__device__ __forceinline__ void lane_rstd(float p0, float p1, int fr, float (&rs)[2][4]) {
#pragma unroll
    for (int m = 0; m < 4; ++m) { rs[0][m] = __shfl(p0, fr + 16 * m); rs[1][m] = __shfl(p1, fr + 16 * m); }
}
template <bool RS> struct EpiStore {
    static constexpr bool PERM = true, AFTER_DRAIN = false; static constexpr int NST = 16; static constexpr bool PRE = RS;
    bf16_t* O; int ldc; const float* ssq;
        __device__ __forceinline__ void pre_load(const Unit& u, int wr, int lane, f32x4& a, f32x4& b) const { rstd_pre_load(ssq, u, wr, lane, a, b); }
    __device__ __forceinline__ void pre_fin(const f32x4& a, const f32x4& b, float& p0, float& p1) const { rstd_pre_fin(a, b, p0, p1); }
    __device__ __forceinline__ void operator()(const f32x4 (&acc)[2][2][4][2], const Unit& u, int wr, int wc, int fr, int fq, float pr0 = 1.0f, float pr1 = 1.0f) const {
        const int row0 = u.pm * BM + wr * 64 + fr, col0 = u.pn * BM + wc * 32 + 8 * fq;
        float rs[2][4]; if (RS) lane_rstd(pr0, pr1, fr, rs);
#pragma unroll
        for (int ai = 0; ai < 2; ++ai)
#pragma unroll
            for (int m = 0; m < 4; ++m) { bf16_t* rowp = O + (size_t)(row0 + ai * HALF + m * 16) * ldc + col0; const float sc = RS ? rs[ai][m] : 1.0f;
#pragma unroll
                for (int bj = 0; bj < 2; ++bj) { const f32x4 v0 = acc[ai][bj][m][0] * sc, v1 = acc[ai][bj][m][1] * sc;
                    u32x4 w; w.x = cvt_pk_bf16(v0[0], v0[1]); w.y = cvt_pk_bf16(v0[2], v0[3]); w.z = cvt_pk_bf16(v1[0], v1[1]); w.w = cvt_pk_bf16(v1[2], v1[3]);
                    st16(rowp + bj * HALF, w);
#if defined(GEMM_EXP) && GEMM_EXP == 3
                    asm volatile("" ::: "memory"); *(volatile u32x4*)(rowp + bj * HALF) = w;
#endif
                } }
    }
};

template <bool RS> struct EpiStoreRot {
    static constexpr bool PERM = true, AFTER_DRAIN = false; static constexpr int NST = 16; static constexpr bool PRE = RS;
    bf16_t* O; const int* pos; const float* ssq;
    __device__ __forceinline__ void pre_load(const Unit& u, int wr, int lane, f32x4& a, f32x4& b) const { rstd_pre_load(ssq, u, wr, lane, a, b); }
    __device__ __forceinline__ void pre_fin(const f32x4& a, const f32x4& b, float& p0, float& p1) const { rstd_pre_fin(a, b, p0, p1); }
    __device__ __forceinline__ void operator()(const f32x4 (&acc)[2][2][4][2], const Unit& u, int wr, int wc, int fr, int fq, float pr0 = 1.0f, float pr1 = 1.0f) const {
        const int row0 = u.pm * BM + wr * 64 + fr, col0 = u.pn * BM + wc * 32 + 8 * fq, d0 = wc * 32 + 8 * fq;
        const bool rot = u.pn < 8; const float sc = (u.pn >= 4 && u.pn < 8) ? 0.0625f : 1.0f;
        float rs[2][4]; if (RS) lane_rstd(pr0, pr1, fr, rs);
        int ps[2][4]; float ifr[8];
        if (rot) {
#pragma unroll
            for (int ai = 0; ai < 2; ++ai)
#pragma unroll
                for (int m = 0; m < 4; ++m) ps[ai][m] = pos[row0 + ai * HALF + m * 16];
#pragma unroll
            for (int e = 0; e < 8; ++e) ifr[e] = __builtin_amdgcn_exp2f(-(float)(d0 + e) * (13.287712379549449f / 128.0f)) * 0.15915494309189535f;
        }
#pragma unroll
        for (int ai = 0; ai < 2; ++ai)
#pragma unroll
            for (int m = 0; m < 4; ++m) { const int row = row0 + ai * HALF + m * 16; bf16_t* rowp = O + (size_t)row * 4096 + col0; const float rsc = RS ? rs[ai][m] : 1.0f;
                f32x4 v[2][2];
#pragma unroll
                for (int bj = 0; bj < 2; ++bj) { v[bj][0] = acc[ai][bj][m][0] * rsc; v[bj][1] = acc[ai][bj][m][1] * rsc; }
                if (rot) { const float pf = (float)ps[ai][m];
#pragma unroll
                    for (int n = 0; n < 2; ++n) { f32x4 c, sn;
#pragma unroll
                        for (int e = 0; e < 4; ++e) { const float rev = __builtin_amdgcn_fractf(pf * ifr[4 * n + e]); c[e] = __builtin_amdgcn_cosf(rev); sn[e] = __builtin_amdgcn_sinf(rev); }
                        const f32x4 x1 = v[0][n], x2 = v[1][n];
                        v[0][n] = (x1 * c - x2 * sn) * sc; v[1][n] = (x2 * c + x1 * sn) * sc; } }
#pragma unroll
                for (int bj = 0; bj < 2; ++bj) { u32x4 w; w.x = cvt_pk_bf16(v[bj][0][0], v[bj][0][1]); w.y = cvt_pk_bf16(v[bj][0][2], v[bj][0][3]); w.z = cvt_pk_bf16(v[bj][1][0], v[bj][1][1]); w.w = cvt_pk_bf16(v[bj][1][2], v[bj][1][3]);
                    *(u32x4*)(rowp + bj * HALF) = w; } }
    }
};
template <bool RS> struct EpiSwiGLU {
    static constexpr bool PERM = true, AFTER_DRAIN = false; static constexpr int NST = 8; static constexpr bool PRE = RS;
    bf16_t* O; int ldc; const float* ssq;
        __device__ __forceinline__ void pre_load(const Unit& u, int wr, int lane, f32x4& a, f32x4& b) const { rstd_pre_load(ssq, u, wr, lane, a, b); }
    __device__ __forceinline__ void pre_fin(const f32x4& a, const f32x4& b, float& p0, float& p1) const { rstd_pre_fin(a, b, p0, p1); }
    __device__ __forceinline__ void operator()(const f32x4 (&acc)[2][2][4][2], const Unit& u, int wr, int wc, int fr, int fq, float pr0 = 1.0f, float pr1 = 1.0f) const {
        const int row0 = u.pm * BM + wr * 64 + fr, col0 = u.pn * HALF + wc * 32 + 8 * fq;
        float rs[2][4]; if (RS) lane_rstd(pr0, pr1, fr, rs);
#pragma unroll
        for (int ai = 0; ai < 2; ++ai)
#pragma unroll
            for (int m = 0; m < 4; ++m) { bf16_t* rowp = O + (size_t)(row0 + ai * HALF + m * 16) * ldc + col0; const float sc = RS ? rs[ai][m] : 1.0f;
                float h[8];
#pragma unroll
                for (int n = 0; n < 2; ++n)
#pragma unroll
                    for (int j = 0; j < 4; ++j) { const float g = acc[ai][0][m][n][j] * sc, up = acc[ai][1][m][n][j] * sc;
#if defined(GEMM_EXP) && GEMM_EXP == 2
                        h[4 * n + j] = g * (0.5f * (fast_sigmoid(g) + (1.0f - fast_sigmoid(-g)))) * up;
#else
                        h[4 * n + j] = g * fast_sigmoid(g) * up;
#endif
                    }
                u32x4 w; w.x = cvt_pk_bf16(h[0], h[1]); w.y = cvt_pk_bf16(h[2], h[3]); w.z = cvt_pk_bf16(h[4], h[5]); w.w = cvt_pk_bf16(h[6], h[7]);

                st16(rowp, w);
                }
    }
};
template <bool NX> struct EpiResid {
    static constexpr bool PERM = false, AFTER_DRAIN = false; static constexpr int NST = 32; static constexpr bool PRE = false;
    const float* base; float* out; int ldc; bf16_t* hb; float* ssq;
    __device__ __forceinline__ void operator()(const f32x4 (&acc)[2][2][4][2], const Unit& u, int wr, int wc, int fr, int fq) const {
        const int row0 = u.pm * BM + wr * 64 + fr, col0 = u.pn * BM + wc * 32 + 4 * fq;
        f32x4 rb[3][4];
#define PG8_RLOAD(g, slot) do { const size_t off_ = (size_t)(row0 + ((g) >> 2) * HALF + ((g) & 3) * 16) * ldc + col0; \
            rb[slot][0] = *(const f32x4*)(base + off_); rb[slot][1] = *(const f32x4*)(base + off_ + 16); rb[slot][2] = *(const f32x4*)(base + off_ + HALF); rb[slot][3] = *(const f32x4*)(base + off_ + HALF + 16); } while (0)
        PG8_RLOAD(0, 0); PG8_RLOAD(1, 1);
#pragma unroll
        for (int g = 0; g < 8; ++g) { const int ai = g >> 2, m = g & 3; const size_t off = (size_t)(row0 + ai * HALF + m * 16) * ldc + col0; float q = 0.f;
            if (g + 2 < 8) PG8_RLOAD(g + 2, (g + 2) % 3);
#pragma unroll
            for (int bj = 0; bj < 2; ++bj)
#pragma unroll
                for (int n = 0; n < 2; ++n) { const f32x4 o = rb[g % 3][bj * 2 + n] + acc[ai][bj][m][n]; *(f32x4*)(out + off + bj * HALF + n * 16) = o;
                    if (NX) { q += (o[0] * o[0] + o[1] * o[1]) + (o[2] * o[2] + o[3] * o[3]); u32x2 w; w.x = cvt_pk_bf16(o[0], o[1]); w.y = cvt_pk_bf16(o[2], o[3]); *(u32x2*)(hb + off + bj * HALF + n * 16) = w; } }
            if (NX) { q += __shfl_xor(q, 16); q += __shfl_xor(q, 32); if (fq == 0) ssq[(size_t)(row0 + ai * HALF + m * 16) * 16 + u.pn * 4 + wc] = q; } }
#undef PG8_RLOAD
    }
};
template <bool BF, bool NX> struct EpiResidB {
    static constexpr bool PERM = true, AFTER_DRAIN = false; static constexpr int NST = 16; static constexpr bool PRE = false;
    const void* base; bf16_t* hb; float* ssq; PG8_LAS float* red;
    __device__ __forceinline__ void operator()(const f32x4 (&acc)[2][2][4][2], const Unit& u, int wr, int wc, int fr, int fq) const {
        const int row0 = u.pm * BM + wr * 64 + fr, col0 = u.pn * BM + wc * 32 + 8 * fq;
        u32x4 hwb[2][2]; f32x4 fb[2][4];
#define PG8_BLOAD(g, slot) do { const size_t o_ = (size_t)(row0 + ((g) >> 2) * HALF + ((g) & 3) * 16) * 1024 + col0; \
            if (BF) { hwb[slot][0] = *(const u32x4*)((const bf16_t*)base + o_); hwb[slot][1] = *(const u32x4*)((const bf16_t*)base + o_ + HALF); } \
            else { const float* b_ = (const float*)base + o_; fb[slot][0] = *(const f32x4*)b_; fb[slot][1] = *(const f32x4*)(b_ + 4); fb[slot][2] = *(const f32x4*)(b_ + HALF); fb[slot][3] = *(const f32x4*)(b_ + HALF + 4); } } while (0)
        PG8_BLOAD(0, 0); float qs[8];
#pragma unroll
        for (int g = 0; g < 8; ++g) { const int ai = g >> 2, m = g & 3, sl = g & 1; bf16_t* rowp = hb + (size_t)(row0 + ai * HALF + m * 16) * 1024 + col0; qs[g] = 0.f;
            if (g + 1 < 8) PG8_BLOAD(g + 1, (g + 1) & 1);
#pragma unroll
            for (int bj = 0; bj < 2; ++bj) { f32x4 b0, b1;
                if (BF) { const u32x4 hw = hwb[sl][bj]; b0 = (f32x4){lo_bf(hw.x), hi_bf(hw.x), lo_bf(hw.y), hi_bf(hw.y)}; b1 = (f32x4){lo_bf(hw.z), hi_bf(hw.z), lo_bf(hw.w), hi_bf(hw.w)}; }
                else { b0 = fb[sl][2 * bj]; b1 = fb[sl][2 * bj + 1]; }
                const f32x4 o0 = b0 + acc[ai][bj][m][0], o1 = b1 + acc[ai][bj][m][1];
                u32x4 w; w.x = cvt_pk_bf16(o0[0], o0[1]); w.y = cvt_pk_bf16(o0[2], o0[3]); w.z = cvt_pk_bf16(o1[0], o1[1]); w.w = cvt_pk_bf16(o1[2], o1[3]);
                if (NX) qs[g] += ((o0[0] * o0[0] + o0[1] * o0[1]) + (o0[2] * o0[2] + o0[3] * o0[3])) + ((o1[0] * o1[0] + o1[1] * o1[1]) + (o1[2] * o1[2] + o1[3] * o1[3]));
                *(u32x4*)(rowp + bj * HALF) = w; } }
#undef PG8_BLOAD
        if (NX) {
#pragma unroll
            for (int g = 0; g < 8; ++g) { float q = qs[g]; q += __shfl_xor(q, 16); q += __shfl_xor(q, 32); if (fq == 0) red[wc * 256 + wr * 64 + (g >> 2) * HALF + (g & 3) * 16 + fr] = q; }
            __syncthreads();
            const int t = wr * 256 + wc * 64 + fq * 16 + fr;
            if (t < 256) ssq[(size_t)(u.pm * BM + t) * 4 + u.pn] = (red[t] + red[256 + t]) + (red[512 + t] + red[768 + t]);
        }
    }
};
struct EpiResidF {
    static constexpr bool PERM = true, AFTER_DRAIN = false; static constexpr int NST = 32; static constexpr bool PRE = false;
    const bf16_t* hb; float* out;
    __device__ __forceinline__ void operator()(const f32x4 (&acc)[2][2][4][2], const Unit& u, int wr, int wc, int fr, int fq) const {
        const int row0 = u.pm * BM + wr * 64 + fr, col0 = u.pn * BM + wc * 32 + 8 * fq;
#pragma unroll
        for (int ai = 0; ai < 2; ++ai)
#pragma unroll
            for (int m = 0; m < 4; ++m) { const size_t o_ = (size_t)(row0 + ai * HALF + m * 16) * 1024 + col0;
#pragma unroll
                for (int bj = 0; bj < 2; ++bj) { const u32x4 hw = *(const u32x4*)(hb + o_ + bj * HALF);
                    const f32x4 b0 = (f32x4){lo_bf(hw.x), hi_bf(hw.x), lo_bf(hw.y), hi_bf(hw.y)}, b1 = (f32x4){lo_bf(hw.z), hi_bf(hw.z), lo_bf(hw.w), hi_bf(hw.w)};
                    *(f32x4*)(out + o_ + bj * HALF) = b0 + acc[ai][bj][m][0]; *(f32x4*)(out + o_ + bj * HALF + 4) = b1 + acc[ai][bj][m][1]; } }
    }
};
struct EpiGateA {
    static constexpr bool PERM = true, AFTER_DRAIN = false; static constexpr int NST = 16; static constexpr bool PRE = false;
    bf16_t* Y; const float* ssq; const float* gout;
    __device__ __forceinline__ void operator()(const f32x4 (&acc)[2][2][4][2], const Unit& u, int wr, int wc, int fr, int fq) const {
        const int row0 = u.pm * BM + wr * 64 + fr, col0 = u.pn * BM + wc * 32 + 8 * fq;
        f32x4 gv[2][2];
#pragma unroll
        for (int bj = 0; bj < 2; ++bj)
#pragma unroll
            for (int n = 0; n < 2; ++n) gv[bj][n] = *(const f32x4*)(gout + col0 + bj * HALF + 4 * n);
        u32x4 hwb[2][2]; f32x4 spb[2][2];
#define PG8_GLOAD(g, slot) do { const int row_ = row0 + ((g) >> 2) * HALF + ((g) & 3) * 16; const bf16_t* rp_ = Y + (size_t)row_ * 1024 + col0; hwb[slot][0] = *(const u32x4*)rp_; hwb[slot][1] = *(const u32x4*)(rp_ + HALF); \
            spb[slot][0] = *(const f32x4*)(ssq + (size_t)row_ * 32 + u.pn * 8); spb[slot][1] = *(const f32x4*)(ssq + (size_t)row_ * 32 + u.pn * 8 + 4); } while (0)
        PG8_GLOAD(0, 0);
#pragma unroll
        for (int g = 0; g < 8; ++g) { const int ai = g >> 2, m = g & 3, sl = g & 1; const int row = row0 + ai * HALF + m * 16; bf16_t* rowp = Y + (size_t)row * 1024 + col0;
            if (g + 1 < 8) PG8_GLOAD(g + 1, (g + 1) & 1);
            const f32x4 sp = spb[sl][0], sp2 = spb[sl][1];
            const float rstd = 1.0f / sqrtf((((sp[0] + sp[1]) + (sp[2] + sp[3])) + ((sp2[0] + sp2[1]) + (sp2[2] + sp2[3]))) * (1.0f / 256.0f) + 1e-6f);
#pragma unroll
            for (int bj = 0; bj < 2; ++bj) { const u32x4 hw = hwb[sl][bj]; float o[8];
                const unsigned hh[4] = {hw.x, hw.y, hw.z, hw.w};
#pragma unroll
                for (int n = 0; n < 2; ++n)
#pragma unroll
                    for (int j = 0; j < 4; ++j) { const unsigned w = hh[2 * n + (j >> 1)]; const float hv = (j & 1) ? hi_bf(w) : lo_bf(w);
                        o[4 * n + j] = hv * rstd * gv[bj][n][j] * fast_sigmoid(acc[ai][bj][m][n][j]); }
                u32x4 w; w.x = cvt_pk_bf16(o[0], o[1]); w.y = cvt_pk_bf16(o[2], o[3]); w.z = cvt_pk_bf16(o[4], o[5]); w.w = cvt_pk_bf16(o[6], o[7]);
                *(u32x4*)(rowp + bj * HALF) = w; } }
#undef PG8_GLOAD
    }
};
template <bool RS> struct EpiGateC {
    static constexpr bool PERM = true, AFTER_DRAIN = false; static constexpr int NST = 16; static constexpr bool PRE = RS;
    bf16_t* Y; int ldy; const float* st; const float* gout; const float* hssq;
        __device__ __forceinline__ void pre_load(const Unit& u, int wr, int lane, f32x4& a, f32x4& b) const { rstd_pre_load(hssq, u, wr, lane, a, b); }
    __device__ __forceinline__ void pre_fin(const f32x4& a, const f32x4& b, float& p0, float& p1) const { rstd_pre_fin(a, b, p0, p1); }
    __device__ __forceinline__ void operator()(const f32x4 (&acc)[2][2][4][2], const Unit& u, int wr, int wc, int fr, int fq, float pr0 = 1.0f, float pr1 = 1.0f) const {
        const int row0 = u.pm * BM + wr * 64 + fr, col0 = u.pn * BM + wc * 32 + 8 * fq, head = u.pn >> 1;
        float rs[2][4]; if (RS) lane_rstd(pr0, pr1, fr, rs);
        f32x4 gv[2][2];
#pragma unroll
        for (int bj = 0; bj < 2; ++bj)
#pragma unroll
            for (int n = 0; n < 2; ++n) gv[bj][n] = *(const f32x4*)(gout + col0 + bj * HALF + 4 * n);
        u32x4 hwb[2][2]; f32x4 spb[2][2];
#define PG8_GLOAD(g, slot) do { const int row_ = row0 + ((g) >> 2) * HALF + ((g) & 3) * 16; const bf16_t* rp_ = Y + (size_t)row_ * ldy + col0; hwb[slot][0] = *(const u32x4*)rp_; hwb[slot][1] = *(const u32x4*)(rp_ + HALF); \
            spb[slot][0] = *(const f32x4*)(st + (size_t)row_ * 32 + head * 8); spb[slot][1] = *(const f32x4*)(st + (size_t)row_ * 32 + head * 8 + 4); } while (0)
        PG8_GLOAD(0, 0);
#pragma unroll
        for (int g = 0; g < 8; ++g) { const int ai = g >> 2, m = g & 3, sl = g & 1; const int row = row0 + ai * HALF + m * 16; bf16_t* rowp = Y + (size_t)row * ldy + col0;
            if (g + 1 < 8) PG8_GLOAD(g + 1, (g + 1) & 1);
            const f32x4 s0 = spb[sl][0], s1 = spb[sl][1];
            const float mu = ((s0[0] + s0[2]) + (s1[0] + s1[2])) * (1.0f / 512.0f), ex2 = ((s0[1] + s0[3]) + (s1[1] + s1[3])) * (1.0f / 512.0f);
            const float var = fmaxf(ex2 - mu * mu, 0.f), rstd = 1.0f / sqrtf(var + 1e-6f);
#pragma unroll
            for (int bj = 0; bj < 2; ++bj) { const u32x4 hw = hwb[sl][bj]; float o[8];
                const unsigned hh[4] = {hw.x, hw.y, hw.z, hw.w};
#pragma unroll
                for (int n = 0; n < 2; ++n)
#pragma unroll
                    for (int j = 0; j < 4; ++j) { const unsigned w = hh[2 * n + (j >> 1)]; const float hv = (j & 1) ? hi_bf(w) : lo_bf(w); const float a = RS ? acc[ai][bj][m][n][j] * rs[ai][m] : acc[ai][bj][m][n][j];
                        o[4 * n + j] = (hv - mu) * rstd * gv[bj][n][j] * (a * fast_sigmoid(a)); }
                u32x4 w; w.x = cvt_pk_bf16(o[0], o[1]); w.y = cvt_pk_bf16(o[2], o[3]); w.z = cvt_pk_bf16(o[4], o[5]); w.w = cvt_pk_bf16(o[6], o[7]);
                *(u32x4*)(rowp + bj * HALF) = w; } }
#undef PG8_GLOAD
    }
};
struct EpiLru {
    static constexpr bool PERM = true, AFTER_DRAIN = false; static constexpr int NST = 16; static constexpr bool PRE = false;
    const bf16_t* XC; bf16_t* LA; bf16_t* BT; const float* bgall; const float* sp;
    __device__ __forceinline__ void operator()(const f32x4 (&acc)[2][2][4][2], const Unit& u, int wr, int wc, int fr, int fq) const {
        const int blk = u.pn >> 1; const float* bg = bgall + blk * 512;
        const int row0 = u.pm * BM + wr * 64 + fr, cb = (u.pn & 1) * HALF + wc * 32 + 8 * fq, ch0 = blk * 256 + cb;
        u32x4 xwb[2]; xwb[0] = *(const u32x4*)(XC + (size_t)row0 * 1024 + ch0);
#pragma unroll
        for (int g = 0; g < 8; ++g) { const int ai = g >> 2, m = g & 3; const size_t off = (size_t)(row0 + ai * HALF + m * 16) * 1024 + ch0;
                if (g + 1 < 8) xwb[(g + 1) & 1] = *(const u32x4*)(XC + (size_t)(row0 + ((g + 1) >> 2) * HALF + ((g + 1) & 3) * 16) * 1024 + ch0);
                const u32x4 xw = xwb[g & 1]; const unsigned xx[4] = {xw.x, xw.y, xw.z, xw.w};
                unsigned lw[4], bw[4];
#pragma unroll
                for (int n = 0; n < 2; ++n) { const f32x4 br = *(const f32x4*)(bg + cb + 4 * n), bi = *(const f32x4*)(bg + 256 + cb + 4 * n), spv = *(const f32x4*)(sp + ch0 + 4 * n); float la[4], bt[4];
#pragma unroll
                    for (int j = 0; j < 4; ++j) { const int q = 4 * n + j; const unsigned w = xx[q >> 1]; const float xc = (q & 1) ? hi_bf(w) : lo_bf(w);
                        const float e1 = 1.0f + __expf(-(acc[ai][0][m][n][j] + br[j])), e2 = 1.0f + __expf(-(acc[ai][1][m][n][j] + bi[j])), inv = __builtin_amdgcn_rcpf(e1 * e2);
                        const float r = e2 * inv, ig = e1 * inv;
                        const float l = -8.0f * r * spv[j]; la[j] = l; bt[j] = __builtin_amdgcn_sqrtf(fmaxf(1.0f - __expf(2.0f * l), 0.f)) * ig * xc; }
                    lw[2 * n] = cvt_pk_bf16(la[0], la[1]); lw[2 * n + 1] = cvt_pk_bf16(la[2], la[3]); bw[2 * n] = cvt_pk_bf16(bt[0], bt[1]); bw[2 * n + 1] = cvt_pk_bf16(bt[2], bt[3]); }
                u32x4 w; w.x = lw[0]; w.y = lw[1]; w.z = lw[2]; w.w = lw[3]; *(u32x4*)(LA + off) = w;
                w.x = bw[0]; w.y = bw[1]; w.z = bw[2]; w.w = bw[3]; *(u32x4*)(BT + off) = w; }
    }
};

template <class Epi, class Sched, bool ALIGN_EPI = false, bool SP2 = false>
__device__ __forceinline__ void gemm_phase(PG8_LAS unsigned char* lds, const Gemm g, const Sched& S, const Epi& E) {
    int tid_ = threadIdx.x; asm volatile("" : "+v"(tid_));
    const int tid = tid_, wid = __builtin_amdgcn_readfirstlane(tid >> 6), lane = tid & 63, wr = wid >> 2, wc = wid & 3, fr = lane & 15, fq = lane >> 4;
    const int K = g.K, nt = K / BK;
    unsigned voffA[2], voffB[2];
#pragma unroll
    for (int i = 0; i < 2; ++i) { int R, C; stage_rc(tid * 16 + i * 8192, R, C); const int Rb = Epi::PERM ? ((R & ~31) + perm32(R & 31)) : R;
        voffA[i] = (unsigned)(R * g.lda + C) * 2u; voffB[i] = (unsigned)(Rb * g.ldb + C) * 2u; }
    const size_t kstep = (size_t)(BK * 2);
    const size_t hstepA = (size_t)HALF * g.lda * 2, hstepB = (size_t)HALF * g.ldb * 2;
    const size_t tstepA = 2 * hstepA, tstepB = 2 * hstepB;
    const unsigned ldsw = (unsigned)wid * 1024u;
    const int aoff = lds_byte(wr * 64 + fr, fq * 8), boff = lds_byte(wc * 32 + fr, fq * 8);
#define PG8_SA(b, h) (((b) * 2 + (h)) * HTB)
#define PG8_SB(b, h) ((4 + (b) * 2 + (h)) * HTB)
#define PG8_STAGE(bufoff, gbase, voff) do { _Pragma("unroll") for (int _i = 0; _i < 2; ++_i) \
        __builtin_amdgcn_global_load_lds((const unsigned*)((const char*)(gbase) + (voff)[_i]), (PG8_LAS unsigned*)(lds + (bufoff) + ldsw + _i * 8192), 16, 0, 0); } while (0)
#define PG8_LDA(dst, b, h) do { _Pragma("unroll") for (int m = 0; m < 4; ++m) _Pragma("unroll") for (int k = 0; k < 2; ++k) dst[m][k] = *(const PG8_LAS bf16x8*)(lds + PG8_SA(b, h) + aoff + m * 2048 + k * 1024); } while (0)
#define PG8_LDB(dst, b, h) do { _Pragma("unroll") for (int n = 0; n < 2; ++n) _Pragma("unroll") for (int k = 0; k < 2; ++k) dst[n][k] = *(const PG8_LAS bf16x8*)(lds + PG8_SB(b, h) + boff + n * 2048 + k * 1024); } while (0)
#define PG8_MMA(ai, bj, At, Bt) do { __builtin_amdgcn_s_setprio(1); _Pragma("unroll") for (int m = 0; m < 4; ++m) _Pragma("unroll") for (int n = 0; n < 2; ++n) _Pragma("unroll") for (int k = 0; k < 2; ++k) \
        acc[ai][bj][m][n] = __builtin_amdgcn_mfma_f32_16x16x32_bf16(Bt[n][k], At[m][k], acc[ai][bj][m][n], 0, 0, 0); __builtin_amdgcn_s_setprio(0); } while (0)
#define PG8_WAIT_V(n) asm volatile("s_waitcnt vmcnt(" #n ")" ::: "memory")
#ifndef PG8_RELAX
#define PG8_RELAX 0
#endif
#define PG8_WAIT_V8F do { if (PG8_RELAX) asm volatile("s_cmp_eq_u32 %0, 0\n\ts_cbranch_scc1 .Lpg8w%=a\n\ts_waitcnt vmcnt(%1)\n\ts_branch .Lpg8w%=b\n.Lpg8w%=a:\n\ts_waitcnt vmcnt(8)\n.Lpg8w%=b:" :: "s"(relax_), "n"(8 + Epi::NST) : "memory", "scc"); else PG8_WAIT_V(8); } while (0)
#define PG8_WAIT_L(n) asm volatile("s_waitcnt lgkmcnt(" #n ")" ::: "memory")
#define PG8_BAR __builtin_amdgcn_s_barrier()
#define PG8_SCHED __builtin_amdgcn_sched_barrier(0)
    Unit cur, nxt; int ui = 0;
    if (!S.next(0, cur)) return;
    f32x4 acc[2][2][4][2];
#pragma unroll
    for (int a = 0; a < 2; ++a)
#pragma unroll
        for (int b = 0; b < 2; ++b)
#pragma unroll
            for (int m = 0; m < 4; ++m)
#pragma unroll
                for (int n = 0; n < 2; ++n) acc[a][b][m][n] = (f32x4){0.f, 0.f, 0.f, 0.f};
    bf16x8 At[4][2], B0[2][2], B1[2][2];
    float pr0 = 1.0f, pr1 = 1.0f;
    const char* cA = (const char*)g.A + (size_t)cur.pm * tstepA + (size_t)((cur.pn >> 1) * g.ablk) * 2; const char* cB = (const char*)g.Bt + (size_t)cur.pn * tstepB;
    S.a_ready(cur);
    if constexpr (SP2) {
        PG8_STAGE(PG8_SB(0, 0), cB, voffB); PG8_STAGE(PG8_SB(0, 1), cB + hstepB, voffB); PG8_STAGE(PG8_SA(0, 0), cA, voffA); PG8_STAGE(PG8_SA(0, 1), cA + hstepA, voffA);
        if (wr == 1) PG8_BAR;
        PG8_WAIT_V(2); PG8_BAR;
        PG8_STAGE(PG8_SB(1, 0), cB + kstep, voffB); PG8_STAGE(PG8_SA(1, 0), cA + kstep, voffA); PG8_STAGE(PG8_SB(1, 1), cB + hstepB + kstep, voffB);
        PG8_WAIT_V(6); PG8_BAR;
    } else {
        PG8_STAGE(PG8_SB(0, 0), cB, voffB); PG8_STAGE(PG8_SA(0, 0), cA, voffA); PG8_STAGE(PG8_SB(0, 1), cB + hstepB, voffB); PG8_STAGE(PG8_SA(0, 1), cA + hstepA, voffA);
        if (wr == 1) PG8_BAR;
        PG8_WAIT_V(4); PG8_BAR;
        PG8_STAGE(PG8_SB(1, 0), cB + kstep, voffB); PG8_STAGE(PG8_SA(1, 0), cA + kstep, voffA); PG8_STAGE(PG8_SB(1, 1), cB + hstepB + kstep, voffB);
        PG8_WAIT_V(6); PG8_BAR;
    }
    for (;;) {
        const bool has_next = S.next(ui + 1, nxt);
        const char* nA = has_next ? (const char*)g.A + (size_t)nxt.pm * tstepA + (size_t)((nxt.pn >> 1) * g.ablk) * 2 : cA; const char* nB = has_next ? (const char*)g.Bt + (size_t)nxt.pn * tstepB : cB;
        for (int t = 0; t < nt; t += 2) {
            const bool last = (t == nt - 2);
            const int relax_ = __builtin_amdgcn_readfirstlane((t == 0 && ui > 0) ? 1 : 0);
            const char* a1 = cA + (size_t)(t + 1) * kstep;
            const char* a2 = last ? nA : cA + (size_t)(t + 2) * kstep; const char* b2 = last ? nB : cB + (size_t)(t + 2) * kstep;
            const char* a3 = a2 + kstep; const char* b3 = b2 + kstep;
            if (last && has_next) S.a_ready(nxt);
            f32x4 pq0, pq1;
            if constexpr (SP2) {
            PG8_LDB(B0, 0, 0); PG8_LDB(B1, 0, 1); PG8_SCHED; PG8_LDA(At, 0, 0); PG8_STAGE(PG8_SA(1, 1), a1 + hstepA, voffA);
            PG8_WAIT_V8F; PG8_WAIT_L(0); PG8_BAR; PG8_MMA(0, 0, At, B0); PG8_MMA(0, 1, At, B1); PG8_BAR; PG8_SCHED;
            PG8_LDA(At, 0, 1); PG8_STAGE(PG8_SB(0, 0), b2, voffB); PG8_STAGE(PG8_SB(0, 1), b2 + hstepB, voffB); PG8_STAGE(PG8_SA(0, 0), a2, voffA);
            PG8_WAIT_V8F; PG8_WAIT_L(0); PG8_BAR; PG8_MMA(1, 0, At, B0); PG8_MMA(1, 1, At, B1); PG8_BAR; PG8_SCHED;
            if constexpr (Epi::PRE) { E.pre_load(cur, wr, lane, pq0, pq1); }
            PG8_LDB(B0, 1, 0); PG8_LDB(B1, 1, 1); PG8_SCHED; PG8_LDA(At, 1, 0); PG8_STAGE(PG8_SA(0, 1), a2 + hstepA, voffA);
            if constexpr (Epi::PRE) PG8_WAIT_V(10); else PG8_WAIT_V(8);
            PG8_WAIT_L(0); PG8_BAR; PG8_MMA(0, 0, At, B0); PG8_MMA(0, 1, At, B1); PG8_BAR; PG8_SCHED;
            PG8_LDA(At, 1, 1); PG8_STAGE(PG8_SB(1, 0), b3, voffB); PG8_STAGE(PG8_SB(1, 1), b3 + hstepB, voffB); PG8_STAGE(PG8_SA(1, 0), a3, voffA);
            PG8_WAIT_V(8); PG8_WAIT_L(0); PG8_BAR; PG8_MMA(1, 0, At, B0); PG8_MMA(1, 1, At, B1); PG8_BAR; PG8_SCHED;
            if constexpr (Epi::PRE) { E.pre_fin(pq0, pq1, pr0, pr1); }
            } else {
            PG8_LDB(B0, 0, 0); PG8_SCHED; PG8_LDA(At, 0, 0); PG8_STAGE(PG8_SA(1, 1), a1 + hstepA, voffA);
            PG8_WAIT_L(8); PG8_BAR; PG8_WAIT_L(0); PG8_MMA(0, 0, At, B0); PG8_BAR; PG8_SCHED;
            PG8_LDB(B1, 0, 1); PG8_STAGE(PG8_SB(0, 0), b2, voffB);
            PG8_BAR; PG8_WAIT_L(0); PG8_MMA(0, 1, At, B1); PG8_BAR;
            PG8_LDA(At, 0, 1); PG8_STAGE(PG8_SA(0, 0), a2, voffA);
            PG8_BAR; PG8_WAIT_L(0); PG8_MMA(1, 0, At, B0); PG8_BAR; PG8_SCHED;
            PG8_STAGE(PG8_SB(0, 1), b2 + hstepB, voffB);
            PG8_WAIT_V(6); PG8_BAR; PG8_MMA(1, 1, At, B1); PG8_BAR;
            PG8_LDB(B0, 1, 0); PG8_SCHED; PG8_LDA(At, 1, 0); PG8_STAGE(PG8_SA(0, 1), a2 + hstepA, voffA);
            PG8_WAIT_L(8); PG8_BAR; PG8_WAIT_L(0); PG8_MMA(0, 0, At, B0); PG8_BAR; PG8_SCHED;
            PG8_LDB(B1, 1, 1); PG8_STAGE(PG8_SB(1, 0), b3, voffB);
            PG8_BAR; PG8_WAIT_L(0); PG8_MMA(0, 1, At, B1); PG8_BAR;
            PG8_LDA(At, 1, 1); PG8_STAGE(PG8_SA(1, 0), a3, voffA);
            PG8_BAR; PG8_WAIT_L(0); PG8_MMA(1, 0, At, B0); PG8_BAR; PG8_SCHED;
            PG8_STAGE(PG8_SB(1, 1), b3 + hstepB, voffB);
            PG8_WAIT_V(6); PG8_BAR; PG8_MMA(1, 1, At, B1); PG8_BAR;
            }
        }
        if constexpr (ALIGN_EPI) { if (wr == 0) PG8_BAR; }
        if constexpr (!Epi::AFTER_DRAIN) { if constexpr (Epi::PRE) E(acc, cur, wr, wc, fr, fq, pr0, pr1); else E(acc, cur, wr, wc, fr, fq); S.done(cur); }
        if (!has_next) break;
#pragma unroll
        for (int a = 0; a < 2; ++a)
#pragma unroll
            for (int b = 0; b < 2; ++b)
#pragma unroll
                for (int m = 0; m < 4; ++m)
#pragma unroll
                    for (int n = 0; n < 2; ++n) acc[a][b][m][n] = (f32x4){0.f, 0.f, 0.f, 0.f};
        cur = nxt; cA = nA; cB = nB; ++ui;
        if constexpr (ALIGN_EPI) { if (wr == 1) PG8_BAR; }
    }
    PG8_WAIT_V(0);
    if constexpr (!ALIGN_EPI) { if (wr == 0) PG8_BAR; }
    PG8_BAR;
    if constexpr (Epi::AFTER_DRAIN) { E.fused(acc, cur, wr, wc, fr, fq, lds, wid, lane); S.done(cur); }
#undef PG8_SA
#undef PG8_SB
#undef PG8_STAGE
#undef PG8_LDA
#undef PG8_LDB
#undef PG8_MMA
#undef PG8_WAIT_V
#undef PG8_WAIT_V8F
#undef PG8_WAIT_L
#undef PG8_BAR
#undef PG8_SCHED
}
}
#define GAS __attribute__((address_space(1)))
#define LAS __attribute__((address_space(3)))
typedef unsigned short bf16;
typedef unsigned v4u __attribute__((ext_vector_type(4)));
typedef float f32x4 __attribute__((ext_vector_type(4)));
typedef short bf16x8 __attribute__((ext_vector_type(8)));
typedef GAS unsigned gu32;
typedef GAS unsigned long long gu64;
#define RLX_AGENT __ATOMIC_RELAXED, __HIP_MEMORY_SCOPE_AGENT
#define LDS_WAIT() asm volatile("s_waitcnt lgkmcnt(0)" ::: "memory")
#define VM_WAIT() asm volatile("s_waitcnt vmcnt(0)" ::: "memory")
__device__ __forceinline__ unsigned long long rt() { return __builtin_amdgcn_s_memrealtime(); }
__device__ __forceinline__ unsigned f2bf(float f) { unsigned u = __builtin_bit_cast(unsigned, f); return (u + 0x7fffu + ((u >> 16) & 1u)) >> 16; }
__device__ __forceinline__ unsigned pk2(float lo, float hi) { return f2bf(lo) | (f2bf(hi) << 16); }

#define XB_TMO      128
#define XB_XCNT(j)  (256  + 64 * (j))
#define XB_XSUB(j)  (1280 + 64 * (j))
#define XB_XGEN(j)  (2304 + 64 * (j))
#define XB_TOP      3328
#define XB_TOPGEN   3392
#define XCD_BAR_WORDS 3456
#define XB_SPIN_CAP (1u << 18)

__device__ __forceinline__ unsigned xb_ld(unsigned* p)              { return __hip_atomic_load(p, __ATOMIC_RELAXED, __HIP_MEMORY_SCOPE_AGENT); }
__device__ __forceinline__ unsigned xb_add(unsigned* p, unsigned v) { return __hip_atomic_fetch_add(p, v, __ATOMIC_RELAXED, __HIP_MEMORY_SCOPE_AGENT); }
__device__ __forceinline__ unsigned xb_xcc_id() { return (unsigned)__builtin_amdgcn_s_getreg((3 << 11) | 20) & 0xFu; }
#define XB_SPIN(cond, bar) do { unsigned _sp = 0; while (cond) { __builtin_amdgcn_s_sleep(1); \
    if ((++_sp & 255u) == 0u) { if (xb_ld(&(bar)[XB_TMO])) break; if (_sp > XB_SPIN_CAP) { atomicAdd(&(bar)[XB_TMO], 1u); break; } } } } while (0)

struct XcdBarrier {
    unsigned* bar; unsigned x;
    volatile LAS unsigned* st;
};

__device__ __forceinline__ XcdBarrier xcd_barrier_post(unsigned* bar, volatile LAS unsigned* st) {
    XcdBarrier b; b.bar = bar; b.x = xb_xcc_id(); b.st = st;
    if (threadIdx.x == 0) (void)xb_add(&bar[XB_XCNT(b.x)], 1u);
    return b;
}
__device__ __forceinline__ void xcd_barrier_complete(unsigned* bar, unsigned x, unsigned& nloc, unsigned& nx) {
    const unsigned G = gridDim.x * gridDim.y * gridDim.z;
    unsigned sum, cnt, mine, sp = 0u;
    for (;;) {
        sum = 0u; cnt = 0u; mine = 0u;
#pragma unroll
        for (unsigned j = 0; j < 16; ++j) { const unsigned c = xb_ld(&bar[XB_XCNT(j)]); sum += c; cnt += (c > 0u) ? 1u : 0u; mine = (j == x) ? c : mine; }
        if (sum == G) break;
        __builtin_amdgcn_s_sleep(1);
        if ((++sp & 255u) == 0u) { if (xb_ld(&bar[XB_TMO])) break; if (sp > XB_SPIN_CAP) { atomicAdd(&bar[XB_TMO], 1u); break; } }
    }
    nloc = mine > 0u ? mine : 1u; nx = cnt > 0u ? cnt : 1u;
}

__device__ __forceinline__ void xcd_barrier(const XcdBarrier& b) {
    asm volatile("s_waitcnt vmcnt(0)" ::: "memory");
    __syncthreads();
    if (threadIdx.x == 0) {
        unsigned* bar = b.bar;
        __builtin_amdgcn_s_waitcnt(0);
        unsigned nloc = b.st[0], nx = b.st[1];
        if (nloc == 0u) { xcd_barrier_complete(bar, b.x, nloc, nx); b.st[0] = nloc; b.st[1] = nx; }
        const unsigned old = xb_add(&bar[XB_XSUB(b.x)], 1u);
        const unsigned gen = old / nloc;
        if (old + 1u == (gen + 1u) * nloc) {
            __builtin_amdgcn_fence(__ATOMIC_RELEASE, "agent");
            asm volatile("s_waitcnt vmcnt(0)" ::: "memory");
            const unsigned og = xb_add(&bar[XB_TOP], 1u);
            const unsigned tg = og / nx;
            if (og + 1u == (tg + 1u) * nx) xb_add(&bar[XB_TOPGEN], 1u);
            else XB_SPIN(xb_ld(&bar[XB_TOPGEN]) == tg, bar);
            __builtin_amdgcn_fence(__ATOMIC_ACQUIRE, "agent");
            xb_add(&bar[XB_XGEN(b.x)], 1u);
            asm volatile("s_waitcnt vmcnt(0)" ::: "memory");
        } else {
            XB_SPIN(xb_ld(&bar[XB_XGEN(b.x)]) == gen, bar);
            __builtin_amdgcn_fence(__ATOMIC_ACQUIRE, "agent");
            asm volatile("s_waitcnt vmcnt(0)" ::: "memory");
        }
    }
    __syncthreads();
}
namespace mattn {
typedef unsigned short bf16;
constexpr int D = 128, NW = 8, QBLK = 32, KVBLK = 64;
constexpr float SCALE = 0.088388347648318440f, THR = 8.f;
constexpr int LDQ = 3072, LDK = 3072, LDO = 1024;
constexpr size_t SHM_V = KVBLK * D * 2, SHM_K = KVBLK * D * 2, SHM_ATTN = 2 * SHM_V + 2 * SHM_K + NW * 64 * 4;
using bf16x8 = __attribute__((ext_vector_type(8))) short;
using s16x4  = __attribute__((ext_vector_type(4))) short;
using f32x16 = __attribute__((ext_vector_type(16))) float;
using u32x4  = __attribute__((ext_vector_type(4))) unsigned;
#define KSWZ(row, colB) ((row) * 256 + ((colB) ^ (((row) & 7) << 4)))
#define SBAR() __builtin_amdgcn_sched_barrier(0)
__device__ __forceinline__ int crow(int r, int hi) { return (r & 3) + 8 * (r >> 2) + 4 * hi; }
__device__ __forceinline__ unsigned cvtpk(float lo, float hi) { unsigned r; asm volatile("v_cvt_pk_bf16_f32 %0, %1, %2" : "=v"(r) : "v"(lo), "v"(hi)); return r; }
struct Msk { int j; unsigned sel; int qpos; };
__device__ __forceinline__ float sconst(unsigned bits) { return __uint_as_float((unsigned)__builtin_amdgcn_readfirstlane((int)bits)); }
__device__ __forceinline__ void partialSM(f32x16& p0, f32x16& p1, float& m_reg, float& mn, float& alpha, int tile, const Msk& mk, int hi) {
  constexpr float C = SCALE * 1.4426950408889634f;
  const int kb = tile >> 2; const bool own = (kb == mk.j), lsel = own || ((mk.sel >> kb) & 1u);
  float pmax = p0[0];
#pragma unroll
for (int r = 1; r < 16; ++r) pmax = fmaxf(pmax, p0[r]);
#pragma unroll
for (int r = 0; r < 16; ++r) pmax = fmaxf(pmax, p1[r]);
  { auto rr = __builtin_amdgcn_permlane32_swap(__float_as_uint(pmax), __float_as_uint(pmax), false, false);
    pmax = fmaxf(__uint_as_float(rr[0]), __uint_as_float(rr[1])); }
  if (!lsel) pmax = sconst(0xf149f2cau);
  if (__builtin_expect(__all(pmax - m_reg <= THR / SCALE), 1)) { mn = m_reg; alpha = 1.f; }
  else { mn = fmaxf(m_reg, pmax); alpha = __builtin_amdgcn_exp2f((m_reg - mn) * C); m_reg = mn; }
  const float mnC = lsel ? -mn * C : sconst(0xff800000u);
#pragma unroll
for (int r = 0; r < 16; ++r) p0[r] = fmaf(p0[r], C, mnC);
#pragma unroll
for (int r = 0; r < 16; ++r) p1[r] = fmaf(p1[r], C, mnC);
#pragma unroll
for (int r = 0; r < 16; ++r) p0[r] = __builtin_amdgcn_exp2f(p0[r]);
}
__device__ __forceinline__ void finishSM(f32x16& p0, f32x16& p1, float alpha, float& l_reg, bf16x8& pa0, bf16x8& pa1, bf16x8& pa2, bf16x8& pa3) {
#pragma unroll
for (int r = 0; r < 16; ++r) p1[r] = __builtin_amdgcn_exp2f(p1[r]);
  float ps = 0;
#pragma unroll
for (int r = 0; r < 16; ++r) ps += p0[r];
#pragma unroll
for (int r = 0; r < 16; ++r) ps += p1[r];
  { auto rr = __builtin_amdgcn_permlane32_swap(__float_as_uint(ps), __float_as_uint(ps), false, false);
    ps = __uint_as_float(rr[0]) + __uint_as_float(rr[1]); }
  l_reg = l_reg * alpha + ps;
#define PK4(P, BASE, OUT) do { unsigned a0 = cvtpk(P[BASE + 0], P[BASE + 1]), a1 = cvtpk(P[BASE + 2], P[BASE + 3]);   \
    unsigned b0 = cvtpk(P[BASE + 4], P[BASE + 5]), b1 = cvtpk(P[BASE + 6], P[BASE + 7]);                              \
    auto r0 = __builtin_amdgcn_permlane32_swap(a0, b0, false, false); auto r1 = __builtin_amdgcn_permlane32_swap(a1, b1, false, false); \
    u32x4 w = {r0[0], r1[0], r0[1], r1[1]}; OUT = *reinterpret_cast<bf16x8*>(&w); } while (0)
  PK4(p0, 0, pa0); PK4(p0, 8, pa1); PK4(p1, 0, pa2); PK4(p1, 8, pa3);
#undef PK4
}
__device__ __forceinline__ void qkt(f32x16& p0, f32x16& p1, const bf16* Ks, const bf16x8* qr, int r32, int hi, int tile, const Msk& mk) {
  if ((tile >> 2) == mk.j) { const float NEGB = sconst(0xf149f2cau); int qp = mk.qpos - (tile & 3) * 64; asm volatile("" : "+v"(qp));
#pragma unroll
    for (int r = 0; r < 16; ++r) { const int k0 = crow(r, hi); p0[r] = (k0 > qp) ? NEGB : 0.f; p1[r] = (k0 + 32 > qp) ? NEGB : 0.f; } }
  else { p0 = f32x16{}; p1 = f32x16{}; }
#pragma unroll
for (int d0 = 0; d0 < 8; ++d0) { int cb = (d0 * 16 + hi * 8) * 2;
    bf16x8 b0 = *reinterpret_cast<const bf16x8*>((const char*)Ks + KSWZ(r32, cb));
    bf16x8 b1 = *reinterpret_cast<const bf16x8*>((const char*)Ks + KSWZ(32 + r32, cb));
    p0 = __builtin_amdgcn_mfma_f32_32x32x16_bf16(b0, qr[d0], p0, 0, 0, 0);
    p1 = __builtin_amdgcn_mfma_f32_32x32x16_bf16(b1, qr[d0], p1, 0, 0, 0); }
}
__device__ __forceinline__ int v_st(int k, int c) { const int kk = (k & ~0xC) | ((k & 4) << 1) | ((k & 8) >> 1); return ((kk >> 3) * 4 + (c >> 5)) * 512 + ((kk & 7) * 32 + (c & 31)) * 2; }
__device__ __forceinline__ int v_rd_base(int lane) { return ((lane & 3) << 3) | (((lane >> 2) & 3) << 6) | (((lane >> 4) & 1) << 5) | (((lane >> 5) & 1) << 8); }
constexpr int v_rd_off(int d0, int ks, int half) { return d0 * 512 + ks * 4096 + half * 2048; }
template <int OFF> __device__ __forceinline__ s16x4 tr_read(int vb) { s16x4 r; asm volatile("ds_read_b64_tr_b16 %0, %1 offset:%2" : "=&v"(r) : "v"(vb), "i"(OFF) : "memory"); return r; }
template <int D0> __device__ __forceinline__ void pv_one(f32x16& od, int vb, bf16x8 pa0, bf16x8 pa1, bf16x8 pa2, bf16x8 pa3) {
  const s16x4 l0 = tr_read<v_rd_off(D0, 0, 0)>(vb), h0 = tr_read<v_rd_off(D0, 0, 1)>(vb), l1 = tr_read<v_rd_off(D0, 1, 0)>(vb), h1 = tr_read<v_rd_off(D0, 1, 1)>(vb);
  const s16x4 l2 = tr_read<v_rd_off(D0, 2, 0)>(vb), h2 = tr_read<v_rd_off(D0, 2, 1)>(vb), l3 = tr_read<v_rd_off(D0, 3, 0)>(vb), h3 = tr_read<v_rd_off(D0, 3, 1)>(vb);
  asm volatile("s_waitcnt lgkmcnt(0)" ::: "memory"); SBAR();
#define PK(L, H) (bf16x8){L[0], L[1], L[2], L[3], H[0], H[1], H[2], H[3]}
  od = __builtin_amdgcn_mfma_f32_32x32x16_bf16(pa0, PK(l0, h0), od, 0, 0, 0);
  od = __builtin_amdgcn_mfma_f32_32x32x16_bf16(pa1, PK(l1, h1), od, 0, 0, 0);
  od = __builtin_amdgcn_mfma_f32_32x32x16_bf16(pa2, PK(l2, h2), od, 0, 0, 0);
  od = __builtin_amdgcn_mfma_f32_32x32x16_bf16(pa3, PK(l3, h3), od, 0, 0, 0);
#undef PK
}
__device__ __forceinline__ void pv_d0(f32x16* o, int vb, bf16x8 pa0, bf16x8 pa1, bf16x8 pa2, bf16x8 pa3) {
  pv_one<0>(o[0], vb, pa0, pa1, pa2, pa3); pv_one<1>(o[1], vb, pa0, pa1, pa2, pa3); pv_one<2>(o[2], vb, pa0, pa1, pa2, pa3); pv_one<3>(o[3], vb, pa0, pa1, pa2, pa3);
}
__device__ __forceinline__ void body(const bf16x8 (&qr)[8], const bf16* __restrict__ Kh, const bf16* __restrict__ Vh, bf16* __restrict__ Ob, int seq, char* lds, const Msk mk) {
  int tid_ = threadIdx.x; asm volatile("" : "+v"(tid_));
  const int tid = tid_, wid = tid >> 6, lane = tid & 63, r32 = lane & 31, hi = lane >> 5;
  bf16* V_lds = (bf16*)lds; bf16* K_lds = (bf16*)(lds + 2 * SHM_V);
  float* ws = (float*)(lds + 2 * SHM_V + 2 * SHM_K) + wid * 64; float* li_l = ws; float* al_l = ws + 32;
  float m_reg = -1e30f, l_reg = 0; f32x16 o[4] = {};
#define VB0() ({ int l2_ = lane; asm volatile("" : "+v"(l2_)); (int)(uintptr_t)V_lds + v_rd_base(l2_); })
  struct { bf16x8 vs0, vs1, ks0, ks1; } sr_[1];
#define STG_IDX() int t2_ = tid; asm volatile("" : "+v"(t2_)); const int sr = t2_ >> 4, sc = (t2_ & 15) * 8
#define SLOAD(i, k0) do { STG_IDX(); const unsigned goff0 = (unsigned)((sr * LDK + sc) * 2), goff1 = (unsigned)(((32 + sr) * LDK + sc) * 2); \
    const char* vb_ = (const char*)(Vh + (long)(k0) * LDK); const char* kb_ = (const char*)(Kh + (long)(k0) * LDK); \
    sr_[i].vs0 = *(const bf16x8*)(vb_ + goff0); sr_[i].vs1 = *(const bf16x8*)(vb_ + goff1); sr_[i].ks0 = *(const bf16x8*)(kb_ + goff0); sr_[i].ks1 = *(const bf16x8*)(kb_ + goff1); } while (0)
#define SWRITE(b, i) do { STG_IDX(); const int vst0 = v_st(sr, sc), vst1 = v_st(32 + sr, sc); *(bf16x8*)((char*)V_lds + (b) * SHM_V + vst0) = sr_[i].vs0; *(bf16x8*)((char*)V_lds + (b) * SHM_V + vst1) = sr_[i].vs1; int kc = sc * 2; \
    *(bf16x8*)((char*)K_lds + (b) * SHM_K + KSWZ(sr, kc)) = sr_[i].ks0; *(bf16x8*)((char*)K_lds + (b) * SHM_K + KSWZ(32 + sr, kc)) = sr_[i].ks1; } while (0)
#define SWAIT() asm volatile("s_waitcnt vmcnt(0)" ::: "memory")
#define RESC(a) do { if (__any((a) < 1.f)) { if (hi == 0) al_l[r32] = (a); asm volatile("s_waitcnt lgkmcnt(0)" ::: "memory"); \
    _Pragma("unroll") for (int d = 0; d < 4; ++d) _Pragma("unroll") for (int r = 0; r < 16; ++r) o[d][r] *= al_l[crow(r, hi)]; } } while (0)
  f32x16 pA0, pA1, pB0, pB1; float mnA, mnB, alA, alB; bf16x8 pa0, pa1, pa2, pa3; const int NT = seq / KVBLK;
  constexpr int SE = 0, SO = 0;
  SLOAD(SE, 0); asm volatile("s_waitcnt vmcnt(0)" ::: "memory"); SWRITE(0, SE); __syncthreads();
  qkt(pA0, pA1, K_lds, qr, r32, hi, 0, mk); partialSM(pA0, pA1, m_reg, mnA, alA, 0, mk, hi);
  SLOAD(SO, KVBLK);
  SWAIT(); SWRITE(1, SO); __syncthreads();
#pragma unroll 1
  for (int j = 1; j + 1 < NT; j += 2) {
    SBAR(); qkt(pB0, pB1, (bf16*)((char*)K_lds + SHM_K), qr, r32, hi, j, mk);
    finishSM(pA0, pA1, alA, l_reg, pa0, pa1, pa2, pa3); SBAR();
    SLOAD(SO, (j + 1) * KVBLK); SBAR();
    pv_d0(o, VB0(), pa0, pa1, pa2, pa3); partialSM(pB0, pB1, m_reg, mnB, alB, j, mk, hi);
    __syncthreads(); SWAIT(); SWRITE(0, SE);
    RESC(alB); __syncthreads();
    SBAR(); qkt(pA0, pA1, K_lds, qr, r32, hi, j + 1, mk);
    finishSM(pB0, pB1, alB, l_reg, pa0, pa1, pa2, pa3); SBAR();
    SLOAD(SE, (j + 2) * KVBLK); SBAR();
    pv_d0(o, VB0() + (int)SHM_V, pa0, pa1, pa2, pa3); partialSM(pA0, pA1, m_reg, mnA, alA, j + 1, mk, hi);
    __syncthreads(); SWAIT(); SWRITE(1, SO);
    RESC(alA); __syncthreads();
  }
  SBAR(); qkt(pB0, pB1, (bf16*)((char*)K_lds + SHM_K), qr, r32, hi, NT - 1, mk);
  finishSM(pA0, pA1, alA, l_reg, pa0, pa1, pa2, pa3); SBAR();
  pv_d0(o, VB0(), pa0, pa1, pa2, pa3); partialSM(pB0, pB1, m_reg, mnB, alB, NT - 1, mk, hi);
  __syncthreads(); RESC(alB);
  finishSM(pB0, pB1, alB, l_reg, pa0, pa1, pa2, pa3); SBAR();
  pv_d0(o, VB0() + (int)SHM_V, pa0, pa1, pa2, pa3);
  if (hi == 0) li_l[r32] = l_reg; asm volatile("s_waitcnt lgkmcnt(0)" ::: "memory");
  float rli[16];
#pragma unroll
for (int r = 0; r < 16; ++r) rli[r] = __builtin_amdgcn_rcpf(li_l[crow(r, hi)]);
  bf16* Ow = Ob + (long)(wid * QBLK) * LDO;
#pragma unroll
for (int r = 0; r < 16; ++r) { int orow = crow(r, hi);
#pragma unroll
for (int d0 = 0; d0 < 4; ++d0) { const float v = o[d0][r] * rli[r]; unsigned u = __float_as_uint(v); u = (u + 0x7fffu + ((u >> 16) & 1u)) >> 16; Ow[(long)orow * LDO + d0 * 32 + r32] = (bf16)u; } }
#undef SLOAD
#undef VB0
#undef STG_IDX
#undef SWRITE
#undef SWAIT
#undef RESC
}
#undef KSWZ
#undef SBAR
}


constexpr int NWAVES = 8, NTHR = 512;
constexpr int MTOK = 32768, DM = 1024, SEQ = 2048, NB = 16, DFF = 2816;
constexpr size_t MiB = 1u << 20;
constexpr size_t WS_CTL = 0, CTL_ZERO_BYTES = 64 * 1024;
constexpr size_t WS_W_MIXIN = 1 * MiB, WS_W_MIXOUT = 13 * MiB, WS_W_FFNIN = 17 * MiB, WS_W_FFNOUT = 28 * MiB;
constexpr size_t WS_GATESA = 34 * MiB, WS_SSQA = 35 * MiB, WS_STATC = 492 * MiB, WS_KMEAN = 41 * MiB, WS_SSQH = 42 * MiB, WS_SPTAB = 33 * MiB + 512 * 1024;
constexpr size_t WS_U = 44 * MiB, WS_BIG = 108 * MiB, WS_END = 500 * MiB;
constexpr int CW_BAR = 1024;
static_assert((CW_BAR + 3456) * 4 <= (int)CTL_ZERO_BYTES, "ctl");
constexpr int LDS_BYTES = 163840, MISC_OFF = 163584;

typedef unsigned u32x4 __attribute__((ext_vector_type(4)));
typedef unsigned u32x2 __attribute__((ext_vector_type(2)));
typedef float f32x2 __attribute__((ext_vector_type(2)));
struct Frame { LAS unsigned char* lds; int tid, lane, wave, G; };
struct Args { const void* in[24]; float* out; unsigned char* ws; int ph_lo, ph_hi; };

__device__ __forceinline__ float wave_sum(float v) {
#pragma unroll
    for (int o = 1; o < 64; o <<= 1) v += __shfl_xor(v, o);
    return v;
}
__device__ __forceinline__ float bf2f(bf16 b) { return __uint_as_float(((unsigned)b) << 16); }
__device__ __forceinline__ float lo_bf(unsigned w) { return __uint_as_float(w << 16); }
__device__ __forceinline__ float hi_bf(unsigned w) { return __uint_as_float(w & 0xffff0000u); }
__device__ __forceinline__ unsigned cvtpk(float lo, float hi) { return pg8::cvt_pk_bf16(lo, hi); }

typedef short v4s16 __attribute__((ext_vector_type(4)));
template <int LD> __device__ __forceinline__ bf16x8 tr_frag(const LAS bf16* T, int r0, int c0, int lane) {
    const int fr = lane & 15, fq = lane >> 4;
    const LAS bf16* a = T + (r0 + 8 * fq + (fr >> 2)) * LD + c0 + 4 * (fr & 3);
    const v4s16 lo = __builtin_amdgcn_ds_read_tr16_b64_v4i16((LAS v4s16*)a);
    const v4s16 hi = __builtin_amdgcn_ds_read_tr16_b64_v4i16((LAS v4s16*)(a + 4 * LD));
    return __builtin_shufflevector(lo, hi, 0, 1, 2, 3, 4, 5, 6, 7);
}
template <int MT, int NT, int K, int LDA, int LDB, bool TA = false, bool TB = false, bool SB = true>
__device__ __forceinline__ void wgemm(f32x4 (&acc)[MT][NT], const LAS bf16* A, const LAS bf16* Bt, int lane) {
    const int fr = lane & 15, fq = lane >> 4;
    const LAS bf16* ap = A + fr * LDA + 8 * fq;
    const LAS bf16* bp = Bt + fr * LDB + 8 * fq;
#pragma unroll
    for (int k0 = 0; k0 < K; k0 += 32) {
        bf16x8 a[MT], b[NT];
#pragma unroll
        for (int i = 0; i < MT; ++i) a[i] = TA ? tr_frag<LDA>(A, k0, 16 * i, lane) : *(const LAS bf16x8*)(ap + 16 * i * LDA + k0);
#pragma unroll
        for (int j = 0; j < NT; ++j) b[j] = TB ? tr_frag<LDB>(Bt, k0, 16 * j, lane) : *(const LAS bf16x8*)(bp + 16 * j * LDB + k0);
#pragma unroll
        for (int i = 0; i < MT; ++i)
#pragma unroll
            for (int j = 0; j < NT; ++j) acc[i][j] = __builtin_amdgcn_mfma_f32_16x16x32_bf16(a[i], b[j], acc[i][j], 0, 0, 0);
        if (SB && MT * NT >= 4) __builtin_amdgcn_sched_barrier(0);
    }
    if (!SB) __builtin_amdgcn_sched_barrier(0);
}

__device__ __forceinline__ int cvt_src_col(int mode, int g0) {
    if (mode == 0) return g0;
    const int pn = g0 >> 8, r = g0 & 255;
    if (mode == 1) return r < 128 ? 128 * pn + r : DFF + 128 * pn + (r - 128);
    return r < 128 ? 128 * pn + r : 256 + 128 * pn + (r - 128);
}
__device__ __forceinline__ void cvt_matrix(Frame& F, const float* W, int ldw, int K, int Np, int mode, bf16* WT, const float* gain = nullptr) {
    LAS float* scr = (LAS float*)(F.lds + F.wave * 16384);
    const int gw = blockIdx.x * NWAVES + F.wave, NGW = F.G * NWAVES, lane = F.lane;
    const int nblk = Np / 32, nitems = (K / 64) * nblk;
    float v[32], vn[32];
#define CVT_LOAD(dst, it) do { const int kb_ = (it) / nblk, nb_ = (it) % nblk, s0_ = cvt_src_col(mode, 32 * nb_); const float* wp_ = W + (size_t)(64 * kb_ + (lane >> 5)) * ldw + s0_ + (lane & 31); \
        _Pragma("unroll") for (int i = 0; i < 32; ++i) dst[i] = wp_[(size_t)(2 * i) * ldw]; } while (0)
    int item = gw;
    if (item < nitems) CVT_LOAD(v, item);
    for (; item < nitems; item += NGW) {
        const int kb = item / nblk, nb = item % nblk, k0 = 64 * kb, n0 = 32 * nb;
        if (item + NGW < nitems) CVT_LOAD(vn, item + NGW);
        if (gain) {
#pragma unroll
            for (int i = 0; i < 32; ++i) v[i] *= gain[k0 + 2 * i + (lane >> 5)]; }
#pragma unroll
        for (int i = 0; i < 32; ++i) scr[(2 * i + (lane >> 5)) * 33 + (lane & 31)] = v[i];
        LDS_WAIT(); asm volatile("" ::: "memory");
        const int c = lane & 7;
#pragma unroll
        for (int j = 0; j < 4; ++j) { const int n = (lane >> 3) + 8 * j; const LAS float* sp = scr + (8 * c) * 33 + n;
            v4u o; o.x = pk2(sp[0 * 33], sp[1 * 33]); o.y = pk2(sp[2 * 33], sp[3 * 33]); o.z = pk2(sp[4 * 33], sp[5 * 33]); o.w = pk2(sp[6 * 33], sp[7 * 33]);
            *(v4u*)(WT + (size_t)(n0 + n) * K + k0 + 8 * c) = o; }
        LDS_WAIT(); asm volatile("" ::: "memory");
#pragma unroll
        for (int i = 0; i < 32; ++i) v[i] = vn[i];
    }
#undef CVT_LOAD
}

__device__ __forceinline__ void norm_phase_b(Frame& F, const bf16* src, const float* gain, bf16* dst) {
    const int gw = blockIdx.x * NWAVES + F.wave, NGW = F.G * NWAVES, lane = F.lane;
    f32x4 g[4];
#pragma unroll
    for (int j = 0; j < 2; ++j) { g[2 * j] = *(const f32x4*)(gain + 8 * lane + 512 * j); g[2 * j + 1] = *(const f32x4*)(gain + 8 * lane + 512 * j + 4); }
    v4u cur[2], nxt[2];
    if (gw < MTOK) {
#pragma unroll
        for (int j = 0; j < 2; ++j) cur[j] = *(const v4u*)(src + (size_t)gw * DM + 8 * lane + 512 * j); }
    for (int m = gw; m < MTOK; m += NGW) {
        if (m + NGW < MTOK) {
#pragma unroll
            for (int j = 0; j < 2; ++j) nxt[j] = *(const v4u*)(src + (size_t)(m + NGW) * DM + 8 * lane + 512 * j); }
        f32x4 v[4]; float s = 0.f;
#pragma unroll
        for (int j = 0; j < 2; ++j) { v[2 * j] = (f32x4){lo_bf(cur[j].x), hi_bf(cur[j].x), lo_bf(cur[j].y), hi_bf(cur[j].y)}; v[2 * j + 1] = (f32x4){lo_bf(cur[j].z), hi_bf(cur[j].z), lo_bf(cur[j].w), hi_bf(cur[j].w)}; }
#pragma unroll
        for (int k = 0; k < 4; ++k) s += (v[k].x * v[k].x + v[k].y * v[k].y) + (v[k].z * v[k].z + v[k].w * v[k].w);
        const float rstd = 1.0f / sqrtf(wave_sum(s) * (1.0f / DM) + 1e-6f);
#pragma unroll
        for (int j = 0; j < 2; ++j) { const f32x4 a = v[2 * j] * rstd * g[2 * j], b = v[2 * j + 1] * rstd * g[2 * j + 1];
            v4u o; o.x = cvtpk(a.x, a.y); o.y = cvtpk(a.z, a.w); o.z = cvtpk(b.x, b.y); o.w = cvtpk(b.z, b.w);
            *(v4u*)(dst + (size_t)m * DM + 8 * lane + 512 * j) = o; }
        cur[0] = nxt[0]; cur[1] = nxt[1];
    }
}
template <bool GATES>
__device__ __forceinline__ void norm_phase(Frame& F, const float* src, const float* gain, bf16* dst, const float* wA, const float* bA, float* gout) {
    LAS float* wg = (LAS float*)F.lds;
    if (GATES) {
        for (int i = F.tid; i < 1024 * 8; i += NTHR) { const int k = i >> 3, q8 = i & 7;
            wg[(((((k >> 8) * 4 + (k & 3)) * 2 + (q8 >> 2)) * 64 + ((k & 255) >> 2)) << 2) + (q8 & 3)] = wA[(size_t)k * 3080 + 3072 + q8]; }
        __syncthreads();
    }
    const int gw = blockIdx.x * NWAVES + F.wave, NGW = F.G * NWAVES, lane = F.lane;
    f32x4 g[4];
#pragma unroll
    for (int j = 0; j < 4; ++j) g[j] = ((const f32x4*)gain)[lane + 64 * j];
    f32x4 v[4], vn[4];
    if (gw < MTOK) {
#pragma unroll
        for (int j = 0; j < 4; ++j) v[j] = ((const f32x4*)(src + (size_t)gw * DM) + lane)[64 * j]; }
    for (int m = gw; m < MTOK; m += NGW) {
        if (m + NGW < MTOK) {
#pragma unroll
            for (int j = 0; j < 4; ++j) vn[j] = ((const f32x4*)(src + (size_t)(m + NGW) * DM) + lane)[64 * j]; }
        float s = 0.f;
#pragma unroll
        for (int j = 0; j < 4; ++j) s += (v[j].x * v[j].x + v[j].y * v[j].y) + (v[j].z * v[j].z + v[j].w * v[j].w);
        const float rstd = 1.0f / sqrtf(wave_sum(s) * (1.0f / DM) + 1e-6f);
        unsigned long long* o8 = (unsigned long long*)(dst + (size_t)m * DM) + lane;
#pragma unroll
        for (int j = 0; j < 4; ++j) { v[j] = v[j] * rstd * g[j];
            o8[64 * j] = (unsigned long long)cvtpk(v[j].x, v[j].y) | ((unsigned long long)cvtpk(v[j].z, v[j].w) << 32); }
        if (GATES) {
            float a[8];
#pragma unroll
            for (int q = 0; q < 8; ++q) a[q] = 0.f;
#pragma unroll
            for (int j = 0; j < 4; ++j)
#pragma unroll
                for (int e = 0; e < 4; ++e) { const LAS float* wp = wg + ((((j * 4 + e) * 2) * 64 + lane) << 2); const f32x4 w0 = *(const LAS f32x4*)wp, w1 = *(const LAS f32x4*)(wp + 256); const float x = v[j][e];
                    a[0] += x * w0.x; a[1] += x * w0.y; a[2] += x * w0.z; a[3] += x * w0.w; a[4] += x * w1.x; a[5] += x * w1.y; a[6] += x * w1.z; a[7] += x * w1.w; }
#pragma unroll
            for (int q = 0; q < 8; ++q) a[q] = wave_sum(a[q]);
            if (lane == 0) { f32x4* gp = (f32x4*)(gout + (size_t)m * 8);
                gp[0] = (f32x4){a[0] + bA[0], a[1] + bA[1], a[2] + bA[2], a[3] + bA[3]}; gp[1] = (f32x4){a[4] + bA[4], a[5] + bA[5], a[6] + bA[6], a[7] + bA[7]}; }
        }
#pragma unroll
        for (int j = 0; j < 4; ++j) v[j] = vn[j];
    }
}

__device__ __forceinline__ void mlstm_pre(Frame& F, const float* gates, float* GT) {
    LAS float* sA = (LAS float*)F.lds, *sPM = sA + 2048, *sBC = sPM + 2048, *sBT = sBC + 2048, *sP63 = sBT + 32, *sM = sP63 + 32;
    const int lane = F.lane, w = F.wave;
    for (int item = blockIdx.x; item < 64; item += F.G) {
        const int b = item >> 2, h = item & 3;
        __syncthreads();
        float gi4[4], gf4[4];
#pragma unroll
        for (int i = 0; i < 4; ++i) { const size_t row = (size_t)b * SEQ + (w + 8 * i) * 64 + lane; gi4[i] = gates[row * 8 + h]; gf4[i] = gates[row * 8 + 4 + h]; }
#pragma unroll
        for (int i = 0; i < 4; ++i) { const int c = w + 8 * i;
            const float gi = gi4[i], gf = gf4[i];
            const float fc = fminf(gf, 0.f) - log1pf(__expf(-fabsf(gf)));
            float bc = fc;
#pragma unroll
            for (int o = 1; o < 64; o <<= 1) { const float t = __shfl_up(bc, o); if (lane >= o) bc += t; }
            const float a = gi - bc; float pm = a;
#pragma unroll
            for (int o = 1; o < 64; o <<= 1) { const float t = __shfl_up(pm, o); if (lane >= o) pm = fmaxf(pm, t); }
            sA[c * 64 + lane] = a; sPM[c * 64 + lane] = pm; sBC[c * 64 + lane] = bc; if (lane == 63) { sBT[c] = bc; sP63[c] = pm; } }
        __syncthreads();
        if (F.tid == 0) { float m = 0.f; for (int c = 0; c < 32; ++c) { sM[c] = m; m = sBT[c] + fmaxf(m, sP63[c]); } }
        __syncthreads();
#pragma unroll
        for (int i = 0; i < 4; ++i) { const int c = w + 8 * i; const float mst = sM[c], Mx = fmaxf(mst, sPM[c * 64 + lane]), Mx63 = fmaxf(mst, sP63[c]);
            float* g = GT + ((size_t)(item * 32 + c)) * 320 + lane;
            g[0] = sA[c * 64 + lane]; g[64] = Mx; g[128] = __expf(mst - Mx); g[192] = __expf(-(sBC[c * 64 + lane] + Mx)); g[256] = __expf(sA[c * 64 + lane] - Mx63); }
    }
}
__device__ __forceinline__ void mlstm_pmat(Frame& F, const bf16* QKV, const float* GT, bf16* PMA, float* DENP) {
    constexpr float SCALE = 0.08838834764831845f;
    LAS bf16* Qs = (LAS bf16*)F.lds;
    LAS bf16* Ks = Qs + 64 * 136;
    LAS bf16* Ps = Ks + 64 * 136;
    LAS float* fA = (LAS float*)(Ps + 64 * 72), *fMX = fA + 64;
    const int tid = F.tid, lane = F.lane, w = F.wave, fr = lane & 15, fq = lane >> 4, wh = w >> 1, wl = w & 1;
    const unsigned qoff0 = (unsigned)((((tid >> 4) * 2048) + (tid & 15) * 8) * 2);
    v4u pQ[2], pK[2]; float pg = 0.f;
    int item = blockIdx.x;
    if (item < 2048) { const int bh = item >> 5, c = item & 31; const char* gq = (const char*)(QKV + ((size_t)(bh >> 2) * SEQ + c * 64) * 2048 + (bh & 3) * 128);
#pragma unroll
        for (int i = 0; i < 2; ++i) { pQ[i] = *(const v4u*)(gq + qoff0 + i * (32 * 2048 * 2)); pK[i] = *(const v4u*)(gq + qoff0 + i * (32 * 2048 * 2) + 1024); }
        if (tid < 128) pg = GT[(size_t)item * 320 + tid]; }
    for (; item < 2048; item += F.G) {
        __syncthreads();
#pragma unroll
        for (int i = 0; i < 2; ++i) { const int id = tid + NTHR * i, row = id >> 4, c8 = id & 15; *(LAS v4u*)(Qs + row * 136 + c8 * 8) = pQ[i]; *(LAS v4u*)(Ks + row * 136 + c8 * 8) = pK[i]; }
        if (tid < 128) fA[tid] = pg;
        const int nit = item + F.G;
        if (nit < 2048) { const int bh = nit >> 5, c = nit & 31; const char* gq = (const char*)(QKV + ((size_t)(bh >> 2) * SEQ + c * 64) * 2048 + (bh & 3) * 128);
#pragma unroll
            for (int i = 0; i < 2; ++i) { pQ[i] = *(const v4u*)(gq + qoff0 + i * (32 * 2048 * 2)); pK[i] = *(const v4u*)(gq + qoff0 + i * (32 * 2048 * 2) + 1024); }
            if (tid < 128) pg = GT[(size_t)nit * 320 + tid]; }
        __syncthreads();
        f32x4 sa[1][2]; sa[0][0] = (f32x4){0.f, 0.f, 0.f, 0.f}; sa[0][1] = sa[0][0];
        wgemm<1, 2, 128, 136, 136>(sa, Qs + 16 * wh * 136, Ks + 32 * wl * 136, lane);
        float rs[4] = {0.f, 0.f, 0.f, 0.f};
#pragma unroll
        for (int e = 0; e < 4; ++e) { const int t = 16 * wh + 4 * fq + e; const float mx = fMX[t];
#pragma unroll
            for (int j = 0; j < 2; ++j) { const int sidx = 32 * wl + 16 * j + fr; const float wgt = (sidx <= t) ? SCALE * __expf(fA[sidx] - mx) : 0.f; const float p = sa[0][j][e] * wgt;
                Ps[t * 72 + sidx] = (bf16)f2bf(p); rs[e] += p; } }
#pragma unroll
        for (int e = 0; e < 4; ++e) { float r = rs[e]; r += __shfl_xor(r, 1); r += __shfl_xor(r, 2); r += __shfl_xor(r, 4); r += __shfl_xor(r, 8); if (fr == 0) DENP[(size_t)item * 128 + wl * 64 + 16 * wh + 4 * fq + e] = r; }
        __syncthreads();
        *(v4u*)(PMA + (size_t)item * 4096 + (tid >> 3) * 64 + (tid & 7) * 8) = *(const LAS v4u*)(Ps + (tid >> 3) * 72 + (tid & 7) * 8);
    }
}
__device__ __forceinline__ void mlstm_core(Frame& F, const bf16* QKV, const float* GT, const bf16* PMA, const float* DENP, bf16* hout, float* ssq) {
    constexpr float SCALE = 0.08838834764831845f;
    LAS bf16* Qs = (LAS bf16*)F.lds;
    LAS bf16* Ks = Qs + 64 * 136;
    LAS bf16* Vs = Ks + 64 * 144;
    LAS bf16* VWs = Vs + 64 * 80;
    LAS bf16* Cb = VWs + 64 * 80;
    LAS bf16* Ps = Cb + 80 * 136;
    LAS bf16* Hs = Ps + 64 * 72;
    const int tid = F.tid, lane = F.lane, w = F.wave, fr = lane & 15, fq = lane >> 4, wh = w >> 1, wl = w & 1;
    const unsigned qoff0 = (unsigned)((((tid >> 4) * 2048) + (tid & 15) * 8) * 2), voff0 = (unsigned)((((tid >> 3) * 2048) + (tid & 7) * 8) * 2);
    for (int item = blockIdx.x; item < 256; item += F.G) {
        const int it2 = (((item & 7) * 8 + ((item >> 3) >> 2)) << 2) | ((item >> 3) & 3);
        const int b = it2 >> 4, h = (it2 >> 2) & 3, vs = it2 & 3, bh = b * 4 + h;
        f32x4 Cacc[1][4], Cn[1][1];
#pragma unroll
        for (int j = 0; j < 4; ++j) Cacc[0][j] = (f32x4){0.f, 0.f, 0.f, 0.f};
        Cn[0][0] = (f32x4){0.f, 0.f, 0.f, 0.f};
        const size_t tb = (size_t)b * SEQ;
        v4u pQ[2], pK[2], pV, pP; float pws, pwc, pwi[4], pem[4], pdn[4];
#define MLSTM_FETCH(cc) do { const size_t t0_ = tb + (size_t)(cc) * 64; const char* gq_ = (const char*)(QKV + t0_ * 2048 + h * 128); const char* gv_ = (const char*)(QKV + t0_ * 2048 + 1024 + h * 256 + vs * 64); \
            _Pragma("unroll") for (int i = 0; i < 2; ++i) { pQ[i] = *(const v4u*)(gq_ + qoff0 + i * (32 * 2048 * 2)); pK[i] = *(const v4u*)(gq_ + qoff0 + i * (32 * 2048 * 2) + 1024); } \
            pV = *(const v4u*)(gv_ + voff0); const size_t it_ = (size_t)(bh * 32 + (cc)); pP = *(const v4u*)(PMA + it_ * 4096 + (tid >> 3) * 64 + (tid & 7) * 8); \
            const float* g_ = GT + it_ * 320; pws = g_[256 + (tid >> 3)]; pwc = g_[128 + 63]; \
            _Pragma("unroll") for (int e = 0; e < 4; ++e) { const int t_ = 16 * wh + 4 * fq + e; pwi[e] = g_[128 + t_]; pem[e] = g_[192 + t_]; pdn[e] = DENP[it_ * 128 + t_] + DENP[it_ * 128 + 64 + t_]; } } while (0)
        MLSTM_FETCH(0);
        for (int c = 0; c < 32; ++c) {
            const size_t t0 = tb + c * 64;
            __syncthreads();
            v4u hprev; if (c > 0) hprev = *(const LAS v4u*)(Hs + (tid >> 3) * 72 + (tid & 7) * 8);
#pragma unroll
            for (int j = 0; j < 4; ++j)
#pragma unroll
                for (int e = 0; e < 4; ++e) Cb[(16 * wh + 4 * fq + e) * 136 + 64 * wl + 16 * j + fr] = (bf16)f2bf(Cacc[0][j][e]);
#pragma unroll
            for (int e = 0; e < 4; ++e) Cb[(64 + 4 * fq + e) * 136 + 16 * w + fr] = (bf16)f2bf(Cn[0][0][e]);
#pragma unroll
            for (int i = 0; i < 2; ++i) { const int id = tid + NTHR * i, row = id >> 4, c8 = id & 15; *(LAS v4u*)(Qs + row * 136 + c8 * 8) = pQ[i]; *(LAS v4u*)(Ks + row * 144 + c8 * 8) = pK[i]; }
            { const int srow = tid >> 3, c8 = tid & 7; const float wsv = pws;
                *(LAS v4u*)(Vs + srow * 80 + c8 * 8) = pV;
                v4u o; o.x = cvtpk(lo_bf(pV.x) * wsv, hi_bf(pV.x) * wsv); o.y = cvtpk(lo_bf(pV.y) * wsv, hi_bf(pV.y) * wsv); o.z = cvtpk(lo_bf(pV.z) * wsv, hi_bf(pV.z) * wsv); o.w = cvtpk(lo_bf(pV.w) * wsv, hi_bf(pV.w) * wsv);
                *(LAS v4u*)(VWs + srow * 80 + c8 * 8) = o;
                if (c8 < 2) { v4u one; one.x = c8 == 0 ? 0x3f80u : 0u; one.y = 0u; one.z = 0u; one.w = 0u; *(LAS v4u*)(Vs + srow * 80 + 64 + c8 * 8) = one;
                    v4u wv; wv.x = c8 == 0 ? (cvtpk(wsv, 0.f) & 0xffffu) : 0u; wv.y = 0u; wv.z = 0u; wv.w = 0u; *(LAS v4u*)(VWs + srow * 80 + 64 + c8 * 8) = wv; }
                *(LAS v4u*)(Ps + srow * 72 + c8 * 8) = pP; }
            float wi[4], em[4], dn[4]; const float wc = pwc;
#pragma unroll
            for (int e = 0; e < 4; ++e) { wi[e] = pwi[e]; em[e] = pem[e]; dn[e] = pdn[e]; }
            if (c < 31) MLSTM_FETCH(c + 1);
            if (c > 0) *(v4u*)(hout + (t0 - 64 + (tid >> 3)) * 1024 + h * 256 + vs * 64 + (tid & 7) * 8) = hprev;
            __syncthreads();
            f32x4 ni[1][2], nx[1][2], nq[1][1]; ni[0][0] = (f32x4){0.f, 0.f, 0.f, 0.f}; ni[0][1] = ni[0][0]; nx[0][0] = ni[0][0]; nx[0][1] = ni[0][0]; nq[0][0] = ni[0][0];
            wgemm<1, 2, 64, 72, 80, false, true>(ni, Ps + 16 * wh * 72, Vs + 32 * wl, lane);
            wgemm<1, 2, 128, 136, 136>(nx, Qs + 16 * wh * 136, Cb + 32 * wl * 136, lane);
            wgemm<1, 1, 128, 136, 136>(nq, Qs + 16 * wh * 136, Cb + 64 * 136, lane);
#pragma unroll
            for (int e = 0; e < 4; ++e) { const int t = 16 * wh + 4 * fq + e;
                const float nqt = __shfl(nq[0][0][e], lane & 48);
                const float den = dn[e] + wi[e] * SCALE * nqt; const float inv = 1.0f / fmaxf(fabsf(den), em[e]); float q2 = 0.f;
#pragma unroll
                for (int j = 0; j < 2; ++j) { const float hv = (ni[0][j][e] + SCALE * wi[e] * nx[0][j][e]) * inv; q2 += hv * hv;
                    Hs[t * 72 + 32 * wl + 16 * j + fr] = (bf16)f2bf(hv); }
                q2 += __shfl_xor(q2, 1); q2 += __shfl_xor(q2, 2); q2 += __shfl_xor(q2, 4); q2 += __shfl_xor(q2, 8);
                if (fr == 0) ssq[(t0 + t) * 32 + (h * 4 + vs) * 2 + wl] = q2; }
#pragma unroll
            for (int j = 0; j < 4; ++j) Cacc[0][j] = Cacc[0][j] * wc;
            Cn[0][0] = Cn[0][0] * wc;
            wgemm<1, 4, 64, 80, 144, true, true>(Cacc, VWs + 16 * wh, Ks + 64 * wl, lane);
            wgemm<1, 1, 64, 80, 144, true, true>(Cn, VWs + 64, Ks + 16 * w, lane);
        }
        __syncthreads();
        *(v4u*)(hout + (tb + 31 * 64 + (tid >> 3)) * 1024 + h * 256 + vs * 64 + (tid & 7) * 8) = *(const LAS v4u*)(Hs + (tid >> 3) * 72 + (tid & 7) * 8);
#undef MLSTM_FETCH
    }
}

__device__ __forceinline__ void moba_prep(Frame& F, bf16* QK, const int* pos, const float* gq, const float* gk, float* kpart) {
    LAS float* part = (LAS float*)F.lds;
    const int lane = F.lane, w = F.wave, c = lane & 15;
    float gqv[8], gkv[8], inv[8];
#pragma unroll
    for (int e = 0; e < 8; ++e) { gqv[e] = gq[c * 8 + e]; gkv[e] = gk[c * 8 + e]; inv[e] = exp2f(-(float)(8 * (c & 1) + e) * (18.931568569324174f / 16.0f)); }
    for (int item = blockIdx.x; item < 256; item += F.G) {
        const int b = item >> 4, blk = (item >> 1) & 7, half = item & 1;
        const size_t row0 = (size_t)b * SEQ + blk * 256 + half * 128 + 16 * w;
        float kacc[2][8];
#pragma unroll
        for (int i = 0; i < 2; ++i)
#pragma unroll
            for (int e = 0; e < 8; ++e) kacc[i][e] = 0.f;
        v4u cur[4], nxt[4];
#pragma unroll
        for (int i4 = 0; i4 < 4; ++i4) cur[i4] = *(const v4u*)(QK + row0 * 3072 + (lane + 64 * i4) * 8);
        for (int t = 0; t < 16; ++t) {
            const size_t row = row0 + t;
            if (t < 15) {
#pragma unroll
                for (int i4 = 0; i4 < 4; ++i4) nxt[i4] = *(const v4u*)(QK + (row + 1) * 3072 + (lane + 64 * i4) * 8); }
            float cs[8], sn[8];
            if (c < 4) { const float ps = (float)pos[row];
#pragma unroll
                for (int e = 0; e < 8; ++e) sincosf(ps * inv[e], &sn[e], &cs[e]); }
            else {
#pragma unroll
                for (int e = 0; e < 8; ++e) { cs[e] = 1.f; sn[e] = 0.f; } }
#pragma unroll
            for (int i4 = 0; i4 < 4; ++i4) {
                const unsigned xw[4] = {cur[i4].x, cur[i4].y, cur[i4].z, cur[i4].w}; float y[8]; float ss = 0.f;
#pragma unroll
                for (int e = 0; e < 4; ++e) { y[2 * e] = lo_bf(xw[e]); y[2 * e + 1] = hi_bf(xw[e]); ss += y[2 * e] * y[2 * e] + y[2 * e + 1] * y[2 * e + 1]; }
                ss += __shfl_xor(ss, 1); ss += __shfl_xor(ss, 2); ss += __shfl_xor(ss, 4); ss += __shfl_xor(ss, 8);
                const float rstd = 1.0f / sqrtf(ss * (1.0f / 128.0f) + 1e-6f);
#pragma unroll
                for (int e = 0; e < 8; ++e) { y[e] = y[e] * rstd * (i4 < 2 ? gqv[e] : gkv[e]); }
#pragma unroll
                for (int e = 0; e < 8; ++e) { const float o = __shfl_xor(y[e], 2); y[e] = (c < 2) ? y[e] * cs[e] - o * sn[e] : (c < 4 ? y[e] * cs[e] + o * sn[e] : y[e]); }
                v4u ov; ov.x = cvtpk(y[0], y[1]); ov.y = cvtpk(y[2], y[3]); ov.z = cvtpk(y[4], y[5]); ov.w = cvtpk(y[6], y[7]);
                *(v4u*)(QK + row * 3072 + (lane + 64 * i4) * 8) = ov;
                if (i4 >= 2) {
#pragma unroll
                    for (int e = 0; e < 8; ++e) kacc[i4 - 2][e] += y[e]; }
            }
#pragma unroll
            for (int i4 = 0; i4 < 4; ++i4) cur[i4] = nxt[i4];
        }
        __syncthreads();
#pragma unroll
        for (int i = 0; i < 2; ++i)
#pragma unroll
            for (int e = 0; e < 8; ++e) part[w * 1024 + i * 512 + lane * 8 + e] = kacc[i][e];
        __syncthreads();
        for (int col = F.tid; col < 1024; col += NTHR) { float sacc = 0.f;
#pragma unroll
            for (int ww = 0; ww < 8; ++ww) sacc += part[ww * 1024 + col];
            kpart[((size_t)(b * 8 + blk) * 2 + half) * 1024 + col] = sacc * (1.0f / 256.0f); }
    }
}
__device__ __forceinline__ void moba_attn(Frame& F, const bf16* QKV, const float* kpart, bf16* O) {
    char* ldsg = (char*)F.lds;
    LAS float* kmS = (LAS float*)(F.lds + mattn::SHM_ATTN);
    for (int it = blockIdx.x; it < 1024; it += F.G) {
        int tid_ = threadIdx.x; asm volatile("" : "+v"(tid_));
        const int tid = tid_, lane = tid & 63, w = __builtin_amdgcn_readfirstlane(tid >> 6), r32 = lane & 31, hi = lane >> 5;
        const int c = it & 255, r = it >> 8, bh = c & 127, typ = c >> 7, b = bh >> 3, h = bh & 7;
        const int jb = (r & 1) ? 7 - (r >> 1) : (r >> 1);
        const int j = typ ? ((r & 1) ? jb - 2 : jb + 2) : jb;
        const size_t qrow0 = (size_t)b * SEQ + j * 256;
        __syncthreads();
        for (int i = tid; i < 1024; i += NTHR) { const int kb_ = i >> 7, d_ = i & 127; const float* kp = kpart + ((size_t)(b * 8 + kb_) * 2) * 1024 + h * 128 + d_; kmS[i] = kp[0] + kp[1024]; }
        mattn::bf16x8 qr[8];
        { const bf16* Qw = QKV + (qrow0 + w * 32 + r32) * 3072 + h * 128 + hi * 8;
#pragma unroll
            for (int d0 = 0; d0 < 8; ++d0) qr[d0] = *(const mattn::bf16x8*)(Qw + d0 * 16); }
        __syncthreads();
        unsigned sel = 0u;
        if (j <= 3) sel = (1u << j) - 1u;
        else { float v0 = -INFINITY, v1 = -INFINITY, v2 = -INFINITY; int i0 = 0, i1 = 0, i2 = 0;
#pragma unroll 1
            for (int blk = 0; blk < j; ++blk) { float sdot = 0.f; const LAS float* km = kmS + blk * 128 + hi * 8;
#pragma unroll
                for (int d0 = 0; d0 < 8; ++d0) asm volatile("" : "+v"(qr[d0]));
#pragma unroll
                for (int d0 = 0; d0 < 8; ++d0) {
#pragma unroll
                    for (int e = 0; e < 8; ++e) sdot += __uint_as_float(((unsigned)(unsigned short)qr[d0][e]) << 16) * km[d0 * 16 + e];
                    __builtin_amdgcn_sched_barrier(0); }
                auto rr = __builtin_amdgcn_permlane32_swap(__float_as_uint(sdot), __float_as_uint(sdot), false, false);
                sdot = __uint_as_float(rr[0]) + __uint_as_float(rr[1]);
                if (sdot > v0) { v2 = v1; i2 = i1; v1 = v0; i1 = i0; v0 = sdot; i0 = blk; }
                else if (sdot > v1) { v2 = v1; i2 = i1; v1 = sdot; i1 = blk; }
                else if (sdot > v2) { v2 = sdot; i2 = blk; } }
            sel = (1u << i0) | (1u << i1) | (1u << i2); }
        const mattn::Msk mk{j, sel, w * 32 + r32};
        const bf16* Kh = QKV + ((size_t)b * SEQ) * 3072 + 1024 + h * 128;
        mattn::body(qr, Kh, Kh + 1024, O + qrow0 * 1024 + h * 128, (j + 1) * 256, ldsg, mk);
    }
}

__device__ __forceinline__ void ret_rot_table(Frame& F, const int* pos, float* cst) {
    const int gw = blockIdx.x * NWAVES + F.wave, NGW = F.G * NWAVES, lane = F.lane;
    const float i0 = exp2f(-(float)(2 * lane) * (13.287712379549449f / 128.0f)), i1 = exp2f(-(float)(2 * lane + 1) * (13.287712379549449f / 128.0f));
    for (int m = gw; m < MTOK; m += NGW) {
        const float ps = (float)pos[m]; float s0, c0, s1, c1; sincosf(ps * i0, &s0, &c0); sincosf(ps * i1, &s1, &c1);
        f32x2* cp = (f32x2*)(cst + (size_t)m * 256) + lane; cp[0] = (f32x2){c0, c1}; cp[64] = (f32x2){s0, s1};
    }
}
__device__ __forceinline__ void ret_pmat(Frame& F, const bf16* QKV, bf16* PM) {
    LAS bf16* Qd = (LAS bf16*)F.lds;
    LAS bf16* Kd = Qd + 128 * 72;
    LAS bf16* Ps = Kd + 128 * 72;
    const int tid = F.tid, lane = F.lane, w = F.wave, fr = lane & 15, fq = lane >> 4, wh = w >> 1, wl = w & 1;
    const unsigned off0 = (unsigned)((((tid >> 3) * 4096) + (tid & 7) * 8) * 2);
    for (int item = blockIdx.x; item < 1024; item += F.G) {
        const int b = item >> 6, h = (item >> 4) & 3, c = item & 15;
        const float lgc = log1pf(-exp2f(-5.0f - (float)h)) * 1.4426950408889634f;
        const char* gq = (const char*)(QKV + ((size_t)b * SEQ + c * 128) * 4096 + h * 256);
        v4u pq[2], pkk[2];
#pragma unroll
        for (int i = 0; i < 2; ++i) { const char* src = gq + off0 + i * (64 * 4096 * 2); pq[i] = *(const v4u*)src; pkk[i] = *(const v4u*)(src + 2048); }
        f32x4 S[2][4];
#pragma unroll
        for (int i = 0; i < 2; ++i)
#pragma unroll
            for (int jj = 0; jj < 4; ++jj) S[i][jj] = (f32x4){0.f, 0.f, 0.f, 0.f};
#pragma unroll 1
        for (int dt = 0; dt < 4; ++dt) {
            __syncthreads();
#pragma unroll
            for (int i = 0; i < 2; ++i) { const int id = tid + NTHR * i, row = id >> 3, c8 = id & 7; *(LAS v4u*)(Qd + row * 72 + c8 * 8) = pq[i]; *(LAS v4u*)(Kd + row * 72 + c8 * 8) = pkk[i]; }
            if (dt < 3) {
#pragma unroll
                for (int i = 0; i < 2; ++i) { const char* src = gq + (dt + 1) * 128 + off0 + i * (64 * 4096 * 2); pq[i] = *(const v4u*)src; pkk[i] = *(const v4u*)(src + 2048); } }
            __syncthreads();
            wgemm<2, 4, 64, 72, 72>(S, Qd + 32 * wh * 72, Kd + 64 * wl * 72, lane);
        }
#pragma unroll
        for (int i = 0; i < 2; ++i)
#pragma unroll
            for (int e = 0; e < 4; ++e) { const int t = 32 * wh + 16 * i + 4 * fq + e;
#pragma unroll
                for (int jj = 0; jj < 4; ++jj) { const int sidx = 64 * wl + 16 * jj + fr; const float wgt = (t >= sidx) ? __builtin_amdgcn_exp2f((float)(t - sidx) * lgc) : 0.f;
                    Ps[t * 136 + sidx] = (bf16)f2bf(S[i][jj][e] * wgt); } }
        __syncthreads();
        bf16* dst = PM + (size_t)item * 128 * 128;
#pragma unroll
        for (int i = 0; i < 4; ++i) { const int id = tid + NTHR * i, row = id >> 4, c8 = id & 15; *(v4u*)(dst + row * 128 + c8 * 8) = *(const LAS v4u*)(Ps + row * 136 + c8 * 8); }
    }
}
#ifndef RET_EXP
#define RET_EXP 0
#endif
__device__ __forceinline__ void ret_core(Frame& F, bf16* QKV, const bf16* PM, float* st) {
    constexpr int TSET = 3 * 128 * 72;
    LAS bf16* T0 = (LAS bf16*)F.lds;
    LAS bf16* Vs = T0 + 2 * TSET;
    LAS bf16* Ps = T0;
    LAS bf16* Xs = T0 + TSET;
    LAS float* fST = (LAS float*)(Vs + 128 * 144);
    const int tid = F.tid, lane = F.lane, w = F.wave, fr = lane & 15, fq = lane >> 4, wh = w >> 1, wl = w & 1;
    const unsigned off8 = (unsigned)((((tid >> 3) * 4096) + (tid & 7) * 8) * 2);
    const unsigned off16 = (unsigned)((((tid >> 4) * 4096) + (tid & 15) * 8) * 2);
    for (int item = blockIdx.x; item < 256; item += F.G) {
        const int it2 = (((item & 7) * 8 + ((item >> 3) >> 2)) << 2) | ((item >> 3) & 3);
        const int b = it2 >> 4, h = (it2 >> 2) & 3, vs = it2 & 3;
        const float lg = log1pf(-exp2f(-5.0f - (float)h)), gch = expf(128.0f * lg);
        f32x4 Racc[4][1][4];
#pragma unroll
        for (int dt = 0; dt < 4; ++dt)
#pragma unroll
            for (int jj = 0; jj < 4; ++jj) Racc[dt][0][jj] = (f32x4){0.f, 0.f, 0.f, 0.f};
        const size_t tb = (size_t)b * SEQ;
        __syncthreads();
        v4u pq[2], pkk[2], pv[4];
        { const char* gq0 = (const char*)(QKV + tb * 4096 + h * 256); const char* gv0 = (const char*)(QKV + tb * 4096 + 2048 + h * 512 + vs * 128);
#pragma unroll
            for (int i = 0; i < 2; ++i) { const char* src = gq0 + off8 + i * (64 * 4096 * 2); pq[i] = *(const v4u*)src; pkk[i] = *(const v4u*)(src + 2048); }
#pragma unroll
            for (int i = 0; i < 4; ++i) pv[i] = *(const v4u*)(gv0 + off16 + i * (32 * 4096 * 2)); }
        for (int c = 0; c < 16; ++c) {
            const size_t t0 = tb + c * 128;
            const char* gq = (const char*)(QKV + t0 * 4096 + h * 256);
            char* gy = (char*)(QKV + t0 * 4096 + 2048 + h * 512 + vs * 128);
            const bf16* pmt = PM + ((size_t)((b * 4 + h) * 16 + c)) * 128 * 128;
            float lgc = lg * 1.4426950408889634f; asm volatile("" : "+v"(lgc));
#pragma unroll
            for (int i = 0; i < 4; ++i) { const int id = tid + NTHR * i; *(LAS v4u*)(Vs + (id >> 4) * 144 + (id & 15) * 8) = pv[i]; }
            f32x4 X[2][4];
#pragma unroll
            for (int i = 0; i < 2; ++i)
#pragma unroll
                for (int jj = 0; jj < 4; ++jj) X[i][jj] = (f32x4){0.f, 0.f, 0.f, 0.f};
#pragma unroll 1
            for (int dt = 0; dt < 4; ++dt) {
                LAS bf16* Qd = T0 + (dt & 1) * TSET; LAS bf16* Kz = Qd + 128 * 72; LAS bf16* Rb = Kz + 128 * 72;
#pragma unroll
                for (int i = 0; i < 2; ++i) { const int id = tid + NTHR * i, row = id >> 3, c8 = id & 7; const float z = __builtin_amdgcn_exp2f((float)(127 - row) * lgc);
                    *(LAS v4u*)(Qd + row * 72 + c8 * 8) = pq[i];
                    v4u zo; zo.x = cvtpk(lo_bf(pkk[i].x) * z, hi_bf(pkk[i].x) * z); zo.y = cvtpk(lo_bf(pkk[i].y) * z, hi_bf(pkk[i].y) * z); zo.z = cvtpk(lo_bf(pkk[i].z) * z, hi_bf(pkk[i].z) * z); zo.w = cvtpk(lo_bf(pkk[i].w) * z, hi_bf(pkk[i].w) * z);
                    *(LAS v4u*)(Kz + row * 72 + c8 * 8) = zo; }
#pragma unroll
                for (int jj = 0; jj < 4; ++jj)
#pragma unroll
                    for (int e = 0; e < 4; ++e) Rb[(16 * w + 4 * fq + e) * 72 + 16 * jj + fr] = (bf16)f2bf(Racc[0][0][jj][e]);
#if RET_EXP == 3
                asm volatile("" ::: "memory");
#pragma unroll
                for (int jj = 0; jj < 4; ++jj)
#pragma unroll
                    for (int e = 0; e < 4; ++e) *(volatile LAS bf16*)(Rb + (16 * w + 4 * fq + e) * 72 + 16 * jj + fr) = (bf16)f2bf(Racc[0][0][jj][e]);
#endif
                if (dt < 3 || c < 15) {
                    const char* nb = (dt < 3) ? gq + (dt + 1) * 128 : gq + (size_t)128 * 4096 * 2;
#pragma unroll
                    for (int i = 0; i < 2; ++i) { const char* src = nb + off8 + i * (64 * 4096 * 2); pq[i] = *(const v4u*)src; pkk[i] = *(const v4u*)(src + 2048); } }
                __syncthreads();
                wgemm<2, 4, 64, 72, 72, false, false, false>(X, Qd + 32 * wh * 72, Rb + 64 * wl * 72, lane);
#if RET_EXP == 5
                { f32x4 D_[2][4];
#pragma unroll
                  for (int i = 0; i < 2; ++i)
#pragma unroll
                    for (int jj = 0; jj < 4; ++jj) D_[i][jj] = (f32x4){0.f, 0.f, 0.f, 0.f};
                  wgemm<2, 4, 64, 72, 72>(D_, Qd + 32 * wh * 72, Rb + 64 * wl * 72, lane);
#pragma unroll
                  for (int i = 0; i < 2; ++i)
#pragma unroll
                    for (int jj = 0; jj < 4; ++jj) asm volatile("" :: "v"(D_[i][jj])); }
#endif
#if RET_EXP == 6
                { f32x4 D_[1][4];
#pragma unroll
                    for (int jj = 0; jj < 4; ++jj) D_[0][jj] = (f32x4){0.f, 0.f, 0.f, 0.f};
                  wgemm<1, 4, 128, 136, 72, true, true>(D_, Vs + 16 * w, Kz, lane);
#pragma unroll
                    for (int jj = 0; jj < 4; ++jj) asm volatile("" :: "v"(D_[0][jj])); }
#endif
#pragma unroll
                for (int jj = 0; jj < 4; ++jj) Racc[0][0][jj] = Racc[0][0][jj] * gch;
                wgemm<1, 4, 128, 144, 72, true, true, false>(Racc[0], Vs + 16 * w, Kz, lane);
#pragma unroll
                for (int jj = 0; jj < 4; ++jj) { const f32x4 t_ = Racc[0][0][jj]; Racc[0][0][jj] = Racc[1][0][jj]; Racc[1][0][jj] = Racc[2][0][jj]; Racc[2][0][jj] = Racc[3][0][jj]; Racc[3][0][jj] = t_; }
            }
            v4u pp[4];
#pragma unroll
            for (int i = 0; i < 4; ++i) { const int id = tid + NTHR * i; pp[i] = *(const v4u*)(pmt + (id >> 4) * 128 + (id & 15) * 8); }
#if RET_EXP == 2
            asm volatile("s_waitcnt vmcnt(0)" ::: "memory");
#pragma unroll
            for (int i = 0; i < 4; ++i) { const int id = tid + NTHR * i; v4u q_ = *(const volatile v4u*)(pmt + 64 * 128 * 128 + (id >> 4) * 128 + (id & 15) * 8); asm volatile("" :: "v"(q_.x), "v"(q_.y), "v"(q_.z), "v"(q_.w)); }
            asm volatile("s_waitcnt vmcnt(0)" ::: "memory");
#endif
#pragma unroll
            for (int i = 0; i < 2; ++i)
#pragma unroll
                for (int e = 0; e < 4; ++e) { const int t = 32 * wh + 16 * i + 4 * fq + e; const float xi = __builtin_amdgcn_exp2f((float)(t + 1) * lgc);
#pragma unroll
                    for (int jj = 0; jj < 4; ++jj) X[i][jj][e] *= xi; }
#pragma unroll
            for (int i = 0; i < 4; ++i) { const int id = tid + NTHR * i; *(LAS v4u*)(Ps + (id >> 4) * 136 + (id & 15) * 8) = pp[i]; }
            __syncthreads();
            wgemm<2, 4, 128, 136, 144, false, true, false>(X, Ps + 32 * wh * 136, Vs + 64 * wl, lane);
#pragma unroll
            for (int i = 0; i < 2; ++i)
#pragma unroll
                for (int e = 0; e < 4; ++e) { const int t = 32 * wh + 16 * i + 4 * fq + e; float s1 = 0.f, s2 = 0.f;
#pragma unroll
                    for (int jj = 0; jj < 4; ++jj) { const float y = X[i][jj][e]; s1 += y; s2 += y * y; Xs[t * 136 + 64 * wl + 16 * jj + fr] = (bf16)f2bf(y); }
                    s1 += __shfl_xor(s1, 1); s1 += __shfl_xor(s1, 2); s1 += __shfl_xor(s1, 4); s1 += __shfl_xor(s1, 8);
                    s2 += __shfl_xor(s2, 1); s2 += __shfl_xor(s2, 2); s2 += __shfl_xor(s2, 4); s2 += __shfl_xor(s2, 8);
                    if (fr == 0) { fST[(wl * 128 + t) * 2] = s1; fST[(wl * 128 + t) * 2 + 1] = s2; } }
            if (c < 15) { const char* gvn = gy + (size_t)128 * 4096 * 2;
#pragma unroll
                for (int i = 0; i < 4; ++i) pv[i] = *(const v4u*)(gvn + off16 + i * (32 * 4096 * 2)); }
            __syncthreads();
#pragma unroll
            for (int i = 0; i < 4; ++i) { const int id = tid + NTHR * i, row = id >> 4, c8 = id & 15; *(v4u*)(gy + (unsigned)((row * 4096 + c8 * 8) * 2)) = *(const LAS v4u*)(Xs + row * 136 + c8 * 8); }
            if (tid < 128) { float* sp = st + (t0 + tid) * 32 + (h * 4 + vs) * 2; sp[0] = fST[tid * 2] + fST[(128 + tid) * 2]; sp[1] = fST[tid * 2 + 1] + fST[(128 + tid) * 2 + 1]; }
        }
    }
}

__device__ __forceinline__ void lru_conv(Frame& F, const bf16* GX, const float* cw, const float* cb, bf16* XC, const float* lru, float* sptab) {
    if (blockIdx.x == 0) for (int i = F.tid; i < 1024; i += NTHR) { const float l = -lru[i]; sptab[i] = fmaxf(l, 0.f) + log1pf(expf(-fabsf(l))); }
    const int c8 = F.tid & 127, rsub = F.tid >> 7;
    f32x4 w0[4], w1[4];
#pragma unroll
    for (int wv = 0; wv < 4; ++wv) { w0[wv] = *(const f32x4*)(cw + wv * 1024 + c8 * 8); w1[wv] = *(const f32x4*)(cw + wv * 1024 + c8 * 8 + 4); }
    const f32x4 b0 = *(const f32x4*)(cb + c8 * 8), b1 = *(const f32x4*)(cb + c8 * 8 + 4);
    for (int r0 = blockIdx.x * 16; r0 < MTOK; r0 += F.G * 16) {
        const int rb = r0 + 4 * rsub, t = rb & (SEQ - 1);
        v4u xin[7];
#pragma unroll
        for (int k = 0; k < 7; ++k) { const int rr = rb - 3 + k; xin[k] = (t - 3 + k >= 0) ? *(const v4u*)(GX + (size_t)rr * 2048 + 1024 + c8 * 8) : (v4u){0u, 0u, 0u, 0u}; }
#pragma unroll
        for (int q = 0; q < 4; ++q) { f32x4 a0 = b0, a1 = b1;
#pragma unroll
            for (int wv = 0; wv < 4; ++wv) { const v4u x = xin[q + wv];
                a0 += (f32x4){lo_bf(x.x), hi_bf(x.x), lo_bf(x.y), hi_bf(x.y)} * w0[wv]; a1 += (f32x4){lo_bf(x.z), hi_bf(x.z), lo_bf(x.w), hi_bf(x.w)} * w1[wv]; }
            v4u o; o.x = cvtpk(a0[0], a0[1]); o.y = cvtpk(a0[2], a0[3]); o.z = cvtpk(a1[0], a1[1]); o.w = cvtpk(a1[2], a1[3]);
            *(v4u*)(XC + (size_t)(rb + q) * 1024 + c8 * 8) = o; }
    }
}
__device__ __forceinline__ float gelu_tanh(float x) { const float z = 0.7978845608028654f * (x + 0.044715f * x * x * x); const float e = __expf(2.0f * z); const float th = 1.0f - 2.0f * __builtin_amdgcn_rcpf(e + 1.0f); return 0.5f * x * (1.0f + th); }
__device__ __forceinline__ void lru_scan(Frame& F, const bf16* LA, const bf16* BT, const bf16* GX, bf16* Y) {
    LAS float* segL = (LAS float*)F.lds;
    LAS float* segH = segL + 512;
    const int lane = F.lane, w = F.wave;
    LAS bf16* tl = (LAS bf16*)(F.lds + 8192) + w * 4096;
    const int srow = lane >> 3, sc8 = (lane & 7) * 8;
#define LRU_WLOAD(dst, p, ld, t0) do { dst[0] = *(const v4u*)((p) + (size_t)((t0) + srow) * (ld) + sc8); dst[1] = *(const v4u*)((p) + (size_t)((t0) + srow + 8) * (ld) + sc8); } while (0)
#define LRU_WPUT(tile, src) do { *(LAS v4u*)((tile) + srow * 64 + sc8) = src[0]; *(LAS v4u*)((tile) + (srow + 8) * 64 + sc8) = src[1]; } while (0)
    for (int item = blockIdx.x; item < 256; item += F.G) {
        const int b = item >> 4, c0 = (item & 15) * 64;
        const size_t r0 = (size_t)b * SEQ + w * 256;
        const bf16* la_p = LA + r0 * 1024 + c0; const bf16* bt_p = BT + r0 * 1024 + c0; const bf16* gx_p = GX + r0 * 2048 + c0; bf16* y_p = Y + r0 * 1024 + c0;
        float L = 0.f, H = 0.f;
        v4u pl[2], pb[2], pg[2];
        LRU_WLOAD(pl, la_p, 1024, 0); LRU_WLOAD(pb, bt_p, 1024, 0);
#pragma unroll 1
        for (int tb = 0; tb < 16; ++tb) {
            asm volatile("" ::: "memory"); LRU_WPUT(tl, pl); LRU_WPUT(tl + 1024, pb); asm volatile("" ::: "memory");
            if (tb + 1 < 16) { LRU_WLOAD(pl, la_p, 1024, (tb + 1) * 16); LRU_WLOAD(pb, bt_p, 1024, (tb + 1) * 16); }
#pragma unroll
            for (int k = 0; k < 16; ++k) { const float la = bf2f(tl[k * 64 + lane]); L += la; H = __expf(la) * H + bf2f(tl[1024 + k * 64 + lane]); }
        }
        __syncthreads();
        segL[w * 64 + lane] = L; segH[w * 64 + lane] = H;
        __syncthreads();
        float hc = 0.f;
        for (int sg = 0; sg < w; ++sg) hc = __expf(segL[sg * 64 + lane]) * hc + segH[sg * 64 + lane];
        LRU_WLOAD(pl, la_p, 1024, 0); LRU_WLOAD(pb, bt_p, 1024, 0); LRU_WLOAD(pg, gx_p, 2048, 0);
#pragma unroll 1
        for (int tb = 0; tb < 16; ++tb) {
            asm volatile("" ::: "memory"); LRU_WPUT(tl, pl); LRU_WPUT(tl + 1024, pb); LRU_WPUT(tl + 2048, pg); asm volatile("" ::: "memory");
            if (tb + 1 < 16) { LRU_WLOAD(pl, la_p, 1024, (tb + 1) * 16); LRU_WLOAD(pb, bt_p, 1024, (tb + 1) * 16); LRU_WLOAD(pg, gx_p, 2048, (tb + 1) * 16); }
#pragma unroll
            for (int k = 0; k < 16; ++k) { hc = __expf(bf2f(tl[k * 64 + lane])) * hc + bf2f(tl[1024 + k * 64 + lane]); tl[3072 + k * 64 + lane] = (bf16)f2bf(hc * gelu_tanh(bf2f(tl[2048 + k * 64 + lane]))); }
            asm volatile("" ::: "memory");
            const v4u y0 = *(const LAS v4u*)(tl + 3072 + srow * 64 + sc8), y1 = *(const LAS v4u*)(tl + 3072 + (srow + 8) * 64 + sc8);
            *(v4u*)(y_p + (size_t)(tb * 16 + srow) * 1024 + sc8) = y0; *(v4u*)(y_p + (size_t)(tb * 16 + srow + 8) * 1024 + sc8) = y1;
        }
        __syncthreads();
    }
#undef LRU_WLOAD
#undef LRU_WPUT
}

#ifndef WGM_BIG
#define WGM_BIG 3
#endif
#ifndef WGM_N4
#define WGM_N4 4
#endif
#ifndef WGM_MID
#define WGM_MID 4
#endif
template <class Epi>
__device__ __forceinline__ void run_gemm(Frame& F, const bf16* A, int lda, const bf16* Bt, int ldb, int N, int K, const Epi& E, int M = MTOK, int ablk = 0) {
    pg8::Gemm g{A, Bt, M, N, K, lda, ldb, ablk}; pg8::StaticOrder S; S.init(M, N, F.G, (int)blockIdx.x, (N >= 4096) ? WGM_BIG : (N <= 1024 ? WGM_N4 : WGM_MID));
#ifndef STAGGER_NG
#define STAGGER_NG 1
#endif
#ifndef STAGGER_STEP
#define STAGGER_STEP 300
#endif
    if (STAGGER_NG > 1 && N >= 4096 && M == MTOK) {
        const unsigned grp = (((unsigned)blockIdx.x >> 3) & 7u) / (8 / STAGGER_NG);
        if (grp) { const unsigned long long t0 = __builtin_amdgcn_s_memrealtime(), dl = (unsigned long long)grp * STAGGER_STEP;
            while (__builtin_amdgcn_s_memrealtime() - t0 < dl) __builtin_amdgcn_s_sleep(8); }
    }
#ifndef FUSE_NX
#define FUSE_NX false
#endif
#ifndef GEMM_ALIGN
#define GEMM_ALIGN true
#endif
#ifndef GEMM_SP2
#define GEMM_SP2 true
#endif
    pg8::gemm_phase<Epi, pg8::StaticOrder, GEMM_ALIGN, GEMM_SP2>(F.lds, g, S, E);
}

typedef const __attribute__((address_space(4))) struct Args* ArgsP;
constexpr int NPHASE = 35;
__device__ __forceinline__ ArgsP get_args() { ArgsP p = (ArgsP)__builtin_amdgcn_kernarg_segment_ptr(); asm volatile("" : "+s"(p)); return p; }
__device__ __forceinline__ bool in_phase(int k) { ArgsP a = get_args(); return a->ph_lo <= k && k < a->ph_hi; }
#ifndef DUP_PHASE
#define DUP_PHASE -1
#endif
#ifndef BAR_EXP
#define BAR_EXP 0
#endif
#ifndef TIMING_MASK
#define TIMING_MASK 0ull
#endif
#define TMISC ((volatile LAS unsigned long long*)((LAS unsigned char*)lds_raw + MISC_OFF))
#define TB(k) do { if (((TIMING_MASK >> (k)) & 1ull) && blockIdx.x == 0 && threadIdx.x == 0) TMISC[0] = __builtin_amdgcn_s_memrealtime(); } while (0)
#define TE(k) do { if (((TIMING_MASK >> (k)) & 1ull) && blockIdx.x == 0 && threadIdx.x == 0) TMISC[1] = TMISC[1] + (__builtin_amdgcn_s_memrealtime() - TMISC[0]); } while (0)
#define REP(k) TB(k); for (int rep_ = 0; rep_ < ((k) == DUP_PHASE ? 2 : 1); ++rep_)
#define AP ArgsP ap = get_args(); { int t_ = threadIdx.x; asm volatile("" : "+v"(t_)); F.tid = t_; F.lane = t_ & 63; F.wave = __builtin_amdgcn_readfirstlane(t_ >> 6); F.G = gridDim.x; F.lds = (LAS unsigned char*)lds_raw; }
__global__ void __launch_bounds__(NTHR, 2) trunk_fwd(Args args) {
    extern __shared__ __attribute__((aligned(16))) unsigned char lds_raw[];
    Frame F; F.lds = (LAS unsigned char*)lds_raw; F.tid = threadIdx.x; F.lane = F.tid & 63; F.wave = __builtin_amdgcn_readfirstlane(F.tid >> 6); F.G = gridDim.x;
    volatile LAS unsigned* MISC = (volatile LAS unsigned*)(F.lds + MISC_OFF);
    if (F.tid < 16) MISC[F.tid] = 0u;
    __syncthreads();
    if (args.ph_hi - args.ph_lo > 1) (void)xcd_barrier_post((unsigned*)(args.ws + WS_CTL) + CW_BAR, MISC + 8);
#ifndef ONLY_PHASE
#define ONLY_PHASE -1
#endif
#define IN(k) ((ONLY_PHASE < 0 || (k) == ONLY_PHASE) && in_phase(k))
#define SEAM(k) do { if (IN(k) && IN((k) + 1)) { XcdBarrier bb; bb.bar = (unsigned*)(get_args()->ws + WS_CTL) + CW_BAR; bb.x = xb_xcc_id(); bb.st = (volatile LAS unsigned*)((LAS unsigned char*)lds_raw + MISC_OFF) + 8; xcd_barrier(bb); if (BAR_EXP) xcd_barrier(bb); } if (IN(k)) TE(k); } while (0)
#define XIN ((const float*)ap->in[0])
#define pos ((const int*)ap->in[1])
#define norm_mix ((const float*)ap->in[2])
#define norm_ffn ((const float*)ap->in[3])
#define ffn_w_in ((const float*)ap->in[4])
#define ffn_w_out ((const float*)ap->in[5])
#define out (ap->out)
#define WSET_D (WS_U - WS_W_MIXIN)
#define Wmi ((bf16*)(ap->ws + WS_W_MIXIN + WS_SET * WSET_D))
#define Wmo ((bf16*)(ap->ws + WS_W_MIXOUT + WS_SET * WSET_D))
#define Wfi ((bf16*)(ap->ws + WS_W_FFNIN + WS_SET * WSET_D))
#define Wfo ((bf16*)(ap->ws + WS_W_FFNOUT + WS_SET * WSET_D))
#define WmiN ((bf16*)(ap->ws + WS_W_MIXIN + (1 - WS_SET) * WSET_D))
#define WmoN ((bf16*)(ap->ws + WS_W_MIXOUT + (1 - WS_SET) * WSET_D))
#define WfiN ((bf16*)(ap->ws + WS_W_FFNIN + (1 - WS_SET) * WSET_D))
#define WfoN ((bf16*)(ap->ws + WS_W_FFNOUT + (1 - WS_SET) * WSET_D))
#define U ((bf16*)(ap->ws + WS_U))
#define BIG ((bf16*)(ap->ws + WS_BIG))
#define gatesA ((float*)(ap->ws + WS_GATESA))
#define ssqA ((float*)(ap->ws + WS_SSQA))
#define statC ((float*)(ap->ws + WS_STATC))
#define kmean ((float*)(ap->ws + WS_KMEAN))
#define sptab ((float*)(ap->ws + WS_SPTAB))
#define ssqH ((float*)(ap->ws + WS_SSQH))

#define a_w_in ((const float*)ap->in[6])
#define a_b ((const float*)ap->in[7])
#define a_g ((const float*)ap->in[8])
#define a_w_out ((const float*)ap->in[9])
#define b_w_in ((const float*)ap->in[10])
#define b_gq ((const float*)ap->in[11])
#define b_gk ((const float*)ap->in[12])
#define b_w_out ((const float*)ap->in[13])
#define c_w_in ((const float*)ap->in[14])
#define c_g ((const float*)ap->in[15])
#define c_w_out ((const float*)ap->in[16])
#define d_w_in ((const float*)ap->in[17])
#define d_cw ((const float*)ap->in[18])
#define d_cb ((const float*)ap->in[19])
#define d_wg ((const float*)ap->in[20])
#define d_bg ((const float*)ap->in[21])
#define d_lru ((const float*)ap->in[22])
#define d_w_out ((const float*)ap->in[23])
#define GX BIG
#define XC (BIG + (size_t)MTOK * 2048)
#define LA (BIG + (size_t)MTOK * 3072)
#define BT (BIG + (size_t)MTOK * 4096)
#define Y (BIG + (size_t)MTOK * 3072)
#define HB (BIG + (size_t)MTOK * 5120)
#define Wg (Wmi + (size_t)2048 * DM)
#define FFN_CVT(l) do { cvt_matrix(F, ffn_w_in + (size_t)(l) * DM * 2 * DFF, 2 * DFF, DM, 2 * DFF, 1, Wfi, norm_ffn + (l) * DM); cvt_matrix(F, ffn_w_out + (size_t)(l) * DFF * DM, DM, DFF, DM, 0, Wfo); } while (0)
#define FFN_CVT_N(l) do { cvt_matrix(F, ffn_w_in + (size_t)(l) * DM * 2 * DFF, 2 * DFF, DM, 2 * DFF, 1, WfiN, norm_ffn + (l) * DM); cvt_matrix(F, ffn_w_out + (size_t)(l) * DFF * DM, DM, DFF, DM, 0, WfoN); } while (0)
#define YS (BIG + 2048)
#define PMB (BIG + (size_t)MTOK * 4096)
#define CSTB ((float*)(BIG + (size_t)MTOK * 4096 + (size_t)16 * 1024 * 1024))
#define CVT_NEXT_0 do { cvt_matrix(F, b_w_in, 3072, DM, 3072, 0, WmiN, norm_mix + DM); cvt_matrix(F, b_w_out, DM, DM, DM, 0, WmoN); FFN_CVT_N(1); } while (0)
#define CVT_NEXT_1 do { cvt_matrix(F, c_w_in, 6144, DM, 6144, 0, WmiN, norm_mix + 2 * DM); cvt_matrix(F, c_w_out, DM, 2048, DM, 0, WmoN); FFN_CVT_N(2); } while (0)
#define CVT_NEXT_2 do { cvt_matrix(F, d_w_in, 2048, DM, 2048, 0, WmiN, norm_mix + 3 * DM); \
        _Pragma("unroll 1") for (int blk = 0; blk < 4; ++blk) cvt_matrix(F, d_wg + (size_t)blk * 256 * 512, 512, 256, 512, 2, WmiN + (size_t)2048 * DM + (size_t)blk * 512 * 256); \
        cvt_matrix(F, d_w_out, DM, DM, DM, 0, WmoN); FFN_CVT_N(3); } while (0)
#define CVT_NEXT_3 do { } while (0)
#define RED ((PG8_LAS float*)(F.lds + 131072))
#define FFN_PHASES(p0, l) do { \
    if (IN((p0) + 1)) { AP; REP((p0) + 1) { pg8::EpiSwiGLU<true> E{BIG, DFF, ssqH}; run_gemm(F, HB, DM, Wfi, DM, 2 * DFF, DM, E); } } SEAM((p0) + 1); \
    if (IN((p0) + 2)) { AP; REP((p0) + 2) { if ((l) < 3) { pg8::EpiResidB<true, true> E{HB, HB, ssqH, RED}; run_gemm(F, BIG, DFF, Wfo, DFF, DM, DFF, E); } else { pg8::EpiResidF E{HB, out}; run_gemm(F, BIG, DFF, Wfo, DFF, DM, DFF, E); } \
        __syncthreads(); CVT_NEXT_##l; } } SEAM((p0) + 2); } while (0)
#define QKV BIG
#define WS_SET 0
#define HO (BIG + (size_t)MTOK * 2048)
#define PMAB (BIG + (size_t)MTOK * 3072)
#define GTB ((float*)(BIG + (size_t)MTOK * 3584))
#define DENB ((float*)(BIG + (size_t)MTOK * 3584) + 2048 * 320)
    if (IN(0)) { AP; REP(0) { cvt_matrix(F, a_w_in, 3080, DM, 3072, 0, Wmi); cvt_matrix(F, a_w_out, DM, DM, DM, 0, Wmo); FFN_CVT(0);
        __syncthreads(); norm_phase<true>(F, XIN, norm_mix, U, a_w_in, a_b, gatesA); } } SEAM(0);
    if (IN(1)) { AP; REP(1) { { pg8::EpiStore<false> E{QKV, 2048, nullptr}; run_gemm(F, U, DM, Wmi, DM, 2048, DM, E); } __syncthreads(); mlstm_pre(F, gatesA, GTB); } } SEAM(1);
    if (IN(2)) { AP; REP(2) { mlstm_pmat(F, QKV, GTB, PMAB, DENB); } } SEAM(2);
    if (IN(3)) { AP; REP(3) { mlstm_core(F, QKV, GTB, PMAB, DENB, HO, ssqA); } } SEAM(3);
    if (IN(4)) { AP; REP(4) { pg8::EpiGateA E{HO, ssqA, a_g}; run_gemm(F, U, DM, Wmi + (size_t)2048 * DM, DM, DM, DM, E); } } SEAM(4);
    if (IN(5)) { AP; REP(5) { pg8::EpiResidB<false, true> E{XIN, HB, ssqH, RED}; run_gemm(F, HO, DM, Wmo, DM, DM, DM, E); } } SEAM(5);
    FFN_PHASES(6, 0);
#define OB (BIG + (size_t)MTOK * 3072)
#define VTB (BIG + (size_t)MTOK * 2048)
#undef WS_SET
#define WS_SET 1
    if (IN(10)) { AP; REP(10) { pg8::EpiStore<true> E{QKV, 3072, ssqH}; run_gemm(F, HB, DM, Wmi, DM, 3072, DM, E); } } SEAM(10);
    if (IN(11)) { AP; REP(11) { moba_prep(F, QKV, pos, b_gq, b_gk, kmean); } } SEAM(11);
    if (IN(12)) { AP; REP(12) { moba_attn(F, QKV, kmean, OB); } } SEAM(12);
    if (IN(13)) { AP; REP(13) { pg8::EpiResidB<true, true> E{HB, HB, ssqH, RED}; run_gemm(F, OB, DM, Wmo, DM, DM, DM, E); } } SEAM(13);
    FFN_PHASES(14, 1);
#undef WS_SET
#define WS_SET 0
    if (IN(18)) { AP; REP(18) { pg8::EpiStoreRot<true> E{QKV, pos, ssqH}; run_gemm(F, HB, DM, Wmi, DM, 4096, DM, E); } } SEAM(18);
    if (IN(19)) { AP; REP(19) { ret_pmat(F, QKV, PMB); } } SEAM(19);
    if (IN(20)) { AP; REP(20) { ret_core(F, QKV, PMB, statC); } } SEAM(20);
    if (IN(21)) { AP; REP(21) { pg8::EpiGateC<true> E{YS, 4096, statC, c_g, ssqH}; run_gemm(F, HB, DM, Wmi + (size_t)4096 * DM, DM, 2048, DM, E); } } SEAM(21);
    if (IN(22)) { AP; REP(22) { pg8::EpiResidB<true, true> E{HB, HB, ssqH, RED}; run_gemm(F, YS, 4096, Wmo, 2048, DM, 2048, E); } } SEAM(22);
    FFN_PHASES(23, 2);
#undef WS_SET
#define WS_SET 1
    if (IN(27)) { AP; REP(27) { pg8::EpiStore<true> E{GX, 2048, ssqH}; run_gemm(F, HB, DM, Wmi, DM, 2048, DM, E); } } SEAM(27);
    if (IN(28)) { AP; REP(28) { lru_conv(F, GX, d_cw, d_cb, XC, d_lru, sptab); } } SEAM(28);
    if (IN(29)) { AP; REP(29) { pg8::EpiLru E{XC, LA, BT, d_bg, sptab}; run_gemm(F, XC, DM, Wg, 256, 2048, 256, E, MTOK, 256); } } SEAM(29);
    if (IN(30)) { AP; REP(30) { lru_scan(F, LA, BT, GX, Y); } } SEAM(30);
    if (IN(31)) { AP; REP(31) { pg8::EpiResidB<true, true> E{HB, HB, ssqH, RED}; run_gemm(F, Y, DM, Wmo, DM, DM, DM, E); } } SEAM(31);
    FFN_PHASES(32, 3);
    if (TIMING_MASK != 0ull && blockIdx.x == 0 && threadIdx.x == 0) { const unsigned long long t0_ = __builtin_amdgcn_s_memrealtime(); const unsigned long long tacc_ = TMISC[1]; while (__builtin_amdgcn_s_memrealtime() - t0_ < tacc_) __builtin_amdgcn_s_sleep(8); }
#undef IN
#undef SEAM
#undef XIN
#undef pos
#undef norm_mix
#undef norm_ffn
#undef ffn_w_in
#undef ffn_w_out
#undef out
#undef Wmi
#undef WmiN
#undef WmoN
#undef WfiN
#undef WfoN
#undef WS_SET
#undef WSET_D
#undef Wmo
#undef Wfi
#undef Wfo
#undef U
#undef BIG
#undef gatesA
#undef ssqA
#undef statC
#undef kmean
#undef sptab
#undef a_w_in
#undef a_b
#undef a_g
#undef a_w_out
#undef b_w_in
#undef b_gq
#undef b_gk
#undef b_w_out
#undef c_w_in
#undef c_g
#undef c_w_out
#undef d_w_in
#undef d_cw
#undef d_cb
#undef d_wg
#undef d_bg
#undef d_lru
#undef d_w_out
#undef GX
#undef XC
#undef LA
#undef BT
#undef Y
#undef Wg
#undef FFN_CVT
#undef OB
#undef HB
#undef RED
#undef CSTB
#undef PMAB
#undef GTB
#undef DENB
#undef PMB
#undef VTB
#undef FFN_PHASES
#undef QKV
#undef HO
#undef YS
#undef ssqH
}

#ifndef MK_ONE_LAUNCH
#define MK_ONE_LAUNCH 1
#endif
extern "C" void kernel_launch(void* const* d_in, const int* in_sizes, int n_in, void* d_out, int out_size, void* d_ws, size_t ws_size, hipStream_t stream) {
    static int grid = 0;
    if (grid == 0) {
        if (n_in != 24 || out_size != MTOK * DM || ws_size < WS_END) { fprintf(stderr, "kernel_launch: unexpected shapes (n_in %d, out %d, ws %zu); nothing launched\n", n_in, out_size, ws_size); grid = -1; return; }
        int dev = 0, cus = 0, per_cu = 0;
        if (hipGetDevice(&dev) != hipSuccess || hipDeviceGetAttribute(&cus, hipDeviceAttributeMultiprocessorCount, dev) != hipSuccess) { grid = -1; return; }
        if (hipFuncSetAttribute((const void*)trunk_fwd, hipFuncAttributeMaxDynamicSharedMemorySize, LDS_BYTES) != hipSuccess) { fprintf(stderr, "kernel_launch: hipFuncSetAttribute failed\n"); grid = -1; return; }
        if (hipOccupancyMaxActiveBlocksPerMultiprocessor(&per_cu, (const void*)trunk_fwd, NTHR, LDS_BYTES) != hipSuccess || per_cu < 1) { fprintf(stderr, "kernel_launch: occupancy query reports %d blocks per CU\n", per_cu); }
        (void)hipGetLastError();
        grid = cus;
    }
    if (grid < 0) return;
    (void)hipMemsetAsync((char*)d_ws + WS_CTL, 0, CTL_ZERO_BYTES, stream);
    Args a{};
    for (int i = 0; i < 24; ++i) a.in[i] = d_in[i];
    a.out = (float*)d_out; a.ws = (unsigned char*)d_ws;
#if MK_ONE_LAUNCH
    a.ph_lo = 0; a.ph_hi = NPHASE;
    hipLaunchKernelGGL(trunk_fwd, dim3(grid), dim3(NTHR), LDS_BYTES, stream, a);
#else
    for (int p = 0; p < NPHASE; ++p) { a.ph_lo = p; a.ph_hi = p + 1; hipLaunchKernelGGL(trunk_fwd, dim3(grid), dim3(NTHR), LDS_BYTES, stream, a); }
#endif
}
```
